# Optimizing an MI355X kernel written in HIP

```python
import math
import jax, jax.numpy as jnp
from jax import lax
import numpy as np

D_MODEL = 2048
BATCH = 4
SEQ = 4096
DEPTH = 1
DEC_BATCH = 128
DEC_SEQ = 4
PAST_LEN = 16384
PAGE_SIZE = 128

RMS_EPS = 1e-6
MIX_WIDTH = D_MODEL
HGRN_EXPAND = 128
HGRN_VAL_WIDTH = MIX_WIDTH // 2
HGRN_HEADS = HGRN_VAL_WIDTH // HGRN_EXPAND
HGRN_DK = HGRN_EXPAND
HGRN_DV = HGRN_VAL_WIDTH // HGRN_HEADS
HGRN_KEY_WIDTH = HGRN_HEADS * HGRN_DK
HGRN_CHUNK = 16
SWA_WIDTH = MIX_WIDTH - HGRN_VAL_WIDTH
SWA_HEAD_DIM = 64
SWA_HEADS = SWA_WIDTH // SWA_HEAD_DIM
SWA_KV_HEADS = 2
SWA_GROUP = SWA_HEADS // SWA_KV_HEADS
SWA_KV_WIDTH = SWA_KV_HEADS * SWA_HEAD_DIM
SWA_WINDOW = 128
REL_BUCKETS = 32
REL_MAX_EXACT = REL_BUCKETS // 2
REL_MAX_DIST = 128
N_MEM = 256
MEM_HEADS = 4
MEM_HEAD_DIM = 128
MEM_WIDTH = MEM_HEADS * MEM_HEAD_DIM
FFN_HIDDEN = -(-8 * D_MODEL // (3 * 256)) * 256
IN_SIZES = (HGRN_KEY_WIDTH, HGRN_KEY_WIDTH, HGRN_VAL_WIDTH, HGRN_VAL_WIDTH,
            SWA_WIDTH, SWA_KV_WIDTH, SWA_KV_WIDTH)
IN_WIDTH = sum(IN_SIZES)
IN_SPLITS = tuple(sum(IN_SIZES[:i + 1]) for i in range(len(IN_SIZES) - 1))

kernel_name = "hymba_hgrn2_swa_sink_memxattn_step"


def rmsnorm(x, w, eps=RMS_EPS):
    xf = x.astype(jnp.float32)
    xf = xf * lax.rsqrt(jnp.mean(xf * xf, axis=-1, keepdims=True) + eps)
    return (xf * w.astype(jnp.float32)).astype(x.dtype)


def hgrn_lower_bounds(lb_logits):
    p = jax.nn.softmax(lb_logits.astype(jnp.float32), axis=0)
    return jnp.cumsum(p, axis=0)[:DEPTH]


def hgrn2_scan(q, k, g, v, s0):
    B, L, H, DK = q.shape
    C = math.gcd(L, HGRN_CHUNK)
    N = L // C
    qc, kc, gc, vc = (t.reshape(B, N, C, H, t.shape[-1]) for t in (q, k, g, v))
    G = jnp.cumsum(gc, axis=2)
    causal = jnp.tril(jnp.ones((C, C), bool))[None, None, :, :, None, None]
    diff = G[:, :, :, None] - G[:, :, None, :]
    decay = jnp.exp(jnp.where(causal, diff, -jnp.inf))
    attn = jnp.einsum('bnthc,bnshc,bntshc->bnhts', qc, kc, decay)
    o_intra = jnp.einsum('bnhts,bnshe->bnthe', attn, vc)
    g_last = G[:, :, -1]
    q_in = qc * jnp.exp(G)
    k_up = kc * jnp.exp(g_last[:, :, None] - G)

    def step(S, xs):
        q_n, k_n, v_n, gl_n = xs
        o = jnp.einsum('bthc,bhce->bthe', q_n, S)
        S = jnp.exp(gl_n)[..., None] * S + jnp.einsum('bshc,bshe->bhce', k_n, v_n)
        return S, o

    xs = tuple(jnp.moveaxis(t, 1, 0) for t in (q_in, k_up, vc, g_last))
    s_final, o_inter = lax.scan(step, s0.astype(jnp.float32), xs)
    o = o_intra + jnp.moveaxis(o_inter, 0, 1)
    return o.reshape(B, L, H, v.shape[-1]), s_final


def hgrn_group(hq, hf, hi, hg, lb, onorm_w, s0):
    B, L, _ = hq.shape
    f = lb + (1.0 - lb) * jax.nn.sigmoid(hf.astype(jnp.float32))
    heads = lambda t, d: t.astype(jnp.float32).reshape(B, L, HGRN_HEADS, d)
    q = heads(hq, HGRN_DK)
    g = heads(jnp.log(f), HGRN_DK)
    k = heads(1.0 - f, HGRN_DK)
    i = heads(hi, HGRN_DV)
    o, s_new = hgrn2_scan(q, k, g, i, s0)
    o = rmsnorm(o, onorm_w) * jax.nn.silu(heads(hg, HGRN_DV))
    return o.reshape(B, L, HGRN_VAL_WIDTH).astype(hq.dtype), s_new


def rel_bucket(dist):
    n = jnp.maximum(dist, 0)
    nf = jnp.maximum(n, 1).astype(jnp.float32)
    large = REL_MAX_EXACT + (jnp.log(nf / REL_MAX_EXACT) / math.log(REL_MAX_DIST / REL_MAX_EXACT)
                             * (REL_BUCKETS - REL_MAX_EXACT)).astype(jnp.int32)
    large = jnp.minimum(large, REL_BUCKETS - 1)
    return jnp.where(n < REL_MAX_EXACT, n, large)


def swa_band(q, k, v, key_valid, sinks, rel_bias):
    B, N, Qn, _ = q.shape
    Kn = k.shape[2]
    qh = q.astype(jnp.float32).reshape(B, N, Qn, SWA_KV_HEADS, SWA_GROUP, SWA_HEAD_DIM)
    kh = k.astype(jnp.float32).reshape(B, N, Kn, SWA_KV_HEADS, SWA_HEAD_DIM)
    vh = v.astype(jnp.float32).reshape(B, N, Kn, SWA_KV_HEADS, SWA_HEAD_DIM)
    dist = (jnp.arange(Qn)[:, None] + (Kn - Qn)) - jnp.arange(Kn)[None, :]
    bias = rel_bias.astype(jnp.float32)[rel_bucket(dist)]
    bias = jnp.transpose(bias, (2, 0, 1)).reshape(SWA_KV_HEADS, SWA_GROUP, Qn, Kn)
    s = jnp.einsum('bnqkgd,bnskd->bnkgqs', qh, kh) * (SWA_HEAD_DIM ** -0.5) + bias
    mask = ((dist >= 0) & (dist < SWA_WINDOW))[None] & key_valid[:, None, :]
    s = jnp.where(mask[None, :, None, None], s, -jnp.inf)
    sink = sinks.astype(jnp.float32).reshape(SWA_KV_HEADS, SWA_GROUP)[:, :, None, None]
    m = jnp.maximum(jnp.max(s, axis=-1, keepdims=True), sink)
    p = jnp.exp(s - m)
    p = p / (jnp.sum(p, axis=-1, keepdims=True) + jnp.exp(sink - m))
    o = jnp.einsum('bnkgqs,bnskd->bnqkgd', p, vh)
    return o.reshape(B, N, Qn, SWA_WIDTH).astype(q.dtype)


def token_mixer(h, s0, k_buf, v_buf, lb, w_in, hgrn_onorm_w, swa_sinks, rel_bias, w_out):
    B, L, _ = h.shape
    hq, hf, hi, hg, sq, sk, sv = jnp.split(h @ w_in, IN_SPLITS, axis=-1)
    a_out, s_new = hgrn_group(hq, hf, hi, hg, lb, hgrn_onorm_w, s0)
    if k_buf is None:
        nb = L // SWA_WINDOW
        qb = sq.reshape(B, nb, SWA_WINDOW, SWA_WIDTH)

        def band(t):
            tb = t.reshape(B, nb, SWA_WINDOW, SWA_KV_WIDTH)
            prev = jnp.concatenate([jnp.zeros_like(tb[:, :1]), tb[:, :-1]], axis=1)
            return jnp.concatenate([prev, tb], axis=2)

        kb, vb = band(sk), band(sv)
        key_valid = (jnp.arange(nb)[:, None] > 0) | (jnp.arange(2 * SWA_WINDOW)[None, :] >= SWA_WINDOW)
        k_last, v_last = sk[:, -SWA_WINDOW:], sv[:, -SWA_WINDOW:]
    else:
        qb = sq[:, None]
        k_all = jnp.concatenate([k_buf.reshape(B, SWA_WINDOW, SWA_KV_WIDTH), sk], axis=1)
        v_all = jnp.concatenate([v_buf.reshape(B, SWA_WINDOW, SWA_KV_WIDTH), sv], axis=1)
        kb, vb = k_all[:, None], v_all[:, None]
        key_valid = jnp.ones((1, SWA_WINDOW + L), bool)
        k_last, v_last = k_all[:, -SWA_WINDOW:], v_all[:, -SWA_WINDOW:]
    b_out = swa_band(qb, kb, vb, key_valid, swa_sinks, rel_bias).reshape(B, L, SWA_WIDTH)
    y = jnp.concatenate([a_out, b_out], axis=-1) @ w_out
    kv_shape = (B, SWA_WINDOW, SWA_KV_HEADS, SWA_HEAD_DIM)
    return y, s_new, k_last.reshape(kv_shape), v_last.reshape(kv_shape)


def memory_kv(mem, mem_norm_w, w_mk, w_mv):
    B = mem.shape[0]
    m = rmsnorm(mem, mem_norm_w)
    k = (m @ w_mk).reshape(B, N_MEM, MEM_HEADS, MEM_HEAD_DIM)
    v = (m @ w_mv).reshape(B, N_MEM, MEM_HEADS, MEM_HEAD_DIM)
    return k, v


def memory_attend(h, mem_k, mem_v, w_mq, w_mo):
    B, L, _ = h.shape
    q = (h @ w_mq).reshape(B, L, MEM_HEADS, MEM_HEAD_DIM).astype(jnp.float32)
    s = jnp.einsum('blhd,bmhd->bhlm', q, mem_k.astype(jnp.float32)) * (MEM_HEAD_DIM ** -0.5)
    p = jax.nn.softmax(s, axis=-1)
    o = jnp.einsum('bhlm,bmhd->blhd', p, mem_v.astype(jnp.float32))
    return o.reshape(B, L, MEM_WIDTH).astype(h.dtype) @ w_mo


def swiglu(h, w_gate, w_up, w_down):
    return (jax.nn.silu(h @ w_gate) * (h @ w_up)) @ w_down


def decoder_layer(x, s0, k_buf, v_buf, mem_k, mem_v, lb, norm_mix_w, w_in, hgrn_onorm_w,
                  swa_sinks, rel_bias, w_out, norm_xattn_w, w_mq, w_mo, norm_ffn_w,
                  w_gate, w_up, w_down):
    y, s_new, k_new, v_new = token_mixer(rmsnorm(x, norm_mix_w), s0, k_buf, v_buf, lb, w_in,
                                         hgrn_onorm_w, swa_sinks, rel_bias, w_out)
    x = x + y
    x = x + memory_attend(rmsnorm(x, norm_xattn_w), mem_k, mem_v, w_mq, w_mo)
    x = x + swiglu(rmsnorm(x, norm_ffn_w), w_gate, w_up, w_down)
    return x, s_new, k_new, v_new


def setup_inputs(seed: int = 0) -> dict:
    key = jax.random.key(seed)
    ks = jax.random.split(key, 32)
    nrm = lambda k, shape, scale=1.0: scale * jax.random.normal(k, shape, jnp.float32)
    gain = lambda k, shape: 1.0 + 0.05 * jax.random.normal(k, shape, jnp.float32)
    kv_shape = (DEPTH, DEC_BATCH, SWA_WINDOW, SWA_KV_HEADS, SWA_HEAD_DIM)
    mem_shape = (DEPTH, DEC_BATCH, N_MEM, MEM_HEADS, MEM_HEAD_DIM)
    return {
        "x_prompt": nrm(ks[0], (BATCH, SEQ, D_MODEL)),
        "x_sample": nrm(ks[1], (DEC_BATCH, DEC_SEQ, D_MODEL)),
        "state_hgrn": nrm(ks[2], (DEPTH, DEC_BATCH, HGRN_HEADS, HGRN_DK, HGRN_DV), 0.5),
        "cache_swa_k": nrm(ks[3], kv_shape),
        "cache_swa_v": nrm(ks[4], kv_shape),
        "cache_mem_k": nrm(ks[5], mem_shape),
        "cache_mem_v": nrm(ks[6], mem_shape),
        "mem_prompt": nrm(ks[7], (BATCH, N_MEM, D_MODEL)),
        "norm_mix_w": gain(ks[8], (DEPTH, D_MODEL)),
        "w_in": nrm(ks[9], (DEPTH, D_MODEL, IN_WIDTH), D_MODEL ** -0.5),
        "hgrn_lb_logits": nrm(ks[10], (DEPTH + 1, HGRN_KEY_WIDTH), 0.5),
        "hgrn_onorm_w": gain(ks[11], (DEPTH, HGRN_DV)),
        "swa_sinks": nrm(ks[12], (DEPTH, SWA_HEADS), 0.5),
        "rel_bias": nrm(ks[13], (REL_BUCKETS, SWA_HEADS), 0.2),
        "w_out": nrm(ks[14], (DEPTH, MIX_WIDTH, D_MODEL), MIX_WIDTH ** -0.5),
        "norm_xattn_w": gain(ks[15], (DEPTH, D_MODEL)),
        "mem_norm_w": gain(ks[16], (DEPTH, D_MODEL)),
        "w_mq": nrm(ks[17], (DEPTH, D_MODEL, MEM_WIDTH), D_MODEL ** -0.5),
        "w_mk": nrm(ks[18], (DEPTH, D_MODEL, MEM_WIDTH), D_MODEL ** -0.5),
        "w_mv": nrm(ks[19], (DEPTH, D_MODEL, MEM_WIDTH), D_MODEL ** -0.5),
        "w_mo": nrm(ks[20], (DEPTH, MEM_WIDTH, D_MODEL), MEM_WIDTH ** -0.5),
        "norm_ffn_w": gain(ks[21], (DEPTH, D_MODEL)),
        "w_gate": nrm(ks[22], (DEPTH, D_MODEL, FFN_HIDDEN), D_MODEL ** -0.5),
        "w_up": nrm(ks[23], (DEPTH, D_MODEL, FFN_HIDDEN), D_MODEL ** -0.5),
        "w_down": nrm(ks[24], (DEPTH, FFN_HIDDEN, D_MODEL), FFN_HIDDEN ** -0.5),
        "norm_final_w": gain(ks[25], (D_MODEL,)),
    }


def reference(x_prompt, x_sample, state_hgrn, cache_swa_k, cache_swa_v, cache_mem_k, cache_mem_v,
              mem_prompt, norm_mix_w, w_in, hgrn_lb_logits, hgrn_onorm_w, swa_sinks, rel_bias,
              w_out, norm_xattn_w, mem_norm_w, w_mq, w_mk, w_mv, w_mo, norm_ffn_w, w_gate, w_up,
              w_down, norm_final_w):
    lbs = hgrn_lower_bounds(hgrn_lb_logits)
    xp, xs = x_prompt, x_sample
    p_s, p_k, p_v, p_mk, p_mv, s_s, s_k, s_v = [], [], [], [], [], [], [], []
    for l in range(DEPTH):
        shared = (lbs[l], norm_mix_w[l], w_in[l], hgrn_onorm_w[l], swa_sinks[l], rel_bias,
                  w_out[l], norm_xattn_w[l], w_mq[l], w_mo[l], norm_ffn_w[l], w_gate[l],
                  w_up[l], w_down[l])
        mk, mv = memory_kv(mem_prompt, mem_norm_w[l], w_mk[l], w_mv[l])
        s0 = jnp.zeros((BATCH, HGRN_HEADS, HGRN_DK, HGRN_DV), jnp.float32)
        xp, sp, kp, vp = decoder_layer(xp, s0, None, None, mk, mv, *shared)
        xs, ss, ksn, vsn = decoder_layer(xs, state_hgrn[l], cache_swa_k[l], cache_swa_v[l],
                                         cache_mem_k[l], cache_mem_v[l], *shared)
        p_s.append(sp); p_k.append(kp); p_v.append(vp); p_mk.append(mk); p_mv.append(mv)
        s_s.append(ss); s_k.append(ksn); s_v.append(vsn)
    y_prompt = rmsnorm(xp, norm_final_w)
    y_sample = rmsnorm(xs, norm_final_w)
    return (y_prompt, y_sample,
            jnp.stack(p_s).astype(x_prompt.dtype), jnp.stack(p_k), jnp.stack(p_v),
            jnp.stack(p_mk), jnp.stack(p_mv),
            jnp.stack(s_s).astype(state_hgrn.dtype), jnp.stack(s_k), jnp.stack(s_v))
```

```cpp
#include <hip/hip_runtime.h>
#include <hip/hip_cooperative_groups.h>
#include <cstdio>
#include <cstdint>
namespace cg = cooperative_groups;

namespace pg8 {
#define PG8_LAS __attribute__((address_space(3)))
typedef unsigned short bf16_t;
typedef short bf16x8 __attribute__((ext_vector_type(8)));
typedef float f32x4 __attribute__((ext_vector_type(4)));
typedef unsigned u32x4 __attribute__((ext_vector_type(4)));
constexpr int BM = 256, BK = 64, HALF = 128, HTB = HALF * BK * 2  , STAGE_BYTES = 8 * HTB, NXCD = 8, WGM = 8;

__host__ __device__ __forceinline__ int lds_byte(int r, int c) { const int st = (r >> 4) * 2 + (c >> 5), rr = r & 15, cc = c & 31, ob = rr * 64 + cc * 2; return st * 1024 + (ob ^ (((ob >> 9) & 1) << 5)); }
__host__ __device__ __forceinline__ void stage_rc(int b, int& R, int& C) { const int st = b / 1024, sb = b % 1024, swz = sb ^ (((sb >> 9) & 1) << 5); R = (st >> 1) * 16 + swz / 64; C = (st & 1) * 32 + (swz % 64) / 2; }
__host__ __device__ __forceinline__ int perm32(int rho) { const int n = rho >> 4, i = rho & 15; return 8 * (i >> 2) + 4 * n + (i & 3); }

struct Unit { int pm, pn; };
struct Gemm { const bf16_t* A; const bf16_t* Bt; int M, N, K; };

struct StaticOrder {
    int nM, nN, nwg, G, c;
    __host__ __device__ void init(int M, int N, int G_, int c_) { nM = M / BM; nN = N / BM; nwg = nM * nN; G = G_; c = c_; }
    __host__ __device__ bool next(int i, Unit& u) const {
        const long L = (long)i * G + c; if (L >= nwg) return false;
        int wgid = (int)L; { const int q = nwg / NXCD, r = nwg % NXCD, xcd = wgid % NXCD, off = wgid / NXCD; wgid = (xcd < r ? xcd * (q + 1) : r * (q + 1) + (xcd - r) * q) + off; }
        const int nig = WGM * nN, gid = wgid / nig, fm = gid * WGM, gsz = (nM - fm) < WGM ? (nM - fm) : WGM;
        u.pm = fm + ((wgid % nig) % gsz); u.pn = (wgid % nig) / gsz; return true;
    }
    __device__ __forceinline__ void a_ready(const Unit&) const {}
    __device__ __forceinline__ void done(const Unit&) const {}
};

template <class Epi, class Sched, bool ALIGN_EPI = false, bool SP2 = false>
__device__ __forceinline__ void gemm_phase(PG8_LAS unsigned char* lds, const Gemm g, const Sched& S, const Epi& E) {
    const int tid = threadIdx.x, wid = __builtin_amdgcn_readfirstlane(tid >> 6), lane = tid & 63, wr = wid >> 2, wc = wid & 3, fr = lane & 15, fq = lane >> 4;
    const int K = g.K, nt = K / BK;
    unsigned voffA[2], voffB[2];
#pragma unroll
    for (int i = 0; i < 2; ++i) { int R, C; stage_rc(tid * 16 + i * 8192, R, C); const int Rb = Epi::PERM ? ((R & ~31) + perm32(R & 31)) : R;
        voffA[i] = (unsigned)(R * K + C) * 2u; voffB[i] = (unsigned)(Rb * K + C) * 2u; }
    const size_t kstep = (size_t)(BK * 2);
    const size_t hstep = (size_t)HALF * K * 2;
    const size_t tstep = 2 * hstep;
    const unsigned ldsw = (unsigned)wid * 1024u;
    const int aoff = lds_byte(wr * 64 + fr, fq * 8), boff = lds_byte(wc * 32 + fr, fq * 8);
#define PG8_SA(b, h) (((b) * 2 + (h)) * HTB)
#define PG8_SB(b, h) ((4 + (b) * 2 + (h)) * HTB)
#define PG8_STAGE(bufoff, gbase, voff) do { _Pragma("unroll") for (int _i = 0; _i < 2; ++_i) \
        __builtin_amdgcn_global_load_lds((const unsigned*)((const char*)(gbase) + (voff)[_i]), (PG8_LAS unsigned*)(lds + (bufoff) + ldsw + _i * 8192), 16, 0, 0); } while (0)
#define PG8_LDA(dst, b, h) do { _Pragma("unroll") for (int m = 0; m < 4; ++m) _Pragma("unroll") for (int k = 0; k < 2; ++k) dst[m][k] = *(const PG8_LAS bf16x8*)(lds + PG8_SA(b, h) + aoff + m * 2048 + k * 1024); } while (0)
#define PG8_LDB(dst, b, h) do { _Pragma("unroll") for (int n = 0; n < 2; ++n) _Pragma("unroll") for (int k = 0; k < 2; ++k) dst[n][k] = *(const PG8_LAS bf16x8*)(lds + PG8_SB(b, h) + boff + n * 2048 + k * 1024); } while (0)
#define PG8_MMA(ai, bj, At, Bt) do { __builtin_amdgcn_s_setprio(1); _Pragma("unroll") for (int m = 0; m < 4; ++m) _Pragma("unroll") for (int n = 0; n < 2; ++n) _Pragma("unroll") for (int k = 0; k < 2; ++k) \
        acc[ai][bj][m][n] = __builtin_amdgcn_mfma_f32_16x16x32_bf16(Bt[n][k], At[m][k], acc[ai][bj][m][n], 0, 0, 0); __builtin_amdgcn_s_setprio(0); } while (0)
#define PG8_WAIT_V(n) asm volatile("s_waitcnt vmcnt(" #n ")" ::: "memory")
#define PG8_WAIT_L(n) asm volatile("s_waitcnt lgkmcnt(" #n ")" ::: "memory")
#define PG8_BAR __builtin_amdgcn_s_barrier()
#define PG8_SCHED __builtin_amdgcn_sched_barrier(0)
    Unit cur, nxt; int ui = 0;
    if (!S.next(0, cur)) return;
    f32x4 acc[2][2][4][2];
#pragma unroll
    for (int a = 0; a < 2; ++a)
#pragma unroll
        for (int b = 0; b < 2; ++b)
#pragma unroll
            for (int m = 0; m < 4; ++m)
#pragma unroll
                for (int n = 0; n < 2; ++n) acc[a][b][m][n] = (f32x4){0.f, 0.f, 0.f, 0.f};
    bf16x8 At[4][2], B0[2][2], B1[2][2];
    const char* cA = (const char*)g.A + (size_t)cur.pm * tstep; const char* cB = (const char*)g.Bt + (size_t)cur.pn * tstep;
    S.a_ready(cur);
    if constexpr (SP2) {
        PG8_STAGE(PG8_SB(0, 0), cB, voffB); PG8_STAGE(PG8_SB(0, 1), cB + hstep, voffB); PG8_STAGE(PG8_SA(0, 0), cA, voffA); PG8_STAGE(PG8_SA(0, 1), cA + hstep, voffA);
        if (wr == 1) PG8_BAR;
        PG8_WAIT_V(2); PG8_BAR;
        PG8_STAGE(PG8_SB(1, 0), cB + kstep, voffB); PG8_STAGE(PG8_SA(1, 0), cA + kstep, voffA); PG8_STAGE(PG8_SB(1, 1), cB + hstep + kstep, voffB);
        PG8_WAIT_V(6); PG8_BAR;
    } else {
        PG8_STAGE(PG8_SB(0, 0), cB, voffB); PG8_STAGE(PG8_SA(0, 0), cA, voffA); PG8_STAGE(PG8_SB(0, 1), cB + hstep, voffB); PG8_STAGE(PG8_SA(0, 1), cA + hstep, voffA);
        if (wr == 1) PG8_BAR;
        PG8_WAIT_V(4); PG8_BAR;
        PG8_STAGE(PG8_SB(1, 0), cB + kstep, voffB); PG8_STAGE(PG8_SA(1, 0), cA + kstep, voffA); PG8_STAGE(PG8_SB(1, 1), cB + hstep + kstep, voffB);
        PG8_WAIT_V(6); PG8_BAR;
    }
    for (;;) {
        const bool has_next = S.next(ui + 1, nxt);
        const char* nA = has_next ? (const char*)g.A + (size_t)nxt.pm * tstep : cA; const char* nB = has_next ? (const char*)g.Bt + (size_t)nxt.pn * tstep : cB;
        for (int t = 0; t < nt; t += 2) {
            const bool last = (t == nt - 2);
            const char* a1 = cA + (size_t)(t + 1) * kstep;
            const char* a2 = last ? nA : cA + (size_t)(t + 2) * kstep; const char* b2 = last ? nB : cB + (size_t)(t + 2) * kstep;
            const char* a3 = a2 + kstep; const char* b3 = b2 + kstep;
            if (last && has_next) S.a_ready(nxt);
            if constexpr (SP2) {
            PG8_LDB(B0, 0, 0); PG8_LDB(B1, 0, 1); PG8_SCHED; PG8_LDA(At, 0, 0); PG8_STAGE(PG8_SA(1, 1), a1 + hstep, voffA);
            PG8_WAIT_V(8); PG8_WAIT_L(0); PG8_BAR; PG8_MMA(0, 0, At, B0); PG8_MMA(0, 1, At, B1); PG8_BAR; PG8_SCHED;
            PG8_LDA(At, 0, 1); PG8_STAGE(PG8_SB(0, 0), b2, voffB); PG8_STAGE(PG8_SB(0, 1), b2 + hstep, voffB); PG8_STAGE(PG8_SA(0, 0), a2, voffA);
            PG8_WAIT_V(8); PG8_WAIT_L(0); PG8_BAR; PG8_MMA(1, 0, At, B0); PG8_MMA(1, 1, At, B1); PG8_BAR; PG8_SCHED;
            PG8_LDB(B0, 1, 0); PG8_LDB(B1, 1, 1); PG8_SCHED; PG8_LDA(At, 1, 0); PG8_STAGE(PG8_SA(0, 1), a2 + hstep, voffA);
            PG8_WAIT_V(8); PG8_WAIT_L(0); PG8_BAR; PG8_MMA(0, 0, At, B0); PG8_MMA(0, 1, At, B1); PG8_BAR; PG8_SCHED;
            PG8_LDA(At, 1, 1); PG8_STAGE(PG8_SB(1, 0), b3, voffB); PG8_STAGE(PG8_SB(1, 1), b3 + hstep, voffB); PG8_STAGE(PG8_SA(1, 0), a3, voffA);
            PG8_WAIT_V(8); PG8_WAIT_L(0); PG8_BAR; PG8_MMA(1, 0, At, B0); PG8_MMA(1, 1, At, B1); PG8_BAR; PG8_SCHED;
            } else {
            PG8_LDB(B0, 0, 0); PG8_SCHED; PG8_LDA(At, 0, 0); PG8_STAGE(PG8_SA(1, 1), a1 + hstep, voffA);
            PG8_WAIT_L(8); PG8_BAR; PG8_WAIT_L(0); PG8_MMA(0, 0, At, B0); PG8_BAR; PG8_SCHED;
            PG8_LDB(B1, 0, 1); PG8_STAGE(PG8_SB(0, 0), b2, voffB);
            PG8_BAR; PG8_WAIT_L(0); PG8_MMA(0, 1, At, B1); PG8_BAR;
            PG8_LDA(At, 0, 1); PG8_STAGE(PG8_SA(0, 0), a2, voffA);
            PG8_BAR; PG8_WAIT_L(0); PG8_MMA(1, 0, At, B0); PG8_BAR; PG8_SCHED;
            PG8_STAGE(PG8_SB(0, 1), b2 + hstep, voffB);
            PG8_WAIT_V(6); PG8_BAR; PG8_MMA(1, 1, At, B1); PG8_BAR;
            PG8_LDB(B0, 1, 0); PG8_SCHED; PG8_LDA(At, 1, 0); PG8_STAGE(PG8_SA(0, 1), a2 + hstep, voffA);
            PG8_WAIT_L(8); PG8_BAR; PG8_WAIT_L(0); PG8_MMA(0, 0, At, B0); PG8_BAR; PG8_SCHED;
            PG8_LDB(B1, 1, 1); PG8_STAGE(PG8_SB(1, 0), b3, voffB);
            PG8_BAR; PG8_WAIT_L(0); PG8_MMA(0, 1, At, B1); PG8_BAR;
            PG8_LDA(At, 1, 1); PG8_STAGE(PG8_SA(1, 0), a3, voffA);
            PG8_BAR; PG8_WAIT_L(0); PG8_MMA(1, 0, At, B0); PG8_BAR; PG8_SCHED;
            PG8_STAGE(PG8_SB(1, 1), b3 + hstep, voffB);
            PG8_WAIT_V(6); PG8_BAR; PG8_MMA(1, 1, At, B1); PG8_BAR;
            }
        }
        if constexpr (ALIGN_EPI) { if (wr == 0) PG8_BAR; }
        if constexpr (!Epi::AFTER_DRAIN) { E(acc, cur, wr, wc, fr, fq); S.done(cur); }
        if (!has_next) break;
#pragma unroll
        for (int a = 0; a < 2; ++a)
#pragma unroll
            for (int b = 0; b < 2; ++b)
#pragma unroll
                for (int m = 0; m < 4; ++m)
#pragma unroll
                    for (int n = 0; n < 2; ++n) acc[a][b][m][n] = (f32x4){0.f, 0.f, 0.f, 0.f};
        cur = nxt; cA = nA; cB = nB; ++ui;
        if constexpr (ALIGN_EPI) { if (wr == 1) PG8_BAR; }
    }
    PG8_WAIT_V(0);
    if constexpr (!ALIGN_EPI) { if (wr == 0) PG8_BAR; }
    PG8_BAR;
    if constexpr (Epi::AFTER_DRAIN) { E.fused(acc, cur, wr, wc, fr, fq, lds, wid, lane); S.done(cur); }
#undef PG8_SA
#undef PG8_SB
#undef PG8_STAGE
#undef PG8_LDA
#undef PG8_LDB
#undef PG8_MMA
#undef PG8_WAIT_V
#undef PG8_WAIT_L
#undef PG8_BAR
#undef PG8_SCHED
}
}

#define LAS __attribute__((address_space(3)))
typedef unsigned short bf16_t;
typedef short bf16x8 __attribute__((ext_vector_type(8)));
typedef short bf16x4 __attribute__((ext_vector_type(4)));
typedef float f32x4 __attribute__((ext_vector_type(4)));
typedef float f32x2 __attribute__((ext_vector_type(2)));
typedef unsigned u32x4 __attribute__((ext_vector_type(4)));
typedef unsigned u32x2 __attribute__((ext_vector_type(2)));
typedef __bf16 hbf16x2 __attribute__((ext_vector_type(2)));

constexpr int DM = 2048, TP = 16384, TS = 512, TT = TP + TS, SEQ = 4096, DB = 128;
constexpr int NIN = 5376, FF = 5632, MEMW = 512;
constexpr int NCHP = TP / 16, NCH = NCHP + DB;
constexpr float RMS_EPS = 1e-6f;
constexpr float LOG2E = 1.4426950408889634f;
constexpr float SWA_QSCALE = 0.125f * LOG2E;
constexpr float MEM_QSCALE = 0.08838834764831845f * LOG2E;
constexpr int NWAVES = 8, NTHREADS = 512;
constexpr int LDS_BYTES = 147456;

constexpr size_t O_YP = 0, O_YS = 33554432, O_PST = 34603008, O_PSK = 35127296, O_PSV = 35192832, O_PMK = 35258368, O_PMV = 35782656,
                 O_SST = 36306944, O_SSK = 53084160, O_SSV = 55181312, O_END = 57278464;
constexpr size_t MiB = 1u << 20;
constexpr size_t WS_TAB = 1 * MiB;
constexpr size_t WS_WIN = 2 * MiB, WS_WOUT = 23 * MiB, WS_WMQ = 31 * MiB, WS_WMKV = 33 * MiB, WS_WMO = 37 * MiB, WS_WGU = 39 * MiB, WS_WDN = 83 * MiB;
constexpr size_t WS_SS = 105 * MiB;
constexpr size_t SS_STRIDE = 2359296;
constexpr size_t WS_MK = 112 * MiB, WS_MVT = 113 * MiB, WS_QM = 114 * MiB, WS_OM = 131 * MiB, WS_MN = 148 * MiB, WS_XB = 152 * MiB;
constexpr size_t WS_D = 218 * MiB;
constexpr size_t WS_GATE = WS_D, WS_SQ = WS_D + 33 * MiB, WS_SKV = WS_D + 66 * MiB, WS_QIN = WS_D + 75 * MiB, WS_KT = WS_D + 111 * MiB, WS_VT = WS_D + 147 * MiB,
                 WS_PSC = WS_D + 183 * MiB, WS_DEC = WS_D + 188 * MiB, WS_MIX = WS_D + 193 * MiB, WS_END = WS_D + 259 * MiB;
constexpr size_t WS_HID = WS_D;
static_assert((size_t)TT * FF * 2 <= 183 * MiB, "HID overlay");

struct Args {
    const float* in[26];
    float* out; unsigned char* ws;
    int ph_lo, ph_hi;
};

__device__ __forceinline__ unsigned cvtpk(float lo, float hi) { f32x2 v = {lo, hi}; hbf16x2 b = __builtin_convertvector(v, hbf16x2); return __builtin_bit_cast(unsigned, b); }
__device__ __forceinline__ float bf2f(unsigned short b) { return __uint_as_float((unsigned)b << 16); }
__device__ __forceinline__ unsigned short f2bf(float f) { return (unsigned short)(cvtpk(f, 0.f) & 0xffffu); }
__device__ __forceinline__ u32x4 pack8(f32x4 a, f32x4 b) { u32x4 w; w.x = cvtpk(a[0], a[1]); w.y = cvtpk(a[2], a[3]); w.z = cvtpk(b[0], b[1]); w.w = cvtpk(b[2], b[3]); return w; }
__device__ __forceinline__ u32x2 pack4(f32x4 a) { u32x2 w; w.x = cvtpk(a[0], a[1]); w.y = cvtpk(a[2], a[3]); return w; }
__device__ __forceinline__ float fexp(float x) { return __builtin_amdgcn_exp2f(x * LOG2E); }
__device__ __forceinline__ float fsigmoid(float x) { return __builtin_amdgcn_rcpf(1.0f + fexp(-x)); }
__device__ __forceinline__ float wave_sum(float v) {
#pragma unroll
    for (int o = 1; o < 64; o <<= 1) v += __shfl_xor(v, o);
    return v;
}
#define LDS_WAIT() asm volatile("s_waitcnt lgkmcnt(0)" ::: "memory")

__device__ __forceinline__ float row_rs(const float* SS, int row) {
    const f32x4* p = (const f32x4*)(SS + (size_t)row * 32);
    f32x4 s = p[0];
#pragma unroll
    for (int i = 1; i < 8; ++i) s += p[i];
    return __builtin_amdgcn_rsqf(((s[0] + s[1]) + (s[2] + s[3])) * (1.0f / DM) + RMS_EPS);
}

using pg8::Unit;
struct EpiIn {
    static constexpr bool PERM = true, AFTER_DRAIN = false;
    float* QF; float* GF; bf16_t* VB; bf16_t* GATE; bf16_t* SQ; bf16_t* SKV; const float* LB; float* out;
    __device__ __forceinline__ void operator()(const f32x4 (&acc)[2][2][4][2], const Unit& u, int wr, int wc, int fr, int fq) const {
        const int pn = u.pn;
#pragma unroll
        for (int ai = 0; ai < 2; ++ai)
#pragma unroll
            for (int m = 0; m < 4; ++m) {
                const int row = u.pm * 256 + ai * 128 + wr * 64 + m * 16 + fr;
#pragma unroll
                for (int bj = 0; bj < 2; ++bj) {
                    const int c = pn * 256 + bj * 128 + wc * 32 + 8 * fq;
                    f32x4 v0 = acc[ai][bj][m][0], v1 = acc[ai][bj][m][1];
                    if (pn < 4) {
                        float* d = QF + (size_t)row * 1024 + c; *(f32x4*)d = v0; *(f32x4*)(d + 4) = v1;
                    } else if (pn < 8) {
                        const int cc = c - 1024;
                        const f32x4 l0 = *(const f32x4*)(LB + cc), l1 = *(const f32x4*)(LB + cc + 4);
#pragma unroll
                        for (int j = 0; j < 4; ++j) { v0[j] = __logf(l0[j] + (1.0f - l0[j]) * fsigmoid(v0[j])); v1[j] = __logf(l1[j] + (1.0f - l1[j]) * fsigmoid(v1[j])); }
                        float* d = GF + (size_t)row * 1024 + cc; *(f32x4*)d = v0; *(f32x4*)(d + 4) = v1;
                    } else if (pn < 12) {
                        *(u32x4*)(VB + (size_t)row * 1024 + (c - 2048)) = pack8(v0, v1);
                    } else if (pn < 16) {
#pragma unroll
                        for (int j = 0; j < 4; ++j) { v0[j] = v0[j] * fsigmoid(v0[j]); v1[j] = v1[j] * fsigmoid(v1[j]); }
                        *(u32x4*)(GATE + (size_t)row * 1024 + (c - 3072)) = pack8(v0, v1);
                    } else if (pn < 20) {
                        *(u32x4*)(SQ + (size_t)row * 1024 + (c - 4096)) = pack8(v0 * SWA_QSCALE, v1 * SWA_QSCALE);
                    } else {
                        const int cc = c - 5120;
                        *(u32x4*)(SKV + (size_t)row * 256 + cc) = pack8(v0, v1);
                        float* d = nullptr;
                        if (row < TP) { const int b = row >> 12, t = row & 4095; if (t >= SEQ - 128) d = out + (bj == 0 ? O_PSK : O_PSV) + (size_t)(b * 128 + (t - (SEQ - 128))) * 128 + (cc & 127); }
                        else { const int rs = row - TP, b = rs >> 2, t = rs & 3; d = out + (bj == 0 ? O_SSK : O_SSV) + (size_t)(b * 128 + 124 + t) * 128 + (cc & 127); }
                        if (d) { *(f32x4*)d = v0; *(f32x4*)(d + 4) = v1; }
                    }
                }
            }
    }
};
struct EpiMemKV {
    static constexpr bool PERM = true, AFTER_DRAIN = false;
    bf16_t* MK; bf16_t* MVT; float* out;
    __device__ __forceinline__ void operator()(const f32x4 (&acc)[2][2][4][2], const Unit& u, int wr, int wc, int fr, int fq) const {
#pragma unroll
        for (int ai = 0; ai < 2; ++ai)
#pragma unroll
            for (int m = 0; m < 4; ++m) {
                const int row = u.pm * 256 + ai * 128 + wr * 64 + m * 16 + fr;
#pragma unroll
                for (int bj = 0; bj < 2; ++bj) {
                    const int c = u.pn * 256 + bj * 128 + wc * 32 + 8 * fq;
                    const f32x4 v0 = acc[ai][bj][m][0], v1 = acc[ai][bj][m][1];
                    if (u.pn < 2) {
                        float* d = out + O_PMK + (size_t)row * 512 + c; *(f32x4*)d = v0; *(f32x4*)(d + 4) = v1;
                        *(u32x4*)(MK + (size_t)row * 512 + c) = pack8(v0, v1);
                    } else {
                        const int cv = c - 512, h = cv >> 7, dd = cv & 127, b = row >> 8, mm = row & 255;
                        float* d = out + O_PMV + (size_t)row * 512 + cv; *(f32x4*)d = v0; *(f32x4*)(d + 4) = v1;
                        bf16_t* t = MVT + ((size_t)((b * 4 + h) * 128 + dd)) * 256 + mm;
#pragma unroll
                        for (int j = 0; j < 4; ++j) { t[(size_t)j * 256] = f2bf(v0[j]); t[(size_t)(j + 4) * 256] = f2bf(v1[j]); }
                    }
                }
            }
    }
};
struct EpiResid {
    static constexpr bool PERM = true, AFTER_DRAIN = false;
    const float* resP; const float* resS; float* X; bf16_t* XB; float* SS;
    __device__ __forceinline__ void operator()(const f32x4 (&acc)[2][2][4][2], const Unit& u, int wr, int wc, int fr, int fq) const {
#pragma unroll
        for (int ai = 0; ai < 2; ++ai)
#pragma unroll
            for (int m = 0; m < 4; ++m) {
                const int row = u.pm * 256 + ai * 128 + wr * 64 + m * 16 + fr;
                const float* rrow = (row < TP) ? resP + (size_t)row * DM : resS + (size_t)(row - TP) * DM;
                float ss = 0.f;
#pragma unroll
                for (int bj = 0; bj < 2; ++bj) {
                    const int c = u.pn * 256 + bj * 128 + wc * 32 + 8 * fq;
                    const f32x4 v0 = acc[ai][bj][m][0] + *(const f32x4*)(rrow + c), v1 = acc[ai][bj][m][1] + *(const f32x4*)(rrow + c + 4);
                    float* d = X + (size_t)row * DM + c; *(f32x4*)d = v0; *(f32x4*)(d + 4) = v1;
                    ss += (v0[0] * v0[0] + v0[1] * v0[1]) + (v0[2] * v0[2] + v0[3] * v0[3]) + (v1[0] * v1[0] + v1[1] * v1[1]) + (v1[2] * v1[2] + v1[3] * v1[3]);
                    if (XB) *(u32x4*)(XB + (size_t)row * DM + c) = pack8(v0, v1);
                }
                ss += __shfl_xor(ss, 16); ss += __shfl_xor(ss, 32);
                if (fq == 0) SS[(size_t)row * 32 + u.pn * 4 + wc] = ss;
            }
    }
};
struct EpiScaleBf16 {
    static constexpr bool PERM = true, AFTER_DRAIN = false;
    bf16_t* O; int ldc; const float* SS; float scale;
    __device__ __forceinline__ void operator()(const f32x4 (&acc)[2][2][4][2], const Unit& u, int wr, int wc, int fr, int fq) const {
#pragma unroll
        for (int ai = 0; ai < 2; ++ai)
#pragma unroll
            for (int m = 0; m < 4; ++m) {
                const int row = u.pm * 256 + ai * 128 + wr * 64 + m * 16 + fr;
                const float s = row_rs(SS, row) * scale;
#pragma unroll
                for (int bj = 0; bj < 2; ++bj) {
                    const int c = u.pn * 256 + bj * 128 + wc * 32 + 8 * fq;
                    *(u32x4*)(O + (size_t)row * ldc + c) = pack8(acc[ai][bj][m][0] * s, acc[ai][bj][m][1] * s);
                }
            }
    }
};
struct EpiSwiGLU {
    static constexpr bool PERM = true, AFTER_DRAIN = false;
    bf16_t* HID; const float* SS;
    __device__ __forceinline__ void operator()(const f32x4 (&acc)[2][2][4][2], const Unit& u, int wr, int wc, int fr, int fq) const {
#pragma unroll
        for (int ai = 0; ai < 2; ++ai)
#pragma unroll
            for (int m = 0; m < 4; ++m) {
                const int row = u.pm * 256 + ai * 128 + wr * 64 + m * 16 + fr;
                const float s = row_rs(SS, row);
                f32x4 h0, h1;
#pragma unroll
                for (int j = 0; j < 4; ++j) {
                    const float g0 = acc[ai][0][m][0][j] * s, u0 = acc[ai][1][m][0][j] * s, g1 = acc[ai][0][m][1][j] * s, u1 = acc[ai][1][m][1][j] * s;
                    h0[j] = g0 * fsigmoid(g0) * u0; h1[j] = g1 * fsigmoid(g1) * u1;
                }
                *(u32x4*)(HID + (size_t)row * FF + u.pn * 128 + wc * 32 + 8 * fq) = pack8(h0, h1);
            }
    }
};

struct Frame {
    LAS unsigned char* lds;
    int tid, lane, wave, G, bid;
    const float* const* in;
    float* out; unsigned char* ws;
};
enum { I_XP = 0, I_XS, I_STATE, I_CSK, I_CSV, I_CMK, I_CMV, I_MEMP, I_NMIX, I_WIN, I_LB, I_ONORM, I_SINKS, I_RELB, I_WOUT, I_NXATT, I_NMEM,
       I_WMQ, I_WMK, I_WMV, I_WMO, I_NFFN, I_WGATE, I_WUP, I_WDOWN, I_NFINAL };

__device__ __forceinline__ void p0_tr_item(const float* __restrict__ W, int K, int N, bf16_t* WT, int k0, int n0, int drow0, const float* __restrict__ scale, LAS float* scr, int lane) {
#pragma unroll 8
    for (int i = 0; i < 32; ++i) { const int kk = 2 * i + (lane >> 5); float v = W[(size_t)(k0 + kk) * N + n0 + (lane & 31)]; if (scale) v *= scale[k0 + kk]; scr[kk * 33 + (lane & 31)] = v; }
    LDS_WAIT(); asm volatile("" ::: "memory");
    const int c = lane & 7;
#pragma unroll
    for (int j = 0; j < 4; ++j) { const int n = (lane >> 3) + 8 * j; const LAS float* s = scr + (8 * c) * 33 + n;
        u32x4 o; o.x = cvtpk(s[0 * 33], s[1 * 33]); o.y = cvtpk(s[2 * 33], s[3 * 33]); o.z = cvtpk(s[4 * 33], s[5 * 33]); o.w = cvtpk(s[6 * 33], s[7 * 33]);
        *(u32x4*)(WT + (size_t)(drow0 + n) * K + k0 + 8 * c) = o; }
    LDS_WAIT(); asm volatile("" ::: "memory");
}
__device__ __forceinline__ void p0_rms_row(const float* xrow, const float* w, bf16_t* orow, int lane) {
    const f32x4* xr = (const f32x4*)xrow + lane; const f32x4* wr = (const f32x4*)w + lane;
    f32x4 v[8]; float s = 0.f;
#pragma unroll
    for (int j = 0; j < 8; ++j) { v[j] = xr[64 * j]; s += (v[j][0] * v[j][0] + v[j][1] * v[j][1]) + (v[j][2] * v[j][2] + v[j][3] * v[j][3]); }
    const float rs = __builtin_amdgcn_rsqf(wave_sum(s) * (1.0f / DM) + RMS_EPS);
    u32x2* o8 = (u32x2*)orow + lane;
#pragma unroll
    for (int j = 0; j < 8; ++j) { const f32x4 ww = wr[64 * j]; f32x4 y; y[0] = v[j][0] * rs * ww[0]; y[1] = v[j][1] * rs * ww[1]; y[2] = v[j][2] * rs * ww[2]; y[3] = v[j][3] * rs * ww[3]; o8[64 * j] = pack4(y); }
}
__device__ __forceinline__ int rel_bucket(int n) {
    if (n < 16) return n;
    int b = 16 + (int)(__logf((float)n * (1.0f / 16.0f)) / 2.0794415416798357f * 16.0f);
    return b < 31 ? b : 31;
}
__device__ __forceinline__ void p0_prologue(Frame& F) {
    LAS float* scr = (LAS float*)(F.lds + F.wave * 16384);
    const int gw = F.bid * NWAVES + F.wave, NGW = F.G * NWAVES;
    unsigned char* ws = F.ws;
    constexpr int I_IN = 32 * (NIN / 32), I_OUT = 32 * 64, I_MQ = 32 * 16, I_MO = 8 * 64, I_G = 32 * (FF / 32), I_DN = (FF / 64) * 64;
    constexpr int NITEMS = I_IN + I_OUT + 3 * I_MQ + I_MO + 2 * I_G + I_DN;
    for (int it = gw; it < NITEMS; it += NGW) {
        int r = it;
        if (r < I_IN) { const int nb = NIN / 32, kb = r / nb, n0 = (r % nb) * 32; p0_tr_item(F.in[I_WIN], DM, NIN, (bf16_t*)(ws + WS_WIN), kb * 64, n0, n0, nullptr, scr, F.lane); continue; } r -= I_IN;
        if (r < I_OUT) { const int kb = r / 64, n0 = (r % 64) * 32; p0_tr_item(F.in[I_WOUT], DM, DM, (bf16_t*)(ws + WS_WOUT), kb * 64, n0, n0, nullptr, scr, F.lane); continue; } r -= I_OUT;
        if (r < I_MQ) { const int kb = r / 16, n0 = (r % 16) * 32; p0_tr_item(F.in[I_WMQ], DM, MEMW, (bf16_t*)(ws + WS_WMQ), kb * 64, n0, n0, F.in[I_NXATT], scr, F.lane); continue; } r -= I_MQ;
        if (r < I_MQ) { const int kb = r / 16, n0 = (r % 16) * 32; p0_tr_item(F.in[I_WMK], DM, MEMW, (bf16_t*)(ws + WS_WMKV), kb * 64, n0, n0, nullptr, scr, F.lane); continue; } r -= I_MQ;
        if (r < I_MQ) { const int kb = r / 16, n0 = (r % 16) * 32; p0_tr_item(F.in[I_WMV], DM, MEMW, (bf16_t*)(ws + WS_WMKV), kb * 64, n0, 512 + n0, nullptr, scr, F.lane); continue; } r -= I_MQ;
        if (r < I_MO) { const int kb = r / 64, n0 = (r % 64) * 32; p0_tr_item(F.in[I_WMO], MEMW, DM, (bf16_t*)(ws + WS_WMO), kb * 64, n0, n0, nullptr, scr, F.lane); continue; } r -= I_MO;
        if (r < 2 * I_G) { const int up = r >= I_G; if (up) r -= I_G; const int nb = FF / 32, kb = r / nb, n0 = (r % nb) * 32;
            p0_tr_item(F.in[up ? I_WUP : I_WGATE], DM, FF, (bf16_t*)(ws + WS_WGU), kb * 64, n0, (n0 >> 7) * 256 + (n0 & 127) + (up ? 128 : 0), F.in[I_NFFN], scr, F.lane); continue; } r -= 2 * I_G;
        { const int kb = r / 64, n0 = (r % 64) * 32; p0_tr_item(F.in[I_WDOWN], FF, DM, (bf16_t*)(ws + WS_WDN), kb * 64, n0, n0, nullptr, scr, F.lane); }
    }
    for (int m = gw; m < TT + 1024; m += NGW) {
        if (m < TP) p0_rms_row(F.in[I_XP] + (size_t)m * DM, F.in[I_NMIX], (bf16_t*)(ws + WS_XB) + (size_t)m * DM, F.lane);
        else if (m < TT) p0_rms_row(F.in[I_XS] + (size_t)(m - TP) * DM, F.in[I_NMIX], (bf16_t*)(ws + WS_XB) + (size_t)m * DM, F.lane);
        else p0_rms_row(F.in[I_MEMP] + (size_t)(m - TT) * DM, F.in[I_NMEM], (bf16_t*)(ws + WS_MN) + (size_t)(m - TT) * DM, F.lane);
    }
    float* LBt = (float*)(ws + WS_TAB); float* BT = (float*)(ws + WS_TAB + 8192);
    const int gt = F.bid * NTHREADS + F.tid, NGT = F.G * NTHREADS;
    for (int i = gt; i < 1024 + 16 * 160; i += NGT) {
        if (i < 1024) { const float l0 = F.in[I_LB][i], l1 = F.in[I_LB][1024 + i]; LBt[i] = 1.0f / (1.0f + __expf(l1 - l0)); }
        else { const int j = i - 1024, h = j / 160, ix = j % 160, dist = 143 - ix;
            BT[j] = (dist >= 0 && dist < 128) ? F.in[I_RELB][rel_bucket(dist) * 16 + h] * LOG2E : -INFINITY; }
    }
}

constexpr int PREP_RS = 1032;
__device__ __forceinline__ void hgrn_prep(Frame& F) {
    unsigned char* ws = F.ws;
    const float* QF = F.out; const float* GF = F.out + (size_t)TT * 1024; const bf16_t* VB = (const bf16_t*)(F.out + O_SST);
    bf16_t* QIN = (bf16_t*)(ws + WS_QIN); bf16_t* KT = (bf16_t*)(ws + WS_KT); bf16_t* VT = (bf16_t*)(ws + WS_VT); bf16_t* PSC = (bf16_t*)(ws + WS_PSC); float* DEC = (float*)(ws + WS_DEC);
    LAS bf16_t* lq = (LAS bf16_t*)F.lds; LAS bf16_t* lk = lq + 16 * PREP_RS;
    const int l15 = F.lane & 15, g4 = F.lane >> 4;
    for (int ch = F.bid; ch < NCH; ch += F.G) {
        const int nv = ch < NCHP ? 16 : 4; const int row0 = ch < NCHP ? ch * 16 : TP + (ch - NCHP) * 4;
#pragma unroll 1
        for (int pass = 0; pass < 2; ++pass) {
            const int cidx = F.tid + 512 * pass;
            float g[16], q[16]; unsigned short vv[16];
#pragma unroll
            for (int t = 0; t < 16; ++t) {
                if (t < nv) { g[t] = GF[(size_t)(row0 + t) * 1024 + cidx]; q[t] = QF[(size_t)(row0 + t) * 1024 + cidx]; vv[t] = VB[(size_t)(row0 + t) * 1024 + cidx]; }
                else { g[t] = 0.f; q[t] = 0.f; vv[t] = 0; }
            }
            float G = 0.f; unsigned kd[8], vt[8];
#pragma unroll
            for (int t = 0; t < 16; t += 2) {
                float qi[2], kk[2];
#pragma unroll
                for (int z = 0; z < 2; ++z) {
                    const float gt = g[t + z]; G += gt;
                    qi[z] = q[t + z] * fexp(G);
                    kk[z] = (1.0f - fexp(gt)) * fexp(fminf(-G, 80.0f));
                    lq[(t + z) * PREP_RS + cidx] = f2bf(qi[z]); lk[(t + z) * PREP_RS + cidx] = f2bf(kk[z]);
                }
                kd[t >> 1] = cvtpk(kk[0], kk[1]); vt[t >> 1] = (unsigned)vv[t] | ((unsigned)vv[t + 1] << 16);
            }
            DEC[(size_t)ch * 1024 + cidx] = fexp(G);
            u32x4* kp = (u32x4*)(KT + ((size_t)ch * 1024 + cidx) * 16); kp[0] = (u32x4){kd[0], kd[1], kd[2], kd[3]}; kp[1] = (u32x4){kd[4], kd[5], kd[6], kd[7]};
            u32x4* vp = (u32x4*)(VT + ((size_t)ch * 1024 + cidx) * 16); vp[0] = (u32x4){vt[0], vt[1], vt[2], vt[3]}; vp[1] = (u32x4){vt[4], vt[5], vt[6], vt[7]};
        }
        __syncthreads();
#pragma unroll
        for (int i = 0; i < 4; ++i) { const int idx = F.tid + 512 * i, t = idx >> 7, c8 = idx & 127;
            *(u32x4*)(QIN + ((size_t)ch * 16 + t) * 1024 + c8 * 8) = *(const LAS u32x4*)(lq + t * PREP_RS + c8 * 8); }
        {
            const int h = F.wave; f32x4 acc = {0.f, 0.f, 0.f, 0.f};
#pragma unroll
            for (int kk = 0; kk < 4; ++kk) {
                const bf16x8 a = *(const LAS bf16x8*)(lq + l15 * PREP_RS + h * 128 + 32 * kk + 8 * g4);
                const bf16x8 b = *(const LAS bf16x8*)(lk + l15 * PREP_RS + h * 128 + 32 * kk + 8 * g4);
                acc = __builtin_amdgcn_mfma_f32_16x16x32_bf16(a, b, acc, 0, 0, 0);
            }
            bf16_t* pd = PSC + ((size_t)ch * 8 + h) * 256;
#pragma unroll
            for (int r = 0; r < 4; ++r) { const int t = 4 * g4 + r, s = l15; pd[t * 16 + s] = (s <= t) ? f2bf(acc[r]) : (bf16_t)0; }
        }
        __syncthreads();
    }
}

constexpr int SC_QS = 136;
constexpr int SC_QI = 0, SC_KT = 16 * SC_QS * 2, SC_VT = SC_KT + 4096, SC_P = SC_VT + 4096, SC_DEC = SC_P + 512, SC_GATE = SC_DEC + 512, SC_BUF = SC_GATE + 16 * SC_QS * 2;
constexpr int SC_RED = 2 * SC_BUF;
static_assert(SC_RED + 1024 <= LDS_BYTES && SC_BUF % 16 == 0, "scan LDS");
struct ScanPf { u32x4 a, b, c; };
__device__ __forceinline__ void scan_fetch(ScanPf& pf, const Frame& F, int ch, int h, int grow0, int ngr) {
    const unsigned char* ws = F.ws; const int tid = F.tid;
    const bf16_t* QIN = (const bf16_t*)(ws + WS_QIN); const bf16_t* KT = (const bf16_t*)(ws + WS_KT); const bf16_t* VT = (const bf16_t*)(ws + WS_VT);
    const bf16_t* PSC = (const bf16_t*)(ws + WS_PSC); const float* DEC = (const float*)(ws + WS_DEC); const bf16_t* GATE = (const bf16_t*)(ws + WS_GATE);
    if (tid < 256) { const int t = tid >> 4, p = tid & 15;
        pf.a = *(const u32x4*)(QIN + ((size_t)ch * 16 + t) * 1024 + h * 128 + p * 8);
        pf.b = *(const u32x4*)(VT + ((size_t)ch * 1024 + h * 128) * 16 + tid * 8);
    } else { const int i = tid - 256, t = i >> 4, p = i & 15; const int tr = t < ngr ? t : ngr - 1;
        pf.a = *(const u32x4*)(KT + ((size_t)ch * 1024 + h * 128) * 16 + i * 8);
        pf.b = *(const u32x4*)(GATE + (size_t)(grow0 + tr) * 1024 + h * 128 + p * 8);
    }
    if (tid < 32) pf.c = *(const u32x4*)(PSC + ((size_t)ch * 8 + h) * 256 + tid * 8);
    else if (tid < 64) pf.c = *(const u32x4*)(DEC + (size_t)ch * 1024 + h * 128 + (tid - 32) * 4);
}
__device__ __forceinline__ void scan_stash(const ScanPf& pf, const Frame& F, int buf) {
    LAS unsigned char* B = F.lds + buf * SC_BUF; const int tid = F.tid;
    if (tid < 256) { const int t = tid >> 4, p = tid & 15;
        *(LAS u32x4*)(B + SC_QI + (t * SC_QS + p * 8) * 2) = pf.a; *(LAS u32x4*)(B + SC_VT + tid * 16) = pf.b;
    } else { const int i = tid - 256, t = i >> 4, p = i & 15;
        *(LAS u32x4*)(B + SC_KT + i * 16) = pf.a; *(LAS u32x4*)(B + SC_GATE + (t * SC_QS + p * 8) * 2) = pf.b;
    }
    if (tid < 32) *(LAS u32x4*)(B + SC_P + tid * 16) = pf.c;
    else if (tid < 64) *(LAS u32x4*)(B + SC_DEC + (tid - 32) * 16) = pf.c;
}
__device__ __forceinline__ void hgrn_scan(Frame& F, int ch0, int nsteps, int h, int mrow0, int nvalid, const float* S0, float* Sout) {
    const int lane = F.lane, l15 = lane & 15, g4 = lane >> 4, e0 = 16 * F.wave;
    bf16_t* MIX = (bf16_t*)(F.ws + WS_MIX);
    const float onw = F.in[I_ONORM][e0 + l15];
    f32x4 S[8];
#pragma unroll
    for (int mt = 0; mt < 8; ++mt)
#pragma unroll
        for (int r = 0; r < 4; ++r) S[mt][r] = S0 ? S0[(size_t)(16 * mt + 4 * g4 + r) * 128 + e0 + l15] : 0.f;
    LAS float* RED = (LAS float*)(F.lds + SC_RED);
    ScanPf pf;
    __syncthreads();
    scan_fetch(pf, F, ch0, h, mrow0, nvalid); scan_stash(pf, F, 0);
    __syncthreads();
    f32x4 o_prev = {0.f, 0.f, 0.f, 0.f}, gate_prev = {0.f, 0.f, 0.f, 0.f};
#pragma unroll 1
    for (int n = 0; n <= nsteps; ++n) {
        const int buf = n & 1;
        f32x4 o = {0.f, 0.f, 0.f, 0.f}, gate = {0.f, 0.f, 0.f, 0.f};
        if (n + 1 < nsteps) scan_fetch(pf, F, ch0 + n + 1, h, mrow0 + 16 * (n + 1), nvalid);
        if (n < nsteps) {
            const LAS unsigned char* B = F.lds + buf * SC_BUF;
            const bf16x4 vt = *(const LAS bf16x4*)(B + SC_VT + ((e0 + l15) * 16 + 4 * g4) * 2);
            const bf16x4 pa = *(const LAS bf16x4*)(B + SC_P + (l15 * 16 + 4 * g4) * 2);
            o = __builtin_amdgcn_mfma_f32_16x16x16bf16_1k(pa, vt, o, 0, 0, 0);
#pragma unroll
            for (int kk = 0; kk < 4; ++kk) {
                const bf16x4 q0 = *(const LAS bf16x4*)(B + SC_QI + (l15 * SC_QS + 32 * kk + 4 * g4) * 2);
                const bf16x4 q1 = *(const LAS bf16x4*)(B + SC_QI + (l15 * SC_QS + 32 * kk + 16 + 4 * g4) * 2);
                const bf16x8 qa = {q0[0], q0[1], q0[2], q0[3], q1[0], q1[1], q1[2], q1[3]};
                const u32x4 sb = pack8(S[2 * kk], S[2 * kk + 1]);
                o = __builtin_amdgcn_mfma_f32_16x16x32_bf16(qa, __builtin_bit_cast(bf16x8, sb), o, 0, 0, 0);
            }
#pragma unroll
            for (int mt = 0; mt < 8; ++mt) {
                const bf16x4 kt = *(const LAS bf16x4*)(B + SC_KT + ((16 * mt + l15) * 16 + 4 * g4) * 2);
                const f32x4 dc = *(const LAS f32x4*)(B + SC_DEC + (16 * mt + 4 * g4) * 4);
                S[mt] = __builtin_amdgcn_mfma_f32_16x16x16bf16_1k(kt, vt, S[mt], 0, 0, 0);
                S[mt] = S[mt] * dc;
            }
#pragma unroll
            for (int r = 0; r < 4; ++r) {
                gate[r] = bf2f(*(const LAS unsigned short*)(B + SC_GATE + ((4 * g4 + r) * SC_QS + e0 + l15) * 2));
                float ss = o[r] * o[r];
                ss += __shfl_xor(ss, 1); ss += __shfl_xor(ss, 2); ss += __shfl_xor(ss, 4); ss += __shfl_xor(ss, 8);
                if (l15 == 0) RED[(buf * 8 + F.wave) * 16 + 4 * g4 + r] = ss;
            }
        }
        if (n > 0) {
            const int pb = (n - 1) & 1;
#pragma unroll
            for (int r = 0; r < 4; ++r) {
                const int t = 4 * g4 + r; float tot = 0.f;
#pragma unroll
                for (int w = 0; w < 8; ++w) tot += RED[(pb * 8 + w) * 16 + t];
                const float rs = __builtin_amdgcn_rsqf(tot * (1.0f / 128.0f) + RMS_EPS);
                if (t < nvalid) MIX[(size_t)(mrow0 + 16 * (n - 1) + t) * DM + h * 128 + e0 + l15] = f2bf(o_prev[r] * rs * onw * gate_prev[r]);
            }
        }
        o_prev = o; gate_prev = gate;
        if (n + 1 < nsteps) scan_stash(pf, F, buf ^ 1);
        __syncthreads();
    }
#pragma unroll
    for (int mt = 0; mt < 8; ++mt)
#pragma unroll
        for (int r = 0; r < 4; ++r) Sout[(size_t)(16 * mt + 4 * g4 + r) * 128 + e0 + l15] = S[mt][r];
}

constexpr int SW_KS = 72, SW_VS = 264;
constexpr int SW_K = 0, SW_V = 256 * SW_KS * 2, SW_BT = SW_V + 64 * SW_VS * 2, SW_END = SW_BT + 8 * 160 * 4;
static_assert(SW_END <= LDS_BYTES, "swa LDS");
__device__ __forceinline__ void swa_qtile(Frame& F, int j, int h, size_t qrow, bool qvalid, bool first_block, float sink2) {
    const int lane = F.lane, l15 = lane & 15, g4 = lane >> 4;
    const bf16_t* SQ = (const bf16_t*)(F.ws + WS_SQ); bf16_t* MIX = (bf16_t*)(F.ws + WS_MIX);
    const LAS bf16_t* Kb = (const LAS bf16_t*)(F.lds + SW_K); const LAS bf16_t* Vt = (const LAS bf16_t*)(F.lds + SW_V);
    const LAS float* BT = (const LAS float*)(F.lds + SW_BT) + F.wave * 160;
    bf16x8 qf[2];
#pragma unroll
    for (int kk = 0; kk < 2; ++kk) qf[kk] = *(const bf16x8*)(SQ + qrow * 1024 + h * 64 + 32 * kk + 8 * g4);
    f32x4 s[9]; float mx = sink2;
    const int bidx = 15 + 4 * g4 - l15;
#pragma unroll
    for (int u = 0; u < 9; ++u) {
        const int mt = j + u; f32x4 acc = {0.f, 0.f, 0.f, 0.f};
#pragma unroll
        for (int kk = 0; kk < 2; ++kk) {
            const bf16x8 a = *(const LAS bf16x8*)(Kb + (16 * mt + l15) * SW_KS + 32 * kk + 8 * g4);
            acc = __builtin_amdgcn_mfma_f32_16x16x32_bf16(a, qf[kk], acc, 0, 0, 0);
        }
        const bool dead = first_block && (mt < 8);
#pragma unroll
        for (int r = 0; r < 4; ++r) { float v = acc[r] + BT[bidx + 16 * u + r]; v = dead ? -INFINITY : v; s[u][r] = v; mx = fmaxf(mx, v); }
    }
    mx = fmaxf(mx, __shfl_xor(mx, 16)); mx = fmaxf(mx, __shfl_xor(mx, 32));
    float sum = 0.f; bf16x4 pb[9];
#pragma unroll
    for (int u = 0; u < 9; ++u) {
        f32x4 p;
#pragma unroll
        for (int r = 0; r < 4; ++r) { p[r] = __builtin_amdgcn_exp2f(s[u][r] - mx); sum += p[r]; }
        pb[u] = __builtin_bit_cast(bf16x4, pack4(p));
    }
    sum += __shfl_xor(sum, 16); sum += __shfl_xor(sum, 32);
    sum += __builtin_amdgcn_exp2f(sink2 - mx);
    const float inv = 1.0f / sum;
#pragma unroll
    for (int dt = 0; dt < 4; ++dt) {
        f32x4 o = {0.f, 0.f, 0.f, 0.f};
#pragma unroll
        for (int u = 0; u < 9; ++u) {
            const bf16x4 a = *(const LAS bf16x4*)(Vt + (16 * dt + l15) * SW_VS + 16 * (j + u) + 4 * g4);
            o = __builtin_amdgcn_mfma_f32_16x16x16bf16_1k(a, pb[u], o, 0, 0, 0);
        }
        if (qvalid) *(u32x2*)(MIX + qrow * DM + 1024 + h * 64 + 16 * dt + 4 * g4) = pack4(o * inv);
    }
}
__device__ __forceinline__ void swa_load_tables(Frame& F, int k) {
    const float* BTg = (const float*)(F.ws + WS_TAB + 8192); LAS float* BT = (LAS float*)(F.lds + SW_BT);
    for (int i = F.tid; i < 8 * 160; i += NTHREADS) BT[i] = BTg[k * 8 * 160 + i];
}
__device__ __forceinline__ void swa_prompt_unit(Frame& F, int unit) {
    const int k = unit & 1, n = (unit >> 1) & 31, b = unit >> 6;
    const bf16_t* SKV = (const bf16_t*)(F.ws + WS_SKV);
    LAS bf16_t* Kb = (LAS bf16_t*)(F.lds + SW_K); LAS bf16_t* Vt = (LAS bf16_t*)(F.lds + SW_V);
    __syncthreads();
    swa_load_tables(F, k);
#pragma unroll
    for (int i = 0; i < 4; ++i) {
        const int idx = F.tid + 512 * i, kj = idx >> 3, p = idx & 7, pos = 128 * (n - 1) + kj;
        u32x4 kv = {0u, 0u, 0u, 0u}, vv = {0u, 0u, 0u, 0u};
        if (pos >= 0) { const bf16_t* src = SKV + (size_t)(b * SEQ + pos) * 256 + k * 64 + p * 8; kv = *(const u32x4*)src; vv = *(const u32x4*)(src + 128); }
        *(LAS u32x4*)(Kb + kj * SW_KS + p * 8) = kv;
        const unsigned w[4] = {vv.x, vv.y, vv.z, vv.w};
#pragma unroll
        for (int e = 0; e < 4; ++e) { Vt[(8 * p + 2 * e) * SW_VS + kj] = (bf16_t)(w[e] & 0xffffu); Vt[(8 * p + 2 * e + 1) * SW_VS + kj] = (bf16_t)(w[e] >> 16); }
    }
    __syncthreads();
    const int h = k * 8 + F.wave; const float sink2 = F.in[I_SINKS][h] * LOG2E;
#pragma unroll 1
    for (int j = 0; j < 8; ++j) swa_qtile(F, j, h, (size_t)(b * SEQ + 128 * n + 16 * j + (F.lane & 15)), true, n == 0, sink2);
}
__device__ __forceinline__ void swa_sample_unit(Frame& F, int unit) {
    const int k = unit & 1, b = unit >> 1;
    const bf16_t* SKV = (const bf16_t*)(F.ws + WS_SKV);
    LAS bf16_t* Kb = (LAS bf16_t*)(F.lds + SW_K); LAS bf16_t* Vt = (LAS bf16_t*)(F.lds + SW_V);
    __syncthreads();
    swa_load_tables(F, k);
#pragma unroll
    for (int i = 0; i < 4; ++i) {
        const int idx = F.tid + 512 * i, kj = idx >> 4, p = idx & 15;
        const size_t so = ((size_t)(b * 128 + kj) * 2 + k) * 64 + p * 4;
        const f32x4 kv = *(const f32x4*)(F.in[I_CSK] + so), vv = *(const f32x4*)(F.in[I_CSV] + so);
        *(LAS u32x2*)(Kb + kj * SW_KS + p * 4) = pack4(kv);
#pragma unroll
        for (int e = 0; e < 4; ++e) Vt[(4 * p + e) * SW_VS + kj] = f2bf(vv[e]);
        if (kj >= 4) { const size_t dof = ((size_t)(b * 128 + kj - 4) * 2 + k) * 64 + p * 4; *(f32x4*)(F.out + O_SSK + dof) = kv; *(f32x4*)(F.out + O_SSV + dof) = vv; }
    }
    if (F.tid < 128) {
        const int kj = 128 + (F.tid >> 3), p = F.tid & 7;
        u32x4 kv = {0u, 0u, 0u, 0u}, vv = {0u, 0u, 0u, 0u};
        if (kj < 132) { const bf16_t* src = SKV + (size_t)(TP + 4 * b + (kj - 128)) * 256 + k * 64 + p * 8; kv = *(const u32x4*)src; vv = *(const u32x4*)(src + 128); }
        *(LAS u32x4*)(Kb + kj * SW_KS + p * 8) = kv;
        const unsigned w[4] = {vv.x, vv.y, vv.z, vv.w};
#pragma unroll
        for (int e = 0; e < 4; ++e) { Vt[(8 * p + 2 * e) * SW_VS + kj] = (bf16_t)(w[e] & 0xffffu); Vt[(8 * p + 2 * e + 1) * SW_VS + kj] = (bf16_t)(w[e] >> 16); }
    }
    __syncthreads();
    const int h = k * 8 + F.wave, l15 = F.lane & 15; const float sink2 = F.in[I_SINKS][h] * LOG2E;
    swa_qtile(F, 0, h, (size_t)(TP + 4 * b + (l15 < 4 ? l15 : 3)), l15 < 4, false, sink2);
}

constexpr int MA_KS = 136, MA_VS = 264;
constexpr int MA_K = 0, MA_V = 256 * MA_KS * 2, MA_END = MA_V + 128 * MA_VS * 2;
static_assert(MA_END <= LDS_BYTES, "memattn LDS");
__device__ __forceinline__ void memattn_prompt_unit(Frame& F, int unit) {
    const int h = unit & 3, pm = unit >> 2, b = pm >> 4;
    const bf16_t* MK = (const bf16_t*)(F.ws + WS_MK); const bf16_t* MVT = (const bf16_t*)(F.ws + WS_MVT);
    const bf16_t* QM = (const bf16_t*)(F.ws + WS_QM); bf16_t* OM = (bf16_t*)(F.ws + WS_OM);
    LAS bf16_t* Kh = (LAS bf16_t*)(F.lds + MA_K); LAS bf16_t* Vt = (LAS bf16_t*)(F.lds + MA_V);
    const int lane = F.lane, l15 = lane & 15, g4 = lane >> 4;
    __syncthreads();
#pragma unroll
    for (int i = 0; i < 8; ++i) {
        const int idx = F.tid + 512 * i;
        { const int m = idx >> 4, p = idx & 15; *(LAS u32x4*)(Kh + m * MA_KS + p * 8) = *(const u32x4*)(MK + (size_t)(b * 256 + m) * 512 + h * 128 + p * 8); }
        { const int d = idx >> 5, p = idx & 31; *(LAS u32x4*)(Vt + d * MA_VS + p * 8) = *(const u32x4*)(MVT + ((size_t)(b * 4 + h) * 128 + d) * 256 + p * 8); }
    }
    __syncthreads();
#pragma unroll 1
    for (int jj = 0; jj < 2; ++jj) {
        const size_t row = (size_t)pm * 256 + 16 * (2 * F.wave + jj) + l15;
        bf16x8 qf[4];
#pragma unroll
        for (int kk = 0; kk < 4; ++kk) qf[kk] = *(const bf16x8*)(QM + row * 512 + h * 128 + 32 * kk + 8 * g4);
        f32x4 s[16]; float mx = -INFINITY;
#pragma unroll
        for (int mt = 0; mt < 16; ++mt) {
            f32x4 acc = {0.f, 0.f, 0.f, 0.f};
#pragma unroll
            for (int kk = 0; kk < 4; ++kk) {
                const bf16x8 a = *(const LAS bf16x8*)(Kh + (16 * mt + l15) * MA_KS + 32 * kk + 8 * g4);
                acc = __builtin_amdgcn_mfma_f32_16x16x32_bf16(a, qf[kk], acc, 0, 0, 0);
            }
            s[mt] = acc; mx = fmaxf(fmaxf(mx, fmaxf(acc[0], acc[1])), fmaxf(acc[2], acc[3]));
            __builtin_amdgcn_sched_barrier(0);
        }
        mx = fmaxf(mx, __shfl_xor(mx, 16)); mx = fmaxf(mx, __shfl_xor(mx, 32));
        float sum = 0.f; bf16x8 pb[8];
#pragma unroll
        for (int i = 0; i < 8; ++i) {
            f32x4 p0, p1;
#pragma unroll
            for (int r = 0; r < 4; ++r) { p0[r] = __builtin_amdgcn_exp2f(s[2 * i][r] - mx); p1[r] = __builtin_amdgcn_exp2f(s[2 * i + 1][r] - mx); sum += p0[r] + p1[r]; }
            pb[i] = __builtin_bit_cast(bf16x8, pack8(p0, p1));
        }
        sum += __shfl_xor(sum, 16); sum += __shfl_xor(sum, 32);
        const float inv = 1.0f / sum;
#pragma unroll
        for (int dt = 0; dt < 8; ++dt) {
            f32x4 o = {0.f, 0.f, 0.f, 0.f};
#pragma unroll
            for (int i = 0; i < 8; ++i) {
                const bf16x4 a0 = *(const LAS bf16x4*)(Vt + (16 * dt + l15) * MA_VS + 32 * i + 4 * g4);
                const bf16x4 a1 = *(const LAS bf16x4*)(Vt + (16 * dt + l15) * MA_VS + 32 * i + 16 + 4 * g4);
                const bf16x8 a = {a0[0], a0[1], a0[2], a0[3], a1[0], a1[1], a1[2], a1[3]};
                o = __builtin_amdgcn_mfma_f32_16x16x32_bf16(a, pb[i], o, 0, 0, 0);
            }
            *(u32x2*)(OM + row * 512 + h * 128 + 16 * dt + 4 * g4) = pack4(o * inv);
            __builtin_amdgcn_sched_barrier(0);
        }
    }
}
constexpr int MS_P = 0;
__device__ __forceinline__ void memattn_sample_task(Frame& F, int task) {
    const int h = task & 3, b = task >> 2;
    const float* CK = F.in[I_CMK] + (size_t)b * 256 * 512 + h * 128; const float* CV = F.in[I_CMV] + (size_t)b * 256 * 512 + h * 128;
    const bf16_t* QM = (const bf16_t*)(F.ws + WS_QM); bf16_t* OM = (bf16_t*)(F.ws + WS_OM);
    const int lane = F.lane, l15 = lane & 15, g4 = lane >> 4;
    LAS float* pl = (LAS float*)(F.lds + F.wave * 4352);
    bf16x8 qf[4];
#pragma unroll
    for (int kk = 0; kk < 4; ++kk) { qf[kk] = *(const bf16x8*)(QM + (size_t)(TP + 4 * b + (l15 & 3)) * 512 + h * 128 + 32 * kk + 8 * g4); if (l15 >= 4) qf[kk] = (bf16x8){0, 0, 0, 0, 0, 0, 0, 0}; }
    f32x4 s[16]; float mx = -INFINITY;
#pragma unroll
    for (int mt = 0; mt < 16; ++mt) {
        f32x4 acc = {0.f, 0.f, 0.f, 0.f};
#pragma unroll
        for (int kk = 0; kk < 4; ++kk) {
            const float* kp = CK + (size_t)(16 * mt + l15) * 512 + 32 * kk + 8 * g4;
            const u32x4 a = pack8(*(const f32x4*)kp, *(const f32x4*)(kp + 4));
            acc = __builtin_amdgcn_mfma_f32_16x16x32_bf16(__builtin_bit_cast(bf16x8, a), qf[kk], acc, 0, 0, 0);
        }
        s[mt] = acc; mx = fmaxf(fmaxf(mx, fmaxf(acc[0], acc[1])), fmaxf(acc[2], acc[3]));
    }
    mx = fmaxf(mx, __shfl_xor(mx, 16)); mx = fmaxf(mx, __shfl_xor(mx, 32));
    float sum = 0.f;
#pragma unroll
    for (int mt = 0; mt < 16; ++mt)
#pragma unroll
        for (int r = 0; r < 4; ++r) { const float p = __builtin_amdgcn_exp2f(s[mt][r] - mx); sum += p; if (l15 < 4) pl[(16 * mt + 4 * g4 + r) * 4 + l15] = p; }
    sum += __shfl_xor(sum, 16); sum += __shfl_xor(sum, 32);
    if (lane < 4) pl[1024 + lane] = 1.0f / sum;
    LDS_WAIT(); asm volatile("" ::: "memory");
    f32x2 o[4] = {{0.f, 0.f}, {0.f, 0.f}, {0.f, 0.f}, {0.f, 0.f}};
#pragma unroll 8
    for (int m = 0; m < 256; ++m) {
        const f32x2 v = *(const f32x2*)(CV + (size_t)m * 512 + 2 * lane);
        const f32x4 p = *(const LAS f32x4*)(pl + m * 4);
#pragma unroll
        for (int t = 0; t < 4; ++t) { o[t][0] += p[t] * v[0]; o[t][1] += p[t] * v[1]; }
    }
#pragma unroll
    for (int t = 0; t < 4; ++t) { const float inv = pl[1024 + t]; *(unsigned*)(OM + (size_t)(TP + 4 * b + t) * 512 + h * 128 + 2 * lane) = cvtpk(o[t][0] * inv, o[t][1] * inv); }
    LDS_WAIT(); asm volatile("" ::: "memory");
}

__device__ __forceinline__ void final_norm_row(float* xrow, const float* SS, int row, const float* w, int lane) {
    const float rs = row_rs(SS, row);
    f32x4* xr = (f32x4*)xrow + lane; const f32x4* wr = (const f32x4*)w + lane;
#pragma unroll
    for (int j = 0; j < 8; ++j) { f32x4 v = xr[64 * j]; const f32x4 ww = wr[64 * j]; v[0] = v[0] * rs * ww[0]; v[1] = v[1] * rs * ww[1]; v[2] = v[2] * rs * ww[2]; v[3] = v[3] * rs * ww[3]; xr[64 * j] = v; }
}

constexpr int N_PHASES = 11;
__global__ void __launch_bounds__(NTHREADS, 2) hymba_fwd(Args args) {
    extern __shared__ __attribute__((aligned(16))) unsigned char lds_raw[];
    cg::grid_group grid = cg::this_grid();
    Frame F;
    F.lds = (LAS unsigned char*)lds_raw;
    F.tid = threadIdx.x; F.lane = F.tid & 63; F.wave = __builtin_amdgcn_readfirstlane(F.tid >> 6);
    F.G = gridDim.x; F.bid = blockIdx.x;
    F.in = args.in; F.out = args.out; F.ws = args.ws;
    unsigned char* ws = args.ws; float* out = args.out;
    const int lo = args.ph_lo, hi = args.ph_hi;
#ifndef HY_PHASE_MASK
#define HY_PHASE_MASK 0x7ff
#endif
#define IN(k) (((HY_PHASE_MASK >> (k)) & 1) && lo <= (k) && (k) < hi)
#define SEAM(k) do { if (IN(k) && IN((k) + 1)) grid.sync(); } while (0)
    float* SS0 = (float*)(ws + WS_SS); float* SS1 = (float*)(ws + WS_SS + SS_STRIDE); float* SS2 = (float*)(ws + WS_SS + 2 * SS_STRIDE);
    bf16_t* XB = (bf16_t*)(ws + WS_XB);

    if (IN(0)) p0_prologue(F);
    SEAM(0);
    if (IN(1)) {
        { pg8::Gemm g{XB, (const bf16_t*)(ws + WS_WIN), TT, NIN, DM}; pg8::StaticOrder S; S.init(TT, NIN, F.G, F.bid);
          EpiIn E{out, out + (size_t)TT * 1024, (bf16_t*)(out + O_SST), (bf16_t*)(ws + WS_GATE), (bf16_t*)(ws + WS_SQ), (bf16_t*)(ws + WS_SKV), (const float*)(ws + WS_TAB), out};
          pg8::gemm_phase<EpiIn, pg8::StaticOrder, true, true>(F.lds, g, S, E); }
        { pg8::Gemm g{(const bf16_t*)(ws + WS_MN), (const bf16_t*)(ws + WS_WMKV), 1024, 1024, DM}; pg8::StaticOrder S; S.init(1024, 1024, F.G, (F.bid + 16) % F.G);
          EpiMemKV E{(bf16_t*)(ws + WS_MK), (bf16_t*)(ws + WS_MVT), out};
          pg8::gemm_phase<EpiMemKV, pg8::StaticOrder, true, true>(F.lds, g, S, E); }
    }
    SEAM(1);
    if (IN(2)) hgrn_prep(F);
    SEAM(2);
    if (IN(3)) {
        const bool split = F.G > 32;
        if (F.bid < 32) {
            for (int bh = F.bid; bh < 32; bh += F.G) { const int b = bh >> 3, h = bh & 7;
                hgrn_scan(F, b * 256, 256, h, b * SEQ, 16, nullptr, out + O_PST + (size_t)bh * 16384); }
        }
        if (!split || F.bid >= 32) {
            const int nw = split ? F.G - 32 : F.G;
            for (int i = split ? F.bid - 32 : F.bid; i < 1536; i += nw) {
                if (i < 256) swa_prompt_unit(F, i);
                else if (i < 512) swa_sample_unit(F, i - 256);
                else { const int t = i - 512, b = t >> 3, h = t & 7;
                    hgrn_scan(F, NCHP + b, 1, h, TP + 4 * b, 4, F.in[I_STATE] + (size_t)t * 16384, out + O_SST + (size_t)t * 16384); }
            }
        }
    }
    SEAM(3);
    if (IN(4)) {
        pg8::Gemm g{(const bf16_t*)(ws + WS_MIX), (const bf16_t*)(ws + WS_WOUT), TT, DM, DM}; pg8::StaticOrder S; S.init(TT, DM, F.G, F.bid);
        EpiResid E{F.in[I_XP], F.in[I_XS], out, XB, SS0};
        pg8::gemm_phase<EpiResid, pg8::StaticOrder, true, true>(F.lds, g, S, E);
    }
    SEAM(4);
    if (IN(5)) {
        pg8::Gemm g{XB, (const bf16_t*)(ws + WS_WMQ), TT, MEMW, DM}; pg8::StaticOrder S; S.init(TT, MEMW, F.G, F.bid);
        EpiScaleBf16 E{(bf16_t*)(ws + WS_QM), MEMW, SS0, MEM_QSCALE};
        pg8::gemm_phase<EpiScaleBf16, pg8::StaticOrder, true, true>(F.lds, g, S, E);
    }
    SEAM(5);
    if (IN(6)) {
        for (int u = F.bid; u < 256; u += F.G) memattn_prompt_unit(F, u);
        __syncthreads();
        for (int t = F.bid * NWAVES + F.wave; t < 512; t += F.G * NWAVES) memattn_sample_task(F, t);
    }
    SEAM(6);
    if (IN(7)) {
        pg8::Gemm g{(const bf16_t*)(ws + WS_OM), (const bf16_t*)(ws + WS_WMO), TT, DM, MEMW}; pg8::StaticOrder S; S.init(TT, DM, F.G, F.bid);
        EpiResid E{out, out + (size_t)TP * DM, out, XB, SS1};
        pg8::gemm_phase<EpiResid, pg8::StaticOrder, true, true>(F.lds, g, S, E);
    }
    SEAM(7);
    if (IN(8)) {
        pg8::Gemm g{XB, (const bf16_t*)(ws + WS_WGU), TT, 2 * FF, DM}; pg8::StaticOrder S; S.init(TT, 2 * FF, F.G, F.bid);
        EpiSwiGLU E{(bf16_t*)(ws + WS_HID), SS1};
        pg8::gemm_phase<EpiSwiGLU, pg8::StaticOrder, true, true>(F.lds, g, S, E);
    }
    SEAM(8);
    if (IN(9)) {
        pg8::Gemm g{(const bf16_t*)(ws + WS_HID), (const bf16_t*)(ws + WS_WDN), TT, DM, FF}; pg8::StaticOrder S; S.init(TT, DM, F.G, F.bid);
        EpiResid E{out, out + (size_t)TP * DM, out, nullptr, SS2};
        pg8::gemm_phase<EpiResid, pg8::StaticOrder, true, true>(F.lds, g, S, E);
    }
    SEAM(9);
    if (IN(10)) {
        for (int m = F.bid * NWAVES + F.wave; m < TT; m += F.G * NWAVES) final_norm_row(out + (size_t)m * DM, SS2, m, F.in[I_NFINAL], F.lane);
    }
#undef IN
#undef SEAM
}

#ifndef HY_N_LAUNCHES
#define HY_N_LAUNCHES 1
#endif
extern "C" void kernel_launch(void* const* d_in, const int* in_sizes, int n_in, void* d_out, int out_size, void* d_ws, size_t ws_size, hipStream_t stream) {
    static int grid = 0;
    if (grid == 0) {
        if (n_in != 26 || (size_t)out_size != O_END || ws_size < WS_END) { fprintf(stderr, "kernel_launch: unexpected problem: n_in %d out %d ws %zu (need %zu)\n", n_in, out_size, ws_size, (size_t)WS_END); grid = -1; return; }
        int dev = 0, cus = 0, per_cu = 0;
        hipGetDevice(&dev); hipDeviceGetAttribute(&cus, hipDeviceAttributeMultiprocessorCount, dev);
        if (hipFuncSetAttribute((const void*)hymba_fwd, hipFuncAttributeMaxDynamicSharedMemorySize, LDS_BYTES) != hipSuccess) { fprintf(stderr, "kernel_launch: hipFuncSetAttribute failed\n"); grid = -1; return; }
        if (hipOccupancyMaxActiveBlocksPerMultiprocessor(&per_cu, (const void*)hymba_fwd, NTHREADS, LDS_BYTES) != hipSuccess || per_cu < 1) { fprintf(stderr, "kernel_launch: occupancy query says %d blocks/CU\n", per_cu); per_cu = 1; }
        (void)hipGetLastError();
        grid = cus;
        fprintf(stderr, "kernel_launch: %d CUs, occupancy %d blocks/CU, grid %d\n", cus, per_cu, grid);
    }
    if (grid < 0) return;
    Args a{};
    for (int i = 0; i < 26; ++i) a.in[i] = (const float*)d_in[i];
    a.out = (float*)d_out; a.ws = (unsigned char*)d_ws;
#if HY_N_LAUNCHES == 1
    a.ph_lo = 0; a.ph_hi = N_PHASES;
    void* kargs[] = {&a};
    hipError_t e = hipLaunchCooperativeKernel((const void*)hymba_fwd, dim3(grid), dim3(NTHREADS), kargs, LDS_BYTES, stream);
    if (e != hipSuccess) fprintf(stderr, "kernel_launch: cooperative launch failed: %s\n", hipGetErrorString(e));
#else
    for (int p = 0; p < N_PHASES; ++p) {
        a.ph_lo = p; a.ph_hi = p + 1;
        hipLaunchKernelGGL(hymba_fwd, dim3(grid), dim3(NTHREADS), LDS_BYTES, stream, a);
    }
#endif
}
```

```cpp
#include <hip/hip_runtime.h>
#include <hip/hip_cooperative_groups.h>
#include <cstdio>
#include <cstdint>
namespace cg = cooperative_groups;

namespace pg8 {
#define PG8_LAS __attribute__((address_space(3)))
typedef unsigned short bf16_t;
typedef short bf16x8 __attribute__((ext_vector_type(8)));
typedef float f32x4 __attribute__((ext_vector_type(4)));
typedef unsigned u32x4 __attribute__((ext_vector_type(4)));
constexpr int BM = 256, BK = 64, HALF = 128, HTB = HALF * BK * 2  , STAGE_BYTES = 8 * HTB, NXCD = 8, WGM = 8;

__host__ __device__ __forceinline__ int lds_byte(int r, int c) { const int st = (r >> 4) * 2 + (c >> 5), rr = r & 15, cc = c & 31, ob = rr * 64 + cc * 2; return st * 1024 + (ob ^ (((ob >> 9) & 1) << 5)); }
__host__ __device__ __forceinline__ void stage_rc(int b, int& R, int& C) { const int st = b / 1024, sb = b % 1024, swz = sb ^ (((sb >> 9) & 1) << 5); R = (st >> 1) * 16 + swz / 64; C = (st & 1) * 32 + (swz % 64) / 2; }
__host__ __device__ __forceinline__ int perm32(int rho) { const int n = rho >> 4, i = rho & 15; return 8 * (i >> 2) + 4 * n + (i & 3); }

struct Unit { int pm, pn; };
struct Gemm { const bf16_t* A; const bf16_t* Bt; int M, N, K; };

struct StaticOrder {
    int nM, nN, nwg, G, c;
    __host__ __device__ void init(int M, int N, int G_, int c_) { nM = M / BM; nN = N / BM; nwg = nM * nN; G = G_; c = c_; }
    __host__ __device__ bool next(int i, Unit& u) const {
        const long L = (long)i * G + c; if (L >= nwg) return false;
        int wgid = (int)L; { const int q = nwg / NXCD, r = nwg % NXCD, xcd = wgid % NXCD, off = wgid / NXCD; wgid = (xcd < r ? xcd * (q + 1) : r * (q + 1) + (xcd - r) * q) + off; }
        const int nig = WGM * nN, gid = wgid / nig, fm = gid * WGM, gsz = (nM - fm) < WGM ? (nM - fm) : WGM;
        u.pm = fm + ((wgid % nig) % gsz); u.pn = (wgid % nig) / gsz; return true;
    }
    __device__ __forceinline__ void a_ready(const Unit&) const {}
    __device__ __forceinline__ void done(const Unit&) const {}
};

template <class Epi, class Sched, bool ALIGN_EPI = false, bool SP2 = false>
__device__ __forceinline__ void gemm_phase(PG8_LAS unsigned char* lds, const Gemm g, const Sched& S, const Epi& E) {
    const int tid = threadIdx.x, wid = __builtin_amdgcn_readfirstlane(tid >> 6), lane = tid & 63, wr = wid >> 2, wc = wid & 3, fr = lane & 15, fq = lane >> 4;
    const int K = g.K, nt = K / BK;
    unsigned voffA[2], voffB[2];
#pragma unroll
    for (int i = 0; i < 2; ++i) { int R, C; stage_rc(tid * 16 + i * 8192, R, C); const int Rb = Epi::PERM ? ((R & ~31) + perm32(R & 31)) : R;
        voffA[i] = (unsigned)(R * K + C) * 2u; voffB[i] = (unsigned)(Rb * K + C) * 2u; }
    const size_t kstep = (size_t)(BK * 2);
    const size_t hstep = (size_t)HALF * K * 2;
    const size_t tstep = 2 * hstep;
    const unsigned ldsw = (unsigned)wid * 1024u;
    const int aoff = lds_byte(wr * 64 + fr, fq * 8), boff = lds_byte(wc * 32 + fr, fq * 8);
#define PG8_SA(b, h) (((b) * 2 + (h)) * HTB)
#define PG8_SB(b, h) ((4 + (b) * 2 + (h)) * HTB)
#define PG8_STAGE(bufoff, gbase, voff) do { _Pragma("unroll") for (int _i = 0; _i < 2; ++_i) \
        __builtin_amdgcn_global_load_lds((const unsigned*)((const char*)(gbase) + (voff)[_i]), (PG8_LAS unsigned*)(lds + (bufoff) + ldsw + _i * 8192), 16, 0, 0); } while (0)
#define PG8_LDA(dst, b, h) do { _Pragma("unroll") for (int m = 0; m < 4; ++m) _Pragma("unroll") for (int k = 0; k < 2; ++k) dst[m][k] = *(const PG8_LAS bf16x8*)(lds + PG8_SA(b, h) + aoff + m * 2048 + k * 1024); } while (0)
#define PG8_LDB(dst, b, h) do { _Pragma("unroll") for (int n = 0; n < 2; ++n) _Pragma("unroll") for (int k = 0; k < 2; ++k) dst[n][k] = *(const PG8_LAS bf16x8*)(lds + PG8_SB(b, h) + boff + n * 2048 + k * 1024); } while (0)
#define PG8_MMA(ai, bj, At, Bt) do { __builtin_amdgcn_s_setprio(1); _Pragma("unroll") for (int m = 0; m < 4; ++m) _Pragma("unroll") for (int n = 0; n < 2; ++n) _Pragma("unroll") for (int k = 0; k < 2; ++k) \
        acc[ai][bj][m][n] = __builtin_amdgcn_mfma_f32_16x16x32_bf16(Bt[n][k], At[m][k], acc[ai][bj][m][n], 0, 0, 0); __builtin_amdgcn_s_setprio(0); } while (0)
#define PG8_WAIT_V(n) asm volatile("s_waitcnt vmcnt(" #n ")" ::: "memory")
#define PG8_WAIT_L(n) asm volatile("s_waitcnt lgkmcnt(" #n ")" ::: "memory")
#define PG8_BAR __builtin_amdgcn_s_barrier()
#define PG8_SCHED __builtin_amdgcn_sched_barrier(0)
    Unit cur, nxt; int ui = 0;
    if (!S.next(0, cur)) return;
    f32x4 acc[2][2][4][2];
#pragma unroll
    for (int a = 0; a < 2; ++a)
#pragma unroll
        for (int b = 0; b < 2; ++b)
#pragma unroll
            for (int m = 0; m < 4; ++m)
#pragma unroll
                for (int n = 0; n < 2; ++n) acc[a][b][m][n] = (f32x4){0.f, 0.f, 0.f, 0.f};
    bf16x8 At[4][2], B0[2][2], B1[2][2];
    const char* cA = (const char*)g.A + (size_t)cur.pm * tstep; const char* cB = (const char*)g.Bt + (size_t)cur.pn * tstep;
    S.a_ready(cur);
    if constexpr (SP2) {
        PG8_STAGE(PG8_SB(0, 0), cB, voffB); PG8_STAGE(PG8_SB(0, 1), cB + hstep, voffB); PG8_STAGE(PG8_SA(0, 0), cA, voffA); PG8_STAGE(PG8_SA(0, 1), cA + hstep, voffA);
        if (wr == 1) PG8_BAR;
        PG8_WAIT_V(2); PG8_BAR;
        PG8_STAGE(PG8_SB(1, 0), cB + kstep, voffB); PG8_STAGE(PG8_SA(1, 0), cA + kstep, voffA); PG8_STAGE(PG8_SB(1, 1), cB + hstep + kstep, voffB);
        PG8_WAIT_V(6); PG8_BAR;
    } else {
        PG8_STAGE(PG8_SB(0, 0), cB, voffB); PG8_STAGE(PG8_SA(0, 0), cA, voffA); PG8_STAGE(PG8_SB(0, 1), cB + hstep, voffB); PG8_STAGE(PG8_SA(0, 1), cA + hstep, voffA);
        if (wr == 1) PG8_BAR;
        PG8_WAIT_V(4); PG8_BAR;
        PG8_STAGE(PG8_SB(1, 0), cB + kstep, voffB); PG8_STAGE(PG8_SA(1, 0), cA + kstep, voffA); PG8_STAGE(PG8_SB(1, 1), cB + hstep + kstep, voffB);
        PG8_WAIT_V(6); PG8_BAR;
    }
    for (;;) {
        const bool has_next = S.next(ui + 1, nxt);
        const char* nA = has_next ? (const char*)g.A + (size_t)nxt.pm * tstep : cA; const char* nB = has_next ? (const char*)g.Bt + (size_t)nxt.pn * tstep : cB;
        for (int t = 0; t < nt; t += 2) {
            const bool last = (t == nt - 2);
            const char* a1 = cA + (size_t)(t + 1) * kstep;
            const char* a2 = last ? nA : cA + (size_t)(t + 2) * kstep; const char* b2 = last ? nB : cB + (size_t)(t + 2) * kstep;
            const char* a3 = a2 + kstep; const char* b3 = b2 + kstep;
            if (last && has_next) S.a_ready(nxt);
            if constexpr (SP2) {
            PG8_LDB(B0, 0, 0); PG8_LDB(B1, 0, 1); PG8_SCHED; PG8_LDA(At, 0, 0); PG8_STAGE(PG8_SA(1, 1), a1 + hstep, voffA);
            PG8_WAIT_V(8); PG8_WAIT_L(0); PG8_BAR; PG8_MMA(0, 0, At, B0); PG8_MMA(0, 1, At, B1); PG8_BAR; PG8_SCHED;
            PG8_LDA(At, 0, 1); PG8_STAGE(PG8_SB(0, 0), b2, voffB); PG8_STAGE(PG8_SB(0, 1), b2 + hstep, voffB); PG8_STAGE(PG8_SA(0, 0), a2, voffA);
            PG8_WAIT_V(8); PG8_WAIT_L(0); PG8_BAR; PG8_MMA(1, 0, At, B0); PG8_MMA(1, 1, At, B1); PG8_BAR; PG8_SCHED;
            PG8_LDB(B0, 1, 0); PG8_LDB(B1, 1, 1); PG8_SCHED; PG8_LDA(At, 1, 0); PG8_STAGE(PG8_SA(0, 1), a2 + hstep, voffA);
            PG8_WAIT_V(8); PG8_WAIT_L(0); PG8_BAR; PG8_MMA(0, 0, At, B0); PG8_MMA(0, 1, At, B1); PG8_BAR; PG8_SCHED;
            PG8_LDA(At, 1, 1); PG8_STAGE(PG8_SB(1, 0), b3, voffB); PG8_STAGE(PG8_SB(1, 1), b3 + hstep, voffB); PG8_STAGE(PG8_SA(1, 0), a3, voffA);
            PG8_WAIT_V(8); PG8_WAIT_L(0); PG8_BAR; PG8_MMA(1, 0, At, B0); PG8_MMA(1, 1, At, B1); PG8_BAR; PG8_SCHED;
            } else {
            PG8_LDB(B0, 0, 0); PG8_SCHED; PG8_LDA(At, 0, 0); PG8_STAGE(PG8_SA(1, 1), a1 + hstep, voffA);
            PG8_WAIT_L(8); PG8_BAR; PG8_WAIT_L(0); PG8_MMA(0, 0, At, B0); PG8_BAR; PG8_SCHED;
            PG8_LDB(B1, 0, 1); PG8_STAGE(PG8_SB(0, 0), b2, voffB);
            PG8_BAR; PG8_WAIT_L(0); PG8_MMA(0, 1, At, B1); PG8_BAR;
            PG8_LDA(At, 0, 1); PG8_STAGE(PG8_SA(0, 0), a2, voffA);
            PG8_BAR; PG8_WAIT_L(0); PG8_MMA(1, 0, At, B0); PG8_BAR; PG8_SCHED;
            PG8_STAGE(PG8_SB(0, 1), b2 + hstep, voffB);
            PG8_WAIT_V(6); PG8_BAR; PG8_MMA(1, 1, At, B1); PG8_BAR;
            PG8_LDB(B0, 1, 0); PG8_SCHED; PG8_LDA(At, 1, 0); PG8_STAGE(PG8_SA(0, 1), a2 + hstep, voffA);
            PG8_WAIT_L(8); PG8_BAR; PG8_WAIT_L(0); PG8_MMA(0, 0, At, B0); PG8_BAR; PG8_SCHED;
            PG8_LDB(B1, 1, 1); PG8_STAGE(PG8_SB(1, 0), b3, voffB);
            PG8_BAR; PG8_WAIT_L(0); PG8_MMA(0, 1, At, B1); PG8_BAR;
            PG8_LDA(At, 1, 1); PG8_STAGE(PG8_SA(1, 0), a3, voffA);
            PG8_BAR; PG8_WAIT_L(0); PG8_MMA(1, 0, At, B0); PG8_BAR; PG8_SCHED;
            PG8_STAGE(PG8_SB(1, 1), b3 + hstep, voffB);
            PG8_WAIT_V(6); PG8_BAR; PG8_MMA(1, 1, At, B1); PG8_BAR;
            }
        }
        if constexpr (ALIGN_EPI) { if (wr == 0) PG8_BAR; }
        if constexpr (!Epi::AFTER_DRAIN) { E(acc, cur, wr, wc, fr, fq); S.done(cur); }
        if (!has_next) break;
#pragma unroll
        for (int a = 0; a < 2; ++a)
#pragma unroll
            for (int b = 0; b < 2; ++b)
#pragma unroll
                for (int m = 0; m < 4; ++m)
#pragma unroll
                    for (int n = 0; n < 2; ++n) acc[a][b][m][n] = (f32x4){0.f, 0.f, 0.f, 0.f};
        cur = nxt; cA = nA; cB = nB; ++ui;
        if constexpr (ALIGN_EPI) { if (wr == 1) PG8_BAR; }
    }
    PG8_WAIT_V(0);
    if constexpr (!ALIGN_EPI) { if (wr == 0) PG8_BAR; }
    PG8_BAR;
    if constexpr (Epi::AFTER_DRAIN) { E.fused(acc, cur, wr, wc, fr, fq, lds, wid, lane); S.done(cur); }
#undef PG8_SA
#undef PG8_SB
#undef PG8_STAGE
#undef PG8_LDA
#undef PG8_LDB
#undef PG8_MMA
#undef PG8_WAIT_V
#undef PG8_WAIT_L
#undef PG8_BAR
#undef PG8_SCHED
}
}

#define LAS __attribute__((address_space(3)))
typedef unsigned short bf16_t;
typedef short bf16x8 __attribute__((ext_vector_type(8)));
typedef short bf16x4 __attribute__((ext_vector_type(4)));
typedef float f32x4 __attribute__((ext_vector_type(4)));
typedef float f32x2 __attribute__((ext_vector_type(2)));
typedef unsigned u32x4 __attribute__((ext_vector_type(4)));
typedef unsigned u32x2 __attribute__((ext_vector_type(2)));
typedef __bf16 hbf16x2 __attribute__((ext_vector_type(2)));

constexpr int DM = 2048, TP = 16384, TS = 512, TT = TP + TS, SEQ = 4096, DB = 128;
constexpr int NIN = 5376, FF = 5632, MEMW = 512;
constexpr int NCHP = TP / 16, NCH = NCHP + DB;
constexpr float RMS_EPS = 1e-6f;
constexpr float LOG2E = 1.4426950408889634f;
constexpr float SWA_QSCALE = 0.125f * LOG2E;
constexpr float MEM_QSCALE = 0.08838834764831845f * LOG2E;
constexpr int NWAVES = 8, NTHREADS = 512;
constexpr int LDS_BYTES = 147456;

constexpr size_t O_YP = 0, O_YS = 33554432, O_PST = 34603008, O_PSK = 35127296, O_PSV = 35192832, O_PMK = 35258368, O_PMV = 35782656,
                 O_SST = 36306944, O_SSK = 53084160, O_SSV = 55181312, O_END = 57278464;
constexpr size_t MiB = 1u << 20;
constexpr size_t WS_TAB = 1 * MiB;
constexpr size_t WS_WIN = 2 * MiB, WS_WOUT = 23 * MiB, WS_WMQ = 31 * MiB, WS_WMKV = 33 * MiB, WS_WMO = 37 * MiB, WS_WGU = 39 * MiB, WS_WDN = 83 * MiB;
constexpr size_t WS_SS = 105 * MiB;
constexpr size_t SS_STRIDE = 2359296;
constexpr size_t WS_MK = 112 * MiB, WS_MVT = 113 * MiB, WS_QM = 114 * MiB, WS_OM = 131 * MiB, WS_MN = 148 * MiB, WS_XB = 152 * MiB;
constexpr size_t WS_D = 218 * MiB;
constexpr size_t WS_GATE = WS_D, WS_SQ = WS_D + 33 * MiB, WS_SKV = WS_D + 66 * MiB, WS_QIN = WS_D + 75 * MiB, WS_KT = WS_D + 111 * MiB, WS_VT = WS_D + 147 * MiB,
                 WS_PSC = WS_D + 183 * MiB, WS_DEC = WS_D + 188 * MiB, WS_MIX = WS_D + 193 * MiB, WS_END = WS_D + 259 * MiB;
constexpr size_t WS_HID = WS_D;
static_assert((size_t)TT * FF * 2 <= 183 * MiB, "HID overlay");

struct Args {
    const float* in[26];
    float* out; unsigned char* ws;
    int ph_lo, ph_hi;
};

__device__ __forceinline__ unsigned cvtpk(float lo, float hi) { f32x2 v = {lo, hi}; hbf16x2 b = __builtin_convertvector(v, hbf16x2); return __builtin_bit_cast(unsigned, b); }
__device__ __forceinline__ float bf2f(unsigned short b) { return __uint_as_float((unsigned)b << 16); }
__device__ __forceinline__ unsigned short f2bf(float f) { return (unsigned short)(cvtpk(f, 0.f) & 0xffffu); }
__device__ __forceinline__ u32x4 pack8(f32x4 a, f32x4 b) { u32x4 w; w.x = cvtpk(a[0], a[1]); w.y = cvtpk(a[2], a[3]); w.z = cvtpk(b[0], b[1]); w.w = cvtpk(b[2], b[3]); return w; }
__device__ __forceinline__ u32x2 pack4(f32x4 a) { u32x2 w; w.x = cvtpk(a[0], a[1]); w.y = cvtpk(a[2], a[3]); return w; }
__device__ __forceinline__ float fexp(float x) { return __builtin_amdgcn_exp2f(x * LOG2E); }
__device__ __forceinline__ float fsigmoid(float x) { return __builtin_amdgcn_rcpf(1.0f + fexp(-x)); }
__device__ __forceinline__ float wave_sum(float v) {
#pragma unroll
    for (int o = 1; o < 64; o <<= 1) v += __shfl_xor(v, o);
    return v;
}
#define LDS_WAIT() asm volatile("s_waitcnt lgkmcnt(0)" ::: "memory")

__device__ __forceinline__ float row_rs(const float* SS, int row) {
    const f32x4* p = (const f32x4*)(SS + (size_t)row * 32);
    f32x4 s = p[0];
#pragma unroll
    for (int i = 1; i < 8; ++i) s += p[i];
    return __builtin_amdgcn_rsqf(((s[0] + s[1]) + (s[2] + s[3])) * (1.0f / DM) + RMS_EPS);
}

using pg8::Unit;
struct EpiIn {
    static constexpr bool PERM = true, AFTER_DRAIN = false;
    float* QF; float* GF; bf16_t* VB; bf16_t* GATE; bf16_t* SQ; bf16_t* SKV; const float* LB; float* out;
    __device__ __forceinline__ void operator()(const f32x4 (&acc)[2][2][4][2], const Unit& u, int wr, int wc, int fr, int fq) const {
        const int pn = u.pn;
#pragma unroll
        for (int ai = 0; ai < 2; ++ai)
#pragma unroll
            for (int m = 0; m < 4; ++m) {
                const int row = u.pm * 256 + ai * 128 + wr * 64 + m * 16 + fr;
#pragma unroll
                for (int bj = 0; bj < 2; ++bj) {
                    const int c = pn * 256 + bj * 128 + wc * 32 + 8 * fq;
                    f32x4 v0 = acc[ai][bj][m][0], v1 = acc[ai][bj][m][1];
                    if (pn < 4) {
                        float* d = QF + (size_t)row * 1024 + c; *(f32x4*)d = v0; *(f32x4*)(d + 4) = v1;
                    } else if (pn < 8) {
                        const int cc = c - 1024;
                        const f32x4 l0 = *(const f32x4*)(LB + cc), l1 = *(const f32x4*)(LB + cc + 4);
#pragma unroll
                        for (int j = 0; j < 4; ++j) { v0[j] = __logf(l0[j] + (1.0f - l0[j]) * fsigmoid(v0[j])); v1[j] = __logf(l1[j] + (1.0f - l1[j]) * fsigmoid(v1[j])); }
                        float* d = GF + (size_t)row * 1024 + cc; *(f32x4*)d = v0; *(f32x4*)(d + 4) = v1;
                    } else if (pn < 12) {
                        *(u32x4*)(VB + (size_t)row * 1024 + (c - 2048)) = pack8(v0, v1);
                    } else if (pn < 16) {
#pragma unroll
                        for (int j = 0; j < 4; ++j) { v0[j] = v0[j] * fsigmoid(v0[j]); v1[j] = v1[j] * fsigmoid(v1[j]); }
                        *(u32x4*)(GATE + (size_t)row * 1024 + (c - 3072)) = pack8(v0, v1);
                    } else if (pn < 20) {
                        *(u32x4*)(SQ + (size_t)row * 1024 + (c - 4096)) = pack8(v0 * SWA_QSCALE, v1 * SWA_QSCALE);
                    } else {
                        const int cc = c - 5120;
                        *(u32x4*)(SKV + (size_t)row * 256 + cc) = pack8(v0, v1);
                        float* d = nullptr;
                        if (row < TP) { const int b = row >> 12, t = row & 4095; if (t >= SEQ - 128) d = out + (bj == 0 ? O_PSK : O_PSV) + (size_t)(b * 128 + (t - (SEQ - 128))) * 128 + (cc & 127); }
                        else { const int rs = row - TP, b = rs >> 2, t = rs & 3; d = out + (bj == 0 ? O_SSK : O_SSV) + (size_t)(b * 128 + 124 + t) * 128 + (cc & 127); }
                        if (d) { *(f32x4*)d = v0; *(f32x4*)(d + 4) = v1; }
                    }
                }
            }
    }
};
struct EpiMemKV {
    static constexpr bool PERM = true, AFTER_DRAIN = false;
    bf16_t* MK; bf16_t* MVT; float* out;
    __device__ __forceinline__ void operator()(const f32x4 (&acc)[2][2][4][2], const Unit& u, int wr, int wc, int fr, int fq) const {
#pragma unroll
        for (int ai = 0; ai < 2; ++ai)
#pragma unroll
            for (int m = 0; m < 4; ++m) {
                const int row = u.pm * 256 + ai * 128 + wr * 64 + m * 16 + fr;
#pragma unroll
                for (int bj = 0; bj < 2; ++bj) {
                    const int c = u.pn * 256 + bj * 128 + wc * 32 + 8 * fq;
                    const f32x4 v0 = acc[ai][bj][m][0], v1 = acc[ai][bj][m][1];
                    if (u.pn < 2) {
                        float* d = out + O_PMK + (size_t)row * 512 + c; *(f32x4*)d = v0; *(f32x4*)(d + 4) = v1;
                        *(u32x4*)(MK + (size_t)row * 512 + c) = pack8(v0, v1);
                    } else {
                        const int cv = c - 512, h = cv >> 7, dd = cv & 127, b = row >> 8, mm = row & 255;
                        float* d = out + O_PMV + (size_t)row * 512 + cv; *(f32x4*)d = v0; *(f32x4*)(d + 4) = v1;
                        bf16_t* t = MVT + ((size_t)((b * 4 + h) * 128 + dd)) * 256 + mm;
#pragma unroll
                        for (int j = 0; j < 4; ++j) { t[(size_t)j * 256] = f2bf(v0[j]); t[(size_t)(j + 4) * 256] = f2bf(v1[j]); }
                    }
                }
            }
    }
};
struct EpiResid {
    static constexpr bool PERM = true, AFTER_DRAIN = false;
    const float* resP; const float* resS; float* X; bf16_t* XB; float* SS;
    __device__ __forceinline__ void operator()(const f32x4 (&acc)[2][2][4][2], const Unit& u, int wr, int wc, int fr, int fq) const {
#pragma unroll
        for (int ai = 0; ai < 2; ++ai)
#pragma unroll
            for (int m = 0; m < 4; ++m) {
                const int row = u.pm * 256 + ai * 128 + wr * 64 + m * 16 + fr;
                const float* rrow = (row < TP) ? resP + (size_t)row * DM : resS + (size_t)(row - TP) * DM;
                float ss = 0.f;
#pragma unroll
                for (int bj = 0; bj < 2; ++bj) {
                    const int c = u.pn * 256 + bj * 128 + wc * 32 + 8 * fq;
                    const f32x4 v0 = acc[ai][bj][m][0] + *(const f32x4*)(rrow + c), v1 = acc[ai][bj][m][1] + *(const f32x4*)(rrow + c + 4);
                    float* d = X + (size_t)row * DM + c; *(f32x4*)d = v0; *(f32x4*)(d + 4) = v1;
                    ss += (v0[0] * v0[0] + v0[1] * v0[1]) + (v0[2] * v0[2] + v0[3] * v0[3]) + (v1[0] * v1[0] + v1[1] * v1[1]) + (v1[2] * v1[2] + v1[3] * v1[3]);
                    if (XB) *(u32x4*)(XB + (size_t)row * DM + c) = pack8(v0, v1);
                }
                ss += __shfl_xor(ss, 16); ss += __shfl_xor(ss, 32);
                if (fq == 0) SS[(size_t)row * 32 + u.pn * 4 + wc] = ss;
            }
    }
};
struct EpiScaleBf16 {
    static constexpr bool PERM = true, AFTER_DRAIN = false;
    bf16_t* O; int ldc; const float* SS; float scale;
    __device__ __forceinline__ void operator()(const f32x4 (&acc)[2][2][4][2], const Unit& u, int wr, int wc, int fr, int fq) const {
#pragma unroll
        for (int ai = 0; ai < 2; ++ai)
#pragma unroll
            for (int m = 0; m < 4; ++m) {
                const int row = u.pm * 256 + ai * 128 + wr * 64 + m * 16 + fr;
                const float s = row_rs(SS, row) * scale;
#pragma unroll
                for (int bj = 0; bj < 2; ++bj) {
                    const int c = u.pn * 256 + bj * 128 + wc * 32 + 8 * fq;
                    *(u32x4*)(O + (size_t)row * ldc + c) = pack8(acc[ai][bj][m][0] * s, acc[ai][bj][m][1] * s);
                }
            }
    }
};
struct EpiSwiGLU {
    static constexpr bool PERM = true, AFTER_DRAIN = false;
    bf16_t* HID; const float* SS;
    __device__ __forceinline__ void operator()(const f32x4 (&acc)[2][2][4][2], const Unit& u, int wr, int wc, int fr, int fq) const {
#pragma unroll
        for (int ai = 0; ai < 2; ++ai)
#pragma unroll
            for (int m = 0; m < 4; ++m) {
                const int row = u.pm * 256 + ai * 128 + wr * 64 + m * 16 + fr;
                const float s = row_rs(SS, row);
                f32x4 h0, h1;
#pragma unroll
                for (int j = 0; j < 4; ++j) {
                    const float g0 = acc[ai][0][m][0][j] * s, u0 = acc[ai][1][m][0][j] * s, g1 = acc[ai][0][m][1][j] * s, u1 = acc[ai][1][m][1][j] * s;
                    h0[j] = g0 * fsigmoid(g0) * u0; h1[j] = g1 * fsigmoid(g1) * u1;
                }
                *(u32x4*)(HID + (size_t)row * FF + u.pn * 128 + wc * 32 + 8 * fq) = pack8(h0, h1);
            }
    }
};

struct Frame {
    LAS unsigned char* lds;
    int tid, lane, wave, G, bid;
    const float* const* in;
    float* out; unsigned char* ws;
};
enum { I_XP = 0, I_XS, I_STATE, I_CSK, I_CSV, I_CMK, I_CMV, I_MEMP, I_NMIX, I_WIN, I_LB, I_ONORM, I_SINKS, I_RELB, I_WOUT, I_NXATT, I_NMEM,
       I_WMQ, I_WMK, I_WMV, I_WMO, I_NFFN, I_WGATE, I_WUP, I_WDOWN, I_NFINAL };

__device__ __forceinline__ void p0_tr_item(const float* __restrict__ W, int K, int N, bf16_t* WT, int k0, int n0, int drow0, const float* __restrict__ scale, LAS float* scr, int lane) {
#pragma unroll 8
    for (int i = 0; i < 32; ++i) { const int kk = 2 * i + (lane >> 5); float v = W[(size_t)(k0 + kk) * N + n0 + (lane & 31)]; if (scale) v *= scale[k0 + kk]; scr[kk * 33 + (lane & 31)] = v; }
    LDS_WAIT(); asm volatile("" ::: "memory");
    const int c = lane & 7;
#pragma unroll
    for (int j = 0; j < 4; ++j) { const int n = (lane >> 3) + 8 * j; const LAS float* s = scr + (8 * c) * 33 + n;
        u32x4 o; o.x = cvtpk(s[0 * 33], s[1 * 33]); o.y = cvtpk(s[2 * 33], s[3 * 33]); o.z = cvtpk(s[4 * 33], s[5 * 33]); o.w = cvtpk(s[6 * 33], s[7 * 33]);
        *(u32x4*)(WT + (size_t)(drow0 + n) * K + k0 + 8 * c) = o; }
    LDS_WAIT(); asm volatile("" ::: "memory");
}
__device__ __forceinline__ void p0_rms_row(const float* xrow, const float* w, bf16_t* orow, int lane) {
    const f32x4* xr = (const f32x4*)xrow + lane; const f32x4* wr = (const f32x4*)w + lane;
    f32x4 v[8]; float s = 0.f;
#pragma unroll
    for (int j = 0; j < 8; ++j) { v[j] = xr[64 * j]; s += (v[j][0] * v[j][0] + v[j][1] * v[j][1]) + (v[j][2] * v[j][2] + v[j][3] * v[j][3]); }
    const float rs = __builtin_amdgcn_rsqf(wave_sum(s) * (1.0f / DM) + RMS_EPS);
    u32x2* o8 = (u32x2*)orow + lane;
#pragma unroll
    for (int j = 0; j < 8; ++j) { const f32x4 ww = wr[64 * j]; f32x4 y; y[0] = v[j][0] * rs * ww[0]; y[1] = v[j][1] * rs * ww[1]; y[2] = v[j][2] * rs * ww[2]; y[3] = v[j][3] * rs * ww[3]; o8[64 * j] = pack4(y); }
}
__device__ __forceinline__ int rel_bucket(int n) {
    if (n < 16) return n;
    int b = 16 + (int)(__logf((float)n * (1.0f / 16.0f)) / 2.0794415416798357f * 16.0f);
    return b < 31 ? b : 31;
}
__device__ __forceinline__ void p0_prologue(Frame& F) {
    LAS float* scr = (LAS float*)(F.lds + F.wave * 16384);
    const int gw = F.bid * NWAVES + F.wave, NGW = F.G * NWAVES;
    unsigned char* ws = F.ws;
    constexpr int I_IN = 32 * (NIN / 32), I_OUT = 32 * 64, I_MQ = 32 * 16, I_MO = 8 * 64, I_G = 32 * (FF / 32), I_DN = (FF / 64) * 64;
    constexpr int NITEMS = I_IN + I_OUT + 3 * I_MQ + I_MO + 2 * I_G + I_DN;
    for (int it = gw; it < NITEMS; it += NGW) {
        int r = it;
        if (r < I_IN) { const int nb = NIN / 32, kb = r / nb, n0 = (r % nb) * 32; p0_tr_item(F.in[I_WIN], DM, NIN, (bf16_t*)(ws + WS_WIN), kb * 64, n0, n0, nullptr, scr, F.lane); continue; } r -= I_IN;
        if (r < I_OUT) { const int kb = r / 64, n0 = (r % 64) * 32; p0_tr_item(F.in[I_WOUT], DM, DM, (bf16_t*)(ws + WS_WOUT), kb * 64, n0, n0, nullptr, scr, F.lane); continue; } r -= I_OUT;
        if (r < I_MQ) { const int kb = r / 16, n0 = (r % 16) * 32; p0_tr_item(F.in[I_WMQ], DM, MEMW, (bf16_t*)(ws + WS_WMQ), kb * 64, n0, n0, F.in[I_NXATT], scr, F.lane); continue; } r -= I_MQ;
        if (r < I_MQ) { const int kb = r / 16, n0 = (r % 16) * 32; p0_tr_item(F.in[I_WMK], DM, MEMW, (bf16_t*)(ws + WS_WMKV), kb * 64, n0, n0, nullptr, scr, F.lane); continue; } r -= I_MQ;
        if (r < I_MQ) { const int kb = r / 16, n0 = (r % 16) * 32; p0_tr_item(F.in[I_WMV], DM, MEMW, (bf16_t*)(ws + WS_WMKV), kb * 64, n0, 512 + n0, nullptr, scr, F.lane); continue; } r -= I_MQ;
        if (r < I_MO) { const int kb = r / 64, n0 = (r % 64) * 32; p0_tr_item(F.in[I_WMO], MEMW, DM, (bf16_t*)(ws + WS_WMO), kb * 64, n0, n0, nullptr, scr, F.lane); continue; } r -= I_MO;
        if (r < 2 * I_G) { const int up = r >= I_G; if (up) r -= I_G; const int nb = FF / 32, kb = r / nb, n0 = (r % nb) * 32;
            p0_tr_item(F.in[up ? I_WUP : I_WGATE], DM, FF, (bf16_t*)(ws + WS_WGU), kb * 64, n0, (n0 >> 7) * 256 + (n0 & 127) + (up ? 128 : 0), F.in[I_NFFN], scr, F.lane); continue; } r -= 2 * I_G;
        { const int kb = r / 64, n0 = (r % 64) * 32; p0_tr_item(F.in[I_WDOWN], FF, DM, (bf16_t*)(ws + WS_WDN), kb * 64, n0, n0, nullptr, scr, F.lane); }
    }
    for (int m = gw; m < TT + 1024; m += NGW) {
        if (m < TP) p0_rms_row(F.in[I_XP] + (size_t)m * DM, F.in[I_NMIX], (bf16_t*)(ws + WS_XB) + (size_t)m * DM, F.lane);
        else if (m < TT) p0_rms_row(F.in[I_XS] + (size_t)(m - TP) * DM, F.in[I_NMIX], (bf16_t*)(ws + WS_XB) + (size_t)m * DM, F.lane);
        else p0_rms_row(F.in[I_MEMP] + (size_t)(m - TT) * DM, F.in[I_NMEM], (bf16_t*)(ws + WS_MN) + (size_t)(m - TT) * DM, F.lane);
    }
    float* LBt = (float*)(ws + WS_TAB); float* BT = (float*)(ws + WS_TAB + 8192);
    const int gt = F.bid * NTHREADS + F.tid, NGT = F.G * NTHREADS;
    for (int i = gt; i < 1024 + 16 * 160; i += NGT) {
        if (i < 1024) { const float l0 = F.in[I_LB][i], l1 = F.in[I_LB][1024 + i]; LBt[i] = 1.0f / (1.0f + __expf(l1 - l0)); }
        else { const int j = i - 1024, h = j / 160, ix = j % 160, dist = 143 - ix;
            BT[j] = (dist >= 0 && dist < 128) ? F.in[I_RELB][rel_bucket(dist) * 16 + h] * LOG2E : -INFINITY; }
    }
}

constexpr int PREP_RS = 1032;
__device__ __forceinline__ void hgrn_prep(Frame& F) {
    unsigned char* ws = F.ws;
    const float* QF = F.out; const float* GF = F.out + (size_t)TT * 1024; const bf16_t* VB = (const bf16_t*)(F.out + O_SST);
    bf16_t* QIN = (bf16_t*)(ws + WS_QIN); bf16_t* KT = (bf16_t*)(ws + WS_KT); bf16_t* VT = (bf16_t*)(ws + WS_VT); bf16_t* PSC = (bf16_t*)(ws + WS_PSC); float* DEC = (float*)(ws + WS_DEC);
    LAS bf16_t* lq = (LAS bf16_t*)F.lds; LAS bf16_t* lk = lq + 16 * PREP_RS;
    const int l15 = F.lane & 15, g4 = F.lane >> 4;
    for (int ch = F.bid; ch < NCH; ch += F.G) {
        const int nv = ch < NCHP ? 16 : 4; const int row0 = ch < NCHP ? ch * 16 : TP + (ch - NCHP) * 4;
#pragma unroll 1
        for (int pass = 0; pass < 2; ++pass) {
            const int cidx = F.tid + 512 * pass;
            float g[16], q[16]; unsigned short vv[16];
#pragma unroll
            for (int t = 0; t < 16; ++t) {
                if (t < nv) { g[t] = GF[(size_t)(row0 + t) * 1024 + cidx]; q[t] = QF[(size_t)(row0 + t) * 1024 + cidx]; vv[t] = VB[(size_t)(row0 + t) * 1024 + cidx]; }
                else { g[t] = 0.f; q[t] = 0.f; vv[t] = 0; }
            }
            float G = 0.f; unsigned kd[8], vt[8];
#pragma unroll
            for (int t = 0; t < 16; t += 2) {
                float qi[2], kk[2];
#pragma unroll
                for (int z = 0; z < 2; ++z) {
                    const float gt = g[t + z]; G += gt;
                    qi[z] = q[t + z] * fexp(G);
                    kk[z] = (1.0f - fexp(gt)) * fexp(fminf(-G, 80.0f));
                    lq[(t + z) * PREP_RS + cidx] = f2bf(qi[z]); lk[(t + z) * PREP_RS + cidx] = f2bf(kk[z]);
                }
                kd[t >> 1] = cvtpk(kk[0], kk[1]); vt[t >> 1] = (unsigned)vv[t] | ((unsigned)vv[t + 1] << 16);
            }
            DEC[(size_t)ch * 1024 + cidx] = fexp(G);
            u32x4* kp = (u32x4*)(KT + ((size_t)ch * 1024 + cidx) * 16); kp[0] = (u32x4){kd[0], kd[1], kd[2], kd[3]}; kp[1] = (u32x4){kd[4], kd[5], kd[6], kd[7]};
            u32x4* vp = (u32x4*)(VT + ((size_t)ch * 1024 + cidx) * 16); vp[0] = (u32x4){vt[0], vt[1], vt[2], vt[3]}; vp[1] = (u32x4){vt[4], vt[5], vt[6], vt[7]};
        }
        __syncthreads();
#pragma unroll
        for (int i = 0; i < 4; ++i) { const int idx = F.tid + 512 * i, t = idx >> 7, c8 = idx & 127;
            *(u32x4*)(QIN + ((size_t)ch * 16 + t) * 1024 + c8 * 8) = *(const LAS u32x4*)(lq + t * PREP_RS + c8 * 8); }
        {
            const int h = F.wave; f32x4 acc = {0.f, 0.f, 0.f, 0.f};
#pragma unroll
            for (int kk = 0; kk < 4; ++kk) {
                const bf16x8 a = *(const LAS bf16x8*)(lq + l15 * PREP_RS + h * 128 + 32 * kk + 8 * g4);
                const bf16x8 b = *(const LAS bf16x8*)(lk + l15 * PREP_RS + h * 128 + 32 * kk + 8 * g4);
                acc = __builtin_amdgcn_mfma_f32_16x16x32_bf16(a, b, acc, 0, 0, 0);
            }
            bf16_t* pd = PSC + ((size_t)ch * 8 + h) * 256;
#pragma unroll
            for (int r = 0; r < 4; ++r) { const int t = 4 * g4 + r, s = l15; pd[t * 16 + s] = (s <= t) ? f2bf(acc[r]) : (bf16_t)0; }
        }
        __syncthreads();
    }
}

constexpr int SC_QS = 136;
constexpr int SC_QI = 0, SC_KT = 16 * SC_QS * 2, SC_VT = SC_KT + 4096, SC_P = SC_VT + 4096, SC_DEC = SC_P + 512, SC_GATE = SC_DEC + 512, SC_BUF = SC_GATE + 16 * SC_QS * 2;
constexpr int SC_RED = 2 * SC_BUF;
static_assert(SC_RED + 1024 <= LDS_BYTES && SC_BUF % 16 == 0, "scan LDS");
struct ScanPf { u32x4 a, b, c; };
struct ScanSrc { const unsigned char* a; const unsigned char* b; const unsigned char* c; unsigned oa, ob, oc; };
__device__ __forceinline__ ScanSrc scan_src(const Frame& F, int ch0, int h, int grow0, int ngr) {
    const unsigned char* ws = F.ws; const int tid = F.tid; ScanSrc s;
    const bf16_t* QIN = (const bf16_t*)(ws + WS_QIN); const bf16_t* KT = (const bf16_t*)(ws + WS_KT); const bf16_t* VT = (const bf16_t*)(ws + WS_VT);
    const bf16_t* PSC = (const bf16_t*)(ws + WS_PSC); const float* DEC = (const float*)(ws + WS_DEC); const bf16_t* GATE = (const bf16_t*)(ws + WS_GATE);
    if (tid < 256) { const int t = tid >> 4, p = tid & 15;
        s.a = (const unsigned char*)(QIN + ((size_t)ch0 * 16 + t) * 1024 + h * 128 + p * 8); s.oa = SC_QI + (t * SC_QS + p * 8) * 2;
        s.b = (const unsigned char*)(VT + ((size_t)ch0 * 1024 + h * 128) * 16 + tid * 8); s.ob = SC_VT + tid * 16;
    } else { const int i = tid - 256, t = i >> 4, p = i & 15; const int tr = t < ngr ? t : ngr - 1;
        s.a = (const unsigned char*)(KT + ((size_t)ch0 * 1024 + h * 128) * 16 + i * 8); s.oa = SC_KT + i * 16;
        s.b = (const unsigned char*)(GATE + (size_t)(grow0 + tr) * 1024 + h * 128 + p * 8); s.ob = SC_GATE + (t * SC_QS + p * 8) * 2;
    }
    if (tid < 32) { s.c = (const unsigned char*)(PSC + ((size_t)ch0 * 8 + h) * 256 + tid * 8); s.oc = SC_P + tid * 16; }
    else { const int i = (tid - 32) & 31; s.c = (const unsigned char*)(DEC + (size_t)ch0 * 1024 + h * 128 + i * 4); s.oc = SC_DEC + i * 16; }
    return s;
}
__device__ __forceinline__ void scan_fetch(ScanPf& pf, const ScanSrc& s, const Frame& F, int step) {
    pf.a = *(const u32x4*)(s.a + (size_t)step * 32768); pf.b = *(const u32x4*)(s.b + (size_t)step * 32768);
    if (F.tid < 64) pf.c = *(const u32x4*)(s.c + (size_t)step * 4096);
}
__device__ __forceinline__ void scan_stash(const ScanPf& pf, const ScanSrc& s, const Frame& F, int buf) {
    LAS unsigned char* B = F.lds + buf * SC_BUF;
    *(LAS u32x4*)(B + s.oa) = pf.a; *(LAS u32x4*)(B + s.ob) = pf.b;
    if (F.tid < 64) *(LAS u32x4*)(B + s.oc) = pf.c;
}
template <int CTRL> __device__ __forceinline__ float dpp_mov(float v) { return __int_as_float(__builtin_amdgcn_update_dpp(0, __float_as_int(v), CTRL, 0xF, 0xF, true)); }
__device__ __forceinline__ float row16_sum(float v) { v += dpp_mov<0xB1>(v); v += dpp_mov<0x4E>(v); v += dpp_mov<0x141>(v); v += dpp_mov<0x140>(v); return v; }
constexpr int SC_ST = SC_RED + 1024, SC_STS = 132;
static_assert(SC_ST + 128 * SC_STS * 4 <= LDS_BYTES, "scan LDS (state image)");
__device__ __forceinline__ void hgrn_scan(Frame& F, int ch0, int nsteps, int h, int mrow0, int nvalid, const float* S0, float* Sout) {
    const int lane = F.lane, l15 = lane & 15, g4 = lane >> 4, e0 = 16 * F.wave;
    bf16_t* MIX = (bf16_t*)(F.ws + WS_MIX);
    const float onw = F.in[I_ONORM][e0 + l15];
    LAS float* RED = (LAS float*)(F.lds + SC_RED);
    LAS float* ST = (LAS float*)(F.lds + SC_ST);
    ScanPf pf;
    __syncthreads();
    const ScanSrc src = scan_src(F, ch0, h, mrow0, nvalid);
    scan_fetch(pf, src, F, 0); scan_stash(pf, src, F, 0);
    if (nsteps > 1) scan_fetch(pf, src, F, 1);
    f32x4 S[8];
    if (S0) {
#pragma unroll
        for (int i = 0; i < 8; ++i) { const int idx = F.tid + 512 * i, c = idx >> 5, e4 = idx & 31; *(LAS f32x4*)(ST + c * SC_STS + e4 * 4) = *(const f32x4*)(S0 + (size_t)c * 128 + e4 * 4); }
    }
    __syncthreads();
#pragma unroll
    for (int mt = 0; mt < 8; ++mt)
#pragma unroll
        for (int r = 0; r < 4; ++r) S[mt][r] = S0 ? ST[(16 * mt + 4 * g4 + r) * SC_STS + e0 + l15] : 0.f;
    f32x4 o_prev = {0.f, 0.f, 0.f, 0.f}, gate_prev = {0.f, 0.f, 0.f, 0.f};
#pragma unroll 1
    for (int n = 0; n <= nsteps; ++n) {
        const int buf = n & 1;
        f32x4 o = {0.f, 0.f, 0.f, 0.f}, gate = {0.f, 0.f, 0.f, 0.f};
        if (n + 1 < nsteps) {
            scan_stash(pf, src, F, buf ^ 1);
            if (n + 2 < nsteps) scan_fetch(pf, src, F, n + 2);
        }
        if (n < nsteps) {
            const LAS unsigned char* B = F.lds + buf * SC_BUF;
            const bf16x4 vt = *(const LAS bf16x4*)(B + SC_VT + ((e0 + l15) * 16 + 4 * g4) * 2);
            const bf16x4 pa = *(const LAS bf16x4*)(B + SC_P + (l15 * 16 + 4 * g4) * 2);
            f32x4 ob = {0.f, 0.f, 0.f, 0.f};
            o = __builtin_amdgcn_mfma_f32_16x16x16bf16_1k(pa, vt, o, 0, 0, 0);
#pragma unroll
            for (int kk = 0; kk < 4; ++kk) {
                const bf16x4 q0 = *(const LAS bf16x4*)(B + SC_QI + (l15 * SC_QS + 32 * kk + 4 * g4) * 2);
                const bf16x4 q1 = *(const LAS bf16x4*)(B + SC_QI + (l15 * SC_QS + 32 * kk + 16 + 4 * g4) * 2);
                const bf16x8 qa = {q0[0], q0[1], q0[2], q0[3], q1[0], q1[1], q1[2], q1[3]};
                const u32x4 sb = pack8(S[2 * kk], S[2 * kk + 1]);
                if (kk & 1) ob = __builtin_amdgcn_mfma_f32_16x16x32_bf16(qa, __builtin_bit_cast(bf16x8, sb), ob, 0, 0, 0);
                else o = __builtin_amdgcn_mfma_f32_16x16x32_bf16(qa, __builtin_bit_cast(bf16x8, sb), o, 0, 0, 0);
            }
#pragma unroll
            for (int mt = 0; mt < 8; ++mt) {
                const bf16x4 kt = *(const LAS bf16x4*)(B + SC_KT + ((16 * mt + l15) * 16 + 4 * g4) * 2);
                const f32x4 dc = *(const LAS f32x4*)(B + SC_DEC + (16 * mt + 4 * g4) * 4);
                S[mt] = __builtin_amdgcn_mfma_f32_16x16x16bf16_1k(kt, vt, S[mt], 0, 0, 0);
                S[mt] = S[mt] * dc;
            }
            o = o + ob;
#pragma unroll
            for (int r = 0; r < 4; ++r) {
                gate[r] = bf2f(*(const LAS unsigned short*)(B + SC_GATE + ((4 * g4 + r) * SC_QS + e0 + l15) * 2));
                const float ss = row16_sum(o[r] * o[r]);
                if (l15 == 0) RED[(buf * 8 + F.wave) * 16 + 4 * g4 + r] = ss;
            }
        }
        if (n > 0) {
            const int pb = (n - 1) & 1;
#pragma unroll
            for (int r = 0; r < 4; ++r) {
                const int t = 4 * g4 + r; float tot = 0.f;
#pragma unroll
                for (int w = 0; w < 8; ++w) tot += RED[(pb * 8 + w) * 16 + t];
                const float rs = __builtin_amdgcn_rsqf(tot * (1.0f / 128.0f) + RMS_EPS);
                if (t < nvalid) MIX[(size_t)(mrow0 + 16 * (n - 1) + t) * DM + h * 128 + e0 + l15] = f2bf(o_prev[r] * rs * onw * gate_prev[r]);
            }
        }
        o_prev = o; gate_prev = gate;
        __syncthreads();
    }
#pragma unroll
    for (int mt = 0; mt < 8; ++mt)
#pragma unroll
        for (int r = 0; r < 4; ++r) ST[(16 * mt + 4 * g4 + r) * SC_STS + e0 + l15] = S[mt][r];
    __syncthreads();
#pragma unroll
    for (int i = 0; i < 8; ++i) { const int idx = F.tid + 512 * i, c = idx >> 5, e4 = idx & 31; *(f32x4*)(Sout + (size_t)c * 128 + e4 * 4) = *(const LAS f32x4*)(ST + c * SC_STS + e4 * 4); }
}


constexpr int SW_KS = 72, SW_VS = 264;
constexpr int SW_K = 0, SW_V = 256 * SW_KS * 2, SW_BT = SW_V + 64 * SW_VS * 2, SW_END = SW_BT + 8 * 160 * 4;
static_assert(SW_END <= LDS_BYTES, "swa LDS");
__device__ __forceinline__ void swa_qtile(Frame& F, int j, int h, size_t qrow, bool qvalid, bool first_block, float sink2) {
    const int lane = F.lane, l15 = lane & 15, g4 = lane >> 4;
    const bf16_t* SQ = (const bf16_t*)(F.ws + WS_SQ); bf16_t* MIX = (bf16_t*)(F.ws + WS_MIX);
    const LAS bf16_t* Kb = (const LAS bf16_t*)(F.lds + SW_K); const LAS bf16_t* Vt = (const LAS bf16_t*)(F.lds + SW_V);
    const LAS float* BT = (const LAS float*)(F.lds + SW_BT) + F.wave * 160;
    bf16x8 qf[2];
#pragma unroll
    for (int kk = 0; kk < 2; ++kk) qf[kk] = *(const bf16x8*)(SQ + qrow * 1024 + h * 64 + 32 * kk + 8 * g4);
    f32x4 s[9]; float mx = sink2;
    const int bidx = 15 + 4 * g4 - l15;
#pragma unroll
    for (int u = 0; u < 9; ++u) {
        const int mt = j + u; f32x4 acc = {0.f, 0.f, 0.f, 0.f};
#pragma unroll
        for (int kk = 0; kk < 2; ++kk) {
            const bf16x8 a = *(const LAS bf16x8*)(Kb + (16 * mt + l15) * SW_KS + 32 * kk + 8 * g4);
            acc = __builtin_amdgcn_mfma_f32_16x16x32_bf16(a, qf[kk], acc, 0, 0, 0);
        }
        const bool dead = first_block && (mt < 8);
#pragma unroll
        for (int r = 0; r < 4; ++r) { float v = acc[r] + BT[bidx + 16 * u + r]; v = dead ? -INFINITY : v; s[u][r] = v; mx = fmaxf(mx, v); }
    }
    mx = fmaxf(mx, __shfl_xor(mx, 16)); mx = fmaxf(mx, __shfl_xor(mx, 32));
    float sum = 0.f; bf16x4 pb[9];
#pragma unroll
    for (int u = 0; u < 9; ++u) {
        f32x4 p;
#pragma unroll
        for (int r = 0; r < 4; ++r) { p[r] = __builtin_amdgcn_exp2f(s[u][r] - mx); sum += p[r]; }
        pb[u] = __builtin_bit_cast(bf16x4, pack4(p));
    }
    sum += __shfl_xor(sum, 16); sum += __shfl_xor(sum, 32);
    sum += __builtin_amdgcn_exp2f(sink2 - mx);
    const float inv = 1.0f / sum;
#pragma unroll
    for (int dt = 0; dt < 4; ++dt) {
        f32x4 o = {0.f, 0.f, 0.f, 0.f};
#pragma unroll
        for (int u = 0; u < 9; ++u) {
            const bf16x4 a = *(const LAS bf16x4*)(Vt + (16 * dt + l15) * SW_VS + 16 * (j + u) + 4 * g4);
            o = __builtin_amdgcn_mfma_f32_16x16x16bf16_1k(a, pb[u], o, 0, 0, 0);
        }
        if (qvalid) *(u32x2*)(MIX + qrow * DM + 1024 + h * 64 + 16 * dt + 4 * g4) = pack4(o * inv);
    }
}
__device__ __forceinline__ void swa_load_tables(Frame& F, int k) {
    const float* BTg = (const float*)(F.ws + WS_TAB + 8192); LAS float* BT = (LAS float*)(F.lds + SW_BT);
    for (int i = F.tid; i < 8 * 160; i += NTHREADS) BT[i] = BTg[k * 8 * 160 + i];
}
__device__ __forceinline__ void swa_prompt_unit(Frame& F, int unit) {
    const int k = unit & 1, n = (unit >> 1) & 31, b = unit >> 6;
    const bf16_t* SKV = (const bf16_t*)(F.ws + WS_SKV);
    LAS bf16_t* Kb = (LAS bf16_t*)(F.lds + SW_K); LAS bf16_t* Vt = (LAS bf16_t*)(F.lds + SW_V);
    __syncthreads();
    swa_load_tables(F, k);
#pragma unroll
    for (int i = 0; i < 4; ++i) {
        const int idx = F.tid + 512 * i, kj = idx >> 3, p = idx & 7, pos = 128 * (n - 1) + kj;
        u32x4 kv = {0u, 0u, 0u, 0u}, vv = {0u, 0u, 0u, 0u};
        if (pos >= 0) { const bf16_t* src = SKV + (size_t)(b * SEQ + pos) * 256 + k * 64 + p * 8; kv = *(const u32x4*)src; vv = *(const u32x4*)(src + 128); }
        *(LAS u32x4*)(Kb + kj * SW_KS + p * 8) = kv;
        const unsigned w[4] = {vv.x, vv.y, vv.z, vv.w};
#pragma unroll
        for (int e = 0; e < 4; ++e) { Vt[(8 * p + 2 * e) * SW_VS + kj] = (bf16_t)(w[e] & 0xffffu); Vt[(8 * p + 2 * e + 1) * SW_VS + kj] = (bf16_t)(w[e] >> 16); }
    }
    __syncthreads();
    const int h = k * 8 + F.wave; const float sink2 = F.in[I_SINKS][h] * LOG2E;
#pragma unroll 1
    for (int j = 0; j < 8; ++j) swa_qtile(F, j, h, (size_t)(b * SEQ + 128 * n + 16 * j + (F.lane & 15)), true, n == 0, sink2);
}
__device__ __forceinline__ void swa_sample_unit(Frame& F, int unit) {
    const int k = unit & 1, b = unit >> 1;
    const bf16_t* SKV = (const bf16_t*)(F.ws + WS_SKV);
    LAS bf16_t* Kb = (LAS bf16_t*)(F.lds + SW_K); LAS bf16_t* Vt = (LAS bf16_t*)(F.lds + SW_V);
    __syncthreads();
    swa_load_tables(F, k);
#pragma unroll
    for (int i = 0; i < 4; ++i) {
        const int idx = F.tid + 512 * i, kj = idx >> 4, p = idx & 15;
        const size_t so = ((size_t)(b * 128 + kj) * 2 + k) * 64 + p * 4;
        const f32x4 kv = *(const f32x4*)(F.in[I_CSK] + so), vv = *(const f32x4*)(F.in[I_CSV] + so);
        *(LAS u32x2*)(Kb + kj * SW_KS + p * 4) = pack4(kv);
#pragma unroll
        for (int e = 0; e < 4; ++e) Vt[(4 * p + e) * SW_VS + kj] = f2bf(vv[e]);
        if (kj >= 4) { const size_t dof = ((size_t)(b * 128 + kj - 4) * 2 + k) * 64 + p * 4; *(f32x4*)(F.out + O_SSK + dof) = kv; *(f32x4*)(F.out + O_SSV + dof) = vv; }
    }
    if (F.tid < 128) {
        const int kj = 128 + (F.tid >> 3), p = F.tid & 7;
        u32x4 kv = {0u, 0u, 0u, 0u}, vv = {0u, 0u, 0u, 0u};
        if (kj < 132) { const bf16_t* src = SKV + (size_t)(TP + 4 * b + (kj - 128)) * 256 + k * 64 + p * 8; kv = *(const u32x4*)src; vv = *(const u32x4*)(src + 128); }
        *(LAS u32x4*)(Kb + kj * SW_KS + p * 8) = kv;
        const unsigned w[4] = {vv.x, vv.y, vv.z, vv.w};
#pragma unroll
        for (int e = 0; e < 4; ++e) { Vt[(8 * p + 2 * e) * SW_VS + kj] = (bf16_t)(w[e] & 0xffffu); Vt[(8 * p + 2 * e + 1) * SW_VS + kj] = (bf16_t)(w[e] >> 16); }
    }
    __syncthreads();
    const int h = k * 8 + F.wave, l15 = F.lane & 15; const float sink2 = F.in[I_SINKS][h] * LOG2E;
    swa_qtile(F, 0, h, (size_t)(TP + 4 * b + (l15 < 4 ? l15 : 3)), l15 < 4, false, sink2);
}

constexpr int MA_KS = 136, MA_VS = 264;
constexpr int MA_K = 0, MA_V = 256 * MA_KS * 2, MA_END = MA_V + 128 * MA_VS * 2;
static_assert(MA_END <= LDS_BYTES, "memattn LDS");
__device__ __forceinline__ void memattn_prompt_unit(Frame& F, int unit) {
    const int h = unit & 3, pm = unit >> 2, b = pm >> 4;
    const bf16_t* MK = (const bf16_t*)(F.ws + WS_MK); const bf16_t* MVT = (const bf16_t*)(F.ws + WS_MVT);
    const bf16_t* QM = (const bf16_t*)(F.ws + WS_QM); bf16_t* OM = (bf16_t*)(F.ws + WS_OM);
    LAS bf16_t* Kh = (LAS bf16_t*)(F.lds + MA_K); LAS bf16_t* Vt = (LAS bf16_t*)(F.lds + MA_V);
    const int lane = F.lane, l15 = lane & 15, g4 = lane >> 4;
    __syncthreads();
#pragma unroll
    for (int i = 0; i < 8; ++i) {
        const int idx = F.tid + 512 * i;
        { const int m = idx >> 4, p = idx & 15; *(LAS u32x4*)(Kh + m * MA_KS + p * 8) = *(const u32x4*)(MK + (size_t)(b * 256 + m) * 512 + h * 128 + p * 8); }
        { const int d = idx >> 5, p = idx & 31; *(LAS u32x4*)(Vt + d * MA_VS + p * 8) = *(const u32x4*)(MVT + ((size_t)(b * 4 + h) * 128 + d) * 256 + p * 8); }
    }
    __syncthreads();
#pragma unroll 1
    for (int jj = 0; jj < 2; ++jj) {
        const size_t row = (size_t)pm * 256 + 16 * (2 * F.wave + jj) + l15;
        bf16x8 qf[4];
#pragma unroll
        for (int kk = 0; kk < 4; ++kk) qf[kk] = *(const bf16x8*)(QM + row * 512 + h * 128 + 32 * kk + 8 * g4);
        f32x4 s[16]; float mx = -INFINITY;
#pragma unroll
        for (int mt = 0; mt < 16; ++mt) {
            f32x4 acc = {0.f, 0.f, 0.f, 0.f};
#pragma unroll
            for (int kk = 0; kk < 4; ++kk) {
                const bf16x8 a = *(const LAS bf16x8*)(Kh + (16 * mt + l15) * MA_KS + 32 * kk + 8 * g4);
                acc = __builtin_amdgcn_mfma_f32_16x16x32_bf16(a, qf[kk], acc, 0, 0, 0);
            }
            s[mt] = acc; mx = fmaxf(fmaxf(mx, fmaxf(acc[0], acc[1])), fmaxf(acc[2], acc[3]));
            __builtin_amdgcn_sched_barrier(0);
        }
        mx = fmaxf(mx, __shfl_xor(mx, 16)); mx = fmaxf(mx, __shfl_xor(mx, 32));
        float sum = 0.f; bf16x8 pb[8];
#pragma unroll
        for (int i = 0; i < 8; ++i) {
            f32x4 p0, p1;
#pragma unroll
            for (int r = 0; r < 4; ++r) { p0[r] = __builtin_amdgcn_exp2f(s[2 * i][r] - mx); p1[r] = __builtin_amdgcn_exp2f(s[2 * i + 1][r] - mx); sum += p0[r] + p1[r]; }
            pb[i] = __builtin_bit_cast(bf16x8, pack8(p0, p1));
        }
        sum += __shfl_xor(sum, 16); sum += __shfl_xor(sum, 32);
        const float inv = 1.0f / sum;
#pragma unroll
        for (int dt = 0; dt < 8; ++dt) {
            f32x4 o = {0.f, 0.f, 0.f, 0.f};
#pragma unroll
            for (int i = 0; i < 8; ++i) {
                const bf16x4 a0 = *(const LAS bf16x4*)(Vt + (16 * dt + l15) * MA_VS + 32 * i + 4 * g4);
                const bf16x4 a1 = *(const LAS bf16x4*)(Vt + (16 * dt + l15) * MA_VS + 32 * i + 16 + 4 * g4);
                const bf16x8 a = {a0[0], a0[1], a0[2], a0[3], a1[0], a1[1], a1[2], a1[3]};
                o = __builtin_amdgcn_mfma_f32_16x16x32_bf16(a, pb[i], o, 0, 0, 0);
            }
            *(u32x2*)(OM + row * 512 + h * 128 + 16 * dt + 4 * g4) = pack4(o * inv);
            __builtin_amdgcn_sched_barrier(0);
        }
    }
}
constexpr int MS_P = 0;
__device__ __forceinline__ void memattn_sample_task(Frame& F, int task) {
    const int h = task & 3, b = task >> 2;
    const float* CK = F.in[I_CMK] + (size_t)b * 256 * 512 + h * 128; const float* CV = F.in[I_CMV] + (size_t)b * 256 * 512 + h * 128;
    const bf16_t* QM = (const bf16_t*)(F.ws + WS_QM); bf16_t* OM = (bf16_t*)(F.ws + WS_OM);
    const int lane = F.lane, l15 = lane & 15, g4 = lane >> 4;
    LAS float* pl = (LAS float*)(F.lds + F.wave * 4352);
    bf16x8 qf[4];
#pragma unroll
    for (int kk = 0; kk < 4; ++kk) { qf[kk] = *(const bf16x8*)(QM + (size_t)(TP + 4 * b + (l15 & 3)) * 512 + h * 128 + 32 * kk + 8 * g4); if (l15 >= 4) qf[kk] = (bf16x8){0, 0, 0, 0, 0, 0, 0, 0}; }
    f32x4 s[16]; float mx = -INFINITY;
#pragma unroll
    for (int mt = 0; mt < 16; ++mt) {
        f32x4 acc = {0.f, 0.f, 0.f, 0.f};
#pragma unroll
        for (int kk = 0; kk < 4; ++kk) {
            const float* kp = CK + (size_t)(16 * mt + l15) * 512 + 32 * kk + 8 * g4;
            const u32x4 a = pack8(*(const f32x4*)kp, *(const f32x4*)(kp + 4));
            acc = __builtin_amdgcn_mfma_f32_16x16x32_bf16(__builtin_bit_cast(bf16x8, a), qf[kk], acc, 0, 0, 0);
        }
        s[mt] = acc; mx = fmaxf(fmaxf(mx, fmaxf(acc[0], acc[1])), fmaxf(acc[2], acc[3]));
    }
    mx = fmaxf(mx, __shfl_xor(mx, 16)); mx = fmaxf(mx, __shfl_xor(mx, 32));
    float sum = 0.f;
#pragma unroll
    for (int mt = 0; mt < 16; ++mt)
#pragma unroll
        for (int r = 0; r < 4; ++r) { const float p = __builtin_amdgcn_exp2f(s[mt][r] - mx); sum += p; if (l15 < 4) pl[(16 * mt + 4 * g4 + r) * 4 + l15] = p; }
    sum += __shfl_xor(sum, 16); sum += __shfl_xor(sum, 32);
    if (lane < 4) pl[1024 + lane] = 1.0f / sum;
    LDS_WAIT(); asm volatile("" ::: "memory");
    f32x2 o[4] = {{0.f, 0.f}, {0.f, 0.f}, {0.f, 0.f}, {0.f, 0.f}};
#pragma unroll 8
    for (int m = 0; m < 256; ++m) {
        const f32x2 v = *(const f32x2*)(CV + (size_t)m * 512 + 2 * lane);
        const f32x4 p = *(const LAS f32x4*)(pl + m * 4);
#pragma unroll
        for (int t = 0; t < 4; ++t) { o[t][0] += p[t] * v[0]; o[t][1] += p[t] * v[1]; }
    }
#pragma unroll
    for (int t = 0; t < 4; ++t) { const float inv = pl[1024 + t]; *(unsigned*)(OM + (size_t)(TP + 4 * b + t) * 512 + h * 128 + 2 * lane) = cvtpk(o[t][0] * inv, o[t][1] * inv); }
    LDS_WAIT(); asm volatile("" ::: "memory");
}

__device__ __forceinline__ void final_norm_row(float* xrow, const float* SS, int row, const float* w, int lane) {
    const float rs = row_rs(SS, row);
    f32x4* xr = (f32x4*)xrow + lane; const f32x4* wr = (const f32x4*)w + lane;
#pragma unroll
    for (int j = 0; j < 8; ++j) { f32x4 v = xr[64 * j]; const f32x4 ww = wr[64 * j]; v[0] = v[0] * rs * ww[0]; v[1] = v[1] * rs * ww[1]; v[2] = v[2] * rs * ww[2]; v[3] = v[3] * rs * ww[3]; xr[64 * j] = v; }
}

#define HGRN_SCAN_PROMPT hgrn_scan
#define HGRN_SCAN_SAMPLE hgrn_scan
#ifdef HY_P3DELAY
#define P3_DELAY do { for (int z_ = 0; z_ < 16; ++z_) __builtin_amdgcn_s_sleep(127); __syncthreads(); } while (0)
#else
#define P3_DELAY do {} while (0)
#endif
constexpr int N_PHASES = 11;
__global__ void __launch_bounds__(NTHREADS, 2) hymba_fwd(Args args) {
    extern __shared__ __attribute__((aligned(16))) unsigned char lds_raw[];
    cg::grid_group grid = cg::this_grid();
    Frame F;
    F.lds = (LAS unsigned char*)lds_raw;
    F.tid = threadIdx.x; F.lane = F.tid & 63; F.wave = __builtin_amdgcn_readfirstlane(F.tid >> 6);
    F.G = gridDim.x; F.bid = blockIdx.x;
    F.in = args.in; F.out = args.out; F.ws = args.ws;
    unsigned char* ws = args.ws; float* out = args.out;
#ifdef HY_LDSCLR
    for (int i = F.tid; i < LDS_BYTES / 16; i += NTHREADS) *(LAS u32x4*)(F.lds + i * 16) = (u32x4){0u, 0u, 0u, 0u};
    __syncthreads();
#endif
    const int lo = args.ph_lo, hi = args.ph_hi;
#ifndef HY_PHASE_MASK
#define HY_PHASE_MASK 0x7ff
#endif
#define IN(k) (((HY_PHASE_MASK >> (k)) & 1) && lo <= (k) && (k) < hi)
#ifndef HY_REPMASK
#define HY_REPMASK 0
#endif
#define PHASE(k, ...) do { if (IN(k)) { __VA_ARGS__ } if (IN(k) && ((HY_REPMASK >> (k)) & 1)) { __VA_ARGS__ } } while (0)
#ifdef HY_XACQ
#define SEAM(k) do { if (IN(k) && IN((k) + 1)) { asm volatile("s_waitcnt vmcnt(0)" ::: "memory"); __builtin_amdgcn_fence(__ATOMIC_RELEASE, "agent"); asm volatile("s_waitcnt vmcnt(0)" ::: "memory"); grid.sync(); __builtin_amdgcn_fence(__ATOMIC_ACQUIRE, "agent"); asm volatile("s_waitcnt vmcnt(0)" ::: "memory"); __syncthreads(); } } while (0)
#else
#define SEAM(k) do { if (IN(k) && IN((k) + 1)) grid.sync(); } while (0)
#endif
    float* SS0 = (float*)(ws + WS_SS); float* SS1 = (float*)(ws + WS_SS + SS_STRIDE); float* SS2 = (float*)(ws + WS_SS + 2 * SS_STRIDE);
    bf16_t* XB = (bf16_t*)(ws + WS_XB);

    PHASE(0, p0_prologue(F););
    SEAM(0);
    PHASE(1,
        { pg8::Gemm g{XB, (const bf16_t*)(ws + WS_WIN), TT, NIN, DM}; pg8::StaticOrder S; S.init(TT, NIN, F.G, F.bid);
          EpiIn E{out, out + (size_t)TT * 1024, (bf16_t*)(out + O_SST), (bf16_t*)(ws + WS_GATE), (bf16_t*)(ws + WS_SQ), (bf16_t*)(ws + WS_SKV), (const float*)(ws + WS_TAB), out};
          pg8::gemm_phase<EpiIn, pg8::StaticOrder, true, true>(F.lds, g, S, E); }
        { pg8::Gemm g{(const bf16_t*)(ws + WS_MN), (const bf16_t*)(ws + WS_WMKV), 1024, 1024, DM}; pg8::StaticOrder S; S.init(1024, 1024, F.G, (F.bid + 16) % F.G);
          EpiMemKV E{(bf16_t*)(ws + WS_MK), (bf16_t*)(ws + WS_MVT), out};
          pg8::gemm_phase<EpiMemKV, pg8::StaticOrder, true, true>(F.lds, g, S, E); }
    );
    SEAM(1);
    PHASE(2, hgrn_prep(F););
    SEAM(2);
    PHASE(3,
        const bool split = F.G > 32;
#define P3_SCAN do { if (F.bid < 32) { P3_DELAY; for (int bh = F.bid; bh < 32; bh += F.G) { const int b = bh >> 3, h = bh & 7; \
                HGRN_SCAN_PROMPT(F, b * 256, 256, h, b * SEQ, 16, nullptr, out + O_PST + (size_t)bh * 16384); } } } while (0)
#define P3_OTHERS do { if (!split || F.bid >= 32) { const int nw = split ? F.G - 32 : F.G; \
            for (int i = split ? F.bid - 32 : F.bid; i < 1536; i += nw) { \
                if (i < 256) swa_prompt_unit(F, i); \
                else if (i < 512) swa_sample_unit(F, i - 256); \
                else { const int t = i - 512, b = t >> 3, h = t & 7; \
                    HGRN_SCAN_SAMPLE(F, NCHP + b, 1, h, TP + 4 * b, 4, F.in[I_STATE] + (size_t)t * 16384, out + O_SST + (size_t)t * 16384); } } } } while (0)
        P3_SCAN;
        if ((HY_REPMASK >> 11) & 1) P3_SCAN;
        P3_OTHERS;
        if ((HY_REPMASK >> 12) & 1) P3_OTHERS;
    );
    SEAM(3);
    PHASE(4,
        pg8::Gemm g{(const bf16_t*)(ws + WS_MIX), (const bf16_t*)(ws + WS_WOUT), TT, DM, DM}; pg8::StaticOrder S; S.init(TT, DM, F.G, F.bid);
        EpiResid E{F.in[I_XP], F.in[I_XS], out, XB, SS0};
        pg8::gemm_phase<EpiResid, pg8::StaticOrder, true, true>(F.lds, g, S, E);
    );
    SEAM(4);
    PHASE(5,
        pg8::Gemm g{XB, (const bf16_t*)(ws + WS_WMQ), TT, MEMW, DM}; pg8::StaticOrder S; S.init(TT, MEMW, F.G, F.bid);
        EpiScaleBf16 E{(bf16_t*)(ws + WS_QM), MEMW, SS0, MEM_QSCALE};
        pg8::gemm_phase<EpiScaleBf16, pg8::StaticOrder, true, true>(F.lds, g, S, E);
    );
    SEAM(5);
    PHASE(6,
        for (int u = F.bid; u < 256; u += F.G) memattn_prompt_unit(F, u);
        __syncthreads();
        for (int t = F.bid * NWAVES + F.wave; t < 512; t += F.G * NWAVES) memattn_sample_task(F, t);
    );
    SEAM(6);
    if (IN(7)) {
        pg8::Gemm g{(const bf16_t*)(ws + WS_OM), (const bf16_t*)(ws + WS_WMO), TT, DM, MEMW}; pg8::StaticOrder S; S.init(TT, DM, F.G, F.bid);
        EpiResid E{out, out + (size_t)TP * DM, out, XB, SS1};
        pg8::gemm_phase<EpiResid, pg8::StaticOrder, true, true>(F.lds, g, S, E);
    }
    SEAM(7);
    PHASE(8,
        pg8::Gemm g{XB, (const bf16_t*)(ws + WS_WGU), TT, 2 * FF, DM}; pg8::StaticOrder S; S.init(TT, 2 * FF, F.G, F.bid);
        EpiSwiGLU E{(bf16_t*)(ws + WS_HID), SS1};
        pg8::gemm_phase<EpiSwiGLU, pg8::StaticOrder, true, true>(F.lds, g, S, E);
    );
    SEAM(8);
    if (IN(9)) {
        pg8::Gemm g{(const bf16_t*)(ws + WS_HID), (const bf16_t*)(ws + WS_WDN), TT, DM, FF}; pg8::StaticOrder S; S.init(TT, DM, F.G, F.bid);
        EpiResid E{out, out + (size_t)TP * DM, out, nullptr, SS2};
        pg8::gemm_phase<EpiResid, pg8::StaticOrder, true, true>(F.lds, g, S, E);
    }
    SEAM(9);
    if (IN(10)) {
        for (int m = F.bid * NWAVES + F.wave; m < TT; m += F.G * NWAVES) final_norm_row(out + (size_t)m * DM, SS2, m, F.in[I_NFINAL], F.lane);
    }
#undef IN
#undef SEAM
}

#ifndef HY_N_LAUNCHES
#define HY_N_LAUNCHES 1
#endif
extern "C" void kernel_launch(void* const* d_in, const int* in_sizes, int n_in, void* d_out, int out_size, void* d_ws, size_t ws_size, hipStream_t stream) {
    static int grid = 0;
    if (grid == 0) {
        if (n_in != 26 || (size_t)out_size != O_END || ws_size < WS_END) { fprintf(stderr, "kernel_launch: unexpected problem: n_in %d out %d ws %zu (need %zu)\n", n_in, out_size, ws_size, (size_t)WS_END); grid = -1; return; }
        int dev = 0, cus = 0, per_cu = 0;
        hipGetDevice(&dev); hipDeviceGetAttribute(&cus, hipDeviceAttributeMultiprocessorCount, dev);
        if (hipFuncSetAttribute((const void*)hymba_fwd, hipFuncAttributeMaxDynamicSharedMemorySize, LDS_BYTES) != hipSuccess) { fprintf(stderr, "kernel_launch: hipFuncSetAttribute failed\n"); grid = -1; return; }
        if (hipOccupancyMaxActiveBlocksPerMultiprocessor(&per_cu, (const void*)hymba_fwd, NTHREADS, LDS_BYTES) != hipSuccess || per_cu < 1) { fprintf(stderr, "kernel_launch: occupancy query says %d blocks/CU\n", per_cu); per_cu = 1; }
        (void)hipGetLastError();
        grid = cus;
        fprintf(stderr, "kernel_launch: %d CUs, occupancy %d blocks/CU, grid %d\n", cus, per_cu, grid);
    }
    if (grid < 0) return;
    Args a{};
    for (int i = 0; i < 26; ++i) a.in[i] = (const float*)d_in[i];
    a.out = (float*)d_out; a.ws = (unsigned char*)d_ws;
#if HY_N_LAUNCHES == 1
    a.ph_lo = 0; a.ph_hi = N_PHASES;
    void* kargs[] = {&a};
    hipError_t e = hipLaunchCooperativeKernel((const void*)hymba_fwd, dim3(grid), dim3(NTHREADS), kargs, LDS_BYTES, stream);
    if (e != hipSuccess) fprintf(stderr, "kernel_launch: cooperative launch failed: %s\n", hipGetErrorString(e));
#else
    for (int p = 0; p < N_PHASES; ++p) {
        a.ph_lo = p; a.ph_hi = p + 1;
        hipLaunchKernelGGL(hymba_fwd, dim3(grid), dim3(NTHREADS), LDS_BYTES, stream, a);
    }
#endif
}
```

```cpp
#include <hip/hip_runtime.h>
#include <hip/hip_cooperative_groups.h>
#include <cstdio>
#include <cstdint>
namespace cg = cooperative_groups;

namespace pg8 {
#define PG8_LAS __attribute__((address_space(3)))
typedef unsigned short bf16_t;
typedef short bf16x8 __attribute__((ext_vector_type(8)));
typedef float f32x4 __attribute__((ext_vector_type(4)));
typedef unsigned u32x4 __attribute__((ext_vector_type(4)));
constexpr int BM = 256, BK = 64, HALF = 128, HTB = HALF * BK * 2  , STAGE_BYTES = 8 * HTB, NXCD = 8, WGM = 8;

__host__ __device__ __forceinline__ int lds_byte(int r, int c) { const int st = (r >> 4) * 2 + (c >> 5), rr = r & 15, cc = c & 31, ob = rr * 64 + cc * 2; return st * 1024 + (ob ^ (((ob >> 9) & 1) << 5)); }
__host__ __device__ __forceinline__ void stage_rc(int b, int& R, int& C) { const int st = b / 1024, sb = b % 1024, swz = sb ^ (((sb >> 9) & 1) << 5); R = (st >> 1) * 16 + swz / 64; C = (st & 1) * 32 + (swz % 64) / 2; }
__host__ __device__ __forceinline__ int perm32(int rho) { const int n = rho >> 4, i = rho & 15; return 8 * (i >> 2) + 4 * n + (i & 3); }

struct Unit { int pm, pn, ks; };
struct Gemm { const bf16_t* A; const bf16_t* Bt; int M, N, K, ld; };

struct StaticOrder {
    int nM, nN, nwg, G, c;
    __host__ __device__ void init(int M, int N, int G_, int c_) { nM = M / BM; nN = N / BM; nwg = nM * nN; G = G_; c = c_; }
    __host__ __device__ bool next(int i, Unit& u) const {
        const long L = (long)i * G + c; if (L >= nwg) return false;
        int wgid = (int)L; { const int q = nwg / NXCD, r = nwg % NXCD, xcd = wgid % NXCD, off = wgid / NXCD; wgid = (xcd < r ? xcd * (q + 1) : r * (q + 1) + (xcd - r) * q) + off; }
        const int nig = WGM * nN, gid = wgid / nig, fm = gid * WGM, gsz = (nM - fm) < WGM ? (nM - fm) : WGM;
        u.pm = fm + ((wgid % nig) % gsz); u.pn = (wgid % nig) / gsz; u.ks = 0; return true;
    }
    __device__ __forceinline__ void a_ready(const Unit&) const {}
    __device__ __forceinline__ void done(const Unit&) const {}
};

template <class Epi, class Sched, bool ALIGN_EPI = false, bool SP2 = false>
__device__ __forceinline__ void gemm_phase(PG8_LAS unsigned char* lds, const Gemm g, const Sched& S, const Epi& E) {
    const int tid = threadIdx.x, wid = __builtin_amdgcn_readfirstlane(tid >> 6), lane = tid & 63, wr = wid >> 2, wc = wid & 3, fr = lane & 15, fq = lane >> 4;
    const int K = g.ld, nt = g.K / BK;
    unsigned voffA[2], voffB[2];
#pragma unroll
    for (int i = 0; i < 2; ++i) { int R, C; stage_rc(tid * 16 + i * 8192, R, C); const int Rb = Epi::PERM ? ((R & ~31) + perm32(R & 31)) : R;
        voffA[i] = (unsigned)(R * K + C) * 2u; voffB[i] = (unsigned)(Rb * K + C) * 2u; }
    const size_t kstep = (size_t)(BK * 2);
    const size_t hstep = (size_t)HALF * K * 2;
    const size_t tstep = 2 * hstep;
    const unsigned ldsw = (unsigned)wid * 1024u;
    const int aoff = lds_byte(wr * 64 + fr, fq * 8), boff = lds_byte(wc * 32 + fr, fq * 8);
#define PG8_SA(b, h) (((b) * 2 + (h)) * HTB)
#define PG8_SB(b, h) ((4 + (b) * 2 + (h)) * HTB)
#define PG8_STAGE(bufoff, gbase, voff) do { _Pragma("unroll") for (int _i = 0; _i < 2; ++_i) \
        __builtin_amdgcn_global_load_lds((const unsigned*)((const char*)(gbase) + (voff)[_i]), (PG8_LAS unsigned*)(lds + (bufoff) + ldsw + _i * 8192), 16, 0, 0); } while (0)
#define PG8_LDA(dst, b, h) do { _Pragma("unroll") for (int m = 0; m < 4; ++m) _Pragma("unroll") for (int k = 0; k < 2; ++k) dst[m][k] = *(const PG8_LAS bf16x8*)(lds + PG8_SA(b, h) + aoff + m * 2048 + k * 1024); } while (0)
#define PG8_LDB(dst, b, h) do { _Pragma("unroll") for (int n = 0; n < 2; ++n) _Pragma("unroll") for (int k = 0; k < 2; ++k) dst[n][k] = *(const PG8_LAS bf16x8*)(lds + PG8_SB(b, h) + boff + n * 2048 + k * 1024); } while (0)
#define PG8_MMA(ai, bj, At, Bt) do { __builtin_amdgcn_s_setprio(1); _Pragma("unroll") for (int m = 0; m < 4; ++m) _Pragma("unroll") for (int n = 0; n < 2; ++n) _Pragma("unroll") for (int k = 0; k < 2; ++k) \
        acc[ai][bj][m][n] = __builtin_amdgcn_mfma_f32_16x16x32_bf16(Bt[n][k], At[m][k], acc[ai][bj][m][n], 0, 0, 0); __builtin_amdgcn_s_setprio(0); } while (0)
#define PG8_WAIT_V(n) asm volatile("s_waitcnt vmcnt(" #n ")" ::: "memory")
#define PG8_WAIT_L(n) asm volatile("s_waitcnt lgkmcnt(" #n ")" ::: "memory")
#define PG8_BAR __builtin_amdgcn_s_barrier()
#define PG8_SCHED __builtin_amdgcn_sched_barrier(0)
    Unit cur, nxt; int ui = 0;
    if (!S.next(0, cur)) return;
    f32x4 acc[2][2][4][2];
#pragma unroll
    for (int a = 0; a < 2; ++a)
#pragma unroll
        for (int b = 0; b < 2; ++b)
#pragma unroll
            for (int m = 0; m < 4; ++m)
#pragma unroll
                for (int n = 0; n < 2; ++n) acc[a][b][m][n] = (f32x4){0.f, 0.f, 0.f, 0.f};
    bf16x8 At[4][2], B0[2][2], B1[2][2];
    const char* cA = (const char*)g.A + (size_t)cur.pm * tstep + (size_t)cur.ks * g.K * 2; const char* cB = (const char*)g.Bt + (size_t)cur.pn * tstep + (size_t)cur.ks * g.K * 2;
    S.a_ready(cur);
    if constexpr (SP2) {
        PG8_STAGE(PG8_SB(0, 0), cB, voffB); PG8_STAGE(PG8_SB(0, 1), cB + hstep, voffB); PG8_STAGE(PG8_SA(0, 0), cA, voffA); PG8_STAGE(PG8_SA(0, 1), cA + hstep, voffA);
        if (wr == 1) PG8_BAR;
        PG8_WAIT_V(2); PG8_BAR;
        PG8_STAGE(PG8_SB(1, 0), cB + kstep, voffB); PG8_STAGE(PG8_SA(1, 0), cA + kstep, voffA); PG8_STAGE(PG8_SB(1, 1), cB + hstep + kstep, voffB);
        PG8_WAIT_V(6); PG8_BAR;
    } else {
        PG8_STAGE(PG8_SB(0, 0), cB, voffB); PG8_STAGE(PG8_SA(0, 0), cA, voffA); PG8_STAGE(PG8_SB(0, 1), cB + hstep, voffB); PG8_STAGE(PG8_SA(0, 1), cA + hstep, voffA);
        if (wr == 1) PG8_BAR;
        PG8_WAIT_V(4); PG8_BAR;
        PG8_STAGE(PG8_SB(1, 0), cB + kstep, voffB); PG8_STAGE(PG8_SA(1, 0), cA + kstep, voffA); PG8_STAGE(PG8_SB(1, 1), cB + hstep + kstep, voffB);
        PG8_WAIT_V(6); PG8_BAR;
    }
    for (;;) {
        const bool has_next = S.next(ui + 1, nxt);
        const char* nA = has_next ? (const char*)g.A + (size_t)nxt.pm * tstep + (size_t)nxt.ks * g.K * 2 : cA; const char* nB = has_next ? (const char*)g.Bt + (size_t)nxt.pn * tstep + (size_t)nxt.ks * g.K * 2 : cB;
        for (int t = 0; t < nt; t += 2) {
            const bool last = (t == nt - 2);
            const char* a1 = cA + (size_t)(t + 1) * kstep;
            const char* a2 = last ? nA : cA + (size_t)(t + 2) * kstep; const char* b2 = last ? nB : cB + (size_t)(t + 2) * kstep;
            const char* a3 = a2 + kstep; const char* b3 = b2 + kstep;
            if (last && has_next) S.a_ready(nxt);
            if constexpr (SP2) {
            PG8_LDB(B0, 0, 0); PG8_LDB(B1, 0, 1); PG8_SCHED; PG8_LDA(At, 0, 0); PG8_STAGE(PG8_SA(1, 1), a1 + hstep, voffA);
            PG8_WAIT_V(8); PG8_WAIT_L(0); PG8_BAR; PG8_MMA(0, 0, At, B0); PG8_MMA(0, 1, At, B1); PG8_BAR; PG8_SCHED;
            PG8_LDA(At, 0, 1); PG8_STAGE(PG8_SB(0, 0), b2, voffB); PG8_STAGE(PG8_SB(0, 1), b2 + hstep, voffB); PG8_STAGE(PG8_SA(0, 0), a2, voffA);
            PG8_WAIT_V(8); PG8_WAIT_L(0); PG8_BAR; PG8_MMA(1, 0, At, B0); PG8_MMA(1, 1, At, B1); PG8_BAR; PG8_SCHED;
            PG8_LDB(B0, 1, 0); PG8_LDB(B1, 1, 1); PG8_SCHED; PG8_LDA(At, 1, 0); PG8_STAGE(PG8_SA(0, 1), a2 + hstep, voffA);
            PG8_WAIT_V(8); PG8_WAIT_L(0); PG8_BAR; PG8_MMA(0, 0, At, B0); PG8_MMA(0, 1, At, B1); PG8_BAR; PG8_SCHED;
            PG8_LDA(At, 1, 1); PG8_STAGE(PG8_SB(1, 0), b3, voffB); PG8_STAGE(PG8_SB(1, 1), b3 + hstep, voffB); PG8_STAGE(PG8_SA(1, 0), a3, voffA);
            PG8_WAIT_V(8); PG8_WAIT_L(0); PG8_BAR; PG8_MMA(1, 0, At, B0); PG8_MMA(1, 1, At, B1); PG8_BAR; PG8_SCHED;
            } else {
            PG8_LDB(B0, 0, 0); PG8_SCHED; PG8_LDA(At, 0, 0); PG8_STAGE(PG8_SA(1, 1), a1 + hstep, voffA);
            PG8_WAIT_L(8); PG8_BAR; PG8_WAIT_L(0); PG8_MMA(0, 0, At, B0); PG8_BAR; PG8_SCHED;
            PG8_LDB(B1, 0, 1); PG8_STAGE(PG8_SB(0, 0), b2, voffB);
            PG8_BAR; PG8_WAIT_L(0); PG8_MMA(0, 1, At, B1); PG8_BAR;
            PG8_LDA(At, 0, 1); PG8_STAGE(PG8_SA(0, 0), a2, voffA);
            PG8_BAR; PG8_WAIT_L(0); PG8_MMA(1, 0, At, B0); PG8_BAR; PG8_SCHED;
            PG8_STAGE(PG8_SB(0, 1), b2 + hstep, voffB);
            PG8_WAIT_V(6); PG8_BAR; PG8_MMA(1, 1, At, B1); PG8_BAR;
            PG8_LDB(B0, 1, 0); PG8_SCHED; PG8_LDA(At, 1, 0); PG8_STAGE(PG8_SA(0, 1), a2 + hstep, voffA);
            PG8_WAIT_L(8); PG8_BAR; PG8_WAIT_L(0); PG8_MMA(0, 0, At, B0); PG8_BAR; PG8_SCHED;
            PG8_LDB(B1, 1, 1); PG8_STAGE(PG8_SB(1, 0), b3, voffB);
            PG8_BAR; PG8_WAIT_L(0); PG8_MMA(0, 1, At, B1); PG8_BAR;
            PG8_LDA(At, 1, 1); PG8_STAGE(PG8_SA(1, 0), a3, voffA);
            PG8_BAR; PG8_WAIT_L(0); PG8_MMA(1, 0, At, B0); PG8_BAR; PG8_SCHED;
            PG8_STAGE(PG8_SB(1, 1), b3 + hstep, voffB);
            PG8_WAIT_V(6); PG8_BAR; PG8_MMA(1, 1, At, B1); PG8_BAR;
            }
        }
        if constexpr (ALIGN_EPI) { if (wr == 0) PG8_BAR; }
        if constexpr (!Epi::AFTER_DRAIN) { E(acc, cur, wr, wc, fr, fq); S.done(cur); }
        if (!has_next) break;
#pragma unroll
        for (int a = 0; a < 2; ++a)
#pragma unroll
            for (int b = 0; b < 2; ++b)
#pragma unroll
                for (int m = 0; m < 4; ++m)
#pragma unroll
                    for (int n = 0; n < 2; ++n) acc[a][b][m][n] = (f32x4){0.f, 0.f, 0.f, 0.f};
        cur = nxt; cA = nA; cB = nB; ++ui;
        if constexpr (ALIGN_EPI) { if (wr == 1) PG8_BAR; }
    }
    PG8_WAIT_V(0);
    if constexpr (!ALIGN_EPI) { if (wr == 0) PG8_BAR; }
    PG8_BAR;
    if constexpr (Epi::AFTER_DRAIN) { E.fused(acc, cur, wr, wc, fr, fq, lds, wid, lane); S.done(cur); }
#undef PG8_SA
#undef PG8_SB
#undef PG8_STAGE
#undef PG8_LDA
#undef PG8_LDB
#undef PG8_MMA
#undef PG8_WAIT_V
#undef PG8_WAIT_L
#undef PG8_BAR
#undef PG8_SCHED
}
}

#define LAS __attribute__((address_space(3)))
typedef unsigned short bf16_t;
typedef short bf16x8 __attribute__((ext_vector_type(8)));
typedef short bf16x4 __attribute__((ext_vector_type(4)));
typedef float f32x4 __attribute__((ext_vector_type(4)));
typedef float f32x2 __attribute__((ext_vector_type(2)));
typedef unsigned u32x4 __attribute__((ext_vector_type(4)));
typedef unsigned u32x2 __attribute__((ext_vector_type(2)));
typedef __bf16 hbf16x2 __attribute__((ext_vector_type(2)));

constexpr int DM = 2048, TP = 16384, TS = 512, TT = TP + TS, SEQ = 4096, DB = 128;
constexpr int NIN = 5376, FF = 5632, MEMW = 512;
constexpr int NCHP = TP / 16, NCH = NCHP + DB;
constexpr float RMS_EPS = 1e-6f;
constexpr float LOG2E = 1.4426950408889634f;
constexpr float SWA_QSCALE = 0.125f * LOG2E;
constexpr float MEM_QSCALE = 0.08838834764831845f * LOG2E;
constexpr int NWAVES = 8, NTHREADS = 512;
constexpr int LDS_BYTES = 147456;

constexpr size_t O_YP = 0, O_YS = 33554432, O_PST = 34603008, O_PSK = 35127296, O_PSV = 35192832, O_PMK = 35258368, O_PMV = 35782656,
                 O_SST = 36306944, O_SSK = 53084160, O_SSV = 55181312, O_END = 57278464;
constexpr size_t MiB = 1u << 20;
constexpr size_t WS_TAB = 1 * MiB;
constexpr size_t WS_WIN = 2 * MiB, WS_WOUT = 23 * MiB, WS_WMQ = 31 * MiB, WS_WMKV = 33 * MiB, WS_WMO = 37 * MiB, WS_WGU = 39 * MiB, WS_WDN = 83 * MiB;
constexpr size_t WS_SS = 105 * MiB;
constexpr size_t SS_STRIDE = 2359296;
constexpr size_t WS_MK = 112 * MiB, WS_MVT = 113 * MiB, WS_QM = 114 * MiB, WS_OM = 131 * MiB, WS_MN = 148 * MiB, WS_XB = 152 * MiB;
constexpr size_t WS_D = 218 * MiB;
constexpr size_t WS_GATE = WS_D, WS_SQ = WS_D + 33 * MiB, WS_SKV = WS_D + 66 * MiB, WS_QIN = WS_D + 75 * MiB, WS_KT = WS_D + 111 * MiB, WS_VT = WS_D + 147 * MiB,
                 WS_PSC = WS_D + 183 * MiB, WS_DEC = WS_D + 188 * MiB, WS_MIX = WS_D + 193 * MiB, WS_END = WS_D + 259 * MiB;
constexpr size_t WS_HID = WS_D;
static_assert((size_t)TT * FF * 2 <= 183 * MiB, "HID overlay");

struct Args {
    const float* in[26];
    float* out; unsigned char* ws;
    int ph_lo, ph_hi;
};

__device__ __forceinline__ unsigned cvtpk(float lo, float hi) { f32x2 v = {lo, hi}; hbf16x2 b = __builtin_convertvector(v, hbf16x2); return __builtin_bit_cast(unsigned, b); }
__device__ __forceinline__ float bf2f(unsigned short b) { return __uint_as_float((unsigned)b << 16); }
__device__ __forceinline__ unsigned short f2bf(float f) { return (unsigned short)(cvtpk(f, 0.f) & 0xffffu); }
__device__ __forceinline__ u32x4 pack8(f32x4 a, f32x4 b) { u32x4 w; w.x = cvtpk(a[0], a[1]); w.y = cvtpk(a[2], a[3]); w.z = cvtpk(b[0], b[1]); w.w = cvtpk(b[2], b[3]); return w; }
__device__ __forceinline__ u32x2 pack4(f32x4 a) { u32x2 w; w.x = cvtpk(a[0], a[1]); w.y = cvtpk(a[2], a[3]); return w; }
__device__ __forceinline__ float fexp(float x) { return __builtin_amdgcn_exp2f(x * LOG2E); }
__device__ __forceinline__ float fsigmoid(float x) { return __builtin_amdgcn_rcpf(1.0f + fexp(-x)); }
__device__ __forceinline__ float wave_sum(float v) {
#pragma unroll
    for (int o = 1; o < 64; o <<= 1) v += __shfl_xor(v, o);
    return v;
}
#define LDS_WAIT() asm volatile("s_waitcnt lgkmcnt(0)" ::: "memory")

__device__ __forceinline__ float row_rs(const float* SS, int row) {
    const f32x4* p = (const f32x4*)(SS + (size_t)row * 32);
    f32x4 s = p[0];
#pragma unroll
    for (int i = 1; i < 8; ++i) s += p[i];
    return __builtin_amdgcn_rsqf(((s[0] + s[1]) + (s[2] + s[3])) * (1.0f / DM) + RMS_EPS);
}

using pg8::Unit;
struct EpiIn {
    static constexpr bool PERM = true, AFTER_DRAIN = false;
    float* QF; float* GF; bf16_t* VB; bf16_t* GATE; bf16_t* SQ; bf16_t* SKV; const float* LB; float* out;
    __device__ __forceinline__ void operator()(const f32x4 (&acc)[2][2][4][2], const Unit& u, int wr, int wc, int fr, int fq) const {
        const int pn = u.pn;
#pragma unroll
        for (int ai = 0; ai < 2; ++ai)
#pragma unroll
            for (int m = 0; m < 4; ++m) {
                const int row = u.pm * 256 + ai * 128 + wr * 64 + m * 16 + fr;
#pragma unroll
                for (int bj = 0; bj < 2; ++bj) {
                    const int c = pn * 256 + bj * 128 + wc * 32 + 8 * fq;
                    f32x4 v0 = acc[ai][bj][m][0], v1 = acc[ai][bj][m][1];
                    if (pn < 4) {
                        float* d = QF + (size_t)row * 1024 + c; *(f32x4*)d = v0; *(f32x4*)(d + 4) = v1;
                    } else if (pn < 8) {
                        const int cc = c - 1024;
                        const f32x4 l0 = *(const f32x4*)(LB + cc), l1 = *(const f32x4*)(LB + cc + 4);
#pragma unroll
                        for (int j = 0; j < 4; ++j) { v0[j] = __logf(l0[j] + (1.0f - l0[j]) * fsigmoid(v0[j])); v1[j] = __logf(l1[j] + (1.0f - l1[j]) * fsigmoid(v1[j])); }
                        float* d = GF + (size_t)row * 1024 + cc; *(f32x4*)d = v0; *(f32x4*)(d + 4) = v1;
                    } else if (pn < 12) {
                        *(u32x4*)(VB + (size_t)row * 1024 + (c - 2048)) = pack8(v0, v1);
                    } else if (pn < 16) {
#pragma unroll
                        for (int j = 0; j < 4; ++j) { v0[j] = v0[j] * fsigmoid(v0[j]); v1[j] = v1[j] * fsigmoid(v1[j]); }
                        *(u32x4*)(GATE + (size_t)row * 1024 + (c - 3072)) = pack8(v0, v1);
                    } else if (pn < 20) {
                        *(u32x4*)(SQ + (size_t)row * 1024 + (c - 4096)) = pack8(v0 * SWA_QSCALE, v1 * SWA_QSCALE);
                    } else {
                        const int cc = c - 5120;
                        *(u32x4*)(SKV + (size_t)row * 256 + cc) = pack8(v0, v1);
                        float* d = nullptr;
                        if (row < TP) { const int b = row >> 12, t = row & 4095; if (t >= SEQ - 128) d = out + (bj == 0 ? O_PSK : O_PSV) + (size_t)(b * 128 + (t - (SEQ - 128))) * 128 + (cc & 127); }
                        else { const int rs = row - TP, b = rs >> 2, t = rs & 3; d = out + (bj == 0 ? O_SSK : O_SSV) + (size_t)(b * 128 + 124 + t) * 128 + (cc & 127); }
                        if (d) { *(f32x4*)d = v0; *(f32x4*)(d + 4) = v1; }
                    }
                }
            }
    }
};
struct EpiMemKV {
    static constexpr bool PERM = true, AFTER_DRAIN = false;
    bf16_t* MK; bf16_t* MVT; float* out;
    __device__ __forceinline__ void operator()(const f32x4 (&acc)[2][2][4][2], const Unit& u, int wr, int wc, int fr, int fq) const {
#pragma unroll
        for (int ai = 0; ai < 2; ++ai)
#pragma unroll
            for (int m = 0; m < 4; ++m) {
                const int row = u.pm * 256 + ai * 128 + wr * 64 + m * 16 + fr;
#pragma unroll
                for (int bj = 0; bj < 2; ++bj) {
                    const int c = u.pn * 256 + bj * 128 + wc * 32 + 8 * fq;
                    const f32x4 v0 = acc[ai][bj][m][0], v1 = acc[ai][bj][m][1];
                    if (u.pn < 2) {
                        float* d = out + O_PMK + (size_t)row * 512 + c; *(f32x4*)d = v0; *(f32x4*)(d + 4) = v1;
                        *(u32x4*)(MK + (size_t)row * 512 + c) = pack8(v0, v1);
                    } else {
                        const int cv = c - 512, h = cv >> 7, dd = cv & 127, b = row >> 8, mm = row & 255;
                        float* d = out + O_PMV + (size_t)row * 512 + cv; *(f32x4*)d = v0; *(f32x4*)(d + 4) = v1;
                        bf16_t* t = MVT + ((size_t)((b * 4 + h) * 128 + dd)) * 256 + mm;
#pragma unroll
                        for (int j = 0; j < 4; ++j) { t[(size_t)j * 256] = f2bf(v0[j]); t[(size_t)(j + 4) * 256] = f2bf(v1[j]); }
                    }
                }
            }
    }
};
struct EpiResid {
    static constexpr bool PERM = true, AFTER_DRAIN = false;
    const float* resP; const float* resS; float* X; bf16_t* XB; float* SS;
    __device__ __forceinline__ void operator()(const f32x4 (&acc)[2][2][4][2], const Unit& u, int wr, int wc, int fr, int fq) const {
#pragma unroll
        for (int ai = 0; ai < 2; ++ai)
#pragma unroll
            for (int m = 0; m < 4; ++m) {
                const int row = u.pm * 256 + ai * 128 + wr * 64 + m * 16 + fr;
                const float* rrow = (row < TP) ? resP + (size_t)row * DM : resS + (size_t)(row - TP) * DM;
                float ss = 0.f;
#pragma unroll
                for (int bj = 0; bj < 2; ++bj) {
                    const int c = u.pn * 256 + bj * 128 + wc * 32 + 8 * fq;
                    const f32x4 v0 = acc[ai][bj][m][0] + *(const f32x4*)(rrow + c), v1 = acc[ai][bj][m][1] + *(const f32x4*)(rrow + c + 4);
                    float* d = X + (size_t)row * DM + c; *(f32x4*)d = v0; *(f32x4*)(d + 4) = v1;
                    ss += (v0[0] * v0[0] + v0[1] * v0[1]) + (v0[2] * v0[2] + v0[3] * v0[3]) + (v1[0] * v1[0] + v1[1] * v1[1]) + (v1[2] * v1[2] + v1[3] * v1[3]);
                    if (XB) *(u32x4*)(XB + (size_t)row * DM + c) = pack8(v0, v1);
                }
                ss += __shfl_xor(ss, 16); ss += __shfl_xor(ss, 32);
                if (fq == 0) SS[(size_t)row * 32 + u.pn * 4 + wc] = ss;
            }
    }
};
struct EpiSlab {
    static constexpr bool PERM = true, AFTER_DRAIN = false;
    float* SLAB; int row0; size_t slab_stride;
    __device__ __forceinline__ void operator()(const f32x4 (&acc)[2][2][4][2], const Unit& u, int wr, int wc, int fr, int fq) const {
        float* base = SLAB + (size_t)u.ks * slab_stride;
#pragma unroll
        for (int ai = 0; ai < 2; ++ai)
#pragma unroll
            for (int m = 0; m < 4; ++m) {
                const int row = u.pm * 256 + ai * 128 + wr * 64 + m * 16 + fr - row0;
#pragma unroll
                for (int bj = 0; bj < 2; ++bj) {
                    float* d = base + (size_t)row * DM + u.pn * 256 + bj * 128 + wc * 32 + 8 * fq;
                    *(f32x4*)d = acc[ai][bj][m][0]; *(f32x4*)(d + 4) = acc[ai][bj][m][1];
                }
            }
    }
};
struct SplitOrder {
    int c, ns;
    __device__ bool next(int i, Unit& u) const { if (i > 0 || c >= 16 * ns) return false; const int tile = c / ns; u.pm = TP / 256 + (tile >> 3); u.pn = tile & 7; u.ks = c % ns; return true; }
    __device__ __forceinline__ void a_ready(const Unit&) const {}
    __device__ __forceinline__ void done(const Unit&) const {}
};
struct EpiScaleBf16 {
    static constexpr bool PERM = true, AFTER_DRAIN = false;
    bf16_t* O; int ldc; const float* SS; float scale;
    __device__ __forceinline__ void operator()(const f32x4 (&acc)[2][2][4][2], const Unit& u, int wr, int wc, int fr, int fq) const {
#pragma unroll
        for (int ai = 0; ai < 2; ++ai)
#pragma unroll
            for (int m = 0; m < 4; ++m) {
                const int row = u.pm * 256 + ai * 128 + wr * 64 + m * 16 + fr;
                const float s = row_rs(SS, row) * scale;
#pragma unroll
                for (int bj = 0; bj < 2; ++bj) {
                    const int c = u.pn * 256 + bj * 128 + wc * 32 + 8 * fq;
                    *(u32x4*)(O + (size_t)row * ldc + c) = pack8(acc[ai][bj][m][0] * s, acc[ai][bj][m][1] * s);
                }
            }
    }
};
struct EpiSwiGLU {
    static constexpr bool PERM = true, AFTER_DRAIN = false;
    bf16_t* HID; const float* SS;
    __device__ __forceinline__ void operator()(const f32x4 (&acc)[2][2][4][2], const Unit& u, int wr, int wc, int fr, int fq) const {
#pragma unroll
        for (int ai = 0; ai < 2; ++ai)
#pragma unroll
            for (int m = 0; m < 4; ++m) {
                const int row = u.pm * 256 + ai * 128 + wr * 64 + m * 16 + fr;
                const float s = row_rs(SS, row);
                f32x4 h0, h1;
#pragma unroll
                for (int j = 0; j < 4; ++j) {
                    const float g0 = acc[ai][0][m][0][j] * s, u0 = acc[ai][1][m][0][j] * s, g1 = acc[ai][0][m][1][j] * s, u1 = acc[ai][1][m][1][j] * s;
                    h0[j] = g0 * fsigmoid(g0) * u0; h1[j] = g1 * fsigmoid(g1) * u1;
                }
                *(u32x4*)(HID + (size_t)row * FF + u.pn * 128 + wc * 32 + 8 * fq) = pack8(h0, h1);
            }
    }
};

struct Frame {
    LAS unsigned char* lds;
    int tid, lane, wave, G, bid;
    const float* const* in;
    float* out; unsigned char* ws;
};
enum { I_XP = 0, I_XS, I_STATE, I_CSK, I_CSV, I_CMK, I_CMV, I_MEMP, I_NMIX, I_WIN, I_LB, I_ONORM, I_SINKS, I_RELB, I_WOUT, I_NXATT, I_NMEM,
       I_WMQ, I_WMK, I_WMV, I_WMO, I_NFFN, I_WGATE, I_WUP, I_WDOWN, I_NFINAL };

__device__ __forceinline__ void p0_tr_item(const float* __restrict__ W, int K, int N, bf16_t* WT, int k0, int n0, int drow0, const float* __restrict__ scale, LAS float* scr, int lane) {
#pragma unroll 8
    for (int i = 0; i < 32; ++i) { const int kk = 2 * i + (lane >> 5); float v = W[(size_t)(k0 + kk) * N + n0 + (lane & 31)]; if (scale) v *= scale[k0 + kk]; scr[kk * 33 + (lane & 31)] = v; }
    LDS_WAIT(); asm volatile("" ::: "memory");
    const int c = lane & 7;
#pragma unroll
    for (int j = 0; j < 4; ++j) { const int n = (lane >> 3) + 8 * j; const LAS float* s = scr + (8 * c) * 33 + n;
        u32x4 o; o.x = cvtpk(s[0 * 33], s[1 * 33]); o.y = cvtpk(s[2 * 33], s[3 * 33]); o.z = cvtpk(s[4 * 33], s[5 * 33]); o.w = cvtpk(s[6 * 33], s[7 * 33]);
        *(u32x4*)(WT + (size_t)(drow0 + n) * K + k0 + 8 * c) = o; }
    LDS_WAIT(); asm volatile("" ::: "memory");
}
__device__ __forceinline__ void p0_rms_row(const float* xrow, const float* w, bf16_t* orow, int lane) {
    const f32x4* xr = (const f32x4*)xrow + lane; const f32x4* wr = (const f32x4*)w + lane;
    f32x4 v[8]; float s = 0.f;
#pragma unroll
    for (int j = 0; j < 8; ++j) { v[j] = xr[64 * j]; s += (v[j][0] * v[j][0] + v[j][1] * v[j][1]) + (v[j][2] * v[j][2] + v[j][3] * v[j][3]); }
    const float rs = __builtin_amdgcn_rsqf(wave_sum(s) * (1.0f / DM) + RMS_EPS);
    u32x2* o8 = (u32x2*)orow + lane;
#pragma unroll
    for (int j = 0; j < 8; ++j) { const f32x4 ww = wr[64 * j]; f32x4 y; y[0] = v[j][0] * rs * ww[0]; y[1] = v[j][1] * rs * ww[1]; y[2] = v[j][2] * rs * ww[2]; y[3] = v[j][3] * rs * ww[3]; o8[64 * j] = pack4(y); }
}
__device__ __forceinline__ int rel_bucket(int n) {
    if (n < 16) return n;
    int b = 16 + (int)(__logf((float)n * (1.0f / 16.0f)) / 2.0794415416798357f * 16.0f);
    return b < 31 ? b : 31;
}
__device__ __forceinline__ void p0_prologue(Frame& F) {
    LAS float* scr = (LAS float*)(F.lds + F.wave * 16384);
    const int gw = F.bid * NWAVES + F.wave, NGW = F.G * NWAVES;
    unsigned char* ws = F.ws;
    constexpr int I_IN = 32 * (NIN / 32), I_OUT = 32 * 64, I_MQ = 32 * 16, I_MO = 8 * 64, I_G = 32 * (FF / 32), I_DN = (FF / 64) * 64;
    constexpr int NITEMS = I_IN + I_OUT + 3 * I_MQ + I_MO + 2 * I_G + I_DN;
    for (int it = gw; it < NITEMS; it += NGW) {
        int r = it;
        if (r < I_IN) { const int nb = NIN / 32, kb = r / nb, n0 = (r % nb) * 32; p0_tr_item(F.in[I_WIN], DM, NIN, (bf16_t*)(ws + WS_WIN), kb * 64, n0, n0, nullptr, scr, F.lane); continue; } r -= I_IN;
        if (r < I_OUT) { const int kb = r / 64, n0 = (r % 64) * 32; p0_tr_item(F.in[I_WOUT], DM, DM, (bf16_t*)(ws + WS_WOUT), kb * 64, n0, n0, nullptr, scr, F.lane); continue; } r -= I_OUT;
        if (r < I_MQ) { const int kb = r / 16, n0 = (r % 16) * 32; p0_tr_item(F.in[I_WMQ], DM, MEMW, (bf16_t*)(ws + WS_WMQ), kb * 64, n0, n0, F.in[I_NXATT], scr, F.lane); continue; } r -= I_MQ;
        if (r < I_MQ) { const int kb = r / 16, n0 = (r % 16) * 32; p0_tr_item(F.in[I_WMK], DM, MEMW, (bf16_t*)(ws + WS_WMKV), kb * 64, n0, n0, nullptr, scr, F.lane); continue; } r -= I_MQ;
        if (r < I_MQ) { const int kb = r / 16, n0 = (r % 16) * 32; p0_tr_item(F.in[I_WMV], DM, MEMW, (bf16_t*)(ws + WS_WMKV), kb * 64, n0, 512 + n0, nullptr, scr, F.lane); continue; } r -= I_MQ;
        if (r < I_MO) { const int kb = r / 64, n0 = (r % 64) * 32; p0_tr_item(F.in[I_WMO], MEMW, DM, (bf16_t*)(ws + WS_WMO), kb * 64, n0, n0, nullptr, scr, F.lane); continue; } r -= I_MO;
        if (r < 2 * I_G) { const int up = r >= I_G; if (up) r -= I_G; const int nb = FF / 32, kb = r / nb, n0 = (r % nb) * 32;
            p0_tr_item(F.in[up ? I_WUP : I_WGATE], DM, FF, (bf16_t*)(ws + WS_WGU), kb * 64, n0, (n0 >> 7) * 256 + (n0 & 127) + (up ? 128 : 0), F.in[I_NFFN], scr, F.lane); continue; } r -= 2 * I_G;
        { const int kb = r / 64, n0 = (r % 64) * 32; p0_tr_item(F.in[I_WDOWN], FF, DM, (bf16_t*)(ws + WS_WDN), kb * 64, n0, n0, nullptr, scr, F.lane); }
    }
    for (int m = gw; m < TT + 1024; m += NGW) {
        if (m < TP) p0_rms_row(F.in[I_XP] + (size_t)m * DM, F.in[I_NMIX], (bf16_t*)(ws + WS_XB) + (size_t)m * DM, F.lane);
        else if (m < TT) p0_rms_row(F.in[I_XS] + (size_t)(m - TP) * DM, F.in[I_NMIX], (bf16_t*)(ws + WS_XB) + (size_t)m * DM, F.lane);
        else p0_rms_row(F.in[I_MEMP] + (size_t)(m - TT) * DM, F.in[I_NMEM], (bf16_t*)(ws + WS_MN) + (size_t)(m - TT) * DM, F.lane);
    }
    float* LBt = (float*)(ws + WS_TAB); float* BT = (float*)(ws + WS_TAB + 8192);
    const int gt = F.bid * NTHREADS + F.tid, NGT = F.G * NTHREADS;
    for (int i = gt; i < 1024 + 16 * 160; i += NGT) {
        if (i < 1024) { const float l0 = F.in[I_LB][i], l1 = F.in[I_LB][1024 + i]; LBt[i] = 1.0f / (1.0f + __expf(l1 - l0)); }
        else { const int j = i - 1024, h = j / 160, ix = j % 160, dist = 143 - ix;
            BT[j] = (dist >= 0 && dist < 128) ? F.in[I_RELB][rel_bucket(dist) * 16 + h] * LOG2E : -INFINITY; }
    }
}

constexpr int PREP_RS = 1032;
__device__ __forceinline__ void hgrn_prep(Frame& F) {
    unsigned char* ws = F.ws;
    const float* QF = F.out; const float* GF = F.out + (size_t)TT * 1024; const bf16_t* VB = (const bf16_t*)(F.out + O_SST);
    bf16_t* QIN = (bf16_t*)(ws + WS_QIN); bf16_t* KT = (bf16_t*)(ws + WS_KT); bf16_t* VT = (bf16_t*)(ws + WS_VT); bf16_t* PSC = (bf16_t*)(ws + WS_PSC); float* DEC = (float*)(ws + WS_DEC);
    LAS bf16_t* lq = (LAS bf16_t*)F.lds; LAS bf16_t* lk = lq + 16 * PREP_RS;
    const int l15 = F.lane & 15, g4 = F.lane >> 4;
    for (int ch = F.bid; ch < NCH; ch += F.G) {
        const int nv = ch < NCHP ? 16 : 4; const int row0 = ch < NCHP ? ch * 16 : TP + (ch - NCHP) * 4;
#pragma unroll 1
        for (int pass = 0; pass < 2; ++pass) {
            const int cidx = F.tid + 512 * pass;
            float g[16], q[16]; unsigned short vv[16];
#pragma unroll
            for (int t = 0; t < 16; ++t) {
                if (t < nv) { g[t] = GF[(size_t)(row0 + t) * 1024 + cidx]; q[t] = QF[(size_t)(row0 + t) * 1024 + cidx]; vv[t] = VB[(size_t)(row0 + t) * 1024 + cidx]; }
                else { g[t] = 0.f; q[t] = 0.f; vv[t] = 0; }
            }
            float G = 0.f; unsigned kd[8], vt[8];
#pragma unroll
            for (int t = 0; t < 16; t += 2) {
                float qi[2], kk[2];
#pragma unroll
                for (int z = 0; z < 2; ++z) {
                    const float gt = g[t + z]; G += gt;
                    qi[z] = q[t + z] * fexp(G);
                    kk[z] = (1.0f - fexp(gt)) * fexp(fminf(-G, 80.0f));
                    lq[(t + z) * PREP_RS + cidx] = f2bf(qi[z]); lk[(t + z) * PREP_RS + cidx] = f2bf(kk[z]);
                }
                kd[t >> 1] = cvtpk(kk[0], kk[1]); vt[t >> 1] = (unsigned)vv[t] | ((unsigned)vv[t + 1] << 16);
            }
            DEC[(size_t)ch * 1024 + cidx] = fexp(G);
            u32x4* kp = (u32x4*)(KT + ((size_t)ch * 1024 + cidx) * 16); kp[0] = (u32x4){kd[0], kd[1], kd[2], kd[3]}; kp[1] = (u32x4){kd[4], kd[5], kd[6], kd[7]};
            u32x4* vp = (u32x4*)(VT + ((size_t)ch * 1024 + cidx) * 16); vp[0] = (u32x4){vt[0], vt[1], vt[2], vt[3]}; vp[1] = (u32x4){vt[4], vt[5], vt[6], vt[7]};
        }
        __syncthreads();
#pragma unroll
        for (int i = 0; i < 4; ++i) { const int idx = F.tid + 512 * i, t = idx >> 7, c8 = idx & 127;
            *(u32x4*)(QIN + ((size_t)ch * 16 + t) * 1024 + c8 * 8) = *(const LAS u32x4*)(lq + t * PREP_RS + c8 * 8); }
        {
            const int h = F.wave; f32x4 acc = {0.f, 0.f, 0.f, 0.f};
#pragma unroll
            for (int kk = 0; kk < 4; ++kk) {
                const bf16x8 a = *(const LAS bf16x8*)(lq + l15 * PREP_RS + h * 128 + 32 * kk + 8 * g4);
                const bf16x8 b = *(const LAS bf16x8*)(lk + l15 * PREP_RS + h * 128 + 32 * kk + 8 * g4);
                acc = __builtin_amdgcn_mfma_f32_16x16x32_bf16(a, b, acc, 0, 0, 0);
            }
            bf16_t* pd = PSC + ((size_t)ch * 8 + h) * 256;
#pragma unroll
            for (int r = 0; r < 4; ++r) { const int t = 4 * g4 + r, s = l15; pd[t * 16 + s] = (s <= t) ? f2bf(acc[r]) : (bf16_t)0; }
        }
        __syncthreads();
    }
}

constexpr int SC_QS = 136;
constexpr int SC_QI = 0, SC_KT = 16 * SC_QS * 2, SC_VT = SC_KT + 4096, SC_P = SC_VT + 4096, SC_DEC = SC_P + 512, SC_GATE = SC_DEC + 512, SC_BUF = SC_GATE + 16 * SC_QS * 2;
constexpr int SC_RED = 2 * SC_BUF;
static_assert(SC_RED + 1024 <= LDS_BYTES && SC_BUF % 16 == 0, "scan LDS");
struct ScanPf { u32x4 a, b, c; };
struct ScanSrc { const unsigned char* a; const unsigned char* b; const unsigned char* c; unsigned oa, ob, oc; };
__device__ __forceinline__ ScanSrc scan_src(const Frame& F, int ch0, int h, int grow0, int ngr) {
    const unsigned char* ws = F.ws; const int tid = F.tid; ScanSrc s;
    const bf16_t* QIN = (const bf16_t*)(ws + WS_QIN); const bf16_t* KT = (const bf16_t*)(ws + WS_KT); const bf16_t* VT = (const bf16_t*)(ws + WS_VT);
    const bf16_t* PSC = (const bf16_t*)(ws + WS_PSC); const float* DEC = (const float*)(ws + WS_DEC); const bf16_t* GATE = (const bf16_t*)(ws + WS_GATE);
    if (tid < 256) { const int t = tid >> 4, p = tid & 15;
        s.a = (const unsigned char*)(QIN + ((size_t)ch0 * 16 + t) * 1024 + h * 128 + p * 8); s.oa = SC_QI + (t * SC_QS + p * 8) * 2;
        s.b = (const unsigned char*)(VT + ((size_t)ch0 * 1024 + h * 128) * 16 + tid * 8); s.ob = SC_VT + tid * 16;
    } else { const int i = tid - 256, t = i >> 4, p = i & 15; const int tr = t < ngr ? t : ngr - 1;
        s.a = (const unsigned char*)(KT + ((size_t)ch0 * 1024 + h * 128) * 16 + i * 8); s.oa = SC_KT + i * 16;
        s.b = (const unsigned char*)(GATE + (size_t)(grow0 + tr) * 1024 + h * 128 + p * 8); s.ob = SC_GATE + (t * SC_QS + p * 8) * 2;
    }
    if (tid < 32) { s.c = (const unsigned char*)(PSC + ((size_t)ch0 * 8 + h) * 256 + tid * 8); s.oc = SC_P + tid * 16; }
    else { const int i = (tid - 32) & 31; s.c = (const unsigned char*)(DEC + (size_t)ch0 * 1024 + h * 128 + i * 4); s.oc = SC_DEC + i * 16; }
    return s;
}
__device__ __forceinline__ void scan_fetch(ScanPf& pf, const ScanSrc& s, const Frame& F, int step) {
    pf.a = *(const u32x4*)(s.a + (size_t)step * 32768); pf.b = *(const u32x4*)(s.b + (size_t)step * 32768);
    if (F.tid < 64) pf.c = *(const u32x4*)(s.c + (size_t)step * 4096);
}
__device__ __forceinline__ void scan_stash(const ScanPf& pf, const ScanSrc& s, const Frame& F, int buf) {
    LAS unsigned char* B = F.lds + buf * SC_BUF;
    *(LAS u32x4*)(B + s.oa) = pf.a; *(LAS u32x4*)(B + s.ob) = pf.b;
    if (F.tid < 64) *(LAS u32x4*)(B + s.oc) = pf.c;
}
template <int CTRL> __device__ __forceinline__ float dpp_mov(float v) { return __int_as_float(__builtin_amdgcn_update_dpp(0, __float_as_int(v), CTRL, 0xF, 0xF, true)); }
__device__ __forceinline__ float row16_sum(float v) { v += dpp_mov<0xB1>(v); v += dpp_mov<0x4E>(v); v += dpp_mov<0x141>(v); v += dpp_mov<0x140>(v); return v; }
constexpr int SC_ST = SC_RED + 1024, SC_STS = 132;
static_assert(SC_ST + 128 * SC_STS * 4 <= LDS_BYTES, "scan LDS (state image)");
__device__ __forceinline__ void hgrn_scan(Frame& F, int ch0, int nsteps, int h, int mrow0, int nvalid, const float* S0, float* Sout) {
    const int lane = F.lane, l15 = lane & 15, g4 = lane >> 4, e0 = 16 * F.wave;
    bf16_t* MIX = (bf16_t*)(F.ws + WS_MIX);
    const float onw = F.in[I_ONORM][e0 + l15];
    LAS float* RED = (LAS float*)(F.lds + SC_RED);
    LAS float* ST = (LAS float*)(F.lds + SC_ST);
    ScanPf pf;
    __syncthreads();
    const ScanSrc src = scan_src(F, ch0, h, mrow0, nvalid);
    scan_fetch(pf, src, F, 0); scan_stash(pf, src, F, 0);
    if (nsteps > 1) scan_fetch(pf, src, F, 1);
    f32x4 S[8];
    if (S0) {
#pragma unroll
        for (int i = 0; i < 8; ++i) { const int idx = F.tid + 512 * i, c = idx >> 5, e4 = idx & 31; *(LAS f32x4*)(ST + c * SC_STS + e4 * 4) = *(const f32x4*)(S0 + (size_t)c * 128 + e4 * 4); }
    }
    __syncthreads();
#pragma unroll
    for (int mt = 0; mt < 8; ++mt)
#pragma unroll
        for (int r = 0; r < 4; ++r) S[mt][r] = S0 ? ST[(16 * mt + 4 * g4 + r) * SC_STS + e0 + l15] : 0.f;
    f32x4 o_prev = {0.f, 0.f, 0.f, 0.f}, gate_prev = {0.f, 0.f, 0.f, 0.f};
#pragma unroll 1
    for (int n = 0; n <= nsteps; ++n) {
        const int buf = n & 1;
        f32x4 o = {0.f, 0.f, 0.f, 0.f}, gate = {0.f, 0.f, 0.f, 0.f};
        if (n + 1 < nsteps) {
            scan_stash(pf, src, F, buf ^ 1);
            if (n + 2 < nsteps) scan_fetch(pf, src, F, n + 2);
        }
        if (n < nsteps) {
            const LAS unsigned char* B = F.lds + buf * SC_BUF;
            const bf16x4 vt = *(const LAS bf16x4*)(B + SC_VT + ((e0 + l15) * 16 + 4 * g4) * 2);
            const bf16x4 pa = *(const LAS bf16x4*)(B + SC_P + (l15 * 16 + 4 * g4) * 2);
            f32x4 ob = {0.f, 0.f, 0.f, 0.f};
            o = __builtin_amdgcn_mfma_f32_16x16x16bf16_1k(pa, vt, o, 0, 0, 0);
#pragma unroll
            for (int kk = 0; kk < 4; ++kk) {
                const bf16x4 q0 = *(const LAS bf16x4*)(B + SC_QI + (l15 * SC_QS + 32 * kk + 4 * g4) * 2);
                const bf16x4 q1 = *(const LAS bf16x4*)(B + SC_QI + (l15 * SC_QS + 32 * kk + 16 + 4 * g4) * 2);
                const bf16x8 qa = {q0[0], q0[1], q0[2], q0[3], q1[0], q1[1], q1[2], q1[3]};
                const u32x4 sb = pack8(S[2 * kk], S[2 * kk + 1]);
                if (kk & 1) ob = __builtin_amdgcn_mfma_f32_16x16x32_bf16(qa, __builtin_bit_cast(bf16x8, sb), ob, 0, 0, 0);
                else o = __builtin_amdgcn_mfma_f32_16x16x32_bf16(qa, __builtin_bit_cast(bf16x8, sb), o, 0, 0, 0);
            }
#pragma unroll
            for (int mt = 0; mt < 8; ++mt) {
                const bf16x4 kt = *(const LAS bf16x4*)(B + SC_KT + ((16 * mt + l15) * 16 + 4 * g4) * 2);
                const f32x4 dc = *(const LAS f32x4*)(B + SC_DEC + (16 * mt + 4 * g4) * 4);
                S[mt] = __builtin_amdgcn_mfma_f32_16x16x16bf16_1k(kt, vt, S[mt], 0, 0, 0);
                S[mt] = S[mt] * dc;
            }
            o = o + ob;
#pragma unroll
            for (int r = 0; r < 4; ++r) {
                gate[r] = bf2f(*(const LAS unsigned short*)(B + SC_GATE + ((4 * g4 + r) * SC_QS + e0 + l15) * 2));
                const float ss = row16_sum(o[r] * o[r]);
                if (l15 == 0) RED[(buf * 8 + F.wave) * 16 + 4 * g4 + r] = ss;
            }
        }
        if (n > 0) {
            const int pb = (n - 1) & 1;
#pragma unroll
            for (int r = 0; r < 4; ++r) {
                const int t = 4 * g4 + r; float tot = 0.f;
#pragma unroll
                for (int w = 0; w < 8; ++w) tot += RED[(pb * 8 + w) * 16 + t];
                const float rs = __builtin_amdgcn_rsqf(tot * (1.0f / 128.0f) + RMS_EPS);
                if (t < nvalid) MIX[(size_t)(mrow0 + 16 * (n - 1) + t) * DM + h * 128 + e0 + l15] = f2bf(o_prev[r] * rs * onw * gate_prev[r]);
            }
        }
        o_prev = o; gate_prev = gate;
        __syncthreads();
    }
#pragma unroll
    for (int mt = 0; mt < 8; ++mt)
#pragma unroll
        for (int r = 0; r < 4; ++r) ST[(16 * mt + 4 * g4 + r) * SC_STS + e0 + l15] = S[mt][r];
    __syncthreads();
#pragma unroll
    for (int i = 0; i < 8; ++i) { const int idx = F.tid + 512 * i, c = idx >> 5, e4 = idx & 31; *(f32x4*)(Sout + (size_t)c * 128 + e4 * 4) = *(const LAS f32x4*)(ST + c * SC_STS + e4 * 4); }
}


constexpr int SW_KS = 72, SW_VS = 264;
constexpr int SW_K = 0, SW_V = 256 * SW_KS * 2, SW_BT = SW_V + 64 * SW_VS * 2, SW_END = SW_BT + 8 * 160 * 4;
static_assert(SW_END <= LDS_BYTES, "swa LDS");
__device__ __forceinline__ void swa_qtile(Frame& F, int j, int h, size_t qrow, bool qvalid, bool first_block, float sink2) {
    const int lane = F.lane, l15 = lane & 15, g4 = lane >> 4;
    const bf16_t* SQ = (const bf16_t*)(F.ws + WS_SQ); bf16_t* MIX = (bf16_t*)(F.ws + WS_MIX);
    const LAS bf16_t* Kb = (const LAS bf16_t*)(F.lds + SW_K); const LAS bf16_t* Vt = (const LAS bf16_t*)(F.lds + SW_V);
    const LAS float* BT = (const LAS float*)(F.lds + SW_BT) + F.wave * 160;
    bf16x8 qf[2];
#pragma unroll
    for (int kk = 0; kk < 2; ++kk) qf[kk] = *(const bf16x8*)(SQ + qrow * 1024 + h * 64 + 32 * kk + 8 * g4);
    f32x4 s[9]; float mx = sink2;
    const int bidx = 15 + 4 * g4 - l15;
#pragma unroll
    for (int u = 0; u < 9; ++u) {
        const int mt = j + u; f32x4 acc = {0.f, 0.f, 0.f, 0.f};
#pragma unroll
        for (int kk = 0; kk < 2; ++kk) {
            const bf16x8 a = *(const LAS bf16x8*)(Kb + (16 * mt + l15) * SW_KS + 32 * kk + 8 * g4);
            acc = __builtin_amdgcn_mfma_f32_16x16x32_bf16(a, qf[kk], acc, 0, 0, 0);
        }
        const bool dead = first_block && (mt < 8);
#pragma unroll
        for (int r = 0; r < 4; ++r) { float v = acc[r] + BT[bidx + 16 * u + r]; v = dead ? -INFINITY : v; s[u][r] = v; mx = fmaxf(mx, v); }
    }
    mx = fmaxf(mx, __shfl_xor(mx, 16)); mx = fmaxf(mx, __shfl_xor(mx, 32));
    float sum = 0.f; bf16x4 pb[9];
#pragma unroll
    for (int u = 0; u < 9; ++u) {
        f32x4 p;
#pragma unroll
        for (int r = 0; r < 4; ++r) { p[r] = __builtin_amdgcn_exp2f(s[u][r] - mx); sum += p[r]; }
        pb[u] = __builtin_bit_cast(bf16x4, pack4(p));
    }
    sum += __shfl_xor(sum, 16); sum += __shfl_xor(sum, 32);
    sum += __builtin_amdgcn_exp2f(sink2 - mx);
    const float inv = 1.0f / sum;
#pragma unroll
    for (int dt = 0; dt < 4; ++dt) {
        f32x4 o = {0.f, 0.f, 0.f, 0.f};
#pragma unroll
        for (int u = 0; u < 9; ++u) {
            const bf16x4 a = *(const LAS bf16x4*)(Vt + (16 * dt + l15) * SW_VS + 16 * (j + u) + 4 * g4);
            o = __builtin_amdgcn_mfma_f32_16x16x16bf16_1k(a, pb[u], o, 0, 0, 0);
        }
        if (qvalid) *(u32x2*)(MIX + qrow * DM + 1024 + h * 64 + 16 * dt + 4 * g4) = pack4(o * inv);
    }
}
__device__ __forceinline__ void swa_load_tables(Frame& F, int k) {
    const float* BTg = (const float*)(F.ws + WS_TAB + 8192); LAS float* BT = (LAS float*)(F.lds + SW_BT);
    for (int i = F.tid; i < 8 * 160; i += NTHREADS) BT[i] = BTg[k * 8 * 160 + i];
}
__device__ __forceinline__ void swa_prompt_unit(Frame& F, int unit) {
    const int k = unit & 1, n = (unit >> 1) & 31, b = unit >> 6;
    const bf16_t* SKV = (const bf16_t*)(F.ws + WS_SKV);
    LAS bf16_t* Kb = (LAS bf16_t*)(F.lds + SW_K); LAS bf16_t* Vt = (LAS bf16_t*)(F.lds + SW_V);
    __syncthreads();
    swa_load_tables(F, k);
#pragma unroll
    for (int i = 0; i < 4; ++i) {
        const int idx = F.tid + 512 * i, kj = idx >> 3, p = idx & 7, pos = 128 * (n - 1) + kj;
        u32x4 kv = {0u, 0u, 0u, 0u}, vv = {0u, 0u, 0u, 0u};
        if (pos >= 0) { const bf16_t* src = SKV + (size_t)(b * SEQ + pos) * 256 + k * 64 + p * 8; kv = *(const u32x4*)src; vv = *(const u32x4*)(src + 128); }
        *(LAS u32x4*)(Kb + kj * SW_KS + p * 8) = kv;
        const unsigned w[4] = {vv.x, vv.y, vv.z, vv.w};
#pragma unroll
        for (int e = 0; e < 4; ++e) { Vt[(8 * p + 2 * e) * SW_VS + kj] = (bf16_t)(w[e] & 0xffffu); Vt[(8 * p + 2 * e + 1) * SW_VS + kj] = (bf16_t)(w[e] >> 16); }
    }
    __syncthreads();
    const int h = k * 8 + F.wave; const float sink2 = F.in[I_SINKS][h] * LOG2E;
#pragma unroll 1
    for (int j = 0; j < 8; ++j) swa_qtile(F, j, h, (size_t)(b * SEQ + 128 * n + 16 * j + (F.lane & 15)), true, n == 0, sink2);
}
__device__ __forceinline__ void swa_sample_unit(Frame& F, int unit) {
    const int k = unit & 1, b = unit >> 1;
    const bf16_t* SKV = (const bf16_t*)(F.ws + WS_SKV);
    LAS bf16_t* Kb = (LAS bf16_t*)(F.lds + SW_K); LAS bf16_t* Vt = (LAS bf16_t*)(F.lds + SW_V);
    __syncthreads();
    swa_load_tables(F, k);
#pragma unroll
    for (int i = 0; i < 4; ++i) {
        const int idx = F.tid + 512 * i, kj = idx >> 4, p = idx & 15;
        const size_t so = ((size_t)(b * 128 + kj) * 2 + k) * 64 + p * 4;
        const f32x4 kv = *(const f32x4*)(F.in[I_CSK] + so), vv = *(const f32x4*)(F.in[I_CSV] + so);
        *(LAS u32x2*)(Kb + kj * SW_KS + p * 4) = pack4(kv);
#pragma unroll
        for (int e = 0; e < 4; ++e) Vt[(4 * p + e) * SW_VS + kj] = f2bf(vv[e]);
        if (kj >= 4) { const size_t dof = ((size_t)(b * 128 + kj - 4) * 2 + k) * 64 + p * 4; *(f32x4*)(F.out + O_SSK + dof) = kv; *(f32x4*)(F.out + O_SSV + dof) = vv; }
    }
    if (F.tid < 128) {
        const int kj = 128 + (F.tid >> 3), p = F.tid & 7;
        u32x4 kv = {0u, 0u, 0u, 0u}, vv = {0u, 0u, 0u, 0u};
        if (kj < 132) { const bf16_t* src = SKV + (size_t)(TP + 4 * b + (kj - 128)) * 256 + k * 64 + p * 8; kv = *(const u32x4*)src; vv = *(const u32x4*)(src + 128); }
        *(LAS u32x4*)(Kb + kj * SW_KS + p * 8) = kv;
        const unsigned w[4] = {vv.x, vv.y, vv.z, vv.w};
#pragma unroll
        for (int e = 0; e < 4; ++e) { Vt[(8 * p + 2 * e) * SW_VS + kj] = (bf16_t)(w[e] & 0xffffu); Vt[(8 * p + 2 * e + 1) * SW_VS + kj] = (bf16_t)(w[e] >> 16); }
    }
    __syncthreads();
    const int h = k * 8 + F.wave, l15 = F.lane & 15; const float sink2 = F.in[I_SINKS][h] * LOG2E;
    swa_qtile(F, 0, h, (size_t)(TP + 4 * b + (l15 < 4 ? l15 : 3)), l15 < 4, false, sink2);
}

constexpr int MA_KS = 136, MA_VS = 264;
constexpr int MA_K = 0, MA_V = 256 * MA_KS * 2, MA_END = MA_V + 128 * MA_VS * 2;
static_assert(MA_END <= LDS_BYTES, "memattn LDS");
__device__ __forceinline__ void memattn_prompt_unit(Frame& F, int unit) {
    const int h = unit & 3, pm = unit >> 2, b = pm >> 4;
    const bf16_t* MK = (const bf16_t*)(F.ws + WS_MK); const bf16_t* MVT = (const bf16_t*)(F.ws + WS_MVT);
    const bf16_t* QM = (const bf16_t*)(F.ws + WS_QM); bf16_t* OM = (bf16_t*)(F.ws + WS_OM);
    LAS bf16_t* Kh = (LAS bf16_t*)(F.lds + MA_K); LAS bf16_t* Vt = (LAS bf16_t*)(F.lds + MA_V);
    const int lane = F.lane, l15 = lane & 15, g4 = lane >> 4;
    __syncthreads();
#pragma unroll
    for (int i = 0; i < 8; ++i) {
        const int idx = F.tid + 512 * i;
        { const int m = idx >> 4, p = idx & 15; *(LAS u32x4*)(Kh + m * MA_KS + p * 8) = *(const u32x4*)(MK + (size_t)(b * 256 + m) * 512 + h * 128 + p * 8); }
        { const int d = idx >> 5, p = idx & 31; *(LAS u32x4*)(Vt + d * MA_VS + p * 8) = *(const u32x4*)(MVT + ((size_t)(b * 4 + h) * 128 + d) * 256 + p * 8); }
    }
    __syncthreads();
#pragma unroll 1
    for (int jj = 0; jj < 2; ++jj) {
        const size_t row = (size_t)pm * 256 + 16 * (2 * F.wave + jj) + l15;
        bf16x8 qf[4];
#pragma unroll
        for (int kk = 0; kk < 4; ++kk) qf[kk] = *(const bf16x8*)(QM + row * 512 + h * 128 + 32 * kk + 8 * g4);
        f32x4 s[16]; float mx = -INFINITY;
#pragma unroll
        for (int mt = 0; mt < 16; ++mt) {
            f32x4 acc = {0.f, 0.f, 0.f, 0.f};
#pragma unroll
            for (int kk = 0; kk < 4; ++kk) {
                const bf16x8 a = *(const LAS bf16x8*)(Kh + (16 * mt + l15) * MA_KS + 32 * kk + 8 * g4);
                acc = __builtin_amdgcn_mfma_f32_16x16x32_bf16(a, qf[kk], acc, 0, 0, 0);
            }
            s[mt] = acc; mx = fmaxf(fmaxf(mx, fmaxf(acc[0], acc[1])), fmaxf(acc[2], acc[3]));
            __builtin_amdgcn_sched_barrier(0);
        }
        mx = fmaxf(mx, __shfl_xor(mx, 16)); mx = fmaxf(mx, __shfl_xor(mx, 32));
        float sum = 0.f; bf16x8 pb[8];
#pragma unroll
        for (int i = 0; i < 8; ++i) {
            f32x4 p0, p1;
#pragma unroll
            for (int r = 0; r < 4; ++r) { p0[r] = __builtin_amdgcn_exp2f(s[2 * i][r] - mx); p1[r] = __builtin_amdgcn_exp2f(s[2 * i + 1][r] - mx); sum += p0[r] + p1[r]; }
            pb[i] = __builtin_bit_cast(bf16x8, pack8(p0, p1));
        }
        sum += __shfl_xor(sum, 16); sum += __shfl_xor(sum, 32);
        const float inv = 1.0f / sum;
#pragma unroll
        for (int dt = 0; dt < 8; ++dt) {
            f32x4 o = {0.f, 0.f, 0.f, 0.f};
#pragma unroll
            for (int i = 0; i < 8; ++i) {
                const bf16x4 a0 = *(const LAS bf16x4*)(Vt + (16 * dt + l15) * MA_VS + 32 * i + 4 * g4);
                const bf16x4 a1 = *(const LAS bf16x4*)(Vt + (16 * dt + l15) * MA_VS + 32 * i + 16 + 4 * g4);
                const bf16x8 a = {a0[0], a0[1], a0[2], a0[3], a1[0], a1[1], a1[2], a1[3]};
                o = __builtin_amdgcn_mfma_f32_16x16x32_bf16(a, pb[i], o, 0, 0, 0);
            }
            *(u32x2*)(OM + row * 512 + h * 128 + 16 * dt + 4 * g4) = pack4(o * inv);
            __builtin_amdgcn_sched_barrier(0);
        }
    }
}
constexpr int MS_P = 0;
__device__ __forceinline__ void memattn_sample_task(Frame& F, int task) {
    const int h = task & 3, b = task >> 2;
    const float* CK = F.in[I_CMK] + (size_t)b * 256 * 512 + h * 128; const float* CV = F.in[I_CMV] + (size_t)b * 256 * 512 + h * 128;
    const bf16_t* QM = (const bf16_t*)(F.ws + WS_QM); bf16_t* OM = (bf16_t*)(F.ws + WS_OM);
    const int lane = F.lane, l15 = lane & 15, g4 = lane >> 4;
    LAS float* pl = (LAS float*)(F.lds + F.wave * 4352);
    bf16x8 qf[4];
#pragma unroll
    for (int kk = 0; kk < 4; ++kk) { qf[kk] = *(const bf16x8*)(QM + (size_t)(TP + 4 * b + (l15 & 3)) * 512 + h * 128 + 32 * kk + 8 * g4); if (l15 >= 4) qf[kk] = (bf16x8){0, 0, 0, 0, 0, 0, 0, 0}; }
    f32x4 s[16]; float mx = -INFINITY;
#pragma unroll
    for (int mt = 0; mt < 16; ++mt) {
        f32x4 acc = {0.f, 0.f, 0.f, 0.f};
#pragma unroll
        for (int kk = 0; kk < 4; ++kk) {
            const float* kp = CK + (size_t)(16 * mt + l15) * 512 + 32 * kk + 8 * g4;
            const u32x4 a = pack8(*(const f32x4*)kp, *(const f32x4*)(kp + 4));
            acc = __builtin_amdgcn_mfma_f32_16x16x32_bf16(__builtin_bit_cast(bf16x8, a), qf[kk], acc, 0, 0, 0);
        }
        s[mt] = acc; mx = fmaxf(fmaxf(mx, fmaxf(acc[0], acc[1])), fmaxf(acc[2], acc[3]));
    }
    mx = fmaxf(mx, __shfl_xor(mx, 16)); mx = fmaxf(mx, __shfl_xor(mx, 32));
    float sum = 0.f;
#pragma unroll
    for (int mt = 0; mt < 16; ++mt)
#pragma unroll
        for (int r = 0; r < 4; ++r) { const float p = __builtin_amdgcn_exp2f(s[mt][r] - mx); sum += p; if (l15 < 4) pl[(16 * mt + 4 * g4 + r) * 4 + l15] = p; }
    sum += __shfl_xor(sum, 16); sum += __shfl_xor(sum, 32);
    if (lane < 4) pl[1024 + lane] = 1.0f / sum;
    LDS_WAIT(); asm volatile("" ::: "memory");
    f32x2 o[4] = {{0.f, 0.f}, {0.f, 0.f}, {0.f, 0.f}, {0.f, 0.f}};
#pragma unroll 8
    for (int m = 0; m < 256; ++m) {
        const f32x2 v = *(const f32x2*)(CV + (size_t)m * 512 + 2 * lane);
        const f32x4 p = *(const LAS f32x4*)(pl + m * 4);
#pragma unroll
        for (int t = 0; t < 4; ++t) { o[t][0] += p[t] * v[0]; o[t][1] += p[t] * v[1]; }
    }
#pragma unroll
    for (int t = 0; t < 4; ++t) { const float inv = pl[1024 + t]; *(unsigned*)(OM + (size_t)(TP + 4 * b + t) * 512 + h * 128 + 2 * lane) = cvtpk(o[t][0] * inv, o[t][1] * inv); }
    LDS_WAIT(); asm volatile("" ::: "memory");
}

__device__ __forceinline__ void final_norm_row_slabs(float* xrow, const float* slab_row, size_t slab_stride, int ns, const float* w, int lane) {
    f32x4* xr = (f32x4*)xrow + lane; const f32x4* wr = (const f32x4*)w + lane;
    f32x4 v[8]; float s = 0.f;
#pragma unroll
    for (int j = 0; j < 8; ++j) v[j] = xr[64 * j];
    for (int k = 0; k < ns; ++k) { const f32x4* sr = (const f32x4*)(slab_row + (size_t)k * slab_stride) + lane;
#pragma unroll
        for (int j = 0; j < 8; ++j) v[j] += sr[64 * j]; }
#pragma unroll
    for (int j = 0; j < 8; ++j) s += (v[j][0] * v[j][0] + v[j][1] * v[j][1]) + (v[j][2] * v[j][2] + v[j][3] * v[j][3]);
    const float rs = __builtin_amdgcn_rsqf(wave_sum(s) * (1.0f / DM) + RMS_EPS);
#pragma unroll
    for (int j = 0; j < 8; ++j) { const f32x4 ww = wr[64 * j]; f32x4 y; y[0] = v[j][0] * rs * ww[0]; y[1] = v[j][1] * rs * ww[1]; y[2] = v[j][2] * rs * ww[2]; y[3] = v[j][3] * rs * ww[3]; xr[64 * j] = y; }
}
__device__ __forceinline__ void final_norm_row(float* xrow, const float* SS, int row, const float* w, int lane) {
    const float rs = row_rs(SS, row);
    f32x4* xr = (f32x4*)xrow + lane; const f32x4* wr = (const f32x4*)w + lane;
#pragma unroll
    for (int j = 0; j < 8; ++j) { f32x4 v = xr[64 * j]; const f32x4 ww = wr[64 * j]; v[0] = v[0] * rs * ww[0]; v[1] = v[1] * rs * ww[1]; v[2] = v[2] * rs * ww[2]; v[3] = v[3] * rs * ww[3]; xr[64 * j] = v; }
}

#define HGRN_SCAN_PROMPT hgrn_scan
#define HGRN_SCAN_SAMPLE hgrn_scan
#ifdef HY_P3DELAY
#define P3_DELAY do { for (int z_ = 0; z_ < 16; ++z_) __builtin_amdgcn_s_sleep(127); __syncthreads(); } while (0)
#else
#define P3_DELAY do {} while (0)
#endif
constexpr int N_PHASES = 11;
__global__ void __launch_bounds__(NTHREADS, 2) hymba_fwd(Args args) {
    extern __shared__ __attribute__((aligned(16))) unsigned char lds_raw[];
    cg::grid_group grid = cg::this_grid();
    Frame F;
    F.lds = (LAS unsigned char*)lds_raw;
    F.tid = threadIdx.x; F.lane = F.tid & 63; F.wave = __builtin_amdgcn_readfirstlane(F.tid >> 6);
    F.G = gridDim.x; F.bid = blockIdx.x;
    F.in = args.in; F.out = args.out; F.ws = args.ws;
    unsigned char* ws = args.ws; float* out = args.out;
#ifdef HY_LDSCLR
    for (int i = F.tid; i < LDS_BYTES / 16; i += NTHREADS) *(LAS u32x4*)(F.lds + i * 16) = (u32x4){0u, 0u, 0u, 0u};
    __syncthreads();
#endif
    const int lo = args.ph_lo, hi = args.ph_hi;
#ifndef HY_PHASE_MASK
#define HY_PHASE_MASK 0x7ff
#endif
#define IN(k) (((HY_PHASE_MASK >> (k)) & 1) && lo <= (k) && (k) < hi)
#ifndef HY_REPMASK
#define HY_REPMASK 0
#endif
#define PHASE(k, ...) do { if (IN(k)) { __VA_ARGS__ } if (IN(k) && ((HY_REPMASK >> (k)) & 1)) { __VA_ARGS__ } } while (0)
#ifdef HY_XACQ
#define SEAM(k) do { if (IN(k) && IN((k) + 1)) { asm volatile("s_waitcnt vmcnt(0)" ::: "memory"); __builtin_amdgcn_fence(__ATOMIC_RELEASE, "agent"); asm volatile("s_waitcnt vmcnt(0)" ::: "memory"); grid.sync(); __builtin_amdgcn_fence(__ATOMIC_ACQUIRE, "agent"); asm volatile("s_waitcnt vmcnt(0)" ::: "memory"); __syncthreads(); } } while (0)
#else
#define SEAM(k) do { if (IN(k) && IN((k) + 1)) grid.sync(); } while (0)
#endif
    float* SS0 = (float*)(ws + WS_SS); float* SS1 = (float*)(ws + WS_SS + SS_STRIDE); float* SS2 = (float*)(ws + WS_SS + 2 * SS_STRIDE);
    bf16_t* XB = (bf16_t*)(ws + WS_XB);

    PHASE(0, p0_prologue(F););
    SEAM(0);
    PHASE(1,
        { pg8::Gemm g{XB, (const bf16_t*)(ws + WS_WIN), TT, NIN, DM, DM}; pg8::StaticOrder S; S.init(TT, NIN, F.G, F.bid);
          EpiIn E{out, out + (size_t)TT * 1024, (bf16_t*)(out + O_SST), (bf16_t*)(ws + WS_GATE), (bf16_t*)(ws + WS_SQ), (bf16_t*)(ws + WS_SKV), (const float*)(ws + WS_TAB), out};
          pg8::gemm_phase<EpiIn, pg8::StaticOrder, true, true>(F.lds, g, S, E); }
        { pg8::Gemm g{(const bf16_t*)(ws + WS_MN), (const bf16_t*)(ws + WS_WMKV), 1024, 1024, DM, DM}; pg8::StaticOrder S; S.init(1024, 1024, F.G, (F.bid + 16) % F.G);
          EpiMemKV E{(bf16_t*)(ws + WS_MK), (bf16_t*)(ws + WS_MVT), out};
          pg8::gemm_phase<EpiMemKV, pg8::StaticOrder, true, true>(F.lds, g, S, E); }
    );
    SEAM(1);
    PHASE(2, hgrn_prep(F););
    SEAM(2);
    PHASE(3,
        const bool split = F.G > 32;
#define P3_SCAN do { if (F.bid < 32) { P3_DELAY; for (int bh = F.bid; bh < 32; bh += F.G) { const int b = bh >> 3, h = bh & 7; \
                HGRN_SCAN_PROMPT(F, b * 256, 256, h, b * SEQ, 16, nullptr, out + O_PST + (size_t)bh * 16384); } } } while (0)
#define P3_OTHERS do { if (!split || F.bid >= 32) { const int nw = split ? F.G - 32 : F.G; \
            for (int i = split ? F.bid - 32 : F.bid; i < 1536; i += nw) { \
                if (i < 256) swa_prompt_unit(F, i); \
                else if (i < 512) swa_sample_unit(F, i - 256); \
                else { const int t = i - 512, b = t >> 3, h = t & 7; \
                    HGRN_SCAN_SAMPLE(F, NCHP + b, 1, h, TP + 4 * b, 4, F.in[I_STATE] + (size_t)t * 16384, out + O_SST + (size_t)t * 16384); } } } } while (0)
        P3_SCAN;
        if ((HY_REPMASK >> 11) & 1) P3_SCAN;
        P3_OTHERS;
        if ((HY_REPMASK >> 12) & 1) P3_OTHERS;
    );
    SEAM(3);
    PHASE(4,
        pg8::Gemm g{(const bf16_t*)(ws + WS_MIX), (const bf16_t*)(ws + WS_WOUT), TT, DM, DM, DM}; pg8::StaticOrder S; S.init(TT, DM, F.G, F.bid);
        EpiResid E{F.in[I_XP], F.in[I_XS], out, XB, SS0};
        pg8::gemm_phase<EpiResid, pg8::StaticOrder, true, true>(F.lds, g, S, E);
    );
    SEAM(4);
    PHASE(5,
        pg8::Gemm g{XB, (const bf16_t*)(ws + WS_WMQ), TT, MEMW, DM, DM}; pg8::StaticOrder S; S.init(TT, MEMW, F.G, F.bid);
        EpiScaleBf16 E{(bf16_t*)(ws + WS_QM), MEMW, SS0, MEM_QSCALE};
        pg8::gemm_phase<EpiScaleBf16, pg8::StaticOrder, true, true>(F.lds, g, S, E);
    );
    SEAM(5);
    PHASE(6,
        for (int u = F.bid; u < 256; u += F.G) memattn_prompt_unit(F, u);
        __syncthreads();
        for (int t = F.bid * NWAVES + F.wave; t < 512; t += F.G * NWAVES) memattn_sample_task(F, t);
    );
    SEAM(6);
    if (IN(7)) {
        pg8::Gemm g{(const bf16_t*)(ws + WS_OM), (const bf16_t*)(ws + WS_WMO), TT, DM, MEMW, MEMW}; pg8::StaticOrder S; S.init(TT, DM, F.G, F.bid);
        EpiResid E{out, out + (size_t)TP * DM, out, XB, SS1};
        pg8::gemm_phase<EpiResid, pg8::StaticOrder, true, true>(F.lds, g, S, E);
    }
    SEAM(7);
    PHASE(8,
        pg8::Gemm g{XB, (const bf16_t*)(ws + WS_WGU), TT, 2 * FF, DM, DM}; pg8::StaticOrder S; S.init(TT, 2 * FF, F.G, F.bid);
        EpiSwiGLU E{(bf16_t*)(ws + WS_HID), SS1};
        pg8::gemm_phase<EpiSwiGLU, pg8::StaticOrder, true, true>(F.lds, g, S, E);
    );
    SEAM(8);
    constexpr int DN_NS = 11; constexpr size_t SLAB_STRIDE = (size_t)TS * DM;
    if (IN(9)) {
        { pg8::Gemm g{(const bf16_t*)(ws + WS_HID), (const bf16_t*)(ws + WS_WDN), TP, DM, FF, FF}; pg8::StaticOrder S; S.init(TP, DM, F.G, F.bid);
          EpiResid E{out, out + (size_t)TP * DM, out, nullptr, SS2};
          pg8::gemm_phase<EpiResid, pg8::StaticOrder, true, true>(F.lds, g, S, E); }
        { pg8::Gemm g{(const bf16_t*)(ws + WS_HID), (const bf16_t*)(ws + WS_WDN), TT, DM, FF / DN_NS, FF}; SplitOrder S{F.bid, DN_NS};
          EpiSlab E{(float*)(ws + WS_MIX), TP, SLAB_STRIDE};
          pg8::gemm_phase<EpiSlab, SplitOrder, true, true>(F.lds, g, S, E); }
    }
    SEAM(9);
    if (IN(10)) {
        for (int m = F.bid * NWAVES + F.wave; m < TT; m += F.G * NWAVES) {
            if (m < TP) final_norm_row(out + (size_t)m * DM, SS2, m, F.in[I_NFINAL], F.lane);
            else final_norm_row_slabs(out + (size_t)m * DM, (const float*)(ws + WS_MIX) + (size_t)(m - TP) * DM, SLAB_STRIDE, DN_NS, F.in[I_NFINAL], F.lane);
        }
    }
#undef IN
#undef SEAM
}

#ifndef HY_N_LAUNCHES
#define HY_N_LAUNCHES 1
#endif
extern "C" void kernel_launch(void* const* d_in, const int* in_sizes, int n_in, void* d_out, int out_size, void* d_ws, size_t ws_size, hipStream_t stream) {
    static int grid = 0;
    if (grid == 0) {
        if (n_in != 26 || (size_t)out_size != O_END || ws_size < WS_END) { fprintf(stderr, "kernel_launch: unexpected problem: n_in %d out %d ws %zu (need %zu)\n", n_in, out_size, ws_size, (size_t)WS_END); grid = -1; return; }
        int dev = 0, cus = 0, per_cu = 0;
        hipGetDevice(&dev); hipDeviceGetAttribute(&cus, hipDeviceAttributeMultiprocessorCount, dev);
        if (hipFuncSetAttribute((const void*)hymba_fwd, hipFuncAttributeMaxDynamicSharedMemorySize, LDS_BYTES) != hipSuccess) { fprintf(stderr, "kernel_launch: hipFuncSetAttribute failed\n"); grid = -1; return; }
        if (hipOccupancyMaxActiveBlocksPerMultiprocessor(&per_cu, (const void*)hymba_fwd, NTHREADS, LDS_BYTES) != hipSuccess || per_cu < 1) { fprintf(stderr, "kernel_launch: occupancy query says %d blocks/CU\n", per_cu); per_cu = 1; }
        (void)hipGetLastError();
        grid = cus;
        fprintf(stderr, "kernel_launch: %d CUs, occupancy %d blocks/CU, grid %d\n", cus, per_cu, grid);
    }
    if (grid < 0) return;
    Args a{};
    for (int i = 0; i < 26; ++i) a.in[i] = (const float*)d_in[i];
    a.out = (float*)d_out; a.ws = (unsigned char*)d_ws;
#if HY_N_LAUNCHES == 1
    a.ph_lo = 0; a.ph_hi = N_PHASES;
    void* kargs[] = {&a};
    hipError_t e = hipLaunchCooperativeKernel((const void*)hymba_fwd, dim3(grid), dim3(NTHREADS), kargs, LDS_BYTES, stream);
    if (e != hipSuccess) fprintf(stderr, "kernel_launch: cooperative launch failed: %s\n", hipGetErrorString(e));
#else
    for (int p = 0; p < N_PHASES; ++p) {
        a.ph_lo = p; a.ph_hi = p + 1;
        hipLaunchKernelGGL(hymba_fwd, dim3(grid), dim3(NTHREADS), LDS_BYTES, stream, a);
    }
#endif
}
```

```cpp
#include <hip/hip_runtime.h>
#include <hip/hip_cooperative_groups.h>
#include <cstdio>
#include <cstdint>
namespace cg = cooperative_groups;

namespace pg8 {
#define PG8_LAS __attribute__((address_space(3)))
typedef unsigned short bf16_t;
typedef short bf16x8 __attribute__((ext_vector_type(8)));
typedef float f32x4 __attribute__((ext_vector_type(4)));
typedef unsigned u32x4 __attribute__((ext_vector_type(4)));
constexpr int BM = 256, BK = 64, HALF = 128, HTB = HALF * BK * 2  , STAGE_BYTES = 8 * HTB, NXCD = 8, WGM = 8;

__host__ __device__ __forceinline__ int lds_byte(int r, int c) { const int st = (r >> 4) * 2 + (c >> 5), rr = r & 15, cc = c & 31, ob = rr * 64 + cc * 2; return st * 1024 + (ob ^ (((ob >> 9) & 1) << 5)); }
__host__ __device__ __forceinline__ void stage_rc(int b, int& R, int& C) { const int st = b / 1024, sb = b % 1024, swz = sb ^ (((sb >> 9) & 1) << 5); R = (st >> 1) * 16 + swz / 64; C = (st & 1) * 32 + (swz % 64) / 2; }
__host__ __device__ __forceinline__ int perm32(int rho) { const int n = rho >> 4, i = rho & 15; return 8 * (i >> 2) + 4 * n + (i & 3); }

struct Unit { int pm, pn, ks; };
struct Gemm { const bf16_t* A; const bf16_t* Bt; int M, N, K, ld; };

struct StaticOrder {
    int nM, nN, nwg, G, c;
    __host__ __device__ void init(int M, int N, int G_, int c_) { nM = M / BM; nN = N / BM; nwg = nM * nN; G = G_; c = c_; }
    __host__ __device__ bool next(int i, Unit& u) const {
        const long L = (long)i * G + c; if (L >= nwg) return false;
        int wgid = (int)L; { const int q = nwg / NXCD, r = nwg % NXCD, xcd = wgid % NXCD, off = wgid / NXCD; wgid = (xcd < r ? xcd * (q + 1) : r * (q + 1) + (xcd - r) * q) + off; }
        const int nig = WGM * nN, gid = wgid / nig, fm = gid * WGM, gsz = (nM - fm) < WGM ? (nM - fm) : WGM;
        u.pm = fm + ((wgid % nig) % gsz); u.pn = (wgid % nig) / gsz; u.ks = 0; return true;
    }
    __device__ __forceinline__ void a_ready(const Unit&) const {}
    __device__ __forceinline__ void done(const Unit&) const {}
};

template <class Epi, class Sched, bool ALIGN_EPI = false, bool SP2 = false>
__device__ __forceinline__ void gemm_phase(PG8_LAS unsigned char* lds, const Gemm g, const Sched& S, const Epi& E) {
    const int tid = threadIdx.x, wid = __builtin_amdgcn_readfirstlane(tid >> 6), lane = tid & 63, wr = wid >> 2, wc = wid & 3, fr = lane & 15, fq = lane >> 4;
    const int K = g.ld, nt = g.K / BK;
    unsigned voffA[2], voffB[2];
#pragma unroll
    for (int i = 0; i < 2; ++i) { int R, C; stage_rc(tid * 16 + i * 8192, R, C); const int Rb = Epi::PERM ? ((R & ~31) + perm32(R & 31)) : R;
        voffA[i] = (unsigned)(R * K + C) * 2u; voffB[i] = (unsigned)(Rb * K + C) * 2u; }
    const size_t kstep = (size_t)(BK * 2);
    const size_t hstep = (size_t)HALF * K * 2;
    const size_t tstep = 2 * hstep;
    const unsigned ldsw = (unsigned)wid * 1024u;
    const int aoff = lds_byte(wr * 64 + fr, fq * 8), boff = lds_byte(wc * 32 + fr, fq * 8);
#define PG8_SA(b, h) (((b) * 2 + (h)) * HTB)
#define PG8_SB(b, h) ((4 + (b) * 2 + (h)) * HTB)
#define PG8_STAGE(bufoff, gbase, voff) do { _Pragma("unroll") for (int _i = 0; _i < 2; ++_i) \
        __builtin_amdgcn_global_load_lds((const unsigned*)((const char*)(gbase) + (voff)[_i]), (PG8_LAS unsigned*)(lds + (bufoff) + ldsw + _i * 8192), 16, 0, 0); } while (0)
#define PG8_LDA(dst, b, h) do { _Pragma("unroll") for (int m = 0; m < 4; ++m) _Pragma("unroll") for (int k = 0; k < 2; ++k) dst[m][k] = *(const PG8_LAS bf16x8*)(lds + PG8_SA(b, h) + aoff + m * 2048 + k * 1024); } while (0)
#define PG8_LDB(dst, b, h) do { _Pragma("unroll") for (int n = 0; n < 2; ++n) _Pragma("unroll") for (int k = 0; k < 2; ++k) dst[n][k] = *(const PG8_LAS bf16x8*)(lds + PG8_SB(b, h) + boff + n * 2048 + k * 1024); } while (0)
#define PG8_MMA(ai, bj, At, Bt) do { __builtin_amdgcn_s_setprio(1); _Pragma("unroll") for (int m = 0; m < 4; ++m) _Pragma("unroll") for (int n = 0; n < 2; ++n) _Pragma("unroll") for (int k = 0; k < 2; ++k) \
        acc[ai][bj][m][n] = __builtin_amdgcn_mfma_f32_16x16x32_bf16(Bt[n][k], At[m][k], acc[ai][bj][m][n], 0, 0, 0); __builtin_amdgcn_s_setprio(0); } while (0)
#define PG8_WAIT_V(n) asm volatile("s_waitcnt vmcnt(" #n ")" ::: "memory")
#define PG8_WAIT_L(n) asm volatile("s_waitcnt lgkmcnt(" #n ")" ::: "memory")
#define PG8_BAR __builtin_amdgcn_s_barrier()
#define PG8_SCHED __builtin_amdgcn_sched_barrier(0)
    Unit cur, nxt; int ui = 0;
    if (!S.next(0, cur)) return;
    f32x4 acc[2][2][4][2];
#pragma unroll
    for (int a = 0; a < 2; ++a)
#pragma unroll
        for (int b = 0; b < 2; ++b)
#pragma unroll
            for (int m = 0; m < 4; ++m)
#pragma unroll
                for (int n = 0; n < 2; ++n) acc[a][b][m][n] = (f32x4){0.f, 0.f, 0.f, 0.f};
    bf16x8 At[4][2], B0[2][2], B1[2][2];
    const char* cA = (const char*)g.A + (size_t)cur.pm * tstep + (size_t)cur.ks * g.K * 2; const char* cB = (const char*)g.Bt + (size_t)cur.pn * tstep + (size_t)cur.ks * g.K * 2;
    S.a_ready(cur);
    if constexpr (SP2) {
        PG8_STAGE(PG8_SB(0, 0), cB, voffB); PG8_STAGE(PG8_SB(0, 1), cB + hstep, voffB); PG8_STAGE(PG8_SA(0, 0), cA, voffA); PG8_STAGE(PG8_SA(0, 1), cA + hstep, voffA);
        if (wr == 1) PG8_BAR;
        PG8_WAIT_V(2); PG8_BAR;
        PG8_STAGE(PG8_SB(1, 0), cB + kstep, voffB); PG8_STAGE(PG8_SA(1, 0), cA + kstep, voffA); PG8_STAGE(PG8_SB(1, 1), cB + hstep + kstep, voffB);
        PG8_WAIT_V(6); PG8_BAR;
    } else {
        PG8_STAGE(PG8_SB(0, 0), cB, voffB); PG8_STAGE(PG8_SA(0, 0), cA, voffA); PG8_STAGE(PG8_SB(0, 1), cB + hstep, voffB); PG8_STAGE(PG8_SA(0, 1), cA + hstep, voffA);
        if (wr == 1) PG8_BAR;
        PG8_WAIT_V(4); PG8_BAR;
        PG8_STAGE(PG8_SB(1, 0), cB + kstep, voffB); PG8_STAGE(PG8_SA(1, 0), cA + kstep, voffA); PG8_STAGE(PG8_SB(1, 1), cB + hstep + kstep, voffB);
        PG8_WAIT_V(6); PG8_BAR;
    }
    for (;;) {
        const bool has_next = S.next(ui + 1, nxt);
        const char* nA = has_next ? (const char*)g.A + (size_t)nxt.pm * tstep + (size_t)nxt.ks * g.K * 2 : cA; const char* nB = has_next ? (const char*)g.Bt + (size_t)nxt.pn * tstep + (size_t)nxt.ks * g.K * 2 : cB;
        for (int t = 0; t < nt; t += 2) {
            const bool last = (t == nt - 2);
            const char* a1 = cA + (size_t)(t + 1) * kstep;
            const char* a2 = last ? nA : cA + (size_t)(t + 2) * kstep; const char* b2 = last ? nB : cB + (size_t)(t + 2) * kstep;
            const char* a3 = a2 + kstep; const char* b3 = b2 + kstep;
            if (last && has_next) S.a_ready(nxt);
            if constexpr (SP2) {
            PG8_LDB(B0, 0, 0); PG8_LDB(B1, 0, 1); PG8_SCHED; PG8_LDA(At, 0, 0); PG8_STAGE(PG8_SA(1, 1), a1 + hstep, voffA);
            PG8_WAIT_V(8); PG8_WAIT_L(0); PG8_BAR; PG8_MMA(0, 0, At, B0); PG8_MMA(0, 1, At, B1); PG8_BAR; PG8_SCHED;
            PG8_LDA(At, 0, 1); PG8_STAGE(PG8_SB(0, 0), b2, voffB); PG8_STAGE(PG8_SB(0, 1), b2 + hstep, voffB); PG8_STAGE(PG8_SA(0, 0), a2, voffA);
            PG8_WAIT_V(8); PG8_WAIT_L(0); PG8_BAR; PG8_MMA(1, 0, At, B0); PG8_MMA(1, 1, At, B1); PG8_BAR; PG8_SCHED;
            PG8_LDB(B0, 1, 0); PG8_LDB(B1, 1, 1); PG8_SCHED; PG8_LDA(At, 1, 0); PG8_STAGE(PG8_SA(0, 1), a2 + hstep, voffA);
            PG8_WAIT_V(8); PG8_WAIT_L(0); PG8_BAR; PG8_MMA(0, 0, At, B0); PG8_MMA(0, 1, At, B1); PG8_BAR; PG8_SCHED;
            PG8_LDA(At, 1, 1); PG8_STAGE(PG8_SB(1, 0), b3, voffB); PG8_STAGE(PG8_SB(1, 1), b3 + hstep, voffB); PG8_STAGE(PG8_SA(1, 0), a3, voffA);
            PG8_WAIT_V(8); PG8_WAIT_L(0); PG8_BAR; PG8_MMA(1, 0, At, B0); PG8_MMA(1, 1, At, B1); PG8_BAR; PG8_SCHED;
            } else {
            PG8_LDB(B0, 0, 0); PG8_SCHED; PG8_LDA(At, 0, 0); PG8_STAGE(PG8_SA(1, 1), a1 + hstep, voffA);
            PG8_WAIT_L(8); PG8_BAR; PG8_WAIT_L(0); PG8_MMA(0, 0, At, B0); PG8_BAR; PG8_SCHED;
            PG8_LDB(B1, 0, 1); PG8_STAGE(PG8_SB(0, 0), b2, voffB);
            PG8_BAR; PG8_WAIT_L(0); PG8_MMA(0, 1, At, B1); PG8_BAR;
            PG8_LDA(At, 0, 1); PG8_STAGE(PG8_SA(0, 0), a2, voffA);
            PG8_BAR; PG8_WAIT_L(0); PG8_MMA(1, 0, At, B0); PG8_BAR; PG8_SCHED;
            PG8_STAGE(PG8_SB(0, 1), b2 + hstep, voffB);
            PG8_WAIT_V(6); PG8_BAR; PG8_MMA(1, 1, At, B1); PG8_BAR;
            PG8_LDB(B0, 1, 0); PG8_SCHED; PG8_LDA(At, 1, 0); PG8_STAGE(PG8_SA(0, 1), a2 + hstep, voffA);
            PG8_WAIT_L(8); PG8_BAR; PG8_WAIT_L(0); PG8_MMA(0, 0, At, B0); PG8_BAR; PG8_SCHED;
            PG8_LDB(B1, 1, 1); PG8_STAGE(PG8_SB(1, 0), b3, voffB);
            PG8_BAR; PG8_WAIT_L(0); PG8_MMA(0, 1, At, B1); PG8_BAR;
            PG8_LDA(At, 1, 1); PG8_STAGE(PG8_SA(1, 0), a3, voffA);
            PG8_BAR; PG8_WAIT_L(0); PG8_MMA(1, 0, At, B0); PG8_BAR; PG8_SCHED;
            PG8_STAGE(PG8_SB(1, 1), b3 + hstep, voffB);
            PG8_WAIT_V(6); PG8_BAR; PG8_MMA(1, 1, At, B1); PG8_BAR;
            }
        }
        if constexpr (ALIGN_EPI) { if (wr == 0) PG8_BAR; }
        if constexpr (!Epi::AFTER_DRAIN) { E(acc, cur, wr, wc, fr, fq); S.done(cur); }
        if (!has_next) break;
#pragma unroll
        for (int a = 0; a < 2; ++a)
#pragma unroll
            for (int b = 0; b < 2; ++b)
#pragma unroll
                for (int m = 0; m < 4; ++m)
#pragma unroll
                    for (int n = 0; n < 2; ++n) acc[a][b][m][n] = (f32x4){0.f, 0.f, 0.f, 0.f};
        cur = nxt; cA = nA; cB = nB; ++ui;
        if constexpr (ALIGN_EPI) { if (wr == 1) PG8_BAR; }
    }
    PG8_WAIT_V(0);
    if constexpr (!ALIGN_EPI) { if (wr == 0) PG8_BAR; }
    PG8_BAR;
    if constexpr (Epi::AFTER_DRAIN) { E.fused(acc, cur, wr, wc, fr, fq, lds, wid, lane); S.done(cur); }
#undef PG8_SA
#undef PG8_SB
#undef PG8_STAGE
#undef PG8_LDA
#undef PG8_LDB
#undef PG8_MMA
#undef PG8_WAIT_V
#undef PG8_WAIT_L
#undef PG8_BAR
#undef PG8_SCHED
}
}

#define LAS __attribute__((address_space(3)))
typedef unsigned short bf16_t;
typedef short bf16x8 __attribute__((ext_vector_type(8)));
typedef short bf16x4 __attribute__((ext_vector_type(4)));
typedef float f32x4 __attribute__((ext_vector_type(4)));
typedef float f32x2 __attribute__((ext_vector_type(2)));
typedef unsigned u32x4 __attribute__((ext_vector_type(4)));
typedef unsigned u32x2 __attribute__((ext_vector_type(2)));
typedef __bf16 hbf16x2 __attribute__((ext_vector_type(2)));

constexpr int DM = 2048, TP = 16384, TS = 512, TT = TP + TS, SEQ = 4096, DB = 128;
constexpr int NIN = 5376, FF = 5632, MEMW = 512;
constexpr int NCHP = TP / 16, NCH = NCHP + DB;
constexpr float RMS_EPS = 1e-6f;
constexpr float LOG2E = 1.4426950408889634f;
constexpr float SWA_QSCALE = 0.125f * LOG2E;
constexpr float MEM_QSCALE = 0.08838834764831845f * LOG2E;
constexpr int NWAVES = 8, NTHREADS = 512;
constexpr int LDS_BYTES = 147456;

constexpr size_t O_YP = 0, O_YS = 33554432, O_PST = 34603008, O_PSK = 35127296, O_PSV = 35192832, O_PMK = 35258368, O_PMV = 35782656,
                 O_SST = 36306944, O_SSK = 53084160, O_SSV = 55181312, O_END = 57278464;
constexpr size_t MiB = 1u << 20;
constexpr size_t WS_TAB = 1 * MiB;
constexpr size_t WS_WIN = 2 * MiB, WS_WOUT = 23 * MiB, WS_WMQ = 31 * MiB, WS_WMKV = 33 * MiB, WS_WMO = 37 * MiB, WS_WGU = 39 * MiB, WS_WDN = 83 * MiB;
constexpr size_t WS_SS = 105 * MiB;
constexpr size_t SS_STRIDE = 2359296;
constexpr size_t WS_MK = 112 * MiB, WS_MVT = 113 * MiB, WS_QM = 114 * MiB, WS_OM = 131 * MiB, WS_MN = 148 * MiB, WS_XB = 152 * MiB;
constexpr size_t WS_D = 218 * MiB;
constexpr size_t WS_GATE = WS_D, WS_SQ = WS_D + 33 * MiB, WS_SKV = WS_D + 66 * MiB, WS_QIN = WS_D + 75 * MiB, WS_KT = WS_D + 111 * MiB, WS_VT = WS_D + 147 * MiB,
                 WS_PSC = WS_D + 183 * MiB, WS_DEC = WS_D + 188 * MiB, WS_MIX = WS_D + 193 * MiB, WS_END = WS_D + 259 * MiB;
constexpr size_t WS_HID = WS_D;
static_assert((size_t)TT * FF * 2 <= 183 * MiB, "HID overlay");

struct Args {
    const float* in[26];
    float* out; unsigned char* ws;
    int ph_lo, ph_hi;
};

__device__ __forceinline__ unsigned cvtpk(float lo, float hi) { f32x2 v = {lo, hi}; hbf16x2 b = __builtin_convertvector(v, hbf16x2); return __builtin_bit_cast(unsigned, b); }
__device__ __forceinline__ float bf2f(unsigned short b) { return __uint_as_float((unsigned)b << 16); }
__device__ __forceinline__ unsigned short f2bf(float f) { return (unsigned short)(cvtpk(f, 0.f) & 0xffffu); }
__device__ __forceinline__ u32x4 pack8(f32x4 a, f32x4 b) { u32x4 w; w.x = cvtpk(a[0], a[1]); w.y = cvtpk(a[2], a[3]); w.z = cvtpk(b[0], b[1]); w.w = cvtpk(b[2], b[3]); return w; }
__device__ __forceinline__ u32x2 pack4(f32x4 a) { u32x2 w; w.x = cvtpk(a[0], a[1]); w.y = cvtpk(a[2], a[3]); return w; }
__device__ __forceinline__ float fexp(float x) { return __builtin_amdgcn_exp2f(x * LOG2E); }
__device__ __forceinline__ float fsigmoid(float x) { return __builtin_amdgcn_rcpf(1.0f + fexp(-x)); }
__device__ __forceinline__ float wave_sum(float v) {
#pragma unroll
    for (int o = 1; o < 64; o <<= 1) v += __shfl_xor(v, o);
    return v;
}
#define LDS_WAIT() asm volatile("s_waitcnt lgkmcnt(0)" ::: "memory")

__device__ __forceinline__ float row_rs(const float* SS, int row) {
    const f32x4* p = (const f32x4*)(SS + (size_t)row * 32);
    f32x4 s = p[0];
#pragma unroll
    for (int i = 1; i < 8; ++i) s += p[i];
    return __builtin_amdgcn_rsqf(((s[0] + s[1]) + (s[2] + s[3])) * (1.0f / DM) + RMS_EPS);
}

using pg8::Unit;
struct EpiIn {
    static constexpr bool PERM = true, AFTER_DRAIN = false;
    float* QF; float* GF; bf16_t* VB; bf16_t* GATE; bf16_t* SQ; bf16_t* SKV; const float* LB; float* out;
    __device__ __forceinline__ void operator()(const f32x4 (&acc)[2][2][4][2], const Unit& u, int wr, int wc, int fr, int fq) const {
        const int pn = u.pn;
#pragma unroll
        for (int ai = 0; ai < 2; ++ai)
#pragma unroll
            for (int m = 0; m < 4; ++m) {
                const int row = u.pm * 256 + ai * 128 + wr * 64 + m * 16 + fr;
#pragma unroll
                for (int bj = 0; bj < 2; ++bj) {
                    const int c = pn * 256 + bj * 128 + wc * 32 + 8 * fq;
                    f32x4 v0 = acc[ai][bj][m][0], v1 = acc[ai][bj][m][1];
                    if (pn < 4) {
                        float* d = QF + (size_t)row * 1024 + c; *(f32x4*)d = v0; *(f32x4*)(d + 4) = v1;
                    } else if (pn < 8) {
                        const int cc = c - 1024;
                        const f32x4 l0 = *(const f32x4*)(LB + cc), l1 = *(const f32x4*)(LB + cc + 4);
#pragma unroll
                        for (int j = 0; j < 4; ++j) { v0[j] = __logf(l0[j] + (1.0f - l0[j]) * fsigmoid(v0[j])); v1[j] = __logf(l1[j] + (1.0f - l1[j]) * fsigmoid(v1[j])); }
                        float* d = GF + (size_t)row * 1024 + cc; *(f32x4*)d = v0; *(f32x4*)(d + 4) = v1;
                    } else if (pn < 12) {
                        *(u32x4*)(VB + (size_t)row * 1024 + (c - 2048)) = pack8(v0, v1);
                    } else if (pn < 16) {
#pragma unroll
                        for (int j = 0; j < 4; ++j) { v0[j] = v0[j] * fsigmoid(v0[j]); v1[j] = v1[j] * fsigmoid(v1[j]); }
                        *(u32x4*)(GATE + (size_t)row * 1024 + (c - 3072)) = pack8(v0, v1);
                    } else if (pn < 20) {
                        *(u32x4*)(SQ + (size_t)row * 1024 + (c - 4096)) = pack8(v0 * SWA_QSCALE, v1 * SWA_QSCALE);
                    } else {
                        const int cc = c - 5120;
                        *(u32x4*)(SKV + (size_t)row * 256 + cc) = pack8(v0, v1);
                        float* d = nullptr;
                        if (row < TP) { const int b = row >> 12, t = row & 4095; if (t >= SEQ - 128) d = out + (bj == 0 ? O_PSK : O_PSV) + (size_t)(b * 128 + (t - (SEQ - 128))) * 128 + (cc & 127); }
                        else { const int rs = row - TP, b = rs >> 2, t = rs & 3; d = out + (bj == 0 ? O_SSK : O_SSV) + (size_t)(b * 128 + 124 + t) * 128 + (cc & 127); }
                        if (d) { *(f32x4*)d = v0; *(f32x4*)(d + 4) = v1; }
                    }
                }
            }
    }
};
struct EpiMemKV {
    static constexpr bool PERM = true, AFTER_DRAIN = false;
    bf16_t* MK; bf16_t* MVT; float* out;
    __device__ __forceinline__ void operator()(const f32x4 (&acc)[2][2][4][2], const Unit& u, int wr, int wc, int fr, int fq) const {
#pragma unroll
        for (int ai = 0; ai < 2; ++ai)
#pragma unroll
            for (int m = 0; m < 4; ++m) {
                const int row = u.pm * 256 + ai * 128 + wr * 64 + m * 16 + fr;
#pragma unroll
                for (int bj = 0; bj < 2; ++bj) {
                    const int c = u.pn * 256 + bj * 128 + wc * 32 + 8 * fq;
                    const f32x4 v0 = acc[ai][bj][m][0], v1 = acc[ai][bj][m][1];
                    if (u.pn < 2) {
                        float* d = out + O_PMK + (size_t)row * 512 + c; *(f32x4*)d = v0; *(f32x4*)(d + 4) = v1;
                        *(u32x4*)(MK + (size_t)row * 512 + c) = pack8(v0, v1);
                    } else {
                        const int cv = c - 512, h = cv >> 7, dd = cv & 127, b = row >> 8, mm = row & 255;
                        float* d = out + O_PMV + (size_t)row * 512 + cv; *(f32x4*)d = v0; *(f32x4*)(d + 4) = v1;
                        bf16_t* t = MVT + ((size_t)((b * 4 + h) * 128 + dd)) * 256 + mm;
#pragma unroll
                        for (int j = 0; j < 4; ++j) { t[(size_t)j * 256] = f2bf(v0[j]); t[(size_t)(j + 4) * 256] = f2bf(v1[j]); }
                    }
                }
            }
    }
};
struct EpiResid {
    static constexpr bool PERM = true, AFTER_DRAIN = false;
    const float* resP; const float* resS; float* X; bf16_t* XB; float* SS;
    __device__ __forceinline__ void operator()(const f32x4 (&acc)[2][2][4][2], const Unit& u, int wr, int wc, int fr, int fq) const {
#pragma unroll
        for (int ai = 0; ai < 2; ++ai)
#pragma unroll
            for (int m = 0; m < 4; ++m) {
                const int row = u.pm * 256 + ai * 128 + wr * 64 + m * 16 + fr;
                const float* rrow = (row < TP) ? resP + (size_t)row * DM : resS + (size_t)(row - TP) * DM;
                float ss = 0.f;
#pragma unroll
                for (int bj = 0; bj < 2; ++bj) {
                    const int c = u.pn * 256 + bj * 128 + wc * 32 + 8 * fq;
                    const f32x4 v0 = acc[ai][bj][m][0] + *(const f32x4*)(rrow + c), v1 = acc[ai][bj][m][1] + *(const f32x4*)(rrow + c + 4);
                    float* d = X + (size_t)row * DM + c; *(f32x4*)d = v0; *(f32x4*)(d + 4) = v1;
                    ss += (v0[0] * v0[0] + v0[1] * v0[1]) + (v0[2] * v0[2] + v0[3] * v0[3]) + (v1[0] * v1[0] + v1[1] * v1[1]) + (v1[2] * v1[2] + v1[3] * v1[3]);
                    if (XB) *(u32x4*)(XB + (size_t)row * DM + c) = pack8(v0, v1);
                }
                ss += __shfl_xor(ss, 16); ss += __shfl_xor(ss, 32);
                if (fq == 0) SS[(size_t)row * 32 + u.pn * 4 + wc] = ss;
            }
    }
};
struct EpiSlab {
    static constexpr bool PERM = true, AFTER_DRAIN = false;
    float* SLAB; int row0; size_t slab_stride;
    __device__ __forceinline__ void operator()(const f32x4 (&acc)[2][2][4][2], const Unit& u, int wr, int wc, int fr, int fq) const {
        float* base = SLAB + (size_t)u.ks * slab_stride;
#pragma unroll
        for (int ai = 0; ai < 2; ++ai)
#pragma unroll
            for (int m = 0; m < 4; ++m) {
                const int row = u.pm * 256 + ai * 128 + wr * 64 + m * 16 + fr - row0;
#pragma unroll
                for (int bj = 0; bj < 2; ++bj) {
                    float* d = base + (size_t)row * DM + u.pn * 256 + bj * 128 + wc * 32 + 8 * fq;
                    *(f32x4*)d = acc[ai][bj][m][0]; *(f32x4*)(d + 4) = acc[ai][bj][m][1];
                }
            }
    }
};
struct SplitOrder {
    int c, ns;
    __device__ bool next(int i, Unit& u) const { if (i > 0 || c >= 16 * ns) return false; const int tile = c / ns; u.pm = TP / 256 + (tile >> 3); u.pn = tile & 7; u.ks = c % ns; return true; }
    __device__ __forceinline__ void a_ready(const Unit&) const {}
    __device__ __forceinline__ void done(const Unit&) const {}
};
struct EpiScaleBf16 {
    static constexpr bool PERM = true, AFTER_DRAIN = false;
    bf16_t* O; int ldc; const float* SS; float scale;
    __device__ __forceinline__ void operator()(const f32x4 (&acc)[2][2][4][2], const Unit& u, int wr, int wc, int fr, int fq) const {
#pragma unroll
        for (int ai = 0; ai < 2; ++ai)
#pragma unroll
            for (int m = 0; m < 4; ++m) {
                const int row = u.pm * 256 + ai * 128 + wr * 64 + m * 16 + fr;
                const float s = row_rs(SS, row) * scale;
#pragma unroll
                for (int bj = 0; bj < 2; ++bj) {
                    const int c = u.pn * 256 + bj * 128 + wc * 32 + 8 * fq;
                    *(u32x4*)(O + (size_t)row * ldc + c) = pack8(acc[ai][bj][m][0] * s, acc[ai][bj][m][1] * s);
                }
            }
    }
};
struct EpiSwiGLU {
    static constexpr bool PERM = true, AFTER_DRAIN = false;
    bf16_t* HID; const float* SS;
    __device__ __forceinline__ void operator()(const f32x4 (&acc)[2][2][4][2], const Unit& u, int wr, int wc, int fr, int fq) const {
#pragma unroll
        for (int ai = 0; ai < 2; ++ai)
#pragma unroll
            for (int m = 0; m < 4; ++m) {
                const int row = u.pm * 256 + ai * 128 + wr * 64 + m * 16 + fr;
                const float s = row_rs(SS, row);
                f32x4 h0, h1;
#pragma unroll
                for (int j = 0; j < 4; ++j) {
                    const float g0 = acc[ai][0][m][0][j] * s, u0 = acc[ai][1][m][0][j] * s, g1 = acc[ai][0][m][1][j] * s, u1 = acc[ai][1][m][1][j] * s;
                    h0[j] = g0 * fsigmoid(g0) * u0; h1[j] = g1 * fsigmoid(g1) * u1;
                }
                *(u32x4*)(HID + (size_t)row * FF + u.pn * 128 + wc * 32 + 8 * fq) = pack8(h0, h1);
            }
    }
};

struct Frame {
    LAS unsigned char* lds;
    int tid, lane, wave, G, bid;
    const float* const* in;
    float* out; unsigned char* ws;
};
enum { I_XP = 0, I_XS, I_STATE, I_CSK, I_CSV, I_CMK, I_CMV, I_MEMP, I_NMIX, I_WIN, I_LB, I_ONORM, I_SINKS, I_RELB, I_WOUT, I_NXATT, I_NMEM,
       I_WMQ, I_WMK, I_WMV, I_WMO, I_NFFN, I_WGATE, I_WUP, I_WDOWN, I_NFINAL };

__device__ __forceinline__ void p0_tr_item(const float* __restrict__ W, int K, int N, bf16_t* WT, int k0, int n0, int drow0, const float* __restrict__ scale, LAS float* scr, int lane) {
#pragma unroll 8
    for (int i = 0; i < 32; ++i) { const int kk = 2 * i + (lane >> 5); float v = W[(size_t)(k0 + kk) * N + n0 + (lane & 31)]; if (scale) v *= scale[k0 + kk]; scr[kk * 33 + (lane & 31)] = v; }
    LDS_WAIT(); asm volatile("" ::: "memory");
    const int c = lane & 7;
#pragma unroll
    for (int j = 0; j < 4; ++j) { const int n = (lane >> 3) + 8 * j; const LAS float* s = scr + (8 * c) * 33 + n;
        u32x4 o; o.x = cvtpk(s[0 * 33], s[1 * 33]); o.y = cvtpk(s[2 * 33], s[3 * 33]); o.z = cvtpk(s[4 * 33], s[5 * 33]); o.w = cvtpk(s[6 * 33], s[7 * 33]);
        *(u32x4*)(WT + (size_t)(drow0 + n) * K + k0 + 8 * c) = o; }
    LDS_WAIT(); asm volatile("" ::: "memory");
}
__device__ __forceinline__ void p0_rms_row(const float* xrow, const float* w, bf16_t* orow, int lane) {
    const f32x4* xr = (const f32x4*)xrow + lane; const f32x4* wr = (const f32x4*)w + lane;
    f32x4 v[8]; float s = 0.f;
#pragma unroll
    for (int j = 0; j < 8; ++j) { v[j] = xr[64 * j]; s += (v[j][0] * v[j][0] + v[j][1] * v[j][1]) + (v[j][2] * v[j][2] + v[j][3] * v[j][3]); }
    const float rs = __builtin_amdgcn_rsqf(wave_sum(s) * (1.0f / DM) + RMS_EPS);
    u32x2* o8 = (u32x2*)orow + lane;
#pragma unroll
    for (int j = 0; j < 8; ++j) { const f32x4 ww = wr[64 * j]; f32x4 y; y[0] = v[j][0] * rs * ww[0]; y[1] = v[j][1] * rs * ww[1]; y[2] = v[j][2] * rs * ww[2]; y[3] = v[j][3] * rs * ww[3]; o8[64 * j] = pack4(y); }
}
__device__ __forceinline__ int rel_bucket(int n) {
    if (n < 16) return n;
    int b = 16 + (int)(__logf((float)n * (1.0f / 16.0f)) / 2.0794415416798357f * 16.0f);
    return b < 31 ? b : 31;
}
__device__ __forceinline__ void p0_prologue(Frame& F) {
    LAS float* scr = (LAS float*)(F.lds + F.wave * 16384);
    const int gw = F.bid * NWAVES + F.wave, NGW = F.G * NWAVES;
    unsigned char* ws = F.ws;
    constexpr int I_IN = 32 * (NIN / 32), I_OUT = 32 * 64, I_MQ = 32 * 16, I_MO = 8 * 64, I_G = 32 * (FF / 32), I_DN = (FF / 64) * 64;
    constexpr int NITEMS = I_IN + I_OUT + 3 * I_MQ + I_MO + 2 * I_G + I_DN;
    for (int it = gw; it < NITEMS; it += NGW) {
        int r = it;
        if (r < I_IN) { const int nb = NIN / 32, kb = r / nb, n0 = (r % nb) * 32; p0_tr_item(F.in[I_WIN], DM, NIN, (bf16_t*)(ws + WS_WIN), kb * 64, n0, n0, nullptr, scr, F.lane); continue; } r -= I_IN;
        if (r < I_OUT) { const int kb = r / 64, n0 = (r % 64) * 32; p0_tr_item(F.in[I_WOUT], DM, DM, (bf16_t*)(ws + WS_WOUT), kb * 64, n0, n0, nullptr, scr, F.lane); continue; } r -= I_OUT;
        if (r < I_MQ) { const int kb = r / 16, n0 = (r % 16) * 32; p0_tr_item(F.in[I_WMQ], DM, MEMW, (bf16_t*)(ws + WS_WMQ), kb * 64, n0, n0, F.in[I_NXATT], scr, F.lane); continue; } r -= I_MQ;
        if (r < I_MQ) { const int kb = r / 16, n0 = (r % 16) * 32; p0_tr_item(F.in[I_WMK], DM, MEMW, (bf16_t*)(ws + WS_WMKV), kb * 64, n0, n0, nullptr, scr, F.lane); continue; } r -= I_MQ;
        if (r < I_MQ) { const int kb = r / 16, n0 = (r % 16) * 32; p0_tr_item(F.in[I_WMV], DM, MEMW, (bf16_t*)(ws + WS_WMKV), kb * 64, n0, 512 + n0, nullptr, scr, F.lane); continue; } r -= I_MQ;
        if (r < I_MO) { const int kb = r / 64, n0 = (r % 64) * 32; p0_tr_item(F.in[I_WMO], MEMW, DM, (bf16_t*)(ws + WS_WMO), kb * 64, n0, n0, nullptr, scr, F.lane); continue; } r -= I_MO;
        if (r < 2 * I_G) { const int up = r >= I_G; if (up) r -= I_G; const int nb = FF / 32, kb = r / nb, n0 = (r % nb) * 32;
            p0_tr_item(F.in[up ? I_WUP : I_WGATE], DM, FF, (bf16_t*)(ws + WS_WGU), kb * 64, n0, (n0 >> 7) * 256 + (n0 & 127) + (up ? 128 : 0), F.in[I_NFFN], scr, F.lane); continue; } r -= 2 * I_G;
        { const int kb = r / 64, n0 = (r % 64) * 32; p0_tr_item(F.in[I_WDOWN], FF, DM, (bf16_t*)(ws + WS_WDN), kb * 64, n0, n0, nullptr, scr, F.lane); }
    }
    for (int m = gw; m < TT + 1024; m += NGW) {
        if (m < TP) p0_rms_row(F.in[I_XP] + (size_t)m * DM, F.in[I_NMIX], (bf16_t*)(ws + WS_XB) + (size_t)m * DM, F.lane);
        else if (m < TT) p0_rms_row(F.in[I_XS] + (size_t)(m - TP) * DM, F.in[I_NMIX], (bf16_t*)(ws + WS_XB) + (size_t)m * DM, F.lane);
        else p0_rms_row(F.in[I_MEMP] + (size_t)(m - TT) * DM, F.in[I_NMEM], (bf16_t*)(ws + WS_MN) + (size_t)(m - TT) * DM, F.lane);
    }
    float* LBt = (float*)(ws + WS_TAB); float* BT = (float*)(ws + WS_TAB + 8192);
    const int gt = F.bid * NTHREADS + F.tid, NGT = F.G * NTHREADS;
    for (int i = gt; i < 1024 + 16 * 160; i += NGT) {
        if (i < 1024) { const float l0 = F.in[I_LB][i], l1 = F.in[I_LB][1024 + i]; LBt[i] = 1.0f / (1.0f + __expf(l1 - l0)); }
        else { const int j = i - 1024, h = j / 160, ix = j % 160, dist = 143 - ix;
            BT[j] = (dist >= 0 && dist < 128) ? F.in[I_RELB][rel_bucket(dist) * 16 + h] * LOG2E : -INFINITY; }
    }
}

constexpr int PREP_RS = 1032;
__device__ __forceinline__ void hgrn_prep(Frame& F) {
    unsigned char* ws = F.ws;
    const float* QF = F.out; const float* GF = F.out + (size_t)TT * 1024; const bf16_t* VB = (const bf16_t*)(F.out + O_SST);
    bf16_t* QIN = (bf16_t*)(ws + WS_QIN); bf16_t* KT = (bf16_t*)(ws + WS_KT); bf16_t* VT = (bf16_t*)(ws + WS_VT); bf16_t* PSC = (bf16_t*)(ws + WS_PSC); float* DEC = (float*)(ws + WS_DEC);
    LAS bf16_t* lq = (LAS bf16_t*)F.lds; LAS bf16_t* lk = lq + 16 * PREP_RS;
    const int l15 = F.lane & 15, g4 = F.lane >> 4;
    for (int ch = F.bid; ch < NCH; ch += F.G) {
        const int nv = ch < NCHP ? 16 : 4; const int row0 = ch < NCHP ? ch * 16 : TP + (ch - NCHP) * 4;
#pragma unroll 1
        for (int pass = 0; pass < 2; ++pass) {
            const int cidx = F.tid + 512 * pass;
            float g[16], q[16]; unsigned short vv[16];
#pragma unroll
            for (int t = 0; t < 16; ++t) {
                if (t < nv) { g[t] = GF[(size_t)(row0 + t) * 1024 + cidx]; q[t] = QF[(size_t)(row0 + t) * 1024 + cidx]; vv[t] = VB[(size_t)(row0 + t) * 1024 + cidx]; }
                else { g[t] = 0.f; q[t] = 0.f; vv[t] = 0; }
            }
            float G = 0.f; unsigned kd[8], vt[8];
#pragma unroll
            for (int t = 0; t < 16; t += 2) {
                float qi[2], kk[2];
#pragma unroll
                for (int z = 0; z < 2; ++z) {
                    const float gt = g[t + z]; G += gt;
                    qi[z] = q[t + z] * fexp(G);
                    kk[z] = (1.0f - fexp(gt)) * fexp(fminf(-G, 80.0f));
                    lq[(t + z) * PREP_RS + cidx] = f2bf(qi[z]); lk[(t + z) * PREP_RS + cidx] = f2bf(kk[z]);
                }
                kd[t >> 1] = cvtpk(kk[0], kk[1]); vt[t >> 1] = (unsigned)vv[t] | ((unsigned)vv[t + 1] << 16);
            }
            DEC[(size_t)ch * 1024 + cidx] = fexp(G);
            u32x4* kp = (u32x4*)(KT + ((size_t)ch * 1024 + cidx) * 16); kp[0] = (u32x4){kd[0], kd[1], kd[2], kd[3]}; kp[1] = (u32x4){kd[4], kd[5], kd[6], kd[7]};
            u32x4* vp = (u32x4*)(VT + ((size_t)ch * 1024 + cidx) * 16); vp[0] = (u32x4){vt[0], vt[1], vt[2], vt[3]}; vp[1] = (u32x4){vt[4], vt[5], vt[6], vt[7]};
        }
        __syncthreads();
#pragma unroll
        for (int i = 0; i < 4; ++i) { const int idx = F.tid + 512 * i, t = idx >> 7, c8 = idx & 127;
            *(u32x4*)(QIN + ((size_t)ch * 16 + t) * 1024 + c8 * 8) = *(const LAS u32x4*)(lq + t * PREP_RS + c8 * 8); }
        {
            const int h = F.wave; f32x4 acc = {0.f, 0.f, 0.f, 0.f};
#pragma unroll
            for (int kk = 0; kk < 4; ++kk) {
                const bf16x8 a = *(const LAS bf16x8*)(lq + l15 * PREP_RS + h * 128 + 32 * kk + 8 * g4);
                const bf16x8 b = *(const LAS bf16x8*)(lk + l15 * PREP_RS + h * 128 + 32 * kk + 8 * g4);
                acc = __builtin_amdgcn_mfma_f32_16x16x32_bf16(a, b, acc, 0, 0, 0);
            }
            bf16_t* pd = PSC + ((size_t)ch * 8 + h) * 256;
#pragma unroll
            for (int r = 0; r < 4; ++r) { const int t = 4 * g4 + r, s = l15; pd[t * 16 + s] = (s <= t) ? f2bf(acc[r]) : (bf16_t)0; }
        }
        __syncthreads();
    }
}

constexpr int SC_QS = 136;
constexpr int SC_QI = 0, SC_KT = 16 * SC_QS * 2, SC_VT = SC_KT + 4096, SC_P = SC_VT + 4096, SC_DEC = SC_P + 512, SC_GATE = SC_DEC + 512, SC_BUF = SC_GATE + 16 * SC_QS * 2;
constexpr int SC_RED = 2 * SC_BUF;
static_assert(SC_RED + 1024 <= LDS_BYTES && SC_BUF % 16 == 0, "scan LDS");
struct ScanPf { u32x4 a, b, c; };
struct ScanSrc { const unsigned char* a; const unsigned char* b; const unsigned char* c; unsigned oa, ob, oc; };
__device__ __forceinline__ ScanSrc scan_src(const Frame& F, int ch0, int h, int grow0, int ngr) {
    const unsigned char* ws = F.ws; const int tid = F.tid; ScanSrc s;
    const bf16_t* QIN = (const bf16_t*)(ws + WS_QIN); const bf16_t* KT = (const bf16_t*)(ws + WS_KT); const bf16_t* VT = (const bf16_t*)(ws + WS_VT);
    const bf16_t* PSC = (const bf16_t*)(ws + WS_PSC); const float* DEC = (const float*)(ws + WS_DEC); const bf16_t* GATE = (const bf16_t*)(ws + WS_GATE);
    if (tid < 256) { const int t = tid >> 4, p = tid & 15;
        s.a = (const unsigned char*)(QIN + ((size_t)ch0 * 16 + t) * 1024 + h * 128 + p * 8); s.oa = SC_QI + (t * SC_QS + p * 8) * 2;
        s.b = (const unsigned char*)(VT + ((size_t)ch0 * 1024 + h * 128) * 16 + tid * 8); s.ob = SC_VT + tid * 16;
    } else { const int i = tid - 256, t = i >> 4, p = i & 15; const int tr = t < ngr ? t : ngr - 1;
        s.a = (const unsigned char*)(KT + ((size_t)ch0 * 1024 + h * 128) * 16 + i * 8); s.oa = SC_KT + i * 16;
        s.b = (const unsigned char*)(GATE + (size_t)(grow0 + tr) * 1024 + h * 128 + p * 8); s.ob = SC_GATE + (t * SC_QS + p * 8) * 2;
    }
    if (tid < 32) { s.c = (const unsigned char*)(PSC + ((size_t)ch0 * 8 + h) * 256 + tid * 8); s.oc = SC_P + tid * 16; }
    else { const int i = (tid - 32) & 31; s.c = (const unsigned char*)(DEC + (size_t)ch0 * 1024 + h * 128 + i * 4); s.oc = SC_DEC + i * 16; }
    return s;
}
__device__ __forceinline__ void scan_fetch(ScanPf& pf, const ScanSrc& s, const Frame& F, int step) {
    pf.a = *(const u32x4*)(s.a + (size_t)step * 32768); pf.b = *(const u32x4*)(s.b + (size_t)step * 32768);
    if (F.tid < 64) pf.c = *(const u32x4*)(s.c + (size_t)step * 4096);
}
__device__ __forceinline__ void scan_stash(const ScanPf& pf, const ScanSrc& s, const Frame& F, int buf) {
    LAS unsigned char* B = F.lds + buf * SC_BUF;
    *(LAS u32x4*)(B + s.oa) = pf.a; *(LAS u32x4*)(B + s.ob) = pf.b;
    if (F.tid < 64) *(LAS u32x4*)(B + s.oc) = pf.c;
}
template <int CTRL> __device__ __forceinline__ float dpp_mov(float v) { return __int_as_float(__builtin_amdgcn_update_dpp(0, __float_as_int(v), CTRL, 0xF, 0xF, true)); }
__device__ __forceinline__ float row16_sum(float v) { v += dpp_mov<0xB1>(v); v += dpp_mov<0x4E>(v); v += dpp_mov<0x141>(v); v += dpp_mov<0x140>(v); return v; }
constexpr int SC_ST = SC_RED + 1024, SC_STS = 132;
static_assert(SC_ST + 128 * SC_STS * 4 <= LDS_BYTES, "scan LDS (state image)");
__device__ __forceinline__ void hgrn_scan(Frame& F, int ch0, int nsteps, int h, int mrow0, int nvalid, const float* S0, float* Sout) {
    const int lane = F.lane, l15 = lane & 15, g4 = lane >> 4, e0 = 16 * F.wave;
    bf16_t* MIX = (bf16_t*)(F.ws + WS_MIX);
    const float onw = F.in[I_ONORM][e0 + l15];
    LAS float* RED = (LAS float*)(F.lds + SC_RED);
    LAS float* ST = (LAS float*)(F.lds + SC_ST);
    ScanPf pf;
    __syncthreads();
    const ScanSrc src = scan_src(F, ch0, h, mrow0, nvalid);
    scan_fetch(pf, src, F, 0); scan_stash(pf, src, F, 0);
    if (nsteps > 1) scan_fetch(pf, src, F, 1);
    f32x4 S[8];
    if (S0) {
#pragma unroll
        for (int i = 0; i < 8; ++i) { const int idx = F.tid + 512 * i, c = idx >> 5, e4 = idx & 31; *(LAS f32x4*)(ST + c * SC_STS + e4 * 4) = *(const f32x4*)(S0 + (size_t)c * 128 + e4 * 4); }
    }
    __syncthreads();
#pragma unroll
    for (int mt = 0; mt < 8; ++mt)
#pragma unroll
        for (int r = 0; r < 4; ++r) S[mt][r] = S0 ? ST[(16 * mt + 4 * g4 + r) * SC_STS + e0 + l15] : 0.f;
    f32x4 o_prev = {0.f, 0.f, 0.f, 0.f}, gate_prev = {0.f, 0.f, 0.f, 0.f};
#pragma unroll 1
    for (int n = 0; n <= nsteps; ++n) {
        const int buf = n & 1;
        f32x4 o = {0.f, 0.f, 0.f, 0.f}, gate = {0.f, 0.f, 0.f, 0.f};
        if (n + 1 < nsteps) {
            scan_stash(pf, src, F, buf ^ 1);
            if (n + 2 < nsteps) scan_fetch(pf, src, F, n + 2);
        }
        if (n < nsteps) {
            const LAS unsigned char* B = F.lds + buf * SC_BUF;
            const bf16x4 vt = *(const LAS bf16x4*)(B + SC_VT + ((e0 + l15) * 16 + 4 * g4) * 2);
            const bf16x4 pa = *(const LAS bf16x4*)(B + SC_P + (l15 * 16 + 4 * g4) * 2);
            f32x4 ob = {0.f, 0.f, 0.f, 0.f};
            o = __builtin_amdgcn_mfma_f32_16x16x16bf16_1k(pa, vt, o, 0, 0, 0);
#pragma unroll
            for (int kk = 0; kk < 4; ++kk) {
                const bf16x4 q0 = *(const LAS bf16x4*)(B + SC_QI + (l15 * SC_QS + 32 * kk + 4 * g4) * 2);
                const bf16x4 q1 = *(const LAS bf16x4*)(B + SC_QI + (l15 * SC_QS + 32 * kk + 16 + 4 * g4) * 2);
                const bf16x8 qa = {q0[0], q0[1], q0[2], q0[3], q1[0], q1[1], q1[2], q1[3]};
                const u32x4 sb = pack8(S[2 * kk], S[2 * kk + 1]);
                if (kk & 1) ob = __builtin_amdgcn_mfma_f32_16x16x32_bf16(qa, __builtin_bit_cast(bf16x8, sb), ob, 0, 0, 0);
                else o = __builtin_amdgcn_mfma_f32_16x16x32_bf16(qa, __builtin_bit_cast(bf16x8, sb), o, 0, 0, 0);
            }
#pragma unroll
            for (int mt = 0; mt < 8; ++mt) {
                const bf16x4 kt = *(const LAS bf16x4*)(B + SC_KT + ((16 * mt + l15) * 16 + 4 * g4) * 2);
                const f32x4 dc = *(const LAS f32x4*)(B + SC_DEC + (16 * mt + 4 * g4) * 4);
                S[mt] = __builtin_amdgcn_mfma_f32_16x16x16bf16_1k(kt, vt, S[mt], 0, 0, 0);
                S[mt] = S[mt] * dc;
            }
            o = o + ob;
#pragma unroll
            for (int r = 0; r < 4; ++r) {
                gate[r] = bf2f(*(const LAS unsigned short*)(B + SC_GATE + ((4 * g4 + r) * SC_QS + e0 + l15) * 2));
                const float ss = row16_sum(o[r] * o[r]);
                if (l15 == 0) RED[(buf * 8 + F.wave) * 16 + 4 * g4 + r] = ss;
            }
        }
        if (n > 0) {
            const int pb = (n - 1) & 1;
#pragma unroll
            for (int r = 0; r < 4; ++r) {
                const int t = 4 * g4 + r; float tot = 0.f;
#pragma unroll
                for (int w = 0; w < 8; ++w) tot += RED[(pb * 8 + w) * 16 + t];
                const float rs = __builtin_amdgcn_rsqf(tot * (1.0f / 128.0f) + RMS_EPS);
                if (t < nvalid) MIX[(size_t)(mrow0 + 16 * (n - 1) + t) * DM + h * 128 + e0 + l15] = f2bf(o_prev[r] * rs * onw * gate_prev[r]);
            }
        }
        o_prev = o; gate_prev = gate;
        __syncthreads();
    }
#pragma unroll
    for (int mt = 0; mt < 8; ++mt)
#pragma unroll
        for (int r = 0; r < 4; ++r) ST[(16 * mt + 4 * g4 + r) * SC_STS + e0 + l15] = S[mt][r];
    __syncthreads();
#pragma unroll
    for (int i = 0; i < 8; ++i) { const int idx = F.tid + 512 * i, c = idx >> 5, e4 = idx & 31; *(f32x4*)(Sout + (size_t)c * 128 + e4 * 4) = *(const LAS f32x4*)(ST + c * SC_STS + e4 * 4); }
}


constexpr int SW_KS = 72, SW_VS = 264;
constexpr int SW_K = 0, SW_V = 256 * SW_KS * 2, SW_BT = SW_V + 64 * SW_VS * 2, SW_END = SW_BT + 8 * 160 * 4;
static_assert(SW_END <= LDS_BYTES, "swa LDS");
__device__ __forceinline__ void swa_qtile(Frame& F, int j, int h, size_t qrow, bool qvalid, bool first_block, float sink2) {
    const int lane = F.lane, l15 = lane & 15, g4 = lane >> 4;
    const bf16_t* SQ = (const bf16_t*)(F.ws + WS_SQ); bf16_t* MIX = (bf16_t*)(F.ws + WS_MIX);
    const LAS bf16_t* Kb = (const LAS bf16_t*)(F.lds + SW_K); const LAS bf16_t* Vt = (const LAS bf16_t*)(F.lds + SW_V);
    const LAS float* BT = (const LAS float*)(F.lds + SW_BT) + F.wave * 160;
    bf16x8 qf[2];
#pragma unroll
    for (int kk = 0; kk < 2; ++kk) qf[kk] = *(const bf16x8*)(SQ + qrow * 1024 + h * 64 + 32 * kk + 8 * g4);
    f32x4 s[9]; float mx = sink2;
    const int bidx = 15 + 4 * g4 - l15;
#pragma unroll
    for (int u = 0; u < 9; ++u) {
        const int mt = j + u; f32x4 acc = {0.f, 0.f, 0.f, 0.f};
#pragma unroll
        for (int kk = 0; kk < 2; ++kk) {
            const bf16x8 a = *(const LAS bf16x8*)(Kb + (16 * mt + l15) * SW_KS + 32 * kk + 8 * g4);
            acc = __builtin_amdgcn_mfma_f32_16x16x32_bf16(a, qf[kk], acc, 0, 0, 0);
        }
        const bool dead = first_block && (mt < 8);
#pragma unroll
        for (int r = 0; r < 4; ++r) { float v = acc[r] + BT[bidx + 16 * u + r]; v = dead ? -INFINITY : v; s[u][r] = v; mx = fmaxf(mx, v); }
    }
    mx = fmaxf(mx, __shfl_xor(mx, 16)); mx = fmaxf(mx, __shfl_xor(mx, 32));
    float sum = 0.f; bf16x4 pb[9];
#pragma unroll
    for (int u = 0; u < 9; ++u) {
        f32x4 p;
#pragma unroll
        for (int r = 0; r < 4; ++r) { p[r] = __builtin_amdgcn_exp2f(s[u][r] - mx); sum += p[r]; }
        pb[u] = __builtin_bit_cast(bf16x4, pack4(p));
    }
    sum += __shfl_xor(sum, 16); sum += __shfl_xor(sum, 32);
    sum += __builtin_amdgcn_exp2f(sink2 - mx);
    const float inv = 1.0f / sum;
#pragma unroll
    for (int dt = 0; dt < 4; ++dt) {
        f32x4 o = {0.f, 0.f, 0.f, 0.f};
#pragma unroll
        for (int u = 0; u < 9; ++u) {
            const bf16x4 a = *(const LAS bf16x4*)(Vt + (16 * dt + l15) * SW_VS + 16 * (j + u) + 4 * g4);
            o = __builtin_amdgcn_mfma_f32_16x16x16bf16_1k(a, pb[u], o, 0, 0, 0);
        }
        if (qvalid) *(u32x2*)(MIX + qrow * DM + 1024 + h * 64 + 16 * dt + 4 * g4) = pack4(o * inv);
    }
}
__device__ __forceinline__ void swa_load_tables(Frame& F, int k) {
    const float* BTg = (const float*)(F.ws + WS_TAB + 8192); LAS float* BT = (LAS float*)(F.lds + SW_BT);
    for (int i = F.tid; i < 8 * 160; i += NTHREADS) BT[i] = BTg[k * 8 * 160 + i];
}
__device__ __forceinline__ void swa_prompt_unit(Frame& F, int unit) {
    const int k = unit & 1, n = (unit >> 1) & 31, b = unit >> 6;
    const bf16_t* SKV = (const bf16_t*)(F.ws + WS_SKV);
    LAS bf16_t* Kb = (LAS bf16_t*)(F.lds + SW_K); LAS bf16_t* Vt = (LAS bf16_t*)(F.lds + SW_V);
    __syncthreads();
    swa_load_tables(F, k);
#pragma unroll
    for (int i = 0; i < 4; ++i) {
        const int idx = F.tid + 512 * i, kj = idx >> 3, p = idx & 7, pos = 128 * (n - 1) + kj;
        u32x4 kv = {0u, 0u, 0u, 0u}, vv = {0u, 0u, 0u, 0u};
        if (pos >= 0) { const bf16_t* src = SKV + (size_t)(b * SEQ + pos) * 256 + k * 64 + p * 8; kv = *(const u32x4*)src; vv = *(const u32x4*)(src + 128); }
        *(LAS u32x4*)(Kb + kj * SW_KS + p * 8) = kv;
        const unsigned w[4] = {vv.x, vv.y, vv.z, vv.w};
#pragma unroll
        for (int e = 0; e < 4; ++e) { Vt[(8 * p + 2 * e) * SW_VS + kj] = (bf16_t)(w[e] & 0xffffu); Vt[(8 * p + 2 * e + 1) * SW_VS + kj] = (bf16_t)(w[e] >> 16); }
    }
    __syncthreads();
    const int h = k * 8 + F.wave; const float sink2 = F.in[I_SINKS][h] * LOG2E;
#pragma unroll 1
    for (int j = 0; j < 8; ++j) swa_qtile(F, j, h, (size_t)(b * SEQ + 128 * n + 16 * j + (F.lane & 15)), true, n == 0, sink2);
}
__device__ __forceinline__ void swa_sample_unit(Frame& F, int unit) {
    const int k = unit & 1, b = unit >> 1;
    const bf16_t* SKV = (const bf16_t*)(F.ws + WS_SKV);
    LAS bf16_t* Kb = (LAS bf16_t*)(F.lds + SW_K); LAS bf16_t* Vt = (LAS bf16_t*)(F.lds + SW_V);
    __syncthreads();
    swa_load_tables(F, k);
#pragma unroll
    for (int i = 0; i < 4; ++i) {
        const int idx = F.tid + 512 * i, kj = idx >> 4, p = idx & 15;
        const size_t so = ((size_t)(b * 128 + kj) * 2 + k) * 64 + p * 4;
        const f32x4 kv = *(const f32x4*)(F.in[I_CSK] + so), vv = *(const f32x4*)(F.in[I_CSV] + so);
        *(LAS u32x2*)(Kb + kj * SW_KS + p * 4) = pack4(kv);
#pragma unroll
        for (int e = 0; e < 4; ++e) Vt[(4 * p + e) * SW_VS + kj] = f2bf(vv[e]);
        if (kj >= 4) { const size_t dof = ((size_t)(b * 128 + kj - 4) * 2 + k) * 64 + p * 4; *(f32x4*)(F.out + O_SSK + dof) = kv; *(f32x4*)(F.out + O_SSV + dof) = vv; }
    }
    if (F.tid < 128) {
        const int kj = 128 + (F.tid >> 3), p = F.tid & 7;
        u32x4 kv = {0u, 0u, 0u, 0u}, vv = {0u, 0u, 0u, 0u};
        if (kj < 132) { const bf16_t* src = SKV + (size_t)(TP + 4 * b + (kj - 128)) * 256 + k * 64 + p * 8; kv = *(const u32x4*)src; vv = *(const u32x4*)(src + 128); }
        *(LAS u32x4*)(Kb + kj * SW_KS + p * 8) = kv;
        const unsigned w[4] = {vv.x, vv.y, vv.z, vv.w};
#pragma unroll
        for (int e = 0; e < 4; ++e) { Vt[(8 * p + 2 * e) * SW_VS + kj] = (bf16_t)(w[e] & 0xffffu); Vt[(8 * p + 2 * e + 1) * SW_VS + kj] = (bf16_t)(w[e] >> 16); }
    }
    __syncthreads();
    const int h = k * 8 + F.wave, l15 = F.lane & 15; const float sink2 = F.in[I_SINKS][h] * LOG2E;
    swa_qtile(F, 0, h, (size_t)(TP + 4 * b + (l15 < 4 ? l15 : 3)), l15 < 4, false, sink2);
}

constexpr int MA_KS = 136, MA_VS = 264;
constexpr int MA_K = 0, MA_V = 256 * MA_KS * 2, MA_END = MA_V + 128 * MA_VS * 2;
static_assert(MA_END <= LDS_BYTES, "memattn LDS");
__device__ __forceinline__ void memattn_prompt_unit(Frame& F, int unit) {
    const int h = unit & 3, pm = unit >> 2, b = pm >> 4;
    const bf16_t* MK = (const bf16_t*)(F.ws + WS_MK); const bf16_t* MVT = (const bf16_t*)(F.ws + WS_MVT);
    const bf16_t* QM = (const bf16_t*)(F.ws + WS_QM); bf16_t* OM = (bf16_t*)(F.ws + WS_OM);
    LAS bf16_t* Kh = (LAS bf16_t*)(F.lds + MA_K); LAS bf16_t* Vt = (LAS bf16_t*)(F.lds + MA_V);
    const int lane = F.lane, l15 = lane & 15, g4 = lane >> 4;
    __syncthreads();
#pragma unroll
    for (int i = 0; i < 8; ++i) {
        const int idx = F.tid + 512 * i;
        { const int m = idx >> 4, p = idx & 15; *(LAS u32x4*)(Kh + m * MA_KS + p * 8) = *(const u32x4*)(MK + (size_t)(b * 256 + m) * 512 + h * 128 + p * 8); }
        { const int d = idx >> 5, p = idx & 31; *(LAS u32x4*)(Vt + d * MA_VS + p * 8) = *(const u32x4*)(MVT + ((size_t)(b * 4 + h) * 128 + d) * 256 + p * 8); }
    }
    __syncthreads();
#pragma unroll 1
    for (int jj = 0; jj < 2; ++jj) {
        const size_t row = (size_t)pm * 256 + 16 * (2 * F.wave + jj) + l15;
        bf16x8 qf[4];
#pragma unroll
        for (int kk = 0; kk < 4; ++kk) qf[kk] = *(const bf16x8*)(QM + row * 512 + h * 128 + 32 * kk + 8 * g4);
        f32x4 s[16]; float mx = -INFINITY;
#pragma unroll
        for (int mt = 0; mt < 16; ++mt) {
            f32x4 acc = {0.f, 0.f, 0.f, 0.f};
#pragma unroll
            for (int kk = 0; kk < 4; ++kk) {
                const bf16x8 a = *(const LAS bf16x8*)(Kh + (16 * mt + l15) * MA_KS + 32 * kk + 8 * g4);
                acc = __builtin_amdgcn_mfma_f32_16x16x32_bf16(a, qf[kk], acc, 0, 0, 0);
            }
            s[mt] = acc; mx = fmaxf(fmaxf(mx, fmaxf(acc[0], acc[1])), fmaxf(acc[2], acc[3]));
            __builtin_amdgcn_sched_barrier(0);
        }
        mx = fmaxf(mx, __shfl_xor(mx, 16)); mx = fmaxf(mx, __shfl_xor(mx, 32));
        float sum = 0.f; bf16x8 pb[8];
#pragma unroll
        for (int i = 0; i < 8; ++i) {
            f32x4 p0, p1;
#pragma unroll
            for (int r = 0; r < 4; ++r) { p0[r] = __builtin_amdgcn_exp2f(s[2 * i][r] - mx); p1[r] = __builtin_amdgcn_exp2f(s[2 * i + 1][r] - mx); sum += p0[r] + p1[r]; }
            pb[i] = __builtin_bit_cast(bf16x8, pack8(p0, p1));
        }
        sum += __shfl_xor(sum, 16); sum += __shfl_xor(sum, 32);
        const float inv = 1.0f / sum;
#pragma unroll
        for (int dt = 0; dt < 8; ++dt) {
            f32x4 o = {0.f, 0.f, 0.f, 0.f};
#pragma unroll
            for (int i = 0; i < 8; ++i) {
                const bf16x4 a0 = *(const LAS bf16x4*)(Vt + (16 * dt + l15) * MA_VS + 32 * i + 4 * g4);
                const bf16x4 a1 = *(const LAS bf16x4*)(Vt + (16 * dt + l15) * MA_VS + 32 * i + 16 + 4 * g4);
                const bf16x8 a = {a0[0], a0[1], a0[2], a0[3], a1[0], a1[1], a1[2], a1[3]};
                o = __builtin_amdgcn_mfma_f32_16x16x32_bf16(a, pb[i], o, 0, 0, 0);
            }
            *(u32x2*)(OM + row * 512 + h * 128 + 16 * dt + 4 * g4) = pack4(o * inv);
            __builtin_amdgcn_sched_barrier(0);
        }
    }
}
constexpr int MSP_P = 0, MSP_O = 8192, MSP_ML = 8192 + 16384;
__device__ __forceinline__ void memattn_sample_block(Frame& F, int task) {
    const int hp = task & 1, b = task >> 1, w = F.wave, h = 2 * hp + (w >> 2), kq = w & 3;
    const float* CK = F.in[I_CMK] + ((size_t)b * 256 + 64 * kq) * 512 + h * 128; const float* CV = F.in[I_CMV] + ((size_t)b * 256 + 64 * kq) * 512 + h * 128;
    const bf16_t* QM = (const bf16_t*)(F.ws + WS_QM); bf16_t* OM = (bf16_t*)(F.ws + WS_OM);
    const int lane = F.lane, l15 = lane & 15, g4 = lane >> 4;
    LAS float* pl = (LAS float*)(F.lds + MSP_P) + w * 256; LAS float* po = (LAS float*)(F.lds + MSP_O) + w * 512; LAS float* ml = (LAS float*)(F.lds + MSP_ML);
    __syncthreads();
    bf16x8 qf[4];
#pragma unroll
    for (int kk = 0; kk < 4; ++kk) { qf[kk] = *(const bf16x8*)(QM + (size_t)(TP + 4 * b + (l15 & 3)) * 512 + h * 128 + 32 * kk + 8 * g4); if (l15 >= 4) qf[kk] = (bf16x8){0, 0, 0, 0, 0, 0, 0, 0}; }
    f32x4 s[4]; float mx = -INFINITY;
#pragma unroll
    for (int mt = 0; mt < 4; ++mt) {
        f32x4 acc = {0.f, 0.f, 0.f, 0.f};
#pragma unroll
        for (int kk = 0; kk < 4; ++kk) {
            const float* kp = CK + (size_t)(16 * mt + l15) * 512 + 32 * kk + 8 * g4;
            const u32x4 a = pack8(*(const f32x4*)kp, *(const f32x4*)(kp + 4));
            acc = __builtin_amdgcn_mfma_f32_16x16x32_bf16(__builtin_bit_cast(bf16x8, a), qf[kk], acc, 0, 0, 0);
        }
        s[mt] = acc; mx = fmaxf(fmaxf(mx, fmaxf(acc[0], acc[1])), fmaxf(acc[2], acc[3]));
    }
    mx = fmaxf(mx, __shfl_xor(mx, 16)); mx = fmaxf(mx, __shfl_xor(mx, 32));
    float sum = 0.f;
#pragma unroll
    for (int mt = 0; mt < 4; ++mt)
#pragma unroll
        for (int r = 0; r < 4; ++r) { const float p = __builtin_amdgcn_exp2f(s[mt][r] - mx); sum += p; if (l15 < 4) pl[(16 * mt + 4 * g4 + r) * 4 + l15] = p; }
    sum += __shfl_xor(sum, 16); sum += __shfl_xor(sum, 32);
    if (lane < 4) { ml[w * 8 + lane] = mx; ml[w * 8 + 4 + lane] = sum; }
    LDS_WAIT(); asm volatile("" ::: "memory");
    f32x2 o[4] = {{0.f, 0.f}, {0.f, 0.f}, {0.f, 0.f}, {0.f, 0.f}};
#pragma unroll 16
    for (int m = 0; m < 64; ++m) {
        const f32x2 v = *(const f32x2*)(CV + (size_t)m * 512 + 2 * lane);
        const f32x4 p = *(const LAS f32x4*)(pl + m * 4);
#pragma unroll
        for (int t = 0; t < 4; ++t) { o[t][0] += p[t] * v[0]; o[t][1] += p[t] * v[1]; }
    }
#pragma unroll
    for (int t = 0; t < 4; ++t) *(LAS f32x2*)(po + t * 128 + 2 * lane) = o[t];
    __syncthreads();
    {
        const int hh = F.tid >> 8, t = (F.tid >> 6) & 3, d = 2 * (F.tid & 63);
        float mq[4], M = -INFINITY;
#pragma unroll
        for (int q = 0; q < 4; ++q) { mq[q] = ml[(hh * 4 + q) * 8 + t]; M = fmaxf(M, mq[q]); }
        float den = 0.f; f32x2 num = {0.f, 0.f};
#pragma unroll
        for (int q = 0; q < 4; ++q) { const float f = __builtin_amdgcn_exp2f(mq[q] - M); den += f * ml[(hh * 4 + q) * 8 + 4 + t];
            const f32x2 oq = *(const LAS f32x2*)((LAS float*)(F.lds + MSP_O) + (hh * 4 + q) * 512 + t * 128 + d); num[0] += f * oq[0]; num[1] += f * oq[1]; }
        const float inv = 1.0f / den;
        *(unsigned*)(OM + (size_t)(TP + 4 * b + t) * 512 + (2 * hp + hh) * 128 + d) = cvtpk(num[0] * inv, num[1] * inv);
    }
}

__device__ __forceinline__ void final_norm_row_slabs(float* xrow, const float* slab_row, size_t slab_stride, int ns, const float* w, int lane) {
    f32x4* xr = (f32x4*)xrow + lane; const f32x4* wr = (const f32x4*)w + lane;
    f32x4 v[8]; float s = 0.f;
#pragma unroll
    for (int j = 0; j < 8; ++j) v[j] = xr[64 * j];
    for (int k = 0; k < ns; ++k) { const f32x4* sr = (const f32x4*)(slab_row + (size_t)k * slab_stride) + lane;
#pragma unroll
        for (int j = 0; j < 8; ++j) v[j] += sr[64 * j]; }
#pragma unroll
    for (int j = 0; j < 8; ++j) s += (v[j][0] * v[j][0] + v[j][1] * v[j][1]) + (v[j][2] * v[j][2] + v[j][3] * v[j][3]);
    const float rs = __builtin_amdgcn_rsqf(wave_sum(s) * (1.0f / DM) + RMS_EPS);
#pragma unroll
    for (int j = 0; j < 8; ++j) { const f32x4 ww = wr[64 * j]; f32x4 y; y[0] = v[j][0] * rs * ww[0]; y[1] = v[j][1] * rs * ww[1]; y[2] = v[j][2] * rs * ww[2]; y[3] = v[j][3] * rs * ww[3]; xr[64 * j] = y; }
}
__device__ __forceinline__ void final_norm_row(float* xrow, const float* SS, int row, const float* w, int lane) {
    const float rs = row_rs(SS, row);
    f32x4* xr = (f32x4*)xrow + lane; const f32x4* wr = (const f32x4*)w + lane;
#pragma unroll
    for (int j = 0; j < 8; ++j) { f32x4 v = xr[64 * j]; const f32x4 ww = wr[64 * j]; v[0] = v[0] * rs * ww[0]; v[1] = v[1] * rs * ww[1]; v[2] = v[2] * rs * ww[2]; v[3] = v[3] * rs * ww[3]; xr[64 * j] = v; }
}

#define HGRN_SCAN_PROMPT hgrn_scan
#define HGRN_SCAN_SAMPLE hgrn_scan
#ifdef HY_P3DELAY
#define P3_DELAY do { for (int z_ = 0; z_ < 16; ++z_) __builtin_amdgcn_s_sleep(127); __syncthreads(); } while (0)
#else
#define P3_DELAY do {} while (0)
#endif
#define XB_TMO      128
#define XB_XCNT(j)  (256  + 64 * (j))
#define XB_XSUB(j)  (1280 + 64 * (j))
#define XB_XGEN(j)  (2304 + 64 * (j))
#define XB_TOP      3328
#define XB_TOPGEN   3392
#define XCD_BAR_WORDS 3456
#define XB_SPIN_CAP (1u << 18)

__device__ __forceinline__ unsigned xb_ld(unsigned* p)              { return __hip_atomic_load(p, __ATOMIC_RELAXED, __HIP_MEMORY_SCOPE_AGENT); }
__device__ __forceinline__ unsigned xb_add(unsigned* p, unsigned v) { return __hip_atomic_fetch_add(p, v, __ATOMIC_RELAXED, __HIP_MEMORY_SCOPE_AGENT); }
__device__ __forceinline__ unsigned xb_xcc_id() { return (unsigned)__builtin_amdgcn_s_getreg((3 << 11) | 20) & 0xFu; }
#define XB_SPIN(cond, bar) do { unsigned _sp = 0; while (cond) { __builtin_amdgcn_s_sleep(1); \
    if ((++_sp & 255u) == 0u) { if (xb_ld(&(bar)[XB_TMO])) break; if (_sp > XB_SPIN_CAP) { atomicAdd(&(bar)[XB_TMO], 1u); break; } } } } while (0)

struct XcdBarrier {
    unsigned* bar; unsigned x;
    volatile LAS unsigned* st;
};

__device__ __forceinline__ XcdBarrier xcd_barrier_post(unsigned* bar, volatile LAS unsigned* st) {
    XcdBarrier b; b.bar = bar; b.x = xb_xcc_id(); b.st = st;
    if (threadIdx.x == 0) (void)xb_add(&bar[XB_XCNT(b.x)], 1u);
    return b;
}
__device__ __forceinline__ void xcd_barrier_complete(unsigned* bar, unsigned x, unsigned& nloc, unsigned& nx) {
    const unsigned G = gridDim.x * gridDim.y * gridDim.z;
    unsigned sum, cnt, mine, sp = 0u;
    for (;;) {
        sum = 0u; cnt = 0u; mine = 0u;
#pragma unroll
        for (unsigned j = 0; j < 16; ++j) { const unsigned c = xb_ld(&bar[XB_XCNT(j)]); sum += c; cnt += (c > 0u) ? 1u : 0u; mine = (j == x) ? c : mine; }
        if (sum == G) break;
        __builtin_amdgcn_s_sleep(1);
        if ((++sp & 255u) == 0u) { if (xb_ld(&bar[XB_TMO])) break; if (sp > XB_SPIN_CAP) { atomicAdd(&bar[XB_TMO], 1u); break; } }
    }
    nloc = mine > 0u ? mine : 1u; nx = cnt > 0u ? cnt : 1u;
}

__device__ __forceinline__ void xcd_barrier(const XcdBarrier& b) {
    asm volatile("s_waitcnt vmcnt(0)" ::: "memory");
    __syncthreads();
    if (threadIdx.x == 0) {
        unsigned* bar = b.bar;
        __builtin_amdgcn_s_waitcnt(0);
        unsigned nloc = b.st[0], nx = b.st[1];
        if (nloc == 0u) { xcd_barrier_complete(bar, b.x, nloc, nx); b.st[0] = nloc; b.st[1] = nx; }
        const unsigned old = xb_add(&bar[XB_XSUB(b.x)], 1u);
        const unsigned gen = old / nloc;
        if (old + 1u == (gen + 1u) * nloc) {
            __builtin_amdgcn_fence(__ATOMIC_RELEASE, "agent");
            asm volatile("s_waitcnt vmcnt(0)" ::: "memory");
            const unsigned og = xb_add(&bar[XB_TOP], 1u);
            const unsigned tg = og / nx;
            if (og + 1u == (tg + 1u) * nx) xb_add(&bar[XB_TOPGEN], 1u);
            else XB_SPIN(xb_ld(&bar[XB_TOPGEN]) == tg, bar);
            __builtin_amdgcn_fence(__ATOMIC_ACQUIRE, "agent");
            xb_add(&bar[XB_XGEN(b.x)], 1u);
            asm volatile("s_waitcnt vmcnt(0)" ::: "memory");
        } else {
            XB_SPIN(xb_ld(&bar[XB_XGEN(b.x)]) == gen, bar);
            __builtin_amdgcn_fence(__ATOMIC_ACQUIRE, "agent");
            asm volatile("s_waitcnt vmcnt(0)" ::: "memory");
        }
    }
    __syncthreads();
}

constexpr size_t WS_BAR = 4096;
constexpr int LDS_BARST = LDS_BYTES - 64;
constexpr int N_PHASES = 11;
__global__ void __launch_bounds__(NTHREADS, 2) hymba_fwd(Args args) {
    extern __shared__ __attribute__((aligned(16))) unsigned char lds_raw[];
    cg::grid_group grid = cg::this_grid();
    Frame F;
    F.lds = (LAS unsigned char*)lds_raw;
    F.tid = threadIdx.x; F.lane = F.tid & 63; F.wave = __builtin_amdgcn_readfirstlane(F.tid >> 6);
    F.G = gridDim.x; F.bid = blockIdx.x;
    F.in = args.in; F.out = args.out; F.ws = args.ws;
    unsigned char* ws = args.ws; float* out = args.out;
    if (F.tid < 16) ((LAS unsigned*)(F.lds + LDS_BARST))[F.tid] = 0u;
    __syncthreads();
    XcdBarrier xbar; xbar.bar = (unsigned*)(ws + WS_BAR); xbar.x = 0; xbar.st = (volatile LAS unsigned*)(F.lds + LDS_BARST);
#ifdef HY_LDSCLR
    for (int i = F.tid; i < LDS_BYTES / 16; i += NTHREADS) *(LAS u32x4*)(F.lds + i * 16) = (u32x4){0u, 0u, 0u, 0u};
    __syncthreads();
#endif
    const int lo = args.ph_lo, hi = args.ph_hi;
#ifndef HY_PHASE_MASK
#define HY_PHASE_MASK 0x7ff
#endif
#define IN(k) (((HY_PHASE_MASK >> (k)) & 1) && lo <= (k) && (k) < hi)
#ifndef HY_REPMASK
#define HY_REPMASK 0
#endif
#define PHASE(k, ...) do { if (IN(k)) { __VA_ARGS__ } if (IN(k) && ((HY_REPMASK >> (k)) & 1)) { __VA_ARGS__ } } while (0)
#ifdef HY_XACQ
#define SEAM(k) do { if (IN(k) && IN((k) + 1)) { asm volatile("s_waitcnt vmcnt(0)" ::: "memory"); __builtin_amdgcn_fence(__ATOMIC_RELEASE, "agent"); asm volatile("s_waitcnt vmcnt(0)" ::: "memory"); grid.sync(); __builtin_amdgcn_fence(__ATOMIC_ACQUIRE, "agent"); asm volatile("s_waitcnt vmcnt(0)" ::: "memory"); __syncthreads(); } } while (0)
#else
#define SEAM(k) do { if (IN(k) && IN((k) + 1)) { if ((k) == 0) { grid.sync(); xbar = xcd_barrier_post((unsigned*)(ws + WS_BAR), (volatile LAS unsigned*)(F.lds + LDS_BARST)); } else xcd_barrier(xbar); } } while (0)
#endif
    float* SS0 = (float*)(ws + WS_SS); float* SS1 = (float*)(ws + WS_SS + SS_STRIDE); float* SS2 = (float*)(ws + WS_SS + 2 * SS_STRIDE);
    bf16_t* XB = (bf16_t*)(ws + WS_XB);

    PHASE(0, if (F.bid == 0) { for (int i = F.tid; i < XCD_BAR_WORDS; i += NTHREADS) ((unsigned*)(ws + WS_BAR))[i] = 0u; } p0_prologue(F););
    SEAM(0);
    PHASE(1,
        { pg8::Gemm g{XB, (const bf16_t*)(ws + WS_WIN), TT, NIN, DM, DM}; pg8::StaticOrder S; S.init(TT, NIN, F.G, F.bid);
          EpiIn E{out, out + (size_t)TT * 1024, (bf16_t*)(out + O_SST), (bf16_t*)(ws + WS_GATE), (bf16_t*)(ws + WS_SQ), (bf16_t*)(ws + WS_SKV), (const float*)(ws + WS_TAB), out};
          pg8::gemm_phase<EpiIn, pg8::StaticOrder, true, true>(F.lds, g, S, E); }
        { pg8::Gemm g{(const bf16_t*)(ws + WS_MN), (const bf16_t*)(ws + WS_WMKV), 1024, 1024, DM, DM}; pg8::StaticOrder S; S.init(1024, 1024, F.G, (F.bid + 16) % F.G);
          EpiMemKV E{(bf16_t*)(ws + WS_MK), (bf16_t*)(ws + WS_MVT), out};
          pg8::gemm_phase<EpiMemKV, pg8::StaticOrder, true, true>(F.lds, g, S, E); }
    );
    SEAM(1);
    PHASE(2, hgrn_prep(F););
    SEAM(2);
    PHASE(3,
        const bool split = F.G > 32;
#define P3_SCAN do { if (F.bid < 32) { P3_DELAY; for (int bh = F.bid; bh < 32; bh += F.G) { const int b = bh >> 3, h = bh & 7; \
                HGRN_SCAN_PROMPT(F, b * 256, 256, h, b * SEQ, 16, nullptr, out + O_PST + (size_t)bh * 16384); } } } while (0)
#define P3_OTHERS do { if (!split || F.bid >= 32) { const int nw = split ? F.G - 32 : F.G; \
            for (int i = split ? F.bid - 32 : F.bid; i < 1536; i += nw) { \
                if (i < 256) swa_prompt_unit(F, i); \
                else if (i < 512) swa_sample_unit(F, i - 256); \
                else { const int t = i - 512, b = t >> 3, h = t & 7; \
                    HGRN_SCAN_SAMPLE(F, NCHP + b, 1, h, TP + 4 * b, 4, F.in[I_STATE] + (size_t)t * 16384, out + O_SST + (size_t)t * 16384); } } } } while (0)
        P3_SCAN;
        if ((HY_REPMASK >> 11) & 1) P3_SCAN;
        P3_OTHERS;
        if ((HY_REPMASK >> 12) & 1) P3_OTHERS;
    );
    SEAM(3);
    PHASE(4,
        pg8::Gemm g{(const bf16_t*)(ws + WS_MIX), (const bf16_t*)(ws + WS_WOUT), TT, DM, DM, DM}; pg8::StaticOrder S; S.init(TT, DM, F.G, F.bid);
        EpiResid E{F.in[I_XP], F.in[I_XS], out, XB, SS0};
        pg8::gemm_phase<EpiResid, pg8::StaticOrder, true, true>(F.lds, g, S, E);
    );
    SEAM(4);
    PHASE(5,
        pg8::Gemm g{XB, (const bf16_t*)(ws + WS_WMQ), TT, MEMW, DM, DM}; pg8::StaticOrder S; S.init(TT, MEMW, F.G, F.bid);
        EpiScaleBf16 E{(bf16_t*)(ws + WS_QM), MEMW, SS0, MEM_QSCALE};
        pg8::gemm_phase<EpiScaleBf16, pg8::StaticOrder, true, true>(F.lds, g, S, E);
    );
    SEAM(5);
    PHASE(6,
        for (int u = F.bid; u < 256; u += F.G) memattn_prompt_unit(F, u);
        for (int t = F.bid; t < 256; t += F.G) memattn_sample_block(F, t);
    );
    SEAM(6);
    if (IN(7)) {
        pg8::Gemm g{(const bf16_t*)(ws + WS_OM), (const bf16_t*)(ws + WS_WMO), TT, DM, MEMW, MEMW}; pg8::StaticOrder S; S.init(TT, DM, F.G, F.bid);
        EpiResid E{out, out + (size_t)TP * DM, out, XB, SS1};
        pg8::gemm_phase<EpiResid, pg8::StaticOrder, true, true>(F.lds, g, S, E);
    }
    SEAM(7);
    PHASE(8,
        pg8::Gemm g{XB, (const bf16_t*)(ws + WS_WGU), TT, 2 * FF, DM, DM}; pg8::StaticOrder S; S.init(TT, 2 * FF, F.G, F.bid);
        EpiSwiGLU E{(bf16_t*)(ws + WS_HID), SS1};
        pg8::gemm_phase<EpiSwiGLU, pg8::StaticOrder, true, true>(F.lds, g, S, E);
    );
    SEAM(8);
    constexpr int DN_NS = 11; constexpr size_t SLAB_STRIDE = (size_t)TS * DM;
    if (IN(9)) {
        { pg8::Gemm g{(const bf16_t*)(ws + WS_HID), (const bf16_t*)(ws + WS_WDN), TP, DM, FF, FF}; pg8::StaticOrder S; S.init(TP, DM, F.G, F.bid);
          EpiResid E{out, out + (size_t)TP * DM, out, nullptr, SS2};
          pg8::gemm_phase<EpiResid, pg8::StaticOrder, true, true>(F.lds, g, S, E); }
        { pg8::Gemm g{(const bf16_t*)(ws + WS_HID), (const bf16_t*)(ws + WS_WDN), TT, DM, FF / DN_NS, FF}; SplitOrder S{F.bid, DN_NS};
          EpiSlab E{(float*)(ws + WS_MIX), TP, SLAB_STRIDE};
          pg8::gemm_phase<EpiSlab, SplitOrder, true, true>(F.lds, g, S, E); }
    }
    SEAM(9);
    if (IN(10)) {
        for (int m = F.bid * NWAVES + F.wave; m < TT; m += F.G * NWAVES) {
            if (m < TP) final_norm_row(out + (size_t)m * DM, SS2, m, F.in[I_NFINAL], F.lane);
            else final_norm_row_slabs(out + (size_t)m * DM, (const float*)(ws + WS_MIX) + (size_t)(m - TP) * DM, SLAB_STRIDE, DN_NS, F.in[I_NFINAL], F.lane);
        }
    }
#undef IN
#undef SEAM
}

#ifndef HY_N_LAUNCHES
#define HY_N_LAUNCHES 1
#endif
extern "C" void kernel_launch(void* const* d_in, const int* in_sizes, int n_in, void* d_out, int out_size, void* d_ws, size_t ws_size, hipStream_t stream) {
    static int grid = 0;
    if (grid == 0) {
        if (n_in != 26 || (size_t)out_size != O_END || ws_size < WS_END) { fprintf(stderr, "kernel_launch: unexpected problem: n_in %d out %d ws %zu (need %zu)\n", n_in, out_size, ws_size, (size_t)WS_END); grid = -1; return; }
        int dev = 0, cus = 0, per_cu = 0;
        hipGetDevice(&dev); hipDeviceGetAttribute(&cus, hipDeviceAttributeMultiprocessorCount, dev);
        if (hipFuncSetAttribute((const void*)hymba_fwd, hipFuncAttributeMaxDynamicSharedMemorySize, LDS_BYTES) != hipSuccess) { fprintf(stderr, "kernel_launch: hipFuncSetAttribute failed\n"); grid = -1; return; }
        if (hipOccupancyMaxActiveBlocksPerMultiprocessor(&per_cu, (const void*)hymba_fwd, NTHREADS, LDS_BYTES) != hipSuccess || per_cu < 1) { fprintf(stderr, "kernel_launch: occupancy query says %d blocks/CU\n", per_cu); per_cu = 1; }
        (void)hipGetLastError();
        grid = cus;
        fprintf(stderr, "kernel_launch: %d CUs, occupancy %d blocks/CU, grid %d\n", cus, per_cu, grid);
    }
    if (grid < 0) return;
    Args a{};
    for (int i = 0; i < 26; ++i) a.in[i] = (const float*)d_in[i];
    a.out = (float*)d_out; a.ws = (unsigned char*)d_ws;
#if HY_N_LAUNCHES == 1
    a.ph_lo = 0; a.ph_hi = N_PHASES;
    void* kargs[] = {&a};
    hipError_t e = hipLaunchCooperativeKernel((const void*)hymba_fwd, dim3(grid), dim3(NTHREADS), kargs, LDS_BYTES, stream);
    if (e != hipSuccess) fprintf(stderr, "kernel_launch: cooperative launch failed: %s\n", hipGetErrorString(e));
#else
    for (int p = 0; p < N_PHASES; ++p) {
        a.ph_lo = p; a.ph_hi = p + 1;
        hipLaunchKernelGGL(hymba_fwd, dim3(grid), dim3(NTHREADS), LDS_BYTES, stream, a);
    }
#endif
}
```

```cpp
#include <hip/hip_runtime.h>
#include <hip/hip_cooperative_groups.h>
#include <cstdio>
#include <cstdint>
namespace cg = cooperative_groups;

namespace pg8 {
#define PG8_LAS __attribute__((address_space(3)))
typedef unsigned short bf16_t;
typedef short bf16x8 __attribute__((ext_vector_type(8)));
typedef float f32x4 __attribute__((ext_vector_type(4)));
typedef unsigned u32x4 __attribute__((ext_vector_type(4)));
constexpr int BM = 256, BK = 64, HALF = 128, HTB = HALF * BK * 2  , STAGE_BYTES = 8 * HTB, NXCD = 8, WGM = 8;

__host__ __device__ __forceinline__ int lds_byte(int r, int c) { const int st = (r >> 4) * 2 + (c >> 5), rr = r & 15, cc = c & 31, ob = rr * 64 + cc * 2; return st * 1024 + (ob ^ (((ob >> 9) & 1) << 5)); }
__host__ __device__ __forceinline__ void stage_rc(int b, int& R, int& C) { const int st = b / 1024, sb = b % 1024, swz = sb ^ (((sb >> 9) & 1) << 5); R = (st >> 1) * 16 + swz / 64; C = (st & 1) * 32 + (swz % 64) / 2; }
__host__ __device__ __forceinline__ int perm32(int rho) { const int n = rho >> 4, i = rho & 15; return 8 * (i >> 2) + 4 * n + (i & 3); }

struct Unit { int pm, pn, ks; };
struct Gemm { const bf16_t* A; const bf16_t* Bt; int M, N, K, ld; };

struct StaticOrder {
    int nM, nN, nwg, G, c, ksv = 0;
    __host__ __device__ void init(int M, int N, int G_, int c_) { nM = M / BM; nN = N / BM; nwg = nM * nN; G = G_; c = c_; }
    __host__ __device__ bool next(int i, Unit& u) const {
        const long L = (long)i * G + c; if (L >= nwg) return false;
        int wgid = (int)L; { const int q = nwg / NXCD, r = nwg % NXCD, xcd = wgid % NXCD, off = wgid / NXCD; wgid = (xcd < r ? xcd * (q + 1) : r * (q + 1) + (xcd - r) * q) + off; }
        const int nig = WGM * nN, gid = wgid / nig, fm = gid * WGM, gsz = (nM - fm) < WGM ? (nM - fm) : WGM;
        u.pm = fm + ((wgid % nig) % gsz); u.pn = (wgid % nig) / gsz; u.ks = ksv; return true;
    }
    __device__ __forceinline__ void a_ready(const Unit&) const {}
    __device__ __forceinline__ void done(const Unit&) const {}
};

template <class Epi, class Sched, bool ALIGN_EPI = false, bool SP2 = false>
__device__ __forceinline__ void gemm_phase(PG8_LAS unsigned char* lds, const Gemm g, const Sched& S, const Epi& E) {
    const int tid = threadIdx.x, wid = __builtin_amdgcn_readfirstlane(tid >> 6), lane = tid & 63, wr = wid >> 2, wc = wid & 3, fr = lane & 15, fq = lane >> 4;
    const int K = g.ld, nt = g.K / BK;
    unsigned voffA[2], voffB[2];
#pragma unroll
    for (int i = 0; i < 2; ++i) { int R, C; stage_rc(tid * 16 + i * 8192, R, C); const int Rb = Epi::PERM ? ((R & ~31) + perm32(R & 31)) : R;
        voffA[i] = (unsigned)(R * K + C) * 2u; voffB[i] = (unsigned)(Rb * K + C) * 2u; }
    const size_t kstep = (size_t)(BK * 2);
    const size_t hstep = (size_t)HALF * K * 2;
    const size_t tstep = 2 * hstep;
    const unsigned ldsw = (unsigned)wid * 1024u;
    const int aoff = lds_byte(wr * 64 + fr, fq * 8), boff = lds_byte(wc * 32 + fr, fq * 8);
#define PG8_SA(b, h) (((b) * 2 + (h)) * HTB)
#define PG8_SB(b, h) ((4 + (b) * 2 + (h)) * HTB)
#define PG8_STAGE(bufoff, gbase, voff) do { _Pragma("unroll") for (int _i = 0; _i < 2; ++_i) \
        __builtin_amdgcn_global_load_lds((const unsigned*)((const char*)(gbase) + (voff)[_i]), (PG8_LAS unsigned*)(lds + (bufoff) + ldsw + _i * 8192), 16, 0, 0); } while (0)
#define PG8_LDA(dst, b, h) do { _Pragma("unroll") for (int m = 0; m < 4; ++m) _Pragma("unroll") for (int k = 0; k < 2; ++k) dst[m][k] = *(const PG8_LAS bf16x8*)(lds + PG8_SA(b, h) + aoff + m * 2048 + k * 1024); } while (0)
#define PG8_LDB(dst, b, h) do { _Pragma("unroll") for (int n = 0; n < 2; ++n) _Pragma("unroll") for (int k = 0; k < 2; ++k) dst[n][k] = *(const PG8_LAS bf16x8*)(lds + PG8_SB(b, h) + boff + n * 2048 + k * 1024); } while (0)
#define PG8_MMA(ai, bj, At, Bt) do { __builtin_amdgcn_s_setprio(1); _Pragma("unroll") for (int m = 0; m < 4; ++m) _Pragma("unroll") for (int n = 0; n < 2; ++n) _Pragma("unroll") for (int k = 0; k < 2; ++k) \
        acc[ai][bj][m][n] = __builtin_amdgcn_mfma_f32_16x16x32_bf16(Bt[n][k], At[m][k], acc[ai][bj][m][n], 0, 0, 0); __builtin_amdgcn_s_setprio(0); } while (0)
#define PG8_WAIT_V(n) asm volatile("s_waitcnt vmcnt(" #n ")" ::: "memory")
#define PG8_WAIT_L(n) asm volatile("s_waitcnt lgkmcnt(" #n ")" ::: "memory")
#define PG8_BAR __builtin_amdgcn_s_barrier()
#define PG8_SCHED __builtin_amdgcn_sched_barrier(0)
    Unit cur, nxt; int ui = 0;
    if (!S.next(0, cur)) return;
    f32x4 acc[2][2][4][2];
#pragma unroll
    for (int a = 0; a < 2; ++a)
#pragma unroll
        for (int b = 0; b < 2; ++b)
#pragma unroll
            for (int m = 0; m < 4; ++m)
#pragma unroll
                for (int n = 0; n < 2; ++n) acc[a][b][m][n] = (f32x4){0.f, 0.f, 0.f, 0.f};
    bf16x8 At[4][2], B0[2][2], B1[2][2];
    const char* cA = (const char*)g.A + (size_t)cur.pm * tstep + (size_t)cur.ks * g.K * 2; const char* cB = (const char*)g.Bt + (size_t)cur.pn * tstep + (size_t)cur.ks * g.K * 2;
    S.a_ready(cur);
    if constexpr (SP2) {
        PG8_STAGE(PG8_SB(0, 0), cB, voffB); PG8_STAGE(PG8_SB(0, 1), cB + hstep, voffB); PG8_STAGE(PG8_SA(0, 0), cA, voffA); PG8_STAGE(PG8_SA(0, 1), cA + hstep, voffA);
        if (wr == 1) PG8_BAR;
        PG8_WAIT_V(2); PG8_BAR;
        PG8_STAGE(PG8_SB(1, 0), cB + kstep, voffB); PG8_STAGE(PG8_SA(1, 0), cA + kstep, voffA); PG8_STAGE(PG8_SB(1, 1), cB + hstep + kstep, voffB);
        PG8_WAIT_V(6); PG8_BAR;
    } else {
        PG8_STAGE(PG8_SB(0, 0), cB, voffB); PG8_STAGE(PG8_SA(0, 0), cA, voffA); PG8_STAGE(PG8_SB(0, 1), cB + hstep, voffB); PG8_STAGE(PG8_SA(0, 1), cA + hstep, voffA);
        if (wr == 1) PG8_BAR;
        PG8_WAIT_V(4); PG8_BAR;
        PG8_STAGE(PG8_SB(1, 0), cB + kstep, voffB); PG8_STAGE(PG8_SA(1, 0), cA + kstep, voffA); PG8_STAGE(PG8_SB(1, 1), cB + hstep + kstep, voffB);
        PG8_WAIT_V(6); PG8_BAR;
    }
    for (;;) {
        const bool has_next = S.next(ui + 1, nxt);
        const char* nA = has_next ? (const char*)g.A + (size_t)nxt.pm * tstep + (size_t)nxt.ks * g.K * 2 : cA; const char* nB = has_next ? (const char*)g.Bt + (size_t)nxt.pn * tstep + (size_t)nxt.ks * g.K * 2 : cB;
        for (int t = 0; t < nt; t += 2) {
            const bool last = (t == nt - 2);
            const char* a1 = cA + (size_t)(t + 1) * kstep;
            const char* a2 = last ? nA : cA + (size_t)(t + 2) * kstep; const char* b2 = last ? nB : cB + (size_t)(t + 2) * kstep;
            const char* a3 = a2 + kstep; const char* b3 = b2 + kstep;
            if (last && has_next) S.a_ready(nxt);
            if constexpr (SP2) {
            PG8_LDB(B0, 0, 0); PG8_LDB(B1, 0, 1); PG8_SCHED; PG8_LDA(At, 0, 0); PG8_STAGE(PG8_SA(1, 1), a1 + hstep, voffA);
            PG8_WAIT_V(8); PG8_WAIT_L(0); PG8_BAR; PG8_MMA(0, 0, At, B0); PG8_MMA(0, 1, At, B1); PG8_BAR; PG8_SCHED;
            PG8_LDA(At, 0, 1); PG8_STAGE(PG8_SB(0, 0), b2, voffB); PG8_STAGE(PG8_SB(0, 1), b2 + hstep, voffB); PG8_STAGE(PG8_SA(0, 0), a2, voffA);
            PG8_WAIT_V(8); PG8_WAIT_L(0); PG8_BAR; PG8_MMA(1, 0, At, B0); PG8_MMA(1, 1, At, B1); PG8_BAR; PG8_SCHED;
            PG8_LDB(B0, 1, 0); PG8_LDB(B1, 1, 1); PG8_SCHED; PG8_LDA(At, 1, 0); PG8_STAGE(PG8_SA(0, 1), a2 + hstep, voffA);
            PG8_WAIT_V(8); PG8_WAIT_L(0); PG8_BAR; PG8_MMA(0, 0, At, B0); PG8_MMA(0, 1, At, B1); PG8_BAR; PG8_SCHED;
            PG8_LDA(At, 1, 1); PG8_STAGE(PG8_SB(1, 0), b3, voffB); PG8_STAGE(PG8_SB(1, 1), b3 + hstep, voffB); PG8_STAGE(PG8_SA(1, 0), a3, voffA);
            PG8_WAIT_V(8); PG8_WAIT_L(0); PG8_BAR; PG8_MMA(1, 0, At, B0); PG8_MMA(1, 1, At, B1); PG8_BAR; PG8_SCHED;
            } else {
            PG8_LDB(B0, 0, 0); PG8_SCHED; PG8_LDA(At, 0, 0); PG8_STAGE(PG8_SA(1, 1), a1 + hstep, voffA);
            PG8_WAIT_L(8); PG8_BAR; PG8_WAIT_L(0); PG8_MMA(0, 0, At, B0); PG8_BAR; PG8_SCHED;
            PG8_LDB(B1, 0, 1); PG8_STAGE(PG8_SB(0, 0), b2, voffB);
            PG8_BAR; PG8_WAIT_L(0); PG8_MMA(0, 1, At, B1); PG8_BAR;
            PG8_LDA(At, 0, 1); PG8_STAGE(PG8_SA(0, 0), a2, voffA);
            PG8_BAR; PG8_WAIT_L(0); PG8_MMA(1, 0, At, B0); PG8_BAR; PG8_SCHED;
            PG8_STAGE(PG8_SB(0, 1), b2 + hstep, voffB);
            PG8_WAIT_V(6); PG8_BAR; PG8_MMA(1, 1, At, B1); PG8_BAR;
            PG8_LDB(B0, 1, 0); PG8_SCHED; PG8_LDA(At, 1, 0); PG8_STAGE(PG8_SA(0, 1), a2 + hstep, voffA);
            PG8_WAIT_L(8); PG8_BAR; PG8_WAIT_L(0); PG8_MMA(0, 0, At, B0); PG8_BAR; PG8_SCHED;
            PG8_LDB(B1, 1, 1); PG8_STAGE(PG8_SB(1, 0), b3, voffB);
            PG8_BAR; PG8_WAIT_L(0); PG8_MMA(0, 1, At, B1); PG8_BAR;
            PG8_LDA(At, 1, 1); PG8_STAGE(PG8_SA(1, 0), a3, voffA);
            PG8_BAR; PG8_WAIT_L(0); PG8_MMA(1, 0, At, B0); PG8_BAR; PG8_SCHED;
            PG8_STAGE(PG8_SB(1, 1), b3 + hstep, voffB);
            PG8_WAIT_V(6); PG8_BAR; PG8_MMA(1, 1, At, B1); PG8_BAR;
            }
        }
        if constexpr (ALIGN_EPI) { if (wr == 0) PG8_BAR; }
        if constexpr (!Epi::AFTER_DRAIN) { E(acc, cur, wr, wc, fr, fq); S.done(cur); }
        if (!has_next) break;
#pragma unroll
        for (int a = 0; a < 2; ++a)
#pragma unroll
            for (int b = 0; b < 2; ++b)
#pragma unroll
                for (int m = 0; m < 4; ++m)
#pragma unroll
                    for (int n = 0; n < 2; ++n) acc[a][b][m][n] = (f32x4){0.f, 0.f, 0.f, 0.f};
        cur = nxt; cA = nA; cB = nB; ++ui;
        if constexpr (ALIGN_EPI) { if (wr == 1) PG8_BAR; }
    }
    PG8_WAIT_V(0);
    if constexpr (!ALIGN_EPI) { if (wr == 0) PG8_BAR; }
    PG8_BAR;
    if constexpr (Epi::AFTER_DRAIN) { E.fused(acc, cur, wr, wc, fr, fq, lds, wid, lane); S.done(cur); }
#undef PG8_SA
#undef PG8_SB
#undef PG8_STAGE
#undef PG8_LDA
#undef PG8_LDB
#undef PG8_MMA
#undef PG8_WAIT_V
#undef PG8_WAIT_L
#undef PG8_BAR
#undef PG8_SCHED
}
}

#define LAS __attribute__((address_space(3)))
typedef unsigned short bf16_t;
typedef short bf16x8 __attribute__((ext_vector_type(8)));
typedef short bf16x4 __attribute__((ext_vector_type(4)));
typedef float f32x4 __attribute__((ext_vector_type(4)));
typedef float f32x2 __attribute__((ext_vector_type(2)));
typedef unsigned u32x4 __attribute__((ext_vector_type(4)));
typedef unsigned u32x2 __attribute__((ext_vector_type(2)));
typedef __bf16 hbf16x2 __attribute__((ext_vector_type(2)));

constexpr int DM = 2048, TP = 16384, TS = 512, TT = TP + TS, SEQ = 4096, DB = 128;
constexpr int NIN = 5376, FF = 5632, MEMW = 512;
constexpr int NCHP = TP / 16, NCH = NCHP + DB;
constexpr float RMS_EPS = 1e-6f;
constexpr float LOG2E = 1.4426950408889634f;
constexpr float SWA_QSCALE = 0.125f * LOG2E;
constexpr float MEM_QSCALE = 0.08838834764831845f * LOG2E;
constexpr int NWAVES = 8, NTHREADS = 512;
constexpr int LDS_BYTES = 147456;

constexpr size_t O_YP = 0, O_YS = 33554432, O_PST = 34603008, O_PSK = 35127296, O_PSV = 35192832, O_PMK = 35258368, O_PMV = 35782656,
                 O_SST = 36306944, O_SSK = 53084160, O_SSV = 55181312, O_END = 57278464;
constexpr size_t MiB = 1u << 20;
constexpr size_t WS_TAB = 1 * MiB;
constexpr size_t WS_WIN = 2 * MiB, WS_WOUT = 23 * MiB, WS_WMQ = 31 * MiB, WS_WMKV = 33 * MiB, WS_WMO = 37 * MiB, WS_WGU = 39 * MiB, WS_WDN = 83 * MiB;
constexpr size_t WS_SS = 105 * MiB;
constexpr size_t SS_STRIDE = 2359296;
constexpr size_t WS_MK = 112 * MiB, WS_MVT = 113 * MiB, WS_QM = 114 * MiB, WS_OM = 131 * MiB, WS_MN = 148 * MiB, WS_XB = 152 * MiB;
constexpr size_t WS_D = 218 * MiB;
constexpr size_t WS_GATE = WS_D, WS_SQ = WS_D + 33 * MiB, WS_SKV = WS_D + 66 * MiB, WS_QIN = WS_D + 75 * MiB, WS_KT = WS_D + 111 * MiB, WS_VT = WS_D + 147 * MiB,
                 WS_PSC = WS_D + 183 * MiB, WS_DEC = WS_D + 188 * MiB, WS_MIX = WS_D + 193 * MiB, WS_END = WS_D + 259 * MiB;
constexpr size_t WS_HID = WS_D;
static_assert((size_t)TT * FF * 2 <= 183 * MiB, "HID overlay");

struct Args {
    const float* in[26];
    float* out; unsigned char* ws;
    int ph_lo, ph_hi;
};

__device__ __forceinline__ unsigned cvtpk(float lo, float hi) { f32x2 v = {lo, hi}; hbf16x2 b = __builtin_convertvector(v, hbf16x2); return __builtin_bit_cast(unsigned, b); }
__device__ __forceinline__ float bf2f(unsigned short b) { return __uint_as_float((unsigned)b << 16); }
__device__ __forceinline__ unsigned short f2bf(float f) { return (unsigned short)(cvtpk(f, 0.f) & 0xffffu); }
__device__ __forceinline__ u32x4 pack8(f32x4 a, f32x4 b) { u32x4 w; w.x = cvtpk(a[0], a[1]); w.y = cvtpk(a[2], a[3]); w.z = cvtpk(b[0], b[1]); w.w = cvtpk(b[2], b[3]); return w; }
__device__ __forceinline__ u32x2 pack4(f32x4 a) { u32x2 w; w.x = cvtpk(a[0], a[1]); w.y = cvtpk(a[2], a[3]); return w; }
__device__ __forceinline__ float fexp(float x) { return __builtin_amdgcn_exp2f(x * LOG2E); }
__device__ __forceinline__ float fsigmoid(float x) { return __builtin_amdgcn_rcpf(1.0f + fexp(-x)); }
__device__ __forceinline__ float wave_sum(float v) {
#pragma unroll
    for (int o = 1; o < 64; o <<= 1) v += __shfl_xor(v, o);
    return v;
}
#define LDS_WAIT() asm volatile("s_waitcnt lgkmcnt(0)" ::: "memory")

__device__ __forceinline__ float row_rs(const float* SS, int row) {
    const f32x4* p = (const f32x4*)(SS + (size_t)row * 32);
    f32x4 s = p[0];
#pragma unroll
    for (int i = 1; i < 8; ++i) s += p[i];
    return __builtin_amdgcn_rsqf(((s[0] + s[1]) + (s[2] + s[3])) * (1.0f / DM) + RMS_EPS);
}

using pg8::Unit;
struct EpiIn {
    static constexpr bool PERM = true, AFTER_DRAIN = false;
    float* QF; float* GF; bf16_t* VB; bf16_t* GATE; bf16_t* SQ; bf16_t* SKV; const float* LB; float* out;
    __device__ __forceinline__ void operator()(const f32x4 (&acc)[2][2][4][2], const Unit& u, int wr, int wc, int fr, int fq) const {
        const int pn = u.pn;
#pragma unroll
        for (int ai = 0; ai < 2; ++ai)
#pragma unroll
            for (int m = 0; m < 4; ++m) {
                const int row = u.pm * 256 + ai * 128 + wr * 64 + m * 16 + fr;
#pragma unroll
                for (int bj = 0; bj < 2; ++bj) {
                    const int c = pn * 256 + bj * 128 + wc * 32 + 8 * fq;
                    f32x4 v0 = acc[ai][bj][m][0], v1 = acc[ai][bj][m][1];
                    if (pn < 4) {
                        float* d = QF + (size_t)row * 1024 + c; *(f32x4*)d = v0; *(f32x4*)(d + 4) = v1;
                    } else if (pn < 8) {
                        const int cc = c - 1024;
                        const f32x4 l0 = *(const f32x4*)(LB + cc), l1 = *(const f32x4*)(LB + cc + 4);
#pragma unroll
                        for (int j = 0; j < 4; ++j) { v0[j] = __logf(l0[j] + (1.0f - l0[j]) * fsigmoid(v0[j])); v1[j] = __logf(l1[j] + (1.0f - l1[j]) * fsigmoid(v1[j])); }
                        float* d = GF + (size_t)row * 1024 + cc; *(f32x4*)d = v0; *(f32x4*)(d + 4) = v1;
                    } else if (pn < 12) {
                        *(u32x4*)(VB + (size_t)row * 1024 + (c - 2048)) = pack8(v0, v1);
                    } else if (pn < 16) {
#pragma unroll
                        for (int j = 0; j < 4; ++j) { v0[j] = v0[j] * fsigmoid(v0[j]); v1[j] = v1[j] * fsigmoid(v1[j]); }
                        *(u32x4*)(GATE + (size_t)row * 1024 + (c - 3072)) = pack8(v0, v1);
                    } else if (pn < 20) {
                        *(u32x4*)(SQ + (size_t)row * 1024 + (c - 4096)) = pack8(v0 * SWA_QSCALE, v1 * SWA_QSCALE);
                    } else {
                        const int cc = c - 5120;
                        *(u32x4*)(SKV + (size_t)row * 256 + cc) = pack8(v0, v1);
                        float* d = nullptr;
                        if (row < TP) { const int b = row >> 12, t = row & 4095; if (t >= SEQ - 128) d = out + (bj == 0 ? O_PSK : O_PSV) + (size_t)(b * 128 + (t - (SEQ - 128))) * 128 + (cc & 127); }
                        else { const int rs = row - TP, b = rs >> 2, t = rs & 3; d = out + (bj == 0 ? O_SSK : O_SSV) + (size_t)(b * 128 + 124 + t) * 128 + (cc & 127); }
                        if (d) { *(f32x4*)d = v0; *(f32x4*)(d + 4) = v1; }
                    }
                }
            }
    }
};
struct EpiMemKV {
    static constexpr bool PERM = true, AFTER_DRAIN = false;
    bf16_t* MK; bf16_t* MVT; float* out;
    __device__ __forceinline__ void operator()(const f32x4 (&acc)[2][2][4][2], const Unit& u, int wr, int wc, int fr, int fq) const {
#pragma unroll
        for (int ai = 0; ai < 2; ++ai)
#pragma unroll
            for (int m = 0; m < 4; ++m) {
                const int row = u.pm * 256 + ai * 128 + wr * 64 + m * 16 + fr;
#pragma unroll
                for (int bj = 0; bj < 2; ++bj) {
                    const int c = u.pn * 256 + bj * 128 + wc * 32 + 8 * fq;
                    const f32x4 v0 = acc[ai][bj][m][0], v1 = acc[ai][bj][m][1];
                    if (u.pn < 2) {
                        float* d = out + O_PMK + (size_t)row * 512 + c; *(f32x4*)d = v0; *(f32x4*)(d + 4) = v1;
                        *(u32x4*)(MK + (size_t)row * 512 + c) = pack8(v0, v1);
                    } else {
                        const int cv = c - 512, h = cv >> 7, dd = cv & 127, b = row >> 8, mm = row & 255;
                        float* d = out + O_PMV + (size_t)row * 512 + cv; *(f32x4*)d = v0; *(f32x4*)(d + 4) = v1;
                        bf16_t* t = MVT + ((size_t)((b * 4 + h) * 128 + dd)) * 256 + mm;
#pragma unroll
                        for (int j = 0; j < 4; ++j) { t[(size_t)j * 256] = f2bf(v0[j]); t[(size_t)(j + 4) * 256] = f2bf(v1[j]); }
                    }
                }
            }
    }
};
struct EpiResid {
    static constexpr bool PERM = true, AFTER_DRAIN = false;
    const float* resP; const float* resS; float* X; bf16_t* XB; float* SS;
    __device__ __forceinline__ void operator()(const f32x4 (&acc)[2][2][4][2], const Unit& u, int wr, int wc, int fr, int fq) const {
#pragma unroll
        for (int ai = 0; ai < 2; ++ai)
#pragma unroll
            for (int m = 0; m < 4; ++m) {
                const int row = u.pm * 256 + ai * 128 + wr * 64 + m * 16 + fr;
                const float* rrow = (row < TP) ? resP + (size_t)row * DM : resS + (size_t)(row - TP) * DM;
                float ss = 0.f;
#pragma unroll
                for (int bj = 0; bj < 2; ++bj) {
                    const int c = u.pn * 256 + bj * 128 + wc * 32 + 8 * fq;
                    const f32x4 v0 = acc[ai][bj][m][0] + *(const f32x4*)(rrow + c), v1 = acc[ai][bj][m][1] + *(const f32x4*)(rrow + c + 4);
                    float* d = X + (size_t)row * DM + c; *(f32x4*)d = v0; *(f32x4*)(d + 4) = v1;
                    ss += (v0[0] * v0[0] + v0[1] * v0[1]) + (v0[2] * v0[2] + v0[3] * v0[3]) + (v1[0] * v1[0] + v1[1] * v1[1]) + (v1[2] * v1[2] + v1[3] * v1[3]);
                    if (XB) *(u32x4*)(XB + (size_t)row * DM + c) = pack8(v0, v1);
                }
                ss += __shfl_xor(ss, 16); ss += __shfl_xor(ss, 32);
                if (SS && fq == 0) SS[(size_t)row * 32 + u.pn * 4 + wc] = ss;
            }
    }
};
struct EpiSlab {
    static constexpr bool PERM = true, AFTER_DRAIN = false;
    float* SLAB; int row0; size_t slab_stride;
    __device__ __forceinline__ void operator()(const f32x4 (&acc)[2][2][4][2], const Unit& u, int wr, int wc, int fr, int fq) const {
        float* base = SLAB + (size_t)u.ks * slab_stride;
#pragma unroll
        for (int ai = 0; ai < 2; ++ai)
#pragma unroll
            for (int m = 0; m < 4; ++m) {
                const int row = u.pm * 256 + ai * 128 + wr * 64 + m * 16 + fr - row0;
#pragma unroll
                for (int bj = 0; bj < 2; ++bj) {
                    float* d = base + (size_t)row * DM + u.pn * 256 + bj * 128 + wc * 32 + 8 * fq;
                    *(f32x4*)d = acc[ai][bj][m][0]; *(f32x4*)(d + 4) = acc[ai][bj][m][1];
                }
            }
    }
};
struct SplitOrder {
    int c, ns;
    __device__ bool next(int i, Unit& u) const { if (i > 0 || c >= 16 * ns) return false; const int tile = c / ns; u.pm = TP / 256 + (tile >> 3); u.pn = tile & 7; u.ks = c % ns; return true; }
    __device__ __forceinline__ void a_ready(const Unit&) const {}
    __device__ __forceinline__ void done(const Unit&) const {}
};
struct EpiScaleBf16 {
    static constexpr bool PERM = true, AFTER_DRAIN = false;
    bf16_t* O; int ldc; const float* SS; float scale;
    __device__ __forceinline__ void operator()(const f32x4 (&acc)[2][2][4][2], const Unit& u, int wr, int wc, int fr, int fq) const {
#pragma unroll
        for (int ai = 0; ai < 2; ++ai)
#pragma unroll
            for (int m = 0; m < 4; ++m) {
                const int row = u.pm * 256 + ai * 128 + wr * 64 + m * 16 + fr;
                const float s = row_rs(SS, row) * scale;
#pragma unroll
                for (int bj = 0; bj < 2; ++bj) {
                    const int c = u.pn * 256 + bj * 128 + wc * 32 + 8 * fq;
                    *(u32x4*)(O + (size_t)row * ldc + c) = pack8(acc[ai][bj][m][0] * s, acc[ai][bj][m][1] * s);
                }
            }
    }
};
struct EpiSwiGLU {
    static constexpr bool PERM = true, AFTER_DRAIN = false;
    bf16_t* HID; const float* SS;
    __device__ __forceinline__ void operator()(const f32x4 (&acc)[2][2][4][2], const Unit& u, int wr, int wc, int fr, int fq) const {
#pragma unroll
        for (int ai = 0; ai < 2; ++ai)
#pragma unroll
            for (int m = 0; m < 4; ++m) {
                const int row = u.pm * 256 + ai * 128 + wr * 64 + m * 16 + fr;
                const float s = row_rs(SS, row);
                f32x4 h0, h1;
#pragma unroll
                for (int j = 0; j < 4; ++j) {
                    const float g0 = acc[ai][0][m][0][j] * s, u0 = acc[ai][1][m][0][j] * s, g1 = acc[ai][0][m][1][j] * s, u1 = acc[ai][1][m][1][j] * s;
                    h0[j] = g0 * fsigmoid(g0) * u0; h1[j] = g1 * fsigmoid(g1) * u1;
                }
                *(u32x4*)(HID + (size_t)row * FF + u.pn * 128 + wc * 32 + 8 * fq) = pack8(h0, h1);
            }
    }
};

struct Frame {
    LAS unsigned char* lds;
    int tid, lane, wave, G, bid;
    const float* const* in;
    float* out; unsigned char* ws;
};
enum { I_XP = 0, I_XS, I_STATE, I_CSK, I_CSV, I_CMK, I_CMV, I_MEMP, I_NMIX, I_WIN, I_LB, I_ONORM, I_SINKS, I_RELB, I_WOUT, I_NXATT, I_NMEM,
       I_WMQ, I_WMK, I_WMV, I_WMO, I_NFFN, I_WGATE, I_WUP, I_WDOWN, I_NFINAL };

__device__ __forceinline__ void p0_tr_item(const float* __restrict__ W, int K, int N, bf16_t* WT, int k0, int n0, int drow0, const float* __restrict__ scale, LAS float* scr, int lane) {
#pragma unroll 8
    for (int i = 0; i < 32; ++i) { const int kk = 2 * i + (lane >> 5); float v = W[(size_t)(k0 + kk) * N + n0 + (lane & 31)]; if (scale) v *= scale[k0 + kk]; scr[kk * 33 + (lane & 31)] = v; }
    LDS_WAIT(); asm volatile("" ::: "memory");
    const int c = lane & 7;
#pragma unroll
    for (int j = 0; j < 4; ++j) { const int n = (lane >> 3) + 8 * j; const LAS float* s = scr + (8 * c) * 33 + n;
        u32x4 o; o.x = cvtpk(s[0 * 33], s[1 * 33]); o.y = cvtpk(s[2 * 33], s[3 * 33]); o.z = cvtpk(s[4 * 33], s[5 * 33]); o.w = cvtpk(s[6 * 33], s[7 * 33]);
        *(u32x4*)(WT + (size_t)(drow0 + n) * K + k0 + 8 * c) = o; }
    LDS_WAIT(); asm volatile("" ::: "memory");
}
__device__ __forceinline__ void p0_rms_row(const float* xrow, const float* w, bf16_t* orow, int lane) {
    const f32x4* xr = (const f32x4*)xrow + lane; const f32x4* wr = (const f32x4*)w + lane;
    f32x4 v[8]; float s = 0.f;
#pragma unroll
    for (int j = 0; j < 8; ++j) { v[j] = xr[64 * j]; s += (v[j][0] * v[j][0] + v[j][1] * v[j][1]) + (v[j][2] * v[j][2] + v[j][3] * v[j][3]); }
    const float rs = __builtin_amdgcn_rsqf(wave_sum(s) * (1.0f / DM) + RMS_EPS);
    u32x2* o8 = (u32x2*)orow + lane;
#pragma unroll
    for (int j = 0; j < 8; ++j) { const f32x4 ww = wr[64 * j]; f32x4 y; y[0] = v[j][0] * rs * ww[0]; y[1] = v[j][1] * rs * ww[1]; y[2] = v[j][2] * rs * ww[2]; y[3] = v[j][3] * rs * ww[3]; o8[64 * j] = pack4(y); }
}
__device__ __forceinline__ int rel_bucket(int n) {
    if (n < 16) return n;
    int b = 16 + (int)(__logf((float)n * (1.0f / 16.0f)) / 2.0794415416798357f * 16.0f);
    return b < 31 ? b : 31;
}
__device__ __forceinline__ void p0_prologue(Frame& F) {
    LAS float* scr = (LAS float*)(F.lds + F.wave * 16384);
    const int gw = F.bid * NWAVES + F.wave, NGW = F.G * NWAVES;
    unsigned char* ws = F.ws;
    constexpr int I_IN = 32 * (NIN / 32), I_OUT = 32 * 64, I_MQ = 32 * 16, I_MO = 8 * 64, I_G = 32 * (FF / 32), I_DN = (FF / 64) * 64;
    constexpr int NITEMS = I_IN + I_OUT + 3 * I_MQ + I_MO + 2 * I_G + I_DN;
    for (int it = gw; it < NITEMS; it += NGW) {
        int r = it;
        if (r < I_IN) { const int nb = NIN / 32, kb = r / nb, n0 = (r % nb) * 32; p0_tr_item(F.in[I_WIN], DM, NIN, (bf16_t*)(ws + WS_WIN), kb * 64, n0, n0, nullptr, scr, F.lane); continue; } r -= I_IN;
        if (r < I_OUT) { const int kb = r / 64, n0 = (r % 64) * 32; p0_tr_item(F.in[I_WOUT], DM, DM, (bf16_t*)(ws + WS_WOUT), kb * 64, n0, n0, nullptr, scr, F.lane); continue; } r -= I_OUT;
        if (r < I_MQ) { const int kb = r / 16, n0 = (r % 16) * 32; p0_tr_item(F.in[I_WMQ], DM, MEMW, (bf16_t*)(ws + WS_WMQ), kb * 64, n0, n0, F.in[I_NXATT], scr, F.lane); continue; } r -= I_MQ;
        if (r < I_MQ) { const int kb = r / 16, n0 = (r % 16) * 32; p0_tr_item(F.in[I_WMK], DM, MEMW, (bf16_t*)(ws + WS_WMKV), kb * 64, n0, n0, nullptr, scr, F.lane); continue; } r -= I_MQ;
        if (r < I_MQ) { const int kb = r / 16, n0 = (r % 16) * 32; p0_tr_item(F.in[I_WMV], DM, MEMW, (bf16_t*)(ws + WS_WMKV), kb * 64, n0, 512 + n0, nullptr, scr, F.lane); continue; } r -= I_MQ;
        if (r < I_MO) { const int kb = r / 64, n0 = (r % 64) * 32; p0_tr_item(F.in[I_WMO], MEMW, DM, (bf16_t*)(ws + WS_WMO), kb * 64, n0, n0, nullptr, scr, F.lane); continue; } r -= I_MO;
        if (r < 2 * I_G) { const int up = r >= I_G; if (up) r -= I_G; const int nb = FF / 32, kb = r / nb, n0 = (r % nb) * 32;
            p0_tr_item(F.in[up ? I_WUP : I_WGATE], DM, FF, (bf16_t*)(ws + WS_WGU), kb * 64, n0, (n0 >> 7) * 256 + (n0 & 127) + (up ? 128 : 0), F.in[I_NFFN], scr, F.lane); continue; } r -= 2 * I_G;
        { const int kb = r / 64, n0 = (r % 64) * 32; p0_tr_item(F.in[I_WDOWN], FF, DM, (bf16_t*)(ws + WS_WDN), kb * 64, n0, n0, nullptr, scr, F.lane); }
    }
    for (int m = gw; m < TT + 1024; m += NGW) {
        if (m < TP) p0_rms_row(F.in[I_XP] + (size_t)m * DM, F.in[I_NMIX], (bf16_t*)(ws + WS_XB) + (size_t)m * DM, F.lane);
        else if (m < TT) p0_rms_row(F.in[I_XS] + (size_t)(m - TP) * DM, F.in[I_NMIX], (bf16_t*)(ws + WS_XB) + (size_t)m * DM, F.lane);
        else p0_rms_row(F.in[I_MEMP] + (size_t)(m - TT) * DM, F.in[I_NMEM], (bf16_t*)(ws + WS_MN) + (size_t)(m - TT) * DM, F.lane);
    }
    float* LBt = (float*)(ws + WS_TAB); float* BT = (float*)(ws + WS_TAB + 8192);
    const int gt = F.bid * NTHREADS + F.tid, NGT = F.G * NTHREADS;
    for (int i = gt; i < 1024 + 16 * 160; i += NGT) {
        if (i < 1024) { const float l0 = F.in[I_LB][i], l1 = F.in[I_LB][1024 + i]; LBt[i] = 1.0f / (1.0f + __expf(l1 - l0)); }
        else { const int j = i - 1024, h = j / 160, ix = j % 160, dist = 143 - ix;
            BT[j] = (dist >= 0 && dist < 128) ? F.in[I_RELB][rel_bucket(dist) * 16 + h] * LOG2E : -INFINITY; }
    }
}

constexpr int PREP_RS = 1032;
__device__ __forceinline__ void hgrn_prep(Frame& F) {
    unsigned char* ws = F.ws;
    const float* QF = F.out; const float* GF = F.out + (size_t)TT * 1024; const bf16_t* VB = (const bf16_t*)(F.out + O_SST);
    bf16_t* QIN = (bf16_t*)(ws + WS_QIN); bf16_t* KT = (bf16_t*)(ws + WS_KT); bf16_t* VT = (bf16_t*)(ws + WS_VT); bf16_t* PSC = (bf16_t*)(ws + WS_PSC); float* DEC = (float*)(ws + WS_DEC);
    LAS bf16_t* lq = (LAS bf16_t*)F.lds; LAS bf16_t* lk = lq + 16 * PREP_RS;
    const int l15 = F.lane & 15, g4 = F.lane >> 4;
    for (int ch = F.bid; ch < NCH; ch += F.G) {
        const int nv = ch < NCHP ? 16 : 4; const int row0 = ch < NCHP ? ch * 16 : TP + (ch - NCHP) * 4;
#pragma unroll 1
        for (int pass = 0; pass < 2; ++pass) {
            const int cidx = F.tid + 512 * pass;
            float g[16], q[16]; unsigned short vv[16];
#pragma unroll
            for (int t = 0; t < 16; ++t) {
                if (t < nv) { g[t] = GF[(size_t)(row0 + t) * 1024 + cidx]; q[t] = QF[(size_t)(row0 + t) * 1024 + cidx]; vv[t] = VB[(size_t)(row0 + t) * 1024 + cidx]; }
                else { g[t] = 0.f; q[t] = 0.f; vv[t] = 0; }
            }
            float G = 0.f; unsigned kd[8], vt[8];
#pragma unroll
            for (int t = 0; t < 16; t += 2) {
                float qi[2], kk[2];
#pragma unroll
                for (int z = 0; z < 2; ++z) {
                    const float gt = g[t + z]; G += gt;
                    qi[z] = q[t + z] * fexp(G);
                    kk[z] = (1.0f - fexp(gt)) * fexp(fminf(-G, 80.0f));
                    lq[(t + z) * PREP_RS + cidx] = f2bf(qi[z]); lk[(t + z) * PREP_RS + cidx] = f2bf(kk[z]);
                }
                kd[t >> 1] = cvtpk(kk[0], kk[1]); vt[t >> 1] = (unsigned)vv[t] | ((unsigned)vv[t + 1] << 16);
            }
            DEC[(size_t)ch * 1024 + cidx] = fexp(G);
            u32x4* kp = (u32x4*)(KT + ((size_t)ch * 1024 + cidx) * 16); kp[0] = (u32x4){kd[0], kd[1], kd[2], kd[3]}; kp[1] = (u32x4){kd[4], kd[5], kd[6], kd[7]};
            u32x4* vp = (u32x4*)(VT + ((size_t)ch * 1024 + cidx) * 16); vp[0] = (u32x4){vt[0], vt[1], vt[2], vt[3]}; vp[1] = (u32x4){vt[4], vt[5], vt[6], vt[7]};
        }
        __syncthreads();
#pragma unroll
        for (int i = 0; i < 4; ++i) { const int idx = F.tid + 512 * i, t = idx >> 7, c8 = idx & 127;
            *(u32x4*)(QIN + ((size_t)ch * 16 + t) * 1024 + c8 * 8) = *(const LAS u32x4*)(lq + t * PREP_RS + c8 * 8); }
        {
            const int h = F.wave; f32x4 acc = {0.f, 0.f, 0.f, 0.f};
#pragma unroll
            for (int kk = 0; kk < 4; ++kk) {
                const bf16x8 a = *(const LAS bf16x8*)(lq + l15 * PREP_RS + h * 128 + 32 * kk + 8 * g4);
                const bf16x8 b = *(const LAS bf16x8*)(lk + l15 * PREP_RS + h * 128 + 32 * kk + 8 * g4);
                acc = __builtin_amdgcn_mfma_f32_16x16x32_bf16(a, b, acc, 0, 0, 0);
            }
            bf16_t* pd = PSC + ((size_t)ch * 8 + h) * 256;
#pragma unroll
            for (int r = 0; r < 4; ++r) { const int t = 4 * g4 + r, s = l15; pd[t * 16 + s] = (s <= t) ? f2bf(acc[r]) : (bf16_t)0; }
        }
        __syncthreads();
    }
}

constexpr int SC_QS = 136;
constexpr int SC_QI = 0, SC_KT = 16 * SC_QS * 2, SC_VT = SC_KT + 4096, SC_P = SC_VT + 4096, SC_DEC = SC_P + 512, SC_GATE = SC_DEC + 512, SC_BUF = SC_GATE + 16 * SC_QS * 2;
constexpr int SC_RED = 2 * SC_BUF;
static_assert(SC_RED + 1024 <= LDS_BYTES && SC_BUF % 16 == 0, "scan LDS");
struct ScanPf { u32x4 a, b, c; };
struct ScanSrc { const unsigned char* a; const unsigned char* b; const unsigned char* c; unsigned oa, ob, oc; };
__device__ __forceinline__ ScanSrc scan_src(const Frame& F, int ch0, int h, int grow0, int ngr) {
    const unsigned char* ws = F.ws; const int tid = F.tid; ScanSrc s;
    const bf16_t* QIN = (const bf16_t*)(ws + WS_QIN); const bf16_t* KT = (const bf16_t*)(ws + WS_KT); const bf16_t* VT = (const bf16_t*)(ws + WS_VT);
    const bf16_t* PSC = (const bf16_t*)(ws + WS_PSC); const float* DEC = (const float*)(ws + WS_DEC); const bf16_t* GATE = (const bf16_t*)(ws + WS_GATE);
    if (tid < 256) { const int t = tid >> 4, p = tid & 15;
        s.a = (const unsigned char*)(QIN + ((size_t)ch0 * 16 + t) * 1024 + h * 128 + p * 8); s.oa = SC_QI + (t * SC_QS + p * 8) * 2;
        s.b = (const unsigned char*)(VT + ((size_t)ch0 * 1024 + h * 128) * 16 + tid * 8); s.ob = SC_VT + tid * 16;
    } else { const int i = tid - 256, t = i >> 4, p = i & 15; const int tr = t < ngr ? t : ngr - 1;
        s.a = (const unsigned char*)(KT + ((size_t)ch0 * 1024 + h * 128) * 16 + i * 8); s.oa = SC_KT + i * 16;
        s.b = (const unsigned char*)(GATE + (size_t)(grow0 + tr) * 1024 + h * 128 + p * 8); s.ob = SC_GATE + (t * SC_QS + p * 8) * 2;
    }
    if (tid < 32) { s.c = (const unsigned char*)(PSC + ((size_t)ch0 * 8 + h) * 256 + tid * 8); s.oc = SC_P + tid * 16; }
    else { const int i = (tid - 32) & 31; s.c = (const unsigned char*)(DEC + (size_t)ch0 * 1024 + h * 128 + i * 4); s.oc = SC_DEC + i * 16; }
    return s;
}
__device__ __forceinline__ void scan_fetch(ScanPf& pf, const ScanSrc& s, const Frame& F, int step) {
    pf.a = *(const u32x4*)(s.a + (size_t)step * 32768); pf.b = *(const u32x4*)(s.b + (size_t)step * 32768);
    if (F.tid < 64) pf.c = *(const u32x4*)(s.c + (size_t)step * 4096);
}
__device__ __forceinline__ void scan_stash(const ScanPf& pf, const ScanSrc& s, const Frame& F, int buf) {
    LAS unsigned char* B = F.lds + buf * SC_BUF;
    *(LAS u32x4*)(B + s.oa) = pf.a; *(LAS u32x4*)(B + s.ob) = pf.b;
    if (F.tid < 64) *(LAS u32x4*)(B + s.oc) = pf.c;
}
template <int CTRL> __device__ __forceinline__ float dpp_mov(float v) { return __int_as_float(__builtin_amdgcn_update_dpp(0, __float_as_int(v), CTRL, 0xF, 0xF, true)); }
__device__ __forceinline__ float row16_sum(float v) { v += dpp_mov<0xB1>(v); v += dpp_mov<0x4E>(v); v += dpp_mov<0x141>(v); v += dpp_mov<0x140>(v); return v; }
constexpr int SC_ST = SC_RED + 1024, SC_STS = 132;
static_assert(SC_ST + 128 * SC_STS * 4 <= LDS_BYTES, "scan LDS (state image)");
__device__ __forceinline__ void hgrn_scan(Frame& F, int ch0, int nsteps, int h, int mrow0, int nvalid, const float* S0, float* Sout) {
    const int lane = F.lane, l15 = lane & 15, g4 = lane >> 4, e0 = 16 * F.wave;
    bf16_t* MIX = (bf16_t*)(F.ws + WS_MIX);
    const float onw = F.in[I_ONORM][e0 + l15];
    LAS float* RED = (LAS float*)(F.lds + SC_RED);
    LAS float* ST = (LAS float*)(F.lds + SC_ST);
    ScanPf pf;
    __syncthreads();
    const ScanSrc src = scan_src(F, ch0, h, mrow0, nvalid);
    scan_fetch(pf, src, F, 0); scan_stash(pf, src, F, 0);
    if (nsteps > 1) scan_fetch(pf, src, F, 1);
    f32x4 S[8];
    if (S0) {
#pragma unroll
        for (int i = 0; i < 8; ++i) { const int idx = F.tid + 512 * i, c = idx >> 5, e4 = idx & 31; *(LAS f32x4*)(ST + c * SC_STS + e4 * 4) = *(const f32x4*)(S0 + (size_t)c * 128 + e4 * 4); }
    }
    __syncthreads();
#pragma unroll
    for (int mt = 0; mt < 8; ++mt)
#pragma unroll
        for (int r = 0; r < 4; ++r) S[mt][r] = S0 ? ST[(16 * mt + 4 * g4 + r) * SC_STS + e0 + l15] : 0.f;
    f32x4 o_prev = {0.f, 0.f, 0.f, 0.f}, gate_prev = {0.f, 0.f, 0.f, 0.f};
#pragma unroll 1
    for (int n = 0; n <= nsteps; ++n) {
        const int buf = n & 1;
        f32x4 o = {0.f, 0.f, 0.f, 0.f}, gate = {0.f, 0.f, 0.f, 0.f};
        if (n + 1 < nsteps) {
            scan_stash(pf, src, F, buf ^ 1);
            if (n + 2 < nsteps) scan_fetch(pf, src, F, n + 2);
        }
        if (n < nsteps) {
            const LAS unsigned char* B = F.lds + buf * SC_BUF;
            const bf16x4 vt = *(const LAS bf16x4*)(B + SC_VT + ((e0 + l15) * 16 + 4 * g4) * 2);
            const bf16x4 pa = *(const LAS bf16x4*)(B + SC_P + (l15 * 16 + 4 * g4) * 2);
            f32x4 ob = {0.f, 0.f, 0.f, 0.f};
            o = __builtin_amdgcn_mfma_f32_16x16x16bf16_1k(pa, vt, o, 0, 0, 0);
#pragma unroll
            for (int kk = 0; kk < 4; ++kk) {
                const bf16x4 q0 = *(const LAS bf16x4*)(B + SC_QI + (l15 * SC_QS + 32 * kk + 4 * g4) * 2);
                const bf16x4 q1 = *(const LAS bf16x4*)(B + SC_QI + (l15 * SC_QS + 32 * kk + 16 + 4 * g4) * 2);
                const bf16x8 qa = {q0[0], q0[1], q0[2], q0[3], q1[0], q1[1], q1[2], q1[3]};
                const u32x4 sb = pack8(S[2 * kk], S[2 * kk + 1]);
                if (kk & 1) ob = __builtin_amdgcn_mfma_f32_16x16x32_bf16(qa, __builtin_bit_cast(bf16x8, sb), ob, 0, 0, 0);
                else o = __builtin_amdgcn_mfma_f32_16x16x32_bf16(qa, __builtin_bit_cast(bf16x8, sb), o, 0, 0, 0);
            }
#pragma unroll
            for (int mt = 0; mt < 8; ++mt) {
                const bf16x4 kt = *(const LAS bf16x4*)(B + SC_KT + ((16 * mt + l15) * 16 + 4 * g4) * 2);
                const f32x4 dc = *(const LAS f32x4*)(B + SC_DEC + (16 * mt + 4 * g4) * 4);
                S[mt] = __builtin_amdgcn_mfma_f32_16x16x16bf16_1k(kt, vt, S[mt], 0, 0, 0);
                S[mt] = S[mt] * dc;
            }
            o = o + ob;
#pragma unroll
            for (int r = 0; r < 4; ++r) {
                gate[r] = bf2f(*(const LAS unsigned short*)(B + SC_GATE + ((4 * g4 + r) * SC_QS + e0 + l15) * 2));
                const float ss = row16_sum(o[r] * o[r]);
                if (l15 == 0) RED[(buf * 8 + F.wave) * 16 + 4 * g4 + r] = ss;
            }
        }
        if (n > 0) {
            const int pb = (n - 1) & 1;
#pragma unroll
            for (int r = 0; r < 4; ++r) {
                const int t = 4 * g4 + r; float tot = 0.f;
#pragma unroll
                for (int w = 0; w < 8; ++w) tot += RED[(pb * 8 + w) * 16 + t];
                const float rs = __builtin_amdgcn_rsqf(tot * (1.0f / 128.0f) + RMS_EPS);
                if (t < nvalid) MIX[(size_t)(mrow0 + 16 * (n - 1) + t) * DM + h * 128 + e0 + l15] = f2bf(o_prev[r] * rs * onw * gate_prev[r]);
            }
        }
        o_prev = o; gate_prev = gate;
        __syncthreads();
    }
#pragma unroll
    for (int mt = 0; mt < 8; ++mt)
#pragma unroll
        for (int r = 0; r < 4; ++r) ST[(16 * mt + 4 * g4 + r) * SC_STS + e0 + l15] = S[mt][r];
    __syncthreads();
#pragma unroll
    for (int i = 0; i < 8; ++i) { const int idx = F.tid + 512 * i, c = idx >> 5, e4 = idx & 31; *(f32x4*)(Sout + (size_t)c * 128 + e4 * 4) = *(const LAS f32x4*)(ST + c * SC_STS + e4 * 4); }
}


constexpr int SW_KS = 72, SW_VS = 264;
constexpr int SW_K = 0, SW_V = 256 * SW_KS * 2, SW_BT = SW_V + 64 * SW_VS * 2, SW_END = SW_BT + 8 * 160 * 4;
static_assert(SW_END <= LDS_BYTES, "swa LDS");
__device__ __forceinline__ void swa_qtile(Frame& F, int j, int h, size_t qrow, bool qvalid, bool first_block, float sink2) {
    const int lane = F.lane, l15 = lane & 15, g4 = lane >> 4;
    const bf16_t* SQ = (const bf16_t*)(F.ws + WS_SQ); bf16_t* MIX = (bf16_t*)(F.ws + WS_MIX);
    const LAS bf16_t* Kb = (const LAS bf16_t*)(F.lds + SW_K); const LAS bf16_t* Vt = (const LAS bf16_t*)(F.lds + SW_V);
    const LAS float* BT = (const LAS float*)(F.lds + SW_BT) + F.wave * 160;
    bf16x8 qf[2];
#pragma unroll
    for (int kk = 0; kk < 2; ++kk) qf[kk] = *(const bf16x8*)(SQ + qrow * 1024 + h * 64 + 32 * kk + 8 * g4);
    f32x4 s[9]; float mx = sink2;
    const int bidx = 15 + 4 * g4 - l15;
#pragma unroll
    for (int u = 0; u < 9; ++u) {
        const int mt = j + u; f32x4 acc = {0.f, 0.f, 0.f, 0.f};
#pragma unroll
        for (int kk = 0; kk < 2; ++kk) {
            const bf16x8 a = *(const LAS bf16x8*)(Kb + (16 * mt + l15) * SW_KS + 32 * kk + 8 * g4);
            acc = __builtin_amdgcn_mfma_f32_16x16x32_bf16(a, qf[kk], acc, 0, 0, 0);
        }
        const bool dead = first_block && (mt < 8);
#pragma unroll
        for (int r = 0; r < 4; ++r) { float v = acc[r] + BT[bidx + 16 * u + r]; v = dead ? -INFINITY : v; s[u][r] = v; mx = fmaxf(mx, v); }
    }
    mx = fmaxf(mx, __shfl_xor(mx, 16)); mx = fmaxf(mx, __shfl_xor(mx, 32));
    float sum = 0.f; bf16x4 pb[9];
#pragma unroll
    for (int u = 0; u < 9; ++u) {
        f32x4 p;
#pragma unroll
        for (int r = 0; r < 4; ++r) { p[r] = __builtin_amdgcn_exp2f(s[u][r] - mx); sum += p[r]; }
        pb[u] = __builtin_bit_cast(bf16x4, pack4(p));
    }
    sum += __shfl_xor(sum, 16); sum += __shfl_xor(sum, 32);
    sum += __builtin_amdgcn_exp2f(sink2 - mx);
    const float inv = 1.0f / sum;
#pragma unroll
    for (int dt = 0; dt < 4; ++dt) {
        f32x4 o = {0.f, 0.f, 0.f, 0.f};
#pragma unroll
        for (int u = 0; u < 9; ++u) {
            const bf16x4 a = *(const LAS bf16x4*)(Vt + (16 * dt + l15) * SW_VS + 16 * (j + u) + 4 * g4);
            o = __builtin_amdgcn_mfma_f32_16x16x16bf16_1k(a, pb[u], o, 0, 0, 0);
        }
        if (qvalid) *(u32x2*)(MIX + qrow * DM + 1024 + h * 64 + 16 * dt + 4 * g4) = pack4(o * inv);
    }
}
__device__ __forceinline__ void swa_load_tables(Frame& F, int k) {
    const float* BTg = (const float*)(F.ws + WS_TAB + 8192); LAS float* BT = (LAS float*)(F.lds + SW_BT);
    for (int i = F.tid; i < 8 * 160; i += NTHREADS) BT[i] = BTg[k * 8 * 160 + i];
}
__device__ __forceinline__ void swa_prompt_unit(Frame& F, int unit) {
    const int k = unit & 1, n = (unit >> 1) & 31, b = unit >> 6;
    const bf16_t* SKV = (const bf16_t*)(F.ws + WS_SKV);
    LAS bf16_t* Kb = (LAS bf16_t*)(F.lds + SW_K); LAS bf16_t* Vt = (LAS bf16_t*)(F.lds + SW_V);
    __syncthreads();
    swa_load_tables(F, k);
#pragma unroll
    for (int i = 0; i < 4; ++i) {
        const int idx = F.tid + 512 * i, kj = idx >> 3, p = idx & 7, pos = 128 * (n - 1) + kj;
        u32x4 kv = {0u, 0u, 0u, 0u}, vv = {0u, 0u, 0u, 0u};
        if (pos >= 0) { const bf16_t* src = SKV + (size_t)(b * SEQ + pos) * 256 + k * 64 + p * 8; kv = *(const u32x4*)src; vv = *(const u32x4*)(src + 128); }
        *(LAS u32x4*)(Kb + kj * SW_KS + p * 8) = kv;
        const unsigned w[4] = {vv.x, vv.y, vv.z, vv.w};
#pragma unroll
        for (int e = 0; e < 4; ++e) { Vt[(8 * p + 2 * e) * SW_VS + kj] = (bf16_t)(w[e] & 0xffffu); Vt[(8 * p + 2 * e + 1) * SW_VS + kj] = (bf16_t)(w[e] >> 16); }
    }
    __syncthreads();
    const int h = k * 8 + F.wave; const float sink2 = F.in[I_SINKS][h] * LOG2E;
#pragma unroll 1
    for (int j = 0; j < 8; ++j) swa_qtile(F, j, h, (size_t)(b * SEQ + 128 * n + 16 * j + (F.lane & 15)), true, n == 0, sink2);
}
__device__ __forceinline__ void swa_sample_unit(Frame& F, int unit) {
    const int k = unit & 1, b = unit >> 1;
    const bf16_t* SKV = (const bf16_t*)(F.ws + WS_SKV);
    LAS bf16_t* Kb = (LAS bf16_t*)(F.lds + SW_K); LAS bf16_t* Vt = (LAS bf16_t*)(F.lds + SW_V);
    __syncthreads();
    swa_load_tables(F, k);
#pragma unroll
    for (int i = 0; i < 4; ++i) {
        const int idx = F.tid + 512 * i, kj = idx >> 4, p = idx & 15;
        const size_t so = ((size_t)(b * 128 + kj) * 2 + k) * 64 + p * 4;
        const f32x4 kv = *(const f32x4*)(F.in[I_CSK] + so), vv = *(const f32x4*)(F.in[I_CSV] + so);
        *(LAS u32x2*)(Kb + kj * SW_KS + p * 4) = pack4(kv);
#pragma unroll
        for (int e = 0; e < 4; ++e) Vt[(4 * p + e) * SW_VS + kj] = f2bf(vv[e]);
        if (kj >= 4) { const size_t dof = ((size_t)(b * 128 + kj - 4) * 2 + k) * 64 + p * 4; *(f32x4*)(F.out + O_SSK + dof) = kv; *(f32x4*)(F.out + O_SSV + dof) = vv; }
    }
    if (F.tid < 128) {
        const int kj = 128 + (F.tid >> 3), p = F.tid & 7;
        u32x4 kv = {0u, 0u, 0u, 0u}, vv = {0u, 0u, 0u, 0u};
        if (kj < 132) { const bf16_t* src = SKV + (size_t)(TP + 4 * b + (kj - 128)) * 256 + k * 64 + p * 8; kv = *(const u32x4*)src; vv = *(const u32x4*)(src + 128); }
        *(LAS u32x4*)(Kb + kj * SW_KS + p * 8) = kv;
        const unsigned w[4] = {vv.x, vv.y, vv.z, vv.w};
#pragma unroll
        for (int e = 0; e < 4; ++e) { Vt[(8 * p + 2 * e) * SW_VS + kj] = (bf16_t)(w[e] & 0xffffu); Vt[(8 * p + 2 * e + 1) * SW_VS + kj] = (bf16_t)(w[e] >> 16); }
    }
    __syncthreads();
    const int h = k * 8 + F.wave, l15 = F.lane & 15; const float sink2 = F.in[I_SINKS][h] * LOG2E;
    swa_qtile(F, 0, h, (size_t)(TP + 4 * b + (l15 < 4 ? l15 : 3)), l15 < 4, false, sink2);
}

constexpr int MA_KS = 136, MA_VS = 264;
constexpr int MA_K = 0, MA_V = 256 * MA_KS * 2, MA_END = MA_V + 128 * MA_VS * 2;
static_assert(MA_END <= LDS_BYTES, "memattn LDS");
__device__ __forceinline__ void memattn_prompt_unit(Frame& F, int unit) {
    const int h = unit & 3, pm = unit >> 2, b = pm >> 4;
    const bf16_t* MK = (const bf16_t*)(F.ws + WS_MK); const bf16_t* MVT = (const bf16_t*)(F.ws + WS_MVT);
    const bf16_t* QM = (const bf16_t*)(F.ws + WS_QM); bf16_t* OM = (bf16_t*)(F.ws + WS_OM);
    LAS bf16_t* Kh = (LAS bf16_t*)(F.lds + MA_K); LAS bf16_t* Vt = (LAS bf16_t*)(F.lds + MA_V);
    const int lane = F.lane, l15 = lane & 15, g4 = lane >> 4;
    __syncthreads();
#pragma unroll
    for (int i = 0; i < 8; ++i) {
        const int idx = F.tid + 512 * i;
        { const int m = idx >> 4, p = idx & 15; *(LAS u32x4*)(Kh + m * MA_KS + p * 8) = *(const u32x4*)(MK + (size_t)(b * 256 + m) * 512 + h * 128 + p * 8); }
        { const int d = idx >> 5, p = idx & 31; *(LAS u32x4*)(Vt + d * MA_VS + p * 8) = *(const u32x4*)(MVT + ((size_t)(b * 4 + h) * 128 + d) * 256 + p * 8); }
    }
    __syncthreads();
#pragma unroll 1
    for (int jj = 0; jj < 2; ++jj) {
        const size_t row = (size_t)pm * 256 + 16 * (2 * F.wave + jj) + l15;
        bf16x8 qf[4];
#pragma unroll
        for (int kk = 0; kk < 4; ++kk) qf[kk] = *(const bf16x8*)(QM + row * 512 + h * 128 + 32 * kk + 8 * g4);
        f32x4 s[16]; float mx = -INFINITY;
#pragma unroll
        for (int mt = 0; mt < 16; ++mt) {
            f32x4 acc = {0.f, 0.f, 0.f, 0.f};
#pragma unroll
            for (int kk = 0; kk < 4; ++kk) {
                const bf16x8 a = *(const LAS bf16x8*)(Kh + (16 * mt + l15) * MA_KS + 32 * kk + 8 * g4);
                acc = __builtin_amdgcn_mfma_f32_16x16x32_bf16(a, qf[kk], acc, 0, 0, 0);
            }
            s[mt] = acc; mx = fmaxf(fmaxf(mx, fmaxf(acc[0], acc[1])), fmaxf(acc[2], acc[3]));
            __builtin_amdgcn_sched_barrier(0);
        }
        mx = fmaxf(mx, __shfl_xor(mx, 16)); mx = fmaxf(mx, __shfl_xor(mx, 32));
        float sum = 0.f; bf16x8 pb[8];
#pragma unroll
        for (int i = 0; i < 8; ++i) {
            f32x4 p0, p1;
#pragma unroll
            for (int r = 0; r < 4; ++r) { p0[r] = __builtin_amdgcn_exp2f(s[2 * i][r] - mx); p1[r] = __builtin_amdgcn_exp2f(s[2 * i + 1][r] - mx); sum += p0[r] + p1[r]; }
            pb[i] = __builtin_bit_cast(bf16x8, pack8(p0, p1));
        }
        sum += __shfl_xor(sum, 16); sum += __shfl_xor(sum, 32);
        const float inv = 1.0f / sum;
#pragma unroll
        for (int dt = 0; dt < 8; ++dt) {
            f32x4 o = {0.f, 0.f, 0.f, 0.f};
#pragma unroll
            for (int i = 0; i < 8; ++i) {
                const bf16x4 a0 = *(const LAS bf16x4*)(Vt + (16 * dt + l15) * MA_VS + 32 * i + 4 * g4);
                const bf16x4 a1 = *(const LAS bf16x4*)(Vt + (16 * dt + l15) * MA_VS + 32 * i + 16 + 4 * g4);
                const bf16x8 a = {a0[0], a0[1], a0[2], a0[3], a1[0], a1[1], a1[2], a1[3]};
                o = __builtin_amdgcn_mfma_f32_16x16x32_bf16(a, pb[i], o, 0, 0, 0);
            }
            *(u32x2*)(OM + row * 512 + h * 128 + 16 * dt + 4 * g4) = pack4(o * inv);
            __builtin_amdgcn_sched_barrier(0);
        }
    }
}
constexpr int MSP_P = 0, MSP_O = 8192, MSP_ML = 8192 + 16384;
__device__ __forceinline__ void memattn_sample_block(Frame& F, int task) {
    const int hp = task & 1, b = task >> 1, w = F.wave, h = 2 * hp + (w >> 2), kq = w & 3;
    const float* CK = F.in[I_CMK] + ((size_t)b * 256 + 64 * kq) * 512 + h * 128; const float* CV = F.in[I_CMV] + ((size_t)b * 256 + 64 * kq) * 512 + h * 128;
    const bf16_t* QM = (const bf16_t*)(F.ws + WS_QM); bf16_t* OM = (bf16_t*)(F.ws + WS_OM);
    const int lane = F.lane, l15 = lane & 15, g4 = lane >> 4;
    LAS float* pl = (LAS float*)(F.lds + MSP_P) + w * 256; LAS float* po = (LAS float*)(F.lds + MSP_O) + w * 512; LAS float* ml = (LAS float*)(F.lds + MSP_ML);
    __syncthreads();
    bf16x8 qf[4];
#pragma unroll
    for (int kk = 0; kk < 4; ++kk) { qf[kk] = *(const bf16x8*)(QM + (size_t)(TP + 4 * b + (l15 & 3)) * 512 + h * 128 + 32 * kk + 8 * g4); if (l15 >= 4) qf[kk] = (bf16x8){0, 0, 0, 0, 0, 0, 0, 0}; }
    f32x4 s[4]; float mx = -INFINITY;
#pragma unroll
    for (int mt = 0; mt < 4; ++mt) {
        f32x4 acc = {0.f, 0.f, 0.f, 0.f};
#pragma unroll
        for (int kk = 0; kk < 4; ++kk) {
            const float* kp = CK + (size_t)(16 * mt + l15) * 512 + 32 * kk + 8 * g4;
            const u32x4 a = pack8(*(const f32x4*)kp, *(const f32x4*)(kp + 4));
            acc = __builtin_amdgcn_mfma_f32_16x16x32_bf16(__builtin_bit_cast(bf16x8, a), qf[kk], acc, 0, 0, 0);
        }
        s[mt] = acc; mx = fmaxf(fmaxf(mx, fmaxf(acc[0], acc[1])), fmaxf(acc[2], acc[3]));
    }
    mx = fmaxf(mx, __shfl_xor(mx, 16)); mx = fmaxf(mx, __shfl_xor(mx, 32));
    float sum = 0.f;
#pragma unroll
    for (int mt = 0; mt < 4; ++mt)
#pragma unroll
        for (int r = 0; r < 4; ++r) { const float p = __builtin_amdgcn_exp2f(s[mt][r] - mx); sum += p; if (l15 < 4) pl[(16 * mt + 4 * g4 + r) * 4 + l15] = p; }
    sum += __shfl_xor(sum, 16); sum += __shfl_xor(sum, 32);
    if (lane < 4) { ml[w * 8 + lane] = mx; ml[w * 8 + 4 + lane] = sum; }
    LDS_WAIT(); asm volatile("" ::: "memory");
    f32x2 o[4] = {{0.f, 0.f}, {0.f, 0.f}, {0.f, 0.f}, {0.f, 0.f}};
#pragma unroll 16
    for (int m = 0; m < 64; ++m) {
        const f32x2 v = *(const f32x2*)(CV + (size_t)m * 512 + 2 * lane);
        const f32x4 p = *(const LAS f32x4*)(pl + m * 4);
#pragma unroll
        for (int t = 0; t < 4; ++t) { o[t][0] += p[t] * v[0]; o[t][1] += p[t] * v[1]; }
    }
#pragma unroll
    for (int t = 0; t < 4; ++t) *(LAS f32x2*)(po + t * 128 + 2 * lane) = o[t];
    __syncthreads();
    {
        const int hh = F.tid >> 8, t = (F.tid >> 6) & 3, d = 2 * (F.tid & 63);
        float mq[4], M = -INFINITY;
#pragma unroll
        for (int q = 0; q < 4; ++q) { mq[q] = ml[(hh * 4 + q) * 8 + t]; M = fmaxf(M, mq[q]); }
        float den = 0.f; f32x2 num = {0.f, 0.f};
#pragma unroll
        for (int q = 0; q < 4; ++q) { const float f = __builtin_amdgcn_exp2f(mq[q] - M); den += f * ml[(hh * 4 + q) * 8 + 4 + t];
            const f32x2 oq = *(const LAS f32x2*)((LAS float*)(F.lds + MSP_O) + (hh * 4 + q) * 512 + t * 128 + d); num[0] += f * oq[0]; num[1] += f * oq[1]; }
        const float inv = 1.0f / den;
        *(unsigned*)(OM + (size_t)(TP + 4 * b + t) * 512 + (2 * hp + hh) * 128 + d) = cvtpk(num[0] * inv, num[1] * inv);
    }
}

__device__ __forceinline__ void final_norm_row_slabs(float* xrow, const float* slab_row, size_t slab_stride, int ns, const float* w, int lane) {
    f32x4* xr = (f32x4*)xrow + lane; const f32x4* wr = (const f32x4*)w + lane;
    f32x4 v[8]; float s = 0.f;
#pragma unroll
    for (int j = 0; j < 8; ++j) v[j] = xr[64 * j];
    for (int k = 0; k < ns; ++k) { const f32x4* sr = (const f32x4*)(slab_row + (size_t)k * slab_stride) + lane;
#pragma unroll
        for (int j = 0; j < 8; ++j) v[j] += sr[64 * j]; }
#pragma unroll
    for (int j = 0; j < 8; ++j) s += (v[j][0] * v[j][0] + v[j][1] * v[j][1]) + (v[j][2] * v[j][2] + v[j][3] * v[j][3]);
    const float rs = __builtin_amdgcn_rsqf(wave_sum(s) * (1.0f / DM) + RMS_EPS);
#pragma unroll
    for (int j = 0; j < 8; ++j) { const f32x4 ww = wr[64 * j]; f32x4 y; y[0] = v[j][0] * rs * ww[0]; y[1] = v[j][1] * rs * ww[1]; y[2] = v[j][2] * rs * ww[2]; y[3] = v[j][3] * rs * ww[3]; xr[64 * j] = y; }
}
__device__ __forceinline__ void final_norm_row(float* xrow, const float* SS, int row, const float* w, int lane) {
    const float rs = row_rs(SS, row);
    f32x4* xr = (f32x4*)xrow + lane; const f32x4* wr = (const f32x4*)w + lane;
#pragma unroll
    for (int j = 0; j < 8; ++j) { f32x4 v = xr[64 * j]; const f32x4 ww = wr[64 * j]; v[0] = v[0] * rs * ww[0]; v[1] = v[1] * rs * ww[1]; v[2] = v[2] * rs * ww[2]; v[3] = v[3] * rs * ww[3]; xr[64 * j] = v; }
}

#define HGRN_SCAN_PROMPT hgrn_scan
#define HGRN_SCAN_SAMPLE hgrn_scan
#ifdef HY_P3DELAY
#define P3_DELAY do { for (int z_ = 0; z_ < 16; ++z_) __builtin_amdgcn_s_sleep(127); __syncthreads(); } while (0)
#else
#define P3_DELAY do {} while (0)
#endif
#define XB_TMO      128
#define XB_XCNT(j)  (256  + 64 * (j))
#define XB_XSUB(j)  (1280 + 64 * (j))
#define XB_XGEN(j)  (2304 + 64 * (j))
#define XB_TOP      3328
#define XB_TOPGEN   3392
#define XCD_BAR_WORDS 3456
#define XB_SPIN_CAP (1u << 18)

__device__ __forceinline__ unsigned xb_ld(unsigned* p)              { return __hip_atomic_load(p, __ATOMIC_RELAXED, __HIP_MEMORY_SCOPE_AGENT); }
__device__ __forceinline__ unsigned xb_add(unsigned* p, unsigned v) { return __hip_atomic_fetch_add(p, v, __ATOMIC_RELAXED, __HIP_MEMORY_SCOPE_AGENT); }
__device__ __forceinline__ unsigned xb_xcc_id() { return (unsigned)__builtin_amdgcn_s_getreg((3 << 11) | 20) & 0xFu; }
#define XB_SPIN(cond, bar) do { unsigned _sp = 0; while (cond) { __builtin_amdgcn_s_sleep(1); \
    if ((++_sp & 255u) == 0u) { if (xb_ld(&(bar)[XB_TMO])) break; if (_sp > XB_SPIN_CAP) { atomicAdd(&(bar)[XB_TMO], 1u); break; } } } } while (0)

struct XcdBarrier {
    unsigned* bar; unsigned x;
    volatile LAS unsigned* st;
};

__device__ __forceinline__ XcdBarrier xcd_barrier_post(unsigned* bar, volatile LAS unsigned* st) {
    XcdBarrier b; b.bar = bar; b.x = xb_xcc_id(); b.st = st;
    if (threadIdx.x == 0) (void)xb_add(&bar[XB_XCNT(b.x)], 1u);
    return b;
}
__device__ __forceinline__ void xcd_barrier_complete(unsigned* bar, unsigned x, unsigned& nloc, unsigned& nx) {
    const unsigned G = gridDim.x * gridDim.y * gridDim.z;
    unsigned sum, cnt, mine, sp = 0u;
    for (;;) {
        sum = 0u; cnt = 0u; mine = 0u;
#pragma unroll
        for (unsigned j = 0; j < 16; ++j) { const unsigned c = xb_ld(&bar[XB_XCNT(j)]); sum += c; cnt += (c > 0u) ? 1u : 0u; mine = (j == x) ? c : mine; }
        if (sum == G) break;
        __builtin_amdgcn_s_sleep(1);
        if ((++sp & 255u) == 0u) { if (xb_ld(&bar[XB_TMO])) break; if (sp > XB_SPIN_CAP) { atomicAdd(&bar[XB_TMO], 1u); break; } }
    }
    nloc = mine > 0u ? mine : 1u; nx = cnt > 0u ? cnt : 1u;
}

__device__ __forceinline__ void xcd_barrier(const XcdBarrier& b) {
    asm volatile("s_waitcnt vmcnt(0)" ::: "memory");
    __syncthreads();
    if (threadIdx.x == 0) {
        unsigned* bar = b.bar;
        __builtin_amdgcn_s_waitcnt(0);
        unsigned nloc = b.st[0], nx = b.st[1];
        if (nloc == 0u) { xcd_barrier_complete(bar, b.x, nloc, nx); b.st[0] = nloc; b.st[1] = nx; }
        const unsigned old = xb_add(&bar[XB_XSUB(b.x)], 1u);
        const unsigned gen = old / nloc;
        if (old + 1u == (gen + 1u) * nloc) {
            __builtin_amdgcn_fence(__ATOMIC_RELEASE, "agent");
            asm volatile("s_waitcnt vmcnt(0)" ::: "memory");
            const unsigned og = xb_add(&bar[XB_TOP], 1u);
            const unsigned tg = og / nx;
            if (og + 1u == (tg + 1u) * nx) xb_add(&bar[XB_TOPGEN], 1u);
            else XB_SPIN(xb_ld(&bar[XB_TOPGEN]) == tg, bar);
            __builtin_amdgcn_fence(__ATOMIC_ACQUIRE, "agent");
            xb_add(&bar[XB_XGEN(b.x)], 1u);
            asm volatile("s_waitcnt vmcnt(0)" ::: "memory");
        } else {
            XB_SPIN(xb_ld(&bar[XB_XGEN(b.x)]) == gen, bar);
            __builtin_amdgcn_fence(__ATOMIC_ACQUIRE, "agent");
            asm volatile("s_waitcnt vmcnt(0)" ::: "memory");
        }
    }
    __syncthreads();
}

constexpr size_t WS_CNT = 4096 + 16384;
constexpr size_t WS_BAR = 4096;
constexpr int LDS_BARST = LDS_BYTES - 64;
constexpr int N_PHASES = 11;
__global__ void __launch_bounds__(NTHREADS, 2) hymba_fwd(Args args) {
    extern __shared__ __attribute__((aligned(16))) unsigned char lds_raw[];
    cg::grid_group grid = cg::this_grid();
    Frame F;
    F.lds = (LAS unsigned char*)lds_raw;
    F.tid = threadIdx.x; F.lane = F.tid & 63; F.wave = __builtin_amdgcn_readfirstlane(F.tid >> 6);
    F.G = gridDim.x; F.bid = blockIdx.x;
    F.in = args.in; F.out = args.out; F.ws = args.ws;
    unsigned char* ws = args.ws; float* out = args.out;
    if (F.tid < 16) ((LAS unsigned*)(F.lds + LDS_BARST))[F.tid] = 0u;
    __syncthreads();
    XcdBarrier xbar = xcd_barrier_post((unsigned*)(ws + WS_BAR), (volatile LAS unsigned*)(F.lds + LDS_BARST));
    if (args.ph_lo > 1000) grid.sync();
#ifdef HY_LDSCLR
    for (int i = F.tid; i < LDS_BYTES / 16; i += NTHREADS) *(LAS u32x4*)(F.lds + i * 16) = (u32x4){0u, 0u, 0u, 0u};
    __syncthreads();
#endif
    const int lo = args.ph_lo, hi = args.ph_hi;
#ifndef HY_PHASE_MASK
#define HY_PHASE_MASK 0x7ff
#endif
#define IN(k) (((HY_PHASE_MASK >> (k)) & 1) && lo <= (k) && (k) < hi)
#ifndef HY_REPMASK
#define HY_REPMASK 0
#endif
#define PHASE(k, ...) do { if (IN(k)) { __VA_ARGS__ } if (IN(k) && ((HY_REPMASK >> (k)) & 1)) { __VA_ARGS__ } } while (0)
#ifdef HY_XACQ
#define SEAM(k) do { if (IN(k) && IN((k) + 1)) { asm volatile("s_waitcnt vmcnt(0)" ::: "memory"); __builtin_amdgcn_fence(__ATOMIC_RELEASE, "agent"); asm volatile("s_waitcnt vmcnt(0)" ::: "memory"); grid.sync(); __builtin_amdgcn_fence(__ATOMIC_ACQUIRE, "agent"); asm volatile("s_waitcnt vmcnt(0)" ::: "memory"); __syncthreads(); } } while (0)
#else
#define SEAM(k) do { if (IN(k) && IN((k) + 1)) { xcd_barrier(xbar); } } while (0)
#endif
    float* SS0 = (float*)(ws + WS_SS); float* SS1 = (float*)(ws + WS_SS + SS_STRIDE); float* SS2 = (float*)(ws + WS_SS + 2 * SS_STRIDE);
    bf16_t* XB = (bf16_t*)(ws + WS_XB);

    PHASE(0, p0_prologue(F););
    SEAM(0);
    PHASE(1,
        { pg8::Gemm g{XB, (const bf16_t*)(ws + WS_WIN), TT, NIN, DM, DM}; pg8::StaticOrder S; S.init(TT, NIN, F.G, F.bid);
          EpiIn E{out, out + (size_t)TT * 1024, (bf16_t*)(out + O_SST), (bf16_t*)(ws + WS_GATE), (bf16_t*)(ws + WS_SQ), (bf16_t*)(ws + WS_SKV), (const float*)(ws + WS_TAB), out};
          pg8::gemm_phase<EpiIn, pg8::StaticOrder, true, true>(F.lds, g, S, E); }
        { pg8::Gemm g{(const bf16_t*)(ws + WS_MN), (const bf16_t*)(ws + WS_WMKV), 1024, 1024, DM, DM}; pg8::StaticOrder S; S.init(1024, 1024, F.G, (F.bid + 16) % F.G);
          EpiMemKV E{(bf16_t*)(ws + WS_MK), (bf16_t*)(ws + WS_MVT), out};
          pg8::gemm_phase<EpiMemKV, pg8::StaticOrder, true, true>(F.lds, g, S, E); }
    );
    SEAM(1);
    PHASE(2, hgrn_prep(F););
    SEAM(2);
    PHASE(3,
        const bool split = F.G > 32;
#define P3_SCAN do { if (F.bid < 32) { P3_DELAY; for (int bh = F.bid; bh < 32; bh += F.G) { const int b = bh >> 3, h = bh & 7; \
                HGRN_SCAN_PROMPT(F, b * 256, 256, h, b * SEQ, 16, nullptr, out + O_PST + (size_t)bh * 16384); } } } while (0)
#define P3_OTHERS do { if (!split || F.bid >= 32) { const int nw = split ? F.G - 32 : F.G; \
            for (int i = split ? F.bid - 32 : F.bid; i < 1536; i += nw) { \
                if (i < 256) swa_prompt_unit(F, i); \
                else if (i < 512) swa_sample_unit(F, i - 256); \
                else { const int t = i - 512, b = t >> 3, h = t & 7; \
                    HGRN_SCAN_SAMPLE(F, NCHP + b, 1, h, TP + 4 * b, 4, F.in[I_STATE] + (size_t)t * 16384, out + O_SST + (size_t)t * 16384); } } } } while (0)
        P3_SCAN;
        if ((HY_REPMASK >> 11) & 1) P3_SCAN;
        P3_OTHERS;
        if (split && F.bid >= 32) {
            const int nw = F.G - 32; unsigned* CNT = (unsigned*)(ws + WS_CNT);
            asm volatile("s_waitcnt vmcnt(0)" ::: "memory"); __syncthreads();
            if (F.tid == 0) {
                __builtin_amdgcn_fence(__ATOMIC_RELEASE, "agent"); asm volatile("s_waitcnt vmcnt(0)" ::: "memory");
                __hip_atomic_fetch_add(CNT, 1u, __ATOMIC_RELAXED, __HIP_MEMORY_SCOPE_AGENT);
                unsigned sp = 0; while (__hip_atomic_load(CNT, __ATOMIC_RELAXED, __HIP_MEMORY_SCOPE_AGENT) < (unsigned)nw) { __builtin_amdgcn_s_sleep(2); if (++sp > (1u << 22)) break; }
                __builtin_amdgcn_fence(__ATOMIC_ACQUIRE, "agent"); asm volatile("s_waitcnt vmcnt(0)" ::: "memory");
            }
            __syncthreads();
            pg8::Gemm g{(const bf16_t*)(ws + WS_MIX), (const bf16_t*)(ws + WS_WOUT), TT, DM, DM / 2, DM}; pg8::StaticOrder S; S.init(TT, DM, nw, F.bid - 32); S.ksv = 1;
            EpiResid E{F.in[I_XP], F.in[I_XS], out, nullptr, nullptr};
            pg8::gemm_phase<EpiResid, pg8::StaticOrder, true, true>(F.lds, g, S, E);
        }
    );
    SEAM(3);
    PHASE(4,
        if (!(F.G > 32)) {
            pg8::Gemm g0{(const bf16_t*)(ws + WS_MIX), (const bf16_t*)(ws + WS_WOUT), TT, DM, DM / 2, DM}; pg8::StaticOrder S0; S0.init(TT, DM, F.G, F.bid); S0.ksv = 1;
            EpiResid E0{F.in[I_XP], F.in[I_XS], out, nullptr, nullptr};
            pg8::gemm_phase<EpiResid, pg8::StaticOrder, true, true>(F.lds, g0, S0, E0);
            xcd_barrier(xbar);
        }
        pg8::Gemm g{(const bf16_t*)(ws + WS_MIX), (const bf16_t*)(ws + WS_WOUT), TT, DM, DM / 2, DM}; pg8::StaticOrder S; S.init(TT, DM, F.G, F.bid);
        EpiResid E{out, out + (size_t)TP * DM, out, XB, SS0};
        pg8::gemm_phase<EpiResid, pg8::StaticOrder, true, true>(F.lds, g, S, E);
    );
    SEAM(4);
    PHASE(5,
        pg8::Gemm g{XB, (const bf16_t*)(ws + WS_WMQ), TT, MEMW, DM, DM}; pg8::StaticOrder S; S.init(TT, MEMW, F.G, F.bid);
        EpiScaleBf16 E{(bf16_t*)(ws + WS_QM), MEMW, SS0, MEM_QSCALE};
        pg8::gemm_phase<EpiScaleBf16, pg8::StaticOrder, true, true>(F.lds, g, S, E);
    );
    SEAM(5);
    PHASE(6,
        for (int u = F.bid; u < 256; u += F.G) memattn_prompt_unit(F, u);
        for (int t = F.bid; t < 256; t += F.G) memattn_sample_block(F, t);
    );
    SEAM(6);
    if (IN(7)) {
        pg8::Gemm g{(const bf16_t*)(ws + WS_OM), (const bf16_t*)(ws + WS_WMO), TT, DM, MEMW, MEMW}; pg8::StaticOrder S; S.init(TT, DM, F.G, F.bid);
        EpiResid E{out, out + (size_t)TP * DM, out, XB, SS1};
        pg8::gemm_phase<EpiResid, pg8::StaticOrder, true, true>(F.lds, g, S, E);
    }
    SEAM(7);
    PHASE(8,
        pg8::Gemm g{XB, (const bf16_t*)(ws + WS_WGU), TT, 2 * FF, DM, DM}; pg8::StaticOrder S; S.init(TT, 2 * FF, F.G, F.bid);
        EpiSwiGLU E{(bf16_t*)(ws + WS_HID), SS1};
        pg8::gemm_phase<EpiSwiGLU, pg8::StaticOrder, true, true>(F.lds, g, S, E);
    );
    SEAM(8);
    constexpr int DN_NS = 11; constexpr size_t SLAB_STRIDE = (size_t)TS * DM;
    if (IN(9)) {
        { pg8::Gemm g{(const bf16_t*)(ws + WS_HID), (const bf16_t*)(ws + WS_WDN), TP, DM, FF, FF}; pg8::StaticOrder S; S.init(TP, DM, F.G, F.bid);
          EpiResid E{out, out + (size_t)TP * DM, out, nullptr, SS2};
          pg8::gemm_phase<EpiResid, pg8::StaticOrder, true, true>(F.lds, g, S, E); }
        { pg8::Gemm g{(const bf16_t*)(ws + WS_HID), (const bf16_t*)(ws + WS_WDN), TT, DM, FF / DN_NS, FF}; SplitOrder S{F.bid, DN_NS};
          EpiSlab E{(float*)(ws + WS_MIX), TP, SLAB_STRIDE};
          pg8::gemm_phase<EpiSlab, SplitOrder, true, true>(F.lds, g, S, E); }
    }
    SEAM(9);
    if (IN(10)) {
        for (int m = F.bid * NWAVES + F.wave; m < TT; m += F.G * NWAVES) {
            if (m < TP) final_norm_row(out + (size_t)m * DM, SS2, m, F.in[I_NFINAL], F.lane);
            else final_norm_row_slabs(out + (size_t)m * DM, (const float*)(ws + WS_MIX) + (size_t)(m - TP) * DM, SLAB_STRIDE, DN_NS, F.in[I_NFINAL], F.lane);
        }
    }
#undef IN
#undef SEAM
}

#ifndef HY_N_LAUNCHES
#define HY_N_LAUNCHES 1
#endif
extern "C" void kernel_launch(void* const* d_in, const int* in_sizes, int n_in, void* d_out, int out_size, void* d_ws, size_t ws_size, hipStream_t stream) {
    static int grid = 0;
    if (grid == 0) {
        if (n_in != 26 || (size_t)out_size != O_END || ws_size < WS_END) { fprintf(stderr, "kernel_launch: unexpected problem: n_in %d out %d ws %zu (need %zu)\n", n_in, out_size, ws_size, (size_t)WS_END); grid = -1; return; }
        int dev = 0, cus = 0, per_cu = 0;
        hipGetDevice(&dev); hipDeviceGetAttribute(&cus, hipDeviceAttributeMultiprocessorCount, dev);
        if (hipFuncSetAttribute((const void*)hymba_fwd, hipFuncAttributeMaxDynamicSharedMemorySize, LDS_BYTES) != hipSuccess) { fprintf(stderr, "kernel_launch: hipFuncSetAttribute failed\n"); grid = -1; return; }
        if (hipOccupancyMaxActiveBlocksPerMultiprocessor(&per_cu, (const void*)hymba_fwd, NTHREADS, LDS_BYTES) != hipSuccess || per_cu < 1) { fprintf(stderr, "kernel_launch: occupancy query says %d blocks/CU\n", per_cu); per_cu = 1; }
        (void)hipGetLastError();
        grid = cus;
        fprintf(stderr, "kernel_launch: %d CUs, occupancy %d blocks/CU, grid %d\n", cus, per_cu, grid);
    }
    if (grid < 0) return;
    Args a{};
    for (int i = 0; i < 26; ++i) a.in[i] = (const float*)d_in[i];
    a.out = (float*)d_out; a.ws = (unsigned char*)d_ws;
    if (hipMemsetAsync((char*)d_ws + WS_BAR, 0, 16384 + 256, stream) != hipSuccess) { fprintf(stderr, "kernel_launch: hipMemsetAsync failed\n"); return; }
#if HY_N_LAUNCHES == 1
    a.ph_lo = 0; a.ph_hi = N_PHASES;
    void* kargs[] = {&a};
    hipError_t e = hipLaunchCooperativeKernel((const void*)hymba_fwd, dim3(grid), dim3(NTHREADS), kargs, LDS_BYTES, stream);
    if (e != hipSuccess) fprintf(stderr, "kernel_launch: cooperative launch failed: %s\n", hipGetErrorString(e));
#else
    for (int p = 0; p < N_PHASES; ++p) {
        a.ph_lo = p; a.ph_hi = p + 1;
        hipLaunchKernelGGL(hymba_fwd, dim3(grid), dim3(NTHREADS), LDS_BYTES, stream, a);
    }
#endif
}
```

```cpp
#include <hip/hip_runtime.h>
#include <hip/hip_cooperative_groups.h>
#include <cstdio>
#include <cstdint>
namespace cg = cooperative_groups;

namespace pg8 {
#define PG8_LAS __attribute__((address_space(3)))
typedef unsigned short bf16_t;
typedef short bf16x8 __attribute__((ext_vector_type(8)));
typedef float f32x4 __attribute__((ext_vector_type(4)));
typedef unsigned u32x4 __attribute__((ext_vector_type(4)));
constexpr int BM = 256, BK = 64, HALF = 128, HTB = HALF * BK * 2  , STAGE_BYTES = 8 * HTB, NXCD = 8, WGM = 8;

__host__ __device__ __forceinline__ int lds_byte(int r, int c) { const int st = (r >> 4) * 2 + (c >> 5), rr = r & 15, cc = c & 31, ob = rr * 64 + cc * 2; return st * 1024 + (ob ^ (((ob >> 9) & 1) << 5)); }
__host__ __device__ __forceinline__ void stage_rc(int b, int& R, int& C) { const int st = b / 1024, sb = b % 1024, swz = sb ^ (((sb >> 9) & 1) << 5); R = (st >> 1) * 16 + swz / 64; C = (st & 1) * 32 + (swz % 64) / 2; }
__host__ __device__ __forceinline__ int perm32(int rho) { const int n = rho >> 4, i = rho & 15; return 8 * (i >> 2) + 4 * n + (i & 3); }

struct Unit { int pm, pn, ks; };
struct Gemm { const bf16_t* A; const bf16_t* Bt; int M, N, K, ld; };

struct StaticOrder {
    int nM, nN, nwg, G, c, ksv = 0;
    __host__ __device__ void init(int M, int N, int G_, int c_) { nM = M / BM; nN = N / BM; nwg = nM * nN; G = G_; c = c_; }
    __host__ __device__ bool next(int i, Unit& u) const {
        const long L = (long)i * G + c; if (L >= nwg) return false;
        int wgid = (int)L; { const int q = nwg / NXCD, r = nwg % NXCD, xcd = wgid % NXCD, off = wgid / NXCD; wgid = (xcd < r ? xcd * (q + 1) : r * (q + 1) + (xcd - r) * q) + off; }
        const int nig = WGM * nN, gid = wgid / nig, fm = gid * WGM, gsz = (nM - fm) < WGM ? (nM - fm) : WGM;
        u.pm = fm + ((wgid % nig) % gsz); u.pn = (wgid % nig) / gsz; u.ks = ksv; return true;
    }
    __device__ __forceinline__ void a_ready(const Unit&) const {}
    __device__ __forceinline__ void done(const Unit&) const {}
};

template <class Epi, class Sched, bool ALIGN_EPI = false, bool SP2 = false>
__device__ __forceinline__ void gemm_phase(PG8_LAS unsigned char* lds, const Gemm g, const Sched& S, const Epi& E) {
    const int tid = threadIdx.x, wid = __builtin_amdgcn_readfirstlane(tid >> 6), lane = tid & 63, wr = wid >> 2, wc = wid & 3, fr = lane & 15, fq = lane >> 4;
    const int K = g.ld, nt = g.K / BK;
    unsigned voffA[2], voffB[2];
#pragma unroll
    for (int i = 0; i < 2; ++i) { int R, C; stage_rc(tid * 16 + i * 8192, R, C); const int Rb = Epi::PERM ? ((R & ~31) + perm32(R & 31)) : R;
        voffA[i] = (unsigned)(R * K + C) * 2u; voffB[i] = (unsigned)(Rb * K + C) * 2u; }
    const size_t kstep = (size_t)(BK * 2);
    const size_t hstep = (size_t)HALF * K * 2;
    const size_t tstep = 2 * hstep;
    const unsigned ldsw = (unsigned)wid * 1024u;
    const int aoff = lds_byte(wr * 64 + fr, fq * 8), boff = lds_byte(wc * 32 + fr, fq * 8);
#define PG8_SA(b, h) (((b) * 2 + (h)) * HTB)
#define PG8_SB(b, h) ((4 + (b) * 2 + (h)) * HTB)
#define PG8_STAGE(bufoff, gbase, voff) do { _Pragma("unroll") for (int _i = 0; _i < 2; ++_i) \
        __builtin_amdgcn_global_load_lds((const unsigned*)((const char*)(gbase) + (voff)[_i]), (PG8_LAS unsigned*)(lds + (bufoff) + ldsw + _i * 8192), 16, 0, 0); } while (0)
#define PG8_LDA(dst, b, h) do { _Pragma("unroll") for (int m = 0; m < 4; ++m) _Pragma("unroll") for (int k = 0; k < 2; ++k) dst[m][k] = *(const PG8_LAS bf16x8*)(lds + PG8_SA(b, h) + aoff + m * 2048 + k * 1024); } while (0)
#define PG8_LDB(dst, b, h) do { _Pragma("unroll") for (int n = 0; n < 2; ++n) _Pragma("unroll") for (int k = 0; k < 2; ++k) dst[n][k] = *(const PG8_LAS bf16x8*)(lds + PG8_SB(b, h) + boff + n * 2048 + k * 1024); } while (0)
#define PG8_MMA(ai, bj, At, Bt) do { __builtin_amdgcn_s_setprio(1); _Pragma("unroll") for (int m = 0; m < 4; ++m) _Pragma("unroll") for (int n = 0; n < 2; ++n) _Pragma("unroll") for (int k = 0; k < 2; ++k) \
        acc[ai][bj][m][n] = __builtin_amdgcn_mfma_f32_16x16x32_bf16(Bt[n][k], At[m][k], acc[ai][bj][m][n], 0, 0, 0); __builtin_amdgcn_s_setprio(0); } while (0)
#define PG8_WAIT_V(n) asm volatile("s_waitcnt vmcnt(" #n ")" ::: "memory")
#define PG8_WAIT_L(n) asm volatile("s_waitcnt lgkmcnt(" #n ")" ::: "memory")
#define PG8_BAR __builtin_amdgcn_s_barrier()
#define PG8_SCHED __builtin_amdgcn_sched_barrier(0)
    Unit cur, nxt; int ui = 0;
    if (!S.next(0, cur)) return;
    f32x4 acc[2][2][4][2];
#pragma unroll
    for (int a = 0; a < 2; ++a)
#pragma unroll
        for (int b = 0; b < 2; ++b)
#pragma unroll
            for (int m = 0; m < 4; ++m)
#pragma unroll
                for (int n = 0; n < 2; ++n) acc[a][b][m][n] = (f32x4){0.f, 0.f, 0.f, 0.f};
    bf16x8 At[4][2], B0[2][2], B1[2][2];
    const char* cA = (const char*)g.A + (size_t)cur.pm * tstep + (size_t)cur.ks * g.K * 2; const char* cB = (const char*)g.Bt + (size_t)cur.pn * tstep + (size_t)cur.ks * g.K * 2;
    S.a_ready(cur);
    if constexpr (SP2) {
        PG8_STAGE(PG8_SB(0, 0), cB, voffB); PG8_STAGE(PG8_SB(0, 1), cB + hstep, voffB); PG8_STAGE(PG8_SA(0, 0), cA, voffA); PG8_STAGE(PG8_SA(0, 1), cA + hstep, voffA);
        if (wr == 1) PG8_BAR;
        PG8_WAIT_V(2); PG8_BAR;
        PG8_STAGE(PG8_SB(1, 0), cB + kstep, voffB); PG8_STAGE(PG8_SA(1, 0), cA + kstep, voffA); PG8_STAGE(PG8_SB(1, 1), cB + hstep + kstep, voffB);
        PG8_WAIT_V(6); PG8_BAR;
    } else {
        PG8_STAGE(PG8_SB(0, 0), cB, voffB); PG8_STAGE(PG8_SA(0, 0), cA, voffA); PG8_STAGE(PG8_SB(0, 1), cB + hstep, voffB); PG8_STAGE(PG8_SA(0, 1), cA + hstep, voffA);
        if (wr == 1) PG8_BAR;
        PG8_WAIT_V(4); PG8_BAR;
        PG8_STAGE(PG8_SB(1, 0), cB + kstep, voffB); PG8_STAGE(PG8_SA(1, 0), cA + kstep, voffA); PG8_STAGE(PG8_SB(1, 1), cB + hstep + kstep, voffB);
        PG8_WAIT_V(6); PG8_BAR;
    }
    for (;;) {
        const bool has_next = S.next(ui + 1, nxt);
        const char* nA = has_next ? (const char*)g.A + (size_t)nxt.pm * tstep + (size_t)nxt.ks * g.K * 2 : cA; const char* nB = has_next ? (const char*)g.Bt + (size_t)nxt.pn * tstep + (size_t)nxt.ks * g.K * 2 : cB;
        for (int t = 0; t < nt; t += 2) {
            const bool last = (t == nt - 2);
            const char* a1 = cA + (size_t)(t + 1) * kstep;
            const char* a2 = last ? nA : cA + (size_t)(t + 2) * kstep; const char* b2 = last ? nB : cB + (size_t)(t + 2) * kstep;
            const char* a3 = a2 + kstep; const char* b3 = b2 + kstep;
            if (last && has_next) S.a_ready(nxt);
            if constexpr (SP2) {
            PG8_LDB(B0, 0, 0); PG8_LDB(B1, 0, 1); PG8_SCHED; PG8_LDA(At, 0, 0); PG8_STAGE(PG8_SA(1, 1), a1 + hstep, voffA);
            PG8_WAIT_V(8); PG8_WAIT_L(0); PG8_BAR; PG8_MMA(0, 0, At, B0); PG8_MMA(0, 1, At, B1); PG8_BAR; PG8_SCHED;
            PG8_LDA(At, 0, 1); PG8_STAGE(PG8_SB(0, 0), b2, voffB); PG8_STAGE(PG8_SB(0, 1), b2 + hstep, voffB); PG8_STAGE(PG8_SA(0, 0), a2, voffA);
            PG8_WAIT_V(8); PG8_WAIT_L(0); PG8_BAR; PG8_MMA(1, 0, At, B0); PG8_MMA(1, 1, At, B1); PG8_BAR; PG8_SCHED;
            PG8_LDB(B0, 1, 0); PG8_LDB(B1, 1, 1); PG8_SCHED; PG8_LDA(At, 1, 0); PG8_STAGE(PG8_SA(0, 1), a2 + hstep, voffA);
            PG8_WAIT_V(8); PG8_WAIT_L(0); PG8_BAR; PG8_MMA(0, 0, At, B0); PG8_MMA(0, 1, At, B1); PG8_BAR; PG8_SCHED;
            PG8_LDA(At, 1, 1); PG8_STAGE(PG8_SB(1, 0), b3, voffB); PG8_STAGE(PG8_SB(1, 1), b3 + hstep, voffB); PG8_STAGE(PG8_SA(1, 0), a3, voffA);
            PG8_WAIT_V(8); PG8_WAIT_L(0); PG8_BAR; PG8_MMA(1, 0, At, B0); PG8_MMA(1, 1, At, B1); PG8_BAR; PG8_SCHED;
            } else {
            PG8_LDB(B0, 0, 0); PG8_SCHED; PG8_LDA(At, 0, 0); PG8_STAGE(PG8_SA(1, 1), a1 + hstep, voffA);
            PG8_WAIT_L(8); PG8_BAR; PG8_WAIT_L(0); PG8_MMA(0, 0, At, B0); PG8_BAR; PG8_SCHED;
            PG8_LDB(B1, 0, 1); PG8_STAGE(PG8_SB(0, 0), b2, voffB);
            PG8_BAR; PG8_WAIT_L(0); PG8_MMA(0, 1, At, B1); PG8_BAR;
            PG8_LDA(At, 0, 1); PG8_STAGE(PG8_SA(0, 0), a2, voffA);
            PG8_BAR; PG8_WAIT_L(0); PG8_MMA(1, 0, At, B0); PG8_BAR; PG8_SCHED;
            PG8_STAGE(PG8_SB(0, 1), b2 + hstep, voffB);
            PG8_WAIT_V(6); PG8_BAR; PG8_MMA(1, 1, At, B1); PG8_BAR;
            PG8_LDB(B0, 1, 0); PG8_SCHED; PG8_LDA(At, 1, 0); PG8_STAGE(PG8_SA(0, 1), a2 + hstep, voffA);
            PG8_WAIT_L(8); PG8_BAR; PG8_WAIT_L(0); PG8_MMA(0, 0, At, B0); PG8_BAR; PG8_SCHED;
            PG8_LDB(B1, 1, 1); PG8_STAGE(PG8_SB(1, 0), b3, voffB);
            PG8_BAR; PG8_WAIT_L(0); PG8_MMA(0, 1, At, B1); PG8_BAR;
            PG8_LDA(At, 1, 1); PG8_STAGE(PG8_SA(1, 0), a3, voffA);
            PG8_BAR; PG8_WAIT_L(0); PG8_MMA(1, 0, At, B0); PG8_BAR; PG8_SCHED;
            PG8_STAGE(PG8_SB(1, 1), b3 + hstep, voffB);
            PG8_WAIT_V(6); PG8_BAR; PG8_MMA(1, 1, At, B1); PG8_BAR;
            }
        }
        if constexpr (ALIGN_EPI) { if (wr == 0) PG8_BAR; }
        if constexpr (!Epi::AFTER_DRAIN) { E(acc, cur, wr, wc, fr, fq); S.done(cur); }
        if (!has_next) break;
#pragma unroll
        for (int a = 0; a < 2; ++a)
#pragma unroll
            for (int b = 0; b < 2; ++b)
#pragma unroll
                for (int m = 0; m < 4; ++m)
#pragma unroll
                    for (int n = 0; n < 2; ++n) acc[a][b][m][n] = (f32x4){0.f, 0.f, 0.f, 0.f};
        cur = nxt; cA = nA; cB = nB; ++ui;
        if constexpr (ALIGN_EPI) { if (wr == 1) PG8_BAR; }
    }
    PG8_WAIT_V(0);
    if constexpr (!ALIGN_EPI) { if (wr == 0) PG8_BAR; }
    PG8_BAR;
    if constexpr (Epi::AFTER_DRAIN) { E.fused(acc, cur, wr, wc, fr, fq, lds, wid, lane); S.done(cur); }
#undef PG8_SA
#undef PG8_SB
#undef PG8_STAGE
#undef PG8_LDA
#undef PG8_LDB
#undef PG8_MMA
#undef PG8_WAIT_V
#undef PG8_WAIT_L
#undef PG8_BAR
#undef PG8_SCHED
}
}

#define LAS __attribute__((address_space(3)))
typedef unsigned short bf16_t;
typedef short bf16x8 __attribute__((ext_vector_type(8)));
typedef short bf16x4 __attribute__((ext_vector_type(4)));
typedef float f32x4 __attribute__((ext_vector_type(4)));
typedef float f32x2 __attribute__((ext_vector_type(2)));
typedef unsigned u32x4 __attribute__((ext_vector_type(4)));
typedef unsigned u32x2 __attribute__((ext_vector_type(2)));
typedef __bf16 hbf16x2 __attribute__((ext_vector_type(2)));

constexpr int DM = 2048, TP = 16384, TS = 512, TT = TP + TS, SEQ = 4096, DB = 128;
constexpr int NIN = 5376, FF = 5632, MEMW = 512;
constexpr int NCHP = TP / 16, NCH = NCHP + DB;
constexpr float RMS_EPS = 1e-6f;
constexpr float LOG2E = 1.4426950408889634f;
constexpr float SWA_QSCALE = 0.125f * LOG2E;
constexpr float MEM_QSCALE = 0.08838834764831845f * LOG2E;
constexpr int NWAVES = 8, NTHREADS = 512;
constexpr int LDS_BYTES = 147456;

constexpr size_t O_YP = 0, O_YS = 33554432, O_PST = 34603008, O_PSK = 35127296, O_PSV = 35192832, O_PMK = 35258368, O_PMV = 35782656,
                 O_SST = 36306944, O_SSK = 53084160, O_SSV = 55181312, O_END = 57278464;
constexpr size_t MiB = 1u << 20;
constexpr size_t WS_TAB = 1 * MiB;
constexpr size_t WS_WIN = 2 * MiB, WS_WOUT = 23 * MiB, WS_WMQ = 31 * MiB, WS_WMKV = 33 * MiB, WS_WMO = 37 * MiB, WS_WGU = 39 * MiB, WS_WDN = 83 * MiB;
constexpr size_t WS_SS = 105 * MiB;
constexpr size_t SS_STRIDE = 2359296;
constexpr size_t WS_MK = 112 * MiB, WS_MVT = 113 * MiB, WS_QM = 114 * MiB, WS_OM = 131 * MiB, WS_MN = 148 * MiB, WS_XB = 152 * MiB;
constexpr size_t WS_D = 218 * MiB;
constexpr size_t WS_GATE = WS_D, WS_SQ = WS_D + 33 * MiB, WS_SKV = WS_D + 66 * MiB, WS_QIN = WS_D + 75 * MiB, WS_KT = WS_D + 111 * MiB, WS_VT = WS_D + 147 * MiB,
                 WS_PSC = WS_D + 183 * MiB, WS_DEC = WS_D + 188 * MiB, WS_MIX = WS_D + 193 * MiB, WS_END = WS_D + 259 * MiB;
constexpr size_t WS_HID = WS_D;
static_assert((size_t)TT * FF * 2 <= 183 * MiB, "HID overlay");

struct Args {
    const float* in[26];
    float* out; unsigned char* ws;
    int ph_lo, ph_hi;
};

__device__ __forceinline__ unsigned cvtpk(float lo, float hi) { f32x2 v = {lo, hi}; hbf16x2 b = __builtin_convertvector(v, hbf16x2); return __builtin_bit_cast(unsigned, b); }
__device__ __forceinline__ float bf2f(unsigned short b) { return __uint_as_float((unsigned)b << 16); }
__device__ __forceinline__ unsigned short f2bf(float f) { return (unsigned short)(cvtpk(f, 0.f) & 0xffffu); }
__device__ __forceinline__ u32x4 pack8(f32x4 a, f32x4 b) { u32x4 w; w.x = cvtpk(a[0], a[1]); w.y = cvtpk(a[2], a[3]); w.z = cvtpk(b[0], b[1]); w.w = cvtpk(b[2], b[3]); return w; }
__device__ __forceinline__ u32x2 pack4(f32x4 a) { u32x2 w; w.x = cvtpk(a[0], a[1]); w.y = cvtpk(a[2], a[3]); return w; }
__device__ __forceinline__ float fexp(float x) { return __builtin_amdgcn_exp2f(x * LOG2E); }
__device__ __forceinline__ float fsigmoid(float x) { return __builtin_amdgcn_rcpf(1.0f + fexp(-x)); }
__device__ __forceinline__ float wave_sum(float v) {
#pragma unroll
    for (int o = 1; o < 64; o <<= 1) v += __shfl_xor(v, o);
    return v;
}
#define LDS_WAIT() asm volatile("s_waitcnt lgkmcnt(0)" ::: "memory")

__device__ __forceinline__ float row_rs(const float* SS, int row) {
    const f32x4* p = (const f32x4*)(SS + (size_t)row * 32);
    f32x4 s = p[0];
#pragma unroll
    for (int i = 1; i < 8; ++i) s += p[i];
    return __builtin_amdgcn_rsqf(((s[0] + s[1]) + (s[2] + s[3])) * (1.0f / DM) + RMS_EPS);
}

using pg8::Unit;
struct EpiIn {
    static constexpr bool PERM = true, AFTER_DRAIN = false;
    float* QF; float* GF; bf16_t* VB; bf16_t* GATE; bf16_t* SQ; bf16_t* SKV; const float* LB; float* out;
    __device__ __forceinline__ void operator()(const f32x4 (&acc)[2][2][4][2], const Unit& u, int wr, int wc, int fr, int fq) const {
        const int pn = u.pn;
#pragma unroll
        for (int ai = 0; ai < 2; ++ai)
#pragma unroll
            for (int m = 0; m < 4; ++m) {
                const int row = u.pm * 256 + ai * 128 + wr * 64 + m * 16 + fr;
#pragma unroll
                for (int bj = 0; bj < 2; ++bj) {
                    const int c = pn * 256 + bj * 128 + wc * 32 + 8 * fq;
                    f32x4 v0 = acc[ai][bj][m][0], v1 = acc[ai][bj][m][1];
                    if (pn < 4) {
                        float* d = QF + (size_t)row * 1024 + c; *(f32x4*)d = v0; *(f32x4*)(d + 4) = v1;
                    } else if (pn < 8) {
                        const int cc = c - 1024;
                        const f32x4 l0 = *(const f32x4*)(LB + cc), l1 = *(const f32x4*)(LB + cc + 4);
#pragma unroll
                        for (int j = 0; j < 4; ++j) { v0[j] = __logf(l0[j] + (1.0f - l0[j]) * fsigmoid(v0[j])); v1[j] = __logf(l1[j] + (1.0f - l1[j]) * fsigmoid(v1[j])); }
                        float* d = GF + (size_t)row * 1024 + cc; *(f32x4*)d = v0; *(f32x4*)(d + 4) = v1;
                    } else if (pn < 12) {
                        *(u32x4*)(VB + (size_t)row * 1024 + (c - 2048)) = pack8(v0, v1);
                    } else if (pn < 16) {
#pragma unroll
                        for (int j = 0; j < 4; ++j) { v0[j] = v0[j] * fsigmoid(v0[j]); v1[j] = v1[j] * fsigmoid(v1[j]); }
                        *(u32x4*)(GATE + (size_t)row * 1024 + (c - 3072)) = pack8(v0, v1);
                    } else if (pn < 20) {
                        *(u32x4*)(SQ + (size_t)row * 1024 + (c - 4096)) = pack8(v0 * SWA_QSCALE, v1 * SWA_QSCALE);
                    } else {
                        const int cc = c - 5120;
                        *(u32x4*)(SKV + (size_t)row * 256 + cc) = pack8(v0, v1);
                        float* d = nullptr;
                        if (row < TP) { const int b = row >> 12, t = row & 4095; if (t >= SEQ - 128) d = out + (bj == 0 ? O_PSK : O_PSV) + (size_t)(b * 128 + (t - (SEQ - 128))) * 128 + (cc & 127); }
                        else { const int rs = row - TP, b = rs >> 2, t = rs & 3; d = out + (bj == 0 ? O_SSK : O_SSV) + (size_t)(b * 128 + 124 + t) * 128 + (cc & 127); }
                        if (d) { *(f32x4*)d = v0; *(f32x4*)(d + 4) = v1; }
                    }
                }
            }
    }
};
struct EpiMemKV {
    static constexpr bool PERM = true, AFTER_DRAIN = false;
    bf16_t* MK; bf16_t* MVT; float* out;
    __device__ __forceinline__ void operator()(const f32x4 (&acc)[2][2][4][2], const Unit& u, int wr, int wc, int fr, int fq) const {
#pragma unroll
        for (int ai = 0; ai < 2; ++ai)
#pragma unroll
            for (int m = 0; m < 4; ++m) {
                const int row = u.pm * 256 + ai * 128 + wr * 64 + m * 16 + fr;
#pragma unroll
                for (int bj = 0; bj < 2; ++bj) {
                    const int c = u.pn * 256 + bj * 128 + wc * 32 + 8 * fq;
                    const f32x4 v0 = acc[ai][bj][m][0], v1 = acc[ai][bj][m][1];
                    if (u.pn < 2) {
                        float* d = out + O_PMK + (size_t)row * 512 + c; *(f32x4*)d = v0; *(f32x4*)(d + 4) = v1;
                        *(u32x4*)(MK + (size_t)row * 512 + c) = pack8(v0, v1);
                    } else {
                        const int cv = c - 512, h = cv >> 7, dd = cv & 127, b = row >> 8, mm = row & 255;
                        float* d = out + O_PMV + (size_t)row * 512 + cv; *(f32x4*)d = v0; *(f32x4*)(d + 4) = v1;
                        bf16_t* t = MVT + ((size_t)((b * 4 + h) * 128 + dd)) * 256 + mm;
#pragma unroll
                        for (int j = 0; j < 4; ++j) { t[(size_t)j * 256] = f2bf(v0[j]); t[(size_t)(j + 4) * 256] = f2bf(v1[j]); }
                    }
                }
            }
    }
};
struct EpiResid {
    static constexpr bool PERM = true, AFTER_DRAIN = false;
    const float* resP; const float* resS; float* X; bf16_t* XB; float* SS;
    __device__ __forceinline__ void operator()(const f32x4 (&acc)[2][2][4][2], const Unit& u, int wr, int wc, int fr, int fq) const {
#pragma unroll
        for (int ai = 0; ai < 2; ++ai)
#pragma unroll
            for (int m = 0; m < 4; ++m) {
                const int row = u.pm * 256 + ai * 128 + wr * 64 + m * 16 + fr;
                const float* rrow = (row < TP) ? resP + (size_t)row * DM : resS + (size_t)(row - TP) * DM;
                float ss = 0.f;
#pragma unroll
                for (int bj = 0; bj < 2; ++bj) {
                    const int c = u.pn * 256 + bj * 128 + wc * 32 + 8 * fq;
                    const f32x4 v0 = acc[ai][bj][m][0] + *(const f32x4*)(rrow + c), v1 = acc[ai][bj][m][1] + *(const f32x4*)(rrow + c + 4);
                    float* d = X + (size_t)row * DM + c; *(f32x4*)d = v0; *(f32x4*)(d + 4) = v1;
                    ss += (v0[0] * v0[0] + v0[1] * v0[1]) + (v0[2] * v0[2] + v0[3] * v0[3]) + (v1[0] * v1[0] + v1[1] * v1[1]) + (v1[2] * v1[2] + v1[3] * v1[3]);
                    if (XB) *(u32x4*)(XB + (size_t)row * DM + c) = pack8(v0, v1);
                }
                ss += __shfl_xor(ss, 16); ss += __shfl_xor(ss, 32);
                if (SS && fq == 0) SS[(size_t)row * 32 + u.pn * 4 + wc] = ss;
            }
    }
};
struct EpiSlab {
    static constexpr bool PERM = true, AFTER_DRAIN = false;
    float* SLAB; int row0; size_t slab_stride;
    __device__ __forceinline__ void operator()(const f32x4 (&acc)[2][2][4][2], const Unit& u, int wr, int wc, int fr, int fq) const {
        float* base = SLAB + (size_t)u.ks * slab_stride;
#pragma unroll
        for (int ai = 0; ai < 2; ++ai)
#pragma unroll
            for (int m = 0; m < 4; ++m) {
                const int row = u.pm * 256 + ai * 128 + wr * 64 + m * 16 + fr - row0;
#pragma unroll
                for (int bj = 0; bj < 2; ++bj) {
                    float* d = base + (size_t)row * DM + u.pn * 256 + bj * 128 + wc * 32 + 8 * fq;
                    *(f32x4*)d = acc[ai][bj][m][0]; *(f32x4*)(d + 4) = acc[ai][bj][m][1];
                }
            }
    }
};
struct SplitOrder {
    int c, ns;
    __device__ bool next(int i, Unit& u) const { if (i > 0 || c >= 16 * ns) return false; const int tile = c / ns; u.pm = TP / 256 + (tile >> 3); u.pn = tile & 7; u.ks = c % ns; return true; }
    __device__ __forceinline__ void a_ready(const Unit&) const {}
    __device__ __forceinline__ void done(const Unit&) const {}
};
struct EpiScaleBf16 {
    static constexpr bool PERM = true, AFTER_DRAIN = false;
    bf16_t* O; int ldc; const float* SS; float scale;
    __device__ __forceinline__ void operator()(const f32x4 (&acc)[2][2][4][2], const Unit& u, int wr, int wc, int fr, int fq) const {
#pragma unroll
        for (int ai = 0; ai < 2; ++ai)
#pragma unroll
            for (int m = 0; m < 4; ++m) {
                const int row = u.pm * 256 + ai * 128 + wr * 64 + m * 16 + fr;
                const float s = row_rs(SS, row) * scale;
#pragma unroll
                for (int bj = 0; bj < 2; ++bj) {
                    const int c = u.pn * 256 + bj * 128 + wc * 32 + 8 * fq;
                    *(u32x4*)(O + (size_t)row * ldc + c) = pack8(acc[ai][bj][m][0] * s, acc[ai][bj][m][1] * s);
                }
            }
    }
};
struct EpiSwiGLU {
    static constexpr bool PERM = true, AFTER_DRAIN = false;
    bf16_t* HID; const float* SS;
    __device__ __forceinline__ void operator()(const f32x4 (&acc)[2][2][4][2], const Unit& u, int wr, int wc, int fr, int fq) const {
#pragma unroll
        for (int ai = 0; ai < 2; ++ai)
#pragma unroll
            for (int m = 0; m < 4; ++m) {
                const int row = u.pm * 256 + ai * 128 + wr * 64 + m * 16 + fr;
                const float s = row_rs(SS, row);
                f32x4 h0, h1;
#pragma unroll
                for (int j = 0; j < 4; ++j) {
                    const float g0 = acc[ai][0][m][0][j] * s, u0 = acc[ai][1][m][0][j] * s, g1 = acc[ai][0][m][1][j] * s, u1 = acc[ai][1][m][1][j] * s;
                    h0[j] = g0 * fsigmoid(g0) * u0; h1[j] = g1 * fsigmoid(g1) * u1;
                }
                *(u32x4*)(HID + (size_t)row * FF + u.pn * 128 + wc * 32 + 8 * fq) = pack8(h0, h1);
            }
    }
};

struct Frame {
    LAS unsigned char* lds;
    int tid, lane, wave, G, bid;
    const float* const* in;
    float* out; unsigned char* ws;
};
enum { I_XP = 0, I_XS, I_STATE, I_CSK, I_CSV, I_CMK, I_CMV, I_MEMP, I_NMIX, I_WIN, I_LB, I_ONORM, I_SINKS, I_RELB, I_WOUT, I_NXATT, I_NMEM,
       I_WMQ, I_WMK, I_WMV, I_WMO, I_NFFN, I_WGATE, I_WUP, I_WDOWN, I_NFINAL };

__device__ __forceinline__ void p0_tr_item(const float* __restrict__ W, int K, int N, bf16_t* WT, int k0, int n0, int drow0, const float* __restrict__ scale, LAS float* scr, int lane) {
#pragma unroll 8
    for (int i = 0; i < 32; ++i) { const int kk = 2 * i + (lane >> 5); float v = W[(size_t)(k0 + kk) * N + n0 + (lane & 31)]; if (scale) v *= scale[k0 + kk]; scr[kk * 33 + (lane & 31)] = v; }
    LDS_WAIT(); asm volatile("" ::: "memory");
    const int c = lane & 7;
#pragma unroll
    for (int j = 0; j < 4; ++j) { const int n = (lane >> 3) + 8 * j; const LAS float* s = scr + (8 * c) * 33 + n;
        u32x4 o; o.x = cvtpk(s[0 * 33], s[1 * 33]); o.y = cvtpk(s[2 * 33], s[3 * 33]); o.z = cvtpk(s[4 * 33], s[5 * 33]); o.w = cvtpk(s[6 * 33], s[7 * 33]);
        *(u32x4*)(WT + (size_t)(drow0 + n) * K + k0 + 8 * c) = o; }
    LDS_WAIT(); asm volatile("" ::: "memory");
}
__device__ __forceinline__ void p0_rms_row(const float* xrow, const float* w, bf16_t* orow, int lane) {
    const f32x4* xr = (const f32x4*)xrow + lane; const f32x4* wr = (const f32x4*)w + lane;
    f32x4 v[8]; float s = 0.f;
#pragma unroll
    for (int j = 0; j < 8; ++j) { v[j] = xr[64 * j]; s += (v[j][0] * v[j][0] + v[j][1] * v[j][1]) + (v[j][2] * v[j][2] + v[j][3] * v[j][3]); }
    const float rs = __builtin_amdgcn_rsqf(wave_sum(s) * (1.0f / DM) + RMS_EPS);
    u32x2* o8 = (u32x2*)orow + lane;
#pragma unroll
    for (int j = 0; j < 8; ++j) { const f32x4 ww = wr[64 * j]; f32x4 y; y[0] = v[j][0] * rs * ww[0]; y[1] = v[j][1] * rs * ww[1]; y[2] = v[j][2] * rs * ww[2]; y[3] = v[j][3] * rs * ww[3]; o8[64 * j] = pack4(y); }
}
__device__ __forceinline__ int rel_bucket(int n) {
    if (n < 16) return n;
    int b = 16 + (int)(__logf((float)n * (1.0f / 16.0f)) / 2.0794415416798357f * 16.0f);
    return b < 31 ? b : 31;
}
__device__ __forceinline__ void p0_prologue(Frame& F) {
    LAS float* scr = (LAS float*)(F.lds + F.wave * 16384);
    const int gw = F.bid * NWAVES + F.wave, NGW = F.G * NWAVES;
    unsigned char* ws = F.ws;
    constexpr int I_IN = 32 * (NIN / 32), I_OUT = 32 * 64, I_MQ = 32 * 16, I_MO = 8 * 64, I_G = 32 * (FF / 32), I_DN = (FF / 64) * 64;
    constexpr int NITEMS = I_IN + I_OUT + 3 * I_MQ + I_MO + 2 * I_G + I_DN;
    for (int it = gw; it < NITEMS; it += NGW) {
        int r = it;
        if (r < I_IN) { const int nb = NIN / 32, kb = r / nb, n0 = (r % nb) * 32; p0_tr_item(F.in[I_WIN], DM, NIN, (bf16_t*)(ws + WS_WIN), kb * 64, n0, n0, nullptr, scr, F.lane); continue; } r -= I_IN;
        if (r < I_OUT) { const int kb = r / 64, n0 = (r % 64) * 32; p0_tr_item(F.in[I_WOUT], DM, DM, (bf16_t*)(ws + WS_WOUT), kb * 64, n0, n0, nullptr, scr, F.lane); continue; } r -= I_OUT;
        if (r < I_MQ) { const int kb = r / 16, n0 = (r % 16) * 32; p0_tr_item(F.in[I_WMQ], DM, MEMW, (bf16_t*)(ws + WS_WMQ), kb * 64, n0, n0, F.in[I_NXATT], scr, F.lane); continue; } r -= I_MQ;
        if (r < I_MQ) { const int kb = r / 16, n0 = (r % 16) * 32; p0_tr_item(F.in[I_WMK], DM, MEMW, (bf16_t*)(ws + WS_WMKV), kb * 64, n0, n0, nullptr, scr, F.lane); continue; } r -= I_MQ;
        if (r < I_MQ) { const int kb = r / 16, n0 = (r % 16) * 32; p0_tr_item(F.in[I_WMV], DM, MEMW, (bf16_t*)(ws + WS_WMKV), kb * 64, n0, 512 + n0, nullptr, scr, F.lane); continue; } r -= I_MQ;
        if (r < I_MO) { const int kb = r / 64, n0 = (r % 64) * 32; p0_tr_item(F.in[I_WMO], MEMW, DM, (bf16_t*)(ws + WS_WMO), kb * 64, n0, n0, nullptr, scr, F.lane); continue; } r -= I_MO;
        if (r < 2 * I_G) { const int up = r >= I_G; if (up) r -= I_G; const int nb = FF / 32, kb = r / nb, n0 = (r % nb) * 32;
            p0_tr_item(F.in[up ? I_WUP : I_WGATE], DM, FF, (bf16_t*)(ws + WS_WGU), kb * 64, n0, (n0 >> 7) * 256 + (n0 & 127) + (up ? 128 : 0), F.in[I_NFFN], scr, F.lane); continue; } r -= 2 * I_G;
        { const int kb = r / 64, n0 = (r % 64) * 32; p0_tr_item(F.in[I_WDOWN], FF, DM, (bf16_t*)(ws + WS_WDN), kb * 64, n0, n0, nullptr, scr, F.lane); }
    }
    for (int m = gw; m < TT + 1024; m += NGW) {
        if (m < TP) p0_rms_row(F.in[I_XP] + (size_t)m * DM, F.in[I_NMIX], (bf16_t*)(ws + WS_XB) + (size_t)m * DM, F.lane);
        else if (m < TT) p0_rms_row(F.in[I_XS] + (size_t)(m - TP) * DM, F.in[I_NMIX], (bf16_t*)(ws + WS_XB) + (size_t)m * DM, F.lane);
        else p0_rms_row(F.in[I_MEMP] + (size_t)(m - TT) * DM, F.in[I_NMEM], (bf16_t*)(ws + WS_MN) + (size_t)(m - TT) * DM, F.lane);
    }
    float* LBt = (float*)(ws + WS_TAB); float* BT = (float*)(ws + WS_TAB + 8192);
    const int gt = F.bid * NTHREADS + F.tid, NGT = F.G * NTHREADS;
    for (int i = gt; i < 1024 + 16 * 160; i += NGT) {
        if (i < 1024) { const float l0 = F.in[I_LB][i], l1 = F.in[I_LB][1024 + i]; LBt[i] = 1.0f / (1.0f + __expf(l1 - l0)); }
        else { const int j = i - 1024, h = j / 160, ix = j % 160, dist = 143 - ix;
            BT[j] = (dist >= 0 && dist < 128) ? F.in[I_RELB][rel_bucket(dist) * 16 + h] * LOG2E : -INFINITY; }
    }
}

constexpr int PREP_RS = 1032;
__device__ __forceinline__ void hgrn_prep(Frame& F) {
    unsigned char* ws = F.ws;
    const float* QF = F.out; const float* GF = F.out + (size_t)TT * 1024; const bf16_t* VB = (const bf16_t*)(F.out + O_SST);
    bf16_t* QIN = (bf16_t*)(ws + WS_QIN); bf16_t* KT = (bf16_t*)(ws + WS_KT); bf16_t* VT = (bf16_t*)(ws + WS_VT); bf16_t* PSC = (bf16_t*)(ws + WS_PSC); float* DEC = (float*)(ws + WS_DEC);
    LAS bf16_t* lq = (LAS bf16_t*)F.lds; LAS bf16_t* lk = lq + 16 * PREP_RS;
    const int l15 = F.lane & 15, g4 = F.lane >> 4;
    for (int ch = F.bid; ch < NCH; ch += F.G) {
        const int nv = ch < NCHP ? 16 : 4; const int row0 = ch < NCHP ? ch * 16 : TP + (ch - NCHP) * 4;
#pragma unroll 1
        for (int pass = 0; pass < 2; ++pass) {
            const int cidx = F.tid + 512 * pass;
            float g[16], q[16]; unsigned short vv[16];
#pragma unroll
            for (int t = 0; t < 16; ++t) {
                if (t < nv) { g[t] = GF[(size_t)(row0 + t) * 1024 + cidx]; q[t] = QF[(size_t)(row0 + t) * 1024 + cidx]; vv[t] = VB[(size_t)(row0 + t) * 1024 + cidx]; }
                else { g[t] = 0.f; q[t] = 0.f; vv[t] = 0; }
            }
            float G = 0.f; unsigned kd[8], vt[8];
#pragma unroll
            for (int t = 0; t < 16; t += 2) {
                float qi[2], kk[2];
#pragma unroll
                for (int z = 0; z < 2; ++z) {
                    const float gt = g[t + z]; G += gt;
                    qi[z] = q[t + z] * fexp(G);
                    kk[z] = (1.0f - fexp(gt)) * fexp(fminf(-G, 80.0f));
                    lq[(t + z) * PREP_RS + cidx] = f2bf(qi[z]); lk[(t + z) * PREP_RS + cidx] = f2bf(kk[z]);
                }
                kd[t >> 1] = cvtpk(kk[0], kk[1]); vt[t >> 1] = (unsigned)vv[t] | ((unsigned)vv[t + 1] << 16);
            }
            DEC[(size_t)ch * 1024 + cidx] = fexp(G);
            u32x4* kp = (u32x4*)(KT + ((size_t)ch * 1024 + cidx) * 16); kp[0] = (u32x4){kd[0], kd[1], kd[2], kd[3]}; kp[1] = (u32x4){kd[4], kd[5], kd[6], kd[7]};
            u32x4* vp = (u32x4*)(VT + ((size_t)ch * 1024 + cidx) * 16); vp[0] = (u32x4){vt[0], vt[1], vt[2], vt[3]}; vp[1] = (u32x4){vt[4], vt[5], vt[6], vt[7]};
        }
        __syncthreads();
#pragma unroll
        for (int i = 0; i < 4; ++i) { const int idx = F.tid + 512 * i, t = idx >> 7, c8 = idx & 127;
            *(u32x4*)(QIN + ((size_t)ch * 16 + t) * 1024 + c8 * 8) = *(const LAS u32x4*)(lq + t * PREP_RS + c8 * 8); }
        {
            const int h = F.wave; f32x4 acc = {0.f, 0.f, 0.f, 0.f};
#pragma unroll
            for (int kk = 0; kk < 4; ++kk) {
                const bf16x8 a = *(const LAS bf16x8*)(lq + l15 * PREP_RS + h * 128 + 32 * kk + 8 * g4);
                const bf16x8 b = *(const LAS bf16x8*)(lk + l15 * PREP_RS + h * 128 + 32 * kk + 8 * g4);
                acc = __builtin_amdgcn_mfma_f32_16x16x32_bf16(a, b, acc, 0, 0, 0);
            }
            bf16_t* pd = PSC + ((size_t)ch * 8 + h) * 256;
#pragma unroll
            for (int r = 0; r < 4; ++r) { const int t = 4 * g4 + r, s = l15; pd[t * 16 + s] = (s <= t) ? f2bf(acc[r]) : (bf16_t)0; }
        }
        __syncthreads();
    }
}

constexpr int SC_QS = 136;
constexpr int SC_QI = 0, SC_KT = 16 * SC_QS * 2, SC_VT = SC_KT + 4096, SC_P = SC_VT + 4096, SC_DEC = SC_P + 512, SC_GATE = SC_DEC + 512, SC_BUF = SC_GATE + 16 * SC_QS * 2;
constexpr int SC_RED = 2 * SC_BUF;
static_assert(SC_RED + 1024 <= LDS_BYTES && SC_BUF % 16 == 0, "scan LDS");
struct ScanPf { u32x4 a, b, c; };
struct ScanSrc { const unsigned char* a; const unsigned char* b; const unsigned char* c; unsigned oa, ob, oc; };
__device__ __forceinline__ ScanSrc scan_src(const Frame& F, int ch0, int h, int grow0, int ngr) {
    const unsigned char* ws = F.ws; const int tid = F.tid; ScanSrc s;
    const bf16_t* QIN = (const bf16_t*)(ws + WS_QIN); const bf16_t* KT = (const bf16_t*)(ws + WS_KT); const bf16_t* VT = (const bf16_t*)(ws + WS_VT);
    const bf16_t* PSC = (const bf16_t*)(ws + WS_PSC); const float* DEC = (const float*)(ws + WS_DEC); const bf16_t* GATE = (const bf16_t*)(ws + WS_GATE);
    if (tid < 256) { const int t = tid >> 4, p = tid & 15;
        s.a = (const unsigned char*)(QIN + ((size_t)ch0 * 16 + t) * 1024 + h * 128 + p * 8); s.oa = SC_QI + (t * SC_QS + p * 8) * 2;
        s.b = (const unsigned char*)(VT + ((size_t)ch0 * 1024 + h * 128) * 16 + tid * 8); s.ob = SC_VT + tid * 16;
    } else { const int i = tid - 256, t = i >> 4, p = i & 15; const int tr = t < ngr ? t : ngr - 1;
        s.a = (const unsigned char*)(KT + ((size_t)ch0 * 1024 + h * 128) * 16 + i * 8); s.oa = SC_KT + i * 16;
        s.b = (const unsigned char*)(GATE + (size_t)(grow0 + tr) * 1024 + h * 128 + p * 8); s.ob = SC_GATE + (t * SC_QS + p * 8) * 2;
    }
    if (tid < 32) { s.c = (const unsigned char*)(PSC + ((size_t)ch0 * 8 + h) * 256 + tid * 8); s.oc = SC_P + tid * 16; }
    else { const int i = (tid - 32) & 31; s.c = (const unsigned char*)(DEC + (size_t)ch0 * 1024 + h * 128 + i * 4); s.oc = SC_DEC + i * 16; }
    return s;
}
__device__ __forceinline__ void scan_fetch(ScanPf& pf, const ScanSrc& s, const Frame& F, int step) {
    pf.a = *(const u32x4*)(s.a + (size_t)step * 32768); pf.b = *(const u32x4*)(s.b + (size_t)step * 32768);
    if (F.tid < 64) pf.c = *(const u32x4*)(s.c + (size_t)step * 4096);
}
__device__ __forceinline__ void scan_stash(const ScanPf& pf, const ScanSrc& s, const Frame& F, int buf) {
    LAS unsigned char* B = F.lds + buf * SC_BUF;
    *(LAS u32x4*)(B + s.oa) = pf.a; *(LAS u32x4*)(B + s.ob) = pf.b;
    if (F.tid < 64) *(LAS u32x4*)(B + s.oc) = pf.c;
}
template <int CTRL> __device__ __forceinline__ float dpp_mov(float v) { return __int_as_float(__builtin_amdgcn_update_dpp(0, __float_as_int(v), CTRL, 0xF, 0xF, true)); }
__device__ __forceinline__ float row16_sum(float v) { v += dpp_mov<0xB1>(v); v += dpp_mov<0x4E>(v); v += dpp_mov<0x141>(v); v += dpp_mov<0x140>(v); return v; }
constexpr int SC_ST = SC_RED + 1024, SC_STS = 132;
static_assert(SC_ST + 128 * SC_STS * 4 <= LDS_BYTES, "scan LDS (state image)");
__device__ __forceinline__ void hgrn_scan(Frame& F, int ch0, int nsteps, int h, int mrow0, int nvalid, const float* S0, float* Sout) {
    const int lane = F.lane, l15 = lane & 15, g4 = lane >> 4, e0 = 16 * F.wave;
    bf16_t* MIX = (bf16_t*)(F.ws + WS_MIX);
    const float onw = F.in[I_ONORM][e0 + l15];
    LAS float* RED = (LAS float*)(F.lds + SC_RED);
    LAS float* ST = (LAS float*)(F.lds + SC_ST);
    ScanPf pf;
    __syncthreads();
    const ScanSrc src = scan_src(F, ch0, h, mrow0, nvalid);
    scan_fetch(pf, src, F, 0); scan_stash(pf, src, F, 0);
    if (nsteps > 1) scan_fetch(pf, src, F, 1);
    f32x4 S[8];
    if (S0) {
#pragma unroll
        for (int i = 0; i < 8; ++i) { const int idx = F.tid + 512 * i, c = idx >> 5, e4 = idx & 31; *(LAS f32x4*)(ST + c * SC_STS + e4 * 4) = *(const f32x4*)(S0 + (size_t)c * 128 + e4 * 4); }
    }
    __syncthreads();
#pragma unroll
    for (int mt = 0; mt < 8; ++mt)
#pragma unroll
        for (int r = 0; r < 4; ++r) S[mt][r] = S0 ? ST[(16 * mt + 4 * g4 + r) * SC_STS + e0 + l15] : 0.f;
    f32x4 o_prev = {0.f, 0.f, 0.f, 0.f}, gate_prev = {0.f, 0.f, 0.f, 0.f};
#pragma unroll 1
    for (int n = 0; n <= nsteps; ++n) {
        const int buf = n & 1;
        f32x4 o = {0.f, 0.f, 0.f, 0.f}, gate = {0.f, 0.f, 0.f, 0.f};
        if (n + 1 < nsteps) {
            scan_stash(pf, src, F, buf ^ 1);
            if (n + 2 < nsteps) scan_fetch(pf, src, F, n + 2);
        }
        if (n < nsteps) {
            const LAS unsigned char* B = F.lds + buf * SC_BUF;
            const bf16x4 vt = *(const LAS bf16x4*)(B + SC_VT + ((e0 + l15) * 16 + 4 * g4) * 2);
            const bf16x4 pa = *(const LAS bf16x4*)(B + SC_P + (l15 * 16 + 4 * g4) * 2);
            const f32x4 zz = {0.f, 0.f, 0.f, 0.f};
            f32x4 oq[4];
            const f32x4 op = __builtin_amdgcn_mfma_f32_16x16x16bf16_1k(pa, vt, zz, 0, 0, 0);
#pragma unroll
            for (int kk = 0; kk < 4; ++kk) {
                const bf16x4 q0 = *(const LAS bf16x4*)(B + SC_QI + (l15 * SC_QS + 32 * kk + 4 * g4) * 2);
                const bf16x4 q1 = *(const LAS bf16x4*)(B + SC_QI + (l15 * SC_QS + 32 * kk + 16 + 4 * g4) * 2);
                const bf16x8 qa = {q0[0], q0[1], q0[2], q0[3], q1[0], q1[1], q1[2], q1[3]};
                const u32x4 sb = pack8(S[2 * kk], S[2 * kk + 1]);
                oq[kk] = __builtin_amdgcn_mfma_f32_16x16x32_bf16(qa, __builtin_bit_cast(bf16x8, sb), zz, 0, 0, 0);
            }
            o = (oq[0] + oq[2]) + op; const f32x4 ob = oq[1] + oq[3];
#pragma unroll
            for (int mt = 0; mt < 8; ++mt) {
                const bf16x4 kt = *(const LAS bf16x4*)(B + SC_KT + ((16 * mt + l15) * 16 + 4 * g4) * 2);
                const f32x4 dc = *(const LAS f32x4*)(B + SC_DEC + (16 * mt + 4 * g4) * 4);
                S[mt] = __builtin_amdgcn_mfma_f32_16x16x16bf16_1k(kt, vt, S[mt], 0, 0, 0);
                S[mt] = S[mt] * dc;
            }
            o = o + ob;
#pragma unroll
            for (int r = 0; r < 4; ++r) {
                gate[r] = bf2f(*(const LAS unsigned short*)(B + SC_GATE + ((4 * g4 + r) * SC_QS + e0 + l15) * 2));
                const float ss = row16_sum(o[r] * o[r]);
                if (l15 == 0) RED[(buf * 8 + F.wave) * 16 + 4 * g4 + r] = ss;
            }
        }
        if (n > 0) {
            const int pb = (n - 1) & 1;
#pragma unroll
            for (int r = 0; r < 4; ++r) {
                const int t = 4 * g4 + r; float tot = 0.f;
#pragma unroll
                for (int w = 0; w < 8; ++w) tot += RED[(pb * 8 + w) * 16 + t];
                const float rs = __builtin_amdgcn_rsqf(tot * (1.0f / 128.0f) + RMS_EPS);
                if (t < nvalid) MIX[(size_t)(mrow0 + 16 * (n - 1) + t) * DM + h * 128 + e0 + l15] = f2bf(o_prev[r] * rs * onw * gate_prev[r]);
            }
        }
        o_prev = o; gate_prev = gate;
        __syncthreads();
    }
#pragma unroll
    for (int mt = 0; mt < 8; ++mt)
#pragma unroll
        for (int r = 0; r < 4; ++r) ST[(16 * mt + 4 * g4 + r) * SC_STS + e0 + l15] = S[mt][r];
    __syncthreads();
#pragma unroll
    for (int i = 0; i < 8; ++i) { const int idx = F.tid + 512 * i, c = idx >> 5, e4 = idx & 31; *(f32x4*)(Sout + (size_t)c * 128 + e4 * 4) = *(const LAS f32x4*)(ST + c * SC_STS + e4 * 4); }
}


constexpr int SW_KS = 72, SW_VS = 264;
constexpr int SW_K = 0, SW_V = 256 * SW_KS * 2, SW_BT = SW_V + 64 * SW_VS * 2, SW_END = SW_BT + 8 * 160 * 4;
static_assert(SW_END <= LDS_BYTES, "swa LDS");
__device__ __forceinline__ void swa_qtile(Frame& F, int j, int h, size_t qrow, bool qvalid, bool first_block, float sink2) {
    const int lane = F.lane, l15 = lane & 15, g4 = lane >> 4;
    const bf16_t* SQ = (const bf16_t*)(F.ws + WS_SQ); bf16_t* MIX = (bf16_t*)(F.ws + WS_MIX);
    const LAS bf16_t* Kb = (const LAS bf16_t*)(F.lds + SW_K); const LAS bf16_t* Vt = (const LAS bf16_t*)(F.lds + SW_V);
    const LAS float* BT = (const LAS float*)(F.lds + SW_BT) + F.wave * 160;
    bf16x8 qf[2];
#pragma unroll
    for (int kk = 0; kk < 2; ++kk) qf[kk] = *(const bf16x8*)(SQ + qrow * 1024 + h * 64 + 32 * kk + 8 * g4);
    f32x4 s[9]; float mx = sink2;
    const int bidx = 15 + 4 * g4 - l15;
#pragma unroll
    for (int u = 0; u < 9; ++u) {
        const int mt = j + u; f32x4 acc = {0.f, 0.f, 0.f, 0.f};
#pragma unroll
        for (int kk = 0; kk < 2; ++kk) {
            const bf16x8 a = *(const LAS bf16x8*)(Kb + (16 * mt + l15) * SW_KS + 32 * kk + 8 * g4);
            acc = __builtin_amdgcn_mfma_f32_16x16x32_bf16(a, qf[kk], acc, 0, 0, 0);
        }
        const bool dead = first_block && (mt < 8);
#pragma unroll
        for (int r = 0; r < 4; ++r) { float v = acc[r] + BT[bidx + 16 * u + r]; v = dead ? -INFINITY : v; s[u][r] = v; mx = fmaxf(mx, v); }
    }
    mx = fmaxf(mx, __shfl_xor(mx, 16)); mx = fmaxf(mx, __shfl_xor(mx, 32));
    float sum = 0.f; bf16x4 pb[9];
#pragma unroll
    for (int u = 0; u < 9; ++u) {
        f32x4 p;
#pragma unroll
        for (int r = 0; r < 4; ++r) { p[r] = __builtin_amdgcn_exp2f(s[u][r] - mx); sum += p[r]; }
        pb[u] = __builtin_bit_cast(bf16x4, pack4(p));
    }
    sum += __shfl_xor(sum, 16); sum += __shfl_xor(sum, 32);
    sum += __builtin_amdgcn_exp2f(sink2 - mx);
    const float inv = 1.0f / sum;
#pragma unroll
    for (int dt = 0; dt < 4; ++dt) {
        f32x4 o = {0.f, 0.f, 0.f, 0.f};
#pragma unroll
        for (int u = 0; u < 9; ++u) {
            const bf16x4 a = *(const LAS bf16x4*)(Vt + (16 * dt + l15) * SW_VS + 16 * (j + u) + 4 * g4);
            o = __builtin_amdgcn_mfma_f32_16x16x16bf16_1k(a, pb[u], o, 0, 0, 0);
        }
        if (qvalid) *(u32x2*)(MIX + qrow * DM + 1024 + h * 64 + 16 * dt + 4 * g4) = pack4(o * inv);
    }
}
__device__ __forceinline__ void swa_load_tables(Frame& F, int k) {
    const float* BTg = (const float*)(F.ws + WS_TAB + 8192); LAS float* BT = (LAS float*)(F.lds + SW_BT);
    for (int i = F.tid; i < 8 * 160; i += NTHREADS) BT[i] = BTg[k * 8 * 160 + i];
}
__device__ __forceinline__ void swa_prompt_unit(Frame& F, int unit) {
    const int k = unit & 1, n = (unit >> 1) & 31, b = unit >> 6;
    const bf16_t* SKV = (const bf16_t*)(F.ws + WS_SKV);
    LAS bf16_t* Kb = (LAS bf16_t*)(F.lds + SW_K); LAS bf16_t* Vt = (LAS bf16_t*)(F.lds + SW_V);
    __syncthreads();
    swa_load_tables(F, k);
#pragma unroll
    for (int i = 0; i < 4; ++i) {
        const int idx = F.tid + 512 * i, kj = idx >> 3, p = idx & 7, pos = 128 * (n - 1) + kj;
        u32x4 kv = {0u, 0u, 0u, 0u}, vv = {0u, 0u, 0u, 0u};
        if (pos >= 0) { const bf16_t* src = SKV + (size_t)(b * SEQ + pos) * 256 + k * 64 + p * 8; kv = *(const u32x4*)src; vv = *(const u32x4*)(src + 128); }
        *(LAS u32x4*)(Kb + kj * SW_KS + p * 8) = kv;
        const unsigned w[4] = {vv.x, vv.y, vv.z, vv.w};
#pragma unroll
        for (int e = 0; e < 4; ++e) { Vt[(8 * p + 2 * e) * SW_VS + kj] = (bf16_t)(w[e] & 0xffffu); Vt[(8 * p + 2 * e + 1) * SW_VS + kj] = (bf16_t)(w[e] >> 16); }
    }
    __syncthreads();
    const int h = k * 8 + F.wave; const float sink2 = F.in[I_SINKS][h] * LOG2E;
#pragma unroll 1
    for (int j = 0; j < 8; ++j) swa_qtile(F, j, h, (size_t)(b * SEQ + 128 * n + 16 * j + (F.lane & 15)), true, n == 0, sink2);
}
__device__ __forceinline__ void swa_sample_unit(Frame& F, int unit) {
    const int k = unit & 1, b = unit >> 1;
    const bf16_t* SKV = (const bf16_t*)(F.ws + WS_SKV);
    LAS bf16_t* Kb = (LAS bf16_t*)(F.lds + SW_K); LAS bf16_t* Vt = (LAS bf16_t*)(F.lds + SW_V);
    __syncthreads();
    swa_load_tables(F, k);
#pragma unroll
    for (int i = 0; i < 4; ++i) {
        const int idx = F.tid + 512 * i, kj = idx >> 4, p = idx & 15;
        const size_t so = ((size_t)(b * 128 + kj) * 2 + k) * 64 + p * 4;
        const f32x4 kv = *(const f32x4*)(F.in[I_CSK] + so), vv = *(const f32x4*)(F.in[I_CSV] + so);
        *(LAS u32x2*)(Kb + kj * SW_KS + p * 4) = pack4(kv);
#pragma unroll
        for (int e = 0; e < 4; ++e) Vt[(4 * p + e) * SW_VS + kj] = f2bf(vv[e]);
        if (kj >= 4) { const size_t dof = ((size_t)(b * 128 + kj - 4) * 2 + k) * 64 + p * 4; *(f32x4*)(F.out + O_SSK + dof) = kv; *(f32x4*)(F.out + O_SSV + dof) = vv; }
    }
    if (F.tid < 128) {
        const int kj = 128 + (F.tid >> 3), p = F.tid & 7;
        u32x4 kv = {0u, 0u, 0u, 0u}, vv = {0u, 0u, 0u, 0u};
        if (kj < 132) { const bf16_t* src = SKV + (size_t)(TP + 4 * b + (kj - 128)) * 256 + k * 64 + p * 8; kv = *(const u32x4*)src; vv = *(const u32x4*)(src + 128); }
        *(LAS u32x4*)(Kb + kj * SW_KS + p * 8) = kv;
        const unsigned w[4] = {vv.x, vv.y, vv.z, vv.w};
#pragma unroll
        for (int e = 0; e < 4; ++e) { Vt[(8 * p + 2 * e) * SW_VS + kj] = (bf16_t)(w[e] & 0xffffu); Vt[(8 * p + 2 * e + 1) * SW_VS + kj] = (bf16_t)(w[e] >> 16); }
    }
    __syncthreads();
    const int h = k * 8 + F.wave, l15 = F.lane & 15; const float sink2 = F.in[I_SINKS][h] * LOG2E;
    swa_qtile(F, 0, h, (size_t)(TP + 4 * b + (l15 < 4 ? l15 : 3)), l15 < 4, false, sink2);
}

constexpr int MA_KS = 136, MA_VS = 264;
constexpr int MA_K = 0, MA_V = 256 * MA_KS * 2, MA_END = MA_V + 128 * MA_VS * 2;
static_assert(MA_END <= LDS_BYTES, "memattn LDS");
__device__ __forceinline__ void memattn_prompt_unit(Frame& F, int unit) {
    const int h = unit & 3, pm = unit >> 2, b = pm >> 4;
    const bf16_t* MK = (const bf16_t*)(F.ws + WS_MK); const bf16_t* MVT = (const bf16_t*)(F.ws + WS_MVT);
    const bf16_t* QM = (const bf16_t*)(F.ws + WS_QM); bf16_t* OM = (bf16_t*)(F.ws + WS_OM);
    LAS bf16_t* Kh = (LAS bf16_t*)(F.lds + MA_K); LAS bf16_t* Vt = (LAS bf16_t*)(F.lds + MA_V);
    const int lane = F.lane, l15 = lane & 15, g4 = lane >> 4;
    __syncthreads();
#pragma unroll
    for (int i = 0; i < 8; ++i) {
        const int idx = F.tid + 512 * i;
        { const int m = idx >> 4, p = idx & 15; *(LAS u32x4*)(Kh + m * MA_KS + p * 8) = *(const u32x4*)(MK + (size_t)(b * 256 + m) * 512 + h * 128 + p * 8); }
        { const int d = idx >> 5, p = idx & 31; *(LAS u32x4*)(Vt + d * MA_VS + p * 8) = *(const u32x4*)(MVT + ((size_t)(b * 4 + h) * 128 + d) * 256 + p * 8); }
    }
    __syncthreads();
#pragma unroll 1
    for (int jj = 0; jj < 2; ++jj) {
        const size_t row = (size_t)pm * 256 + 16 * (2 * F.wave + jj) + l15;
        bf16x8 qf[4];
#pragma unroll
        for (int kk = 0; kk < 4; ++kk) qf[kk] = *(const bf16x8*)(QM + row * 512 + h * 128 + 32 * kk + 8 * g4);
        f32x4 s[16]; float mx = -INFINITY;
#pragma unroll
        for (int mt = 0; mt < 16; ++mt) {
            f32x4 acc = {0.f, 0.f, 0.f, 0.f};
#pragma unroll
            for (int kk = 0; kk < 4; ++kk) {
                const bf16x8 a = *(const LAS bf16x8*)(Kh + (16 * mt + l15) * MA_KS + 32 * kk + 8 * g4);
                acc = __builtin_amdgcn_mfma_f32_16x16x32_bf16(a, qf[kk], acc, 0, 0, 0);
            }
            s[mt] = acc; mx = fmaxf(fmaxf(mx, fmaxf(acc[0], acc[1])), fmaxf(acc[2], acc[3]));
            __builtin_amdgcn_sched_barrier(0);
        }
        mx = fmaxf(mx, __shfl_xor(mx, 16)); mx = fmaxf(mx, __shfl_xor(mx, 32));
        float sum = 0.f; bf16x8 pb[8];
#pragma unroll
        for (int i = 0; i < 8; ++i) {
            f32x4 p0, p1;
#pragma unroll
            for (int r = 0; r < 4; ++r) { p0[r] = __builtin_amdgcn_exp2f(s[2 * i][r] - mx); p1[r] = __builtin_amdgcn_exp2f(s[2 * i + 1][r] - mx); sum += p0[r] + p1[r]; }
            pb[i] = __builtin_bit_cast(bf16x8, pack8(p0, p1));
        }
        sum += __shfl_xor(sum, 16); sum += __shfl_xor(sum, 32);
        const float inv = 1.0f / sum;
#pragma unroll
        for (int dt = 0; dt < 8; ++dt) {
            f32x4 o = {0.f, 0.f, 0.f, 0.f};
#pragma unroll
            for (int i = 0; i < 8; ++i) {
                const bf16x4 a0 = *(const LAS bf16x4*)(Vt + (16 * dt + l15) * MA_VS + 32 * i + 4 * g4);
                const bf16x4 a1 = *(const LAS bf16x4*)(Vt + (16 * dt + l15) * MA_VS + 32 * i + 16 + 4 * g4);
                const bf16x8 a = {a0[0], a0[1], a0[2], a0[3], a1[0], a1[1], a1[2], a1[3]};
                o = __builtin_amdgcn_mfma_f32_16x16x32_bf16(a, pb[i], o, 0, 0, 0);
            }
            *(u32x2*)(OM + row * 512 + h * 128 + 16 * dt + 4 * g4) = pack4(o * inv);
            __builtin_amdgcn_sched_barrier(0);
        }
    }
}
constexpr int MSP_P = 0, MSP_O = 8192, MSP_ML = 8192 + 16384;
__device__ __forceinline__ void memattn_sample_block(Frame& F, int task) {
    const int hp = task & 1, b = task >> 1, w = F.wave, h = 2 * hp + (w >> 2), kq = w & 3;
    const float* CK = F.in[I_CMK] + ((size_t)b * 256 + 64 * kq) * 512 + h * 128; const float* CV = F.in[I_CMV] + ((size_t)b * 256 + 64 * kq) * 512 + h * 128;
    const bf16_t* QM = (const bf16_t*)(F.ws + WS_QM); bf16_t* OM = (bf16_t*)(F.ws + WS_OM);
    const int lane = F.lane, l15 = lane & 15, g4 = lane >> 4;
    LAS float* pl = (LAS float*)(F.lds + MSP_P) + w * 256; LAS float* po = (LAS float*)(F.lds + MSP_O) + w * 512; LAS float* ml = (LAS float*)(F.lds + MSP_ML);
    __syncthreads();
    bf16x8 qf[4];
#pragma unroll
    for (int kk = 0; kk < 4; ++kk) { qf[kk] = *(const bf16x8*)(QM + (size_t)(TP + 4 * b + (l15 & 3)) * 512 + h * 128 + 32 * kk + 8 * g4); if (l15 >= 4) qf[kk] = (bf16x8){0, 0, 0, 0, 0, 0, 0, 0}; }
    f32x4 s[4]; float mx = -INFINITY;
#pragma unroll
    for (int mt = 0; mt < 4; ++mt) {
        f32x4 acc = {0.f, 0.f, 0.f, 0.f};
#pragma unroll
        for (int kk = 0; kk < 4; ++kk) {
            const float* kp = CK + (size_t)(16 * mt + l15) * 512 + 32 * kk + 8 * g4;
            const u32x4 a = pack8(*(const f32x4*)kp, *(const f32x4*)(kp + 4));
            acc = __builtin_amdgcn_mfma_f32_16x16x32_bf16(__builtin_bit_cast(bf16x8, a), qf[kk], acc, 0, 0, 0);
        }
        s[mt] = acc; mx = fmaxf(fmaxf(mx, fmaxf(acc[0], acc[1])), fmaxf(acc[2], acc[3]));
    }
    mx = fmaxf(mx, __shfl_xor(mx, 16)); mx = fmaxf(mx, __shfl_xor(mx, 32));
    float sum = 0.f;
#pragma unroll
    for (int mt = 0; mt < 4; ++mt)
#pragma unroll
        for (int r = 0; r < 4; ++r) { const float p = __builtin_amdgcn_exp2f(s[mt][r] - mx); sum += p; if (l15 < 4) pl[(16 * mt + 4 * g4 + r) * 4 + l15] = p; }
    sum += __shfl_xor(sum, 16); sum += __shfl_xor(sum, 32);
    if (lane < 4) { ml[w * 8 + lane] = mx; ml[w * 8 + 4 + lane] = sum; }
    LDS_WAIT(); asm volatile("" ::: "memory");
    f32x2 o[4] = {{0.f, 0.f}, {0.f, 0.f}, {0.f, 0.f}, {0.f, 0.f}};
#pragma unroll 16
    for (int m = 0; m < 64; ++m) {
        const f32x2 v = *(const f32x2*)(CV + (size_t)m * 512 + 2 * lane);
        const f32x4 p = *(const LAS f32x4*)(pl + m * 4);
#pragma unroll
        for (int t = 0; t < 4; ++t) { o[t][0] += p[t] * v[0]; o[t][1] += p[t] * v[1]; }
    }
#pragma unroll
    for (int t = 0; t < 4; ++t) *(LAS f32x2*)(po + t * 128 + 2 * lane) = o[t];
    __syncthreads();
    {
        const int hh = F.tid >> 8, t = (F.tid >> 6) & 3, d = 2 * (F.tid & 63);
        float mq[4], M = -INFINITY;
#pragma unroll
        for (int q = 0; q < 4; ++q) { mq[q] = ml[(hh * 4 + q) * 8 + t]; M = fmaxf(M, mq[q]); }
        float den = 0.f; f32x2 num = {0.f, 0.f};
#pragma unroll
        for (int q = 0; q < 4; ++q) { const float f = __builtin_amdgcn_exp2f(mq[q] - M); den += f * ml[(hh * 4 + q) * 8 + 4 + t];
            const f32x2 oq = *(const LAS f32x2*)((LAS float*)(F.lds + MSP_O) + (hh * 4 + q) * 512 + t * 128 + d); num[0] += f * oq[0]; num[1] += f * oq[1]; }
        const float inv = 1.0f / den;
        *(unsigned*)(OM + (size_t)(TP + 4 * b + t) * 512 + (2 * hp + hh) * 128 + d) = cvtpk(num[0] * inv, num[1] * inv);
    }
}

__device__ __forceinline__ void final_norm_row_slabs(float* xrow, const float* slab_row, size_t slab_stride, int ns, const float* w, int lane) {
    f32x4* xr = (f32x4*)xrow + lane; const f32x4* wr = (const f32x4*)w + lane;
    f32x4 v[8]; float s = 0.f;
#pragma unroll
    for (int j = 0; j < 8; ++j) v[j] = xr[64 * j];
    for (int k = 0; k < ns; ++k) { const f32x4* sr = (const f32x4*)(slab_row + (size_t)k * slab_stride) + lane;
#pragma unroll
        for (int j = 0; j < 8; ++j) v[j] += sr[64 * j]; }
#pragma unroll
    for (int j = 0; j < 8; ++j) s += (v[j][0] * v[j][0] + v[j][1] * v[j][1]) + (v[j][2] * v[j][2] + v[j][3] * v[j][3]);
    const float rs = __builtin_amdgcn_rsqf(wave_sum(s) * (1.0f / DM) + RMS_EPS);
#pragma unroll
    for (int j = 0; j < 8; ++j) { const f32x4 ww = wr[64 * j]; f32x4 y; y[0] = v[j][0] * rs * ww[0]; y[1] = v[j][1] * rs * ww[1]; y[2] = v[j][2] * rs * ww[2]; y[3] = v[j][3] * rs * ww[3]; xr[64 * j] = y; }
}
__device__ __forceinline__ void final_norm_row(float* xrow, const float* SS, int row, const float* w, int lane) {
    const float rs = row_rs(SS, row);
    f32x4* xr = (f32x4*)xrow + lane; const f32x4* wr = (const f32x4*)w + lane;
#pragma unroll
    for (int j = 0; j < 8; ++j) { f32x4 v = xr[64 * j]; const f32x4 ww = wr[64 * j]; v[0] = v[0] * rs * ww[0]; v[1] = v[1] * rs * ww[1]; v[2] = v[2] * rs * ww[2]; v[3] = v[3] * rs * ww[3]; xr[64 * j] = v; }
}

#define HGRN_SCAN_PROMPT hgrn_scan
#define HGRN_SCAN_SAMPLE hgrn_scan
#ifdef HY_P3DELAY
#define P3_DELAY do { for (int z_ = 0; z_ < 16; ++z_) __builtin_amdgcn_s_sleep(127); __syncthreads(); } while (0)
#else
#define P3_DELAY do {} while (0)
#endif
#define XB_TMO      128
#define XB_XCNT(j)  (256  + 64 * (j))
#define XB_XSUB(j)  (1280 + 64 * (j))
#define XB_XGEN(j)  (2304 + 64 * (j))
#define XB_TOP      3328
#define XB_TOPGEN   3392
#define XCD_BAR_WORDS 3456
#define XB_SPIN_CAP (1u << 18)

__device__ __forceinline__ unsigned xb_ld(unsigned* p)              { return __hip_atomic_load(p, __ATOMIC_RELAXED, __HIP_MEMORY_SCOPE_AGENT); }
__device__ __forceinline__ unsigned xb_add(unsigned* p, unsigned v) { return __hip_atomic_fetch_add(p, v, __ATOMIC_RELAXED, __HIP_MEMORY_SCOPE_AGENT); }
__device__ __forceinline__ unsigned xb_xcc_id() { return (unsigned)__builtin_amdgcn_s_getreg((3 << 11) | 20) & 0xFu; }
#define XB_SPIN(cond, bar) do { unsigned _sp = 0; while (cond) { __builtin_amdgcn_s_sleep(1); \
    if ((++_sp & 255u) == 0u) { if (xb_ld(&(bar)[XB_TMO])) break; if (_sp > XB_SPIN_CAP) { atomicAdd(&(bar)[XB_TMO], 1u); break; } } } } while (0)

struct XcdBarrier {
    unsigned* bar; unsigned x;
    volatile LAS unsigned* st;
};

__device__ __forceinline__ XcdBarrier xcd_barrier_post(unsigned* bar, volatile LAS unsigned* st) {
    XcdBarrier b; b.bar = bar; b.x = xb_xcc_id(); b.st = st;
    if (threadIdx.x == 0) (void)xb_add(&bar[XB_XCNT(b.x)], 1u);
    return b;
}
__device__ __forceinline__ void xcd_barrier_complete(unsigned* bar, unsigned x, unsigned& nloc, unsigned& nx) {
    const unsigned G = gridDim.x * gridDim.y * gridDim.z;
    unsigned sum, cnt, mine, sp = 0u;
    for (;;) {
        sum = 0u; cnt = 0u; mine = 0u;
#pragma unroll
        for (unsigned j = 0; j < 16; ++j) { const unsigned c = xb_ld(&bar[XB_XCNT(j)]); sum += c; cnt += (c > 0u) ? 1u : 0u; mine = (j == x) ? c : mine; }
        if (sum == G) break;
        __builtin_amdgcn_s_sleep(1);
        if ((++sp & 255u) == 0u) { if (xb_ld(&bar[XB_TMO])) break; if (sp > XB_SPIN_CAP) { atomicAdd(&bar[XB_TMO], 1u); break; } }
    }
    nloc = mine > 0u ? mine : 1u; nx = cnt > 0u ? cnt : 1u;
}

__device__ __forceinline__ void xcd_barrier(const XcdBarrier& b) {
    asm volatile("s_waitcnt vmcnt(0)" ::: "memory");
    __syncthreads();
    if (threadIdx.x == 0) {
        unsigned* bar = b.bar;
        __builtin_amdgcn_s_waitcnt(0);
        unsigned nloc = b.st[0], nx = b.st[1];
        if (nloc == 0u) { xcd_barrier_complete(bar, b.x, nloc, nx); b.st[0] = nloc; b.st[1] = nx; }
        const unsigned old = xb_add(&bar[XB_XSUB(b.x)], 1u);
        const unsigned gen = old / nloc;
        if (old + 1u == (gen + 1u) * nloc) {
            __builtin_amdgcn_fence(__ATOMIC_RELEASE, "agent");
            asm volatile("s_waitcnt vmcnt(0)" ::: "memory");
            const unsigned og = xb_add(&bar[XB_TOP], 1u);
            const unsigned tg = og / nx;
            if (og + 1u == (tg + 1u) * nx) xb_add(&bar[XB_TOPGEN], 1u);
            else XB_SPIN(xb_ld(&bar[XB_TOPGEN]) == tg, bar);
            __builtin_amdgcn_fence(__ATOMIC_ACQUIRE, "agent");
            xb_add(&bar[XB_XGEN(b.x)], 1u);
            asm volatile("s_waitcnt vmcnt(0)" ::: "memory");
        } else {
            XB_SPIN(xb_ld(&bar[XB_XGEN(b.x)]) == gen, bar);
            __builtin_amdgcn_fence(__ATOMIC_ACQUIRE, "agent");
            asm volatile("s_waitcnt vmcnt(0)" ::: "memory");
        }
    }
    __syncthreads();
}

constexpr size_t WS_CNT = 4096 + 16384;
constexpr size_t WS_BAR = 4096;
constexpr int LDS_BARST = LDS_BYTES - 64;
constexpr int N_PHASES = 11;
__global__ void __launch_bounds__(NTHREADS, 2) hymba_fwd(Args args) {
    extern __shared__ __attribute__((aligned(16))) unsigned char lds_raw[];
    cg::grid_group grid = cg::this_grid();
    Frame F;
    F.lds = (LAS unsigned char*)lds_raw;
    F.tid = threadIdx.x; F.lane = F.tid & 63; F.wave = __builtin_amdgcn_readfirstlane(F.tid >> 6);
    F.G = gridDim.x; F.bid = blockIdx.x;
    F.in = args.in; F.out = args.out; F.ws = args.ws;
    unsigned char* ws = args.ws; float* out = args.out;
    if (F.tid < 16) ((LAS unsigned*)(F.lds + LDS_BARST))[F.tid] = 0u;
    __syncthreads();
    XcdBarrier xbar = xcd_barrier_post((unsigned*)(ws + WS_BAR), (volatile LAS unsigned*)(F.lds + LDS_BARST));
    if (args.ph_lo > 1000) grid.sync();
#ifdef HY_LDSCLR
    for (int i = F.tid; i < LDS_BYTES / 16; i += NTHREADS) *(LAS u32x4*)(F.lds + i * 16) = (u32x4){0u, 0u, 0u, 0u};
    __syncthreads();
#endif
    const int lo = args.ph_lo, hi = args.ph_hi;
#ifndef HY_PHASE_MASK
#define HY_PHASE_MASK 0x7ff
#endif
#define IN(k) (((HY_PHASE_MASK >> (k)) & 1) && lo <= (k) && (k) < hi)
#ifndef HY_REPMASK
#define HY_REPMASK 0
#endif
#define PHASE(k, ...) do { if (IN(k)) { __VA_ARGS__ } if (IN(k) && ((HY_REPMASK >> (k)) & 1)) { __VA_ARGS__ } } while (0)
#ifdef HY_XACQ
#define SEAM(k) do { if (IN(k) && IN((k) + 1)) { asm volatile("s_waitcnt vmcnt(0)" ::: "memory"); __builtin_amdgcn_fence(__ATOMIC_RELEASE, "agent"); asm volatile("s_waitcnt vmcnt(0)" ::: "memory"); grid.sync(); __builtin_amdgcn_fence(__ATOMIC_ACQUIRE, "agent"); asm volatile("s_waitcnt vmcnt(0)" ::: "memory"); __syncthreads(); } } while (0)
#else
#define SEAM(k) do { if (IN(k) && IN((k) + 1)) { xcd_barrier(xbar); } } while (0)
#endif
    float* SS0 = (float*)(ws + WS_SS); float* SS1 = (float*)(ws + WS_SS + SS_STRIDE); float* SS2 = (float*)(ws + WS_SS + 2 * SS_STRIDE);
    bf16_t* XB = (bf16_t*)(ws + WS_XB);

    PHASE(0, p0_prologue(F););
    SEAM(0);
    PHASE(1,
        { pg8::Gemm g{XB, (const bf16_t*)(ws + WS_WIN), TT, NIN, DM, DM}; pg8::StaticOrder S; S.init(TT, NIN, F.G, F.bid);
          EpiIn E{out, out + (size_t)TT * 1024, (bf16_t*)(out + O_SST), (bf16_t*)(ws + WS_GATE), (bf16_t*)(ws + WS_SQ), (bf16_t*)(ws + WS_SKV), (const float*)(ws + WS_TAB), out};
          pg8::gemm_phase<EpiIn, pg8::StaticOrder, true, true>(F.lds, g, S, E); }
        { pg8::Gemm g{(const bf16_t*)(ws + WS_MN), (const bf16_t*)(ws + WS_WMKV), 1024, 1024, DM, DM}; pg8::StaticOrder S; S.init(1024, 1024, F.G, (F.bid + 16) % F.G);
          EpiMemKV E{(bf16_t*)(ws + WS_MK), (bf16_t*)(ws + WS_MVT), out};
          pg8::gemm_phase<EpiMemKV, pg8::StaticOrder, true, true>(F.lds, g, S, E); }
    );
    SEAM(1);
    PHASE(2, hgrn_prep(F););
    SEAM(2);
    PHASE(3,
        const bool split = F.G > 32;
#define P3_SCAN do { if (F.bid < 32) { P3_DELAY; for (int bh = F.bid; bh < 32; bh += F.G) { const int b = bh >> 3, h = bh & 7; \
                HGRN_SCAN_PROMPT(F, b * 256, 256, h, b * SEQ, 16, nullptr, out + O_PST + (size_t)bh * 16384); } } } while (0)
#define P3_OTHERS do { if (!split || F.bid >= 32) { const int nw = split ? F.G - 32 : F.G; \
            for (int i = split ? F.bid - 32 : F.bid; i < 1536; i += nw) { \
                if (i < 256) swa_prompt_unit(F, i); \
                else if (i < 512) swa_sample_unit(F, i - 256); \
                else { const int t = i - 512, b = t >> 3, h = t & 7; \
                    HGRN_SCAN_SAMPLE(F, NCHP + b, 1, h, TP + 4 * b, 4, F.in[I_STATE] + (size_t)t * 16384, out + O_SST + (size_t)t * 16384); } } } } while (0)
        P3_SCAN;
        if ((HY_REPMASK >> 11) & 1) P3_SCAN;
        P3_OTHERS;
        if (split && F.bid >= 32) {
            const int nw = F.G - 32; unsigned* CNT = (unsigned*)(ws + WS_CNT);
            asm volatile("s_waitcnt vmcnt(0)" ::: "memory"); __syncthreads();
            if (F.tid == 0) {
                __builtin_amdgcn_fence(__ATOMIC_RELEASE, "agent"); asm volatile("s_waitcnt vmcnt(0)" ::: "memory");
                __hip_atomic_fetch_add(CNT, 1u, __ATOMIC_RELAXED, __HIP_MEMORY_SCOPE_AGENT);
                unsigned sp = 0; while (__hip_atomic_load(CNT, __ATOMIC_RELAXED, __HIP_MEMORY_SCOPE_AGENT) < (unsigned)nw) { __builtin_amdgcn_s_sleep(2); if (++sp > (1u << 22)) break; }
                __builtin_amdgcn_fence(__ATOMIC_ACQUIRE, "agent"); asm volatile("s_waitcnt vmcnt(0)" ::: "memory");
            }
            __syncthreads();
            pg8::Gemm g{(const bf16_t*)(ws + WS_MIX), (const bf16_t*)(ws + WS_WOUT), TT, DM, DM / 2, DM}; pg8::StaticOrder S; S.init(TT, DM, nw, F.bid - 32); S.ksv = 1;
            EpiResid E{F.in[I_XP], F.in[I_XS], out, nullptr, nullptr};
            pg8::gemm_phase<EpiResid, pg8::StaticOrder, true, true>(F.lds, g, S, E);
        }
    );
    SEAM(3);
    PHASE(4,
        if (!(F.G > 32)) {
            pg8::Gemm g0{(const bf16_t*)(ws + WS_MIX), (const bf16_t*)(ws + WS_WOUT), TT, DM, DM / 2, DM}; pg8::StaticOrder S0; S0.init(TT, DM, F.G, F.bid); S0.ksv = 1;
            EpiResid E0{F.in[I_XP], F.in[I_XS], out, nullptr, nullptr};
            pg8::gemm_phase<EpiResid, pg8::StaticOrder, true, true>(F.lds, g0, S0, E0);
            xcd_barrier(xbar);
        }
        pg8::Gemm g{(const bf16_t*)(ws + WS_MIX), (const bf16_t*)(ws + WS_WOUT), TT, DM, DM / 2, DM}; pg8::StaticOrder S; S.init(TT, DM, F.G, F.bid);
        EpiResid E{out, out + (size_t)TP * DM, out, XB, SS0};
        pg8::gemm_phase<EpiResid, pg8::StaticOrder, true, true>(F.lds, g, S, E);
    );
    SEAM(4);
    PHASE(5,
        pg8::Gemm g{XB, (const bf16_t*)(ws + WS_WMQ), TT, MEMW, DM, DM}; pg8::StaticOrder S; S.init(TT, MEMW, F.G, F.bid);
        EpiScaleBf16 E{(bf16_t*)(ws + WS_QM), MEMW, SS0, MEM_QSCALE};
        pg8::gemm_phase<EpiScaleBf16, pg8::StaticOrder, true, true>(F.lds, g, S, E);
    );
    SEAM(5);
    PHASE(6,
        for (int u = F.bid; u < 256; u += F.G) memattn_prompt_unit(F, u);
        for (int t = F.bid; t < 256; t += F.G) memattn_sample_block(F, t);
    );
    SEAM(6);
    if (IN(7)) {
        pg8::Gemm g{(const bf16_t*)(ws + WS_OM), (const bf16_t*)(ws + WS_WMO), TT, DM, MEMW, MEMW}; pg8::StaticOrder S; S.init(TT, DM, F.G, F.bid);
        EpiResid E{out, out + (size_t)TP * DM, out, XB, SS1};
        pg8::gemm_phase<EpiResid, pg8::StaticOrder, true, true>(F.lds, g, S, E);
    }
    SEAM(7);
    PHASE(8,
        pg8::Gemm g{XB, (const bf16_t*)(ws + WS_WGU), TT, 2 * FF, DM, DM}; pg8::StaticOrder S; S.init(TT, 2 * FF, F.G, F.bid);
        EpiSwiGLU E{(bf16_t*)(ws + WS_HID), SS1};
        pg8::gemm_phase<EpiSwiGLU, pg8::StaticOrder, true, true>(F.lds, g, S, E);
    );
    SEAM(8);
    constexpr int DN_NS = 11; constexpr size_t SLAB_STRIDE = (size_t)TS * DM;
    if (IN(9)) {
        { pg8::Gemm g{(const bf16_t*)(ws + WS_HID), (const bf16_t*)(ws + WS_WDN), TP, DM, FF, FF}; pg8::StaticOrder S; S.init(TP, DM, F.G, F.bid);
          EpiResid E{out, out + (size_t)TP * DM, out, nullptr, SS2};
          pg8::gemm_phase<EpiResid, pg8::StaticOrder, true, true>(F.lds, g, S, E); }
        { pg8::Gemm g{(const bf16_t*)(ws + WS_HID), (const bf16_t*)(ws + WS_WDN), TT, DM, FF / DN_NS, FF}; SplitOrder S{F.bid, DN_NS};
          EpiSlab E{(float*)(ws + WS_MIX), TP, SLAB_STRIDE};
          pg8::gemm_phase<EpiSlab, SplitOrder, true, true>(F.lds, g, S, E); }
    }
    SEAM(9);
    if (IN(10)) {
        for (int m = F.bid * NWAVES + F.wave; m < TT; m += F.G * NWAVES) {
            if (m < TP) final_norm_row(out + (size_t)m * DM, SS2, m, F.in[I_NFINAL], F.lane);
            else final_norm_row_slabs(out + (size_t)m * DM, (const float*)(ws + WS_MIX) + (size_t)(m - TP) * DM, SLAB_STRIDE, DN_NS, F.in[I_NFINAL], F.lane);
        }
    }
#undef IN
#undef SEAM
}

#ifndef HY_N_LAUNCHES
#define HY_N_LAUNCHES 1
#endif
extern "C" void kernel_launch(void* const* d_in, const int* in_sizes, int n_in, void* d_out, int out_size, void* d_ws, size_t ws_size, hipStream_t stream) {
    static int grid = 0;
    if (grid == 0) {
        if (n_in != 26 || (size_t)out_size != O_END || ws_size < WS_END) { fprintf(stderr, "kernel_launch: unexpected problem: n_in %d out %d ws %zu (need %zu)\n", n_in, out_size, ws_size, (size_t)WS_END); grid = -1; return; }
        int dev = 0, cus = 0, per_cu = 0;
        hipGetDevice(&dev); hipDeviceGetAttribute(&cus, hipDeviceAttributeMultiprocessorCount, dev);
        if (hipFuncSetAttribute((const void*)hymba_fwd, hipFuncAttributeMaxDynamicSharedMemorySize, LDS_BYTES) != hipSuccess) { fprintf(stderr, "kernel_launch: hipFuncSetAttribute failed\n"); grid = -1; return; }
        if (hipOccupancyMaxActiveBlocksPerMultiprocessor(&per_cu, (const void*)hymba_fwd, NTHREADS, LDS_BYTES) != hipSuccess || per_cu < 1) { fprintf(stderr, "kernel_launch: occupancy query says %d blocks/CU\n", per_cu); per_cu = 1; }
        (void)hipGetLastError();
        grid = cus;
        fprintf(stderr, "kernel_launch: %d CUs, occupancy %d blocks/CU, grid %d\n", cus, per_cu, grid);
    }
    if (grid < 0) return;
    Args a{};
    for (int i = 0; i < 26; ++i) a.in[i] = (const float*)d_in[i];
    a.out = (float*)d_out; a.ws = (unsigned char*)d_ws;
    if (hipMemsetAsync((char*)d_ws + WS_BAR, 0, 16384 + 256, stream) != hipSuccess) { fprintf(stderr, "kernel_launch: hipMemsetAsync failed\n"); return; }
#if HY_N_LAUNCHES == 1
    a.ph_lo = 0; a.ph_hi = N_PHASES;
    void* kargs[] = {&a};
    hipError_t e = hipLaunchCooperativeKernel((const void*)hymba_fwd, dim3(grid), dim3(NTHREADS), kargs, LDS_BYTES, stream);
    if (e != hipSuccess) fprintf(stderr, "kernel_launch: cooperative launch failed: %s\n", hipGetErrorString(e));
#else
    for (int p = 0; p < N_PHASES; ++p) {
        a.ph_lo = p; a.ph_hi = p + 1;
        hipLaunchKernelGGL(hymba_fwd, dim3(grid), dim3(NTHREADS), LDS_BYTES, stream, a);
    }
#endif
}
```

```cpp
#include <hip/hip_runtime.h>
#include <hip/hip_cooperative_groups.h>
#include <cstdio>
#include <cstdint>
namespace cg = cooperative_groups;

namespace pg8 {
#define PG8_LAS __attribute__((address_space(3)))
typedef unsigned short bf16_t;
typedef short bf16x8 __attribute__((ext_vector_type(8)));
typedef float f32x4 __attribute__((ext_vector_type(4)));
typedef unsigned u32x4 __attribute__((ext_vector_type(4)));
constexpr int BM = 256, BK = 64, HALF = 128, HTB = HALF * BK * 2  , STAGE_BYTES = 8 * HTB, NXCD = 8, WGM = 8;

__host__ __device__ __forceinline__ int lds_byte(int r, int c) { const int st = (r >> 4) * 2 + (c >> 5), rr = r & 15, cc = c & 31, ob = rr * 64 + cc * 2; return st * 1024 + (ob ^ (((ob >> 9) & 1) << 5)); }
__host__ __device__ __forceinline__ void stage_rc(int b, int& R, int& C) { const int st = b / 1024, sb = b % 1024, swz = sb ^ (((sb >> 9) & 1) << 5); R = (st >> 1) * 16 + swz / 64; C = (st & 1) * 32 + (swz % 64) / 2; }
__host__ __device__ __forceinline__ int perm32(int rho) { const int n = rho >> 4, i = rho & 15; return 8 * (i >> 2) + 4 * n + (i & 3); }

struct Unit { int pm, pn, ks; };
struct Gemm { const bf16_t* A; const bf16_t* Bt; int M, N, K, ld; };

struct StaticOrder {
    int nM, nN, nwg, G, c, ksv = 0;
    __host__ __device__ void init(int M, int N, int G_, int c_) { nM = M / BM; nN = N / BM; nwg = nM * nN; G = G_; c = c_; }
    __host__ __device__ bool next(int i, Unit& u) const {
        const long L = (long)i * G + c; if (L >= nwg) return false;
        int wgid = (int)L; { const int q = nwg / NXCD, r = nwg % NXCD, xcd = wgid % NXCD, off = wgid / NXCD; wgid = (xcd < r ? xcd * (q + 1) : r * (q + 1) + (xcd - r) * q) + off; }
        const int nig = WGM * nN, gid = wgid / nig, fm = gid * WGM, gsz = (nM - fm) < WGM ? (nM - fm) : WGM;
        u.pm = fm + ((wgid % nig) % gsz); u.pn = (wgid % nig) / gsz; u.ks = ksv; return true;
    }
    __device__ __forceinline__ void a_ready(const Unit&) const {}
    __device__ __forceinline__ void done(const Unit&) const {}
};

template <class Epi, class Sched, bool ALIGN_EPI = false, bool SP2 = false>
__device__ __forceinline__ void gemm_phase(PG8_LAS unsigned char* lds, const Gemm g, const Sched& S, const Epi& E) {
    const int tid = threadIdx.x, wid = __builtin_amdgcn_readfirstlane(tid >> 6), lane = tid & 63, wr = wid >> 2, wc = wid & 3, fr = lane & 15, fq = lane >> 4;
    const int K = g.ld, nt = g.K / BK;
    unsigned voffA[2], voffB[2];
#pragma unroll
    for (int i = 0; i < 2; ++i) { int R, C; stage_rc(tid * 16 + i * 8192, R, C); const int Rb = Epi::PERM ? ((R & ~31) + perm32(R & 31)) : R;
        voffA[i] = (unsigned)(R * K + C) * 2u; voffB[i] = (unsigned)(Rb * K + C) * 2u; }
    const size_t kstep = (size_t)(BK * 2);
    const size_t hstep = (size_t)HALF * K * 2;
    const size_t tstep = 2 * hstep;
    const unsigned ldsw = (unsigned)wid * 1024u;
    const int aoff = lds_byte(wr * 64 + fr, fq * 8), boff = lds_byte(wc * 32 + fr, fq * 8);
#define PG8_SA(b, h) (((b) * 2 + (h)) * HTB)
#define PG8_SB(b, h) ((4 + (b) * 2 + (h)) * HTB)
#define PG8_STAGE(bufoff, gbase, voff) do { _Pragma("unroll") for (int _i = 0; _i < 2; ++_i) \
        __builtin_amdgcn_global_load_lds((const unsigned*)((const char*)(gbase) + (voff)[_i]), (PG8_LAS unsigned*)(lds + (bufoff) + ldsw + _i * 8192), 16, 0, 0); } while (0)
#define PG8_LDA(dst, b, h) do { _Pragma("unroll") for (int m = 0; m < 4; ++m) _Pragma("unroll") for (int k = 0; k < 2; ++k) dst[m][k] = *(const PG8_LAS bf16x8*)(lds + PG8_SA(b, h) + aoff + m * 2048 + k * 1024); } while (0)
#define PG8_LDB(dst, b, h) do { _Pragma("unroll") for (int n = 0; n < 2; ++n) _Pragma("unroll") for (int k = 0; k < 2; ++k) dst[n][k] = *(const PG8_LAS bf16x8*)(lds + PG8_SB(b, h) + boff + n * 2048 + k * 1024); } while (0)
#define PG8_MMA(ai, bj, At, Bt) do { __builtin_amdgcn_s_setprio(1); _Pragma("unroll") for (int m = 0; m < 4; ++m) _Pragma("unroll") for (int n = 0; n < 2; ++n) _Pragma("unroll") for (int k = 0; k < 2; ++k) \
        acc[ai][bj][m][n] = __builtin_amdgcn_mfma_f32_16x16x32_bf16(Bt[n][k], At[m][k], acc[ai][bj][m][n], 0, 0, 0); __builtin_amdgcn_s_setprio(0); } while (0)
#define PG8_WAIT_V(n) asm volatile("s_waitcnt vmcnt(" #n ")" ::: "memory")
#define PG8_WAIT_L(n) asm volatile("s_waitcnt lgkmcnt(" #n ")" ::: "memory")
#define PG8_BAR __builtin_amdgcn_s_barrier()
#define PG8_SCHED __builtin_amdgcn_sched_barrier(0)
    Unit cur, nxt; int ui = 0;
    if (!S.next(0, cur)) return;
    f32x4 acc[2][2][4][2];
#pragma unroll
    for (int a = 0; a < 2; ++a)
#pragma unroll
        for (int b = 0; b < 2; ++b)
#pragma unroll
            for (int m = 0; m < 4; ++m)
#pragma unroll
                for (int n = 0; n < 2; ++n) acc[a][b][m][n] = (f32x4){0.f, 0.f, 0.f, 0.f};
    bf16x8 At[4][2], B0[2][2], B1[2][2];
    const char* cA = (const char*)g.A + (size_t)cur.pm * tstep + (size_t)cur.ks * g.K * 2; const char* cB = (const char*)g.Bt + (size_t)cur.pn * tstep + (size_t)cur.ks * g.K * 2;
    S.a_ready(cur);
    if constexpr (SP2) {
        PG8_STAGE(PG8_SB(0, 0), cB, voffB); PG8_STAGE(PG8_SB(0, 1), cB + hstep, voffB); PG8_STAGE(PG8_SA(0, 0), cA, voffA); PG8_STAGE(PG8_SA(0, 1), cA + hstep, voffA);
        if (wr == 1) PG8_BAR;
        PG8_WAIT_V(2); PG8_BAR;
        PG8_STAGE(PG8_SB(1, 0), cB + kstep, voffB); PG8_STAGE(PG8_SA(1, 0), cA + kstep, voffA); PG8_STAGE(PG8_SB(1, 1), cB + hstep + kstep, voffB);
        PG8_WAIT_V(6); PG8_BAR;
    } else {
        PG8_STAGE(PG8_SB(0, 0), cB, voffB); PG8_STAGE(PG8_SA(0, 0), cA, voffA); PG8_STAGE(PG8_SB(0, 1), cB + hstep, voffB); PG8_STAGE(PG8_SA(0, 1), cA + hstep, voffA);
        if (wr == 1) PG8_BAR;
        PG8_WAIT_V(4); PG8_BAR;
        PG8_STAGE(PG8_SB(1, 0), cB + kstep, voffB); PG8_STAGE(PG8_SA(1, 0), cA + kstep, voffA); PG8_STAGE(PG8_SB(1, 1), cB + hstep + kstep, voffB);
        PG8_WAIT_V(6); PG8_BAR;
    }
    for (;;) {
        const bool has_next = S.next(ui + 1, nxt);
        const char* nA = has_next ? (const char*)g.A + (size_t)nxt.pm * tstep + (size_t)nxt.ks * g.K * 2 : cA; const char* nB = has_next ? (const char*)g.Bt + (size_t)nxt.pn * tstep + (size_t)nxt.ks * g.K * 2 : cB;
        for (int t = 0; t < nt; t += 2) {
            const bool last = (t == nt - 2);
            const char* a1 = cA + (size_t)(t + 1) * kstep;
            const char* a2 = last ? nA : cA + (size_t)(t + 2) * kstep; const char* b2 = last ? nB : cB + (size_t)(t + 2) * kstep;
            const char* a3 = a2 + kstep; const char* b3 = b2 + kstep;
            if (last && has_next) S.a_ready(nxt);
            if constexpr (SP2) {
            PG8_LDB(B0, 0, 0); PG8_LDB(B1, 0, 1); PG8_SCHED; PG8_LDA(At, 0, 0); PG8_STAGE(PG8_SA(1, 1), a1 + hstep, voffA);
            PG8_WAIT_V(8); PG8_WAIT_L(0); PG8_BAR; PG8_MMA(0, 0, At, B0); PG8_MMA(0, 1, At, B1); PG8_BAR; PG8_SCHED;
            PG8_LDA(At, 0, 1); PG8_STAGE(PG8_SB(0, 0), b2, voffB); PG8_STAGE(PG8_SB(0, 1), b2 + hstep, voffB); PG8_STAGE(PG8_SA(0, 0), a2, voffA);
            PG8_WAIT_V(8); PG8_WAIT_L(0); PG8_BAR; PG8_MMA(1, 0, At, B0); PG8_MMA(1, 1, At, B1); PG8_BAR; PG8_SCHED;
            PG8_LDB(B0, 1, 0); PG8_LDB(B1, 1, 1); PG8_SCHED; PG8_LDA(At, 1, 0); PG8_STAGE(PG8_SA(0, 1), a2 + hstep, voffA);
            PG8_WAIT_V(8); PG8_WAIT_L(0); PG8_BAR; PG8_MMA(0, 0, At, B0); PG8_MMA(0, 1, At, B1); PG8_BAR; PG8_SCHED;
            PG8_LDA(At, 1, 1); PG8_STAGE(PG8_SB(1, 0), b3, voffB); PG8_STAGE(PG8_SB(1, 1), b3 + hstep, voffB); PG8_STAGE(PG8_SA(1, 0), a3, voffA);
            PG8_WAIT_V(8); PG8_WAIT_L(0); PG8_BAR; PG8_MMA(1, 0, At, B0); PG8_MMA(1, 1, At, B1); PG8_BAR; PG8_SCHED;
            } else {
            PG8_LDB(B0, 0, 0); PG8_SCHED; PG8_LDA(At, 0, 0); PG8_STAGE(PG8_SA(1, 1), a1 + hstep, voffA);
            PG8_WAIT_L(8); PG8_BAR; PG8_WAIT_L(0); PG8_MMA(0, 0, At, B0); PG8_BAR; PG8_SCHED;
            PG8_LDB(B1, 0, 1); PG8_STAGE(PG8_SB(0, 0), b2, voffB);
            PG8_BAR; PG8_WAIT_L(0); PG8_MMA(0, 1, At, B1); PG8_BAR;
            PG8_LDA(At, 0, 1); PG8_STAGE(PG8_SA(0, 0), a2, voffA);
            PG8_BAR; PG8_WAIT_L(0); PG8_MMA(1, 0, At, B0); PG8_BAR; PG8_SCHED;
            PG8_STAGE(PG8_SB(0, 1), b2 + hstep, voffB);
            PG8_WAIT_V(6); PG8_BAR; PG8_MMA(1, 1, At, B1); PG8_BAR;
            PG8_LDB(B0, 1, 0); PG8_SCHED; PG8_LDA(At, 1, 0); PG8_STAGE(PG8_SA(0, 1), a2 + hstep, voffA);
            PG8_WAIT_L(8); PG8_BAR; PG8_WAIT_L(0); PG8_MMA(0, 0, At, B0); PG8_BAR; PG8_SCHED;
            PG8_LDB(B1, 1, 1); PG8_STAGE(PG8_SB(1, 0), b3, voffB);
            PG8_BAR; PG8_WAIT_L(0); PG8_MMA(0, 1, At, B1); PG8_BAR;
            PG8_LDA(At, 1, 1); PG8_STAGE(PG8_SA(1, 0), a3, voffA);
            PG8_BAR; PG8_WAIT_L(0); PG8_MMA(1, 0, At, B0); PG8_BAR; PG8_SCHED;
            PG8_STAGE(PG8_SB(1, 1), b3 + hstep, voffB);
            PG8_WAIT_V(6); PG8_BAR; PG8_MMA(1, 1, At, B1); PG8_BAR;
            }
        }
        if constexpr (ALIGN_EPI) { if (wr == 0) PG8_BAR; }
        if constexpr (!Epi::AFTER_DRAIN) { E(acc, cur, wr, wc, fr, fq); S.done(cur); }
        if (!has_next) break;
#pragma unroll
        for (int a = 0; a < 2; ++a)
#pragma unroll
            for (int b = 0; b < 2; ++b)
#pragma unroll
                for (int m = 0; m < 4; ++m)
#pragma unroll
                    for (int n = 0; n < 2; ++n) acc[a][b][m][n] = (f32x4){0.f, 0.f, 0.f, 0.f};
        cur = nxt; cA = nA; cB = nB; ++ui;
        if constexpr (ALIGN_EPI) { if (wr == 1) PG8_BAR; }
    }
    PG8_WAIT_V(0);
    if constexpr (!ALIGN_EPI) { if (wr == 0) PG8_BAR; }
    PG8_BAR;
    if constexpr (Epi::AFTER_DRAIN) { E.fused(acc, cur, wr, wc, fr, fq, lds, wid, lane); S.done(cur); }
#undef PG8_SA
#undef PG8_SB
#undef PG8_STAGE
#undef PG8_LDA
#undef PG8_LDB
#undef PG8_MMA
#undef PG8_WAIT_V
#undef PG8_WAIT_L
#undef PG8_BAR
#undef PG8_SCHED
}
}

#define LAS __attribute__((address_space(3)))
typedef unsigned short bf16_t;
typedef short bf16x8 __attribute__((ext_vector_type(8)));
typedef short bf16x4 __attribute__((ext_vector_type(4)));
typedef float f32x4 __attribute__((ext_vector_type(4)));
typedef float f32x2 __attribute__((ext_vector_type(2)));
typedef unsigned u32x4 __attribute__((ext_vector_type(4)));
typedef unsigned u32x2 __attribute__((ext_vector_type(2)));
typedef __bf16 hbf16x2 __attribute__((ext_vector_type(2)));

constexpr int DM = 2048, TP = 16384, TS = 512, TT = TP + TS, SEQ = 4096, DB = 128;
constexpr int NIN = 5376, FF = 5632, MEMW = 512;
constexpr int NCHP = TP / 16, NCH = NCHP + DB;
constexpr float RMS_EPS = 1e-6f;
constexpr float LOG2E = 1.4426950408889634f;
constexpr float SWA_QSCALE = 0.125f * LOG2E;
constexpr float MEM_QSCALE = 0.08838834764831845f * LOG2E;
constexpr int NWAVES = 8, NTHREADS = 512;
constexpr int LDS_BYTES = 147456;

constexpr size_t O_YP = 0, O_YS = 33554432, O_PST = 34603008, O_PSK = 35127296, O_PSV = 35192832, O_PMK = 35258368, O_PMV = 35782656,
                 O_SST = 36306944, O_SSK = 53084160, O_SSV = 55181312, O_END = 57278464;
constexpr size_t MiB = 1u << 20;
constexpr size_t WS_TAB = 1 * MiB;
constexpr size_t WS_WIN = 2 * MiB, WS_WOUT = 23 * MiB, WS_WMQ = 31 * MiB, WS_WMKV = 33 * MiB, WS_WMO = 37 * MiB, WS_WGU = 39 * MiB, WS_WDN = 83 * MiB;
constexpr size_t WS_SS = 105 * MiB;
constexpr size_t SS_STRIDE = 2359296;
constexpr size_t WS_MK = 112 * MiB, WS_MVT = 113 * MiB, WS_QM = 114 * MiB, WS_OM = 131 * MiB, WS_MN = 148 * MiB, WS_XB = 152 * MiB;
constexpr size_t WS_D = 218 * MiB;
constexpr size_t WS_GATE = WS_D, WS_SQ = WS_D + 33 * MiB, WS_SKV = WS_D + 66 * MiB, WS_QIN = WS_D + 75 * MiB, WS_KT = WS_D + 111 * MiB, WS_VT = WS_D + 147 * MiB,
                 WS_PSC = WS_D + 183 * MiB, WS_DEC = WS_D + 188 * MiB, WS_MIX = WS_D + 193 * MiB, WS_END = WS_D + 259 * MiB;
constexpr size_t WS_HID = WS_D;
static_assert((size_t)TT * FF * 2 <= 183 * MiB, "HID overlay");

struct Args {
    const float* in[26];
    float* out; unsigned char* ws;
    int ph_lo, ph_hi;
};

__device__ __forceinline__ unsigned cvtpk(float lo, float hi) { f32x2 v = {lo, hi}; hbf16x2 b = __builtin_convertvector(v, hbf16x2); return __builtin_bit_cast(unsigned, b); }
__device__ __forceinline__ float bf2f(unsigned short b) { return __uint_as_float((unsigned)b << 16); }
__device__ __forceinline__ unsigned short f2bf(float f) { return (unsigned short)(cvtpk(f, 0.f) & 0xffffu); }
__device__ __forceinline__ u32x4 pack8(f32x4 a, f32x4 b) { u32x4 w; w.x = cvtpk(a[0], a[1]); w.y = cvtpk(a[2], a[3]); w.z = cvtpk(b[0], b[1]); w.w = cvtpk(b[2], b[3]); return w; }
__device__ __forceinline__ u32x2 pack4(f32x4 a) { u32x2 w; w.x = cvtpk(a[0], a[1]); w.y = cvtpk(a[2], a[3]); return w; }
__device__ __forceinline__ float fexp(float x) { return __builtin_amdgcn_exp2f(x * LOG2E); }
__device__ __forceinline__ float fsigmoid(float x) { return __builtin_amdgcn_rcpf(1.0f + fexp(-x)); }
__device__ __forceinline__ float wave_sum(float v) {
#pragma unroll
    for (int o = 1; o < 64; o <<= 1) v += __shfl_xor(v, o);
    return v;
}
#define LDS_WAIT() asm volatile("s_waitcnt lgkmcnt(0)" ::: "memory")

__device__ __forceinline__ float row_rs(const float* SS, int row) {
    const f32x4* p = (const f32x4*)(SS + (size_t)row * 32);
    f32x4 s = p[0];
#pragma unroll
    for (int i = 1; i < 8; ++i) s += p[i];
    return __builtin_amdgcn_rsqf(((s[0] + s[1]) + (s[2] + s[3])) * (1.0f / DM) + RMS_EPS);
}

using pg8::Unit;
struct EpiIn {
    static constexpr bool PERM = true, AFTER_DRAIN = false;
    float* QF; float* GF; bf16_t* VB; bf16_t* GATE; bf16_t* SQ; bf16_t* SKV; const float* LB; float* out;
    __device__ __forceinline__ void operator()(const f32x4 (&acc)[2][2][4][2], const Unit& u, int wr, int wc, int fr, int fq) const {
        const int pn = u.pn;
#pragma unroll
        for (int ai = 0; ai < 2; ++ai)
#pragma unroll
            for (int m = 0; m < 4; ++m) {
                const int row = u.pm * 256 + ai * 128 + wr * 64 + m * 16 + fr;
#pragma unroll
                for (int bj = 0; bj < 2; ++bj) {
                    const int c = pn * 256 + bj * 128 + wc * 32 + 8 * fq;
                    f32x4 v0 = acc[ai][bj][m][0], v1 = acc[ai][bj][m][1];
                    if (pn < 4) {
                        float* d = QF + (size_t)row * 1024 + c; *(f32x4*)d = v0; *(f32x4*)(d + 4) = v1;
                    } else if (pn < 8) {
                        const int cc = c - 1024;
                        const f32x4 l0 = *(const f32x4*)(LB + cc), l1 = *(const f32x4*)(LB + cc + 4);
#pragma unroll
                        for (int j = 0; j < 4; ++j) { v0[j] = __logf(l0[j] + (1.0f - l0[j]) * fsigmoid(v0[j])); v1[j] = __logf(l1[j] + (1.0f - l1[j]) * fsigmoid(v1[j])); }
                        float* d = GF + (size_t)row * 1024 + cc; *(f32x4*)d = v0; *(f32x4*)(d + 4) = v1;
                    } else if (pn < 12) {
                        *(u32x4*)(VB + (size_t)row * 1024 + (c - 2048)) = pack8(v0, v1);
                    } else if (pn < 16) {
#pragma unroll
                        for (int j = 0; j < 4; ++j) { v0[j] = v0[j] * fsigmoid(v0[j]); v1[j] = v1[j] * fsigmoid(v1[j]); }
                        *(u32x4*)(GATE + (size_t)row * 1024 + (c - 3072)) = pack8(v0, v1);
                    } else if (pn < 20) {
                        *(u32x4*)(SQ + (size_t)row * 1024 + (c - 4096)) = pack8(v0 * SWA_QSCALE, v1 * SWA_QSCALE);
                    } else {
                        const int cc = c - 5120;
                        *(u32x4*)(SKV + (size_t)row * 256 + cc) = pack8(v0, v1);
                        float* d = nullptr;
                        if (row < TP) { const int b = row >> 12, t = row & 4095; if (t >= SEQ - 128) d = out + (bj == 0 ? O_PSK : O_PSV) + (size_t)(b * 128 + (t - (SEQ - 128))) * 128 + (cc & 127); }
                        else { const int rs = row - TP, b = rs >> 2, t = rs & 3; d = out + (bj == 0 ? O_SSK : O_SSV) + (size_t)(b * 128 + 124 + t) * 128 + (cc & 127); }
                        if (d) { *(f32x4*)d = v0; *(f32x4*)(d + 4) = v1; }
                    }
                }
            }
    }
};
struct EpiMemKV {
    static constexpr bool PERM = true, AFTER_DRAIN = false;
    bf16_t* MK; bf16_t* MVT; float* out;
    __device__ __forceinline__ void operator()(const f32x4 (&acc)[2][2][4][2], const Unit& u, int wr, int wc, int fr, int fq) const {
#pragma unroll
        for (int ai = 0; ai < 2; ++ai)
#pragma unroll
            for (int m = 0; m < 4; ++m) {
                const int row = u.pm * 256 + ai * 128 + wr * 64 + m * 16 + fr;
#pragma unroll
                for (int bj = 0; bj < 2; ++bj) {
                    const int c = u.pn * 256 + bj * 128 + wc * 32 + 8 * fq;
                    const f32x4 v0 = acc[ai][bj][m][0], v1 = acc[ai][bj][m][1];
                    if (u.pn < 2) {
                        float* d = out + O_PMK + (size_t)row * 512 + c; *(f32x4*)d = v0; *(f32x4*)(d + 4) = v1;
                        *(u32x4*)(MK + (size_t)row * 512 + c) = pack8(v0, v1);
                    } else {
                        const int cv = c - 512, h = cv >> 7, dd = cv & 127, b = row >> 8, mm = row & 255;
                        float* d = out + O_PMV + (size_t)row * 512 + cv; *(f32x4*)d = v0; *(f32x4*)(d + 4) = v1;
                        bf16_t* t = MVT + ((size_t)((b * 4 + h) * 128 + dd)) * 256 + mm;
#pragma unroll
                        for (int j = 0; j < 4; ++j) { t[(size_t)j * 256] = f2bf(v0[j]); t[(size_t)(j + 4) * 256] = f2bf(v1[j]); }
                    }
                }
            }
    }
};
struct EpiResid {
    static constexpr bool PERM = true, AFTER_DRAIN = false;
    const float* resP; const float* resS; float* X; bf16_t* XB; float* SS;
    __device__ __forceinline__ void operator()(const f32x4 (&acc)[2][2][4][2], const Unit& u, int wr, int wc, int fr, int fq) const {
#pragma unroll
        for (int ai = 0; ai < 2; ++ai)
#pragma unroll
            for (int m = 0; m < 4; ++m) {
                const int row = u.pm * 256 + ai * 128 + wr * 64 + m * 16 + fr;
                const float* rrow = (row < TP) ? resP + (size_t)row * DM : resS + (size_t)(row - TP) * DM;
                float ss = 0.f;
#pragma unroll
                for (int bj = 0; bj < 2; ++bj) {
                    const int c = u.pn * 256 + bj * 128 + wc * 32 + 8 * fq;
                    const f32x4 v0 = acc[ai][bj][m][0] + *(const f32x4*)(rrow + c), v1 = acc[ai][bj][m][1] + *(const f32x4*)(rrow + c + 4);
                    float* d = X + (size_t)row * DM + c; *(f32x4*)d = v0; *(f32x4*)(d + 4) = v1;
                    ss += (v0[0] * v0[0] + v0[1] * v0[1]) + (v0[2] * v0[2] + v0[3] * v0[3]) + (v1[0] * v1[0] + v1[1] * v1[1]) + (v1[2] * v1[2] + v1[3] * v1[3]);
                    if (XB) *(u32x4*)(XB + (size_t)row * DM + c) = pack8(v0, v1);
                }
                ss += __shfl_xor(ss, 16); ss += __shfl_xor(ss, 32);
                if (SS && fq == 0) SS[(size_t)row * 32 + u.pn * 4 + wc] = ss;
            }
    }
};
struct EpiSlab {
    static constexpr bool PERM = true, AFTER_DRAIN = false;
    float* SLAB; int row0; size_t slab_stride;
    __device__ __forceinline__ void operator()(const f32x4 (&acc)[2][2][4][2], const Unit& u, int wr, int wc, int fr, int fq) const {
        float* base = SLAB + (size_t)u.ks * slab_stride;
#pragma unroll
        for (int ai = 0; ai < 2; ++ai)
#pragma unroll
            for (int m = 0; m < 4; ++m) {
                const int row = u.pm * 256 + ai * 128 + wr * 64 + m * 16 + fr - row0;
#pragma unroll
                for (int bj = 0; bj < 2; ++bj) {
                    float* d = base + (size_t)row * DM + u.pn * 256 + bj * 128 + wc * 32 + 8 * fq;
                    *(f32x4*)d = acc[ai][bj][m][0]; *(f32x4*)(d + 4) = acc[ai][bj][m][1];
                }
            }
    }
};
struct SplitOrder {
    int c, ns;
    __device__ bool next(int i, Unit& u) const { if (i > 0 || c >= 16 * ns) return false; const int tile = c / ns; u.pm = TP / 256 + (tile >> 3); u.pn = tile & 7; u.ks = c % ns; return true; }
    __device__ __forceinline__ void a_ready(const Unit&) const {}
    __device__ __forceinline__ void done(const Unit&) const {}
};
struct EpiScaleBf16 {
    static constexpr bool PERM = true, AFTER_DRAIN = false;
    bf16_t* O; int ldc; const float* SS; float scale;
    __device__ __forceinline__ void operator()(const f32x4 (&acc)[2][2][4][2], const Unit& u, int wr, int wc, int fr, int fq) const {
#pragma unroll
        for (int ai = 0; ai < 2; ++ai)
#pragma unroll
            for (int m = 0; m < 4; ++m) {
                const int row = u.pm * 256 + ai * 128 + wr * 64 + m * 16 + fr;
                const float s = row_rs(SS, row) * scale;
#pragma unroll
                for (int bj = 0; bj < 2; ++bj) {
                    const int c = u.pn * 256 + bj * 128 + wc * 32 + 8 * fq;
                    *(u32x4*)(O + (size_t)row * ldc + c) = pack8(acc[ai][bj][m][0] * s, acc[ai][bj][m][1] * s);
                }
            }
    }
};
struct EpiSwiGLU {
    static constexpr bool PERM = true, AFTER_DRAIN = false;
    bf16_t* HID; const float* SS;
    __device__ __forceinline__ void operator()(const f32x4 (&acc)[2][2][4][2], const Unit& u, int wr, int wc, int fr, int fq) const {
#pragma unroll
        for (int ai = 0; ai < 2; ++ai)
#pragma unroll
            for (int m = 0; m < 4; ++m) {
                const int row = u.pm * 256 + ai * 128 + wr * 64 + m * 16 + fr;
                const float s = row_rs(SS, row);
                f32x4 h0, h1;
#pragma unroll
                for (int j = 0; j < 4; ++j) {
                    const float g0 = acc[ai][0][m][0][j] * s, u0 = acc[ai][1][m][0][j] * s, g1 = acc[ai][0][m][1][j] * s, u1 = acc[ai][1][m][1][j] * s;
                    h0[j] = g0 * fsigmoid(g0) * u0; h1[j] = g1 * fsigmoid(g1) * u1;
                }
                *(u32x4*)(HID + (size_t)row * FF + u.pn * 128 + wc * 32 + 8 * fq) = pack8(h0, h1);
            }
    }
};

struct Frame {
    LAS unsigned char* lds;
    int tid, lane, wave, G, bid;
    const float* const* in;
    float* out; unsigned char* ws;
};
enum { I_XP = 0, I_XS, I_STATE, I_CSK, I_CSV, I_CMK, I_CMV, I_MEMP, I_NMIX, I_WIN, I_LB, I_ONORM, I_SINKS, I_RELB, I_WOUT, I_NXATT, I_NMEM,
       I_WMQ, I_WMK, I_WMV, I_WMO, I_NFFN, I_WGATE, I_WUP, I_WDOWN, I_NFINAL };

__device__ __forceinline__ void p0_tr_item(const float* __restrict__ W, int K, int N, bf16_t* WT, int k0, int n0, int drow0, const float* __restrict__ scale, LAS float* scr, int lane) {
#pragma unroll 8
    for (int i = 0; i < 32; ++i) { const int kk = 2 * i + (lane >> 5); float v = W[(size_t)(k0 + kk) * N + n0 + (lane & 31)]; if (scale) v *= scale[k0 + kk]; scr[kk * 33 + (lane & 31)] = v; }
    LDS_WAIT(); asm volatile("" ::: "memory");
    const int c = lane & 7;
#pragma unroll
    for (int j = 0; j < 4; ++j) { const int n = (lane >> 3) + 8 * j; const LAS float* s = scr + (8 * c) * 33 + n;
        u32x4 o; o.x = cvtpk(s[0 * 33], s[1 * 33]); o.y = cvtpk(s[2 * 33], s[3 * 33]); o.z = cvtpk(s[4 * 33], s[5 * 33]); o.w = cvtpk(s[6 * 33], s[7 * 33]);
        *(u32x4*)(WT + (size_t)(drow0 + n) * K + k0 + 8 * c) = o; }
    LDS_WAIT(); asm volatile("" ::: "memory");
}
__device__ __forceinline__ void p0_rms_row(const float* xrow, const float* w, bf16_t* orow, int lane) {
    const f32x4* xr = (const f32x4*)xrow + lane; const f32x4* wr = (const f32x4*)w + lane;
    f32x4 v[8]; float s = 0.f;
#pragma unroll
    for (int j = 0; j < 8; ++j) { v[j] = xr[64 * j]; s += (v[j][0] * v[j][0] + v[j][1] * v[j][1]) + (v[j][2] * v[j][2] + v[j][3] * v[j][3]); }
    const float rs = __builtin_amdgcn_rsqf(wave_sum(s) * (1.0f / DM) + RMS_EPS);
    u32x2* o8 = (u32x2*)orow + lane;
#pragma unroll
    for (int j = 0; j < 8; ++j) { const f32x4 ww = wr[64 * j]; f32x4 y; y[0] = v[j][0] * rs * ww[0]; y[1] = v[j][1] * rs * ww[1]; y[2] = v[j][2] * rs * ww[2]; y[3] = v[j][3] * rs * ww[3]; o8[64 * j] = pack4(y); }
}
__device__ __forceinline__ int rel_bucket(int n) {
    if (n < 16) return n;
    int b = 16 + (int)(__logf((float)n * (1.0f / 16.0f)) / 2.0794415416798357f * 16.0f);
    return b < 31 ? b : 31;
}
constexpr int CV_IN = 32 * (NIN / 32), CV_OUT = 32 * 64, CV_MQ = 32 * 16, CV_MO = 8 * 64, CV_G = 32 * (FF / 32), CV_DN = (FF / 64) * 64;
constexpr int CV_EARLY = CV_IN + CV_OUT + 3 * CV_MQ, CV_ALL = CV_EARLY + CV_MO + 2 * CV_G + CV_DN;
__device__ __forceinline__ void p0_convert(Frame& F, int it0, int it1, int gw, int NGW) {
    LAS float* scr = (LAS float*)(F.lds + F.wave * 16384);
    unsigned char* ws = F.ws;
    constexpr int I_IN = CV_IN, I_OUT = CV_OUT, I_MQ = CV_MQ, I_MO = CV_MO, I_G = CV_G;
    for (int it = it0 + gw; it < it1; it += NGW) {
        int r = it;
        if (r < I_IN) { const int nb = NIN / 32, kb = r / nb, n0 = (r % nb) * 32; p0_tr_item(F.in[I_WIN], DM, NIN, (bf16_t*)(ws + WS_WIN), kb * 64, n0, n0, nullptr, scr, F.lane); continue; } r -= I_IN;
        if (r < I_OUT) { const int kb = r / 64, n0 = (r % 64) * 32; p0_tr_item(F.in[I_WOUT], DM, DM, (bf16_t*)(ws + WS_WOUT), kb * 64, n0, n0, nullptr, scr, F.lane); continue; } r -= I_OUT;
        if (r < I_MQ) { const int kb = r / 16, n0 = (r % 16) * 32; p0_tr_item(F.in[I_WMQ], DM, MEMW, (bf16_t*)(ws + WS_WMQ), kb * 64, n0, n0, F.in[I_NXATT], scr, F.lane); continue; } r -= I_MQ;
        if (r < I_MQ) { const int kb = r / 16, n0 = (r % 16) * 32; p0_tr_item(F.in[I_WMK], DM, MEMW, (bf16_t*)(ws + WS_WMKV), kb * 64, n0, n0, nullptr, scr, F.lane); continue; } r -= I_MQ;
        if (r < I_MQ) { const int kb = r / 16, n0 = (r % 16) * 32; p0_tr_item(F.in[I_WMV], DM, MEMW, (bf16_t*)(ws + WS_WMKV), kb * 64, n0, 512 + n0, nullptr, scr, F.lane); continue; } r -= I_MQ;
        if (r < I_MO) { const int kb = r / 64, n0 = (r % 64) * 32; p0_tr_item(F.in[I_WMO], MEMW, DM, (bf16_t*)(ws + WS_WMO), kb * 64, n0, n0, nullptr, scr, F.lane); continue; } r -= I_MO;
        if (r < 2 * I_G) { const int up = r >= I_G; if (up) r -= I_G; const int nb = FF / 32, kb = r / nb, n0 = (r % nb) * 32;
            p0_tr_item(F.in[up ? I_WUP : I_WGATE], DM, FF, (bf16_t*)(ws + WS_WGU), kb * 64, n0, (n0 >> 7) * 256 + (n0 & 127) + (up ? 128 : 0), F.in[I_NFFN], scr, F.lane); continue; } r -= 2 * I_G;
        { const int kb = r / 64, n0 = (r % 64) * 32; p0_tr_item(F.in[I_WDOWN], FF, DM, (bf16_t*)(ws + WS_WDN), kb * 64, n0, n0, nullptr, scr, F.lane); }
    }
}
__device__ __forceinline__ void p0_prologue(Frame& F, bool all_weights) {
    const int gw = F.bid * NWAVES + F.wave, NGW = F.G * NWAVES;
    unsigned char* ws = F.ws;
    p0_convert(F, 0, all_weights ? CV_ALL : CV_EARLY, gw, NGW);
    for (int m = gw; m < TT + 1024; m += NGW) {
        if (m < TP) p0_rms_row(F.in[I_XP] + (size_t)m * DM, F.in[I_NMIX], (bf16_t*)(ws + WS_XB) + (size_t)m * DM, F.lane);
        else if (m < TT) p0_rms_row(F.in[I_XS] + (size_t)(m - TP) * DM, F.in[I_NMIX], (bf16_t*)(ws + WS_XB) + (size_t)m * DM, F.lane);
        else p0_rms_row(F.in[I_MEMP] + (size_t)(m - TT) * DM, F.in[I_NMEM], (bf16_t*)(ws + WS_MN) + (size_t)(m - TT) * DM, F.lane);
    }
    float* LBt = (float*)(ws + WS_TAB); float* BT = (float*)(ws + WS_TAB + 8192);
    const int gt = F.bid * NTHREADS + F.tid, NGT = F.G * NTHREADS;
    for (int i = gt; i < 1024 + 16 * 160; i += NGT) {
        if (i < 1024) { const float l0 = F.in[I_LB][i], l1 = F.in[I_LB][1024 + i]; LBt[i] = 1.0f / (1.0f + __expf(l1 - l0)); }
        else { const int j = i - 1024, h = j / 160, ix = j % 160, dist = 143 - ix;
            BT[j] = (dist >= 0 && dist < 128) ? F.in[I_RELB][rel_bucket(dist) * 16 + h] * LOG2E : -INFINITY; }
    }
}

constexpr int PREP_RS = 1032;
__device__ __forceinline__ void hgrn_prep(Frame& F) {
    unsigned char* ws = F.ws;
    const float* QF = F.out; const float* GF = F.out + (size_t)TT * 1024; const bf16_t* VB = (const bf16_t*)(F.out + O_SST);
    bf16_t* QIN = (bf16_t*)(ws + WS_QIN); bf16_t* KT = (bf16_t*)(ws + WS_KT); bf16_t* VT = (bf16_t*)(ws + WS_VT); bf16_t* PSC = (bf16_t*)(ws + WS_PSC); float* DEC = (float*)(ws + WS_DEC);
    LAS bf16_t* lq = (LAS bf16_t*)F.lds; LAS bf16_t* lk = lq + 16 * PREP_RS;
    const int l15 = F.lane & 15, g4 = F.lane >> 4;
    for (int ch = F.bid; ch < NCH; ch += F.G) {
        const int nv = ch < NCHP ? 16 : 4; const int row0 = ch < NCHP ? ch * 16 : TP + (ch - NCHP) * 4;
#pragma unroll 1
        for (int pass = 0; pass < 2; ++pass) {
            const int cidx = F.tid + 512 * pass;
            float g[16], q[16]; unsigned short vv[16];
#pragma unroll
            for (int t = 0; t < 16; ++t) {
                if (t < nv) { g[t] = GF[(size_t)(row0 + t) * 1024 + cidx]; q[t] = QF[(size_t)(row0 + t) * 1024 + cidx]; vv[t] = VB[(size_t)(row0 + t) * 1024 + cidx]; }
                else { g[t] = 0.f; q[t] = 0.f; vv[t] = 0; }
            }
            float G = 0.f; unsigned kd[8], vt[8];
#pragma unroll
            for (int t = 0; t < 16; t += 2) {
                float qi[2], kk[2];
#pragma unroll
                for (int z = 0; z < 2; ++z) {
                    const float gt = g[t + z]; G += gt;
                    qi[z] = q[t + z] * fexp(G);
                    kk[z] = (1.0f - fexp(gt)) * fexp(fminf(-G, 80.0f));
                    lq[(t + z) * PREP_RS + cidx] = f2bf(qi[z]); lk[(t + z) * PREP_RS + cidx] = f2bf(kk[z]);
                }
                kd[t >> 1] = cvtpk(kk[0], kk[1]); vt[t >> 1] = (unsigned)vv[t] | ((unsigned)vv[t + 1] << 16);
            }
            DEC[(size_t)ch * 1024 + cidx] = fexp(G);
            u32x4* kp = (u32x4*)(KT + ((size_t)ch * 1024 + cidx) * 16); kp[0] = (u32x4){kd[0], kd[1], kd[2], kd[3]}; kp[1] = (u32x4){kd[4], kd[5], kd[6], kd[7]};
            u32x4* vp = (u32x4*)(VT + ((size_t)ch * 1024 + cidx) * 16); vp[0] = (u32x4){vt[0], vt[1], vt[2], vt[3]}; vp[1] = (u32x4){vt[4], vt[5], vt[6], vt[7]};
        }
        __syncthreads();
#pragma unroll
        for (int i = 0; i < 4; ++i) { const int idx = F.tid + 512 * i, t = idx >> 7, c8 = idx & 127;
            *(u32x4*)(QIN + ((size_t)ch * 16 + t) * 1024 + c8 * 8) = *(const LAS u32x4*)(lq + t * PREP_RS + c8 * 8); }
        {
            const int h = F.wave; f32x4 acc = {0.f, 0.f, 0.f, 0.f};
#pragma unroll
            for (int kk = 0; kk < 4; ++kk) {
                const bf16x8 a = *(const LAS bf16x8*)(lq + l15 * PREP_RS + h * 128 + 32 * kk + 8 * g4);
                const bf16x8 b = *(const LAS bf16x8*)(lk + l15 * PREP_RS + h * 128 + 32 * kk + 8 * g4);
                acc = __builtin_amdgcn_mfma_f32_16x16x32_bf16(a, b, acc, 0, 0, 0);
            }
            bf16_t* pd = PSC + ((size_t)ch * 8 + h) * 256;
#pragma unroll
            for (int r = 0; r < 4; ++r) { const int t = 4 * g4 + r, s = l15; pd[t * 16 + s] = (s <= t) ? f2bf(acc[r]) : (bf16_t)0; }
        }
        __syncthreads();
    }
}

constexpr int SC_QS = 136;
constexpr int SC_QI = 0, SC_KT = 16 * SC_QS * 2, SC_VT = SC_KT + 4096, SC_P = SC_VT + 4096, SC_DEC = SC_P + 512, SC_GATE = SC_DEC + 512, SC_BUF = SC_GATE + 16 * SC_QS * 2;
constexpr int SC_RED = 2 * SC_BUF;
static_assert(SC_RED + 1024 <= LDS_BYTES && SC_BUF % 16 == 0, "scan LDS");
struct ScanPf { u32x4 a, b, c; };
struct ScanSrc { const unsigned char* a; const unsigned char* b; const unsigned char* c; unsigned oa, ob, oc; };
__device__ __forceinline__ ScanSrc scan_src(const Frame& F, int ch0, int h, int grow0, int ngr) {
    const unsigned char* ws = F.ws; const int tid = F.tid; ScanSrc s;
    const bf16_t* QIN = (const bf16_t*)(ws + WS_QIN); const bf16_t* KT = (const bf16_t*)(ws + WS_KT); const bf16_t* VT = (const bf16_t*)(ws + WS_VT);
    const bf16_t* PSC = (const bf16_t*)(ws + WS_PSC); const float* DEC = (const float*)(ws + WS_DEC); const bf16_t* GATE = (const bf16_t*)(ws + WS_GATE);
    if (tid < 256) { const int t = tid >> 4, p = tid & 15;
        s.a = (const unsigned char*)(QIN + ((size_t)ch0 * 16 + t) * 1024 + h * 128 + p * 8); s.oa = SC_QI + (t * SC_QS + p * 8) * 2;
        s.b = (const unsigned char*)(VT + ((size_t)ch0 * 1024 + h * 128) * 16 + tid * 8); s.ob = SC_VT + tid * 16;
    } else { const int i = tid - 256, t = i >> 4, p = i & 15; const int tr = t < ngr ? t : ngr - 1;
        s.a = (const unsigned char*)(KT + ((size_t)ch0 * 1024 + h * 128) * 16 + i * 8); s.oa = SC_KT + i * 16;
        s.b = (const unsigned char*)(GATE + (size_t)(grow0 + tr) * 1024 + h * 128 + p * 8); s.ob = SC_GATE + (t * SC_QS + p * 8) * 2;
    }
    if (tid < 32) { s.c = (const unsigned char*)(PSC + ((size_t)ch0 * 8 + h) * 256 + tid * 8); s.oc = SC_P + tid * 16; }
    else { const int i = (tid - 32) & 31; s.c = (const unsigned char*)(DEC + (size_t)ch0 * 1024 + h * 128 + i * 4); s.oc = SC_DEC + i * 16; }
    return s;
}
__device__ __forceinline__ void scan_fetch(ScanPf& pf, const ScanSrc& s, const Frame& F, int step) {
    pf.a = *(const u32x4*)(s.a + (size_t)step * 32768); pf.b = *(const u32x4*)(s.b + (size_t)step * 32768);
    if (F.tid < 64) pf.c = *(const u32x4*)(s.c + (size_t)step * 4096);
}
__device__ __forceinline__ void scan_stash(const ScanPf& pf, const ScanSrc& s, const Frame& F, int buf) {
    LAS unsigned char* B = F.lds + buf * SC_BUF;
    *(LAS u32x4*)(B + s.oa) = pf.a; *(LAS u32x4*)(B + s.ob) = pf.b;
    if (F.tid < 64) *(LAS u32x4*)(B + s.oc) = pf.c;
}
template <int CTRL> __device__ __forceinline__ float dpp_mov(float v) { return __int_as_float(__builtin_amdgcn_update_dpp(0, __float_as_int(v), CTRL, 0xF, 0xF, true)); }
__device__ __forceinline__ float row16_sum(float v) { v += dpp_mov<0xB1>(v); v += dpp_mov<0x4E>(v); v += dpp_mov<0x141>(v); v += dpp_mov<0x140>(v); return v; }
constexpr int SC_ST = SC_RED + 1024, SC_STS = 132;
static_assert(SC_ST + 128 * SC_STS * 4 <= LDS_BYTES, "scan LDS (state image)");
__device__ __forceinline__ void hgrn_scan(Frame& F, int ch0, int nsteps, int h, int mrow0, int nvalid, const float* S0, float* Sout) {
    const int lane = F.lane, l15 = lane & 15, g4 = lane >> 4, e0 = 16 * F.wave;
    bf16_t* MIX = (bf16_t*)(F.ws + WS_MIX);
    const float onw = F.in[I_ONORM][e0 + l15];
    LAS float* RED = (LAS float*)(F.lds + SC_RED);
    LAS float* ST = (LAS float*)(F.lds + SC_ST);
    ScanPf pf;
    __syncthreads();
    const ScanSrc src = scan_src(F, ch0, h, mrow0, nvalid);
    scan_fetch(pf, src, F, 0); scan_stash(pf, src, F, 0);
    if (nsteps > 1) scan_fetch(pf, src, F, 1);
    f32x4 S[8];
    if (S0) {
#pragma unroll
        for (int i = 0; i < 8; ++i) { const int idx = F.tid + 512 * i, c = idx >> 5, e4 = idx & 31; *(LAS f32x4*)(ST + c * SC_STS + e4 * 4) = *(const f32x4*)(S0 + (size_t)c * 128 + e4 * 4); }
    }
    __syncthreads();
#pragma unroll
    for (int mt = 0; mt < 8; ++mt)
#pragma unroll
        for (int r = 0; r < 4; ++r) S[mt][r] = S0 ? ST[(16 * mt + 4 * g4 + r) * SC_STS + e0 + l15] : 0.f;
    f32x4 o_prev = {0.f, 0.f, 0.f, 0.f}, gate_prev = {0.f, 0.f, 0.f, 0.f};
#pragma unroll 1
    for (int n = 0; n <= nsteps; ++n) {
        const int buf = n & 1;
        f32x4 o = {0.f, 0.f, 0.f, 0.f}, gate = {0.f, 0.f, 0.f, 0.f};
        if (n + 1 < nsteps) {
            scan_stash(pf, src, F, buf ^ 1);
            if (n + 2 < nsteps) scan_fetch(pf, src, F, n + 2);
        }
        if (n < nsteps) {
            const LAS unsigned char* B = F.lds + buf * SC_BUF;
            const bf16x4 vt = *(const LAS bf16x4*)(B + SC_VT + ((e0 + l15) * 16 + 4 * g4) * 2);
            const bf16x4 pa = *(const LAS bf16x4*)(B + SC_P + (l15 * 16 + 4 * g4) * 2);
            const f32x4 zz = {0.f, 0.f, 0.f, 0.f};
            f32x4 oq[4];
            const f32x4 op = __builtin_amdgcn_mfma_f32_16x16x16bf16_1k(pa, vt, zz, 0, 0, 0);
#pragma unroll
            for (int kk = 0; kk < 4; ++kk) {
                const bf16x4 q0 = *(const LAS bf16x4*)(B + SC_QI + (l15 * SC_QS + 32 * kk + 4 * g4) * 2);
                const bf16x4 q1 = *(const LAS bf16x4*)(B + SC_QI + (l15 * SC_QS + 32 * kk + 16 + 4 * g4) * 2);
                const bf16x8 qa = {q0[0], q0[1], q0[2], q0[3], q1[0], q1[1], q1[2], q1[3]};
                const u32x4 sb = pack8(S[2 * kk], S[2 * kk + 1]);
                oq[kk] = __builtin_amdgcn_mfma_f32_16x16x32_bf16(qa, __builtin_bit_cast(bf16x8, sb), zz, 0, 0, 0);
            }
            o = (oq[0] + oq[2]) + op; const f32x4 ob = oq[1] + oq[3];
#pragma unroll
            for (int mt = 0; mt < 8; ++mt) {
                const bf16x4 kt = *(const LAS bf16x4*)(B + SC_KT + ((16 * mt + l15) * 16 + 4 * g4) * 2);
                const f32x4 dc = *(const LAS f32x4*)(B + SC_DEC + (16 * mt + 4 * g4) * 4);
                S[mt] = __builtin_amdgcn_mfma_f32_16x16x16bf16_1k(kt, vt, S[mt], 0, 0, 0);
                S[mt] = S[mt] * dc;
            }
            o = o + ob;
#pragma unroll
            for (int r = 0; r < 4; ++r) {
                gate[r] = bf2f(*(const LAS unsigned short*)(B + SC_GATE + ((4 * g4 + r) * SC_QS + e0 + l15) * 2));
                const float ss = row16_sum(o[r] * o[r]);
                if (l15 == 0) RED[(buf * 8 + F.wave) * 16 + 4 * g4 + r] = ss;
            }
        }
        if (n > 0) {
            const int pb = (n - 1) & 1;
#pragma unroll
            for (int r = 0; r < 4; ++r) {
                const int t = 4 * g4 + r; float tot = 0.f;
#pragma unroll
                for (int w = 0; w < 8; ++w) tot += RED[(pb * 8 + w) * 16 + t];
                const float rs = __builtin_amdgcn_rsqf(tot * (1.0f / 128.0f) + RMS_EPS);
                if (t < nvalid) MIX[(size_t)(mrow0 + 16 * (n - 1) + t) * DM + h * 128 + e0 + l15] = f2bf(o_prev[r] * rs * onw * gate_prev[r]);
            }
        }
        o_prev = o; gate_prev = gate;
        __syncthreads();
    }
#pragma unroll
    for (int mt = 0; mt < 8; ++mt)
#pragma unroll
        for (int r = 0; r < 4; ++r) ST[(16 * mt + 4 * g4 + r) * SC_STS + e0 + l15] = S[mt][r];
    __syncthreads();
#pragma unroll
    for (int i = 0; i < 8; ++i) { const int idx = F.tid + 512 * i, c = idx >> 5, e4 = idx & 31; *(f32x4*)(Sout + (size_t)c * 128 + e4 * 4) = *(const LAS f32x4*)(ST + c * SC_STS + e4 * 4); }
}


constexpr int SW_KS = 72, SW_VS = 264;
constexpr int SW_K = 0, SW_V = 256 * SW_KS * 2, SW_BT = SW_V + 64 * SW_VS * 2, SW_END = SW_BT + 8 * 160 * 4;
static_assert(SW_END <= LDS_BYTES, "swa LDS");
__device__ __forceinline__ void swa_qtile(Frame& F, int j, int h, size_t qrow, bool qvalid, bool first_block, float sink2) {
    const int lane = F.lane, l15 = lane & 15, g4 = lane >> 4;
    const bf16_t* SQ = (const bf16_t*)(F.ws + WS_SQ); bf16_t* MIX = (bf16_t*)(F.ws + WS_MIX);
    const LAS bf16_t* Kb = (const LAS bf16_t*)(F.lds + SW_K); const LAS bf16_t* Vt = (const LAS bf16_t*)(F.lds + SW_V);
    const LAS float* BT = (const LAS float*)(F.lds + SW_BT) + F.wave * 160;
    bf16x8 qf[2];
#pragma unroll
    for (int kk = 0; kk < 2; ++kk) qf[kk] = *(const bf16x8*)(SQ + qrow * 1024 + h * 64 + 32 * kk + 8 * g4);
    f32x4 s[9]; float mx = sink2;
    const int bidx = 15 + 4 * g4 - l15;
#pragma unroll
    for (int u = 0; u < 9; ++u) {
        const int mt = j + u; f32x4 acc = {0.f, 0.f, 0.f, 0.f};
#pragma unroll
        for (int kk = 0; kk < 2; ++kk) {
            const bf16x8 a = *(const LAS bf16x8*)(Kb + (16 * mt + l15) * SW_KS + 32 * kk + 8 * g4);
            acc = __builtin_amdgcn_mfma_f32_16x16x32_bf16(a, qf[kk], acc, 0, 0, 0);
        }
        const bool dead = first_block && (mt < 8);
#pragma unroll
        for (int r = 0; r < 4; ++r) { float v = acc[r] + BT[bidx + 16 * u + r]; v = dead ? -INFINITY : v; s[u][r] = v; mx = fmaxf(mx, v); }
    }
    mx = fmaxf(mx, __shfl_xor(mx, 16)); mx = fmaxf(mx, __shfl_xor(mx, 32));
    float sum = 0.f; bf16x4 pb[9];
#pragma unroll
    for (int u = 0; u < 9; ++u) {
        f32x4 p;
#pragma unroll
        for (int r = 0; r < 4; ++r) { p[r] = __builtin_amdgcn_exp2f(s[u][r] - mx); sum += p[r]; }
        pb[u] = __builtin_bit_cast(bf16x4, pack4(p));
    }
    sum += __shfl_xor(sum, 16); sum += __shfl_xor(sum, 32);
    sum += __builtin_amdgcn_exp2f(sink2 - mx);
    const float inv = 1.0f / sum;
#pragma unroll
    for (int dt = 0; dt < 4; ++dt) {
        f32x4 o = {0.f, 0.f, 0.f, 0.f};
#pragma unroll
        for (int u = 0; u < 9; ++u) {
            const bf16x4 a = *(const LAS bf16x4*)(Vt + (16 * dt + l15) * SW_VS + 16 * (j + u) + 4 * g4);
            o = __builtin_amdgcn_mfma_f32_16x16x16bf16_1k(a, pb[u], o, 0, 0, 0);
        }
        if (qvalid) *(u32x2*)(MIX + qrow * DM + 1024 + h * 64 + 16 * dt + 4 * g4) = pack4(o * inv);
    }
}
__device__ __forceinline__ void swa_load_tables(Frame& F, int k) {
    const float* BTg = (const float*)(F.ws + WS_TAB + 8192); LAS float* BT = (LAS float*)(F.lds + SW_BT);
    for (int i = F.tid; i < 8 * 160; i += NTHREADS) BT[i] = BTg[k * 8 * 160 + i];
}
__device__ __forceinline__ void swa_prompt_unit(Frame& F, int unit) {
    const int k = unit & 1, n = (unit >> 1) & 31, b = unit >> 6;
    const bf16_t* SKV = (const bf16_t*)(F.ws + WS_SKV);
    LAS bf16_t* Kb = (LAS bf16_t*)(F.lds + SW_K); LAS bf16_t* Vt = (LAS bf16_t*)(F.lds + SW_V);
    __syncthreads();
    swa_load_tables(F, k);
#pragma unroll
    for (int i = 0; i < 4; ++i) {
        const int idx = F.tid + 512 * i, kj = idx >> 3, p = idx & 7, pos = 128 * (n - 1) + kj;
        u32x4 kv = {0u, 0u, 0u, 0u}, vv = {0u, 0u, 0u, 0u};
        if (pos >= 0) { const bf16_t* src = SKV + (size_t)(b * SEQ + pos) * 256 + k * 64 + p * 8; kv = *(const u32x4*)src; vv = *(const u32x4*)(src + 128); }
        *(LAS u32x4*)(Kb + kj * SW_KS + p * 8) = kv;
        const unsigned w[4] = {vv.x, vv.y, vv.z, vv.w};
#pragma unroll
        for (int e = 0; e < 4; ++e) { Vt[(8 * p + 2 * e) * SW_VS + kj] = (bf16_t)(w[e] & 0xffffu); Vt[(8 * p + 2 * e + 1) * SW_VS + kj] = (bf16_t)(w[e] >> 16); }
    }
    __syncthreads();
    const int h = k * 8 + F.wave; const float sink2 = F.in[I_SINKS][h] * LOG2E;
#pragma unroll 1
    for (int j = 0; j < 8; ++j) swa_qtile(F, j, h, (size_t)(b * SEQ + 128 * n + 16 * j + (F.lane & 15)), true, n == 0, sink2);
}
__device__ __forceinline__ void swa_sample_unit(Frame& F, int unit) {
    const int k = unit & 1, b = unit >> 1;
    const bf16_t* SKV = (const bf16_t*)(F.ws + WS_SKV);
    LAS bf16_t* Kb = (LAS bf16_t*)(F.lds + SW_K); LAS bf16_t* Vt = (LAS bf16_t*)(F.lds + SW_V);
    __syncthreads();
    swa_load_tables(F, k);
#pragma unroll
    for (int i = 0; i < 4; ++i) {
        const int idx = F.tid + 512 * i, kj = idx >> 4, p = idx & 15;
        const size_t so = ((size_t)(b * 128 + kj) * 2 + k) * 64 + p * 4;
        const f32x4 kv = *(const f32x4*)(F.in[I_CSK] + so), vv = *(const f32x4*)(F.in[I_CSV] + so);
        *(LAS u32x2*)(Kb + kj * SW_KS + p * 4) = pack4(kv);
#pragma unroll
        for (int e = 0; e < 4; ++e) Vt[(4 * p + e) * SW_VS + kj] = f2bf(vv[e]);
        if (kj >= 4) { const size_t dof = ((size_t)(b * 128 + kj - 4) * 2 + k) * 64 + p * 4; *(f32x4*)(F.out + O_SSK + dof) = kv; *(f32x4*)(F.out + O_SSV + dof) = vv; }
    }
    if (F.tid < 128) {
        const int kj = 128 + (F.tid >> 3), p = F.tid & 7;
        u32x4 kv = {0u, 0u, 0u, 0u}, vv = {0u, 0u, 0u, 0u};
        if (kj < 132) { const bf16_t* src = SKV + (size_t)(TP + 4 * b + (kj - 128)) * 256 + k * 64 + p * 8; kv = *(const u32x4*)src; vv = *(const u32x4*)(src + 128); }
        *(LAS u32x4*)(Kb + kj * SW_KS + p * 8) = kv;
        const unsigned w[4] = {vv.x, vv.y, vv.z, vv.w};
#pragma unroll
        for (int e = 0; e < 4; ++e) { Vt[(8 * p + 2 * e) * SW_VS + kj] = (bf16_t)(w[e] & 0xffffu); Vt[(8 * p + 2 * e + 1) * SW_VS + kj] = (bf16_t)(w[e] >> 16); }
    }
    __syncthreads();
    const int h = k * 8 + F.wave, l15 = F.lane & 15; const float sink2 = F.in[I_SINKS][h] * LOG2E;
    swa_qtile(F, 0, h, (size_t)(TP + 4 * b + (l15 < 4 ? l15 : 3)), l15 < 4, false, sink2);
}

constexpr int MA_KS = 136, MA_VS = 264;
constexpr int MA_K = 0, MA_V = 256 * MA_KS * 2, MA_END = MA_V + 128 * MA_VS * 2;
static_assert(MA_END <= LDS_BYTES, "memattn LDS");
__device__ __forceinline__ void memattn_prompt_unit(Frame& F, int unit) {
    const int h = unit & 3, pm = unit >> 2, b = pm >> 4;
    const bf16_t* MK = (const bf16_t*)(F.ws + WS_MK); const bf16_t* MVT = (const bf16_t*)(F.ws + WS_MVT);
    const bf16_t* QM = (const bf16_t*)(F.ws + WS_QM); bf16_t* OM = (bf16_t*)(F.ws + WS_OM);
    LAS bf16_t* Kh = (LAS bf16_t*)(F.lds + MA_K); LAS bf16_t* Vt = (LAS bf16_t*)(F.lds + MA_V);
    const int lane = F.lane, l15 = lane & 15, g4 = lane >> 4;
    __syncthreads();
#pragma unroll
    for (int i = 0; i < 8; ++i) {
        const int idx = F.tid + 512 * i;
        { const int m = idx >> 4, p = idx & 15; *(LAS u32x4*)(Kh + m * MA_KS + p * 8) = *(const u32x4*)(MK + (size_t)(b * 256 + m) * 512 + h * 128 + p * 8); }
        { const int d = idx >> 5, p = idx & 31; *(LAS u32x4*)(Vt + d * MA_VS + p * 8) = *(const u32x4*)(MVT + ((size_t)(b * 4 + h) * 128 + d) * 256 + p * 8); }
    }
    __syncthreads();
#pragma unroll 1
    for (int jj = 0; jj < 2; ++jj) {
        const size_t row = (size_t)pm * 256 + 16 * (2 * F.wave + jj) + l15;
        bf16x8 qf[4];
#pragma unroll
        for (int kk = 0; kk < 4; ++kk) qf[kk] = *(const bf16x8*)(QM + row * 512 + h * 128 + 32 * kk + 8 * g4);
        f32x4 s[16]; float mx = -INFINITY;
#pragma unroll
        for (int mt = 0; mt < 16; ++mt) {
            f32x4 acc = {0.f, 0.f, 0.f, 0.f};
#pragma unroll
            for (int kk = 0; kk < 4; ++kk) {
                const bf16x8 a = *(const LAS bf16x8*)(Kh + (16 * mt + l15) * MA_KS + 32 * kk + 8 * g4);
                acc = __builtin_amdgcn_mfma_f32_16x16x32_bf16(a, qf[kk], acc, 0, 0, 0);
            }
            s[mt] = acc; mx = fmaxf(fmaxf(mx, fmaxf(acc[0], acc[1])), fmaxf(acc[2], acc[3]));
            __builtin_amdgcn_sched_barrier(0);
        }
        mx = fmaxf(mx, __shfl_xor(mx, 16)); mx = fmaxf(mx, __shfl_xor(mx, 32));
        float sum = 0.f; bf16x8 pb[8];
#pragma unroll
        for (int i = 0; i < 8; ++i) {
            f32x4 p0, p1;
#pragma unroll
            for (int r = 0; r < 4; ++r) { p0[r] = __builtin_amdgcn_exp2f(s[2 * i][r] - mx); p1[r] = __builtin_amdgcn_exp2f(s[2 * i + 1][r] - mx); sum += p0[r] + p1[r]; }
            pb[i] = __builtin_bit_cast(bf16x8, pack8(p0, p1));
        }
        sum += __shfl_xor(sum, 16); sum += __shfl_xor(sum, 32);
        const float inv = 1.0f / sum;
#pragma unroll
        for (int dt = 0; dt < 8; ++dt) {
            f32x4 o = {0.f, 0.f, 0.f, 0.f};
#pragma unroll
            for (int i = 0; i < 8; ++i) {
                const bf16x4 a0 = *(const LAS bf16x4*)(Vt + (16 * dt + l15) * MA_VS + 32 * i + 4 * g4);
                const bf16x4 a1 = *(const LAS bf16x4*)(Vt + (16 * dt + l15) * MA_VS + 32 * i + 16 + 4 * g4);
                const bf16x8 a = {a0[0], a0[1], a0[2], a0[3], a1[0], a1[1], a1[2], a1[3]};
                o = __builtin_amdgcn_mfma_f32_16x16x32_bf16(a, pb[i], o, 0, 0, 0);
            }
            *(u32x2*)(OM + row * 512 + h * 128 + 16 * dt + 4 * g4) = pack4(o * inv);
            __builtin_amdgcn_sched_barrier(0);
        }
    }
}
constexpr int MSP_P = 0, MSP_O = 8192, MSP_ML = 8192 + 16384;
__device__ __forceinline__ void memattn_sample_block(Frame& F, int task) {
    const int hp = task & 1, b = task >> 1, w = F.wave, h = 2 * hp + (w >> 2), kq = w & 3;
    const float* CK = F.in[I_CMK] + ((size_t)b * 256 + 64 * kq) * 512 + h * 128; const float* CV = F.in[I_CMV] + ((size_t)b * 256 + 64 * kq) * 512 + h * 128;
    const bf16_t* QM = (const bf16_t*)(F.ws + WS_QM); bf16_t* OM = (bf16_t*)(F.ws + WS_OM);
    const int lane = F.lane, l15 = lane & 15, g4 = lane >> 4;
    LAS float* pl = (LAS float*)(F.lds + MSP_P) + w * 256; LAS float* po = (LAS float*)(F.lds + MSP_O) + w * 512; LAS float* ml = (LAS float*)(F.lds + MSP_ML);
    __syncthreads();
    bf16x8 qf[4];
#pragma unroll
    for (int kk = 0; kk < 4; ++kk) { qf[kk] = *(const bf16x8*)(QM + (size_t)(TP + 4 * b + (l15 & 3)) * 512 + h * 128 + 32 * kk + 8 * g4); if (l15 >= 4) qf[kk] = (bf16x8){0, 0, 0, 0, 0, 0, 0, 0}; }
    f32x4 s[4]; float mx = -INFINITY;
#pragma unroll
    for (int mt = 0; mt < 4; ++mt) {
        f32x4 acc = {0.f, 0.f, 0.f, 0.f};
#pragma unroll
        for (int kk = 0; kk < 4; ++kk) {
            const float* kp = CK + (size_t)(16 * mt + l15) * 512 + 32 * kk + 8 * g4;
            const u32x4 a = pack8(*(const f32x4*)kp, *(const f32x4*)(kp + 4));
            acc = __builtin_amdgcn_mfma_f32_16x16x32_bf16(__builtin_bit_cast(bf16x8, a), qf[kk], acc, 0, 0, 0);
        }
        s[mt] = acc; mx = fmaxf(fmaxf(mx, fmaxf(acc[0], acc[1])), fmaxf(acc[2], acc[3]));
    }
    mx = fmaxf(mx, __shfl_xor(mx, 16)); mx = fmaxf(mx, __shfl_xor(mx, 32));
    float sum = 0.f;
#pragma unroll
    for (int mt = 0; mt < 4; ++mt)
#pragma unroll
        for (int r = 0; r < 4; ++r) { const float p = __builtin_amdgcn_exp2f(s[mt][r] - mx); sum += p; if (l15 < 4) pl[(16 * mt + 4 * g4 + r) * 4 + l15] = p; }
    sum += __shfl_xor(sum, 16); sum += __shfl_xor(sum, 32);
    if (lane < 4) { ml[w * 8 + lane] = mx; ml[w * 8 + 4 + lane] = sum; }
    LDS_WAIT(); asm volatile("" ::: "memory");
    f32x2 o[4] = {{0.f, 0.f}, {0.f, 0.f}, {0.f, 0.f}, {0.f, 0.f}};
#pragma unroll 16
    for (int m = 0; m < 64; ++m) {
        const f32x2 v = *(const f32x2*)(CV + (size_t)m * 512 + 2 * lane);
        const f32x4 p = *(const LAS f32x4*)(pl + m * 4);
#pragma unroll
        for (int t = 0; t < 4; ++t) { o[t][0] += p[t] * v[0]; o[t][1] += p[t] * v[1]; }
    }
#pragma unroll
    for (int t = 0; t < 4; ++t) *(LAS f32x2*)(po + t * 128 + 2 * lane) = o[t];
    __syncthreads();
    {
        const int hh = F.tid >> 8, t = (F.tid >> 6) & 3, d = 2 * (F.tid & 63);
        float mq[4], M = -INFINITY;
#pragma unroll
        for (int q = 0; q < 4; ++q) { mq[q] = ml[(hh * 4 + q) * 8 + t]; M = fmaxf(M, mq[q]); }
        float den = 0.f; f32x2 num = {0.f, 0.f};
#pragma unroll
        for (int q = 0; q < 4; ++q) { const float f = __builtin_amdgcn_exp2f(mq[q] - M); den += f * ml[(hh * 4 + q) * 8 + 4 + t];
            const f32x2 oq = *(const LAS f32x2*)((LAS float*)(F.lds + MSP_O) + (hh * 4 + q) * 512 + t * 128 + d); num[0] += f * oq[0]; num[1] += f * oq[1]; }
        const float inv = 1.0f / den;
        *(unsigned*)(OM + (size_t)(TP + 4 * b + t) * 512 + (2 * hp + hh) * 128 + d) = cvtpk(num[0] * inv, num[1] * inv);
    }
}

__device__ __forceinline__ void final_norm_row_slabs(float* xrow, const float* slab_row, size_t slab_stride, int ns, const float* w, int lane) {
    f32x4* xr = (f32x4*)xrow + lane; const f32x4* wr = (const f32x4*)w + lane;
    f32x4 v[8]; float s = 0.f;
#pragma unroll
    for (int j = 0; j < 8; ++j) v[j] = xr[64 * j];
    for (int k = 0; k < ns; ++k) { const f32x4* sr = (const f32x4*)(slab_row + (size_t)k * slab_stride) + lane;
#pragma unroll
        for (int j = 0; j < 8; ++j) v[j] += sr[64 * j]; }
#pragma unroll
    for (int j = 0; j < 8; ++j) s += (v[j][0] * v[j][0] + v[j][1] * v[j][1]) + (v[j][2] * v[j][2] + v[j][3] * v[j][3]);
    const float rs = __builtin_amdgcn_rsqf(wave_sum(s) * (1.0f / DM) + RMS_EPS);
#pragma unroll
    for (int j = 0; j < 8; ++j) { const f32x4 ww = wr[64 * j]; f32x4 y; y[0] = v[j][0] * rs * ww[0]; y[1] = v[j][1] * rs * ww[1]; y[2] = v[j][2] * rs * ww[2]; y[3] = v[j][3] * rs * ww[3]; xr[64 * j] = y; }
}
__device__ __forceinline__ void final_norm_row(float* xrow, const float* SS, int row, const float* w, int lane) {
    const float rs = row_rs(SS, row);
    f32x4* xr = (f32x4*)xrow + lane; const f32x4* wr = (const f32x4*)w + lane;
#pragma unroll
    for (int j = 0; j < 8; ++j) { f32x4 v = xr[64 * j]; const f32x4 ww = wr[64 * j]; v[0] = v[0] * rs * ww[0]; v[1] = v[1] * rs * ww[1]; v[2] = v[2] * rs * ww[2]; v[3] = v[3] * rs * ww[3]; xr[64 * j] = v; }
}

#define HGRN_SCAN_PROMPT hgrn_scan
#define HGRN_SCAN_SAMPLE hgrn_scan
#ifdef HY_P3DELAY
#define P3_DELAY do { for (int z_ = 0; z_ < 16; ++z_) __builtin_amdgcn_s_sleep(127); __syncthreads(); } while (0)
#else
#define P3_DELAY do {} while (0)
#endif
#define XB_TMO      128
#define XB_XCNT(j)  (256  + 64 * (j))
#define XB_XSUB(j)  (1280 + 64 * (j))
#define XB_XGEN(j)  (2304 + 64 * (j))
#define XB_TOP      3328
#define XB_TOPGEN   3392
#define XCD_BAR_WORDS 3456
#define XB_SPIN_CAP (1u << 18)

__device__ __forceinline__ unsigned xb_ld(unsigned* p)              { return __hip_atomic_load(p, __ATOMIC_RELAXED, __HIP_MEMORY_SCOPE_AGENT); }
__device__ __forceinline__ unsigned xb_add(unsigned* p, unsigned v) { return __hip_atomic_fetch_add(p, v, __ATOMIC_RELAXED, __HIP_MEMORY_SCOPE_AGENT); }
__device__ __forceinline__ unsigned xb_xcc_id() { return (unsigned)__builtin_amdgcn_s_getreg((3 << 11) | 20) & 0xFu; }
#define XB_SPIN(cond, bar) do { unsigned _sp = 0; while (cond) { __builtin_amdgcn_s_sleep(1); \
    if ((++_sp & 255u) == 0u) { if (xb_ld(&(bar)[XB_TMO])) break; if (_sp > XB_SPIN_CAP) { atomicAdd(&(bar)[XB_TMO], 1u); break; } } } } while (0)

struct XcdBarrier {
    unsigned* bar; unsigned x;
    volatile LAS unsigned* st;
};

__device__ __forceinline__ XcdBarrier xcd_barrier_post(unsigned* bar, volatile LAS unsigned* st) {
    XcdBarrier b; b.bar = bar; b.x = xb_xcc_id(); b.st = st;
    if (threadIdx.x == 0) (void)xb_add(&bar[XB_XCNT(b.x)], 1u);
    return b;
}
__device__ __forceinline__ void xcd_barrier_complete(unsigned* bar, unsigned x, unsigned& nloc, unsigned& nx) {
    const unsigned G = gridDim.x * gridDim.y * gridDim.z;
    unsigned sum, cnt, mine, sp = 0u;
    for (;;) {
        sum = 0u; cnt = 0u; mine = 0u;
#pragma unroll
        for (unsigned j = 0; j < 16; ++j) { const unsigned c = xb_ld(&bar[XB_XCNT(j)]); sum += c; cnt += (c > 0u) ? 1u : 0u; mine = (j == x) ? c : mine; }
        if (sum == G) break;
        __builtin_amdgcn_s_sleep(1);
        if ((++sp & 255u) == 0u) { if (xb_ld(&bar[XB_TMO])) break; if (sp > XB_SPIN_CAP) { atomicAdd(&bar[XB_TMO], 1u); break; } }
    }
    nloc = mine > 0u ? mine : 1u; nx = cnt > 0u ? cnt : 1u;
}

__device__ __forceinline__ void xcd_barrier(const XcdBarrier& b) {
    asm volatile("s_waitcnt vmcnt(0)" ::: "memory");
    __syncthreads();
    if (threadIdx.x == 0) {
        unsigned* bar = b.bar;
        __builtin_amdgcn_s_waitcnt(0);
        unsigned nloc = b.st[0], nx = b.st[1];
        if (nloc == 0u) { xcd_barrier_complete(bar, b.x, nloc, nx); b.st[0] = nloc; b.st[1] = nx; }
        const unsigned old = xb_add(&bar[XB_XSUB(b.x)], 1u);
        const unsigned gen = old / nloc;
        if (old + 1u == (gen + 1u) * nloc) {
            __builtin_amdgcn_fence(__ATOMIC_RELEASE, "agent");
            asm volatile("s_waitcnt vmcnt(0)" ::: "memory");
            const unsigned og = xb_add(&bar[XB_TOP], 1u);
            const unsigned tg = og / nx;
            if (og + 1u == (tg + 1u) * nx) xb_add(&bar[XB_TOPGEN], 1u);
            else XB_SPIN(xb_ld(&bar[XB_TOPGEN]) == tg, bar);
            __builtin_amdgcn_fence(__ATOMIC_ACQUIRE, "agent");
            xb_add(&bar[XB_XGEN(b.x)], 1u);
            asm volatile("s_waitcnt vmcnt(0)" ::: "memory");
        } else {
            XB_SPIN(xb_ld(&bar[XB_XGEN(b.x)]) == gen, bar);
            __builtin_amdgcn_fence(__ATOMIC_ACQUIRE, "agent");
            asm volatile("s_waitcnt vmcnt(0)" ::: "memory");
        }
    }
    __syncthreads();
}

constexpr size_t WS_CNT = 4096 + 16384;
constexpr size_t WS_BAR = 4096;
constexpr int LDS_BARST = LDS_BYTES - 64;
constexpr int N_PHASES = 11;
__global__ void __launch_bounds__(NTHREADS, 2) hymba_fwd(Args args) {
    extern __shared__ __attribute__((aligned(16))) unsigned char lds_raw[];
    cg::grid_group grid = cg::this_grid();
    Frame F;
    F.lds = (LAS unsigned char*)lds_raw;
    F.tid = threadIdx.x; F.lane = F.tid & 63; F.wave = __builtin_amdgcn_readfirstlane(F.tid >> 6);
    F.G = gridDim.x; F.bid = blockIdx.x;
    F.in = args.in; F.out = args.out; F.ws = args.ws;
    unsigned char* ws = args.ws; float* out = args.out;
    if (F.tid < 16) ((LAS unsigned*)(F.lds + LDS_BARST))[F.tid] = 0u;
    __syncthreads();
    XcdBarrier xbar = xcd_barrier_post((unsigned*)(ws + WS_BAR), (volatile LAS unsigned*)(F.lds + LDS_BARST));
    if (args.ph_lo > 1000) grid.sync();
#ifdef HY_LDSCLR
    for (int i = F.tid; i < LDS_BYTES / 16; i += NTHREADS) *(LAS u32x4*)(F.lds + i * 16) = (u32x4){0u, 0u, 0u, 0u};
    __syncthreads();
#endif
    const int lo = args.ph_lo, hi = args.ph_hi;
#ifndef HY_PHASE_MASK
#define HY_PHASE_MASK 0x7ff
#endif
#define IN(k) (((HY_PHASE_MASK >> (k)) & 1) && lo <= (k) && (k) < hi)
#ifndef HY_REPMASK
#define HY_REPMASK 0
#endif
#define PHASE(k, ...) do { if (IN(k)) { __VA_ARGS__ } if (IN(k) && ((HY_REPMASK >> (k)) & 1)) { __VA_ARGS__ } } while (0)
#ifdef HY_XACQ
#define SEAM(k) do { if (IN(k) && IN((k) + 1)) { asm volatile("s_waitcnt vmcnt(0)" ::: "memory"); __builtin_amdgcn_fence(__ATOMIC_RELEASE, "agent"); asm volatile("s_waitcnt vmcnt(0)" ::: "memory"); grid.sync(); __builtin_amdgcn_fence(__ATOMIC_ACQUIRE, "agent"); asm volatile("s_waitcnt vmcnt(0)" ::: "memory"); __syncthreads(); } } while (0)
#else
#define SEAM(k) do { if (IN(k) && IN((k) + 1)) { xcd_barrier(xbar); } } while (0)
#endif
    float* SS0 = (float*)(ws + WS_SS); float* SS1 = (float*)(ws + WS_SS + SS_STRIDE); float* SS2 = (float*)(ws + WS_SS + 2 * SS_STRIDE);
    bf16_t* XB = (bf16_t*)(ws + WS_XB);

    PHASE(0, p0_prologue(F, !(F.G > 32)););
    SEAM(0);
    PHASE(1,
        { pg8::Gemm g{XB, (const bf16_t*)(ws + WS_WIN), TT, NIN, DM, DM}; pg8::StaticOrder S; S.init(TT, NIN, F.G, F.bid);
          EpiIn E{out, out + (size_t)TT * 1024, (bf16_t*)(out + O_SST), (bf16_t*)(ws + WS_GATE), (bf16_t*)(ws + WS_SQ), (bf16_t*)(ws + WS_SKV), (const float*)(ws + WS_TAB), out};
          pg8::gemm_phase<EpiIn, pg8::StaticOrder, true, true>(F.lds, g, S, E); }
        { pg8::Gemm g{(const bf16_t*)(ws + WS_MN), (const bf16_t*)(ws + WS_WMKV), 1024, 1024, DM, DM}; pg8::StaticOrder S; S.init(1024, 1024, F.G, (F.bid + 16) % F.G);
          EpiMemKV E{(bf16_t*)(ws + WS_MK), (bf16_t*)(ws + WS_MVT), out};
          pg8::gemm_phase<EpiMemKV, pg8::StaticOrder, true, true>(F.lds, g, S, E); }
    );
    SEAM(1);
    PHASE(2, hgrn_prep(F););
    SEAM(2);
    PHASE(3,
        const bool split = F.G > 32;
#define P3_SCAN do { if (F.bid < 32) { P3_DELAY; for (int bh = F.bid; bh < 32; bh += F.G) { const int b = bh >> 3, h = bh & 7; \
                HGRN_SCAN_PROMPT(F, b * 256, 256, h, b * SEQ, 16, nullptr, out + O_PST + (size_t)bh * 16384); } } } while (0)
#define P3_OTHERS do { if (!split || F.bid >= 32) { const int nw = split ? F.G - 32 : F.G; \
            for (int i = split ? F.bid - 32 : F.bid; i < 1536; i += nw) { \
                if (i < 256) swa_prompt_unit(F, i); \
                else if (i < 512) swa_sample_unit(F, i - 256); \
                else { const int t = i - 512, b = t >> 3, h = t & 7; \
                    HGRN_SCAN_SAMPLE(F, NCHP + b, 1, h, TP + 4 * b, 4, F.in[I_STATE] + (size_t)t * 16384, out + O_SST + (size_t)t * 16384); } } } } while (0)
        P3_SCAN;
        if ((HY_REPMASK >> 11) & 1) P3_SCAN;
        P3_OTHERS;
        if (split && F.bid >= 32) {
            const int nw = F.G - 32; unsigned* CNT = (unsigned*)(ws + WS_CNT);
            asm volatile("s_waitcnt vmcnt(0)" ::: "memory"); __syncthreads();
            if (F.tid == 0) {
                __builtin_amdgcn_fence(__ATOMIC_RELEASE, "agent"); asm volatile("s_waitcnt vmcnt(0)" ::: "memory");
                __hip_atomic_fetch_add(CNT, 1u, __ATOMIC_RELAXED, __HIP_MEMORY_SCOPE_AGENT);
                unsigned sp = 0; while (__hip_atomic_load(CNT, __ATOMIC_RELAXED, __HIP_MEMORY_SCOPE_AGENT) < (unsigned)nw) { __builtin_amdgcn_s_sleep(2); if (++sp > (1u << 22)) break; }
                __builtin_amdgcn_fence(__ATOMIC_ACQUIRE, "agent"); asm volatile("s_waitcnt vmcnt(0)" ::: "memory");
            }
            __syncthreads();
            pg8::Gemm g{(const bf16_t*)(ws + WS_MIX), (const bf16_t*)(ws + WS_WOUT), TT, DM, DM / 2, DM}; pg8::StaticOrder S; S.init(TT, DM, nw, F.bid - 32); S.ksv = 1;
            EpiResid E{F.in[I_XP], F.in[I_XS], out, nullptr, nullptr};
            pg8::gemm_phase<EpiResid, pg8::StaticOrder, true, true>(F.lds, g, S, E);
            __syncthreads();
            p0_convert(F, CV_EARLY, CV_ALL, (F.bid - 32) * NWAVES + F.wave, nw * NWAVES);
        }
    );
    SEAM(3);
    PHASE(4,
        if (!(F.G > 32)) {
            pg8::Gemm g0{(const bf16_t*)(ws + WS_MIX), (const bf16_t*)(ws + WS_WOUT), TT, DM, DM / 2, DM}; pg8::StaticOrder S0; S0.init(TT, DM, F.G, F.bid); S0.ksv = 1;
            EpiResid E0{F.in[I_XP], F.in[I_XS], out, nullptr, nullptr};
            pg8::gemm_phase<EpiResid, pg8::StaticOrder, true, true>(F.lds, g0, S0, E0);
            xcd_barrier(xbar);
        }
        pg8::Gemm g{(const bf16_t*)(ws + WS_MIX), (const bf16_t*)(ws + WS_WOUT), TT, DM, DM / 2, DM}; pg8::StaticOrder S; S.init(TT, DM, F.G, F.bid);
        EpiResid E{out, out + (size_t)TP * DM, out, XB, SS0};
        pg8::gemm_phase<EpiResid, pg8::StaticOrder, true, true>(F.lds, g, S, E);
    );
    SEAM(4);
    PHASE(5,
        pg8::Gemm g{XB, (const bf16_t*)(ws + WS_WMQ), TT, MEMW, DM, DM}; pg8::StaticOrder S; S.init(TT, MEMW, F.G, F.bid);
        EpiScaleBf16 E{(bf16_t*)(ws + WS_QM), MEMW, SS0, MEM_QSCALE};
        pg8::gemm_phase<EpiScaleBf16, pg8::StaticOrder, true, true>(F.lds, g, S, E);
    );
    SEAM(5);
    PHASE(6,
        for (int u = F.bid; u < 256; u += F.G) memattn_prompt_unit(F, u);
        for (int t = F.bid; t < 256; t += F.G) memattn_sample_block(F, t);
    );
    SEAM(6);
    if (IN(7)) {
        pg8::Gemm g{(const bf16_t*)(ws + WS_OM), (const bf16_t*)(ws + WS_WMO), TT, DM, MEMW, MEMW}; pg8::StaticOrder S; S.init(TT, DM, F.G, F.bid);
        EpiResid E{out, out + (size_t)TP * DM, out, XB, SS1};
        pg8::gemm_phase<EpiResid, pg8::StaticOrder, true, true>(F.lds, g, S, E);
    }
    SEAM(7);
    PHASE(8,
        pg8::Gemm g{XB, (const bf16_t*)(ws + WS_WGU), TT, 2 * FF, DM, DM}; pg8::StaticOrder S; S.init(TT, 2 * FF, F.G, F.bid);
        EpiSwiGLU E{(bf16_t*)(ws + WS_HID), SS1};
        pg8::gemm_phase<EpiSwiGLU, pg8::StaticOrder, true, true>(F.lds, g, S, E);
    );
    SEAM(8);
    constexpr int DN_NS = 11; constexpr size_t SLAB_STRIDE = (size_t)TS * DM;
    if (IN(9)) {
        { pg8::Gemm g{(const bf16_t*)(ws + WS_HID), (const bf16_t*)(ws + WS_WDN), TP, DM, FF, FF}; pg8::StaticOrder S; S.init(TP, DM, F.G, F.bid);
          EpiResid E{out, out + (size_t)TP * DM, out, nullptr, SS2};
          pg8::gemm_phase<EpiResid, pg8::StaticOrder, true, true>(F.lds, g, S, E); }
        { pg8::Gemm g{(const bf16_t*)(ws + WS_HID), (const bf16_t*)(ws + WS_WDN), TT, DM, FF / DN_NS, FF}; SplitOrder S{F.bid, DN_NS};
          EpiSlab E{(float*)(ws + WS_MIX), TP, SLAB_STRIDE};
          pg8::gemm_phase<EpiSlab, SplitOrder, true, true>(F.lds, g, S, E); }
    }
    SEAM(9);
    if (IN(10)) {
        for (int m = F.bid * NWAVES + F.wave; m < TT; m += F.G * NWAVES) {
            if (m < TP) final_norm_row(out + (size_t)m * DM, SS2, m, F.in[I_NFINAL], F.lane);
            else final_norm_row_slabs(out + (size_t)m * DM, (const float*)(ws + WS_MIX) + (size_t)(m - TP) * DM, SLAB_STRIDE, DN_NS, F.in[I_NFINAL], F.lane);
        }
    }
#undef IN
#undef SEAM
}

#ifndef HY_N_LAUNCHES
#define HY_N_LAUNCHES 1
#endif
extern "C" void kernel_launch(void* const* d_in, const int* in_sizes, int n_in, void* d_out, int out_size, void* d_ws, size_t ws_size, hipStream_t stream) {
    static int grid = 0;
    if (grid == 0) {
        if (n_in != 26 || (size_t)out_size != O_END || ws_size < WS_END) { fprintf(stderr, "kernel_launch: unexpected problem: n_in %d out %d ws %zu (need %zu)\n", n_in, out_size, ws_size, (size_t)WS_END); grid = -1; return; }
        int dev = 0, cus = 0, per_cu = 0;
        hipGetDevice(&dev); hipDeviceGetAttribute(&cus, hipDeviceAttributeMultiprocessorCount, dev);
        if (hipFuncSetAttribute((const void*)hymba_fwd, hipFuncAttributeMaxDynamicSharedMemorySize, LDS_BYTES) != hipSuccess) { fprintf(stderr, "kernel_launch: hipFuncSetAttribute failed\n"); grid = -1; return; }
        if (hipOccupancyMaxActiveBlocksPerMultiprocessor(&per_cu, (const void*)hymba_fwd, NTHREADS, LDS_BYTES) != hipSuccess || per_cu < 1) { fprintf(stderr, "kernel_launch: occupancy query says %d blocks/CU\n", per_cu); per_cu = 1; }
        (void)hipGetLastError();
        grid = cus;
        fprintf(stderr, "kernel_launch: %d CUs, occupancy %d blocks/CU, grid %d\n", cus, per_cu, grid);
    }
    if (grid < 0) return;
    Args a{};
    for (int i = 0; i < 26; ++i) a.in[i] = (const float*)d_in[i];
    a.out = (float*)d_out; a.ws = (unsigned char*)d_ws;
    if (hipMemsetAsync((char*)d_ws + WS_BAR, 0, 16384 + 256, stream) != hipSuccess) { fprintf(stderr, "kernel_launch: hipMemsetAsync failed\n"); return; }
#if HY_N_LAUNCHES == 1
    a.ph_lo = 0; a.ph_hi = N_PHASES;
    void* kargs[] = {&a};
    hipError_t e = hipLaunchCooperativeKernel((const void*)hymba_fwd, dim3(grid), dim3(NTHREADS), kargs, LDS_BYTES, stream);
    if (e != hipSuccess) fprintf(stderr, "kernel_launch: cooperative launch failed: %s\n", hipGetErrorString(e));
#else
    for (int p = 0; p < N_PHASES; ++p) {
        a.ph_lo = p; a.ph_hi = p + 1;
        hipLaunchKernelGGL(hymba_fwd, dim3(grid), dim3(NTHREADS), LDS_BYTES, stream, a);
    }
#endif
}
```

```cpp
#include <hip/hip_runtime.h>
#include <hip/hip_cooperative_groups.h>
#include <cstdio>
#include <cstdint>
namespace cg = cooperative_groups;

namespace pg8 {
#define PG8_LAS __attribute__((address_space(3)))
typedef unsigned short bf16_t;
typedef short bf16x8 __attribute__((ext_vector_type(8)));
typedef float f32x4 __attribute__((ext_vector_type(4)));
typedef unsigned u32x4 __attribute__((ext_vector_type(4)));
constexpr int BM = 256, BK = 64, HALF = 128, HTB = HALF * BK * 2  , STAGE_BYTES = 8 * HTB, NXCD = 8, WGM = 8;

__host__ __device__ __forceinline__ int lds_byte(int r, int c) { const int st = (r >> 4) * 2 + (c >> 5), rr = r & 15, cc = c & 31, ob = rr * 64 + cc * 2; return st * 1024 + (ob ^ (((ob >> 9) & 1) << 5)); }
__host__ __device__ __forceinline__ void stage_rc(int b, int& R, int& C) { const int st = b / 1024, sb = b % 1024, swz = sb ^ (((sb >> 9) & 1) << 5); R = (st >> 1) * 16 + swz / 64; C = (st & 1) * 32 + (swz % 64) / 2; }
__host__ __device__ __forceinline__ int perm32(int rho) { const int n = rho >> 4, i = rho & 15; return 8 * (i >> 2) + 4 * n + (i & 3); }

struct Unit { int pm, pn, ks; };
struct Gemm { const bf16_t* A; const bf16_t* Bt; int M, N, K, ld; };

struct StaticOrder {
    int nM, nN, nwg, G, c, ksv = 0;
    __host__ __device__ void init(int M, int N, int G_, int c_) { nM = M / BM; nN = N / BM; nwg = nM * nN; G = G_; c = c_; }
    __host__ __device__ bool next(int i, Unit& u) const {
        const long L = (long)i * G + c; if (L >= nwg) return false;
        int wgid = (int)L; { const int q = nwg / NXCD, r = nwg % NXCD, xcd = wgid % NXCD, off = wgid / NXCD; wgid = (xcd < r ? xcd * (q + 1) : r * (q + 1) + (xcd - r) * q) + off; }
        const int nig = WGM * nN, gid = wgid / nig, fm = gid * WGM, gsz = (nM - fm) < WGM ? (nM - fm) : WGM;
        u.pm = fm + ((wgid % nig) % gsz); u.pn = (wgid % nig) / gsz; u.ks = ksv; return true;
    }
    __device__ __forceinline__ void a_ready(const Unit&) const {}
    __device__ __forceinline__ void done(const Unit&) const {}
};

template <class Epi, class Sched, bool ALIGN_EPI = false, bool SP2 = false>
__device__ __forceinline__ void gemm_phase(PG8_LAS unsigned char* lds, const Gemm g, const Sched& S, const Epi& E) {
    const int tid = threadIdx.x, wid = __builtin_amdgcn_readfirstlane(tid >> 6), lane = tid & 63, wr = wid >> 2, wc = wid & 3, fr = lane & 15, fq = lane >> 4;
    const int K = g.ld, nt = g.K / BK;
    unsigned voffA[2], voffB[2];
#pragma unroll
    for (int i = 0; i < 2; ++i) { int R, C; stage_rc(tid * 16 + i * 8192, R, C); const int Rb = Epi::PERM ? ((R & ~31) + perm32(R & 31)) : R;
        voffA[i] = (unsigned)(R * K + C) * 2u; voffB[i] = (unsigned)(Rb * K + C) * 2u; }
    const size_t kstep = (size_t)(BK * 2);
    const size_t hstep = (size_t)HALF * K * 2;
    const size_t tstep = 2 * hstep;
    const unsigned ldsw = (unsigned)wid * 1024u;
    const int aoff = lds_byte(wr * 64 + fr, fq * 8), boff = lds_byte(wc * 32 + fr, fq * 8);
#define PG8_SA(b, h) (((b) * 2 + (h)) * HTB)
#define PG8_SB(b, h) ((4 + (b) * 2 + (h)) * HTB)
#define PG8_STAGE(bufoff, gbase, voff) do { _Pragma("unroll") for (int _i = 0; _i < 2; ++_i) \
        __builtin_amdgcn_global_load_lds((const unsigned*)((const char*)(gbase) + (voff)[_i]), (PG8_LAS unsigned*)(lds + (bufoff) + ldsw + _i * 8192), 16, 0, 0); } while (0)
#define PG8_LDA(dst, b, h) do { _Pragma("unroll") for (int m = 0; m < 4; ++m) _Pragma("unroll") for (int k = 0; k < 2; ++k) dst[m][k] = *(const PG8_LAS bf16x8*)(lds + PG8_SA(b, h) + aoff + m * 2048 + k * 1024); } while (0)
#define PG8_LDB(dst, b, h) do { _Pragma("unroll") for (int n = 0; n < 2; ++n) _Pragma("unroll") for (int k = 0; k < 2; ++k) dst[n][k] = *(const PG8_LAS bf16x8*)(lds + PG8_SB(b, h) + boff + n * 2048 + k * 1024); } while (0)
#define PG8_MMA(ai, bj, At, Bt) do { __builtin_amdgcn_s_setprio(1); _Pragma("unroll") for (int m = 0; m < 4; ++m) _Pragma("unroll") for (int n = 0; n < 2; ++n) _Pragma("unroll") for (int k = 0; k < 2; ++k) \
        acc[ai][bj][m][n] = __builtin_amdgcn_mfma_f32_16x16x32_bf16(Bt[n][k], At[m][k], acc[ai][bj][m][n], 0, 0, 0); __builtin_amdgcn_s_setprio(0); } while (0)
#define PG8_WAIT_V(n) asm volatile("s_waitcnt vmcnt(" #n ")" ::: "memory")
#define PG8_WAIT_L(n) asm volatile("s_waitcnt lgkmcnt(" #n ")" ::: "memory")
#define PG8_BAR __builtin_amdgcn_s_barrier()
#define PG8_SCHED __builtin_amdgcn_sched_barrier(0)
    Unit cur, nxt; int ui = 0;
    if (!S.next(0, cur)) return;
    f32x4 acc[2][2][4][2];
#pragma unroll
    for (int a = 0; a < 2; ++a)
#pragma unroll
        for (int b = 0; b < 2; ++b)
#pragma unroll
            for (int m = 0; m < 4; ++m)
#pragma unroll
                for (int n = 0; n < 2; ++n) acc[a][b][m][n] = (f32x4){0.f, 0.f, 0.f, 0.f};
    bf16x8 At[4][2], B0[2][2], B1[2][2];
    const char* cA = (const char*)g.A + (size_t)cur.pm * tstep + (size_t)cur.ks * g.K * 2; const char* cB = (const char*)g.Bt + (size_t)cur.pn * tstep + (size_t)cur.ks * g.K * 2;
    S.a_ready(cur);
    if constexpr (SP2) {
        PG8_STAGE(PG8_SB(0, 0), cB, voffB); PG8_STAGE(PG8_SB(0, 1), cB + hstep, voffB); PG8_STAGE(PG8_SA(0, 0), cA, voffA); PG8_STAGE(PG8_SA(0, 1), cA + hstep, voffA);
        if (wr == 1) PG8_BAR;
        PG8_WAIT_V(2); PG8_BAR;
        PG8_STAGE(PG8_SB(1, 0), cB + kstep, voffB); PG8_STAGE(PG8_SA(1, 0), cA + kstep, voffA); PG8_STAGE(PG8_SB(1, 1), cB + hstep + kstep, voffB);
        PG8_WAIT_V(6); PG8_BAR;
    } else {
        PG8_STAGE(PG8_SB(0, 0), cB, voffB); PG8_STAGE(PG8_SA(0, 0), cA, voffA); PG8_STAGE(PG8_SB(0, 1), cB + hstep, voffB); PG8_STAGE(PG8_SA(0, 1), cA + hstep, voffA);
        if (wr == 1) PG8_BAR;
        PG8_WAIT_V(4); PG8_BAR;
        PG8_STAGE(PG8_SB(1, 0), cB + kstep, voffB); PG8_STAGE(PG8_SA(1, 0), cA + kstep, voffA); PG8_STAGE(PG8_SB(1, 1), cB + hstep + kstep, voffB);
        PG8_WAIT_V(6); PG8_BAR;
    }
    for (;;) {
        const bool has_next = S.next(ui + 1, nxt);
        const char* nA = has_next ? (const char*)g.A + (size_t)nxt.pm * tstep + (size_t)nxt.ks * g.K * 2 : cA; const char* nB = has_next ? (const char*)g.Bt + (size_t)nxt.pn * tstep + (size_t)nxt.ks * g.K * 2 : cB;
        for (int t = 0; t < nt; t += 2) {
            const bool last = (t == nt - 2);
            const char* a1 = cA + (size_t)(t + 1) * kstep;
            const char* a2 = last ? nA : cA + (size_t)(t + 2) * kstep; const char* b2 = last ? nB : cB + (size_t)(t + 2) * kstep;
            const char* a3 = a2 + kstep; const char* b3 = b2 + kstep;
            if (last && has_next) S.a_ready(nxt);
            if constexpr (SP2) {
            PG8_LDB(B0, 0, 0); PG8_LDB(B1, 0, 1); PG8_SCHED; PG8_LDA(At, 0, 0); PG8_STAGE(PG8_SA(1, 1), a1 + hstep, voffA);
            PG8_WAIT_V(8); PG8_WAIT_L(0); PG8_BAR; PG8_MMA(0, 0, At, B0); PG8_MMA(0, 1, At, B1); PG8_BAR; PG8_SCHED;
            PG8_LDA(At, 0, 1); PG8_STAGE(PG8_SB(0, 0), b2, voffB); PG8_STAGE(PG8_SB(0, 1), b2 + hstep, voffB); PG8_STAGE(PG8_SA(0, 0), a2, voffA);
            PG8_WAIT_V(8); PG8_WAIT_L(0); PG8_BAR; PG8_MMA(1, 0, At, B0); PG8_MMA(1, 1, At, B1); PG8_BAR; PG8_SCHED;
            PG8_LDB(B0, 1, 0); PG8_LDB(B1, 1, 1); PG8_SCHED; PG8_LDA(At, 1, 0); PG8_STAGE(PG8_SA(0, 1), a2 + hstep, voffA);
            PG8_WAIT_V(8); PG8_WAIT_L(0); PG8_BAR; PG8_MMA(0, 0, At, B0); PG8_MMA(0, 1, At, B1); PG8_BAR; PG8_SCHED;
            PG8_LDA(At, 1, 1); PG8_STAGE(PG8_SB(1, 0), b3, voffB); PG8_STAGE(PG8_SB(1, 1), b3 + hstep, voffB); PG8_STAGE(PG8_SA(1, 0), a3, voffA);
            PG8_WAIT_V(8); PG8_WAIT_L(0); PG8_BAR; PG8_MMA(1, 0, At, B0); PG8_MMA(1, 1, At, B1); PG8_BAR; PG8_SCHED;
            } else {
            PG8_LDB(B0, 0, 0); PG8_SCHED; PG8_LDA(At, 0, 0); PG8_STAGE(PG8_SA(1, 1), a1 + hstep, voffA);
            PG8_WAIT_L(8); PG8_BAR; PG8_WAIT_L(0); PG8_MMA(0, 0, At, B0); PG8_BAR; PG8_SCHED;
            PG8_LDB(B1, 0, 1); PG8_STAGE(PG8_SB(0, 0), b2, voffB);
            PG8_BAR; PG8_WAIT_L(0); PG8_MMA(0, 1, At, B1); PG8_BAR;
            PG8_LDA(At, 0, 1); PG8_STAGE(PG8_SA(0, 0), a2, voffA);
            PG8_BAR; PG8_WAIT_L(0); PG8_MMA(1, 0, At, B0); PG8_BAR; PG8_SCHED;
            PG8_STAGE(PG8_SB(0, 1), b2 + hstep, voffB);
            PG8_WAIT_V(6); PG8_BAR; PG8_MMA(1, 1, At, B1); PG8_BAR;
            PG8_LDB(B0, 1, 0); PG8_SCHED; PG8_LDA(At, 1, 0); PG8_STAGE(PG8_SA(0, 1), a2 + hstep, voffA);
            PG8_WAIT_L(8); PG8_BAR; PG8_WAIT_L(0); PG8_MMA(0, 0, At, B0); PG8_BAR; PG8_SCHED;
            PG8_LDB(B1, 1, 1); PG8_STAGE(PG8_SB(1, 0), b3, voffB);
            PG8_BAR; PG8_WAIT_L(0); PG8_MMA(0, 1, At, B1); PG8_BAR;
            PG8_LDA(At, 1, 1); PG8_STAGE(PG8_SA(1, 0), a3, voffA);
            PG8_BAR; PG8_WAIT_L(0); PG8_MMA(1, 0, At, B0); PG8_BAR; PG8_SCHED;
            PG8_STAGE(PG8_SB(1, 1), b3 + hstep, voffB);
            PG8_WAIT_V(6); PG8_BAR; PG8_MMA(1, 1, At, B1); PG8_BAR;
            }
        }
        if constexpr (ALIGN_EPI) { if (wr == 0) PG8_BAR; }
        if constexpr (!Epi::AFTER_DRAIN) { E(acc, cur, wr, wc, fr, fq); S.done(cur); }
        if (!has_next) break;
#pragma unroll
        for (int a = 0; a < 2; ++a)
#pragma unroll
            for (int b = 0; b < 2; ++b)
#pragma unroll
                for (int m = 0; m < 4; ++m)
#pragma unroll
                    for (int n = 0; n < 2; ++n) acc[a][b][m][n] = (f32x4){0.f, 0.f, 0.f, 0.f};
        cur = nxt; cA = nA; cB = nB; ++ui;
        if constexpr (ALIGN_EPI) { if (wr == 1) PG8_BAR; }
    }
    PG8_WAIT_V(0);
    if constexpr (!ALIGN_EPI) { if (wr == 0) PG8_BAR; }
    PG8_BAR;
    if constexpr (Epi::AFTER_DRAIN) { E.fused(acc, cur, wr, wc, fr, fq, lds, wid, lane); S.done(cur); }
#undef PG8_SA
#undef PG8_SB
#undef PG8_STAGE
#undef PG8_LDA
#undef PG8_LDB
#undef PG8_MMA
#undef PG8_WAIT_V
#undef PG8_WAIT_L
#undef PG8_BAR
#undef PG8_SCHED
}
}

#define LAS __attribute__((address_space(3)))
typedef unsigned short bf16_t;
typedef short bf16x8 __attribute__((ext_vector_type(8)));
typedef short bf16x4 __attribute__((ext_vector_type(4)));
typedef float f32x4 __attribute__((ext_vector_type(4)));
typedef float f32x2 __attribute__((ext_vector_type(2)));
typedef unsigned u32x4 __attribute__((ext_vector_type(4)));
typedef unsigned u32x2 __attribute__((ext_vector_type(2)));
typedef __bf16 hbf16x2 __attribute__((ext_vector_type(2)));

constexpr int DM = 2048, TP = 16384, TS = 512, TT = TP + TS, SEQ = 4096, DB = 128;
constexpr int NIN = 5376, FF = 5632, MEMW = 512;
constexpr int NCHP = TP / 16, NCH = NCHP + DB;
constexpr float RMS_EPS = 1e-6f;
constexpr float LOG2E = 1.4426950408889634f;
constexpr float SWA_QSCALE = 0.125f * LOG2E;
constexpr float MEM_QSCALE = 0.08838834764831845f * LOG2E;
constexpr int NWAVES = 8, NTHREADS = 512;
constexpr int LDS_BYTES = 147456;

constexpr size_t O_YP = 0, O_YS = 33554432, O_PST = 34603008, O_PSK = 35127296, O_PSV = 35192832, O_PMK = 35258368, O_PMV = 35782656,
                 O_SST = 36306944, O_SSK = 53084160, O_SSV = 55181312, O_END = 57278464;
constexpr size_t MiB = 1u << 20;
constexpr size_t WS_TAB = 1 * MiB;
constexpr size_t WS_WIN = 2 * MiB, WS_WOUT = 23 * MiB, WS_WMQ = 31 * MiB, WS_WMKV = 33 * MiB, WS_WMO = 37 * MiB, WS_WGU = 39 * MiB, WS_WDN = 83 * MiB;
constexpr size_t WS_SS = 105 * MiB;
constexpr size_t SS_STRIDE = 2359296;
constexpr size_t WS_MK = 112 * MiB, WS_MVT = 113 * MiB, WS_QM = 114 * MiB, WS_OM = 131 * MiB, WS_MN = 148 * MiB, WS_XB = 152 * MiB;
constexpr size_t WS_D = 218 * MiB;
constexpr size_t WS_GATE = WS_D, WS_SQ = WS_D + 33 * MiB, WS_SKV = WS_D + 66 * MiB, WS_QIN = WS_D + 75 * MiB, WS_KT = WS_D + 111 * MiB, WS_VT = WS_D + 147 * MiB,
                 WS_PSC = WS_D + 183 * MiB, WS_DEC = WS_D + 188 * MiB, WS_MIX = WS_D + 193 * MiB, WS_END = WS_D + 259 * MiB;
constexpr size_t WS_HID = WS_D;
static_assert((size_t)TT * FF * 2 <= 183 * MiB, "HID overlay");

struct Args {
    const float* in[26];
    float* out; unsigned char* ws;
    int ph_lo, ph_hi;
};

__device__ __forceinline__ unsigned cvtpk(float lo, float hi) { f32x2 v = {lo, hi}; hbf16x2 b = __builtin_convertvector(v, hbf16x2); return __builtin_bit_cast(unsigned, b); }
__device__ __forceinline__ float bf2f(unsigned short b) { return __uint_as_float((unsigned)b << 16); }
__device__ __forceinline__ unsigned short f2bf(float f) { return (unsigned short)(cvtpk(f, 0.f) & 0xffffu); }
__device__ __forceinline__ u32x4 pack8(f32x4 a, f32x4 b) { u32x4 w; w.x = cvtpk(a[0], a[1]); w.y = cvtpk(a[2], a[3]); w.z = cvtpk(b[0], b[1]); w.w = cvtpk(b[2], b[3]); return w; }
__device__ __forceinline__ u32x2 pack4(f32x4 a) { u32x2 w; w.x = cvtpk(a[0], a[1]); w.y = cvtpk(a[2], a[3]); return w; }
__device__ __forceinline__ float fexp(float x) { return __builtin_amdgcn_exp2f(x * LOG2E); }
__device__ __forceinline__ float fsigmoid(float x) { return __builtin_amdgcn_rcpf(1.0f + fexp(-x)); }
__device__ __forceinline__ float wave_sum(float v) {
#pragma unroll
    for (int o = 1; o < 64; o <<= 1) v += __shfl_xor(v, o);
    return v;
}
#define LDS_WAIT() asm volatile("s_waitcnt lgkmcnt(0)" ::: "memory")

__device__ __forceinline__ float row_rs(const float* SS, int row) {
    const f32x4* p = (const f32x4*)(SS + (size_t)row * 32);
    f32x4 s = p[0];
#pragma unroll
    for (int i = 1; i < 8; ++i) s += p[i];
    return __builtin_amdgcn_rsqf(((s[0] + s[1]) + (s[2] + s[3])) * (1.0f / DM) + RMS_EPS);
}

using pg8::Unit;
struct EpiIn {
    static constexpr bool PERM = true, AFTER_DRAIN = false;
    float* QF; float* GF; bf16_t* VB; bf16_t* GATE; bf16_t* SQ; bf16_t* SKV; const float* LB; float* out;
    __device__ __forceinline__ void operator()(const f32x4 (&acc)[2][2][4][2], const Unit& u, int wr, int wc, int fr, int fq) const {
        const int pn = u.pn;
#pragma unroll
        for (int ai = 0; ai < 2; ++ai)
#pragma unroll
            for (int m = 0; m < 4; ++m) {
                const int row = u.pm * 256 + ai * 128 + wr * 64 + m * 16 + fr;
#pragma unroll
                for (int bj = 0; bj < 2; ++bj) {
                    const int c = pn * 256 + bj * 128 + wc * 32 + 8 * fq;
                    f32x4 v0 = acc[ai][bj][m][0], v1 = acc[ai][bj][m][1];
                    if (pn < 4) {
                        float* d = QF + (size_t)row * 1024 + c; *(f32x4*)d = v0; *(f32x4*)(d + 4) = v1;
                    } else if (pn < 8) {
                        const int cc = c - 1024;
                        const f32x4 l0 = *(const f32x4*)(LB + cc), l1 = *(const f32x4*)(LB + cc + 4);
#pragma unroll
                        for (int j = 0; j < 4; ++j) { v0[j] = __logf(l0[j] + (1.0f - l0[j]) * fsigmoid(v0[j])); v1[j] = __logf(l1[j] + (1.0f - l1[j]) * fsigmoid(v1[j])); }
                        float* d = GF + (size_t)row * 1024 + cc; *(f32x4*)d = v0; *(f32x4*)(d + 4) = v1;
                    } else if (pn < 12) {
                        *(u32x4*)(VB + (size_t)row * 1024 + (c - 2048)) = pack8(v0, v1);
                    } else if (pn < 16) {
#pragma unroll
                        for (int j = 0; j < 4; ++j) { v0[j] = v0[j] * fsigmoid(v0[j]); v1[j] = v1[j] * fsigmoid(v1[j]); }
                        *(u32x4*)(GATE + (size_t)row * 1024 + (c - 3072)) = pack8(v0, v1);
                    } else if (pn < 20) {
                        *(u32x4*)(SQ + (size_t)row * 1024 + (c - 4096)) = pack8(v0 * SWA_QSCALE, v1 * SWA_QSCALE);
                    } else {
                        const int cc = c - 5120;
                        *(u32x4*)(SKV + (size_t)row * 256 + cc) = pack8(v0, v1);
                        float* d = nullptr;
                        if (row < TP) { const int b = row >> 12, t = row & 4095; if (t >= SEQ - 128) d = out + (bj == 0 ? O_PSK : O_PSV) + (size_t)(b * 128 + (t - (SEQ - 128))) * 128 + (cc & 127); }
                        else { const int rs = row - TP, b = rs >> 2, t = rs & 3; d = out + (bj == 0 ? O_SSK : O_SSV) + (size_t)(b * 128 + 124 + t) * 128 + (cc & 127); }
                        if (d) { *(f32x4*)d = v0; *(f32x4*)(d + 4) = v1; }
                    }
                }
            }
    }
};
struct EpiMemKV {
    static constexpr bool PERM = true, AFTER_DRAIN = false;
    bf16_t* MK; bf16_t* MVT; float* out;
    __device__ __forceinline__ void operator()(const f32x4 (&acc)[2][2][4][2], const Unit& u, int wr, int wc, int fr, int fq) const {
#pragma unroll
        for (int ai = 0; ai < 2; ++ai)
#pragma unroll
            for (int m = 0; m < 4; ++m) {
                const int row = u.pm * 256 + ai * 128 + wr * 64 + m * 16 + fr;
#pragma unroll
                for (int bj = 0; bj < 2; ++bj) {
                    const int c = u.pn * 256 + bj * 128 + wc * 32 + 8 * fq;
                    const f32x4 v0 = acc[ai][bj][m][0], v1 = acc[ai][bj][m][1];
                    if (u.pn < 2) {
                        float* d = out + O_PMK + (size_t)row * 512 + c; *(f32x4*)d = v0; *(f32x4*)(d + 4) = v1;
                        *(u32x4*)(MK + (size_t)row * 512 + c) = pack8(v0, v1);
                    } else {
                        const int cv = c - 512, h = cv >> 7, dd = cv & 127, b = row >> 8, mm = row & 255;
                        float* d = out + O_PMV + (size_t)row * 512 + cv; *(f32x4*)d = v0; *(f32x4*)(d + 4) = v1;
                        bf16_t* t = MVT + ((size_t)((b * 4 + h) * 128 + dd)) * 256 + mm;
#pragma unroll
                        for (int j = 0; j < 4; ++j) { t[(size_t)j * 256] = f2bf(v0[j]); t[(size_t)(j + 4) * 256] = f2bf(v1[j]); }
                    }
                }
            }
    }
};
struct EpiResid {
    static constexpr bool PERM = true, AFTER_DRAIN = false;
    const float* resP; const float* resS; float* X; bf16_t* XB; float* SS;
    __device__ __forceinline__ void operator()(const f32x4 (&acc)[2][2][4][2], const Unit& u, int wr, int wc, int fr, int fq) const {
#pragma unroll
        for (int ai = 0; ai < 2; ++ai)
#pragma unroll
            for (int m = 0; m < 4; ++m) {
                const int row = u.pm * 256 + ai * 128 + wr * 64 + m * 16 + fr;
                const float* rrow = (row < TP) ? resP + (size_t)row * DM : resS + (size_t)(row - TP) * DM;
                float ss = 0.f;
#pragma unroll
                for (int bj = 0; bj < 2; ++bj) {
                    const int c = u.pn * 256 + bj * 128 + wc * 32 + 8 * fq;
                    const f32x4 v0 = acc[ai][bj][m][0] + *(const f32x4*)(rrow + c), v1 = acc[ai][bj][m][1] + *(const f32x4*)(rrow + c + 4);
                    float* d = X + (size_t)row * DM + c; *(f32x4*)d = v0; *(f32x4*)(d + 4) = v1;
                    ss += (v0[0] * v0[0] + v0[1] * v0[1]) + (v0[2] * v0[2] + v0[3] * v0[3]) + (v1[0] * v1[0] + v1[1] * v1[1]) + (v1[2] * v1[2] + v1[3] * v1[3]);
                    if (XB) *(u32x4*)(XB + (size_t)row * DM + c) = pack8(v0, v1);
                }
                ss += __shfl_xor(ss, 16); ss += __shfl_xor(ss, 32);
                if (SS && fq == 0) SS[(size_t)row * 32 + u.pn * 4 + wc] = ss;
            }
    }
};
struct EpiSlab {
    static constexpr bool PERM = true, AFTER_DRAIN = false;
    float* SLAB; int row0; size_t slab_stride;
    __device__ __forceinline__ void operator()(const f32x4 (&acc)[2][2][4][2], const Unit& u, int wr, int wc, int fr, int fq) const {
        float* base = SLAB + (size_t)u.ks * slab_stride;
#pragma unroll
        for (int ai = 0; ai < 2; ++ai)
#pragma unroll
            for (int m = 0; m < 4; ++m) {
                const int row = u.pm * 256 + ai * 128 + wr * 64 + m * 16 + fr - row0;
#pragma unroll
                for (int bj = 0; bj < 2; ++bj) {
                    float* d = base + (size_t)row * DM + u.pn * 256 + bj * 128 + wc * 32 + 8 * fq;
                    *(f32x4*)d = acc[ai][bj][m][0]; *(f32x4*)(d + 4) = acc[ai][bj][m][1];
                }
            }
    }
};
struct SplitOrder {
    int c, ns;
    __device__ bool next(int i, Unit& u) const { if (i > 0 || c >= 16 * ns) return false; const int tile = c / ns; u.pm = TP / 256 + (tile >> 3); u.pn = tile & 7; u.ks = c % ns; return true; }
    __device__ __forceinline__ void a_ready(const Unit&) const {}
    __device__ __forceinline__ void done(const Unit&) const {}
};
struct EpiScaleBf16 {
    static constexpr bool PERM = true, AFTER_DRAIN = false;
    bf16_t* O; int ldc; const float* SS; float scale;
    __device__ __forceinline__ void operator()(const f32x4 (&acc)[2][2][4][2], const Unit& u, int wr, int wc, int fr, int fq) const {
#pragma unroll
        for (int ai = 0; ai < 2; ++ai)
#pragma unroll
            for (int m = 0; m < 4; ++m) {
                const int row = u.pm * 256 + ai * 128 + wr * 64 + m * 16 + fr;
                const float s = row_rs(SS, row) * scale;
#pragma unroll
                for (int bj = 0; bj < 2; ++bj) {
                    const int c = u.pn * 256 + bj * 128 + wc * 32 + 8 * fq;
                    *(u32x4*)(O + (size_t)row * ldc + c) = pack8(acc[ai][bj][m][0] * s, acc[ai][bj][m][1] * s);
                }
            }
    }
};
struct EpiSwiGLU {
    static constexpr bool PERM = true, AFTER_DRAIN = false;
    bf16_t* HID; const float* SS;
    __device__ __forceinline__ void operator()(const f32x4 (&acc)[2][2][4][2], const Unit& u, int wr, int wc, int fr, int fq) const {
#pragma unroll
        for (int ai = 0; ai < 2; ++ai)
#pragma unroll
            for (int m = 0; m < 4; ++m) {
                const int row = u.pm * 256 + ai * 128 + wr * 64 + m * 16 + fr;
                const float s = row_rs(SS, row);
                f32x4 h0, h1;
#pragma unroll
                for (int j = 0; j < 4; ++j) {
                    const float g0 = acc[ai][0][m][0][j] * s, u0 = acc[ai][1][m][0][j] * s, g1 = acc[ai][0][m][1][j] * s, u1 = acc[ai][1][m][1][j] * s;
                    h0[j] = g0 * fsigmoid(g0) * u0; h1[j] = g1 * fsigmoid(g1) * u1;
                }
                *(u32x4*)(HID + (size_t)row * FF + u.pn * 128 + wc * 32 + 8 * fq) = pack8(h0, h1);
            }
    }
};

struct Frame {
    LAS unsigned char* lds;
    int tid, lane, wave, G, bid;
    const float* const* in;
    float* out; unsigned char* ws;
};
enum { I_XP = 0, I_XS, I_STATE, I_CSK, I_CSV, I_CMK, I_CMV, I_MEMP, I_NMIX, I_WIN, I_LB, I_ONORM, I_SINKS, I_RELB, I_WOUT, I_NXATT, I_NMEM,
       I_WMQ, I_WMK, I_WMV, I_WMO, I_NFFN, I_WGATE, I_WUP, I_WDOWN, I_NFINAL };

__device__ __forceinline__ void p0_tr_item(const float* __restrict__ W, int K, int N, bf16_t* WT, int k0, int n0, int drow0, const float* __restrict__ scale, LAS float* scr, int lane) {
#pragma unroll 8
    for (int i = 0; i < 32; ++i) { const int kk = 2 * i + (lane >> 5); float v = W[(size_t)(k0 + kk) * N + n0 + (lane & 31)]; if (scale) v *= scale[k0 + kk]; scr[kk * 33 + (lane & 31)] = v; }
    LDS_WAIT(); asm volatile("" ::: "memory");
    const int c = lane & 7;
#pragma unroll
    for (int j = 0; j < 4; ++j) { const int n = (lane >> 3) + 8 * j; const LAS float* s = scr + (8 * c) * 33 + n;
        u32x4 o; o.x = cvtpk(s[0 * 33], s[1 * 33]); o.y = cvtpk(s[2 * 33], s[3 * 33]); o.z = cvtpk(s[4 * 33], s[5 * 33]); o.w = cvtpk(s[6 * 33], s[7 * 33]);
        *(u32x4*)(WT + (size_t)(drow0 + n) * K + k0 + 8 * c) = o; }
    LDS_WAIT(); asm volatile("" ::: "memory");
}
__device__ __forceinline__ void p0_rms_row(const float* xrow, const float* w, bf16_t* orow, int lane) {
    const f32x4* xr = (const f32x4*)xrow + lane; const f32x4* wr = (const f32x4*)w + lane;
    f32x4 v[8]; float s = 0.f;
#pragma unroll
    for (int j = 0; j < 8; ++j) { v[j] = xr[64 * j]; s += (v[j][0] * v[j][0] + v[j][1] * v[j][1]) + (v[j][2] * v[j][2] + v[j][3] * v[j][3]); }
    const float rs = __builtin_amdgcn_rsqf(wave_sum(s) * (1.0f / DM) + RMS_EPS);
    u32x2* o8 = (u32x2*)orow + lane;
#pragma unroll
    for (int j = 0; j < 8; ++j) { const f32x4 ww = wr[64 * j]; f32x4 y; y[0] = v[j][0] * rs * ww[0]; y[1] = v[j][1] * rs * ww[1]; y[2] = v[j][2] * rs * ww[2]; y[3] = v[j][3] * rs * ww[3]; o8[64 * j] = pack4(y); }
}
__device__ __forceinline__ int rel_bucket(int n) {
    if (n < 16) return n;
    int b = 16 + (int)(__logf((float)n * (1.0f / 16.0f)) / 2.0794415416798357f * 16.0f);
    return b < 31 ? b : 31;
}
constexpr int CV_IN = 32 * (NIN / 32), CV_OUT = 32 * 64, CV_MQ = 32 * 16, CV_MO = 8 * 64, CV_G = 32 * (FF / 32), CV_DN = (FF / 64) * 64;
constexpr int CV_EARLY = CV_IN + CV_OUT + 3 * CV_MQ, CV_ALL = CV_EARLY + CV_MO + 2 * CV_G + CV_DN;
__device__ __forceinline__ void p0_convert(Frame& F, int it0, int it1, int gw, int NGW) {
    LAS float* scr = (LAS float*)(F.lds + F.wave * 16384);
    unsigned char* ws = F.ws;
    constexpr int I_IN = CV_IN, I_OUT = CV_OUT, I_MQ = CV_MQ, I_MO = CV_MO, I_G = CV_G;
    for (int it = it0 + gw; it < it1; it += NGW) {
        int r = it;
        if (r < I_IN) { const int nb = NIN / 32, kb = r / nb, n0 = (r % nb) * 32; p0_tr_item(F.in[I_WIN], DM, NIN, (bf16_t*)(ws + WS_WIN), kb * 64, n0, n0, nullptr, scr, F.lane); continue; } r -= I_IN;
        if (r < I_OUT) { const int kb = r / 64, n0 = (r % 64) * 32; p0_tr_item(F.in[I_WOUT], DM, DM, (bf16_t*)(ws + WS_WOUT), kb * 64, n0, n0, nullptr, scr, F.lane); continue; } r -= I_OUT;
        if (r < I_MQ) { const int kb = r / 16, n0 = (r % 16) * 32; p0_tr_item(F.in[I_WMQ], DM, MEMW, (bf16_t*)(ws + WS_WMQ), kb * 64, n0, n0, F.in[I_NXATT], scr, F.lane); continue; } r -= I_MQ;
        if (r < I_MQ) { const int kb = r / 16, n0 = (r % 16) * 32; p0_tr_item(F.in[I_WMK], DM, MEMW, (bf16_t*)(ws + WS_WMKV), kb * 64, n0, n0, nullptr, scr, F.lane); continue; } r -= I_MQ;
        if (r < I_MQ) { const int kb = r / 16, n0 = (r % 16) * 32; p0_tr_item(F.in[I_WMV], DM, MEMW, (bf16_t*)(ws + WS_WMKV), kb * 64, n0, 512 + n0, nullptr, scr, F.lane); continue; } r -= I_MQ;
        if (r < I_MO) { const int kb = r / 64, n0 = (r % 64) * 32; p0_tr_item(F.in[I_WMO], MEMW, DM, (bf16_t*)(ws + WS_WMO), kb * 64, n0, n0, nullptr, scr, F.lane); continue; } r -= I_MO;
        if (r < 2 * I_G) { const int up = r >= I_G; if (up) r -= I_G; const int nb = FF / 32, kb = r / nb, n0 = (r % nb) * 32;
            p0_tr_item(F.in[up ? I_WUP : I_WGATE], DM, FF, (bf16_t*)(ws + WS_WGU), kb * 64, n0, (n0 >> 7) * 256 + (n0 & 127) + (up ? 128 : 0), F.in[I_NFFN], scr, F.lane); continue; } r -= 2 * I_G;
        { const int kb = r / 64, n0 = (r % 64) * 32; p0_tr_item(F.in[I_WDOWN], FF, DM, (bf16_t*)(ws + WS_WDN), kb * 64, n0, n0, nullptr, scr, F.lane); }
    }
}
__device__ __forceinline__ void p0_prologue(Frame& F, bool all_weights) {
    const int gw = F.bid * NWAVES + F.wave, NGW = F.G * NWAVES;
    unsigned char* ws = F.ws;
    p0_convert(F, 0, all_weights ? CV_ALL : CV_EARLY, gw, NGW);
    for (int m = gw; m < TT + 1024; m += NGW) {
        if (m < TP) p0_rms_row(F.in[I_XP] + (size_t)m * DM, F.in[I_NMIX], (bf16_t*)(ws + WS_XB) + (size_t)m * DM, F.lane);
        else if (m < TT) p0_rms_row(F.in[I_XS] + (size_t)(m - TP) * DM, F.in[I_NMIX], (bf16_t*)(ws + WS_XB) + (size_t)m * DM, F.lane);
        else p0_rms_row(F.in[I_MEMP] + (size_t)(m - TT) * DM, F.in[I_NMEM], (bf16_t*)(ws + WS_MN) + (size_t)(m - TT) * DM, F.lane);
    }
    float* LBt = (float*)(ws + WS_TAB); float* BT = (float*)(ws + WS_TAB + 8192);
    const int gt = F.bid * NTHREADS + F.tid, NGT = F.G * NTHREADS;
    for (int i = gt; i < 1024 + 16 * 160; i += NGT) {
        if (i < 1024) { const float l0 = F.in[I_LB][i], l1 = F.in[I_LB][1024 + i]; LBt[i] = 1.0f / (1.0f + __expf(l1 - l0)); }
        else { const int j = i - 1024, h = j / 160, ix = j % 160, dist = 143 - ix;
            BT[j] = (dist >= 0 && dist < 128) ? F.in[I_RELB][rel_bucket(dist) * 16 + h] * LOG2E : -INFINITY; }
    }
}

constexpr int PREP_RS = 1032;
__device__ __forceinline__ void hgrn_prep(Frame& F) {
    unsigned char* ws = F.ws;
    const float* QF = F.out; const float* GF = F.out + (size_t)TT * 1024; const bf16_t* VB = (const bf16_t*)(F.out + O_SST);
    bf16_t* QIN = (bf16_t*)(ws + WS_QIN); bf16_t* KT = (bf16_t*)(ws + WS_KT); bf16_t* VT = (bf16_t*)(ws + WS_VT); bf16_t* PSC = (bf16_t*)(ws + WS_PSC); float* DEC = (float*)(ws + WS_DEC);
    LAS bf16_t* lq = (LAS bf16_t*)F.lds; LAS bf16_t* lk = lq + 16 * PREP_RS;
    const int l15 = F.lane & 15, g4 = F.lane >> 4;
    for (int ch = F.bid; ch < NCH; ch += F.G) {
        const int nv = ch < NCHP ? 16 : 4; const int row0 = ch < NCHP ? ch * 16 : TP + (ch - NCHP) * 4;
#pragma unroll 1
        for (int pass = 0; pass < 2; ++pass) {
            const int cidx = F.tid + 512 * pass;
            float g[16], q[16]; unsigned short vv[16];
#pragma unroll
            for (int t = 0; t < 16; ++t) {
                if (t < nv) { g[t] = GF[(size_t)(row0 + t) * 1024 + cidx]; q[t] = QF[(size_t)(row0 + t) * 1024 + cidx]; vv[t] = VB[(size_t)(row0 + t) * 1024 + cidx]; }
                else { g[t] = 0.f; q[t] = 0.f; vv[t] = 0; }
            }
            float G = 0.f; unsigned kd[8], vt[8];
#pragma unroll
            for (int t = 0; t < 16; t += 2) {
                float qi[2], kk[2];
#pragma unroll
                for (int z = 0; z < 2; ++z) {
                    const float gt = g[t + z]; G += gt;
                    qi[z] = q[t + z] * fexp(G);
                    kk[z] = (1.0f - fexp(gt)) * fexp(fminf(-G, 80.0f));
                    lq[(t + z) * PREP_RS + cidx] = f2bf(qi[z]); lk[(t + z) * PREP_RS + cidx] = f2bf(kk[z]);
                }
                kd[t >> 1] = cvtpk(kk[0], kk[1]); vt[t >> 1] = (unsigned)vv[t] | ((unsigned)vv[t + 1] << 16);
            }
            DEC[(size_t)ch * 1024 + cidx] = fexp(G);
            u32x4* kp = (u32x4*)(KT + ((size_t)ch * 1024 + cidx) * 16); kp[0] = (u32x4){kd[0], kd[1], kd[2], kd[3]}; kp[1] = (u32x4){kd[4], kd[5], kd[6], kd[7]};
            u32x4* vp = (u32x4*)(VT + ((size_t)ch * 1024 + cidx) * 16); vp[0] = (u32x4){vt[0], vt[1], vt[2], vt[3]}; vp[1] = (u32x4){vt[4], vt[5], vt[6], vt[7]};
        }
        __syncthreads();
#pragma unroll
        for (int i = 0; i < 4; ++i) { const int idx = F.tid + 512 * i, t = idx >> 7, c8 = idx & 127;
            *(u32x4*)(QIN + ((size_t)ch * 16 + t) * 1024 + c8 * 8) = *(const LAS u32x4*)(lq + t * PREP_RS + c8 * 8); }
        {
            const int h = F.wave; f32x4 acc = {0.f, 0.f, 0.f, 0.f};
#pragma unroll
            for (int kk = 0; kk < 4; ++kk) {
                const bf16x8 a = *(const LAS bf16x8*)(lq + l15 * PREP_RS + h * 128 + 32 * kk + 8 * g4);
                const bf16x8 b = *(const LAS bf16x8*)(lk + l15 * PREP_RS + h * 128 + 32 * kk + 8 * g4);
                acc = __builtin_amdgcn_mfma_f32_16x16x32_bf16(a, b, acc, 0, 0, 0);
            }
            bf16_t* pd = PSC + ((size_t)ch * 8 + h) * 256;
#pragma unroll
            for (int r = 0; r < 4; ++r) { const int t = 4 * g4 + r, s = l15; pd[t * 16 + s] = (s <= t) ? f2bf(acc[r]) : (bf16_t)0; }
        }
        __syncthreads();
    }
}

constexpr int SC_QS = 136;
constexpr int SC_QI = 0, SC_KT = 16 * SC_QS * 2, SC_VT = SC_KT + 4096, SC_P = SC_VT + 4096, SC_DEC = SC_P + 512, SC_GATE = SC_DEC + 512, SC_BUF = SC_GATE + 16 * SC_QS * 2;
constexpr int SC_RED = 2 * SC_BUF;
static_assert(SC_RED + 1024 <= LDS_BYTES && SC_BUF % 16 == 0, "scan LDS");
struct ScanPf { u32x4 a, b, c; };
struct ScanSrc { const unsigned char* a; const unsigned char* b; const unsigned char* c; unsigned oa, ob, oc; };
__device__ __forceinline__ ScanSrc scan_src(const Frame& F, int ch0, int h, int grow0, int ngr) {
    const unsigned char* ws = F.ws; const int tid = F.tid; ScanSrc s;
    const bf16_t* QIN = (const bf16_t*)(ws + WS_QIN); const bf16_t* KT = (const bf16_t*)(ws + WS_KT); const bf16_t* VT = (const bf16_t*)(ws + WS_VT);
    const bf16_t* PSC = (const bf16_t*)(ws + WS_PSC); const float* DEC = (const float*)(ws + WS_DEC); const bf16_t* GATE = (const bf16_t*)(ws + WS_GATE);
    if (tid < 256) { const int t = tid >> 4, p = tid & 15;
        s.a = (const unsigned char*)(QIN + ((size_t)ch0 * 16 + t) * 1024 + h * 128 + p * 8); s.oa = SC_QI + (t * SC_QS + p * 8) * 2;
        s.b = (const unsigned char*)(VT + ((size_t)ch0 * 1024 + h * 128) * 16 + tid * 8); s.ob = SC_VT + tid * 16;
    } else { const int i = tid - 256, t = i >> 4, p = i & 15; const int tr = t < ngr ? t : ngr - 1;
        s.a = (const unsigned char*)(KT + ((size_t)ch0 * 1024 + h * 128) * 16 + i * 8); s.oa = SC_KT + i * 16;
        s.b = (const unsigned char*)(GATE + (size_t)(grow0 + tr) * 1024 + h * 128 + p * 8); s.ob = SC_GATE + (t * SC_QS + p * 8) * 2;
    }
    if (tid < 32) { s.c = (const unsigned char*)(PSC + ((size_t)ch0 * 8 + h) * 256 + tid * 8); s.oc = SC_P + tid * 16; }
    else { const int i = (tid - 32) & 31; s.c = (const unsigned char*)(DEC + (size_t)ch0 * 1024 + h * 128 + i * 4); s.oc = SC_DEC + i * 16; }
    return s;
}
__device__ __forceinline__ void scan_fetch(ScanPf& pf, const ScanSrc& s, const Frame& F, int step) {
    pf.a = *(const u32x4*)(s.a + (size_t)step * 32768); pf.b = *(const u32x4*)(s.b + (size_t)step * 32768);
    if (F.tid < 64) pf.c = *(const u32x4*)(s.c + (size_t)step * 4096);
}
__device__ __forceinline__ void scan_stash(const ScanPf& pf, const ScanSrc& s, const Frame& F, int buf) {
    LAS unsigned char* B = F.lds + buf * SC_BUF;
    *(LAS u32x4*)(B + s.oa) = pf.a; *(LAS u32x4*)(B + s.ob) = pf.b;
    if (F.tid < 64) *(LAS u32x4*)(B + s.oc) = pf.c;
}
template <int CTRL> __device__ __forceinline__ float dpp_mov(float v) { return __int_as_float(__builtin_amdgcn_update_dpp(0, __float_as_int(v), CTRL, 0xF, 0xF, true)); }
__device__ __forceinline__ float row16_sum(float v) { v += dpp_mov<0xB1>(v); v += dpp_mov<0x4E>(v); v += dpp_mov<0x141>(v); v += dpp_mov<0x140>(v); return v; }
constexpr int SC_ST = SC_RED + 1024, SC_STS = 132;
static_assert(SC_ST + 128 * SC_STS * 4 <= LDS_BYTES, "scan LDS (state image)");
template <int DBG>
__device__ __forceinline__ void hgrn_scan_t(Frame& F, int ch0, int nsteps, int h, int mrow0, int nvalid, const float* S0, float* Sout, bf16_t* MIXP, int mixld, float* DBGP) {
    const int lane = F.lane, l15 = lane & 15, g4 = lane >> 4, e0 = 16 * F.wave;
    bf16_t* MIX = MIXP;
    const float onw = F.in[I_ONORM][e0 + l15];
    LAS float* RED = (LAS float*)(F.lds + SC_RED);
    LAS float* ST = (LAS float*)(F.lds + SC_ST);
    ScanPf pf;
    __syncthreads();
    const ScanSrc src = scan_src(F, ch0, h, mrow0, nvalid);
    scan_fetch(pf, src, F, 0); scan_stash(pf, src, F, 0);
    if (nsteps > 1) scan_fetch(pf, src, F, 1);
    f32x4 S[8];
    if (S0) {
#pragma unroll
        for (int i = 0; i < 8; ++i) { const int idx = F.tid + 512 * i, c = idx >> 5, e4 = idx & 31; *(LAS f32x4*)(ST + c * SC_STS + e4 * 4) = *(const f32x4*)(S0 + (size_t)c * 128 + e4 * 4); }
    }
    __syncthreads();
#pragma unroll
    for (int mt = 0; mt < 8; ++mt)
#pragma unroll
        for (int r = 0; r < 4; ++r) S[mt][r] = S0 ? ST[(16 * mt + 4 * g4 + r) * SC_STS + e0 + l15] : 0.f;
    f32x4 o_prev = {0.f, 0.f, 0.f, 0.f}, gate_prev = {0.f, 0.f, 0.f, 0.f};
#pragma unroll 1
    for (int n = 0; n <= nsteps; ++n) {
        const int buf = n & 1;
        f32x4 o = {0.f, 0.f, 0.f, 0.f}, gate = {0.f, 0.f, 0.f, 0.f};
        if (n + 1 < nsteps) {
            scan_stash(pf, src, F, buf ^ 1);
            if (n + 2 < nsteps) scan_fetch(pf, src, F, n + 2);
        }
        if (n < nsteps) {
            const LAS unsigned char* B = F.lds + buf * SC_BUF;
            const bf16x4 vt = *(const LAS bf16x4*)(B + SC_VT + ((e0 + l15) * 16 + 4 * g4) * 2);
            const bf16x4 pa = *(const LAS bf16x4*)(B + SC_P + (l15 * 16 + 4 * g4) * 2);
            const f32x4 zz = {0.f, 0.f, 0.f, 0.f};
            f32x4 oq[4];
            const f32x4 op = __builtin_amdgcn_mfma_f32_16x16x16bf16_1k(pa, vt, zz, 0, 0, 0);
#pragma unroll
            for (int kk = 0; kk < 4; ++kk) {
                const bf16x4 q0 = *(const LAS bf16x4*)(B + SC_QI + (l15 * SC_QS + 32 * kk + 4 * g4) * 2);
                const bf16x4 q1 = *(const LAS bf16x4*)(B + SC_QI + (l15 * SC_QS + 32 * kk + 16 + 4 * g4) * 2);
                const bf16x8 qa = {q0[0], q0[1], q0[2], q0[3], q1[0], q1[1], q1[2], q1[3]};
                const u32x4 sb = pack8(S[2 * kk], S[2 * kk + 1]);
                oq[kk] = __builtin_amdgcn_mfma_f32_16x16x32_bf16(qa, __builtin_bit_cast(bf16x8, sb), zz, 0, 0, 0);
            }
            o = (oq[0] + oq[2]) + op; const f32x4 ob = oq[1] + oq[3];
#pragma unroll
            for (int mt = 0; mt < 8; ++mt) {
                const bf16x4 kt = *(const LAS bf16x4*)(B + SC_KT + ((16 * mt + l15) * 16 + 4 * g4) * 2);
                const f32x4 dc = *(const LAS f32x4*)(B + SC_DEC + (16 * mt + 4 * g4) * 4);
                S[mt] = __builtin_amdgcn_mfma_f32_16x16x16bf16_1k(kt, vt, S[mt], 0, 0, 0);
                S[mt] = S[mt] * dc;
            }
            o = o + ob;
            if constexpr (DBG == 1) {
#pragma unroll
                for (int r = 0; r < 4; ++r) DBGP[(size_t)(mrow0 + 16 * n + 4 * g4 + r) * 1024 + h * 128 + e0 + l15] = o[r];
            }
#pragma unroll
            for (int r = 0; r < 4; ++r) {
                gate[r] = bf2f(*(const LAS unsigned short*)(B + SC_GATE + ((4 * g4 + r) * SC_QS + e0 + l15) * 2));
                const float ss = row16_sum(o[r] * o[r]);
                if (l15 == 0) RED[(buf * 8 + F.wave) * 16 + 4 * g4 + r] = ss;
            }
        }
        if (n > 0) {
            const int pb = (n - 1) & 1;
#pragma unroll
            for (int r = 0; r < 4; ++r) {
                const int t = 4 * g4 + r; float tot = 0.f;
#pragma unroll
                for (int w = 0; w < 8; ++w) tot += RED[(pb * 8 + w) * 16 + t];
                const float rs = __builtin_amdgcn_rsqf(tot * (1.0f / 128.0f) + RMS_EPS);
                if constexpr (DBG == 2) DBGP[(size_t)(mrow0 + 16 * (n - 1) + t) * 1024 + h * 128 + e0 + l15] = tot;
                if constexpr (DBG == 3) DBGP[(size_t)(mrow0 + 16 * (n - 1) + t) * 1024 + h * 128 + e0 + l15] = gate_prev[r];
                if constexpr (DBG == 4) DBGP[(size_t)(mrow0 + 16 * (n - 1) + t) * 1024 + h * 128 + e0 + l15] = o_prev[r];
                if (t < nvalid) MIX[(size_t)(mrow0 + 16 * (n - 1) + t) * mixld + h * 128 + e0 + l15] = f2bf(o_prev[r] * rs * onw * gate_prev[r]);
            }
        }
        o_prev = o; gate_prev = gate;
        __syncthreads();
    }
#pragma unroll
    for (int mt = 0; mt < 8; ++mt)
#pragma unroll
        for (int r = 0; r < 4; ++r) ST[(16 * mt + 4 * g4 + r) * SC_STS + e0 + l15] = S[mt][r];
    __syncthreads();
#pragma unroll
    for (int i = 0; i < 8; ++i) { const int idx = F.tid + 512 * i, c = idx >> 5, e4 = idx & 31; *(f32x4*)(Sout + (size_t)c * 128 + e4 * 4) = *(const LAS f32x4*)(ST + c * SC_STS + e4 * 4); }
}


template <int DBG>
__device__ __forceinline__ void hgrn_scan_pd_t(Frame& F, int ch0, int nsteps, int h, int mrow0, int nvalid, const float* S0, float* Sout, bf16_t* MIXP, int mixld, float* DBGP) {
    const int lane = F.lane, l15 = lane & 15, g4 = lane >> 4, e0 = 16 * F.wave;
    bf16_t* MIX = MIXP;
    const float onw = F.in[I_ONORM][e0 + l15];
    LAS float* RED = (LAS float*)(F.lds + SC_RED);
    LAS float* ST = (LAS float*)(F.lds + SC_ST);
    constexpr int PD = 2;
    ScanPf pf[PD];
    __syncthreads();
    const ScanSrc src = scan_src(F, ch0, h, mrow0, nvalid);
#pragma unroll
    for (int j = 0; j < PD; ++j) if (j < nsteps) scan_fetch(pf[j], src, F, j);
    scan_stash(pf[0], src, F, 0);
    if (PD < nsteps) scan_fetch(pf[0], src, F, PD);
    f32x4 S[8];
    if (S0) {
#pragma unroll
        for (int i = 0; i < 8; ++i) { const int idx = F.tid + 512 * i, c = idx >> 5, e4 = idx & 31; *(LAS f32x4*)(ST + c * SC_STS + e4 * 4) = *(const f32x4*)(S0 + (size_t)c * 128 + e4 * 4); }
    }
    __syncthreads();
#pragma unroll
    for (int mt = 0; mt < 8; ++mt)
#pragma unroll
        for (int r = 0; r < 4; ++r) S[mt][r] = S0 ? ST[(16 * mt + 4 * g4 + r) * SC_STS + e0 + l15] : 0.f;
    f32x4 o_prev = {0.f, 0.f, 0.f, 0.f}, gate_prev = {0.f, 0.f, 0.f, 0.f};
#pragma unroll 1
    for (int n = 0; n <= nsteps; ++n) {
        const int buf = n & 1;
        f32x4 o = {0.f, 0.f, 0.f, 0.f}, gate = {0.f, 0.f, 0.f, 0.f};
        if (n + 1 < nsteps) {
            const bool more = n + 1 + PD < nsteps;
            if (((n + 1) & 1) == 0) { scan_stash(pf[0], src, F, buf ^ 1); if (more) scan_fetch(pf[0], src, F, n + 1 + PD); }
            else { scan_stash(pf[1], src, F, buf ^ 1); if (more) scan_fetch(pf[1], src, F, n + 1 + PD); }
        }
        if (n < nsteps) {
            const LAS unsigned char* B = F.lds + buf * SC_BUF;
            const bf16x4 vt = *(const LAS bf16x4*)(B + SC_VT + ((e0 + l15) * 16 + 4 * g4) * 2);
            const bf16x4 pa = *(const LAS bf16x4*)(B + SC_P + (l15 * 16 + 4 * g4) * 2);
            f32x4 ob = {0.f, 0.f, 0.f, 0.f};
            o = __builtin_amdgcn_mfma_f32_16x16x16bf16_1k(pa, vt, o, 0, 0, 0);
#pragma unroll
            for (int kk = 0; kk < 4; ++kk) {
                const bf16x4 q0 = *(const LAS bf16x4*)(B + SC_QI + (l15 * SC_QS + 32 * kk + 4 * g4) * 2);
                const bf16x4 q1 = *(const LAS bf16x4*)(B + SC_QI + (l15 * SC_QS + 32 * kk + 16 + 4 * g4) * 2);
                const bf16x8 qa = {q0[0], q0[1], q0[2], q0[3], q1[0], q1[1], q1[2], q1[3]};
                const u32x4 sb = pack8(S[2 * kk], S[2 * kk + 1]);
                if (kk & 1) ob = __builtin_amdgcn_mfma_f32_16x16x32_bf16(qa, __builtin_bit_cast(bf16x8, sb), ob, 0, 0, 0);
                else o = __builtin_amdgcn_mfma_f32_16x16x32_bf16(qa, __builtin_bit_cast(bf16x8, sb), o, 0, 0, 0);
            }
#pragma unroll
            for (int mt = 0; mt < 8; ++mt) {
                const bf16x4 kt = *(const LAS bf16x4*)(B + SC_KT + ((16 * mt + l15) * 16 + 4 * g4) * 2);
                const f32x4 dc = *(const LAS f32x4*)(B + SC_DEC + (16 * mt + 4 * g4) * 4);
                S[mt] = __builtin_amdgcn_mfma_f32_16x16x16bf16_1k(kt, vt, S[mt], 0, 0, 0);
                S[mt] = S[mt] * dc;
            }
            o = o + ob;
            if constexpr (DBG == 1) {
#pragma unroll
                for (int r = 0; r < 4; ++r) DBGP[(size_t)(mrow0 + 16 * n + 4 * g4 + r) * 1024 + h * 128 + e0 + l15] = o[r];
            }
#pragma unroll
            for (int r = 0; r < 4; ++r) {
                gate[r] = bf2f(*(const LAS unsigned short*)(B + SC_GATE + ((4 * g4 + r) * SC_QS + e0 + l15) * 2));
                const float ss = row16_sum(o[r] * o[r]);
                if (l15 == 0) RED[(buf * 8 + F.wave) * 16 + 4 * g4 + r] = ss;
            }
        }
        if (n > 0) {
            const int pb = (n - 1) & 1;
#pragma unroll
            for (int r = 0; r < 4; ++r) {
                const int t = 4 * g4 + r; float tot = 0.f;
#pragma unroll
                for (int w = 0; w < 8; ++w) tot += RED[(pb * 8 + w) * 16 + t];
                const float rs = __builtin_amdgcn_rsqf(tot * (1.0f / 128.0f) + RMS_EPS);
                if constexpr (DBG == 2) DBGP[(size_t)(mrow0 + 16 * (n - 1) + t) * 1024 + h * 128 + e0 + l15] = tot;
                if constexpr (DBG == 3) DBGP[(size_t)(mrow0 + 16 * (n - 1) + t) * 1024 + h * 128 + e0 + l15] = gate_prev[r];
                if constexpr (DBG == 4) DBGP[(size_t)(mrow0 + 16 * (n - 1) + t) * 1024 + h * 128 + e0 + l15] = o_prev[r];
                if (t < nvalid) MIX[(size_t)(mrow0 + 16 * (n - 1) + t) * mixld + h * 128 + e0 + l15] = f2bf(o_prev[r] * rs * onw * gate_prev[r]);
            }
        }
        o_prev = o; gate_prev = gate;
        __syncthreads();
    }
#pragma unroll
    for (int mt = 0; mt < 8; ++mt)
#pragma unroll
        for (int r = 0; r < 4; ++r) ST[(16 * mt + 4 * g4 + r) * SC_STS + e0 + l15] = S[mt][r];
    __syncthreads();
#pragma unroll
    for (int i = 0; i < 8; ++i) { const int idx = F.tid + 512 * i, c = idx >> 5, e4 = idx & 31; *(f32x4*)(Sout + (size_t)c * 128 + e4 * 4) = *(const LAS f32x4*)(ST + c * SC_STS + e4 * 4); }
}


#ifndef HY_VFIN
#define HY_VFIN 1
#endif
#ifndef HY_VST
#define HY_VST 1
#endif
#ifndef HY_VPART
#define HY_VPART 15
#endif
#ifndef HY_VLDSW
#define HY_VLDSW 1
#endif
#ifndef HY_VISSUE
#define HY_VISSUE 1
#endif
#ifndef HY_VCOMP
#define HY_VCOMP 1
#endif
#ifndef HY_VWRITE
#define HY_VWRITE 1
#endif
constexpr int DS_QSB = 272, DS_SLOT = 18432, DS_R = 6;
constexpr int DS_RED = DS_R * DS_SLOT;
constexpr int DS_OUT = DS_RED + 1024;
constexpr int DS_ST = 0, DS_STS = 132;
static_assert(DS_OUT + 8192 <= LDS_BYTES - 64 && 128 * DS_STS * 4 <= DS_RED && DS_SLOT % 1024 == 0, "dma scan LDS");
#ifdef HY_NO_DMA
extern __shared__ __attribute__((aligned(16))) unsigned char lds_raw2[];
__device__ __forceinline__ void glds16(const void* gsrc, unsigned lds_dst) { u32x4 v = *(const u32x4*)gsrc; if (HY_VLDSW) *(LAS u32x4*)((LAS unsigned char*)lds_raw2 + lds_dst + 16 * (threadIdx.x & 63)) = v; else asm volatile("" :: "v"(v)); }
__device__ __forceinline__ void glds4(const void* gsrc, unsigned lds_dst) { unsigned v = *(const unsigned*)gsrc; if (HY_VLDSW) *(LAS unsigned*)((LAS unsigned char*)lds_raw2 + lds_dst + 4 * (threadIdx.x & 63)) = v; else asm volatile("" :: "v"(v)); }
#else
__device__ __forceinline__ void glds16(const void* gsrc, unsigned lds_dst) { unsigned keep;
    asm volatile("s_mov_b32 %0, m0\n\ts_mov_b32 m0, %2\n\ts_nop 0\n\tglobal_load_lds_dwordx4 %1, off\n\ts_mov_b32 m0, %0" : "=&s"(keep) : "v"(gsrc), "s"(lds_dst) : "memory"); }
__device__ __forceinline__ void glds4(const void* gsrc, unsigned lds_dst) { unsigned keep;
    asm volatile("s_mov_b32 %0, m0\n\ts_mov_b32 m0, %2\n\ts_nop 0\n\tglobal_load_lds_dword %1, off\n\ts_mov_b32 m0, %0" : "=&s"(keep) : "v"(gsrc), "s"(lds_dst) : "memory"); }
#endif
#ifdef HY_DSSYNC
#define DS_BAR() __syncthreads()
#else
#define DS_BAR() do { asm volatile("s_waitcnt lgkmcnt(0)" ::: "memory"); __builtin_amdgcn_s_barrier(); asm volatile("" ::: "memory"); } while (0)
#endif
template <int DBG>
__device__ __forceinline__ void hgrn_scan_dma_t(Frame& F, int ch0, int nsteps, int h, int mrow0, int nvalid, const float* S0, float* Sout, bf16_t* MIXP, int mixld, float* DBGP) {
    const int lane = F.lane, l15 = lane & 15, g4 = lane >> 4, e0 = 16 * F.wave, w = F.wave;
    const unsigned char* ws = F.ws;
    bf16_t* MIX = MIXP;
    const float onw = F.in[I_ONORM][e0 + l15];
    LAS float* RED = (LAS float*)(F.lds + DS_RED);
    LAS float* ST = (LAS float*)(F.lds + DS_ST);
    LAS bf16_t* OUTB = (LAS bf16_t*)(F.lds + DS_OUT);
    const int wq = w & 3;
    const unsigned char* sq = ws + WS_QIN + (((size_t)ch0 * 16 + 4 * wq) * 1024 + h * 128) * 2 + lane * 4;
    const unsigned char* sk = ws + WS_KT + (((size_t)ch0 * 1024 + h * 128) * 16 + (wq * 64 + lane) * 8) * 2;
    const unsigned char* sv = ws + WS_VT + (((size_t)ch0 * 1024 + h * 128) * 16 + (wq * 64 + lane) * 8) * 2;
    const unsigned char* sg = ws + WS_GATE + ((size_t)mrow0 * 1024 + h * 128) * 2 + lane * 4;
    const unsigned char* sc = lane < 32 ? ws + WS_PSC + (((size_t)ch0 * 8 + h) * 256 + lane * 8) * 2 : ws + WS_DEC + ((size_t)ch0 * 1024 + h * 128 + (lane - 32) * 4) * 4;
    int grow[4];
#pragma unroll
    for (int r = 0; r < 4; ++r) { const int t = 4 * wq + r; grow[r] = (t < nvalid ? t : nvalid - 1) * 2048; }
#ifdef HY_NO_DMA
    const unsigned ring0 = 0u;
#else
    const unsigned ring0 = (unsigned)(uintptr_t)F.lds;
#endif
#define DS_ISSUE(step, slot) do { if (w < 4) { const unsigned so_ = ring0 + (unsigned)__builtin_amdgcn_readfirstlane((int)((slot) * DS_SLOT)); const size_t go_ = (size_t)(step) * 32768; \
        if (HY_VPART & 1) { _Pragma("unroll") for (int r_ = 0; r_ < 4; ++r_) glds4(sq + go_ + r_ * 2048, so_ + SC_QI + (4 * wq + r_) * DS_QSB); } \
        if (HY_VPART & 2) { glds16(sk + go_, so_ + SC_KT + wq * 1024); glds16(sv + go_, so_ + SC_VT + wq * 1024); } \
        if (HY_VPART & 4) { _Pragma("unroll") for (int r_ = 0; r_ < 4; ++r_) glds4(sg + go_ + grow[r_], so_ + SC_GATE + (4 * wq + r_) * DS_QSB); } \
        if ((HY_VPART & 8) && w == 0) glds16(sc + (size_t)(step) * 4096, so_ + SC_P); } } while (0)
    __syncthreads();
    f32x4 S[8];
    if (S0) {
#pragma unroll
        for (int i = 0; i < 8; ++i) { const int idx = F.tid + 512 * i, c = idx >> 5, e4 = idx & 31; *(LAS f32x4*)(ST + c * DS_STS + e4 * 4) = *(const f32x4*)(S0 + (size_t)c * 128 + e4 * 4); }
        __syncthreads();
#pragma unroll
        for (int mt = 0; mt < 8; ++mt)
#pragma unroll
            for (int r = 0; r < 4; ++r) S[mt][r] = ST[(16 * mt + 4 * g4 + r) * DS_STS + e0 + l15];
        __syncthreads();
    } else {
#pragma unroll
        for (int mt = 0; mt < 8; ++mt) S[mt] = (f32x4){0.f, 0.f, 0.f, 0.f};
    }
    if (HY_VISSUE) for (int s = 0; s < DS_R - 1 && s < nsteps; ++s) DS_ISSUE(s, s);
    f32x4 o_prev = {0.f, 0.f, 0.f, 0.f}, gate_prev = {0.f, 0.f, 0.f, 0.f};
    int slot = 0;
#pragma unroll 1
    for (int n = 0; n <= nsteps + 1; ++n) {
        if (w < 4) {
#ifndef HY_DRAIN
            if (n >= DS_R && n + DS_R <= nsteps + 1) { if (w == 0) asm volatile("s_waitcnt vmcnt(44)" ::: "memory"); else asm volatile("s_waitcnt vmcnt(40)" ::: "memory"); }
            else
#endif
            asm volatile("s_waitcnt vmcnt(0)" ::: "memory");
        }
        static_assert(DS_R == 6, "the counted waits above are (DS_R - 2) * 11 and (DS_R - 2) * 10");
        DS_BAR();
        if (HY_VISSUE && n - 1 + DS_R < nsteps) { const int ps = slot == 0 ? DS_R - 1 : slot - 1; DS_ISSUE(n - 1 + DS_R, ps); }
        const int buf = n & 1;
        f32x4 o = {0.f, 0.f, 0.f, 0.f}, gate = {0.f, 0.f, 0.f, 0.f};
        if (HY_VCOMP && n < nsteps) {
            const LAS unsigned char* B = F.lds + slot * DS_SLOT;
            const bf16x4 vt = *(const LAS bf16x4*)(B + SC_VT + ((e0 + l15) * 16 + 4 * g4) * 2);
            const bf16x4 pa = *(const LAS bf16x4*)(B + SC_P + (l15 * 16 + 4 * g4) * 2);
            const f32x4 zz = {0.f, 0.f, 0.f, 0.f};
            f32x4 oq[4];
            const f32x4 op = __builtin_amdgcn_mfma_f32_16x16x16bf16_1k(pa, vt, zz, 0, 0, 0);
#pragma unroll
            for (int kk = 0; kk < 4; ++kk) {
                const bf16x4 q0 = *(const LAS bf16x4*)(B + SC_QI + l15 * DS_QSB + (32 * kk + 4 * g4) * 2);
                const bf16x4 q1 = *(const LAS bf16x4*)(B + SC_QI + l15 * DS_QSB + (32 * kk + 16 + 4 * g4) * 2);
                const bf16x8 qa = {q0[0], q0[1], q0[2], q0[3], q1[0], q1[1], q1[2], q1[3]};
                const u32x4 sb8 = pack8(S[2 * kk], S[2 * kk + 1]);
                oq[kk] = __builtin_amdgcn_mfma_f32_16x16x32_bf16(qa, __builtin_bit_cast(bf16x8, sb8), zz, 0, 0, 0);
            }
            o = (oq[0] + oq[2]) + op; const f32x4 ob = oq[1] + oq[3];
#pragma unroll
            for (int mt = 0; mt < 8; ++mt) {
                const bf16x4 kt = *(const LAS bf16x4*)(B + SC_KT + ((16 * mt + l15) * 16 + 4 * g4) * 2);
                const f32x4 dc4 = *(const LAS f32x4*)(B + SC_DEC + (16 * mt + 4 * g4) * 4);
                S[mt] = __builtin_amdgcn_mfma_f32_16x16x16bf16_1k(kt, vt, S[mt], 0, 0, 0);
                S[mt] = S[mt] * dc4;
            }
            o = o + ob;
            if constexpr (DBG == 1) {
#pragma unroll
                for (int r = 0; r < 4; ++r) DBGP[(size_t)(mrow0 + 16 * n + 4 * g4 + r) * 1024 + h * 128 + e0 + l15] = o[r];
            }
#pragma unroll
            for (int r = 0; r < 4; ++r) {
                const int t = 4 * g4 + r;
                gate[r] = bf2f(*(const LAS unsigned short*)(B + SC_GATE + t * DS_QSB + (e0 + l15) * 2));
                const float ss = row16_sum(o[r] * o[r]);
                if (l15 == 0) RED[(buf * 8 + w) * 16 + t] = ss;
            }
        }
        if (HY_VFIN && n > 0 && n <= nsteps) {
            const int pb = buf ^ 1;
#pragma unroll
            for (int r = 0; r < 4; ++r) {
                const int t = 4 * g4 + r; float tot = 0.f;
#pragma unroll
                for (int ww = 0; ww < 8; ++ww) tot += RED[(pb * 8 + ww) * 16 + t];
                const float rs = __builtin_amdgcn_rsqf(tot * (1.0f / 128.0f) + RMS_EPS);
                if constexpr (DBG == 2) DBGP[(size_t)(mrow0 + 16 * (n - 1) + t) * 1024 + h * 128 + e0 + l15] = tot;
                if constexpr (DBG == 3) DBGP[(size_t)(mrow0 + 16 * (n - 1) + t) * 1024 + h * 128 + e0 + l15] = gate_prev[r];
                if constexpr (DBG == 4) DBGP[(size_t)(mrow0 + 16 * (n - 1) + t) * 1024 + h * 128 + e0 + l15] = o_prev[r];
                OUTB[(buf * 16 + t) * 128 + e0 + l15] = f2bf(o_prev[r] * rs * onw * gate_prev[r]);
            }
        }
        if (n > 1 && w >= 4) {
            const int i = (w - 4) * 64 + lane, t = i >> 4, p = i & 15;
            if (HY_VWRITE && t < nvalid) *(u32x4*)(MIX + (size_t)(mrow0 + 16 * (n - 2) + t) * mixld + h * 128 + p * 8) = *(const LAS u32x4*)(OUTB + ((buf ^ 1) * 16 + t) * 128 + p * 8);
        }
        o_prev = o; gate_prev = gate;
        slot = slot == DS_R - 1 ? 0 : slot + 1;
    }
    asm volatile("s_waitcnt vmcnt(0)" ::: "memory");
    __syncthreads();
    if (HY_VST) {
#pragma unroll
    for (int mt = 0; mt < 8; ++mt)
#pragma unroll
        for (int r = 0; r < 4; ++r) ST[(16 * mt + 4 * g4 + r) * DS_STS + e0 + l15] = S[mt][r];
    }
    __syncthreads();
    if (HY_VWRITE)
#pragma unroll
    for (int i = 0; i < 8; ++i) { const int idx = F.tid + 512 * i, c = idx >> 5, e4 = idx & 31; *(f32x4*)(Sout + (size_t)c * 128 + e4 * 4) = *(const LAS f32x4*)(ST + c * DS_STS + e4 * 4); }
#undef DS_ISSUE
}

__device__ __forceinline__ void hgrn_scan_dma(Frame& F, int ch0, int nsteps, int h, int mrow0, int nvalid, const float* S0, float* Sout) {
    hgrn_scan_dma_t<0>(F, ch0, nsteps, h, mrow0, nvalid, S0, Sout, (bf16_t*)(F.ws + WS_MIX), DM, nullptr);
}
__device__ __forceinline__ void hgrn_scan(Frame& F, int ch0, int nsteps, int h, int mrow0, int nvalid, const float* S0, float* Sout) {
    hgrn_scan_t<0>(F, ch0, nsteps, h, mrow0, nvalid, S0, Sout, (bf16_t*)(F.ws + WS_MIX), DM, nullptr);
}

constexpr int SW_KS = 72, SW_VS = 264;
constexpr int SW_K = 0, SW_V = 256 * SW_KS * 2, SW_BT = SW_V + 64 * SW_VS * 2, SW_END = SW_BT + 8 * 160 * 4;
static_assert(SW_END <= LDS_BYTES, "swa LDS");
__device__ __forceinline__ void swa_qtile(Frame& F, int j, int h, size_t qrow, bool qvalid, bool first_block, float sink2) {
    const int lane = F.lane, l15 = lane & 15, g4 = lane >> 4;
    const bf16_t* SQ = (const bf16_t*)(F.ws + WS_SQ); bf16_t* MIX = (bf16_t*)(F.ws + WS_MIX);
    const LAS bf16_t* Kb = (const LAS bf16_t*)(F.lds + SW_K); const LAS bf16_t* Vt = (const LAS bf16_t*)(F.lds + SW_V);
    const LAS float* BT = (const LAS float*)(F.lds + SW_BT) + F.wave * 160;
    bf16x8 qf[2];
#pragma unroll
    for (int kk = 0; kk < 2; ++kk) qf[kk] = *(const bf16x8*)(SQ + qrow * 1024 + h * 64 + 32 * kk + 8 * g4);
    f32x4 s[9]; float mx = sink2;
    const int bidx = 15 + 4 * g4 - l15;
#pragma unroll
    for (int u = 0; u < 9; ++u) {
        const int mt = j + u; f32x4 acc = {0.f, 0.f, 0.f, 0.f};
#pragma unroll
        for (int kk = 0; kk < 2; ++kk) {
            const bf16x8 a = *(const LAS bf16x8*)(Kb + (16 * mt + l15) * SW_KS + 32 * kk + 8 * g4);
            acc = __builtin_amdgcn_mfma_f32_16x16x32_bf16(a, qf[kk], acc, 0, 0, 0);
        }
        const bool dead = first_block && (mt < 8);
#pragma unroll
        for (int r = 0; r < 4; ++r) { float v = acc[r] + BT[bidx + 16 * u + r]; v = dead ? -INFINITY : v; s[u][r] = v; mx = fmaxf(mx, v); }
    }
    mx = fmaxf(mx, __shfl_xor(mx, 16)); mx = fmaxf(mx, __shfl_xor(mx, 32));
    float sum = 0.f; bf16x4 pb[9];
#pragma unroll
    for (int u = 0; u < 9; ++u) {
        f32x4 p;
#pragma unroll
        for (int r = 0; r < 4; ++r) { p[r] = __builtin_amdgcn_exp2f(s[u][r] - mx); sum += p[r]; }
        pb[u] = __builtin_bit_cast(bf16x4, pack4(p));
    }
    sum += __shfl_xor(sum, 16); sum += __shfl_xor(sum, 32);
    sum += __builtin_amdgcn_exp2f(sink2 - mx);
    const float inv = 1.0f / sum;
#pragma unroll
    for (int dt = 0; dt < 4; ++dt) {
        f32x4 o = {0.f, 0.f, 0.f, 0.f};
#pragma unroll
        for (int u = 0; u < 9; ++u) {
            const bf16x4 a = *(const LAS bf16x4*)(Vt + (16 * dt + l15) * SW_VS + 16 * (j + u) + 4 * g4);
            o = __builtin_amdgcn_mfma_f32_16x16x16bf16_1k(a, pb[u], o, 0, 0, 0);
        }
        if (qvalid) *(u32x2*)(MIX + qrow * DM + 1024 + h * 64 + 16 * dt + 4 * g4) = pack4(o * inv);
    }
}
__device__ __forceinline__ void swa_load_tables(Frame& F, int k) {
    const float* BTg = (const float*)(F.ws + WS_TAB + 8192); LAS float* BT = (LAS float*)(F.lds + SW_BT);
    for (int i = F.tid; i < 8 * 160; i += NTHREADS) BT[i] = BTg[k * 8 * 160 + i];
}
__device__ __forceinline__ void swa_prompt_unit(Frame& F, int unit) {
    const int k = unit & 1, n = (unit >> 1) & 31, b = unit >> 6;
    const bf16_t* SKV = (const bf16_t*)(F.ws + WS_SKV);
    LAS bf16_t* Kb = (LAS bf16_t*)(F.lds + SW_K); LAS bf16_t* Vt = (LAS bf16_t*)(F.lds + SW_V);
    __syncthreads();
    swa_load_tables(F, k);
#pragma unroll
    for (int i = 0; i < 4; ++i) {
        const int idx = F.tid + 512 * i, kj = idx >> 3, p = idx & 7, pos = 128 * (n - 1) + kj;
        u32x4 kv = {0u, 0u, 0u, 0u}, vv = {0u, 0u, 0u, 0u};
        if (pos >= 0) { const bf16_t* src = SKV + (size_t)(b * SEQ + pos) * 256 + k * 64 + p * 8; kv = *(const u32x4*)src; vv = *(const u32x4*)(src + 128); }
        *(LAS u32x4*)(Kb + kj * SW_KS + p * 8) = kv;
        const unsigned w[4] = {vv.x, vv.y, vv.z, vv.w};
#pragma unroll
        for (int e = 0; e < 4; ++e) { Vt[(8 * p + 2 * e) * SW_VS + kj] = (bf16_t)(w[e] & 0xffffu); Vt[(8 * p + 2 * e + 1) * SW_VS + kj] = (bf16_t)(w[e] >> 16); }
    }
    __syncthreads();
    const int h = k * 8 + F.wave; const float sink2 = F.in[I_SINKS][h] * LOG2E;
#pragma unroll 1
    for (int j = 0; j < 8; ++j) swa_qtile(F, j, h, (size_t)(b * SEQ + 128 * n + 16 * j + (F.lane & 15)), true, n == 0, sink2);
}
__device__ __forceinline__ void swa_sample_unit(Frame& F, int unit) {
    const int k = unit & 1, b = unit >> 1;
    const bf16_t* SKV = (const bf16_t*)(F.ws + WS_SKV);
    LAS bf16_t* Kb = (LAS bf16_t*)(F.lds + SW_K); LAS bf16_t* Vt = (LAS bf16_t*)(F.lds + SW_V);
    __syncthreads();
    swa_load_tables(F, k);
#pragma unroll
    for (int i = 0; i < 4; ++i) {
        const int idx = F.tid + 512 * i, kj = idx >> 4, p = idx & 15;
        const size_t so = ((size_t)(b * 128 + kj) * 2 + k) * 64 + p * 4;
        const f32x4 kv = *(const f32x4*)(F.in[I_CSK] + so), vv = *(const f32x4*)(F.in[I_CSV] + so);
        *(LAS u32x2*)(Kb + kj * SW_KS + p * 4) = pack4(kv);
#pragma unroll
        for (int e = 0; e < 4; ++e) Vt[(4 * p + e) * SW_VS + kj] = f2bf(vv[e]);
        if (kj >= 4) { const size_t dof = ((size_t)(b * 128 + kj - 4) * 2 + k) * 64 + p * 4; *(f32x4*)(F.out + O_SSK + dof) = kv; *(f32x4*)(F.out + O_SSV + dof) = vv; }
    }
    if (F.tid < 128) {
        const int kj = 128 + (F.tid >> 3), p = F.tid & 7;
        u32x4 kv = {0u, 0u, 0u, 0u}, vv = {0u, 0u, 0u, 0u};
        if (kj < 132) { const bf16_t* src = SKV + (size_t)(TP + 4 * b + (kj - 128)) * 256 + k * 64 + p * 8; kv = *(const u32x4*)src; vv = *(const u32x4*)(src + 128); }
        *(LAS u32x4*)(Kb + kj * SW_KS + p * 8) = kv;
        const unsigned w[4] = {vv.x, vv.y, vv.z, vv.w};
#pragma unroll
        for (int e = 0; e < 4; ++e) { Vt[(8 * p + 2 * e) * SW_VS + kj] = (bf16_t)(w[e] & 0xffffu); Vt[(8 * p + 2 * e + 1) * SW_VS + kj] = (bf16_t)(w[e] >> 16); }
    }
    __syncthreads();
    const int h = k * 8 + F.wave, l15 = F.lane & 15; const float sink2 = F.in[I_SINKS][h] * LOG2E;
    swa_qtile(F, 0, h, (size_t)(TP + 4 * b + (l15 < 4 ? l15 : 3)), l15 < 4, false, sink2);
}

constexpr int MA_KS = 136, MA_VS = 264;
constexpr int MA_K = 0, MA_V = 256 * MA_KS * 2, MA_END = MA_V + 128 * MA_VS * 2;
static_assert(MA_END <= LDS_BYTES, "memattn LDS");
__device__ __forceinline__ void memattn_prompt_unit(Frame& F, int unit) {
    const int h = unit & 3, pm = unit >> 2, b = pm >> 4;
    const bf16_t* MK = (const bf16_t*)(F.ws + WS_MK); const bf16_t* MVT = (const bf16_t*)(F.ws + WS_MVT);
    const bf16_t* QM = (const bf16_t*)(F.ws + WS_QM); bf16_t* OM = (bf16_t*)(F.ws + WS_OM);
    LAS bf16_t* Kh = (LAS bf16_t*)(F.lds + MA_K); LAS bf16_t* Vt = (LAS bf16_t*)(F.lds + MA_V);
    const int lane = F.lane, l15 = lane & 15, g4 = lane >> 4;
    __syncthreads();
#pragma unroll
    for (int i = 0; i < 8; ++i) {
        const int idx = F.tid + 512 * i;
        { const int m = idx >> 4, p = idx & 15; *(LAS u32x4*)(Kh + m * MA_KS + p * 8) = *(const u32x4*)(MK + (size_t)(b * 256 + m) * 512 + h * 128 + p * 8); }
        { const int d = idx >> 5, p = idx & 31; *(LAS u32x4*)(Vt + d * MA_VS + p * 8) = *(const u32x4*)(MVT + ((size_t)(b * 4 + h) * 128 + d) * 256 + p * 8); }
    }
    __syncthreads();
#pragma unroll 1
    for (int jj = 0; jj < 2; ++jj) {
        const size_t row = (size_t)pm * 256 + 16 * (2 * F.wave + jj) + l15;
        bf16x8 qf[4];
#pragma unroll
        for (int kk = 0; kk < 4; ++kk) qf[kk] = *(const bf16x8*)(QM + row * 512 + h * 128 + 32 * kk + 8 * g4);
        f32x4 s[16]; float mx = -INFINITY;
#pragma unroll
        for (int mt = 0; mt < 16; ++mt) {
            f32x4 acc = {0.f, 0.f, 0.f, 0.f};
#pragma unroll
            for (int kk = 0; kk < 4; ++kk) {
                const bf16x8 a = *(const LAS bf16x8*)(Kh + (16 * mt + l15) * MA_KS + 32 * kk + 8 * g4);
                acc = __builtin_amdgcn_mfma_f32_16x16x32_bf16(a, qf[kk], acc, 0, 0, 0);
            }
            s[mt] = acc; mx = fmaxf(fmaxf(mx, fmaxf(acc[0], acc[1])), fmaxf(acc[2], acc[3]));
            __builtin_amdgcn_sched_barrier(0);
        }
        mx = fmaxf(mx, __shfl_xor(mx, 16)); mx = fmaxf(mx, __shfl_xor(mx, 32));
        float sum = 0.f; bf16x8 pb[8];
#pragma unroll
        for (int i = 0; i < 8; ++i) {
            f32x4 p0, p1;
#pragma unroll
            for (int r = 0; r < 4; ++r) { p0[r] = __builtin_amdgcn_exp2f(s[2 * i][r] - mx); p1[r] = __builtin_amdgcn_exp2f(s[2 * i + 1][r] - mx); sum += p0[r] + p1[r]; }
            pb[i] = __builtin_bit_cast(bf16x8, pack8(p0, p1));
        }
        sum += __shfl_xor(sum, 16); sum += __shfl_xor(sum, 32);
        const float inv = 1.0f / sum;
#pragma unroll
        for (int dt = 0; dt < 8; ++dt) {
            f32x4 o = {0.f, 0.f, 0.f, 0.f};
#pragma unroll
            for (int i = 0; i < 8; ++i) {
                const bf16x4 a0 = *(const LAS bf16x4*)(Vt + (16 * dt + l15) * MA_VS + 32 * i + 4 * g4);
                const bf16x4 a1 = *(const LAS bf16x4*)(Vt + (16 * dt + l15) * MA_VS + 32 * i + 16 + 4 * g4);
                const bf16x8 a = {a0[0], a0[1], a0[2], a0[3], a1[0], a1[1], a1[2], a1[3]};
                o = __builtin_amdgcn_mfma_f32_16x16x32_bf16(a, pb[i], o, 0, 0, 0);
            }
            *(u32x2*)(OM + row * 512 + h * 128 + 16 * dt + 4 * g4) = pack4(o * inv);
            __builtin_amdgcn_sched_barrier(0);
        }
    }
}
constexpr int MSP_P = 0, MSP_O = 8192, MSP_ML = 8192 + 16384;
__device__ __forceinline__ void memattn_sample_block(Frame& F, int task) {
    const int hp = task & 1, b = task >> 1, w = F.wave, h = 2 * hp + (w >> 2), kq = w & 3;
    const float* CK = F.in[I_CMK] + ((size_t)b * 256 + 64 * kq) * 512 + h * 128; const float* CV = F.in[I_CMV] + ((size_t)b * 256 + 64 * kq) * 512 + h * 128;
    const bf16_t* QM = (const bf16_t*)(F.ws + WS_QM); bf16_t* OM = (bf16_t*)(F.ws + WS_OM);
    const int lane = F.lane, l15 = lane & 15, g4 = lane >> 4;
    LAS float* pl = (LAS float*)(F.lds + MSP_P) + w * 256; LAS float* po = (LAS float*)(F.lds + MSP_O) + w * 512; LAS float* ml = (LAS float*)(F.lds + MSP_ML);
    __syncthreads();
    bf16x8 qf[4];
#pragma unroll
    for (int kk = 0; kk < 4; ++kk) { qf[kk] = *(const bf16x8*)(QM + (size_t)(TP + 4 * b + (l15 & 3)) * 512 + h * 128 + 32 * kk + 8 * g4); if (l15 >= 4) qf[kk] = (bf16x8){0, 0, 0, 0, 0, 0, 0, 0}; }
    f32x4 s[4]; float mx = -INFINITY;
#pragma unroll
    for (int mt = 0; mt < 4; ++mt) {
        f32x4 acc = {0.f, 0.f, 0.f, 0.f};
#pragma unroll
        for (int kk = 0; kk < 4; ++kk) {
            const float* kp = CK + (size_t)(16 * mt + l15) * 512 + 32 * kk + 8 * g4;
            const u32x4 a = pack8(*(const f32x4*)kp, *(const f32x4*)(kp + 4));
            acc = __builtin_amdgcn_mfma_f32_16x16x32_bf16(__builtin_bit_cast(bf16x8, a), qf[kk], acc, 0, 0, 0);
        }
        s[mt] = acc; mx = fmaxf(fmaxf(mx, fmaxf(acc[0], acc[1])), fmaxf(acc[2], acc[3]));
    }
    mx = fmaxf(mx, __shfl_xor(mx, 16)); mx = fmaxf(mx, __shfl_xor(mx, 32));
    float sum = 0.f;
#pragma unroll
    for (int mt = 0; mt < 4; ++mt)
#pragma unroll
        for (int r = 0; r < 4; ++r) { const float p = __builtin_amdgcn_exp2f(s[mt][r] - mx); sum += p; if (l15 < 4) pl[(16 * mt + 4 * g4 + r) * 4 + l15] = p; }
    sum += __shfl_xor(sum, 16); sum += __shfl_xor(sum, 32);
    if (lane < 4) { ml[w * 8 + lane] = mx; ml[w * 8 + 4 + lane] = sum; }
    LDS_WAIT(); asm volatile("" ::: "memory");
    f32x2 o[4] = {{0.f, 0.f}, {0.f, 0.f}, {0.f, 0.f}, {0.f, 0.f}};
#pragma unroll 16
    for (int m = 0; m < 64; ++m) {
        const f32x2 v = *(const f32x2*)(CV + (size_t)m * 512 + 2 * lane);
        const f32x4 p = *(const LAS f32x4*)(pl + m * 4);
#pragma unroll
        for (int t = 0; t < 4; ++t) { o[t][0] += p[t] * v[0]; o[t][1] += p[t] * v[1]; }
    }
#pragma unroll
    for (int t = 0; t < 4; ++t) *(LAS f32x2*)(po + t * 128 + 2 * lane) = o[t];
    __syncthreads();
    {
        const int hh = F.tid >> 8, t = (F.tid >> 6) & 3, d = 2 * (F.tid & 63);
        float mq[4], M = -INFINITY;
#pragma unroll
        for (int q = 0; q < 4; ++q) { mq[q] = ml[(hh * 4 + q) * 8 + t]; M = fmaxf(M, mq[q]); }
        float den = 0.f; f32x2 num = {0.f, 0.f};
#pragma unroll
        for (int q = 0; q < 4; ++q) { const float f = __builtin_amdgcn_exp2f(mq[q] - M); den += f * ml[(hh * 4 + q) * 8 + 4 + t];
            const f32x2 oq = *(const LAS f32x2*)((LAS float*)(F.lds + MSP_O) + (hh * 4 + q) * 512 + t * 128 + d); num[0] += f * oq[0]; num[1] += f * oq[1]; }
        const float inv = 1.0f / den;
        *(unsigned*)(OM + (size_t)(TP + 4 * b + t) * 512 + (2 * hp + hh) * 128 + d) = cvtpk(num[0] * inv, num[1] * inv);
    }
}

__device__ __forceinline__ void final_norm_row_slabs(float* xrow, const float* slab_row, size_t slab_stride, int ns, const float* w, int lane) {
    f32x4* xr = (f32x4*)xrow + lane; const f32x4* wr = (const f32x4*)w + lane;
    f32x4 v[8]; float s = 0.f;
#pragma unroll
    for (int j = 0; j < 8; ++j) v[j] = xr[64 * j];
    for (int k = 0; k < ns; ++k) { const f32x4* sr = (const f32x4*)(slab_row + (size_t)k * slab_stride) + lane;
#pragma unroll
        for (int j = 0; j < 8; ++j) v[j] += sr[64 * j]; }
#pragma unroll
    for (int j = 0; j < 8; ++j) s += (v[j][0] * v[j][0] + v[j][1] * v[j][1]) + (v[j][2] * v[j][2] + v[j][3] * v[j][3]);
    const float rs = __builtin_amdgcn_rsqf(wave_sum(s) * (1.0f / DM) + RMS_EPS);
#pragma unroll
    for (int j = 0; j < 8; ++j) { const f32x4 ww = wr[64 * j]; f32x4 y; y[0] = v[j][0] * rs * ww[0]; y[1] = v[j][1] * rs * ww[1]; y[2] = v[j][2] * rs * ww[2]; y[3] = v[j][3] * rs * ww[3]; xr[64 * j] = y; }
}
__device__ __forceinline__ void final_norm_row(float* xrow, const float* SS, int row, const float* w, int lane) {
    const float rs = row_rs(SS, row);
    f32x4* xr = (f32x4*)xrow + lane; const f32x4* wr = (const f32x4*)w + lane;
#pragma unroll
    for (int j = 0; j < 8; ++j) { f32x4 v = xr[64 * j]; const f32x4 ww = wr[64 * j]; v[0] = v[0] * rs * ww[0]; v[1] = v[1] * rs * ww[1]; v[2] = v[2] * rs * ww[2]; v[3] = v[3] * rs * ww[3]; xr[64 * j] = v; }
}

#ifndef HGRN_SCAN_PROMPT
#define HGRN_SCAN_PROMPT hgrn_scan_dma
#endif
#define HGRN_SCAN_SAMPLE hgrn_scan
#ifdef HY_P3DELAY
#define P3_DELAY do { for (int z_ = 0; z_ < 16; ++z_) __builtin_amdgcn_s_sleep(127); __syncthreads(); } while (0)
#else
#define P3_DELAY do {} while (0)
#endif
#define XB_TMO      128
#define XB_XCNT(j)  (256  + 64 * (j))
#define XB_XSUB(j)  (1280 + 64 * (j))
#define XB_XGEN(j)  (2304 + 64 * (j))
#define XB_TOP      3328
#define XB_TOPGEN   3392
#define XCD_BAR_WORDS 3456
#define XB_SPIN_CAP (1u << 18)

__device__ __forceinline__ unsigned xb_ld(unsigned* p)              { return __hip_atomic_load(p, __ATOMIC_RELAXED, __HIP_MEMORY_SCOPE_AGENT); }
__device__ __forceinline__ unsigned xb_add(unsigned* p, unsigned v) { return __hip_atomic_fetch_add(p, v, __ATOMIC_RELAXED, __HIP_MEMORY_SCOPE_AGENT); }
__device__ __forceinline__ unsigned xb_xcc_id() { return (unsigned)__builtin_amdgcn_s_getreg((3 << 11) | 20) & 0xFu; }
#define XB_SPIN(cond, bar) do { unsigned _sp = 0; while (cond) { __builtin_amdgcn_s_sleep(1); \
    if ((++_sp & 255u) == 0u) { if (xb_ld(&(bar)[XB_TMO])) break; if (_sp > XB_SPIN_CAP) { atomicAdd(&(bar)[XB_TMO], 1u); break; } } } } while (0)

struct XcdBarrier {
    unsigned* bar; unsigned x;
    volatile LAS unsigned* st;
};

__device__ __forceinline__ XcdBarrier xcd_barrier_post(unsigned* bar, volatile LAS unsigned* st) {
    XcdBarrier b; b.bar = bar; b.x = xb_xcc_id(); b.st = st;
    if (threadIdx.x == 0) (void)xb_add(&bar[XB_XCNT(b.x)], 1u);
    return b;
}
__device__ __forceinline__ void xcd_barrier_complete(unsigned* bar, unsigned x, unsigned& nloc, unsigned& nx) {
    const unsigned G = gridDim.x * gridDim.y * gridDim.z;
    unsigned sum, cnt, mine, sp = 0u;
    for (;;) {
        sum = 0u; cnt = 0u; mine = 0u;
#pragma unroll
        for (unsigned j = 0; j < 16; ++j) { const unsigned c = xb_ld(&bar[XB_XCNT(j)]); sum += c; cnt += (c > 0u) ? 1u : 0u; mine = (j == x) ? c : mine; }
        if (sum == G) break;
        __builtin_amdgcn_s_sleep(1);
        if ((++sp & 255u) == 0u) { if (xb_ld(&bar[XB_TMO])) break; if (sp > XB_SPIN_CAP) { atomicAdd(&bar[XB_TMO], 1u); break; } }
    }
    nloc = mine > 0u ? mine : 1u; nx = cnt > 0u ? cnt : 1u;
}

__device__ __forceinline__ void xcd_barrier(const XcdBarrier& b) {
    asm volatile("s_waitcnt vmcnt(0)" ::: "memory");
    __syncthreads();
    if (threadIdx.x == 0) {
        unsigned* bar = b.bar;
        __builtin_amdgcn_s_waitcnt(0);
        unsigned nloc = b.st[0], nx = b.st[1];
        if (nloc == 0u) { xcd_barrier_complete(bar, b.x, nloc, nx); b.st[0] = nloc; b.st[1] = nx; }
        const unsigned old = xb_add(&bar[XB_XSUB(b.x)], 1u);
        const unsigned gen = old / nloc;
        if (old + 1u == (gen + 1u) * nloc) {
            __builtin_amdgcn_fence(__ATOMIC_RELEASE, "agent");
            asm volatile("s_waitcnt vmcnt(0)" ::: "memory");
            const unsigned og = xb_add(&bar[XB_TOP], 1u);
            const unsigned tg = og / nx;
            if (og + 1u == (tg + 1u) * nx) xb_add(&bar[XB_TOPGEN], 1u);
            else XB_SPIN(xb_ld(&bar[XB_TOPGEN]) == tg, bar);
            __builtin_amdgcn_fence(__ATOMIC_ACQUIRE, "agent");
            xb_add(&bar[XB_XGEN(b.x)], 1u);
            asm volatile("s_waitcnt vmcnt(0)" ::: "memory");
        } else {
            XB_SPIN(xb_ld(&bar[XB_XGEN(b.x)]) == gen, bar);
            __builtin_amdgcn_fence(__ATOMIC_ACQUIRE, "agent");
            asm volatile("s_waitcnt vmcnt(0)" ::: "memory");
        }
    }
    __syncthreads();
}

constexpr size_t WS_CNT = 4096 + 16384;
constexpr size_t WS_BAR = 4096;
constexpr int LDS_BARST = LDS_BYTES - 64;
constexpr int N_PHASES = 11;
__global__ void __launch_bounds__(NTHREADS, 2) hymba_fwd(Args args) {
    extern __shared__ __attribute__((aligned(16))) unsigned char lds_raw[];
    cg::grid_group grid = cg::this_grid();
    Frame F;
    F.lds = (LAS unsigned char*)lds_raw;
    F.tid = threadIdx.x; F.lane = F.tid & 63; F.wave = __builtin_amdgcn_readfirstlane(F.tid >> 6);
    F.G = gridDim.x; F.bid = blockIdx.x;
    F.in = args.in; F.out = args.out; F.ws = args.ws;
    unsigned char* ws = args.ws; float* out = args.out;
    if (F.tid < 16) ((LAS unsigned*)(F.lds + LDS_BARST))[F.tid] = 0u;
    __syncthreads();
    XcdBarrier xbar = xcd_barrier_post((unsigned*)(ws + WS_BAR), (volatile LAS unsigned*)(F.lds + LDS_BARST));
    if (args.ph_lo > 1000) grid.sync();
#ifdef HY_LDSCLR
    for (int i = F.tid; i < LDS_BYTES / 16; i += NTHREADS) *(LAS u32x4*)(F.lds + i * 16) = (u32x4){0u, 0u, 0u, 0u};
    __syncthreads();
#endif
    const int lo = args.ph_lo, hi = args.ph_hi;
#ifndef HY_PHASE_MASK
#define HY_PHASE_MASK 0x7ff
#endif
#define IN(k) (((HY_PHASE_MASK >> (k)) & 1) && lo <= (k) && (k) < hi)
#ifndef HY_REPMASK
#define HY_REPMASK 0
#endif
#define PHASE(k, ...) do { if (IN(k)) { __VA_ARGS__ } if (IN(k) && ((HY_REPMASK >> (k)) & 1)) { __VA_ARGS__ } } while (0)
#ifdef HY_XACQ
#define SEAM(k) do { if (IN(k) && IN((k) + 1)) { asm volatile("s_waitcnt vmcnt(0)" ::: "memory"); __builtin_amdgcn_fence(__ATOMIC_RELEASE, "agent"); asm volatile("s_waitcnt vmcnt(0)" ::: "memory"); grid.sync(); __builtin_amdgcn_fence(__ATOMIC_ACQUIRE, "agent"); asm volatile("s_waitcnt vmcnt(0)" ::: "memory"); __syncthreads(); } } while (0)
#else
#define SEAM(k) do { if (IN(k) && IN((k) + 1)) { xcd_barrier(xbar); } } while (0)
#endif
    float* SS0 = (float*)(ws + WS_SS); float* SS1 = (float*)(ws + WS_SS + SS_STRIDE); float* SS2 = (float*)(ws + WS_SS + 2 * SS_STRIDE);
    bf16_t* XB = (bf16_t*)(ws + WS_XB);

    PHASE(0, p0_prologue(F, !(F.G > 32)););
    SEAM(0);
    PHASE(1,
        { pg8::Gemm g{XB, (const bf16_t*)(ws + WS_WIN), TT, NIN, DM, DM}; pg8::StaticOrder S; S.init(TT, NIN, F.G, F.bid);
          EpiIn E{out, out + (size_t)TT * 1024, (bf16_t*)(out + O_SST), (bf16_t*)(ws + WS_GATE), (bf16_t*)(ws + WS_SQ), (bf16_t*)(ws + WS_SKV), (const float*)(ws + WS_TAB), out};
          pg8::gemm_phase<EpiIn, pg8::StaticOrder, true, true>(F.lds, g, S, E); }
        { pg8::Gemm g{(const bf16_t*)(ws + WS_MN), (const bf16_t*)(ws + WS_WMKV), 1024, 1024, DM, DM}; pg8::StaticOrder S; S.init(1024, 1024, F.G, (F.bid + 16) % F.G);
          EpiMemKV E{(bf16_t*)(ws + WS_MK), (bf16_t*)(ws + WS_MVT), out};
          pg8::gemm_phase<EpiMemKV, pg8::StaticOrder, true, true>(F.lds, g, S, E); }
    );
    SEAM(1);
    PHASE(2, hgrn_prep(F););
    SEAM(2);
    PHASE(3,
        const bool split = F.G > 32;
#define P3_SCAN do { if (F.bid < 32) { P3_DELAY; for (int bh = F.bid; bh < 32; bh += F.G) { const int b = bh >> 3, h = bh & 7; \
                HGRN_SCAN_PROMPT(F, b * 256, 256, h, b * SEQ, 16, nullptr, out + O_PST + (size_t)bh * 16384); } } } while (0)
#define P3_OTHERS do { if (!split || F.bid >= 32) { const int nw = split ? F.G - 32 : F.G; \
            for (int i = split ? F.bid - 32 : F.bid; i < 1536; i += nw) { \
                if (i < 256) swa_prompt_unit(F, i); \
                else if (i < 512) swa_sample_unit(F, i - 256); \
                else { const int t = i - 512, b = t >> 3, h = t & 7; \
                    HGRN_SCAN_SAMPLE(F, NCHP + b, 1, h, TP + 4 * b, 4, F.in[I_STATE] + (size_t)t * 16384, out + O_SST + (size_t)t * 16384); } } } } while (0)
        P3_SCAN;
        if ((HY_REPMASK >> 11) & 1) P3_SCAN;
        P3_OTHERS;
        if (split && F.bid >= 32) {
            const int nw = F.G - 32; unsigned* CNT = (unsigned*)(ws + WS_CNT);
            asm volatile("s_waitcnt vmcnt(0)" ::: "memory"); __syncthreads();
            if (F.tid == 0) {
                __builtin_amdgcn_fence(__ATOMIC_RELEASE, "agent"); asm volatile("s_waitcnt vmcnt(0)" ::: "memory");
                __hip_atomic_fetch_add(CNT, 1u, __ATOMIC_RELAXED, __HIP_MEMORY_SCOPE_AGENT);
                unsigned sp = 0; while (__hip_atomic_load(CNT, __ATOMIC_RELAXED, __HIP_MEMORY_SCOPE_AGENT) < (unsigned)nw) { __builtin_amdgcn_s_sleep(2); if (++sp > (1u << 22)) break; }
                __builtin_amdgcn_fence(__ATOMIC_ACQUIRE, "agent"); asm volatile("s_waitcnt vmcnt(0)" ::: "memory");
            }
            __syncthreads();
            pg8::Gemm g{(const bf16_t*)(ws + WS_MIX), (const bf16_t*)(ws + WS_WOUT), TT, DM, DM / 2, DM}; pg8::StaticOrder S; S.init(TT, DM, nw, F.bid - 32); S.ksv = 1;
            EpiResid E{F.in[I_XP], F.in[I_XS], out, nullptr, nullptr};
            pg8::gemm_phase<EpiResid, pg8::StaticOrder, true, true>(F.lds, g, S, E);
            __syncthreads();
            p0_convert(F, CV_EARLY, CV_ALL, (F.bid - 32) * NWAVES + F.wave, nw * NWAVES);
        }
    );
    SEAM(3);
    PHASE(4,
        if (!(F.G > 32)) {
            pg8::Gemm g0{(const bf16_t*)(ws + WS_MIX), (const bf16_t*)(ws + WS_WOUT), TT, DM, DM / 2, DM}; pg8::StaticOrder S0; S0.init(TT, DM, F.G, F.bid); S0.ksv = 1;
            EpiResid E0{F.in[I_XP], F.in[I_XS], out, nullptr, nullptr};
            pg8::gemm_phase<EpiResid, pg8::StaticOrder, true, true>(F.lds, g0, S0, E0);
            xcd_barrier(xbar);
        }
        pg8::Gemm g{(const bf16_t*)(ws + WS_MIX), (const bf16_t*)(ws + WS_WOUT), TT, DM, DM / 2, DM}; pg8::StaticOrder S; S.init(TT, DM, F.G, F.bid);
        EpiResid E{out, out + (size_t)TP * DM, out, XB, SS0};
        pg8::gemm_phase<EpiResid, pg8::StaticOrder, true, true>(F.lds, g, S, E);
    );
    SEAM(4);
    PHASE(5,
        pg8::Gemm g{XB, (const bf16_t*)(ws + WS_WMQ), TT, MEMW, DM, DM}; pg8::StaticOrder S; S.init(TT, MEMW, F.G, F.bid);
        EpiScaleBf16 E{(bf16_t*)(ws + WS_QM), MEMW, SS0, MEM_QSCALE};
        pg8::gemm_phase<EpiScaleBf16, pg8::StaticOrder, true, true>(F.lds, g, S, E);
    );
    SEAM(5);
    PHASE(6,
        for (int u = F.bid; u < 256; u += F.G) memattn_prompt_unit(F, u);
        for (int t = F.bid; t < 256; t += F.G) memattn_sample_block(F, t);
    );
    SEAM(6);
    if (IN(7)) {
        pg8::Gemm g{(const bf16_t*)(ws + WS_OM), (const bf16_t*)(ws + WS_WMO), TT, DM, MEMW, MEMW}; pg8::StaticOrder S; S.init(TT, DM, F.G, F.bid);
        EpiResid E{out, out + (size_t)TP * DM, out, XB, SS1};
        pg8::gemm_phase<EpiResid, pg8::StaticOrder, true, true>(F.lds, g, S, E);
    }
    SEAM(7);
    PHASE(8,
        pg8::Gemm g{XB, (const bf16_t*)(ws + WS_WGU), TT, 2 * FF, DM, DM}; pg8::StaticOrder S; S.init(TT, 2 * FF, F.G, F.bid);
        EpiSwiGLU E{(bf16_t*)(ws + WS_HID), SS1};
        pg8::gemm_phase<EpiSwiGLU, pg8::StaticOrder, true, true>(F.lds, g, S, E);
    );
    SEAM(8);
    constexpr int DN_NS = 11; constexpr size_t SLAB_STRIDE = (size_t)TS * DM;
    if (IN(9)) {
        { pg8::Gemm g{(const bf16_t*)(ws + WS_HID), (const bf16_t*)(ws + WS_WDN), TP, DM, FF, FF}; pg8::StaticOrder S; S.init(TP, DM, F.G, F.bid);
          EpiResid E{out, out + (size_t)TP * DM, out, nullptr, SS2};
          pg8::gemm_phase<EpiResid, pg8::StaticOrder, true, true>(F.lds, g, S, E); }
        { pg8::Gemm g{(const bf16_t*)(ws + WS_HID), (const bf16_t*)(ws + WS_WDN), TT, DM, FF / DN_NS, FF}; SplitOrder S{F.bid, DN_NS};
          EpiSlab E{(float*)(ws + WS_MIX), TP, SLAB_STRIDE};
          pg8::gemm_phase<EpiSlab, SplitOrder, true, true>(F.lds, g, S, E); }
    }
    SEAM(9);
    if (IN(10)) {
        for (int m = F.bid * NWAVES + F.wave; m < TT; m += F.G * NWAVES) {
            if (m < TP) final_norm_row(out + (size_t)m * DM, SS2, m, F.in[I_NFINAL], F.lane);
            else final_norm_row_slabs(out + (size_t)m * DM, (const float*)(ws + WS_MIX) + (size_t)(m - TP) * DM, SLAB_STRIDE, DN_NS, F.in[I_NFINAL], F.lane);
        }
    }
#undef IN
#undef SEAM
}

#ifndef HY_N_LAUNCHES
#define HY_N_LAUNCHES 1
#endif
extern "C" void kernel_launch(void* const* d_in, const int* in_sizes, int n_in, void* d_out, int out_size, void* d_ws, size_t ws_size, hipStream_t stream) {
    static int grid = 0;
    if (grid == 0) {
        if (n_in != 26 || (size_t)out_size != O_END || ws_size < WS_END) { fprintf(stderr, "kernel_launch: unexpected problem: n_in %d out %d ws %zu (need %zu)\n", n_in, out_size, ws_size, (size_t)WS_END); grid = -1; return; }
        int dev = 0, cus = 0, per_cu = 0;
        hipGetDevice(&dev); hipDeviceGetAttribute(&cus, hipDeviceAttributeMultiprocessorCount, dev);
        if (hipFuncSetAttribute((const void*)hymba_fwd, hipFuncAttributeMaxDynamicSharedMemorySize, LDS_BYTES) != hipSuccess) { fprintf(stderr, "kernel_launch: hipFuncSetAttribute failed\n"); grid = -1; return; }
        if (hipOccupancyMaxActiveBlocksPerMultiprocessor(&per_cu, (const void*)hymba_fwd, NTHREADS, LDS_BYTES) != hipSuccess || per_cu < 1) { fprintf(stderr, "kernel_launch: occupancy query says %d blocks/CU\n", per_cu); per_cu = 1; }
        (void)hipGetLastError();
        grid = cus;
        fprintf(stderr, "kernel_launch: %d CUs, occupancy %d blocks/CU, grid %d\n", cus, per_cu, grid);
    }
    if (grid < 0) return;
    Args a{};
    for (int i = 0; i < 26; ++i) a.in[i] = (const float*)d_in[i];
    a.out = (float*)d_out; a.ws = (unsigned char*)d_ws;
    if (hipMemsetAsync((char*)d_ws + WS_BAR, 0, 16384 + 256, stream) != hipSuccess) { fprintf(stderr, "kernel_launch: hipMemsetAsync failed\n"); return; }
#if HY_N_LAUNCHES == 1
    a.ph_lo = 0; a.ph_hi = N_PHASES;
    void* kargs[] = {&a};
    hipError_t e = hipLaunchCooperativeKernel((const void*)hymba_fwd, dim3(grid), dim3(NTHREADS), kargs, LDS_BYTES, stream);
    if (e != hipSuccess) fprintf(stderr, "kernel_launch: cooperative launch failed: %s\n", hipGetErrorString(e));
#else
    for (int p = 0; p < N_PHASES; ++p) {
        a.ph_lo = p; a.ph_hi = p + 1;
        hipLaunchKernelGGL(hymba_fwd, dim3(grid), dim3(NTHREADS), LDS_BYTES, stream, a);
    }
#endif
}
```

```cpp
#include <hip/hip_runtime.h>
#include <hip/hip_cooperative_groups.h>
#include <cstdio>
#include <cstdint>
namespace cg = cooperative_groups;

namespace pg8 {
#define PG8_LAS __attribute__((address_space(3)))
typedef unsigned short bf16_t;
typedef short bf16x8 __attribute__((ext_vector_type(8)));
typedef float f32x4 __attribute__((ext_vector_type(4)));
typedef unsigned u32x4 __attribute__((ext_vector_type(4)));
constexpr int BM = 256, BK = 64, HALF = 128, HTB = HALF * BK * 2  , STAGE_BYTES = 8 * HTB, NXCD = 8, WGM = 8;

__host__ __device__ __forceinline__ int lds_byte(int r, int c) { const int st = (r >> 4) * 2 + (c >> 5), rr = r & 15, cc = c & 31, ob = rr * 64 + cc * 2; return st * 1024 + (ob ^ (((ob >> 9) & 1) << 5)); }
__host__ __device__ __forceinline__ void stage_rc(int b, int& R, int& C) { const int st = b / 1024, sb = b % 1024, swz = sb ^ (((sb >> 9) & 1) << 5); R = (st >> 1) * 16 + swz / 64; C = (st & 1) * 32 + (swz % 64) / 2; }
__host__ __device__ __forceinline__ int perm32(int rho) { const int n = rho >> 4, i = rho & 15; return 8 * (i >> 2) + 4 * n + (i & 3); }

struct Unit { int pm, pn, ks; };
struct Gemm { const bf16_t* A; const bf16_t* Bt; int M, N, K, ld; };

struct StaticOrder {
    int nM, nN, nwg, G, c, ksv = 0;
    __host__ __device__ void init(int M, int N, int G_, int c_) { nM = M / BM; nN = N / BM; nwg = nM * nN; G = G_; c = c_; }
    __host__ __device__ bool next(int i, Unit& u) const {
        const long L = (long)i * G + c; if (L >= nwg) return false;
        int wgid = (int)L; { const int q = nwg / NXCD, r = nwg % NXCD, xcd = wgid % NXCD, off = wgid / NXCD; wgid = (xcd < r ? xcd * (q + 1) : r * (q + 1) + (xcd - r) * q) + off; }
        const int nig = WGM * nN, gid = wgid / nig, fm = gid * WGM, gsz = (nM - fm) < WGM ? (nM - fm) : WGM;
        u.pm = fm + ((wgid % nig) % gsz); u.pn = (wgid % nig) / gsz; u.ks = ksv; return true;
    }
    __device__ __forceinline__ void a_ready(const Unit&) const {}
    __device__ __forceinline__ void done(const Unit&) const {}
};

template <class Epi, class Sched, bool ALIGN_EPI = false, bool SP2 = false>
__device__ __forceinline__ void gemm_phase(PG8_LAS unsigned char* lds, const Gemm g, const Sched& S, const Epi& E) {
    const int tid = threadIdx.x, wid = __builtin_amdgcn_readfirstlane(tid >> 6), lane = tid & 63, wr = wid >> 2, wc = wid & 3, fr = lane & 15, fq = lane >> 4;
    const int K = g.ld, nt = g.K / BK;
    unsigned voffA[2], voffB[2];
#pragma unroll
    for (int i = 0; i < 2; ++i) { int R, C; stage_rc(tid * 16 + i * 8192, R, C); const int Rb = Epi::PERM ? ((R & ~31) + perm32(R & 31)) : R;
        voffA[i] = (unsigned)(R * K + C) * 2u; voffB[i] = (unsigned)(Rb * K + C) * 2u; }
    const size_t kstep = (size_t)(BK * 2);
    const size_t hstep = (size_t)HALF * K * 2;
    const size_t tstep = 2 * hstep;
    const unsigned ldsw = (unsigned)wid * 1024u;
    const int aoff = lds_byte(wr * 64 + fr, fq * 8), boff = lds_byte(wc * 32 + fr, fq * 8);
#define PG8_SA(b, h) (((b) * 2 + (h)) * HTB)
#define PG8_SB(b, h) ((4 + (b) * 2 + (h)) * HTB)
#define PG8_STAGE(bufoff, gbase, voff) do { _Pragma("unroll") for (int _i = 0; _i < 2; ++_i) \
        __builtin_amdgcn_global_load_lds((const unsigned*)((const char*)(gbase) + (voff)[_i]), (PG8_LAS unsigned*)(lds + (bufoff) + ldsw + _i * 8192), 16, 0, 0); } while (0)
#define PG8_LDA(dst, b, h) do { _Pragma("unroll") for (int m = 0; m < 4; ++m) _Pragma("unroll") for (int k = 0; k < 2; ++k) dst[m][k] = *(const PG8_LAS bf16x8*)(lds + PG8_SA(b, h) + aoff + m * 2048 + k * 1024); } while (0)
#define PG8_LDB(dst, b, h) do { _Pragma("unroll") for (int n = 0; n < 2; ++n) _Pragma("unroll") for (int k = 0; k < 2; ++k) dst[n][k] = *(const PG8_LAS bf16x8*)(lds + PG8_SB(b, h) + boff + n * 2048 + k * 1024); } while (0)
#define PG8_MMA(ai, bj, At, Bt) do { __builtin_amdgcn_s_setprio(1); _Pragma("unroll") for (int m = 0; m < 4; ++m) _Pragma("unroll") for (int n = 0; n < 2; ++n) _Pragma("unroll") for (int k = 0; k < 2; ++k) \
        acc[ai][bj][m][n] = __builtin_amdgcn_mfma_f32_16x16x32_bf16(Bt[n][k], At[m][k], acc[ai][bj][m][n], 0, 0, 0); __builtin_amdgcn_s_setprio(0); } while (0)
#define PG8_WAIT_V(n) asm volatile("s_waitcnt vmcnt(" #n ")" ::: "memory")
#define PG8_WAIT_L(n) asm volatile("s_waitcnt lgkmcnt(" #n ")" ::: "memory")
#define PG8_BAR __builtin_amdgcn_s_barrier()
#define PG8_SCHED __builtin_amdgcn_sched_barrier(0)
    Unit cur, nxt; int ui = 0;
    if (!S.next(0, cur)) return;
    f32x4 acc[2][2][4][2];
#pragma unroll
    for (int a = 0; a < 2; ++a)
#pragma unroll
        for (int b = 0; b < 2; ++b)
#pragma unroll
            for (int m = 0; m < 4; ++m)
#pragma unroll
                for (int n = 0; n < 2; ++n) acc[a][b][m][n] = (f32x4){0.f, 0.f, 0.f, 0.f};
    bf16x8 At[4][2], B0[2][2], B1[2][2];
    const char* cA = (const char*)g.A + (size_t)cur.pm * tstep + (size_t)cur.ks * g.K * 2; const char* cB = (const char*)g.Bt + (size_t)cur.pn * tstep + (size_t)cur.ks * g.K * 2;
    S.a_ready(cur);
    if constexpr (SP2) {
        PG8_STAGE(PG8_SB(0, 0), cB, voffB); PG8_STAGE(PG8_SB(0, 1), cB + hstep, voffB); PG8_STAGE(PG8_SA(0, 0), cA, voffA); PG8_STAGE(PG8_SA(0, 1), cA + hstep, voffA);
        if (wr == 1) PG8_BAR;
        PG8_WAIT_V(2); PG8_BAR;
        PG8_STAGE(PG8_SB(1, 0), cB + kstep, voffB); PG8_STAGE(PG8_SA(1, 0), cA + kstep, voffA); PG8_STAGE(PG8_SB(1, 1), cB + hstep + kstep, voffB);
        PG8_WAIT_V(6); PG8_BAR;
    } else {
        PG8_STAGE(PG8_SB(0, 0), cB, voffB); PG8_STAGE(PG8_SA(0, 0), cA, voffA); PG8_STAGE(PG8_SB(0, 1), cB + hstep, voffB); PG8_STAGE(PG8_SA(0, 1), cA + hstep, voffA);
        if (wr == 1) PG8_BAR;
        PG8_WAIT_V(4); PG8_BAR;
        PG8_STAGE(PG8_SB(1, 0), cB + kstep, voffB); PG8_STAGE(PG8_SA(1, 0), cA + kstep, voffA); PG8_STAGE(PG8_SB(1, 1), cB + hstep + kstep, voffB);
        PG8_WAIT_V(6); PG8_BAR;
    }
    for (;;) {
        const bool has_next = S.next(ui + 1, nxt);
        const char* nA = has_next ? (const char*)g.A + (size_t)nxt.pm * tstep + (size_t)nxt.ks * g.K * 2 : cA; const char* nB = has_next ? (const char*)g.Bt + (size_t)nxt.pn * tstep + (size_t)nxt.ks * g.K * 2 : cB;
        for (int t = 0; t < nt; t += 2) {
            const bool last = (t == nt - 2);
            const char* a1 = cA + (size_t)(t + 1) * kstep;
            const char* a2 = last ? nA : cA + (size_t)(t + 2) * kstep; const char* b2 = last ? nB : cB + (size_t)(t + 2) * kstep;
            const char* a3 = a2 + kstep; const char* b3 = b2 + kstep;
            if (last && has_next) S.a_ready(nxt);
            if constexpr (SP2) {
            PG8_LDB(B0, 0, 0); PG8_LDB(B1, 0, 1); PG8_SCHED; PG8_LDA(At, 0, 0); PG8_STAGE(PG8_SA(1, 1), a1 + hstep, voffA);
            PG8_WAIT_V(8); PG8_WAIT_L(0); PG8_BAR; PG8_MMA(0, 0, At, B0); PG8_MMA(0, 1, At, B1); PG8_BAR; PG8_SCHED;
            PG8_LDA(At, 0, 1); PG8_STAGE(PG8_SB(0, 0), b2, voffB); PG8_STAGE(PG8_SB(0, 1), b2 + hstep, voffB); PG8_STAGE(PG8_SA(0, 0), a2, voffA);
            PG8_WAIT_V(8); PG8_WAIT_L(0); PG8_BAR; PG8_MMA(1, 0, At, B0); PG8_MMA(1, 1, At, B1); PG8_BAR; PG8_SCHED;
            PG8_LDB(B0, 1, 0); PG8_LDB(B1, 1, 1); PG8_SCHED; PG8_LDA(At, 1, 0); PG8_STAGE(PG8_SA(0, 1), a2 + hstep, voffA);
            PG8_WAIT_V(8); PG8_WAIT_L(0); PG8_BAR; PG8_MMA(0, 0, At, B0); PG8_MMA(0, 1, At, B1); PG8_BAR; PG8_SCHED;
            PG8_LDA(At, 1, 1); PG8_STAGE(PG8_SB(1, 0), b3, voffB); PG8_STAGE(PG8_SB(1, 1), b3 + hstep, voffB); PG8_STAGE(PG8_SA(1, 0), a3, voffA);
            PG8_WAIT_V(8); PG8_WAIT_L(0); PG8_BAR; PG8_MMA(1, 0, At, B0); PG8_MMA(1, 1, At, B1); PG8_BAR; PG8_SCHED;
            } else {
            PG8_LDB(B0, 0, 0); PG8_SCHED; PG8_LDA(At, 0, 0); PG8_STAGE(PG8_SA(1, 1), a1 + hstep, voffA);
            PG8_WAIT_L(8); PG8_BAR; PG8_WAIT_L(0); PG8_MMA(0, 0, At, B0); PG8_BAR; PG8_SCHED;
            PG8_LDB(B1, 0, 1); PG8_STAGE(PG8_SB(0, 0), b2, voffB);
            PG8_BAR; PG8_WAIT_L(0); PG8_MMA(0, 1, At, B1); PG8_BAR;
            PG8_LDA(At, 0, 1); PG8_STAGE(PG8_SA(0, 0), a2, voffA);
            PG8_BAR; PG8_WAIT_L(0); PG8_MMA(1, 0, At, B0); PG8_BAR; PG8_SCHED;
            PG8_STAGE(PG8_SB(0, 1), b2 + hstep, voffB);
            PG8_WAIT_V(6); PG8_BAR; PG8_MMA(1, 1, At, B1); PG8_BAR;
            PG8_LDB(B0, 1, 0); PG8_SCHED; PG8_LDA(At, 1, 0); PG8_STAGE(PG8_SA(0, 1), a2 + hstep, voffA);
            PG8_WAIT_L(8); PG8_BAR; PG8_WAIT_L(0); PG8_MMA(0, 0, At, B0); PG8_BAR; PG8_SCHED;
            PG8_LDB(B1, 1, 1); PG8_STAGE(PG8_SB(1, 0), b3, voffB);
            PG8_BAR; PG8_WAIT_L(0); PG8_MMA(0, 1, At, B1); PG8_BAR;
            PG8_LDA(At, 1, 1); PG8_STAGE(PG8_SA(1, 0), a3, voffA);
            PG8_BAR; PG8_WAIT_L(0); PG8_MMA(1, 0, At, B0); PG8_BAR; PG8_SCHED;
            PG8_STAGE(PG8_SB(1, 1), b3 + hstep, voffB);
            PG8_WAIT_V(6); PG8_BAR; PG8_MMA(1, 1, At, B1); PG8_BAR;
            }
        }
        if constexpr (ALIGN_EPI) { if (wr == 0) PG8_BAR; }
        if constexpr (!Epi::AFTER_DRAIN) { E(acc, cur, wr, wc, fr, fq); S.done(cur); }
        if (!has_next) break;
#pragma unroll
        for (int a = 0; a < 2; ++a)
#pragma unroll
            for (int b = 0; b < 2; ++b)
#pragma unroll
                for (int m = 0; m < 4; ++m)
#pragma unroll
                    for (int n = 0; n < 2; ++n) acc[a][b][m][n] = (f32x4){0.f, 0.f, 0.f, 0.f};
        cur = nxt; cA = nA; cB = nB; ++ui;
        if constexpr (ALIGN_EPI) { if (wr == 1) PG8_BAR; }
    }
    PG8_WAIT_V(0);
    if constexpr (!ALIGN_EPI) { if (wr == 0) PG8_BAR; }
    PG8_BAR;
    if constexpr (Epi::AFTER_DRAIN) { E.fused(acc, cur, wr, wc, fr, fq, lds, wid, lane); S.done(cur); }
#undef PG8_SA
#undef PG8_SB
#undef PG8_STAGE
#undef PG8_LDA
#undef PG8_LDB
#undef PG8_MMA
#undef PG8_WAIT_V
#undef PG8_WAIT_L
#undef PG8_BAR
#undef PG8_SCHED
}
}

#define LAS __attribute__((address_space(3)))
typedef unsigned short bf16_t;
typedef short bf16x8 __attribute__((ext_vector_type(8)));
typedef short bf16x4 __attribute__((ext_vector_type(4)));
typedef float f32x4 __attribute__((ext_vector_type(4)));
typedef float f32x2 __attribute__((ext_vector_type(2)));
typedef unsigned u32x4 __attribute__((ext_vector_type(4)));
typedef unsigned u32x2 __attribute__((ext_vector_type(2)));
typedef __bf16 hbf16x2 __attribute__((ext_vector_type(2)));

constexpr int DM = 2048, TP = 16384, TS = 512, TT = TP + TS, SEQ = 4096, DB = 128;
constexpr int NIN = 5376, FF = 5632, MEMW = 512;
constexpr int NCHP = TP / 16, NCH = NCHP + DB;
constexpr float RMS_EPS = 1e-6f;
constexpr float LOG2E = 1.4426950408889634f;
constexpr float SWA_QSCALE = 0.125f * LOG2E;
constexpr float MEM_QSCALE = 0.08838834764831845f * LOG2E;
constexpr int NWAVES = 8, NTHREADS = 512;
constexpr int LDS_BYTES = 147456;

constexpr size_t O_YP = 0, O_YS = 33554432, O_PST = 34603008, O_PSK = 35127296, O_PSV = 35192832, O_PMK = 35258368, O_PMV = 35782656,
                 O_SST = 36306944, O_SSK = 53084160, O_SSV = 55181312, O_END = 57278464;
constexpr size_t MiB = 1u << 20;
constexpr size_t WS_TAB = 1 * MiB;
constexpr size_t WS_WIN = 2 * MiB, WS_WOUT = 23 * MiB, WS_WMQ = 31 * MiB, WS_WMKV = 33 * MiB, WS_WMO = 37 * MiB, WS_WGU = 39 * MiB, WS_WDN = 83 * MiB;
constexpr size_t WS_SS = 105 * MiB;
constexpr size_t SS_STRIDE = 2359296;
constexpr size_t WS_MK = 112 * MiB, WS_MVT = 113 * MiB, WS_QM = 114 * MiB, WS_OM = 131 * MiB, WS_MN = 148 * MiB, WS_XB = 152 * MiB;
constexpr size_t WS_D = 218 * MiB;
constexpr size_t WS_GATE = WS_D, WS_SQ = WS_D + 33 * MiB, WS_SKV = WS_D + 66 * MiB, WS_QIN = WS_D + 75 * MiB, WS_KT = WS_D + 111 * MiB, WS_VT = WS_D + 147 * MiB,
                 WS_PSC = WS_D + 183 * MiB, WS_DEC = WS_D + 188 * MiB, WS_MIX = WS_D + 193 * MiB, WS_END = WS_D + 259 * MiB;
constexpr size_t WS_HID = WS_D;
static_assert((size_t)TT * FF * 2 <= 183 * MiB, "HID overlay");

struct Args {
    const float* in[26];
    float* out; unsigned char* ws;
    int ph_lo, ph_hi;
};

__device__ __forceinline__ unsigned cvtpk(float lo, float hi) { f32x2 v = {lo, hi}; hbf16x2 b = __builtin_convertvector(v, hbf16x2); return __builtin_bit_cast(unsigned, b); }
__device__ __forceinline__ float bf2f(unsigned short b) { return __uint_as_float((unsigned)b << 16); }
__device__ __forceinline__ unsigned short f2bf(float f) { return (unsigned short)(cvtpk(f, 0.f) & 0xffffu); }
__device__ __forceinline__ u32x4 pack8(f32x4 a, f32x4 b) { u32x4 w; w.x = cvtpk(a[0], a[1]); w.y = cvtpk(a[2], a[3]); w.z = cvtpk(b[0], b[1]); w.w = cvtpk(b[2], b[3]); return w; }
__device__ __forceinline__ u32x2 pack4(f32x4 a) { u32x2 w; w.x = cvtpk(a[0], a[1]); w.y = cvtpk(a[2], a[3]); return w; }
__device__ __forceinline__ float fexp(float x) { return __builtin_amdgcn_exp2f(x * LOG2E); }
__device__ __forceinline__ float fsigmoid(float x) { return __builtin_amdgcn_rcpf(1.0f + fexp(-x)); }
__device__ __forceinline__ float wave_sum(float v) {
#pragma unroll
    for (int o = 1; o < 64; o <<= 1) v += __shfl_xor(v, o);
    return v;
}
#define LDS_WAIT() asm volatile("s_waitcnt lgkmcnt(0)" ::: "memory")

__device__ __forceinline__ float row_rs(const float* SS, int row) {
    const f32x4* p = (const f32x4*)(SS + (size_t)row * 32);
    f32x4 s = p[0];
#pragma unroll
    for (int i = 1; i < 8; ++i) s += p[i];
    return __builtin_amdgcn_rsqf(((s[0] + s[1]) + (s[2] + s[3])) * (1.0f / DM) + RMS_EPS);
}

using pg8::Unit;
struct EpiIn {
    static constexpr bool PERM = true, AFTER_DRAIN = false;
    float* QF; float* GF; bf16_t* VB; bf16_t* GATE; bf16_t* SQ; bf16_t* SKV; const float* LB; float* out;
    __device__ __forceinline__ void operator()(const f32x4 (&acc)[2][2][4][2], const Unit& u, int wr, int wc, int fr, int fq) const {
        const int pn = u.pn;
#pragma unroll
        for (int ai = 0; ai < 2; ++ai)
#pragma unroll
            for (int m = 0; m < 4; ++m) {
                const int row = u.pm * 256 + ai * 128 + wr * 64 + m * 16 + fr;
#pragma unroll
                for (int bj = 0; bj < 2; ++bj) {
                    const int c = pn * 256 + bj * 128 + wc * 32 + 8 * fq;
                    f32x4 v0 = acc[ai][bj][m][0], v1 = acc[ai][bj][m][1];
                    if (pn < 4) {
                        float* d = QF + (size_t)row * 1024 + c; *(f32x4*)d = v0; *(f32x4*)(d + 4) = v1;
                    } else if (pn < 8) {
                        const int cc = c - 1024;
                        const f32x4 l0 = *(const f32x4*)(LB + cc), l1 = *(const f32x4*)(LB + cc + 4);
#pragma unroll
                        for (int j = 0; j < 4; ++j) { v0[j] = __logf(l0[j] + (1.0f - l0[j]) * fsigmoid(v0[j])); v1[j] = __logf(l1[j] + (1.0f - l1[j]) * fsigmoid(v1[j])); }
                        float* d = GF + (size_t)row * 1024 + cc; *(f32x4*)d = v0; *(f32x4*)(d + 4) = v1;
                    } else if (pn < 12) {
                        *(u32x4*)(VB + (size_t)row * 1024 + (c - 2048)) = pack8(v0, v1);
                    } else if (pn < 16) {
#pragma unroll
                        for (int j = 0; j < 4; ++j) { v0[j] = v0[j] * fsigmoid(v0[j]); v1[j] = v1[j] * fsigmoid(v1[j]); }
                        *(u32x4*)(GATE + (size_t)row * 1024 + (c - 3072)) = pack8(v0, v1);
                    } else if (pn < 20) {
                        *(u32x4*)(SQ + (size_t)row * 1024 + (c - 4096)) = pack8(v0 * SWA_QSCALE, v1 * SWA_QSCALE);
                    } else {
                        const int cc = c - 5120;
                        *(u32x4*)(SKV + (size_t)row * 256 + cc) = pack8(v0, v1);
                        float* d = nullptr;
                        if (row < TP) { const int b = row >> 12, t = row & 4095; if (t >= SEQ - 128) d = out + (bj == 0 ? O_PSK : O_PSV) + (size_t)(b * 128 + (t - (SEQ - 128))) * 128 + (cc & 127); }
                        else { const int rs = row - TP, b = rs >> 2, t = rs & 3; d = out + (bj == 0 ? O_SSK : O_SSV) + (size_t)(b * 128 + 124 + t) * 128 + (cc & 127); }
                        if (d) { *(f32x4*)d = v0; *(f32x4*)(d + 4) = v1; }
                    }
                }
            }
    }
};
struct EpiMemKV {
    static constexpr bool PERM = true, AFTER_DRAIN = false;
    bf16_t* MK; bf16_t* MVT; float* out;
    __device__ __forceinline__ void operator()(const f32x4 (&acc)[2][2][4][2], const Unit& u, int wr, int wc, int fr, int fq) const {
#pragma unroll
        for (int ai = 0; ai < 2; ++ai)
#pragma unroll
            for (int m = 0; m < 4; ++m) {
                const int row = u.pm * 256 + ai * 128 + wr * 64 + m * 16 + fr;
#pragma unroll
                for (int bj = 0; bj < 2; ++bj) {
                    const int c = u.pn * 256 + bj * 128 + wc * 32 + 8 * fq;
                    const f32x4 v0 = acc[ai][bj][m][0], v1 = acc[ai][bj][m][1];
                    if (u.pn < 2) {
                        float* d = out + O_PMK + (size_t)row * 512 + c; *(f32x4*)d = v0; *(f32x4*)(d + 4) = v1;
                        *(u32x4*)(MK + (size_t)row * 512 + c) = pack8(v0, v1);
                    } else {
                        const int cv = c - 512, h = cv >> 7, dd = cv & 127, b = row >> 8, mm = row & 255;
                        float* d = out + O_PMV + (size_t)row * 512 + cv; *(f32x4*)d = v0; *(f32x4*)(d + 4) = v1;
                        bf16_t* t = MVT + ((size_t)((b * 4 + h) * 128 + dd)) * 256 + mm;
#pragma unroll
                        for (int j = 0; j < 4; ++j) { t[(size_t)j * 256] = f2bf(v0[j]); t[(size_t)(j + 4) * 256] = f2bf(v1[j]); }
                    }
                }
            }
    }
};
struct EpiResid {
    static constexpr bool PERM = true, AFTER_DRAIN = false;
    const float* resP; const float* resS; float* X; bf16_t* XB; float* SS;
    __device__ __forceinline__ void operator()(const f32x4 (&acc)[2][2][4][2], const Unit& u, int wr, int wc, int fr, int fq) const {
#pragma unroll
        for (int ai = 0; ai < 2; ++ai)
#pragma unroll
            for (int m = 0; m < 4; ++m) {
                const int row = u.pm * 256 + ai * 128 + wr * 64 + m * 16 + fr;
                const float* rrow = (row < TP) ? resP + (size_t)row * DM : resS + (size_t)(row - TP) * DM;
                float ss = 0.f;
#pragma unroll
                for (int bj = 0; bj < 2; ++bj) {
                    const int c = u.pn * 256 + bj * 128 + wc * 32 + 8 * fq;
                    const f32x4 v0 = acc[ai][bj][m][0] + *(const f32x4*)(rrow + c), v1 = acc[ai][bj][m][1] + *(const f32x4*)(rrow + c + 4);
                    float* d = X + (size_t)row * DM + c; *(f32x4*)d = v0; *(f32x4*)(d + 4) = v1;
                    ss += (v0[0] * v0[0] + v0[1] * v0[1]) + (v0[2] * v0[2] + v0[3] * v0[3]) + (v1[0] * v1[0] + v1[1] * v1[1]) + (v1[2] * v1[2] + v1[3] * v1[3]);
                    if (XB) *(u32x4*)(XB + (size_t)row * DM + c) = pack8(v0, v1);
                }
                ss += __shfl_xor(ss, 16); ss += __shfl_xor(ss, 32);
                if (SS && fq == 0) SS[(size_t)row * 32 + u.pn * 4 + wc] = ss;
            }
    }
};
struct EpiResidB {
    static constexpr bool PERM = true, AFTER_DRAIN = false;
    const float* resP; const float* resS; bf16_t* XB; float* SS;
    __device__ __forceinline__ void operator()(const f32x4 (&acc)[2][2][4][2], const Unit& u, int wr, int wc, int fr, int fq) const {
#pragma unroll
        for (int ai = 0; ai < 2; ++ai)
#pragma unroll
            for (int m = 0; m < 4; ++m) {
                const int row = u.pm * 256 + ai * 128 + wr * 64 + m * 16 + fr;
                float ss = 0.f;
#pragma unroll
                for (int bj = 0; bj < 2; ++bj) {
                    const int c = u.pn * 256 + bj * 128 + wc * 32 + 8 * fq;
                    bf16_t* d = XB + (size_t)row * DM + c;
                    f32x4 r0, r1;
                    if (resP) { const float* rrow = (row < TP) ? resP + (size_t)row * DM : resS + (size_t)(row - TP) * DM; r0 = *(const f32x4*)(rrow + c); r1 = *(const f32x4*)(rrow + c + 4); }
                    else { const u32x4 w = *(const u32x4*)d;
                        r0[0] = __uint_as_float(w.x << 16); r0[1] = __uint_as_float(w.x & 0xffff0000u); r0[2] = __uint_as_float(w.y << 16); r0[3] = __uint_as_float(w.y & 0xffff0000u);
                        r1[0] = __uint_as_float(w.z << 16); r1[1] = __uint_as_float(w.z & 0xffff0000u); r1[2] = __uint_as_float(w.w << 16); r1[3] = __uint_as_float(w.w & 0xffff0000u); }
                    const f32x4 v0 = acc[ai][bj][m][0] + r0, v1 = acc[ai][bj][m][1] + r1;
                    *(u32x4*)d = pack8(v0, v1);
                    ss += (v0[0] * v0[0] + v0[1] * v0[1]) + (v0[2] * v0[2] + v0[3] * v0[3]) + (v1[0] * v1[0] + v1[1] * v1[1]) + (v1[2] * v1[2] + v1[3] * v1[3]);
                }
                ss += __shfl_xor(ss, 16); ss += __shfl_xor(ss, 32);
                if (SS && fq == 0) SS[(size_t)row * 32 + u.pn * 4 + wc] = ss;
            }
    }
};
struct EpiSlab {
    static constexpr bool PERM = true, AFTER_DRAIN = false;
    float* SLAB; int row0; size_t slab_stride;
    __device__ __forceinline__ void operator()(const f32x4 (&acc)[2][2][4][2], const Unit& u, int wr, int wc, int fr, int fq) const {
        float* base = SLAB + (size_t)u.ks * slab_stride;
#pragma unroll
        for (int ai = 0; ai < 2; ++ai)
#pragma unroll
            for (int m = 0; m < 4; ++m) {
                const int row = u.pm * 256 + ai * 128 + wr * 64 + m * 16 + fr - row0;
#pragma unroll
                for (int bj = 0; bj < 2; ++bj) {
                    float* d = base + (size_t)row * DM + u.pn * 256 + bj * 128 + wc * 32 + 8 * fq;
                    *(f32x4*)d = acc[ai][bj][m][0]; *(f32x4*)(d + 4) = acc[ai][bj][m][1];
                }
            }
    }
};
struct SplitOrder {
    int c, ns;
    __device__ bool next(int i, Unit& u) const { if (i > 0 || c >= 16 * ns) return false; const int tile = c / ns; u.pm = TP / 256 + (tile >> 3); u.pn = tile & 7; u.ks = c % ns; return true; }
    __device__ __forceinline__ void a_ready(const Unit&) const {}
    __device__ __forceinline__ void done(const Unit&) const {}
};
struct EpiScaleBf16 {
    static constexpr bool PERM = true, AFTER_DRAIN = false;
    bf16_t* O; int ldc; const float* SS; float scale;
    __device__ __forceinline__ void operator()(const f32x4 (&acc)[2][2][4][2], const Unit& u, int wr, int wc, int fr, int fq) const {
#pragma unroll
        for (int ai = 0; ai < 2; ++ai)
#pragma unroll
            for (int m = 0; m < 4; ++m) {
                const int row = u.pm * 256 + ai * 128 + wr * 64 + m * 16 + fr;
                const float s = row_rs(SS, row) * scale;
#pragma unroll
                for (int bj = 0; bj < 2; ++bj) {
                    const int c = u.pn * 256 + bj * 128 + wc * 32 + 8 * fq;
                    *(u32x4*)(O + (size_t)row * ldc + c) = pack8(acc[ai][bj][m][0] * s, acc[ai][bj][m][1] * s);
                }
            }
    }
};
struct EpiSwiGLU {
    static constexpr bool PERM = true, AFTER_DRAIN = false;
    bf16_t* HID; const float* SS;
    __device__ __forceinline__ void operator()(const f32x4 (&acc)[2][2][4][2], const Unit& u, int wr, int wc, int fr, int fq) const {
#pragma unroll
        for (int ai = 0; ai < 2; ++ai)
#pragma unroll
            for (int m = 0; m < 4; ++m) {
                const int row = u.pm * 256 + ai * 128 + wr * 64 + m * 16 + fr;
                const float s = row_rs(SS, row);
                f32x4 h0, h1;
#pragma unroll
                for (int j = 0; j < 4; ++j) {
                    const float g0 = acc[ai][0][m][0][j] * s, u0 = acc[ai][1][m][0][j] * s, g1 = acc[ai][0][m][1][j] * s, u1 = acc[ai][1][m][1][j] * s;
                    h0[j] = g0 * fsigmoid(g0) * u0; h1[j] = g1 * fsigmoid(g1) * u1;
                }
                *(u32x4*)(HID + (size_t)row * FF + u.pn * 128 + wc * 32 + 8 * fq) = pack8(h0, h1);
            }
    }
};

struct Frame {
    LAS unsigned char* lds;
    int tid, lane, wave, G, bid;
    const float* const* in;
    float* out; unsigned char* ws;
};
enum { I_XP = 0, I_XS, I_STATE, I_CSK, I_CSV, I_CMK, I_CMV, I_MEMP, I_NMIX, I_WIN, I_LB, I_ONORM, I_SINKS, I_RELB, I_WOUT, I_NXATT, I_NMEM,
       I_WMQ, I_WMK, I_WMV, I_WMO, I_NFFN, I_WGATE, I_WUP, I_WDOWN, I_NFINAL };

__device__ __forceinline__ void p0_tr_item(const float* __restrict__ W, int K, int N, bf16_t* WT, int k0, int n0, int drow0, const float* __restrict__ scale, LAS float* scr, int lane) {
#pragma unroll 8
    for (int i = 0; i < 32; ++i) { const int kk = 2 * i + (lane >> 5); float v = W[(size_t)(k0 + kk) * N + n0 + (lane & 31)]; if (scale) v *= scale[k0 + kk]; scr[kk * 33 + (lane & 31)] = v; }
    LDS_WAIT(); asm volatile("" ::: "memory");
    const int c = lane & 7;
#pragma unroll
    for (int j = 0; j < 4; ++j) { const int n = (lane >> 3) + 8 * j; const LAS float* s = scr + (8 * c) * 33 + n;
        u32x4 o; o.x = cvtpk(s[0 * 33], s[1 * 33]); o.y = cvtpk(s[2 * 33], s[3 * 33]); o.z = cvtpk(s[4 * 33], s[5 * 33]); o.w = cvtpk(s[6 * 33], s[7 * 33]);
        *(u32x4*)(WT + (size_t)(drow0 + n) * K + k0 + 8 * c) = o; }
    LDS_WAIT(); asm volatile("" ::: "memory");
}
__device__ __forceinline__ void p0_rms_row(const float* xrow, const float* w, bf16_t* orow, int lane) {
    const f32x4* xr = (const f32x4*)xrow + lane; const f32x4* wr = (const f32x4*)w + lane;
    f32x4 v[8]; float s = 0.f;
#pragma unroll
    for (int j = 0; j < 8; ++j) { v[j] = xr[64 * j]; s += (v[j][0] * v[j][0] + v[j][1] * v[j][1]) + (v[j][2] * v[j][2] + v[j][3] * v[j][3]); }
    const float rs = __builtin_amdgcn_rsqf(wave_sum(s) * (1.0f / DM) + RMS_EPS);
    u32x2* o8 = (u32x2*)orow + lane;
#pragma unroll
    for (int j = 0; j < 8; ++j) { const f32x4 ww = wr[64 * j]; f32x4 y; y[0] = v[j][0] * rs * ww[0]; y[1] = v[j][1] * rs * ww[1]; y[2] = v[j][2] * rs * ww[2]; y[3] = v[j][3] * rs * ww[3]; o8[64 * j] = pack4(y); }
}
__device__ __forceinline__ int rel_bucket(int n) {
    if (n < 16) return n;
    int b = 16 + (int)(__logf((float)n * (1.0f / 16.0f)) / 2.0794415416798357f * 16.0f);
    return b < 31 ? b : 31;
}
constexpr int CV_IN = 32 * (NIN / 32), CV_OUT = 32 * 64, CV_MQ = 32 * 16, CV_MO = 8 * 64, CV_G = 32 * (FF / 32), CV_DN = (FF / 64) * 64;
constexpr int CV_EARLY = CV_IN + CV_OUT + 3 * CV_MQ, CV_ALL = CV_EARLY + CV_MO + 2 * CV_G + CV_DN;
__device__ __forceinline__ void p0_convert(Frame& F, int it0, int it1, int gw, int NGW) {
    LAS float* scr = (LAS float*)(F.lds + F.wave * 16384);
    unsigned char* ws = F.ws;
    constexpr int I_IN = CV_IN, I_OUT = CV_OUT, I_MQ = CV_MQ, I_MO = CV_MO, I_G = CV_G;
    for (int it = it0 + gw; it < it1; it += NGW) {
        int r = it;
        if (r < I_IN) { const int nb = NIN / 32, kb = r / nb, n0 = (r % nb) * 32; p0_tr_item(F.in[I_WIN], DM, NIN, (bf16_t*)(ws + WS_WIN), kb * 64, n0, n0, nullptr, scr, F.lane); continue; } r -= I_IN;
        if (r < I_OUT) { const int kb = r / 64, n0 = (r % 64) * 32; p0_tr_item(F.in[I_WOUT], DM, DM, (bf16_t*)(ws + WS_WOUT), kb * 64, n0, n0, nullptr, scr, F.lane); continue; } r -= I_OUT;
        if (r < I_MQ) { const int kb = r / 16, n0 = (r % 16) * 32; p0_tr_item(F.in[I_WMQ], DM, MEMW, (bf16_t*)(ws + WS_WMQ), kb * 64, n0, n0, F.in[I_NXATT], scr, F.lane); continue; } r -= I_MQ;
        if (r < I_MQ) { const int kb = r / 16, n0 = (r % 16) * 32; p0_tr_item(F.in[I_WMK], DM, MEMW, (bf16_t*)(ws + WS_WMKV), kb * 64, n0, n0, nullptr, scr, F.lane); continue; } r -= I_MQ;
        if (r < I_MQ) { const int kb = r / 16, n0 = (r % 16) * 32; p0_tr_item(F.in[I_WMV], DM, MEMW, (bf16_t*)(ws + WS_WMKV), kb * 64, n0, 512 + n0, nullptr, scr, F.lane); continue; } r -= I_MQ;
        if (r < I_MO) { const int kb = r / 64, n0 = (r % 64) * 32; p0_tr_item(F.in[I_WMO], MEMW, DM, (bf16_t*)(ws + WS_WMO), kb * 64, n0, n0, nullptr, scr, F.lane); continue; } r -= I_MO;
        if (r < 2 * I_G) { const int up = r >= I_G; if (up) r -= I_G; const int nb = FF / 32, kb = r / nb, n0 = (r % nb) * 32;
            p0_tr_item(F.in[up ? I_WUP : I_WGATE], DM, FF, (bf16_t*)(ws + WS_WGU), kb * 64, n0, (n0 >> 7) * 256 + (n0 & 127) + (up ? 128 : 0), F.in[I_NFFN], scr, F.lane); continue; } r -= 2 * I_G;
        { const int kb = r / 64, n0 = (r % 64) * 32; p0_tr_item(F.in[I_WDOWN], FF, DM, (bf16_t*)(ws + WS_WDN), kb * 64, n0, n0, nullptr, scr, F.lane); }
    }
}
__device__ __forceinline__ void p0_prologue(Frame& F, bool all_weights) {
    const int gw = F.bid * NWAVES + F.wave, NGW = F.G * NWAVES;
    unsigned char* ws = F.ws;
    p0_convert(F, 0, all_weights ? CV_ALL : CV_EARLY, gw, NGW);
    for (int m = gw; m < TT + 1024; m += NGW) {
        if (m < TP) p0_rms_row(F.in[I_XP] + (size_t)m * DM, F.in[I_NMIX], (bf16_t*)(ws + WS_XB) + (size_t)m * DM, F.lane);
        else if (m < TT) p0_rms_row(F.in[I_XS] + (size_t)(m - TP) * DM, F.in[I_NMIX], (bf16_t*)(ws + WS_XB) + (size_t)m * DM, F.lane);
        else p0_rms_row(F.in[I_MEMP] + (size_t)(m - TT) * DM, F.in[I_NMEM], (bf16_t*)(ws + WS_MN) + (size_t)(m - TT) * DM, F.lane);
    }
    float* LBt = (float*)(ws + WS_TAB); float* BT = (float*)(ws + WS_TAB + 8192);
    const int gt = F.bid * NTHREADS + F.tid, NGT = F.G * NTHREADS;
    for (int i = gt; i < 1024 + 16 * 160; i += NGT) {
        if (i < 1024) { const float l0 = F.in[I_LB][i], l1 = F.in[I_LB][1024 + i]; LBt[i] = 1.0f / (1.0f + __expf(l1 - l0)); }
        else { const int j = i - 1024, h = j / 160, ix = j % 160, dist = 143 - ix;
            BT[j] = (dist >= 0 && dist < 128) ? F.in[I_RELB][rel_bucket(dist) * 16 + h] * LOG2E : -INFINITY; }
    }
}

constexpr int PREP_RS = 1032;
__device__ __forceinline__ void hgrn_prep(Frame& F, int j0, int j1, int stride, bool stepmajor) {
    unsigned char* ws = F.ws;
    const float* QF = F.out; const float* GF = F.out + (size_t)TT * 1024; const bf16_t* VB = (const bf16_t*)(F.out + O_SST);
    bf16_t* QIN = (bf16_t*)(ws + WS_QIN); bf16_t* KT = (bf16_t*)(ws + WS_KT); bf16_t* VT = (bf16_t*)(ws + WS_VT); bf16_t* PSC = (bf16_t*)(ws + WS_PSC); float* DEC = (float*)(ws + WS_DEC);
    LAS bf16_t* lq = (LAS bf16_t*)F.lds; LAS bf16_t* lk = lq + 16 * PREP_RS;
    const int l15 = F.lane & 15, g4 = F.lane >> 4;
    for (int j = j0; j < j1; j += stride) {
        const int ch = (stepmajor && j < NCHP) ? ((j & 3) * (NCHP / 4) + (j >> 2)) : j;
        const int nv = ch < NCHP ? 16 : 4; const int row0 = ch < NCHP ? ch * 16 : TP + (ch - NCHP) * 4;
#pragma unroll 1
        for (int pass = 0; pass < 2; ++pass) {
            const int cidx = F.tid + 512 * pass;
            float g[16], q[16]; unsigned short vv[16];
#pragma unroll
            for (int t = 0; t < 16; ++t) {
                if (t < nv) { g[t] = GF[(size_t)(row0 + t) * 1024 + cidx]; q[t] = QF[(size_t)(row0 + t) * 1024 + cidx]; vv[t] = VB[(size_t)(row0 + t) * 1024 + cidx]; }
                else { g[t] = 0.f; q[t] = 0.f; vv[t] = 0; }
            }
            float G = 0.f; unsigned kd[8], vt[8];
#pragma unroll
            for (int t = 0; t < 16; t += 2) {
                float qi[2], kk[2];
#pragma unroll
                for (int z = 0; z < 2; ++z) {
                    const float gt = g[t + z]; G += gt;
                    qi[z] = q[t + z] * fexp(G);
                    kk[z] = (1.0f - fexp(gt)) * fexp(fminf(-G, 80.0f));
                    lq[(t + z) * PREP_RS + cidx] = f2bf(qi[z]); lk[(t + z) * PREP_RS + cidx] = f2bf(kk[z]);
                }
                kd[t >> 1] = cvtpk(kk[0], kk[1]); vt[t >> 1] = (unsigned)vv[t] | ((unsigned)vv[t + 1] << 16);
            }
            DEC[(size_t)ch * 1024 + cidx] = fexp(G);
            u32x4* kp = (u32x4*)(KT + ((size_t)ch * 1024 + cidx) * 16); kp[0] = (u32x4){kd[0], kd[1], kd[2], kd[3]}; kp[1] = (u32x4){kd[4], kd[5], kd[6], kd[7]};
            u32x4* vp = (u32x4*)(VT + ((size_t)ch * 1024 + cidx) * 16); vp[0] = (u32x4){vt[0], vt[1], vt[2], vt[3]}; vp[1] = (u32x4){vt[4], vt[5], vt[6], vt[7]};
        }
        __syncthreads();
#pragma unroll
        for (int i = 0; i < 4; ++i) { const int idx = F.tid + 512 * i, t = idx >> 7, c8 = idx & 127;
            *(u32x4*)(QIN + ((size_t)ch * 16 + t) * 1024 + c8 * 8) = *(const LAS u32x4*)(lq + t * PREP_RS + c8 * 8); }
        {
            const int h = F.wave; f32x4 acc = {0.f, 0.f, 0.f, 0.f};
#pragma unroll
            for (int kk = 0; kk < 4; ++kk) {
                const bf16x8 a = *(const LAS bf16x8*)(lq + l15 * PREP_RS + h * 128 + 32 * kk + 8 * g4);
                const bf16x8 b = *(const LAS bf16x8*)(lk + l15 * PREP_RS + h * 128 + 32 * kk + 8 * g4);
                acc = __builtin_amdgcn_mfma_f32_16x16x32_bf16(a, b, acc, 0, 0, 0);
            }
            bf16_t* pd = PSC + ((size_t)ch * 8 + h) * 256;
#pragma unroll
            for (int r = 0; r < 4; ++r) { const int t = 4 * g4 + r, s = l15; pd[t * 16 + s] = (s <= t) ? f2bf(acc[r]) : (bf16_t)0; }
        }
        __syncthreads();
    }
}

__device__ __forceinline__ void flag_signal(unsigned* p) {
    asm volatile("s_waitcnt vmcnt(0)" ::: "memory"); __syncthreads();
    if (threadIdx.x == 0) { __builtin_amdgcn_fence(__ATOMIC_RELEASE, "agent"); asm volatile("s_waitcnt vmcnt(0)" ::: "memory"); __hip_atomic_fetch_add(p, 1u, __ATOMIC_RELAXED, __HIP_MEMORY_SCOPE_AGENT); }
}
__device__ __forceinline__ void flag_wait(unsigned* p, unsigned need) {
    if (threadIdx.x == 0) {
        unsigned sp = 0; while (__hip_atomic_load(p, __ATOMIC_RELAXED, __HIP_MEMORY_SCOPE_AGENT) < need) { __builtin_amdgcn_s_sleep(2); if (++sp > (1u << 22)) break; }
        __builtin_amdgcn_fence(__ATOMIC_ACQUIRE, "agent"); asm volatile("s_waitcnt vmcnt(0)" ::: "memory");
    }
    __syncthreads();
}
constexpr int SC_QS = 136;
constexpr int SC_QI = 0, SC_KT = 16 * SC_QS * 2, SC_VT = SC_KT + 4096, SC_P = SC_VT + 4096, SC_DEC = SC_P + 512, SC_GATE = SC_DEC + 512, SC_BUF = SC_GATE + 16 * SC_QS * 2;
constexpr int SC_RED = 2 * SC_BUF;
static_assert(SC_RED + 1024 <= LDS_BYTES && SC_BUF % 16 == 0, "scan LDS");
struct ScanPf { u32x4 a, b, c; };
struct ScanSrc { const unsigned char* a; const unsigned char* b; const unsigned char* c; unsigned oa, ob, oc; };
__device__ __forceinline__ ScanSrc scan_src(const Frame& F, int ch0, int h, int grow0, int ngr) {
    const unsigned char* ws = F.ws; const int tid = F.tid; ScanSrc s;
    const bf16_t* QIN = (const bf16_t*)(ws + WS_QIN); const bf16_t* KT = (const bf16_t*)(ws + WS_KT); const bf16_t* VT = (const bf16_t*)(ws + WS_VT);
    const bf16_t* PSC = (const bf16_t*)(ws + WS_PSC); const float* DEC = (const float*)(ws + WS_DEC); const bf16_t* GATE = (const bf16_t*)(ws + WS_GATE);
    if (tid < 256) { const int t = tid >> 4, p = tid & 15;
        s.a = (const unsigned char*)(QIN + ((size_t)ch0 * 16 + t) * 1024 + h * 128 + p * 8); s.oa = SC_QI + (t * SC_QS + p * 8) * 2;
        s.b = (const unsigned char*)(VT + ((size_t)ch0 * 1024 + h * 128) * 16 + tid * 8); s.ob = SC_VT + tid * 16;
    } else { const int i = tid - 256, t = i >> 4, p = i & 15; const int tr = t < ngr ? t : ngr - 1;
        s.a = (const unsigned char*)(KT + ((size_t)ch0 * 1024 + h * 128) * 16 + i * 8); s.oa = SC_KT + i * 16;
        s.b = (const unsigned char*)(GATE + (size_t)(grow0 + tr) * 1024 + h * 128 + p * 8); s.ob = SC_GATE + (t * SC_QS + p * 8) * 2;
    }
    if (tid < 32) { s.c = (const unsigned char*)(PSC + ((size_t)ch0 * 8 + h) * 256 + tid * 8); s.oc = SC_P + tid * 16; }
    else { const int i = (tid - 32) & 31; s.c = (const unsigned char*)(DEC + (size_t)ch0 * 1024 + h * 128 + i * 4); s.oc = SC_DEC + i * 16; }
    return s;
}
__device__ __forceinline__ void scan_fetch(ScanPf& pf, const ScanSrc& s, const Frame& F, int step) {
    pf.a = *(const u32x4*)(s.a + (size_t)step * 32768); pf.b = *(const u32x4*)(s.b + (size_t)step * 32768);
    if (F.tid < 64) pf.c = *(const u32x4*)(s.c + (size_t)step * 4096);
}
__device__ __forceinline__ void scan_stash(const ScanPf& pf, const ScanSrc& s, const Frame& F, int buf) {
    LAS unsigned char* B = F.lds + buf * SC_BUF;
    *(LAS u32x4*)(B + s.oa) = pf.a; *(LAS u32x4*)(B + s.ob) = pf.b;
    if (F.tid < 64) *(LAS u32x4*)(B + s.oc) = pf.c;
}
template <int CTRL> __device__ __forceinline__ float dpp_mov(float v) { return __int_as_float(__builtin_amdgcn_update_dpp(0, __float_as_int(v), CTRL, 0xF, 0xF, true)); }
__device__ __forceinline__ float row16_sum(float v) { v += dpp_mov<0xB1>(v); v += dpp_mov<0x4E>(v); v += dpp_mov<0x141>(v); v += dpp_mov<0x140>(v); return v; }
constexpr int SC_ST = SC_RED + 1024, SC_STS = 132;
static_assert(SC_ST + 128 * SC_STS * 4 <= LDS_BYTES, "scan LDS (state image)");
template <int DBG>
__device__ __forceinline__ void hgrn_scan_t(Frame& F, int ch0, int nsteps, int h, int mrow0, int nvalid, const float* S0, float* Sout, bf16_t* MIXP, int mixld, float* DBGP) {
    const int lane = F.lane, l15 = lane & 15, g4 = lane >> 4, e0 = 16 * F.wave;
    bf16_t* MIX = MIXP;
    const float onw = F.in[I_ONORM][e0 + l15];
    LAS float* RED = (LAS float*)(F.lds + SC_RED);
    LAS float* ST = (LAS float*)(F.lds + SC_ST);
    ScanPf pf;
    __syncthreads();
    const ScanSrc src = scan_src(F, ch0, h, mrow0, nvalid);
    scan_fetch(pf, src, F, 0); scan_stash(pf, src, F, 0);
    if (nsteps > 1) scan_fetch(pf, src, F, 1);
    f32x4 S[8];
    if (S0) {
#pragma unroll
        for (int i = 0; i < 8; ++i) { const int idx = F.tid + 512 * i, c = idx >> 5, e4 = idx & 31; *(LAS f32x4*)(ST + c * SC_STS + e4 * 4) = *(const f32x4*)(S0 + (size_t)c * 128 + e4 * 4); }
    }
    __syncthreads();
#pragma unroll
    for (int mt = 0; mt < 8; ++mt)
#pragma unroll
        for (int r = 0; r < 4; ++r) S[mt][r] = S0 ? ST[(16 * mt + 4 * g4 + r) * SC_STS + e0 + l15] : 0.f;
    f32x4 o_prev = {0.f, 0.f, 0.f, 0.f}, gate_prev = {0.f, 0.f, 0.f, 0.f};
#pragma unroll 1
    for (int n = 0; n <= nsteps; ++n) {
        const int buf = n & 1;
        f32x4 o = {0.f, 0.f, 0.f, 0.f}, gate = {0.f, 0.f, 0.f, 0.f};
        if (n + 1 < nsteps) {
            scan_stash(pf, src, F, buf ^ 1);
            if (n + 2 < nsteps) scan_fetch(pf, src, F, n + 2);
        }
        if (n < nsteps) {
            const LAS unsigned char* B = F.lds + buf * SC_BUF;
            const bf16x4 vt = *(const LAS bf16x4*)(B + SC_VT + ((e0 + l15) * 16 + 4 * g4) * 2);
            const bf16x4 pa = *(const LAS bf16x4*)(B + SC_P + (l15 * 16 + 4 * g4) * 2);
            const f32x4 zz = {0.f, 0.f, 0.f, 0.f};
            f32x4 oq[4];
            const f32x4 op = __builtin_amdgcn_mfma_f32_16x16x16bf16_1k(pa, vt, zz, 0, 0, 0);
#pragma unroll
            for (int kk = 0; kk < 4; ++kk) {
                const bf16x4 q0 = *(const LAS bf16x4*)(B + SC_QI + (l15 * SC_QS + 32 * kk + 4 * g4) * 2);
                const bf16x4 q1 = *(const LAS bf16x4*)(B + SC_QI + (l15 * SC_QS + 32 * kk + 16 + 4 * g4) * 2);
                const bf16x8 qa = {q0[0], q0[1], q0[2], q0[3], q1[0], q1[1], q1[2], q1[3]};
                const u32x4 sb = pack8(S[2 * kk], S[2 * kk + 1]);
                oq[kk] = __builtin_amdgcn_mfma_f32_16x16x32_bf16(qa, __builtin_bit_cast(bf16x8, sb), zz, 0, 0, 0);
            }
            o = (oq[0] + oq[2]) + op; const f32x4 ob = oq[1] + oq[3];
#pragma unroll
            for (int mt = 0; mt < 8; ++mt) {
                const bf16x4 kt = *(const LAS bf16x4*)(B + SC_KT + ((16 * mt + l15) * 16 + 4 * g4) * 2);
                const f32x4 dc = *(const LAS f32x4*)(B + SC_DEC + (16 * mt + 4 * g4) * 4);
                S[mt] = __builtin_amdgcn_mfma_f32_16x16x16bf16_1k(kt, vt, S[mt], 0, 0, 0);
                S[mt] = S[mt] * dc;
            }
            o = o + ob;
            if constexpr (DBG == 1) {
#pragma unroll
                for (int r = 0; r < 4; ++r) DBGP[(size_t)(mrow0 + 16 * n + 4 * g4 + r) * 1024 + h * 128 + e0 + l15] = o[r];
            }
#pragma unroll
            for (int r = 0; r < 4; ++r) {
                gate[r] = bf2f(*(const LAS unsigned short*)(B + SC_GATE + ((4 * g4 + r) * SC_QS + e0 + l15) * 2));
                const float ss = row16_sum(o[r] * o[r]);
                if (l15 == 0) RED[(buf * 8 + F.wave) * 16 + 4 * g4 + r] = ss;
            }
        }
        if (n > 0) {
            const int pb = (n - 1) & 1;
#pragma unroll
            for (int r = 0; r < 4; ++r) {
                const int t = 4 * g4 + r; float tot = 0.f;
#pragma unroll
                for (int w = 0; w < 8; ++w) tot += RED[(pb * 8 + w) * 16 + t];
                const float rs = __builtin_amdgcn_rsqf(tot * (1.0f / 128.0f) + RMS_EPS);
                if constexpr (DBG == 2) DBGP[(size_t)(mrow0 + 16 * (n - 1) + t) * 1024 + h * 128 + e0 + l15] = tot;
                if constexpr (DBG == 3) DBGP[(size_t)(mrow0 + 16 * (n - 1) + t) * 1024 + h * 128 + e0 + l15] = gate_prev[r];
                if constexpr (DBG == 4) DBGP[(size_t)(mrow0 + 16 * (n - 1) + t) * 1024 + h * 128 + e0 + l15] = o_prev[r];
                if (t < nvalid) MIX[(size_t)(mrow0 + 16 * (n - 1) + t) * mixld + h * 128 + e0 + l15] = f2bf(o_prev[r] * rs * onw * gate_prev[r]);
            }
        }
        o_prev = o; gate_prev = gate;
        __syncthreads();
    }
#pragma unroll
    for (int mt = 0; mt < 8; ++mt)
#pragma unroll
        for (int r = 0; r < 4; ++r) ST[(16 * mt + 4 * g4 + r) * SC_STS + e0 + l15] = S[mt][r];
    __syncthreads();
#pragma unroll
    for (int i = 0; i < 8; ++i) { const int idx = F.tid + 512 * i, c = idx >> 5, e4 = idx & 31; *(f32x4*)(Sout + (size_t)c * 128 + e4 * 4) = *(const LAS f32x4*)(ST + c * SC_STS + e4 * 4); }
}


template <int DBG>
__device__ __forceinline__ void hgrn_scan_pd_t(Frame& F, int ch0, int nsteps, int h, int mrow0, int nvalid, const float* S0, float* Sout, bf16_t* MIXP, int mixld, float* DBGP) {
    const int lane = F.lane, l15 = lane & 15, g4 = lane >> 4, e0 = 16 * F.wave;
    bf16_t* MIX = MIXP;
    const float onw = F.in[I_ONORM][e0 + l15];
    LAS float* RED = (LAS float*)(F.lds + SC_RED);
    LAS float* ST = (LAS float*)(F.lds + SC_ST);
    constexpr int PD = 2;
    ScanPf pf[PD];
    __syncthreads();
    const ScanSrc src = scan_src(F, ch0, h, mrow0, nvalid);
#pragma unroll
    for (int j = 0; j < PD; ++j) if (j < nsteps) scan_fetch(pf[j], src, F, j);
    scan_stash(pf[0], src, F, 0);
    if (PD < nsteps) scan_fetch(pf[0], src, F, PD);
    f32x4 S[8];
    if (S0) {
#pragma unroll
        for (int i = 0; i < 8; ++i) { const int idx = F.tid + 512 * i, c = idx >> 5, e4 = idx & 31; *(LAS f32x4*)(ST + c * SC_STS + e4 * 4) = *(const f32x4*)(S0 + (size_t)c * 128 + e4 * 4); }
    }
    __syncthreads();
#pragma unroll
    for (int mt = 0; mt < 8; ++mt)
#pragma unroll
        for (int r = 0; r < 4; ++r) S[mt][r] = S0 ? ST[(16 * mt + 4 * g4 + r) * SC_STS + e0 + l15] : 0.f;
    f32x4 o_prev = {0.f, 0.f, 0.f, 0.f}, gate_prev = {0.f, 0.f, 0.f, 0.f};
#pragma unroll 1
    for (int n = 0; n <= nsteps; ++n) {
        const int buf = n & 1;
        f32x4 o = {0.f, 0.f, 0.f, 0.f}, gate = {0.f, 0.f, 0.f, 0.f};
        if (n + 1 < nsteps) {
            const bool more = n + 1 + PD < nsteps;
            if (((n + 1) & 1) == 0) { scan_stash(pf[0], src, F, buf ^ 1); if (more) scan_fetch(pf[0], src, F, n + 1 + PD); }
            else { scan_stash(pf[1], src, F, buf ^ 1); if (more) scan_fetch(pf[1], src, F, n + 1 + PD); }
        }
        if (n < nsteps) {
            const LAS unsigned char* B = F.lds + buf * SC_BUF;
            const bf16x4 vt = *(const LAS bf16x4*)(B + SC_VT + ((e0 + l15) * 16 + 4 * g4) * 2);
            const bf16x4 pa = *(const LAS bf16x4*)(B + SC_P + (l15 * 16 + 4 * g4) * 2);
            f32x4 ob = {0.f, 0.f, 0.f, 0.f};
            o = __builtin_amdgcn_mfma_f32_16x16x16bf16_1k(pa, vt, o, 0, 0, 0);
#pragma unroll
            for (int kk = 0; kk < 4; ++kk) {
                const bf16x4 q0 = *(const LAS bf16x4*)(B + SC_QI + (l15 * SC_QS + 32 * kk + 4 * g4) * 2);
                const bf16x4 q1 = *(const LAS bf16x4*)(B + SC_QI + (l15 * SC_QS + 32 * kk + 16 + 4 * g4) * 2);
                const bf16x8 qa = {q0[0], q0[1], q0[2], q0[3], q1[0], q1[1], q1[2], q1[3]};
                const u32x4 sb = pack8(S[2 * kk], S[2 * kk + 1]);
                if (kk & 1) ob = __builtin_amdgcn_mfma_f32_16x16x32_bf16(qa, __builtin_bit_cast(bf16x8, sb), ob, 0, 0, 0);
                else o = __builtin_amdgcn_mfma_f32_16x16x32_bf16(qa, __builtin_bit_cast(bf16x8, sb), o, 0, 0, 0);
            }
#pragma unroll
            for (int mt = 0; mt < 8; ++mt) {
                const bf16x4 kt = *(const LAS bf16x4*)(B + SC_KT + ((16 * mt + l15) * 16 + 4 * g4) * 2);
                const f32x4 dc = *(const LAS f32x4*)(B + SC_DEC + (16 * mt + 4 * g4) * 4);
                S[mt] = __builtin_amdgcn_mfma_f32_16x16x16bf16_1k(kt, vt, S[mt], 0, 0, 0);
                S[mt] = S[mt] * dc;
            }
            o = o + ob;
            if constexpr (DBG == 1) {
#pragma unroll
                for (int r = 0; r < 4; ++r) DBGP[(size_t)(mrow0 + 16 * n + 4 * g4 + r) * 1024 + h * 128 + e0 + l15] = o[r];
            }
#pragma unroll
            for (int r = 0; r < 4; ++r) {
                gate[r] = bf2f(*(const LAS unsigned short*)(B + SC_GATE + ((4 * g4 + r) * SC_QS + e0 + l15) * 2));
                const float ss = row16_sum(o[r] * o[r]);
                if (l15 == 0) RED[(buf * 8 + F.wave) * 16 + 4 * g4 + r] = ss;
            }
        }
        if (n > 0) {
            const int pb = (n - 1) & 1;
#pragma unroll
            for (int r = 0; r < 4; ++r) {
                const int t = 4 * g4 + r; float tot = 0.f;
#pragma unroll
                for (int w = 0; w < 8; ++w) tot += RED[(pb * 8 + w) * 16 + t];
                const float rs = __builtin_amdgcn_rsqf(tot * (1.0f / 128.0f) + RMS_EPS);
                if constexpr (DBG == 2) DBGP[(size_t)(mrow0 + 16 * (n - 1) + t) * 1024 + h * 128 + e0 + l15] = tot;
                if constexpr (DBG == 3) DBGP[(size_t)(mrow0 + 16 * (n - 1) + t) * 1024 + h * 128 + e0 + l15] = gate_prev[r];
                if constexpr (DBG == 4) DBGP[(size_t)(mrow0 + 16 * (n - 1) + t) * 1024 + h * 128 + e0 + l15] = o_prev[r];
                if (t < nvalid) MIX[(size_t)(mrow0 + 16 * (n - 1) + t) * mixld + h * 128 + e0 + l15] = f2bf(o_prev[r] * rs * onw * gate_prev[r]);
            }
        }
        o_prev = o; gate_prev = gate;
        __syncthreads();
    }
#pragma unroll
    for (int mt = 0; mt < 8; ++mt)
#pragma unroll
        for (int r = 0; r < 4; ++r) ST[(16 * mt + 4 * g4 + r) * SC_STS + e0 + l15] = S[mt][r];
    __syncthreads();
#pragma unroll
    for (int i = 0; i < 8; ++i) { const int idx = F.tid + 512 * i, c = idx >> 5, e4 = idx & 31; *(f32x4*)(Sout + (size_t)c * 128 + e4 * 4) = *(const LAS f32x4*)(ST + c * SC_STS + e4 * 4); }
}


#ifndef HY_VFIN
#define HY_VFIN 1
#endif
#ifndef HY_VST
#define HY_VST 1
#endif
#ifndef HY_VPART
#define HY_VPART 15
#endif
#ifndef HY_VLDSW
#define HY_VLDSW 1
#endif
#ifndef HY_VISSUE
#define HY_VISSUE 1
#endif
#ifndef HY_VCOMP
#define HY_VCOMP 1
#endif
#ifndef HY_VWRITE
#define HY_VWRITE 1
#endif
constexpr int DS_QSB = 272, DS_SLOT = 18432, DS_R = 6;
constexpr int DS_RED = DS_R * DS_SLOT;
constexpr int DS_OUT = DS_RED + 1024;
constexpr int DS_ST = 0, DS_STS = 132;
static_assert(DS_OUT + 8192 <= LDS_BYTES - 64 && 128 * DS_STS * 4 <= DS_RED && DS_SLOT % 1024 == 0, "dma scan LDS");
#ifdef HY_NO_DMA
extern __shared__ __attribute__((aligned(16))) unsigned char lds_raw2[];
__device__ __forceinline__ void glds16(const void* gsrc, unsigned lds_dst) { u32x4 v = *(const u32x4*)gsrc; if (HY_VLDSW) *(LAS u32x4*)((LAS unsigned char*)lds_raw2 + lds_dst + 16 * (threadIdx.x & 63)) = v; else asm volatile("" :: "v"(v)); }
__device__ __forceinline__ void glds4(const void* gsrc, unsigned lds_dst) { unsigned v = *(const unsigned*)gsrc; if (HY_VLDSW) *(LAS unsigned*)((LAS unsigned char*)lds_raw2 + lds_dst + 4 * (threadIdx.x & 63)) = v; else asm volatile("" :: "v"(v)); }
#else
__device__ __forceinline__ void glds16(const void* gsrc, unsigned lds_dst) { unsigned keep;
    asm volatile("s_mov_b32 %0, m0\n\ts_mov_b32 m0, %2\n\ts_nop 0\n\tglobal_load_lds_dwordx4 %1, off\n\ts_mov_b32 m0, %0" : "=&s"(keep) : "v"(gsrc), "s"(lds_dst) : "memory"); }
__device__ __forceinline__ void glds4(const void* gsrc, unsigned lds_dst) { unsigned keep;
    asm volatile("s_mov_b32 %0, m0\n\ts_mov_b32 m0, %2\n\ts_nop 0\n\tglobal_load_lds_dword %1, off\n\ts_mov_b32 m0, %0" : "=&s"(keep) : "v"(gsrc), "s"(lds_dst) : "memory"); }
#endif
#ifdef HY_DSSYNC
#define DS_BAR() __syncthreads()
#else
#define DS_BAR() do { asm volatile("s_waitcnt lgkmcnt(0)" ::: "memory"); __builtin_amdgcn_s_barrier(); asm volatile("" ::: "memory"); } while (0)
#endif
template <int DBG>
__device__ __forceinline__ void hgrn_scan_dma_t(Frame& F, int ch0, int nsteps, int h, int mrow0, int nvalid, const float* S0, float* Sout, bf16_t* MIXP, int mixld, float* DBGP) {
    const int lane = F.lane, l15 = lane & 15, g4 = lane >> 4, e0 = 16 * F.wave, w = F.wave;
    const unsigned char* ws = F.ws;
    bf16_t* MIX = MIXP;
    const float onw = F.in[I_ONORM][e0 + l15];
    LAS float* RED = (LAS float*)(F.lds + DS_RED);
    LAS float* ST = (LAS float*)(F.lds + DS_ST);
    LAS bf16_t* OUTB = (LAS bf16_t*)(F.lds + DS_OUT);
    const int wq = w & 3;
    const unsigned char* sq = ws + WS_QIN + (((size_t)ch0 * 16 + 4 * wq) * 1024 + h * 128) * 2 + lane * 4;
    const unsigned char* sk = ws + WS_KT + (((size_t)ch0 * 1024 + h * 128) * 16 + (wq * 64 + lane) * 8) * 2;
    const unsigned char* sv = ws + WS_VT + (((size_t)ch0 * 1024 + h * 128) * 16 + (wq * 64 + lane) * 8) * 2;
    const unsigned char* sg = ws + WS_GATE + ((size_t)mrow0 * 1024 + h * 128) * 2 + lane * 4;
    const unsigned char* sc = lane < 32 ? ws + WS_PSC + (((size_t)ch0 * 8 + h) * 256 + lane * 8) * 2 : ws + WS_DEC + ((size_t)ch0 * 1024 + h * 128 + (lane - 32) * 4) * 4;
    int grow[4];
#pragma unroll
    for (int r = 0; r < 4; ++r) { const int t = 4 * wq + r; grow[r] = (t < nvalid ? t : nvalid - 1) * 2048; }
#ifdef HY_NO_DMA
    const unsigned ring0 = 0u;
#else
    const unsigned ring0 = (unsigned)(uintptr_t)F.lds;
#endif
#define DS_ISSUE(step, slot) do { if (w < 4) { const unsigned so_ = ring0 + (unsigned)__builtin_amdgcn_readfirstlane((int)((slot) * DS_SLOT)); const size_t go_ = (size_t)(step) * 32768; \
        if (HY_VPART & 1) { _Pragma("unroll") for (int r_ = 0; r_ < 4; ++r_) glds4(sq + go_ + r_ * 2048, so_ + SC_QI + (4 * wq + r_) * DS_QSB); } \
        if (HY_VPART & 2) { glds16(sk + go_, so_ + SC_KT + wq * 1024); glds16(sv + go_, so_ + SC_VT + wq * 1024); } \
        if (HY_VPART & 4) { _Pragma("unroll") for (int r_ = 0; r_ < 4; ++r_) glds4(sg + go_ + grow[r_], so_ + SC_GATE + (4 * wq + r_) * DS_QSB); } \
        if ((HY_VPART & 8) && w == 0) glds16(sc + (size_t)(step) * 4096, so_ + SC_P); } } while (0)
    __syncthreads();
    f32x4 S[8];
    if (S0) {
#pragma unroll
        for (int i = 0; i < 8; ++i) { const int idx = F.tid + 512 * i, c = idx >> 5, e4 = idx & 31; *(LAS f32x4*)(ST + c * DS_STS + e4 * 4) = *(const f32x4*)(S0 + (size_t)c * 128 + e4 * 4); }
        __syncthreads();
#pragma unroll
        for (int mt = 0; mt < 8; ++mt)
#pragma unroll
            for (int r = 0; r < 4; ++r) S[mt][r] = ST[(16 * mt + 4 * g4 + r) * DS_STS + e0 + l15];
        __syncthreads();
    } else {
#pragma unroll
        for (int mt = 0; mt < 8; ++mt) S[mt] = (f32x4){0.f, 0.f, 0.f, 0.f};
    }
    if (HY_VISSUE) for (int s = 0; s < DS_R - 1 && s < nsteps; ++s) DS_ISSUE(s, s);
    f32x4 o_prev = {0.f, 0.f, 0.f, 0.f}, gate_prev = {0.f, 0.f, 0.f, 0.f};
    int slot = 0;
#pragma unroll 1
    for (int n = 0; n <= nsteps + 1; ++n) {
        if (w < 4) {
#ifndef HY_DRAIN
            if (n >= DS_R && n + DS_R <= nsteps + 1) { if (w == 0) asm volatile("s_waitcnt vmcnt(44)" ::: "memory"); else asm volatile("s_waitcnt vmcnt(40)" ::: "memory"); }
            else
#endif
            asm volatile("s_waitcnt vmcnt(0)" ::: "memory");
        }
        static_assert(DS_R == 6, "the counted waits above are (DS_R - 2) * 11 and (DS_R - 2) * 10");
        DS_BAR();
        if (HY_VISSUE && n - 1 + DS_R < nsteps) { const int ps = slot == 0 ? DS_R - 1 : slot - 1; DS_ISSUE(n - 1 + DS_R, ps); }
        const int buf = n & 1;
        f32x4 o = {0.f, 0.f, 0.f, 0.f}, gate = {0.f, 0.f, 0.f, 0.f};
        if (HY_VCOMP && n < nsteps) {
            const LAS unsigned char* B = F.lds + slot * DS_SLOT;
            const bf16x4 vt = *(const LAS bf16x4*)(B + SC_VT + ((e0 + l15) * 16 + 4 * g4) * 2);
            const bf16x4 pa = *(const LAS bf16x4*)(B + SC_P + (l15 * 16 + 4 * g4) * 2);
            const f32x4 zz = {0.f, 0.f, 0.f, 0.f};
            f32x4 oq[4];
            const f32x4 op = __builtin_amdgcn_mfma_f32_16x16x16bf16_1k(pa, vt, zz, 0, 0, 0);
#pragma unroll
            for (int kk = 0; kk < 4; ++kk) {
                const bf16x4 q0 = *(const LAS bf16x4*)(B + SC_QI + l15 * DS_QSB + (32 * kk + 4 * g4) * 2);
                const bf16x4 q1 = *(const LAS bf16x4*)(B + SC_QI + l15 * DS_QSB + (32 * kk + 16 + 4 * g4) * 2);
                const bf16x8 qa = {q0[0], q0[1], q0[2], q0[3], q1[0], q1[1], q1[2], q1[3]};
                const u32x4 sb8 = pack8(S[2 * kk], S[2 * kk + 1]);
                oq[kk] = __builtin_amdgcn_mfma_f32_16x16x32_bf16(qa, __builtin_bit_cast(bf16x8, sb8), zz, 0, 0, 0);
            }
            o = (oq[0] + oq[2]) + op; const f32x4 ob = oq[1] + oq[3];
#pragma unroll
            for (int mt = 0; mt < 8; ++mt) {
                const bf16x4 kt = *(const LAS bf16x4*)(B + SC_KT + ((16 * mt + l15) * 16 + 4 * g4) * 2);
                const f32x4 dc4 = *(const LAS f32x4*)(B + SC_DEC + (16 * mt + 4 * g4) * 4);
                S[mt] = __builtin_amdgcn_mfma_f32_16x16x16bf16_1k(kt, vt, S[mt], 0, 0, 0);
                S[mt] = S[mt] * dc4;
            }
            o = o + ob;
            if constexpr (DBG == 1) {
#pragma unroll
                for (int r = 0; r < 4; ++r) DBGP[(size_t)(mrow0 + 16 * n + 4 * g4 + r) * 1024 + h * 128 + e0 + l15] = o[r];
            }
#pragma unroll
            for (int r = 0; r < 4; ++r) {
                const int t = 4 * g4 + r;
                gate[r] = bf2f(*(const LAS unsigned short*)(B + SC_GATE + t * DS_QSB + (e0 + l15) * 2));
                const float ss = row16_sum(o[r] * o[r]);
                if (l15 == 0) RED[(buf * 8 + w) * 16 + t] = ss;
            }
        }
        if (HY_VFIN && n > 0 && n <= nsteps) {
            const int pb = buf ^ 1;
#pragma unroll
            for (int r = 0; r < 4; ++r) {
                const int t = 4 * g4 + r; float tot = 0.f;
#pragma unroll
                for (int ww = 0; ww < 8; ++ww) tot += RED[(pb * 8 + ww) * 16 + t];
                const float rs = __builtin_amdgcn_rsqf(tot * (1.0f / 128.0f) + RMS_EPS);
                if constexpr (DBG == 2) DBGP[(size_t)(mrow0 + 16 * (n - 1) + t) * 1024 + h * 128 + e0 + l15] = tot;
                if constexpr (DBG == 3) DBGP[(size_t)(mrow0 + 16 * (n - 1) + t) * 1024 + h * 128 + e0 + l15] = gate_prev[r];
                if constexpr (DBG == 4) DBGP[(size_t)(mrow0 + 16 * (n - 1) + t) * 1024 + h * 128 + e0 + l15] = o_prev[r];
                OUTB[(buf * 16 + t) * 128 + e0 + l15] = f2bf(o_prev[r] * rs * onw * gate_prev[r]);
            }
        }
        if (n > 1 && w >= 4) {
            const int i = (w - 4) * 64 + lane, t = i >> 4, p = i & 15;
            if (HY_VWRITE && t < nvalid) *(u32x4*)(MIX + (size_t)(mrow0 + 16 * (n - 2) + t) * mixld + h * 128 + p * 8) = *(const LAS u32x4*)(OUTB + ((buf ^ 1) * 16 + t) * 128 + p * 8);
        }
        o_prev = o; gate_prev = gate;
        slot = slot == DS_R - 1 ? 0 : slot + 1;
    }
    asm volatile("s_waitcnt vmcnt(0)" ::: "memory");
    __syncthreads();
    if (HY_VST) {
#pragma unroll
    for (int mt = 0; mt < 8; ++mt)
#pragma unroll
        for (int r = 0; r < 4; ++r) ST[(16 * mt + 4 * g4 + r) * DS_STS + e0 + l15] = S[mt][r];
    }
    __syncthreads();
    if (HY_VWRITE)
#pragma unroll
    for (int i = 0; i < 8; ++i) { const int idx = F.tid + 512 * i, c = idx >> 5, e4 = idx & 31; *(f32x4*)(Sout + (size_t)c * 128 + e4 * 4) = *(const LAS f32x4*)(ST + c * DS_STS + e4 * 4); }
#undef DS_ISSUE
}


constexpr int D2_RED = DS_R * DS_SLOT;
constexpr int D2_RS = D2_RED + 1024;
constexpr int D2_OUT = D2_RS + 128;
static_assert(D2_OUT + 8192 <= LDS_BYTES - 64 && D2_OUT % 16 == 0, "dma2 scan LDS");
template <int N> __device__ __forceinline__ float dpp_bcast(float v) { return __int_as_float(__builtin_amdgcn_update_dpp(0, __float_as_int(v), 0x150 + N, 0xF, 0xF, true)); }
template <int MT> __device__ __forceinline__ void scan_decay(f32x4& s, float d0, float d1) {
    s[0] = s[0] * dpp_bcast<2 * MT>(d0); s[1] = s[1] * dpp_bcast<2 * MT>(d1); s[2] = s[2] * dpp_bcast<2 * MT + 1>(d0); s[3] = s[3] * dpp_bcast<2 * MT + 1>(d1);
}
__device__ __forceinline__ void hgrn_scan_dma2(Frame& F, int ch0, int nsteps, int h, int mrow0, float* Sout, unsigned* rdy, unsigned need, int rdy_step) {
    const int lane = F.lane, l15 = lane & 15, g4 = lane >> 4, e0 = 16 * F.wave, w = F.wave;
    const unsigned char* ws = F.ws;
    bf16_t* MIX = (bf16_t*)(F.ws + WS_MIX);
    const float onw = F.in[I_ONORM][e0 + l15];
    LAS float* RED = (LAS float*)(F.lds + D2_RED);
    LAS float* RS = (LAS float*)(F.lds + D2_RS);
    LAS float* ST = (LAS float*)(F.lds + DS_ST);
    LAS bf16_t* OUTB = (LAS bf16_t*)(F.lds + D2_OUT);
    const int wq = w & 3;
    const unsigned char* sq = ws + WS_QIN + (((size_t)ch0 * 16 + 4 * wq) * 1024 + h * 128) * 2 + lane * 4;
    const unsigned char* sk = ws + WS_KT + (((size_t)ch0 * 1024 + h * 128) * 16 + (wq * 64 + lane) * 8) * 2;
    const unsigned char* sv = ws + WS_VT + (((size_t)ch0 * 1024 + h * 128) * 16 + (wq * 64 + lane) * 8) * 2;
    const unsigned char* sg = ws + WS_GATE + (((size_t)mrow0 + 4 * wq) * 1024 + h * 128) * 2 + lane * 4;
    const unsigned char* sc = lane < 32 ? ws + WS_PSC + (((size_t)ch0 * 8 + h) * 256 + lane * 8) * 2 : ws + WS_DEC + ((size_t)ch0 * 1024 + h * 128 + (lane - 32) * 4) * 4;
    const unsigned ring0 = (unsigned)(uintptr_t)F.lds;
#define D2_ISSUE(step, slot) do { if (w < 4) { const unsigned so_ = ring0 + (unsigned)__builtin_amdgcn_readfirstlane((int)((slot) * DS_SLOT)); const size_t go_ = (size_t)(step) * 32768; \
        _Pragma("unroll") for (int r_ = 0; r_ < 4; ++r_) glds4(sq + go_ + r_ * 2048, so_ + SC_QI + (4 * wq + r_) * DS_QSB); \
        glds16(sk + go_, so_ + SC_KT + wq * 1024); glds16(sv + go_, so_ + SC_VT + wq * 1024); \
        _Pragma("unroll") for (int r_ = 0; r_ < 4; ++r_) glds4(sg + go_ + r_ * 2048, so_ + SC_GATE + (4 * wq + r_) * DS_QSB); \
        if (w == 0) glds16(sc + (size_t)(step) * 4096, so_ + SC_P); } } while (0)
    __syncthreads();
    f32x4 S[8];
#pragma unroll
    for (int mt = 0; mt < 8; ++mt) S[mt] = (f32x4){0.f, 0.f, 0.f, 0.f};
    for (int s = 0; s < DS_R - 1 && s < nsteps; ++s) D2_ISSUE(s, s);
    f32x4 o_p1 = {0.f, 0.f, 0.f, 0.f}, o_p2 = o_p1, gate_p1 = o_p1, gate_p2 = o_p1;
    int slot = 0;
#pragma unroll 1
    for (int n = 0; n <= nsteps + 2; ++n) {
        if (w < 4) {
            if (n >= DS_R && n + DS_R <= nsteps + 1) { if (w == 0) asm volatile("s_waitcnt vmcnt(44)" ::: "memory"); else asm volatile("s_waitcnt vmcnt(40)" ::: "memory"); }
            else asm volatile("s_waitcnt vmcnt(0)" ::: "memory");
        }
        static_assert(DS_R == 6, "the counted waits above are (DS_R - 2) * 11 and (DS_R - 2) * 10");
        DS_BAR();
        if (rdy && n - 1 + DS_R == rdy_step) flag_wait(rdy, need);
        if (n - 1 + DS_R < nsteps) { const int ps = slot == 0 ? DS_R - 1 : slot - 1; D2_ISSUE(n - 1 + DS_R, ps); }
        const int buf = n & 1;
        f32x4 o = {0.f, 0.f, 0.f, 0.f}, gate = {0.f, 0.f, 0.f, 0.f};
        if (n < nsteps) {
            const LAS unsigned char* B = F.lds + slot * DS_SLOT;
            const bf16x4 vt = *(const LAS bf16x4*)(B + SC_VT + ((e0 + l15) * 16 + 4 * g4) * 2);
            const bf16x4 pa = *(const LAS bf16x4*)(B + SC_P + (l15 * 16 + 4 * g4) * 2);
            const f32x2 dcp = *(const LAS f32x2*)(B + SC_DEC + (16 * (l15 >> 1) + 4 * g4 + 2 * (l15 & 1)) * 4);
            const f32x4 zz = {0.f, 0.f, 0.f, 0.f};
            f32x4 oq[4];
            const f32x4 op = __builtin_amdgcn_mfma_f32_16x16x16bf16_1k(pa, vt, zz, 0, 0, 0);
#pragma unroll
            for (int kk = 0; kk < 4; ++kk) {
                const bf16x4 q0 = *(const LAS bf16x4*)(B + SC_QI + l15 * DS_QSB + (32 * kk + 4 * g4) * 2);
                const bf16x4 q1 = *(const LAS bf16x4*)(B + SC_QI + l15 * DS_QSB + (32 * kk + 16 + 4 * g4) * 2);
                const bf16x8 qa = {q0[0], q0[1], q0[2], q0[3], q1[0], q1[1], q1[2], q1[3]};
                const u32x4 sb8 = pack8(S[2 * kk], S[2 * kk + 1]);
                oq[kk] = __builtin_amdgcn_mfma_f32_16x16x32_bf16(qa, __builtin_bit_cast(bf16x8, sb8), zz, 0, 0, 0);
            }
            bf16x4 kt[8];
#pragma unroll
            for (int mt = 0; mt < 8; ++mt) kt[mt] = *(const LAS bf16x4*)(B + SC_KT + ((16 * mt + l15) * 16 + 4 * g4) * 2);
#pragma unroll
            for (int mt = 0; mt < 8; ++mt) S[mt] = __builtin_amdgcn_mfma_f32_16x16x16bf16_1k(kt[mt], vt, S[mt], 0, 0, 0);
            scan_decay<0>(S[0], dcp[0], dcp[1]); scan_decay<1>(S[1], dcp[0], dcp[1]); scan_decay<2>(S[2], dcp[0], dcp[1]); scan_decay<3>(S[3], dcp[0], dcp[1]);
            scan_decay<4>(S[4], dcp[0], dcp[1]); scan_decay<5>(S[5], dcp[0], dcp[1]); scan_decay<6>(S[6], dcp[0], dcp[1]); scan_decay<7>(S[7], dcp[0], dcp[1]);
            o = ((oq[0] + oq[2]) + op) + (oq[1] + oq[3]);
#pragma unroll
            for (int r = 0; r < 4; ++r) {
                const int t = 4 * g4 + r;
                gate[r] = bf2f(*(const LAS unsigned short*)(B + SC_GATE + t * DS_QSB + (e0 + l15) * 2));
                const float ss = row16_sum(o[r] * o[r]);
                if (l15 == 0) RED[(buf * 16 + t) * 8 + w] = ss;
            }
        }
        if (n > 0 && n <= nsteps) {
            const int i = lane & 15, t = 2 * w + (i >> 3);
            float v = RED[((buf ^ 1) * 16 + t) * 8 + (i & 7)];
            v += dpp_mov<0xB1>(v); v += dpp_mov<0x4E>(v); v += dpp_mov<0x141>(v);
            const float rs = __builtin_amdgcn_rsqf(v * (1.0f / 128.0f) + RMS_EPS);
            if (lane < 16 && (lane & 7) == 0) RS[(buf ^ 1) * 16 + t] = rs;
        }
        if (n > 1 && n <= nsteps + 1) {
            const f32x4 rs4 = *(const LAS f32x4*)(RS + buf * 16 + 4 * g4);
#pragma unroll
            for (int r = 0; r < 4; ++r) OUTB[(buf * 16 + 4 * g4 + r) * 128 + e0 + l15] = f2bf(o_p2[r] * rs4[r] * onw * gate_p2[r]);
        }
        if (n > 2 && w >= 4) {
            const int i = (w - 4) * 64 + lane, t = i >> 4, p = i & 15;
            *(u32x4*)(MIX + (size_t)(mrow0 + 16 * (n - 3) + t) * DM + h * 128 + p * 8) = *(const LAS u32x4*)(OUTB + ((buf ^ 1) * 16 + t) * 128 + p * 8);
        }
        o_p2 = o_p1; gate_p2 = gate_p1; o_p1 = o; gate_p1 = gate;
        slot = slot == DS_R - 1 ? 0 : slot + 1;
    }
    asm volatile("s_waitcnt vmcnt(0)" ::: "memory");
    __syncthreads();
#pragma unroll
    for (int mt = 0; mt < 8; ++mt)
#pragma unroll
        for (int r = 0; r < 4; ++r) ST[(16 * mt + 4 * g4 + r) * DS_STS + e0 + l15] = S[mt][r];
    __syncthreads();
#pragma unroll
    for (int i = 0; i < 8; ++i) { const int idx = F.tid + 512 * i, c = idx >> 5, e4 = idx & 31; *(f32x4*)(Sout + (size_t)c * 128 + e4 * 4) = *(const LAS f32x4*)(ST + c * DS_STS + e4 * 4); }
#undef D2_ISSUE
}

__device__ __forceinline__ void hgrn_scan_dma(Frame& F, int ch0, int nsteps, int h, int mrow0, int nvalid, const float* S0, float* Sout) {
#ifdef HY_DMA1
    hgrn_scan_dma_t<0>(F, ch0, nsteps, h, mrow0, nvalid, S0, Sout, (bf16_t*)(F.ws + WS_MIX), DM, nullptr);
#else
    hgrn_scan_dma2(F, ch0, nsteps, h, mrow0, Sout, nullptr, 0u, 0);
#endif
}
__device__ __forceinline__ void hgrn_scan(Frame& F, int ch0, int nsteps, int h, int mrow0, int nvalid, const float* S0, float* Sout) {
    hgrn_scan_t<0>(F, ch0, nsteps, h, mrow0, nvalid, S0, Sout, (bf16_t*)(F.ws + WS_MIX), DM, nullptr);
}

constexpr int SW_KS = 72, SW_VS = 264;
constexpr int SW_K = 0, SW_V = 256 * SW_KS * 2, SW_BT = SW_V + 64 * SW_VS * 2, SW_END = SW_BT + 8 * 160 * 4;
static_assert(SW_END <= LDS_BYTES, "swa LDS");
__device__ __forceinline__ void swa_qtile(Frame& F, int j, int h, size_t qrow, bool qvalid, bool first_block, float sink2) {
    const int lane = F.lane, l15 = lane & 15, g4 = lane >> 4;
    const bf16_t* SQ = (const bf16_t*)(F.ws + WS_SQ); bf16_t* MIX = (bf16_t*)(F.ws + WS_MIX);
    const LAS bf16_t* Kb = (const LAS bf16_t*)(F.lds + SW_K); const LAS bf16_t* Vt = (const LAS bf16_t*)(F.lds + SW_V);
    const LAS float* BT = (const LAS float*)(F.lds + SW_BT) + F.wave * 160;
    bf16x8 qf[2];
#pragma unroll
    for (int kk = 0; kk < 2; ++kk) qf[kk] = *(const bf16x8*)(SQ + qrow * 1024 + h * 64 + 32 * kk + 8 * g4);
    f32x4 s[9]; float mx = sink2;
    const int bidx = 15 + 4 * g4 - l15;
#pragma unroll
    for (int u = 0; u < 9; ++u) {
        const int mt = j + u; f32x4 acc = {0.f, 0.f, 0.f, 0.f};
#pragma unroll
        for (int kk = 0; kk < 2; ++kk) {
            const bf16x8 a = *(const LAS bf16x8*)(Kb + (16 * mt + l15) * SW_KS + 32 * kk + 8 * g4);
            acc = __builtin_amdgcn_mfma_f32_16x16x32_bf16(a, qf[kk], acc, 0, 0, 0);
        }
        const bool dead = first_block && (mt < 8);
#pragma unroll
        for (int r = 0; r < 4; ++r) { float v = acc[r] + BT[bidx + 16 * u + r]; v = dead ? -INFINITY : v; s[u][r] = v; mx = fmaxf(mx, v); }
    }
    mx = fmaxf(mx, __shfl_xor(mx, 16)); mx = fmaxf(mx, __shfl_xor(mx, 32));
    float sum = 0.f; bf16x4 pb[9];
#pragma unroll
    for (int u = 0; u < 9; ++u) {
        f32x4 p;
#pragma unroll
        for (int r = 0; r < 4; ++r) { p[r] = __builtin_amdgcn_exp2f(s[u][r] - mx); sum += p[r]; }
        pb[u] = __builtin_bit_cast(bf16x4, pack4(p));
    }
    sum += __shfl_xor(sum, 16); sum += __shfl_xor(sum, 32);
    sum += __builtin_amdgcn_exp2f(sink2 - mx);
    const float inv = 1.0f / sum;
#pragma unroll
    for (int dt = 0; dt < 4; ++dt) {
        f32x4 o = {0.f, 0.f, 0.f, 0.f};
#pragma unroll
        for (int u = 0; u < 9; ++u) {
            const bf16x4 a = *(const LAS bf16x4*)(Vt + (16 * dt + l15) * SW_VS + 16 * (j + u) + 4 * g4);
            o = __builtin_amdgcn_mfma_f32_16x16x16bf16_1k(a, pb[u], o, 0, 0, 0);
        }
        if (qvalid) *(u32x2*)(MIX + qrow * DM + 1024 + h * 64 + 16 * dt + 4 * g4) = pack4(o * inv);
    }
}
__device__ __forceinline__ void swa_load_tables(Frame& F, int k) {
    const float* BTg = (const float*)(F.ws + WS_TAB + 8192); LAS float* BT = (LAS float*)(F.lds + SW_BT);
    for (int i = F.tid; i < 8 * 160; i += NTHREADS) BT[i] = BTg[k * 8 * 160 + i];
}
__device__ __forceinline__ void swa_prompt_unit(Frame& F, int unit) {
    const int k = unit & 1, n = (unit >> 1) & 31, b = unit >> 6;
    const bf16_t* SKV = (const bf16_t*)(F.ws + WS_SKV);
    LAS bf16_t* Kb = (LAS bf16_t*)(F.lds + SW_K); LAS bf16_t* Vt = (LAS bf16_t*)(F.lds + SW_V);
    __syncthreads();
    swa_load_tables(F, k);
#pragma unroll
    for (int i = 0; i < 4; ++i) {
        const int idx = F.tid + 512 * i, kj = idx >> 3, p = idx & 7, pos = 128 * (n - 1) + kj;
        u32x4 kv = {0u, 0u, 0u, 0u}, vv = {0u, 0u, 0u, 0u};
        if (pos >= 0) { const bf16_t* src = SKV + (size_t)(b * SEQ + pos) * 256 + k * 64 + p * 8; kv = *(const u32x4*)src; vv = *(const u32x4*)(src + 128); }
        *(LAS u32x4*)(Kb + kj * SW_KS + p * 8) = kv;
        const unsigned w[4] = {vv.x, vv.y, vv.z, vv.w};
#pragma unroll
        for (int e = 0; e < 4; ++e) { Vt[(8 * p + 2 * e) * SW_VS + kj] = (bf16_t)(w[e] & 0xffffu); Vt[(8 * p + 2 * e + 1) * SW_VS + kj] = (bf16_t)(w[e] >> 16); }
    }
    __syncthreads();
    const int h = k * 8 + F.wave; const float sink2 = F.in[I_SINKS][h] * LOG2E;
#pragma unroll 1
    for (int j = 0; j < 8; ++j) swa_qtile(F, j, h, (size_t)(b * SEQ + 128 * n + 16 * j + (F.lane & 15)), true, n == 0, sink2);
}
__device__ __forceinline__ void swa_sample_unit(Frame& F, int unit) {
    const int k = unit & 1, b = unit >> 1;
    const bf16_t* SKV = (const bf16_t*)(F.ws + WS_SKV);
    LAS bf16_t* Kb = (LAS bf16_t*)(F.lds + SW_K); LAS bf16_t* Vt = (LAS bf16_t*)(F.lds + SW_V);
    __syncthreads();
    swa_load_tables(F, k);
#pragma unroll
    for (int i = 0; i < 4; ++i) {
        const int idx = F.tid + 512 * i, kj = idx >> 4, p = idx & 15;
        const size_t so = ((size_t)(b * 128 + kj) * 2 + k) * 64 + p * 4;
        const f32x4 kv = *(const f32x4*)(F.in[I_CSK] + so), vv = *(const f32x4*)(F.in[I_CSV] + so);
        *(LAS u32x2*)(Kb + kj * SW_KS + p * 4) = pack4(kv);
#pragma unroll
        for (int e = 0; e < 4; ++e) Vt[(4 * p + e) * SW_VS + kj] = f2bf(vv[e]);
        if (kj >= 4) { const size_t dof = ((size_t)(b * 128 + kj - 4) * 2 + k) * 64 + p * 4; *(f32x4*)(F.out + O_SSK + dof) = kv; *(f32x4*)(F.out + O_SSV + dof) = vv; }
    }
    if (F.tid < 128) {
        const int kj = 128 + (F.tid >> 3), p = F.tid & 7;
        u32x4 kv = {0u, 0u, 0u, 0u}, vv = {0u, 0u, 0u, 0u};
        if (kj < 132) { const bf16_t* src = SKV + (size_t)(TP + 4 * b + (kj - 128)) * 256 + k * 64 + p * 8; kv = *(const u32x4*)src; vv = *(const u32x4*)(src + 128); }
        *(LAS u32x4*)(Kb + kj * SW_KS + p * 8) = kv;
        const unsigned w[4] = {vv.x, vv.y, vv.z, vv.w};
#pragma unroll
        for (int e = 0; e < 4; ++e) { Vt[(8 * p + 2 * e) * SW_VS + kj] = (bf16_t)(w[e] & 0xffffu); Vt[(8 * p + 2 * e + 1) * SW_VS + kj] = (bf16_t)(w[e] >> 16); }
    }
    __syncthreads();
    const int h = k * 8 + F.wave, l15 = F.lane & 15; const float sink2 = F.in[I_SINKS][h] * LOG2E;
    swa_qtile(F, 0, h, (size_t)(TP + 4 * b + (l15 < 4 ? l15 : 3)), l15 < 4, false, sink2);
}

constexpr int MA_KS = 136, MA_VS = 264;
constexpr int MA_K = 0, MA_V = 256 * MA_KS * 2, MA_END = MA_V + 128 * MA_VS * 2;
static_assert(MA_END <= LDS_BYTES, "memattn LDS");
__device__ __forceinline__ void memattn_prompt_unit(Frame& F, int unit) {
    const int h = unit & 3, pm = unit >> 2, b = pm >> 4;
    const bf16_t* MK = (const bf16_t*)(F.ws + WS_MK); const bf16_t* MVT = (const bf16_t*)(F.ws + WS_MVT);
    const bf16_t* QM = (const bf16_t*)(F.ws + WS_QM); bf16_t* OM = (bf16_t*)(F.ws + WS_OM);
    LAS bf16_t* Kh = (LAS bf16_t*)(F.lds + MA_K); LAS bf16_t* Vt = (LAS bf16_t*)(F.lds + MA_V);
    const int lane = F.lane, l15 = lane & 15, g4 = lane >> 4;
    __syncthreads();
#pragma unroll
    for (int i = 0; i < 8; ++i) {
        const int idx = F.tid + 512 * i;
        { const int m = idx >> 4, p = idx & 15; *(LAS u32x4*)(Kh + m * MA_KS + p * 8) = *(const u32x4*)(MK + (size_t)(b * 256 + m) * 512 + h * 128 + p * 8); }
        { const int d = idx >> 5, p = idx & 31; *(LAS u32x4*)(Vt + d * MA_VS + p * 8) = *(const u32x4*)(MVT + ((size_t)(b * 4 + h) * 128 + d) * 256 + p * 8); }
    }
    __syncthreads();
#pragma unroll 1
    for (int jj = 0; jj < 2; ++jj) {
        const size_t row = (size_t)pm * 256 + 16 * (2 * F.wave + jj) + l15;
        bf16x8 qf[4];
#pragma unroll
        for (int kk = 0; kk < 4; ++kk) qf[kk] = *(const bf16x8*)(QM + row * 512 + h * 128 + 32 * kk + 8 * g4);
        f32x4 s[16]; float mx = -INFINITY;
#pragma unroll
        for (int mt = 0; mt < 16; ++mt) {
            f32x4 acc = {0.f, 0.f, 0.f, 0.f};
#pragma unroll
            for (int kk = 0; kk < 4; ++kk) {
                const bf16x8 a = *(const LAS bf16x8*)(Kh + (16 * mt + l15) * MA_KS + 32 * kk + 8 * g4);
                acc = __builtin_amdgcn_mfma_f32_16x16x32_bf16(a, qf[kk], acc, 0, 0, 0);
            }
            s[mt] = acc; mx = fmaxf(fmaxf(mx, fmaxf(acc[0], acc[1])), fmaxf(acc[2], acc[3]));
            __builtin_amdgcn_sched_barrier(0);
        }
        mx = fmaxf(mx, __shfl_xor(mx, 16)); mx = fmaxf(mx, __shfl_xor(mx, 32));
        float sum = 0.f; bf16x8 pb[8];
#pragma unroll
        for (int i = 0; i < 8; ++i) {
            f32x4 p0, p1;
#pragma unroll
            for (int r = 0; r < 4; ++r) { p0[r] = __builtin_amdgcn_exp2f(s[2 * i][r] - mx); p1[r] = __builtin_amdgcn_exp2f(s[2 * i + 1][r] - mx); sum += p0[r] + p1[r]; }
            pb[i] = __builtin_bit_cast(bf16x8, pack8(p0, p1));
        }
        sum += __shfl_xor(sum, 16); sum += __shfl_xor(sum, 32);
        const float inv = 1.0f / sum;
#pragma unroll
        for (int dt = 0; dt < 8; ++dt) {
            f32x4 o = {0.f, 0.f, 0.f, 0.f};
#pragma unroll
            for (int i = 0; i < 8; ++i) {
                const bf16x4 a0 = *(const LAS bf16x4*)(Vt + (16 * dt + l15) * MA_VS + 32 * i + 4 * g4);
                const bf16x4 a1 = *(const LAS bf16x4*)(Vt + (16 * dt + l15) * MA_VS + 32 * i + 16 + 4 * g4);
                const bf16x8 a = {a0[0], a0[1], a0[2], a0[3], a1[0], a1[1], a1[2], a1[3]};
                o = __builtin_amdgcn_mfma_f32_16x16x32_bf16(a, pb[i], o, 0, 0, 0);
            }
            *(u32x2*)(OM + row * 512 + h * 128 + 16 * dt + 4 * g4) = pack4(o * inv);
            __builtin_amdgcn_sched_barrier(0);
        }
    }
}
constexpr int MSP_P = 0, MSP_O = 8192, MSP_ML = 8192 + 16384;
__device__ __forceinline__ void memattn_sample_block(Frame& F, int task) {
    const int hp = task & 1, b = task >> 1, w = F.wave, h = 2 * hp + (w >> 2), kq = w & 3;
    const float* CK = F.in[I_CMK] + ((size_t)b * 256 + 64 * kq) * 512 + h * 128; const float* CV = F.in[I_CMV] + ((size_t)b * 256 + 64 * kq) * 512 + h * 128;
    const bf16_t* QM = (const bf16_t*)(F.ws + WS_QM); bf16_t* OM = (bf16_t*)(F.ws + WS_OM);
    const int lane = F.lane, l15 = lane & 15, g4 = lane >> 4;
    LAS float* pl = (LAS float*)(F.lds + MSP_P) + w * 256; LAS float* po = (LAS float*)(F.lds + MSP_O) + w * 512; LAS float* ml = (LAS float*)(F.lds + MSP_ML);
    __syncthreads();
    bf16x8 qf[4];
#pragma unroll
    for (int kk = 0; kk < 4; ++kk) { qf[kk] = *(const bf16x8*)(QM + (size_t)(TP + 4 * b + (l15 & 3)) * 512 + h * 128 + 32 * kk + 8 * g4); if (l15 >= 4) qf[kk] = (bf16x8){0, 0, 0, 0, 0, 0, 0, 0}; }
    f32x4 s[4]; float mx = -INFINITY;
#pragma unroll
    for (int mt = 0; mt < 4; ++mt) {
        f32x4 acc = {0.f, 0.f, 0.f, 0.f};
#pragma unroll
        for (int kk = 0; kk < 4; ++kk) {
            const float* kp = CK + (size_t)(16 * mt + l15) * 512 + 32 * kk + 8 * g4;
            const u32x4 a = pack8(*(const f32x4*)kp, *(const f32x4*)(kp + 4));
            acc = __builtin_amdgcn_mfma_f32_16x16x32_bf16(__builtin_bit_cast(bf16x8, a), qf[kk], acc, 0, 0, 0);
        }
        s[mt] = acc; mx = fmaxf(fmaxf(mx, fmaxf(acc[0], acc[1])), fmaxf(acc[2], acc[3]));
    }
    mx = fmaxf(mx, __shfl_xor(mx, 16)); mx = fmaxf(mx, __shfl_xor(mx, 32));
    float sum = 0.f;
#pragma unroll
    for (int mt = 0; mt < 4; ++mt)
#pragma unroll
        for (int r = 0; r < 4; ++r) { const float p = __builtin_amdgcn_exp2f(s[mt][r] - mx); sum += p; if (l15 < 4) pl[(16 * mt + 4 * g4 + r) * 4 + l15] = p; }
    sum += __shfl_xor(sum, 16); sum += __shfl_xor(sum, 32);
    if (lane < 4) { ml[w * 8 + lane] = mx; ml[w * 8 + 4 + lane] = sum; }
    LDS_WAIT(); asm volatile("" ::: "memory");
    f32x2 o[4] = {{0.f, 0.f}, {0.f, 0.f}, {0.f, 0.f}, {0.f, 0.f}};
#pragma unroll 16
    for (int m = 0; m < 64; ++m) {
        const f32x2 v = *(const f32x2*)(CV + (size_t)m * 512 + 2 * lane);
        const f32x4 p = *(const LAS f32x4*)(pl + m * 4);
#pragma unroll
        for (int t = 0; t < 4; ++t) { o[t][0] += p[t] * v[0]; o[t][1] += p[t] * v[1]; }
    }
#pragma unroll
    for (int t = 0; t < 4; ++t) *(LAS f32x2*)(po + t * 128 + 2 * lane) = o[t];
    __syncthreads();
    {
        const int hh = F.tid >> 8, t = (F.tid >> 6) & 3, d = 2 * (F.tid & 63);
        float mq[4], M = -INFINITY;
#pragma unroll
        for (int q = 0; q < 4; ++q) { mq[q] = ml[(hh * 4 + q) * 8 + t]; M = fmaxf(M, mq[q]); }
        float den = 0.f; f32x2 num = {0.f, 0.f};
#pragma unroll
        for (int q = 0; q < 4; ++q) { const float f = __builtin_amdgcn_exp2f(mq[q] - M); den += f * ml[(hh * 4 + q) * 8 + 4 + t];
            const f32x2 oq = *(const LAS f32x2*)((LAS float*)(F.lds + MSP_O) + (hh * 4 + q) * 512 + t * 128 + d); num[0] += f * oq[0]; num[1] += f * oq[1]; }
        const float inv = 1.0f / den;
        *(unsigned*)(OM + (size_t)(TP + 4 * b + t) * 512 + (2 * hp + hh) * 128 + d) = cvtpk(num[0] * inv, num[1] * inv);
    }
}

__device__ __forceinline__ f32x4 bf4_f32(u32x2 w) { f32x4 v; v[0] = __uint_as_float(w.x << 16); v[1] = __uint_as_float(w.x & 0xffff0000u); v[2] = __uint_as_float(w.y << 16); v[3] = __uint_as_float(w.y & 0xffff0000u); return v; }
__device__ __forceinline__ void final_norm_row_slabs_b(float* yrow, const bf16_t* xbrow, const float* slab_row, size_t slab_stride, int ns, const float* w, int lane) {
    f32x4* yr = (f32x4*)yrow + lane; const u32x2* xr = (const u32x2*)xbrow + lane; const f32x4* wr = (const f32x4*)w + lane;
    f32x4 v[8]; float s = 0.f;
#pragma unroll
    for (int j = 0; j < 8; ++j) v[j] = bf4_f32(xr[64 * j]);
    for (int k = 0; k < ns; ++k) { const f32x4* sr = (const f32x4*)(slab_row + (size_t)k * slab_stride) + lane;
#pragma unroll
        for (int j = 0; j < 8; ++j) v[j] += sr[64 * j]; }
#pragma unroll
    for (int j = 0; j < 8; ++j) s += (v[j][0] * v[j][0] + v[j][1] * v[j][1]) + (v[j][2] * v[j][2] + v[j][3] * v[j][3]);
    const float rs = __builtin_amdgcn_rsqf(wave_sum(s) * (1.0f / DM) + RMS_EPS);
#pragma unroll
    for (int j = 0; j < 8; ++j) { const f32x4 ww = wr[64 * j]; f32x4 y; y[0] = v[j][0] * rs * ww[0]; y[1] = v[j][1] * rs * ww[1]; y[2] = v[j][2] * rs * ww[2]; y[3] = v[j][3] * rs * ww[3]; yr[64 * j] = y; }
}
__device__ __forceinline__ void final_norm_row_b(float* yrow, const bf16_t* xbrow, const float* SS, int row, const float* w, int lane) {
    const float rs = row_rs(SS, row);
    f32x4* yr = (f32x4*)yrow + lane; const u32x2* xr = (const u32x2*)xbrow + lane; const f32x4* wr = (const f32x4*)w + lane;
#pragma unroll
    for (int j = 0; j < 8; ++j) { f32x4 v = bf4_f32(xr[64 * j]); const f32x4 ww = wr[64 * j]; v[0] = v[0] * rs * ww[0]; v[1] = v[1] * rs * ww[1]; v[2] = v[2] * rs * ww[2]; v[3] = v[3] * rs * ww[3]; yr[64 * j] = v; }
}
__device__ __forceinline__ void final_norm_row_slabs(float* xrow, const float* slab_row, size_t slab_stride, int ns, const float* w, int lane) {
    f32x4* xr = (f32x4*)xrow + lane; const f32x4* wr = (const f32x4*)w + lane;
    f32x4 v[8]; float s = 0.f;
#pragma unroll
    for (int j = 0; j < 8; ++j) v[j] = xr[64 * j];
    for (int k = 0; k < ns; ++k) { const f32x4* sr = (const f32x4*)(slab_row + (size_t)k * slab_stride) + lane;
#pragma unroll
        for (int j = 0; j < 8; ++j) v[j] += sr[64 * j]; }
#pragma unroll
    for (int j = 0; j < 8; ++j) s += (v[j][0] * v[j][0] + v[j][1] * v[j][1]) + (v[j][2] * v[j][2] + v[j][3] * v[j][3]);
    const float rs = __builtin_amdgcn_rsqf(wave_sum(s) * (1.0f / DM) + RMS_EPS);
#pragma unroll
    for (int j = 0; j < 8; ++j) { const f32x4 ww = wr[64 * j]; f32x4 y; y[0] = v[j][0] * rs * ww[0]; y[1] = v[j][1] * rs * ww[1]; y[2] = v[j][2] * rs * ww[2]; y[3] = v[j][3] * rs * ww[3]; xr[64 * j] = y; }
}
__device__ __forceinline__ void final_norm_row(float* xrow, const float* SS, int row, const float* w, int lane) {
    const float rs = row_rs(SS, row);
    f32x4* xr = (f32x4*)xrow + lane; const f32x4* wr = (const f32x4*)w + lane;
#pragma unroll
    for (int j = 0; j < 8; ++j) { f32x4 v = xr[64 * j]; const f32x4 ww = wr[64 * j]; v[0] = v[0] * rs * ww[0]; v[1] = v[1] * rs * ww[1]; v[2] = v[2] * rs * ww[2]; v[3] = v[3] * rs * ww[3]; xr[64 * j] = v; }
}

#ifndef HGRN_SCAN_PROMPT
#define HGRN_SCAN_PROMPT hgrn_scan_dma
#endif
#define HGRN_SCAN_SAMPLE hgrn_scan
#ifdef HY_P3DELAY
#define P3_DELAY do { for (int z_ = 0; z_ < 16; ++z_) __builtin_amdgcn_s_sleep(127); __syncthreads(); } while (0)
#else
#define P3_DELAY do {} while (0)
#endif
#define XB_TMO      128
#define XB_XCNT(j)  (256  + 64 * (j))
#define XB_XSUB(j)  (1280 + 64 * (j))
#define XB_XGEN(j)  (2304 + 64 * (j))
#define XB_TOP      3328
#define XB_TOPGEN   3392
#define XCD_BAR_WORDS 3456
#define XB_SPIN_CAP (1u << 18)

__device__ __forceinline__ unsigned xb_ld(unsigned* p)              { return __hip_atomic_load(p, __ATOMIC_RELAXED, __HIP_MEMORY_SCOPE_AGENT); }
__device__ __forceinline__ unsigned xb_add(unsigned* p, unsigned v) { return __hip_atomic_fetch_add(p, v, __ATOMIC_RELAXED, __HIP_MEMORY_SCOPE_AGENT); }
__device__ __forceinline__ unsigned xb_xcc_id() { return (unsigned)__builtin_amdgcn_s_getreg((3 << 11) | 20) & 0xFu; }
#define XB_SPIN(cond, bar) do { unsigned _sp = 0; while (cond) { __builtin_amdgcn_s_sleep(1); \
    if ((++_sp & 255u) == 0u) { if (xb_ld(&(bar)[XB_TMO])) break; if (_sp > XB_SPIN_CAP) { atomicAdd(&(bar)[XB_TMO], 1u); break; } } } } while (0)

struct XcdBarrier {
    unsigned* bar; unsigned x;
    volatile LAS unsigned* st;
};

__device__ __forceinline__ XcdBarrier xcd_barrier_post(unsigned* bar, volatile LAS unsigned* st) {
    XcdBarrier b; b.bar = bar; b.x = xb_xcc_id(); b.st = st;
    if (threadIdx.x == 0) (void)xb_add(&bar[XB_XCNT(b.x)], 1u);
    return b;
}
__device__ __forceinline__ void xcd_barrier_complete(unsigned* bar, unsigned x, unsigned& nloc, unsigned& nx) {
    const unsigned G = gridDim.x * gridDim.y * gridDim.z;
    unsigned sum, cnt, mine, sp = 0u;
    for (;;) {
        sum = 0u; cnt = 0u; mine = 0u;
#pragma unroll
        for (unsigned j = 0; j < 16; ++j) { const unsigned c = xb_ld(&bar[XB_XCNT(j)]); sum += c; cnt += (c > 0u) ? 1u : 0u; mine = (j == x) ? c : mine; }
        if (sum == G) break;
        __builtin_amdgcn_s_sleep(1);
        if ((++sp & 255u) == 0u) { if (xb_ld(&bar[XB_TMO])) break; if (sp > XB_SPIN_CAP) { atomicAdd(&bar[XB_TMO], 1u); break; } }
    }
    nloc = mine > 0u ? mine : 1u; nx = cnt > 0u ? cnt : 1u;
}

__device__ __forceinline__ void xcd_barrier(const XcdBarrier& b) {
    asm volatile("s_waitcnt vmcnt(0)" ::: "memory");
    __syncthreads();
    if (threadIdx.x == 0) {
        unsigned* bar = b.bar;
        __builtin_amdgcn_s_waitcnt(0);
        unsigned nloc = b.st[0], nx = b.st[1];
        if (nloc == 0u) { xcd_barrier_complete(bar, b.x, nloc, nx); b.st[0] = nloc; b.st[1] = nx; }
        const unsigned old = xb_add(&bar[XB_XSUB(b.x)], 1u);
        const unsigned gen = old / nloc;
        if (old + 1u == (gen + 1u) * nloc) {
            __builtin_amdgcn_fence(__ATOMIC_RELEASE, "agent");
            asm volatile("s_waitcnt vmcnt(0)" ::: "memory");
            const unsigned og = xb_add(&bar[XB_TOP], 1u);
            const unsigned tg = og / nx;
            if (og + 1u == (tg + 1u) * nx) xb_add(&bar[XB_TOPGEN], 1u);
            else XB_SPIN(xb_ld(&bar[XB_TOPGEN]) == tg, bar);
            __builtin_amdgcn_fence(__ATOMIC_ACQUIRE, "agent");
            xb_add(&bar[XB_XGEN(b.x)], 1u);
            asm volatile("s_waitcnt vmcnt(0)" ::: "memory");
        } else {
            XB_SPIN(xb_ld(&bar[XB_XGEN(b.x)]) == gen, bar);
            __builtin_amdgcn_fence(__ATOMIC_ACQUIRE, "agent");
            asm volatile("s_waitcnt vmcnt(0)" ::: "memory");
        }
    }
    __syncthreads();
}

constexpr size_t WS_CNT = 4096 + 16384;
constexpr size_t WS_BAR = 4096;
constexpr int LDS_BARST = LDS_BYTES - 64;
constexpr int N_PHASES = 11;
__global__ void __launch_bounds__(NTHREADS, 2) hymba_fwd(Args args) {
    extern __shared__ __attribute__((aligned(16))) unsigned char lds_raw[];
    cg::grid_group grid = cg::this_grid();
    Frame F;
    F.lds = (LAS unsigned char*)lds_raw;
    F.tid = threadIdx.x; F.lane = F.tid & 63; F.wave = __builtin_amdgcn_readfirstlane(F.tid >> 6);
    F.G = gridDim.x; F.bid = blockIdx.x;
    F.in = args.in; F.out = args.out; F.ws = args.ws;
    unsigned char* ws = args.ws; float* out = args.out;
    if (F.tid < 16) ((LAS unsigned*)(F.lds + LDS_BARST))[F.tid] = 0u;
    __syncthreads();
    XcdBarrier xbar = xcd_barrier_post((unsigned*)(ws + WS_BAR), (volatile LAS unsigned*)(F.lds + LDS_BARST));
    if (args.ph_lo > 1000) grid.sync();
#ifdef HY_LDSCLR
    for (int i = F.tid; i < LDS_BYTES / 16; i += NTHREADS) *(LAS u32x4*)(F.lds + i * 16) = (u32x4){0u, 0u, 0u, 0u};
    __syncthreads();
#endif
    const int lo = args.ph_lo, hi = args.ph_hi;
#ifndef HY_PHASE_MASK
#define HY_PHASE_MASK 0x7ff
#endif
#define IN(k) (((HY_PHASE_MASK >> (k)) & 1) && lo <= (k) && (k) < hi)
#ifndef HY_REPMASK
#define HY_REPMASK 0
#endif
#define PHASE(k, ...) do { if (IN(k)) { __VA_ARGS__ } if (IN(k) && ((HY_REPMASK >> (k)) & 1)) { __VA_ARGS__ } } while (0)
#ifdef HY_XACQ
#define SEAM(k) do { if (IN(k) && IN((k) + 1)) { asm volatile("s_waitcnt vmcnt(0)" ::: "memory"); __builtin_amdgcn_fence(__ATOMIC_RELEASE, "agent"); asm volatile("s_waitcnt vmcnt(0)" ::: "memory"); grid.sync(); __builtin_amdgcn_fence(__ATOMIC_ACQUIRE, "agent"); asm volatile("s_waitcnt vmcnt(0)" ::: "memory"); __syncthreads(); } } while (0)
#else
#define SEAM(k) do { if (IN(k) && IN((k) + 1)) { xcd_barrier(xbar); } } while (0)
#endif
    float* SS0 = (float*)(ws + WS_SS); float* SS1 = (float*)(ws + WS_SS + SS_STRIDE); float* SS2 = (float*)(ws + WS_SS + 2 * SS_STRIDE);
    bf16_t* XB = (bf16_t*)(ws + WS_XB);

#ifndef HY_FILL
#define HY_FILL 0
#endif
    const bool fill = HY_FILL && F.G > 32;
    constexpr int FL_C = CV_ALL - CV_DN, FL_A = CV_EARLY + 4000, FL_B = FL_A + 4300;
#ifndef HY_FILLMASK
#define HY_FILLMASK 15
#endif
#define FILL(bit, nunits, busy_hi, it0, it1) do { const int rem_ = (nunits) % F.G, hi_ = (busy_hi); if (fill && ((HY_FILLMASK >> (bit)) & 1) && F.bid >= rem_ && F.bid < hi_) { __syncthreads(); p0_convert(F, it0, it1, (F.bid - rem_) * NWAVES + F.wave, (hi_ - rem_) * NWAVES); } } while (0)
    PHASE(0, p0_prologue(F, !(F.G > 32)););
    SEAM(0);
    PHASE(1,
        { pg8::Gemm g{XB, (const bf16_t*)(ws + WS_WIN), TT, NIN, DM, DM}; pg8::StaticOrder S; S.init(TT, NIN, F.G, F.bid);
          EpiIn E{out, out + (size_t)TT * 1024, (bf16_t*)(out + O_SST), (bf16_t*)(ws + WS_GATE), (bf16_t*)(ws + WS_SQ), (bf16_t*)(ws + WS_SKV), (const float*)(ws + WS_TAB), out};
          pg8::gemm_phase<EpiIn, pg8::StaticOrder, true, true>(F.lds, g, S, E); }
        { pg8::Gemm g{(const bf16_t*)(ws + WS_MN), (const bf16_t*)(ws + WS_WMKV), 1024, 1024, DM, DM}; pg8::StaticOrder S; S.init(1024, 1024, F.G, (F.bid + 16) % F.G);
          EpiMemKV E{(bf16_t*)(ws + WS_MK), (bf16_t*)(ws + WS_MVT), out};
          pg8::gemm_phase<EpiMemKV, pg8::StaticOrder, true, true>(F.lds, g, S, E); }
        FILL(0, (TT / 256) * (NIN / 256), F.G - 16, CV_EARLY, FL_A);
    );
    SEAM(1);
#ifndef HY_P2OVL
#define HY_P2OVL 0
#endif
    PHASE(2, if (!(HY_P2OVL && F.G > 32)) hgrn_prep(F, F.bid, NCH, F.G, false););
    if (!(HY_P2OVL && F.G > 32)) SEAM(2);
    PHASE(3,
        const bool split = F.G > 32;
#define P3_SCAN do { if (F.bid < 32) { P3_DELAY; for (int bh = F.bid; bh < 32; bh += F.G) { const int b = bh >> 3, h = bh & 7; \
                if (HY_P2OVL && split) { flag_wait(RDY0, (unsigned)(F.G - 32)); hgrn_scan_dma2(F, b * 256, 256, h, b * SEQ, out + O_PST + (size_t)bh * 16384, RDYA, (unsigned)(F.G - 32), (F.G - 32) / 4); } \
                else HGRN_SCAN_PROMPT(F, b * 256, 256, h, b * SEQ, 16, nullptr, out + O_PST + (size_t)bh * 16384); } } } while (0)
#define P3_OTHERS do { if (!split || F.bid >= 32) { const int nw = split ? F.G - 32 : F.G; \
            for (int i = split ? F.bid - 32 : F.bid; i < 1536; i += nw) { \
                if (i < 256) swa_prompt_unit(F, i); \
                else if (i < 512) swa_sample_unit(F, i - 256); \
                else { const int t = i - 512, b = t >> 3, h = t & 7; \
                    HGRN_SCAN_SAMPLE(F, NCHP + b, 1, h, TP + 4 * b, 4, F.in[I_STATE] + (size_t)t * 16384, out + O_SST + (size_t)t * 16384); } } } } while (0)
        unsigned* RDY0 = (unsigned*)(ws + WS_CNT) + 16; unsigned* RDYA = (unsigned*)(ws + WS_CNT) + 32;
        if (HY_P2OVL && split && F.bid >= 32) {
            hgrn_prep(F, F.bid - 32, F.G - 32, F.G - 32, true); flag_signal(RDY0);
            hgrn_prep(F, F.bid - 32 + (F.G - 32), NCH, F.G - 32, true); flag_signal(RDYA);
            flag_wait(RDYA, (unsigned)(F.G - 32));
        }
        P3_SCAN;
        if ((HY_REPMASK >> 11) & 1) P3_SCAN;
        P3_OTHERS;
        if ((HY_REPMASK >> 12) & 1) P3_OTHERS;
        if (split && F.bid >= 32) {
            const int nw = F.G - 32; unsigned* CNT = (unsigned*)(ws + WS_CNT);
            asm volatile("s_waitcnt vmcnt(0)" ::: "memory"); __syncthreads();
            if (F.tid == 0) {
                __builtin_amdgcn_fence(__ATOMIC_RELEASE, "agent"); asm volatile("s_waitcnt vmcnt(0)" ::: "memory");
                __hip_atomic_fetch_add(CNT, 1u, __ATOMIC_RELAXED, __HIP_MEMORY_SCOPE_AGENT);
                unsigned sp = 0; while (__hip_atomic_load(CNT, __ATOMIC_RELAXED, __HIP_MEMORY_SCOPE_AGENT) < (unsigned)nw) { __builtin_amdgcn_s_sleep(2); if (++sp > (1u << 22)) break; }
                __builtin_amdgcn_fence(__ATOMIC_ACQUIRE, "agent"); asm volatile("s_waitcnt vmcnt(0)" ::: "memory");
            }
            __syncthreads();
            pg8::Gemm g{(const bf16_t*)(ws + WS_MIX), (const bf16_t*)(ws + WS_WOUT), TT, DM, DM / 2, DM}; pg8::StaticOrder S; S.init(TT, DM, nw, F.bid - 32); S.ksv = 1;
            EpiResidB E{F.in[I_XP], F.in[I_XS], XB, nullptr};
            pg8::gemm_phase<EpiResidB, pg8::StaticOrder, true, true>(F.lds, g, S, E);
            if ((HY_REPMASK >> 13) & 1) { __syncthreads(); pg8::gemm_phase<EpiResidB, pg8::StaticOrder, true, true>(F.lds, g, S, E); }
            __syncthreads();
            if ((HY_REPMASK >> 14) & 1) { p0_convert(F, CV_EARLY, CV_ALL, (F.bid - 32) * NWAVES + F.wave, nw * NWAVES); __syncthreads(); }
            if (!fill) p0_convert(F, CV_EARLY, CV_ALL, (F.bid - 32) * NWAVES + F.wave, nw * NWAVES);
            else { if (!(HY_FILLMASK & 1)) p0_convert(F, CV_EARLY, FL_A, (F.bid - 32) * NWAVES + F.wave, nw * NWAVES); if (!(HY_FILLMASK & 2)) p0_convert(F, FL_A, FL_B, (F.bid - 32) * NWAVES + F.wave, nw * NWAVES);
                   if (!(HY_FILLMASK & 4)) p0_convert(F, FL_B, FL_C, (F.bid - 32) * NWAVES + F.wave, nw * NWAVES); if (!(HY_FILLMASK & 8)) p0_convert(F, FL_C, CV_ALL, (F.bid - 32) * NWAVES + F.wave, nw * NWAVES); }
        }
    );
    SEAM(3);
    PHASE(4,
        if (!(F.G > 32)) {
            pg8::Gemm g0{(const bf16_t*)(ws + WS_MIX), (const bf16_t*)(ws + WS_WOUT), TT, DM, DM / 2, DM}; pg8::StaticOrder S0; S0.init(TT, DM, F.G, F.bid); S0.ksv = 1;
            EpiResidB E0{F.in[I_XP], F.in[I_XS], XB, nullptr};
            pg8::gemm_phase<EpiResidB, pg8::StaticOrder, true, true>(F.lds, g0, S0, E0);
            xcd_barrier(xbar);
        }
        pg8::Gemm g{(const bf16_t*)(ws + WS_MIX), (const bf16_t*)(ws + WS_WOUT), TT, DM, DM / 2, DM}; pg8::StaticOrder S; S.init(TT, DM, F.G, F.bid);
        EpiResidB E{nullptr, nullptr, XB, SS0};
        pg8::gemm_phase<EpiResidB, pg8::StaticOrder, true, true>(F.lds, g, S, E);
        FILL(1, (TT / 256) * (DM / 256), F.G, FL_A, FL_B);
    );
    SEAM(4);
    PHASE(5,
        pg8::Gemm g{XB, (const bf16_t*)(ws + WS_WMQ), TT, MEMW, DM, DM}; pg8::StaticOrder S; S.init(TT, MEMW, F.G, F.bid);
        EpiScaleBf16 E{(bf16_t*)(ws + WS_QM), MEMW, SS0, MEM_QSCALE};
        pg8::gemm_phase<EpiScaleBf16, pg8::StaticOrder, true, true>(F.lds, g, S, E);
        FILL(2, (TT / 256) * (MEMW / 256), F.G, FL_B, FL_C);
    );
    SEAM(5);
    PHASE(6,
        for (int u = F.bid; u < 256; u += F.G) memattn_prompt_unit(F, u);
        for (int t = F.bid; t < 256; t += F.G) memattn_sample_block(F, t);
    );
    SEAM(6);
    if (IN(7)) {
        pg8::Gemm g{(const bf16_t*)(ws + WS_OM), (const bf16_t*)(ws + WS_WMO), TT, DM, MEMW, MEMW}; pg8::StaticOrder S; S.init(TT, DM, F.G, F.bid);
        EpiResidB E{nullptr, nullptr, XB, SS1};
        pg8::gemm_phase<EpiResidB, pg8::StaticOrder, true, true>(F.lds, g, S, E);
    }
    SEAM(7);
    PHASE(8,
        pg8::Gemm g{XB, (const bf16_t*)(ws + WS_WGU), TT, 2 * FF, DM, DM}; pg8::StaticOrder S; S.init(TT, 2 * FF, F.G, F.bid);
        EpiSwiGLU E{(bf16_t*)(ws + WS_HID), SS1};
        pg8::gemm_phase<EpiSwiGLU, pg8::StaticOrder, true, true>(F.lds, g, S, E);
        FILL(3, (TT / 256) * (2 * FF / 256), F.G, FL_C, CV_ALL);
    );
    SEAM(8);
    constexpr int DN_NS = 11; constexpr size_t SLAB_STRIDE = (size_t)TS * DM;
    if (IN(9)) {
        { pg8::Gemm g{(const bf16_t*)(ws + WS_HID), (const bf16_t*)(ws + WS_WDN), TP, DM, FF, FF}; pg8::StaticOrder S; S.init(TP, DM, F.G, F.bid);
          EpiResidB E{nullptr, nullptr, XB, SS2};
          pg8::gemm_phase<EpiResidB, pg8::StaticOrder, true, true>(F.lds, g, S, E); }
        { pg8::Gemm g{(const bf16_t*)(ws + WS_HID), (const bf16_t*)(ws + WS_WDN), TT, DM, FF / DN_NS, FF}; SplitOrder S{F.bid, DN_NS};
          EpiSlab E{(float*)(ws + WS_MIX), TP, SLAB_STRIDE};
          pg8::gemm_phase<EpiSlab, SplitOrder, true, true>(F.lds, g, S, E); }
    }
    SEAM(9);
    if (IN(10)) {
        for (int m = F.bid * NWAVES + F.wave; m < TT; m += F.G * NWAVES) {
            if (m < TP) final_norm_row_b(out + (size_t)m * DM, XB + (size_t)m * DM, SS2, m, F.in[I_NFINAL], F.lane);
            else final_norm_row_slabs_b(out + (size_t)m * DM, XB + (size_t)m * DM, (const float*)(ws + WS_MIX) + (size_t)(m - TP) * DM, SLAB_STRIDE, DN_NS, F.in[I_NFINAL], F.lane);
        }
    }
#undef IN
#undef SEAM
}

#ifndef HY_N_LAUNCHES
#define HY_N_LAUNCHES 1
#endif
extern "C" void kernel_launch(void* const* d_in, const int* in_sizes, int n_in, void* d_out, int out_size, void* d_ws, size_t ws_size, hipStream_t stream) {
    static int grid = 0;
    if (grid == 0) {
        if (n_in != 26 || (size_t)out_size != O_END || ws_size < WS_END) { fprintf(stderr, "kernel_launch: unexpected problem: n_in %d out %d ws %zu (need %zu)\n", n_in, out_size, ws_size, (size_t)WS_END); grid = -1; return; }
        int dev = 0, cus = 0, per_cu = 0;
        hipGetDevice(&dev); hipDeviceGetAttribute(&cus, hipDeviceAttributeMultiprocessorCount, dev);
        if (hipFuncSetAttribute((const void*)hymba_fwd, hipFuncAttributeMaxDynamicSharedMemorySize, LDS_BYTES) != hipSuccess) { fprintf(stderr, "kernel_launch: hipFuncSetAttribute failed\n"); grid = -1; return; }
        if (hipOccupancyMaxActiveBlocksPerMultiprocessor(&per_cu, (const void*)hymba_fwd, NTHREADS, LDS_BYTES) != hipSuccess || per_cu < 1) { fprintf(stderr, "kernel_launch: occupancy query says %d blocks/CU\n", per_cu); per_cu = 1; }
        (void)hipGetLastError();
        grid = cus;
        fprintf(stderr, "kernel_launch: %d CUs, occupancy %d blocks/CU, grid %d\n", cus, per_cu, grid);
    }
    if (grid < 0) return;
    Args a{};
    for (int i = 0; i < 26; ++i) a.in[i] = (const float*)d_in[i];
    a.out = (float*)d_out; a.ws = (unsigned char*)d_ws;
    if (hipMemsetAsync((char*)d_ws + WS_BAR, 0, 16384 + 256, stream) != hipSuccess) { fprintf(stderr, "kernel_launch: hipMemsetAsync failed\n"); return; }
#if HY_N_LAUNCHES == 1
    a.ph_lo = 0; a.ph_hi = N_PHASES;
    void* kargs[] = {&a};
    hipError_t e = hipLaunchCooperativeKernel((const void*)hymba_fwd, dim3(grid), dim3(NTHREADS), kargs, LDS_BYTES, stream);
    if (e != hipSuccess) fprintf(stderr, "kernel_launch: cooperative launch failed: %s\n", hipGetErrorString(e));
#else
    for (int p = 0; p < N_PHASES; ++p) {
        a.ph_lo = p; a.ph_hi = p + 1;
        hipLaunchKernelGGL(hymba_fwd, dim3(grid), dim3(NTHREADS), LDS_BYTES, stream, a);
    }
#endif
}
```

```cpp
#include <hip/hip_runtime.h>
#include <hip/hip_cooperative_groups.h>
#include <cstdio>
#include <cstdint>
namespace cg = cooperative_groups;

#define HY_DMA7 1
#define HY_P1LATE 1
namespace pg8 {
#define PG8_LAS __attribute__((address_space(3)))
typedef unsigned short bf16_t;
typedef short bf16x8 __attribute__((ext_vector_type(8)));
typedef float f32x4 __attribute__((ext_vector_type(4)));
typedef unsigned u32x4 __attribute__((ext_vector_type(4)));
constexpr int BM = 256, BK = 64, HALF = 128, HTB = HALF * BK * 2  , STAGE_BYTES = 8 * HTB, NXCD = 8, WGM = 8;

__host__ __device__ __forceinline__ int lds_byte(int r, int c) { const int st = (r >> 4) * 2 + (c >> 5), rr = r & 15, cc = c & 31, ob = rr * 64 + cc * 2; return st * 1024 + (ob ^ (((ob >> 9) & 1) << 5)); }
__host__ __device__ __forceinline__ void stage_rc(int b, int& R, int& C) { const int st = b / 1024, sb = b % 1024, swz = sb ^ (((sb >> 9) & 1) << 5); R = (st >> 1) * 16 + swz / 64; C = (st & 1) * 32 + (swz % 64) / 2; }
__host__ __device__ __forceinline__ int perm32(int rho) { const int n = rho >> 4, i = rho & 15; return 8 * (i >> 2) + 4 * n + (i & 3); }

struct Unit { int pm, pn, ks; };
struct Gemm { const bf16_t* A; const bf16_t* Bt; int M, N, K, ld; };

struct StaticOrder {
    int nM, nN, nwg, G, c, ksv = 0;
    __host__ __device__ void init(int M, int N, int G_, int c_) { nM = M / BM; nN = N / BM; nwg = nM * nN; G = G_; c = c_; }
    __host__ __device__ bool next(int i, Unit& u) const {
        const long L = (long)i * G + c; if (L >= nwg) return false;
        int wgid = (int)L; { const int q = nwg / NXCD, r = nwg % NXCD, xcd = wgid % NXCD, off = wgid / NXCD; wgid = (xcd < r ? xcd * (q + 1) : r * (q + 1) + (xcd - r) * q) + off; }
        const int nig = WGM * nN, gid = wgid / nig, fm = gid * WGM, gsz = (nM - fm) < WGM ? (nM - fm) : WGM;
        u.pm = fm + ((wgid % nig) % gsz); u.pn = (wgid % nig) / gsz; u.ks = ksv; return true;
    }
    __device__ __forceinline__ void a_ready(const Unit&) const {}
    __device__ __forceinline__ void done(const Unit&) const {}
};
struct ChainHooks {
    const unsigned* ready = nullptr; unsigned need = 0, total = 0; unsigned* pub = nullptr; unsigned* tmo = nullptr;
    mutable unsigned known = 0;
    __device__ __forceinline__ void wait(int pm) const {
        if (!ready) return;
        if (threadIdx.x < 64 && !known) {
            const unsigned long long t0 = __builtin_amdgcn_s_memrealtime(); unsigned polls = 0;
            while ((unsigned)__builtin_amdgcn_readfirstlane(__hip_atomic_load(ready + 64 * pm, __ATOMIC_RELAXED, __HIP_MEMORY_SCOPE_AGENT)) < need) {
                if ((++polls & 255u) == 0u && __builtin_amdgcn_readfirstlane(__hip_atomic_load(tmo, __ATOMIC_RELAXED, __HIP_MEMORY_SCOPE_AGENT)) != 0u) break;
                if (__builtin_amdgcn_s_memrealtime() - t0 > 2000000ull) { if (threadIdx.x == 0) __hip_atomic_store(tmo, 1u, __ATOMIC_RELAXED, __HIP_MEMORY_SCOPE_AGENT); break; }
                __builtin_amdgcn_s_sleep(2); }
            if ((unsigned)__builtin_amdgcn_readfirstlane(__hip_atomic_load(ready + 64 * 66, __ATOMIC_RELAXED, __HIP_MEMORY_SCOPE_AGENT)) >= total) known = 1u;
            __builtin_amdgcn_fence(__ATOMIC_ACQUIRE, "agent");
            asm volatile("s_waitcnt vmcnt(0)" ::: "memory");
        }
        asm volatile("" ::: "memory"); __builtin_amdgcn_s_barrier(); asm volatile("" ::: "memory");
    }
    __device__ __forceinline__ void publish(int pm) const {
        if (!pub) return;
        asm volatile("s_waitcnt vmcnt(0)" ::: "memory");
        __builtin_amdgcn_fence(__ATOMIC_RELEASE, "agent");
        asm volatile("s_waitcnt vmcnt(0)" ::: "memory");
        if ((threadIdx.x & 63) == 0) { __hip_atomic_fetch_add(pub + 64 * pm, 1u, __ATOMIC_RELAXED, __HIP_MEMORY_SCOPE_AGENT); __hip_atomic_fetch_add(pub + 64 * 66, 1u, __ATOMIC_RELAXED, __HIP_MEMORY_SCOPE_AGENT); }
    }
};
struct ChainOrder : StaticOrder {
    ChainHooks h;
    __device__ __forceinline__ void a_ready(const Unit& u) const { h.wait(u.pm); }
    __device__ __forceinline__ void done(const Unit& u) const { h.publish(u.pm); }
};

template <class Epi, class Sched, bool ALIGN_EPI = false, bool SP2 = false>
__device__ __forceinline__ void gemm_phase(PG8_LAS unsigned char* lds, const Gemm g, const Sched& S, const Epi& E) {
    const int tid = threadIdx.x, wid = __builtin_amdgcn_readfirstlane(tid >> 6), lane = tid & 63, wr = wid >> 2, wc = wid & 3, fr = lane & 15, fq = lane >> 4;
    const int K = g.ld, nt = g.K / BK;
    unsigned voffA[2], voffB[2];
#pragma unroll
    for (int i = 0; i < 2; ++i) { int R, C; stage_rc(tid * 16 + i * 8192, R, C); const int Rb = Epi::PERM ? ((R & ~31) + perm32(R & 31)) : R;
        voffA[i] = (unsigned)(R * K + C) * 2u; voffB[i] = (unsigned)(Rb * K + C) * 2u; }
    const size_t kstep = (size_t)(BK * 2);
    const size_t hstep = (size_t)HALF * K * 2;
    const size_t tstep = 2 * hstep;
    const unsigned ldsw = (unsigned)wid * 1024u;
    const int aoff = lds_byte(wr * 64 + fr, fq * 8), boff = lds_byte(wc * 32 + fr, fq * 8);
#define PG8_SA(b, h) (((b) * 2 + (h)) * HTB)
#define PG8_SB(b, h) ((4 + (b) * 2 + (h)) * HTB)
#define PG8_STAGE(bufoff, gbase, voff) do { _Pragma("unroll") for (int _i = 0; _i < 2; ++_i) \
        __builtin_amdgcn_global_load_lds((const unsigned*)((const char*)(gbase) + (voff)[_i]), (PG8_LAS unsigned*)(lds + (bufoff) + ldsw + _i * 8192), 16, 0, 0); } while (0)
#define PG8_LDA(dst, b, h) do { _Pragma("unroll") for (int m = 0; m < 4; ++m) _Pragma("unroll") for (int k = 0; k < 2; ++k) dst[m][k] = *(const PG8_LAS bf16x8*)(lds + PG8_SA(b, h) + aoff + m * 2048 + k * 1024); } while (0)
#define PG8_LDB(dst, b, h) do { _Pragma("unroll") for (int n = 0; n < 2; ++n) _Pragma("unroll") for (int k = 0; k < 2; ++k) dst[n][k] = *(const PG8_LAS bf16x8*)(lds + PG8_SB(b, h) + boff + n * 2048 + k * 1024); } while (0)
#define PG8_MMA(ai, bj, At, Bt) do { __builtin_amdgcn_s_setprio(1); _Pragma("unroll") for (int m = 0; m < 4; ++m) _Pragma("unroll") for (int n = 0; n < 2; ++n) _Pragma("unroll") for (int k = 0; k < 2; ++k) \
        acc[ai][bj][m][n] = __builtin_amdgcn_mfma_f32_16x16x32_bf16(Bt[n][k], At[m][k], acc[ai][bj][m][n], 0, 0, 0); __builtin_amdgcn_s_setprio(0); } while (0)
#define PG8_WAIT_V(n) asm volatile("s_waitcnt vmcnt(" #n ")" ::: "memory")
#define PG8_WAIT_L(n) asm volatile("s_waitcnt lgkmcnt(" #n ")" ::: "memory")
#define PG8_BAR __builtin_amdgcn_s_barrier()
#define PG8_SCHED __builtin_amdgcn_sched_barrier(0)
    Unit cur, nxt; int ui = 0;
    if (!S.next(0, cur)) return;
    f32x4 acc[2][2][4][2];
#pragma unroll
    for (int a = 0; a < 2; ++a)
#pragma unroll
        for (int b = 0; b < 2; ++b)
#pragma unroll
            for (int m = 0; m < 4; ++m)
#pragma unroll
                for (int n = 0; n < 2; ++n) acc[a][b][m][n] = (f32x4){0.f, 0.f, 0.f, 0.f};
    bf16x8 At[4][2], B0[2][2], B1[2][2];
    const char* cA = (const char*)g.A + (size_t)cur.pm * tstep + (size_t)cur.ks * g.K * 2; const char* cB = (const char*)g.Bt + (size_t)cur.pn * tstep + (size_t)cur.ks * g.K * 2;
    S.a_ready(cur);
    if constexpr (SP2) {
        PG8_STAGE(PG8_SB(0, 0), cB, voffB); PG8_STAGE(PG8_SB(0, 1), cB + hstep, voffB); PG8_STAGE(PG8_SA(0, 0), cA, voffA); PG8_STAGE(PG8_SA(0, 1), cA + hstep, voffA);
        if (wr == 1) PG8_BAR;
        PG8_WAIT_V(2); PG8_BAR;
        PG8_STAGE(PG8_SB(1, 0), cB + kstep, voffB); PG8_STAGE(PG8_SA(1, 0), cA + kstep, voffA); PG8_STAGE(PG8_SB(1, 1), cB + hstep + kstep, voffB);
        PG8_WAIT_V(6); PG8_BAR;
    } else {
        PG8_STAGE(PG8_SB(0, 0), cB, voffB); PG8_STAGE(PG8_SA(0, 0), cA, voffA); PG8_STAGE(PG8_SB(0, 1), cB + hstep, voffB); PG8_STAGE(PG8_SA(0, 1), cA + hstep, voffA);
        if (wr == 1) PG8_BAR;
        PG8_WAIT_V(4); PG8_BAR;
        PG8_STAGE(PG8_SB(1, 0), cB + kstep, voffB); PG8_STAGE(PG8_SA(1, 0), cA + kstep, voffA); PG8_STAGE(PG8_SB(1, 1), cB + hstep + kstep, voffB);
        PG8_WAIT_V(6); PG8_BAR;
    }
    for (;;) {
        const bool has_next = S.next(ui + 1, nxt);
        const char* nA = has_next ? (const char*)g.A + (size_t)nxt.pm * tstep + (size_t)nxt.ks * g.K * 2 : cA; const char* nB = has_next ? (const char*)g.Bt + (size_t)nxt.pn * tstep + (size_t)nxt.ks * g.K * 2 : cB;
        for (int t = 0; t < nt; t += 2) {
            const bool last = (t == nt - 2);
            const char* a1 = cA + (size_t)(t + 1) * kstep;
            const char* a2 = last ? nA : cA + (size_t)(t + 2) * kstep; const char* b2 = last ? nB : cB + (size_t)(t + 2) * kstep;
            const char* a3 = a2 + kstep; const char* b3 = b2 + kstep;
            if (last && has_next) S.a_ready(nxt);
            if constexpr (SP2) {
            PG8_LDB(B0, 0, 0); PG8_LDB(B1, 0, 1); PG8_SCHED; PG8_LDA(At, 0, 0); PG8_STAGE(PG8_SA(1, 1), a1 + hstep, voffA);
            PG8_WAIT_V(8); PG8_WAIT_L(0); PG8_BAR; PG8_MMA(0, 0, At, B0); PG8_MMA(0, 1, At, B1); PG8_BAR; PG8_SCHED;
            PG8_LDA(At, 0, 1); PG8_STAGE(PG8_SB(0, 0), b2, voffB); PG8_STAGE(PG8_SB(0, 1), b2 + hstep, voffB); PG8_STAGE(PG8_SA(0, 0), a2, voffA);
            PG8_WAIT_V(8); PG8_WAIT_L(0); PG8_BAR; PG8_MMA(1, 0, At, B0); PG8_MMA(1, 1, At, B1); PG8_BAR; PG8_SCHED;
            PG8_LDB(B0, 1, 0); PG8_LDB(B1, 1, 1); PG8_SCHED; PG8_LDA(At, 1, 0); PG8_STAGE(PG8_SA(0, 1), a2 + hstep, voffA);
            PG8_WAIT_V(8); PG8_WAIT_L(0); PG8_BAR; PG8_MMA(0, 0, At, B0); PG8_MMA(0, 1, At, B1); PG8_BAR; PG8_SCHED;
            PG8_LDA(At, 1, 1); PG8_STAGE(PG8_SB(1, 0), b3, voffB); PG8_STAGE(PG8_SB(1, 1), b3 + hstep, voffB); PG8_STAGE(PG8_SA(1, 0), a3, voffA);
            PG8_WAIT_V(8); PG8_WAIT_L(0); PG8_BAR; PG8_MMA(1, 0, At, B0); PG8_MMA(1, 1, At, B1); PG8_BAR; PG8_SCHED;
            } else {
            PG8_LDB(B0, 0, 0); PG8_SCHED; PG8_LDA(At, 0, 0); PG8_STAGE(PG8_SA(1, 1), a1 + hstep, voffA);
            PG8_WAIT_L(8); PG8_BAR; PG8_WAIT_L(0); PG8_MMA(0, 0, At, B0); PG8_BAR; PG8_SCHED;
            PG8_LDB(B1, 0, 1); PG8_STAGE(PG8_SB(0, 0), b2, voffB);
            PG8_BAR; PG8_WAIT_L(0); PG8_MMA(0, 1, At, B1); PG8_BAR;
            PG8_LDA(At, 0, 1); PG8_STAGE(PG8_SA(0, 0), a2, voffA);
            PG8_BAR; PG8_WAIT_L(0); PG8_MMA(1, 0, At, B0); PG8_BAR; PG8_SCHED;
            PG8_STAGE(PG8_SB(0, 1), b2 + hstep, voffB);
            PG8_WAIT_V(6); PG8_BAR; PG8_MMA(1, 1, At, B1); PG8_BAR;
            PG8_LDB(B0, 1, 0); PG8_SCHED; PG8_LDA(At, 1, 0); PG8_STAGE(PG8_SA(0, 1), a2 + hstep, voffA);
            PG8_WAIT_L(8); PG8_BAR; PG8_WAIT_L(0); PG8_MMA(0, 0, At, B0); PG8_BAR; PG8_SCHED;
            PG8_LDB(B1, 1, 1); PG8_STAGE(PG8_SB(1, 0), b3, voffB);
            PG8_BAR; PG8_WAIT_L(0); PG8_MMA(0, 1, At, B1); PG8_BAR;
            PG8_LDA(At, 1, 1); PG8_STAGE(PG8_SA(1, 0), a3, voffA);
            PG8_BAR; PG8_WAIT_L(0); PG8_MMA(1, 0, At, B0); PG8_BAR; PG8_SCHED;
            PG8_STAGE(PG8_SB(1, 1), b3 + hstep, voffB);
            PG8_WAIT_V(6); PG8_BAR; PG8_MMA(1, 1, At, B1); PG8_BAR;
            }
        }
        if constexpr (ALIGN_EPI) { if (wr == 0) PG8_BAR; }
        if constexpr (!Epi::AFTER_DRAIN) { E(acc, cur, wr, wc, fr, fq); S.done(cur); }
        if (!has_next) break;
#pragma unroll
        for (int a = 0; a < 2; ++a)
#pragma unroll
            for (int b = 0; b < 2; ++b)
#pragma unroll
                for (int m = 0; m < 4; ++m)
#pragma unroll
                    for (int n = 0; n < 2; ++n) acc[a][b][m][n] = (f32x4){0.f, 0.f, 0.f, 0.f};
        cur = nxt; cA = nA; cB = nB; ++ui;
        if constexpr (ALIGN_EPI) { if (wr == 1) PG8_BAR; }
    }
    PG8_WAIT_V(0);
    if constexpr (!ALIGN_EPI) { if (wr == 0) PG8_BAR; }
    PG8_BAR;
    if constexpr (Epi::AFTER_DRAIN) { E.fused(acc, cur, wr, wc, fr, fq, lds, wid, lane); S.done(cur); }
#undef PG8_SA
#undef PG8_SB
#undef PG8_STAGE
#undef PG8_LDA
#undef PG8_LDB
#undef PG8_MMA
#undef PG8_WAIT_V
#undef PG8_WAIT_L
#undef PG8_BAR
#undef PG8_SCHED
}
}

#define LAS __attribute__((address_space(3)))
typedef unsigned short bf16_t;
typedef short bf16x8 __attribute__((ext_vector_type(8)));
typedef short bf16x4 __attribute__((ext_vector_type(4)));
typedef float f32x4 __attribute__((ext_vector_type(4)));
typedef float f32x2 __attribute__((ext_vector_type(2)));
typedef unsigned u32x4 __attribute__((ext_vector_type(4)));
typedef unsigned u32x2 __attribute__((ext_vector_type(2)));
typedef __bf16 hbf16x2 __attribute__((ext_vector_type(2)));

constexpr int DM = 2048, TP = 16384, TS = 512, TT = TP + TS, SEQ = 4096, DB = 128;
constexpr int NIN = 5376, FF = 5632, MEMW = 512;
constexpr int NCHP = TP / 16, NCH = NCHP + DB;
constexpr float RMS_EPS = 1e-6f;
constexpr float LOG2E = 1.4426950408889634f;
constexpr float SWA_QSCALE = 0.125f * LOG2E;
constexpr float MEM_QSCALE = 0.08838834764831845f * LOG2E;
constexpr int NWAVES = 8, NTHREADS = 512;
constexpr int LDS_BYTES = 147456;

constexpr size_t O_YP = 0, O_YS = 33554432, O_PST = 34603008, O_PSK = 35127296, O_PSV = 35192832, O_PMK = 35258368, O_PMV = 35782656,
                 O_SST = 36306944, O_SSK = 53084160, O_SSV = 55181312, O_END = 57278464;
constexpr size_t MiB = 1u << 20;
constexpr size_t WS_TAB = 1 * MiB;
constexpr size_t WS_WIN = 2 * MiB, WS_WOUT = 23 * MiB, WS_WMQ = 31 * MiB, WS_WMKV = 33 * MiB, WS_WMO = 37 * MiB, WS_WGU = 39 * MiB, WS_WDN = 83 * MiB;
constexpr size_t WS_SS = 105 * MiB;
constexpr size_t SS_STRIDE = 2359296;
constexpr size_t WS_MK = 112 * MiB, WS_MVT = 113 * MiB, WS_QM = 114 * MiB, WS_OM = 131 * MiB, WS_MN = 148 * MiB, WS_XB = 152 * MiB;
constexpr size_t WS_D = 218 * MiB;
constexpr size_t WS_GATE = WS_D, WS_SQ = WS_D + 33 * MiB, WS_SKV = WS_D + 66 * MiB, WS_QIN = WS_D + 75 * MiB, WS_KT = WS_D + 111 * MiB, WS_VT = WS_D + 147 * MiB,
                 WS_PSC = WS_D + 183 * MiB, WS_DEC = WS_D + 188 * MiB, WS_MIX = WS_D + 193 * MiB, WS_END = WS_D + 259 * MiB;
constexpr size_t WS_HID = WS_D;
static_assert((size_t)TT * FF * 2 <= 183 * MiB, "HID overlay");

struct Args {
    const float* in[26];
    float* out; unsigned char* ws;
    int ph_lo, ph_hi;
};

__device__ __forceinline__ unsigned cvtpk(float lo, float hi) { f32x2 v = {lo, hi}; hbf16x2 b = __builtin_convertvector(v, hbf16x2); return __builtin_bit_cast(unsigned, b); }
__device__ __forceinline__ float bf2f(unsigned short b) { return __uint_as_float((unsigned)b << 16); }
__device__ __forceinline__ unsigned short f2bf(float f) { return (unsigned short)(cvtpk(f, 0.f) & 0xffffu); }
__device__ __forceinline__ u32x4 pack8(f32x4 a, f32x4 b) { u32x4 w; w.x = cvtpk(a[0], a[1]); w.y = cvtpk(a[2], a[3]); w.z = cvtpk(b[0], b[1]); w.w = cvtpk(b[2], b[3]); return w; }
__device__ __forceinline__ u32x2 pack4(f32x4 a) { u32x2 w; w.x = cvtpk(a[0], a[1]); w.y = cvtpk(a[2], a[3]); return w; }
__device__ __forceinline__ float fexp(float x) { return __builtin_amdgcn_exp2f(x * LOG2E); }
__device__ __forceinline__ float fsigmoid(float x) { return __builtin_amdgcn_rcpf(1.0f + fexp(-x)); }
__device__ __forceinline__ float wave_sum(float v) {
#pragma unroll
    for (int o = 1; o < 64; o <<= 1) v += __shfl_xor(v, o);
    return v;
}
#define LDS_WAIT() asm volatile("s_waitcnt lgkmcnt(0)" ::: "memory")

__device__ __forceinline__ float row_rs(const float* SS, int row) {
    const f32x4* p = (const f32x4*)(SS + (size_t)row * 32);
    f32x4 s = p[0];
#pragma unroll
    for (int i = 1; i < 8; ++i) s += p[i];
    return __builtin_amdgcn_rsqf(((s[0] + s[1]) + (s[2] + s[3])) * (1.0f / DM) + RMS_EPS);
}

using pg8::Unit;
struct EpiIn {
    static constexpr bool PERM = true, AFTER_DRAIN = false;
    bf16_t* QF; bf16_t* GF; bf16_t* VB; bf16_t* GATE; bf16_t* SQ; bf16_t* SKV; const float* LB; float* out; int pn0 = 0;
    __device__ __forceinline__ void operator()(const f32x4 (&acc)[2][2][4][2], const Unit& u, int wr, int wc, int fr, int fq) const {
        const int pn = u.pn + pn0;
#pragma unroll
        for (int ai = 0; ai < 2; ++ai)
#pragma unroll
            for (int m = 0; m < 4; ++m) {
                const int row = u.pm * 256 + ai * 128 + wr * 64 + m * 16 + fr;
#pragma unroll
                for (int bj = 0; bj < 2; ++bj) {
                    const int c = pn * 256 + bj * 128 + wc * 32 + 8 * fq;
                    f32x4 v0 = acc[ai][bj][m][0], v1 = acc[ai][bj][m][1];
                    if (pn < 4) {
                        *(u32x4*)(QF + (size_t)row * 1024 + c) = pack8(v0, v1);
                    } else if (pn < 8) {
                        const int cc = c - 1024;
                        const f32x4 l0 = *(const f32x4*)(LB + cc), l1 = *(const f32x4*)(LB + cc + 4);
#pragma unroll
                        for (int j = 0; j < 4; ++j) { v0[j] = __logf(l0[j] + (1.0f - l0[j]) * fsigmoid(v0[j])); v1[j] = __logf(l1[j] + (1.0f - l1[j]) * fsigmoid(v1[j])); }
                        *(u32x4*)(GF + (size_t)row * 1024 + cc) = pack8(v0, v1);
                    } else if (pn < 12) {
                        *(u32x4*)(VB + (size_t)row * 1024 + (c - 2048)) = pack8(v0, v1);
                    } else if (pn < 16) {
#pragma unroll
                        for (int j = 0; j < 4; ++j) { v0[j] = v0[j] * fsigmoid(v0[j]); v1[j] = v1[j] * fsigmoid(v1[j]); }
                        *(u32x4*)(GATE + (size_t)row * 1024 + (c - 3072)) = pack8(v0, v1);
                    } else if (pn < 20) {
                        *(u32x4*)(SQ + (size_t)row * 1024 + (c - 4096)) = pack8(v0 * SWA_QSCALE, v1 * SWA_QSCALE);
                    } else {
                        const int cc = c - 5120;
                        *(u32x4*)(SKV + (size_t)row * 256 + cc) = pack8(v0, v1);
                        float* d = nullptr;
                        if (row < TP) { const int b = row >> 12, t = row & 4095; if (t >= SEQ - 128) d = out + (bj == 0 ? O_PSK : O_PSV) + (size_t)(b * 128 + (t - (SEQ - 128))) * 128 + (cc & 127); }
                        else { const int rs = row - TP, b = rs >> 2, t = rs & 3; d = out + (bj == 0 ? O_SSK : O_SSV) + (size_t)(b * 128 + 124 + t) * 128 + (cc & 127); }
                        if (d) { *(f32x4*)d = v0; *(f32x4*)(d + 4) = v1; }
                    }
                }
            }
    }
};
struct EpiMemKV {
    static constexpr bool PERM = true, AFTER_DRAIN = false;
    bf16_t* MK; bf16_t* MVT; float* out;
    __device__ __forceinline__ void operator()(const f32x4 (&acc)[2][2][4][2], const Unit& u, int wr, int wc, int fr, int fq) const {
#pragma unroll
        for (int ai = 0; ai < 2; ++ai)
#pragma unroll
            for (int m = 0; m < 4; ++m) {
                const int row = u.pm * 256 + ai * 128 + wr * 64 + m * 16 + fr;
#pragma unroll
                for (int bj = 0; bj < 2; ++bj) {
                    const int c = u.pn * 256 + bj * 128 + wc * 32 + 8 * fq;
                    const f32x4 v0 = acc[ai][bj][m][0], v1 = acc[ai][bj][m][1];
                    if (u.pn < 2) {
                        float* d = out + O_PMK + (size_t)row * 512 + c; *(f32x4*)d = v0; *(f32x4*)(d + 4) = v1;
                        *(u32x4*)(MK + (size_t)row * 512 + c) = pack8(v0, v1);
                    } else {
                        const int cv = c - 512, h = cv >> 7, dd = cv & 127, b = row >> 8, mm = row & 255;
                        float* d = out + O_PMV + (size_t)row * 512 + cv; *(f32x4*)d = v0; *(f32x4*)(d + 4) = v1;
                        bf16_t* t = MVT + ((size_t)((b * 4 + h) * 128 + dd)) * 256 + mm;
#pragma unroll
                        for (int j = 0; j < 4; ++j) { t[(size_t)j * 256] = f2bf(v0[j]); t[(size_t)(j + 4) * 256] = f2bf(v1[j]); }
                    }
                }
            }
    }
};
struct EpiResid {
    static constexpr bool PERM = true, AFTER_DRAIN = false;
    const float* resP; const float* resS; float* X; bf16_t* XB; float* SS;
    __device__ __forceinline__ void operator()(const f32x4 (&acc)[2][2][4][2], const Unit& u, int wr, int wc, int fr, int fq) const {
#pragma unroll
        for (int ai = 0; ai < 2; ++ai)
#pragma unroll
            for (int m = 0; m < 4; ++m) {
                const int row = u.pm * 256 + ai * 128 + wr * 64 + m * 16 + fr;
                const float* rrow = (row < TP) ? resP + (size_t)row * DM : resS + (size_t)(row - TP) * DM;
                float ss = 0.f;
#pragma unroll
                for (int bj = 0; bj < 2; ++bj) {
                    const int c = u.pn * 256 + bj * 128 + wc * 32 + 8 * fq;
                    const f32x4 v0 = acc[ai][bj][m][0] + *(const f32x4*)(rrow + c), v1 = acc[ai][bj][m][1] + *(const f32x4*)(rrow + c + 4);
                    float* d = X + (size_t)row * DM + c; *(f32x4*)d = v0; *(f32x4*)(d + 4) = v1;
                    ss += (v0[0] * v0[0] + v0[1] * v0[1]) + (v0[2] * v0[2] + v0[3] * v0[3]) + (v1[0] * v1[0] + v1[1] * v1[1]) + (v1[2] * v1[2] + v1[3] * v1[3]);
                    if (XB) *(u32x4*)(XB + (size_t)row * DM + c) = pack8(v0, v1);
                }
                ss += __shfl_xor(ss, 16); ss += __shfl_xor(ss, 32);
                if (SS && fq == 0) SS[(size_t)row * 32 + u.pn * 4 + wc] = ss;
            }
    }
};
struct EpiResidB {
    static constexpr bool PERM = true, AFTER_DRAIN = false;
    const float* resP; const float* resS; bf16_t* XB; float* SS;
    __device__ __forceinline__ void operator()(const f32x4 (&acc)[2][2][4][2], const Unit& u, int wr, int wc, int fr, int fq) const {
#pragma unroll
        for (int ai = 0; ai < 2; ++ai)
#pragma unroll
            for (int m = 0; m < 4; ++m) {
                const int row = u.pm * 256 + ai * 128 + wr * 64 + m * 16 + fr;
                float ss = 0.f;
#pragma unroll
                for (int bj = 0; bj < 2; ++bj) {
                    const int c = u.pn * 256 + bj * 128 + wc * 32 + 8 * fq;
                    bf16_t* d = XB + (size_t)row * DM + c;
                    f32x4 r0, r1;
                    if (resP) { const float* rrow = (row < TP) ? resP + (size_t)row * DM : resS + (size_t)(row - TP) * DM; r0 = *(const f32x4*)(rrow + c); r1 = *(const f32x4*)(rrow + c + 4); }
                    else { const u32x4 w = *(const u32x4*)d;
                        r0[0] = __uint_as_float(w.x << 16); r0[1] = __uint_as_float(w.x & 0xffff0000u); r0[2] = __uint_as_float(w.y << 16); r0[3] = __uint_as_float(w.y & 0xffff0000u);
                        r1[0] = __uint_as_float(w.z << 16); r1[1] = __uint_as_float(w.z & 0xffff0000u); r1[2] = __uint_as_float(w.w << 16); r1[3] = __uint_as_float(w.w & 0xffff0000u); }
                    const f32x4 v0 = acc[ai][bj][m][0] + r0, v1 = acc[ai][bj][m][1] + r1;
                    *(u32x4*)d = pack8(v0, v1);
                    ss += (v0[0] * v0[0] + v0[1] * v0[1]) + (v0[2] * v0[2] + v0[3] * v0[3]) + (v1[0] * v1[0] + v1[1] * v1[1]) + (v1[2] * v1[2] + v1[3] * v1[3]);
                }
                ss += __shfl_xor(ss, 16); ss += __shfl_xor(ss, 32);
                if (SS && fq == 0) SS[(size_t)row * 32 + u.pn * 4 + wc] = ss;
            }
    }
};
struct EpiSlab {
    static constexpr bool PERM = true, AFTER_DRAIN = false;
    float* SLAB; int row0; size_t slab_stride;
    __device__ __forceinline__ void operator()(const f32x4 (&acc)[2][2][4][2], const Unit& u, int wr, int wc, int fr, int fq) const {
        float* base = SLAB + (size_t)u.ks * slab_stride;
#pragma unroll
        for (int ai = 0; ai < 2; ++ai)
#pragma unroll
            for (int m = 0; m < 4; ++m) {
                const int row = u.pm * 256 + ai * 128 + wr * 64 + m * 16 + fr - row0;
#pragma unroll
                for (int bj = 0; bj < 2; ++bj) {
                    float* d = base + (size_t)row * DM + u.pn * 256 + bj * 128 + wc * 32 + 8 * fq;
                    *(f32x4*)d = acc[ai][bj][m][0]; *(f32x4*)(d + 4) = acc[ai][bj][m][1];
                }
            }
    }
};
struct SampleOrder {
    int c, nN;
    __device__ bool next(int i, Unit& u) const { if (i > 0 || c >= 2 * nN) return false; u.pm = TP / 256 + c / nN; u.pn = c % nN; u.ks = 0; return true; }
    __device__ __forceinline__ void a_ready(const Unit&) const {}
    __device__ __forceinline__ void done(const Unit&) const {}
};
struct SplitOrder {
    int c, ns;
#if defined(HY_LINKS) && HY_LINKS
    pg8::ChainHooks h;
#endif
    __device__ bool next(int i, Unit& u) const { if (i > 0 || c >= 16 * ns) return false; const int tile = c / ns; u.pm = TP / 256 + (tile >> 3); u.pn = tile & 7; u.ks = c % ns; return true; }
#if defined(HY_LINKS) && HY_LINKS
    __device__ __forceinline__ void a_ready(const Unit& u) const { h.wait(u.pm); }
#else
    __device__ __forceinline__ void a_ready(const Unit&) const {}
#endif
    __device__ __forceinline__ void done(const Unit&) const {}
};
struct EpiScaleBf16 {
    static constexpr bool PERM = true, AFTER_DRAIN = false;
    bf16_t* O; int ldc; const float* SS; float scale;
    __device__ __forceinline__ void operator()(const f32x4 (&acc)[2][2][4][2], const Unit& u, int wr, int wc, int fr, int fq) const {
#pragma unroll
        for (int ai = 0; ai < 2; ++ai)
#pragma unroll
            for (int m = 0; m < 4; ++m) {
                const int row = u.pm * 256 + ai * 128 + wr * 64 + m * 16 + fr;
                const float s = row_rs(SS, row) * scale;
#pragma unroll
                for (int bj = 0; bj < 2; ++bj) {
                    const int c = u.pn * 256 + bj * 128 + wc * 32 + 8 * fq;
                    *(u32x4*)(O + (size_t)row * ldc + c) = pack8(acc[ai][bj][m][0] * s, acc[ai][bj][m][1] * s);
                }
            }
    }
};
struct EpiSwiGLU {
    static constexpr bool PERM = true, AFTER_DRAIN = false;
    bf16_t* HID; const float* SS;
    __device__ __forceinline__ void operator()(const f32x4 (&acc)[2][2][4][2], const Unit& u, int wr, int wc, int fr, int fq) const {
#pragma unroll
        for (int ai = 0; ai < 2; ++ai)
#pragma unroll
            for (int m = 0; m < 4; ++m) {
                const int row = u.pm * 256 + ai * 128 + wr * 64 + m * 16 + fr;
                const float s = row_rs(SS, row);
                f32x4 h0, h1;
#pragma unroll
                for (int j = 0; j < 4; ++j) {
                    const float g0 = acc[ai][0][m][0][j] * s, u0 = acc[ai][1][m][0][j] * s, g1 = acc[ai][0][m][1][j] * s, u1 = acc[ai][1][m][1][j] * s;
                    h0[j] = g0 * fsigmoid(g0) * u0; h1[j] = g1 * fsigmoid(g1) * u1;
                }
                *(u32x4*)(HID + (size_t)row * FF + u.pn * 128 + wc * 32 + 8 * fq) = pack8(h0, h1);
            }
    }
};

struct Frame {
    LAS unsigned char* lds;
    int tid, lane, wave, G, bid;
    const float* const* in;
    float* out; unsigned char* ws;
};
enum { I_XP = 0, I_XS, I_STATE, I_CSK, I_CSV, I_CMK, I_CMV, I_MEMP, I_NMIX, I_WIN, I_LB, I_ONORM, I_SINKS, I_RELB, I_WOUT, I_NXATT, I_NMEM,
       I_WMQ, I_WMK, I_WMV, I_WMO, I_NFFN, I_WGATE, I_WUP, I_WDOWN, I_NFINAL };

__device__ __forceinline__ void p0_tr_item(const float* __restrict__ W, int K, int N, bf16_t* WT, int k0, int n0, int drow0, const float* __restrict__ scale, LAS float* scr, int lane) {
    float v[32];
#pragma unroll
    for (int i = 0; i < 32; ++i) v[i] = W[(size_t)(k0 + 2 * i + (lane >> 5)) * N + n0 + (lane & 31)];
    if (scale) {
#pragma unroll
        for (int i = 0; i < 32; ++i) v[i] *= scale[k0 + 2 * i + (lane >> 5)];
    }
#pragma unroll
    for (int i = 0; i < 32; ++i) scr[(2 * i + (lane >> 5)) * 33 + (lane & 31)] = v[i];
    LDS_WAIT(); asm volatile("" ::: "memory");
    const int c = lane & 7;
#pragma unroll
    for (int j = 0; j < 4; ++j) { const int n = (lane >> 3) + 8 * j; const LAS float* s = scr + (8 * c) * 33 + n;
        u32x4 o; o.x = cvtpk(s[0 * 33], s[1 * 33]); o.y = cvtpk(s[2 * 33], s[3 * 33]); o.z = cvtpk(s[4 * 33], s[5 * 33]); o.w = cvtpk(s[6 * 33], s[7 * 33]);
        *(u32x4*)(WT + (size_t)(drow0 + n) * K + k0 + 8 * c) = o; }
    LDS_WAIT(); asm volatile("" ::: "memory");
}
__device__ __forceinline__ void p0_rms_row(const float* xrow, const float* w, bf16_t* orow, int lane) {
    const f32x4* xr = (const f32x4*)xrow + lane; const f32x4* wr = (const f32x4*)w + lane;
    f32x4 v[8]; float s = 0.f;
#pragma unroll
    for (int j = 0; j < 8; ++j) { v[j] = xr[64 * j]; s += (v[j][0] * v[j][0] + v[j][1] * v[j][1]) + (v[j][2] * v[j][2] + v[j][3] * v[j][3]); }
    const float rs = __builtin_amdgcn_rsqf(wave_sum(s) * (1.0f / DM) + RMS_EPS);
    u32x2* o8 = (u32x2*)orow + lane;
#pragma unroll
    for (int j = 0; j < 8; ++j) { const f32x4 ww = wr[64 * j]; f32x4 y; y[0] = v[j][0] * rs * ww[0]; y[1] = v[j][1] * rs * ww[1]; y[2] = v[j][2] * rs * ww[2]; y[3] = v[j][3] * rs * ww[3]; o8[64 * j] = pack4(y); }
}
__device__ __forceinline__ int rel_bucket(int n) {
    if (n < 16) return n;
    int b = 16 + (int)(__logf((float)n * (1.0f / 16.0f)) / 2.0794415416798357f * 16.0f);
    return b < 31 ? b : 31;
}
constexpr int CV_IN = 32 * (NIN / 32), CV_OUT = 32 * 64, CV_MQ = 32 * 16, CV_MO = 8 * 64, CV_G = 32 * (FF / 32), CV_DN = (FF / 64) * 64;
constexpr int CV_MID1 = CV_IN + CV_OUT + CV_MQ;
constexpr int CV_EARLY = CV_IN + CV_OUT + 3 * CV_MQ, CV_ALL = CV_EARLY + CV_MO + 2 * CV_G + CV_DN;
__device__ __forceinline__ void p0_convert(Frame& F, int it0, int it1, int gw, int NGW) {
    LAS float* scr = (LAS float*)(F.lds + F.wave * 16384);
    unsigned char* ws = F.ws;
    constexpr int I_IN = CV_IN, I_OUT = CV_OUT, I_MQ = CV_MQ, I_MO = CV_MO, I_G = CV_G;
    for (int it = it0 + gw; it < it1; it += NGW) {
        int r = it;
        if (r < I_IN) { const int nb = NIN / 32, kb = r / nb, n0 = (r % nb) * 32; p0_tr_item(F.in[I_WIN], DM, NIN, (bf16_t*)(ws + WS_WIN), kb * 64, n0, n0, nullptr, scr, F.lane); continue; } r -= I_IN;
        if (r < I_OUT) { const int kb = r / 64, n0 = (r % 64) * 32; p0_tr_item(F.in[I_WOUT], DM, DM, (bf16_t*)(ws + WS_WOUT), kb * 64, n0, n0, nullptr, scr, F.lane); continue; } r -= I_OUT;
        if (r < I_MQ) { const int kb = r / 16, n0 = (r % 16) * 32; p0_tr_item(F.in[I_WMQ], DM, MEMW, (bf16_t*)(ws + WS_WMQ), kb * 64, n0, n0, F.in[I_NXATT], scr, F.lane); continue; } r -= I_MQ;
        if (r < I_MQ) { const int kb = r / 16, n0 = (r % 16) * 32; p0_tr_item(F.in[I_WMK], DM, MEMW, (bf16_t*)(ws + WS_WMKV), kb * 64, n0, n0, nullptr, scr, F.lane); continue; } r -= I_MQ;
        if (r < I_MQ) { const int kb = r / 16, n0 = (r % 16) * 32; p0_tr_item(F.in[I_WMV], DM, MEMW, (bf16_t*)(ws + WS_WMKV), kb * 64, n0, 512 + n0, nullptr, scr, F.lane); continue; } r -= I_MQ;
        if (r < I_MO) { const int kb = r / 64, n0 = (r % 64) * 32; p0_tr_item(F.in[I_WMO], MEMW, DM, (bf16_t*)(ws + WS_WMO), kb * 64, n0, n0, nullptr, scr, F.lane); continue; } r -= I_MO;
        if (r < 2 * I_G) { const int up = r >= I_G; if (up) r -= I_G; const int nb = FF / 32, kb = r / nb, n0 = (r % nb) * 32;
            p0_tr_item(F.in[up ? I_WUP : I_WGATE], DM, FF, (bf16_t*)(ws + WS_WGU), kb * 64, n0, (n0 >> 7) * 256 + (n0 & 127) + (up ? 128 : 0), F.in[I_NFFN], scr, F.lane); continue; } r -= 2 * I_G;
        { const int kb = r / 64, n0 = (r % 64) * 32; p0_tr_item(F.in[I_WDOWN], FF, DM, (bf16_t*)(ws + WS_WDN), kb * 64, n0, n0, nullptr, scr, F.lane); }
    }
}
__device__ __forceinline__ void p0_prologue(Frame& F, bool all_weights) {
    const int gw = F.bid * NWAVES + F.wave, NGW = F.G * NWAVES;
    unsigned char* ws = F.ws;
    if (all_weights) p0_convert(F, 0, CV_ALL, gw, NGW);
    else { p0_convert(F, 0, CV_IN, gw, NGW); p0_convert(F, CV_MID1, CV_EARLY, gw, NGW); }
    for (int m = gw; m < TT + 1024; m += NGW) {
        if (m < TP) p0_rms_row(F.in[I_XP] + (size_t)m * DM, F.in[I_NMIX], (bf16_t*)(ws + WS_XB) + (size_t)m * DM, F.lane);
        else if (m < TT) p0_rms_row(F.in[I_XS] + (size_t)(m - TP) * DM, F.in[I_NMIX], (bf16_t*)(ws + WS_XB) + (size_t)m * DM, F.lane);
        else p0_rms_row(F.in[I_MEMP] + (size_t)(m - TT) * DM, F.in[I_NMEM], (bf16_t*)(ws + WS_MN) + (size_t)(m - TT) * DM, F.lane);
    }
    float* LBt = (float*)(ws + WS_TAB); float* BT = (float*)(ws + WS_TAB + 8192);
    const int gt = F.bid * NTHREADS + F.tid, NGT = F.G * NTHREADS;
    for (int i = gt; i < 1024 + 16 * 160; i += NGT) {
        if (i < 1024) { const float l0 = F.in[I_LB][i], l1 = F.in[I_LB][1024 + i]; LBt[i] = 1.0f / (1.0f + __expf(l1 - l0)); }
        else { const int j = i - 1024, h = j / 160, ix = j % 160, dist = 143 - ix;
            BT[j] = (dist >= 0 && dist < 128) ? F.in[I_RELB][rel_bucket(dist) * 16 + h] * LOG2E : -INFINITY; }
    }
}


constexpr int PREP_RS = 1032;
__device__ __forceinline__ void hgrn_prep(Frame& F, int j0, int j1, int stride, bool stepmajor) {
    unsigned char* ws = F.ws;
    const bf16_t* QF = (const bf16_t*)F.out; const bf16_t* GF = QF + (size_t)TT * 1024; const bf16_t* VB = (const bf16_t*)(F.out + O_SST);
    bf16_t* QIN = (bf16_t*)(ws + WS_QIN); bf16_t* KT = (bf16_t*)(ws + WS_KT); bf16_t* VT = (bf16_t*)(ws + WS_VT); bf16_t* PSC = (bf16_t*)(ws + WS_PSC); float* DEC = (float*)(ws + WS_DEC);
    LAS bf16_t* lq = (LAS bf16_t*)F.lds; LAS bf16_t* lk = lq + 16 * PREP_RS;
    const int l15 = F.lane & 15, g4 = F.lane >> 4;
    for (int j = j0; j < j1; j += stride) {
        const int ch = (stepmajor && j < NCHP) ? ((j & 3) * (NCHP / 4) + (j >> 2)) : j;
        const int nv = ch < NCHP ? 16 : 4; const int row0 = ch < NCHP ? ch * 16 : TP + (ch - NCHP) * 4;
        {
            const int c2 = 2 * F.tid;
            unsigned gq[16], qq[16], vv[16];
#pragma unroll
            for (int t = 0; t < 16; ++t) {
                if (t < nv) { gq[t] = *(const unsigned*)(GF + (size_t)(row0 + t) * 1024 + c2); qq[t] = *(const unsigned*)(QF + (size_t)(row0 + t) * 1024 + c2); vv[t] = *(const unsigned*)(VB + (size_t)(row0 + t) * 1024 + c2); }
                else { gq[t] = 0u; qq[t] = 0u; vv[t] = 0u; }
            }
            float G0 = 0.f, G1 = 0.f; unsigned kd0[8], kd1[8], vt0[8], vt1[8];
#pragma unroll
            for (int t = 0; t < 16; t += 2) {
                float ka[2], kb[2];
#pragma unroll
                for (int z = 0; z < 2; ++z) {
                    const float g0 = __uint_as_float(gq[t + z] << 16), g1 = __uint_as_float(gq[t + z] & 0xffff0000u);
                    const float q0 = __uint_as_float(qq[t + z] << 16), q1 = __uint_as_float(qq[t + z] & 0xffff0000u);
                    G0 += g0; G1 += g1;
                    const float qi0 = q0 * fexp(G0), qi1 = q1 * fexp(G1);
                    ka[z] = (1.0f - fexp(g0)) * fexp(fminf(-G0, 80.0f)); kb[z] = (1.0f - fexp(g1)) * fexp(fminf(-G1, 80.0f));
                    *(LAS unsigned*)(lq + (t + z) * PREP_RS + c2) = cvtpk(qi0, qi1); *(LAS unsigned*)(lk + (t + z) * PREP_RS + c2) = cvtpk(ka[z], kb[z]);
                }
                kd0[t >> 1] = cvtpk(ka[0], ka[1]); kd1[t >> 1] = cvtpk(kb[0], kb[1]);
                vt0[t >> 1] = (vv[t] & 0xffffu) | (vv[t + 1] << 16); vt1[t >> 1] = (vv[t] >> 16) | (vv[t + 1] & 0xffff0000u);
            }
            *(f32x2*)(DEC + (size_t)ch * 1024 + c2) = (f32x2){fexp(G0), fexp(G1)};
            u32x4* kp = (u32x4*)(KT + ((size_t)ch * 1024 + c2) * 16); kp[0] = (u32x4){kd0[0], kd0[1], kd0[2], kd0[3]}; kp[1] = (u32x4){kd0[4], kd0[5], kd0[6], kd0[7]}; kp[2] = (u32x4){kd1[0], kd1[1], kd1[2], kd1[3]}; kp[3] = (u32x4){kd1[4], kd1[5], kd1[6], kd1[7]};
            u32x4* vp = (u32x4*)(VT + ((size_t)ch * 1024 + c2) * 16); vp[0] = (u32x4){vt0[0], vt0[1], vt0[2], vt0[3]}; vp[1] = (u32x4){vt0[4], vt0[5], vt0[6], vt0[7]}; vp[2] = (u32x4){vt1[0], vt1[1], vt1[2], vt1[3]}; vp[3] = (u32x4){vt1[4], vt1[5], vt1[6], vt1[7]};
        }
        __syncthreads();
#pragma unroll
        for (int i = 0; i < 4; ++i) { const int idx = F.tid + 512 * i, t = idx >> 7, c8 = idx & 127;
            *(u32x4*)(QIN + ((size_t)ch * 16 + t) * 1024 + c8 * 8) = *(const LAS u32x4*)(lq + t * PREP_RS + c8 * 8); }
        {
            const int h = F.wave; f32x4 acc = {0.f, 0.f, 0.f, 0.f};
#pragma unroll
            for (int kk = 0; kk < 4; ++kk) {
                const bf16x8 a = *(const LAS bf16x8*)(lq + l15 * PREP_RS + h * 128 + 32 * kk + 8 * g4);
                const bf16x8 b = *(const LAS bf16x8*)(lk + l15 * PREP_RS + h * 128 + 32 * kk + 8 * g4);
                acc = __builtin_amdgcn_mfma_f32_16x16x32_bf16(a, b, acc, 0, 0, 0);
            }
            bf16_t* pd = PSC + ((size_t)ch * 8 + h) * 256;
#pragma unroll
            for (int r = 0; r < 4; ++r) { const int t = 4 * g4 + r, s = l15; pd[t * 16 + s] = (s <= t) ? f2bf(acc[r]) : (bf16_t)0; }
        }
        __syncthreads();
    }
}

__device__ __forceinline__ void flag_signal(unsigned* p) {
    asm volatile("s_waitcnt vmcnt(0)" ::: "memory"); __syncthreads();
    if (threadIdx.x == 0) { __builtin_amdgcn_fence(__ATOMIC_RELEASE, "agent"); asm volatile("s_waitcnt vmcnt(0)" ::: "memory"); __hip_atomic_fetch_add(p, 1u, __ATOMIC_RELAXED, __HIP_MEMORY_SCOPE_AGENT); }
}
__device__ __forceinline__ void flag_wait(unsigned* p, unsigned need) {
    if (threadIdx.x == 0) {
        unsigned sp = 0; while (__hip_atomic_load(p, __ATOMIC_RELAXED, __HIP_MEMORY_SCOPE_AGENT) < need) { __builtin_amdgcn_s_sleep(2); if (++sp > (1u << 22)) break; }
        __builtin_amdgcn_fence(__ATOMIC_ACQUIRE, "agent"); asm volatile("s_waitcnt vmcnt(0)" ::: "memory");
    }
    __syncthreads();
}
constexpr int SC_QS = 136;
constexpr int SC_QI = 0, SC_KT = 16 * SC_QS * 2, SC_VT = SC_KT + 4096, SC_P = SC_VT + 4096, SC_DEC = SC_P + 512, SC_GATE = SC_DEC + 512, SC_BUF = SC_GATE + 16 * SC_QS * 2;
constexpr int SC_RED = 2 * SC_BUF;
static_assert(SC_RED + 1024 <= LDS_BYTES && SC_BUF % 16 == 0, "scan LDS");
struct ScanPf { u32x4 a, b, c; };
struct ScanSrc { const unsigned char* a; const unsigned char* b; const unsigned char* c; unsigned oa, ob, oc; };
__device__ __forceinline__ ScanSrc scan_src(const Frame& F, int ch0, int h, int grow0, int ngr) {
    const unsigned char* ws = F.ws; const int tid = F.tid; ScanSrc s;
    const bf16_t* QIN = (const bf16_t*)(ws + WS_QIN); const bf16_t* KT = (const bf16_t*)(ws + WS_KT); const bf16_t* VT = (const bf16_t*)(ws + WS_VT);
    const bf16_t* PSC = (const bf16_t*)(ws + WS_PSC); const float* DEC = (const float*)(ws + WS_DEC); const bf16_t* GATE = (const bf16_t*)(ws + WS_GATE);
    if (tid < 256) { const int t = tid >> 4, p = tid & 15;
        s.a = (const unsigned char*)(QIN + ((size_t)ch0 * 16 + t) * 1024 + h * 128 + p * 8); s.oa = SC_QI + (t * SC_QS + p * 8) * 2;
        s.b = (const unsigned char*)(VT + ((size_t)ch0 * 1024 + h * 128) * 16 + tid * 8); s.ob = SC_VT + tid * 16;
    } else { const int i = tid - 256, t = i >> 4, p = i & 15; const int tr = t < ngr ? t : ngr - 1;
        s.a = (const unsigned char*)(KT + ((size_t)ch0 * 1024 + h * 128) * 16 + i * 8); s.oa = SC_KT + i * 16;
        s.b = (const unsigned char*)(GATE + (size_t)(grow0 + tr) * 1024 + h * 128 + p * 8); s.ob = SC_GATE + (t * SC_QS + p * 8) * 2;
    }
    if (tid < 32) { s.c = (const unsigned char*)(PSC + ((size_t)ch0 * 8 + h) * 256 + tid * 8); s.oc = SC_P + tid * 16; }
    else { const int i = (tid - 32) & 31; s.c = (const unsigned char*)(DEC + (size_t)ch0 * 1024 + h * 128 + i * 4); s.oc = SC_DEC + i * 16; }
    return s;
}
__device__ __forceinline__ void scan_fetch(ScanPf& pf, const ScanSrc& s, const Frame& F, int step) {
    pf.a = *(const u32x4*)(s.a + (size_t)step * 32768); pf.b = *(const u32x4*)(s.b + (size_t)step * 32768);
    if (F.tid < 64) pf.c = *(const u32x4*)(s.c + (size_t)step * 4096);
}
__device__ __forceinline__ void scan_stash(const ScanPf& pf, const ScanSrc& s, const Frame& F, int buf) {
    LAS unsigned char* B = F.lds + buf * SC_BUF;
    *(LAS u32x4*)(B + s.oa) = pf.a; *(LAS u32x4*)(B + s.ob) = pf.b;
    if (F.tid < 64) *(LAS u32x4*)(B + s.oc) = pf.c;
}
template <int CTRL> __device__ __forceinline__ float dpp_mov(float v) { return __int_as_float(__builtin_amdgcn_update_dpp(0, __float_as_int(v), CTRL, 0xF, 0xF, true)); }
__device__ __forceinline__ float row16_sum(float v) { v += dpp_mov<0xB1>(v); v += dpp_mov<0x4E>(v); v += dpp_mov<0x141>(v); v += dpp_mov<0x140>(v); return v; }
constexpr int SC_ST = SC_RED + 1024, SC_STS = 132;
static_assert(SC_ST + 128 * SC_STS * 4 <= LDS_BYTES, "scan LDS (state image)");
template <int DBG>
__device__ __forceinline__ void hgrn_scan_t(Frame& F, int ch0, int nsteps, int h, int mrow0, int nvalid, const float* S0, float* Sout, bf16_t* MIXP, int mixld, float* DBGP) {
    const int lane = F.lane, l15 = lane & 15, g4 = lane >> 4, e0 = 16 * F.wave;
    bf16_t* MIX = MIXP;
    const float onw = F.in[I_ONORM][e0 + l15];
    LAS float* RED = (LAS float*)(F.lds + SC_RED);
    LAS float* ST = (LAS float*)(F.lds + SC_ST);
    ScanPf pf;
    __syncthreads();
    const ScanSrc src = scan_src(F, ch0, h, mrow0, nvalid);
    scan_fetch(pf, src, F, 0); scan_stash(pf, src, F, 0);
    if (nsteps > 1) scan_fetch(pf, src, F, 1);
    f32x4 S[8];
    if (S0) {
#pragma unroll
        for (int i = 0; i < 8; ++i) { const int idx = F.tid + 512 * i, c = idx >> 5, e4 = idx & 31; *(LAS f32x4*)(ST + c * SC_STS + e4 * 4) = *(const f32x4*)(S0 + (size_t)c * 128 + e4 * 4); }
    }
    __syncthreads();
#pragma unroll
    for (int mt = 0; mt < 8; ++mt)
#pragma unroll
        for (int r = 0; r < 4; ++r) S[mt][r] = S0 ? ST[(16 * mt + 4 * g4 + r) * SC_STS + e0 + l15] : 0.f;
    f32x4 o_prev = {0.f, 0.f, 0.f, 0.f}, gate_prev = {0.f, 0.f, 0.f, 0.f};
#pragma unroll 1
    for (int n = 0; n <= nsteps; ++n) {
        const int buf = n & 1;
        f32x4 o = {0.f, 0.f, 0.f, 0.f}, gate = {0.f, 0.f, 0.f, 0.f};
        if (n + 1 < nsteps) {
            scan_stash(pf, src, F, buf ^ 1);
            if (n + 2 < nsteps) scan_fetch(pf, src, F, n + 2);
        }
        if (n < nsteps) {
            const LAS unsigned char* B = F.lds + buf * SC_BUF;
            const bf16x4 vt = *(const LAS bf16x4*)(B + SC_VT + ((e0 + l15) * 16 + 4 * g4) * 2);
            const bf16x4 pa = *(const LAS bf16x4*)(B + SC_P + (l15 * 16 + 4 * g4) * 2);
            const f32x4 zz = {0.f, 0.f, 0.f, 0.f};
            f32x4 oq[4];
            const f32x4 op = __builtin_amdgcn_mfma_f32_16x16x16bf16_1k(pa, vt, zz, 0, 0, 0);
#pragma unroll
            for (int kk = 0; kk < 4; ++kk) {
                const bf16x4 q0 = *(const LAS bf16x4*)(B + SC_QI + (l15 * SC_QS + 32 * kk + 4 * g4) * 2);
                const bf16x4 q1 = *(const LAS bf16x4*)(B + SC_QI + (l15 * SC_QS + 32 * kk + 16 + 4 * g4) * 2);
                const bf16x8 qa = {q0[0], q0[1], q0[2], q0[3], q1[0], q1[1], q1[2], q1[3]};
                const u32x4 sb = pack8(S[2 * kk], S[2 * kk + 1]);
                oq[kk] = __builtin_amdgcn_mfma_f32_16x16x32_bf16(qa, __builtin_bit_cast(bf16x8, sb), zz, 0, 0, 0);
            }
            o = (oq[0] + oq[2]) + op; const f32x4 ob = oq[1] + oq[3];
#pragma unroll
            for (int mt = 0; mt < 8; ++mt) {
                const bf16x4 kt = *(const LAS bf16x4*)(B + SC_KT + ((16 * mt + l15) * 16 + 4 * g4) * 2);
                const f32x4 dc = *(const LAS f32x4*)(B + SC_DEC + (16 * mt + 4 * g4) * 4);
                S[mt] = __builtin_amdgcn_mfma_f32_16x16x16bf16_1k(kt, vt, S[mt], 0, 0, 0);
                S[mt] = S[mt] * dc;
            }
            o = o + ob;
            if constexpr (DBG == 1) {
#pragma unroll
                for (int r = 0; r < 4; ++r) DBGP[(size_t)(mrow0 + 16 * n + 4 * g4 + r) * 1024 + h * 128 + e0 + l15] = o[r];
            }
#pragma unroll
            for (int r = 0; r < 4; ++r) {
                gate[r] = bf2f(*(const LAS unsigned short*)(B + SC_GATE + ((4 * g4 + r) * SC_QS + e0 + l15) * 2));
                const float ss = row16_sum(o[r] * o[r]);
                if (l15 == 0) RED[(buf * 8 + F.wave) * 16 + 4 * g4 + r] = ss;
            }
        }
        if (n > 0) {
            const int pb = (n - 1) & 1;
#pragma unroll
            for (int r = 0; r < 4; ++r) {
                const int t = 4 * g4 + r; float tot = 0.f;
#pragma unroll
                for (int w = 0; w < 8; ++w) tot += RED[(pb * 8 + w) * 16 + t];
                const float rs = __builtin_amdgcn_rsqf(tot * (1.0f / 128.0f) + RMS_EPS);
                if constexpr (DBG == 2) DBGP[(size_t)(mrow0 + 16 * (n - 1) + t) * 1024 + h * 128 + e0 + l15] = tot;
                if constexpr (DBG == 3) DBGP[(size_t)(mrow0 + 16 * (n - 1) + t) * 1024 + h * 128 + e0 + l15] = gate_prev[r];
                if constexpr (DBG == 4) DBGP[(size_t)(mrow0 + 16 * (n - 1) + t) * 1024 + h * 128 + e0 + l15] = o_prev[r];
                if (t < nvalid) MIX[(size_t)(mrow0 + 16 * (n - 1) + t) * mixld + h * 128 + e0 + l15] = f2bf(o_prev[r] * rs * onw * gate_prev[r]);
            }
        }
        o_prev = o; gate_prev = gate;
        __syncthreads();
    }
#pragma unroll
    for (int mt = 0; mt < 8; ++mt)
#pragma unroll
        for (int r = 0; r < 4; ++r) ST[(16 * mt + 4 * g4 + r) * SC_STS + e0 + l15] = S[mt][r];
    __syncthreads();
#pragma unroll
    for (int i = 0; i < 8; ++i) { const int idx = F.tid + 512 * i, c = idx >> 5, e4 = idx & 31; *(f32x4*)(Sout + (size_t)c * 128 + e4 * 4) = *(const LAS f32x4*)(ST + c * SC_STS + e4 * 4); }
}


template <int DBG>
__device__ __forceinline__ void hgrn_scan_pd_t(Frame& F, int ch0, int nsteps, int h, int mrow0, int nvalid, const float* S0, float* Sout, bf16_t* MIXP, int mixld, float* DBGP) {
    const int lane = F.lane, l15 = lane & 15, g4 = lane >> 4, e0 = 16 * F.wave;
    bf16_t* MIX = MIXP;
    const float onw = F.in[I_ONORM][e0 + l15];
    LAS float* RED = (LAS float*)(F.lds + SC_RED);
    LAS float* ST = (LAS float*)(F.lds + SC_ST);
    constexpr int PD = 2;
    ScanPf pf[PD];
    __syncthreads();
    const ScanSrc src = scan_src(F, ch0, h, mrow0, nvalid);
#pragma unroll
    for (int j = 0; j < PD; ++j) if (j < nsteps) scan_fetch(pf[j], src, F, j);
    scan_stash(pf[0], src, F, 0);
    if (PD < nsteps) scan_fetch(pf[0], src, F, PD);
    f32x4 S[8];
    if (S0) {
#pragma unroll
        for (int i = 0; i < 8; ++i) { const int idx = F.tid + 512 * i, c = idx >> 5, e4 = idx & 31; *(LAS f32x4*)(ST + c * SC_STS + e4 * 4) = *(const f32x4*)(S0 + (size_t)c * 128 + e4 * 4); }
    }
    __syncthreads();
#pragma unroll
    for (int mt = 0; mt < 8; ++mt)
#pragma unroll
        for (int r = 0; r < 4; ++r) S[mt][r] = S0 ? ST[(16 * mt + 4 * g4 + r) * SC_STS + e0 + l15] : 0.f;
    f32x4 o_prev = {0.f, 0.f, 0.f, 0.f}, gate_prev = {0.f, 0.f, 0.f, 0.f};
#pragma unroll 1
    for (int n = 0; n <= nsteps; ++n) {
        const int buf = n & 1;
        f32x4 o = {0.f, 0.f, 0.f, 0.f}, gate = {0.f, 0.f, 0.f, 0.f};
        if (n + 1 < nsteps) {
            const bool more = n + 1 + PD < nsteps;
            if (((n + 1) & 1) == 0) { scan_stash(pf[0], src, F, buf ^ 1); if (more) scan_fetch(pf[0], src, F, n + 1 + PD); }
            else { scan_stash(pf[1], src, F, buf ^ 1); if (more) scan_fetch(pf[1], src, F, n + 1 + PD); }
        }
        if (n < nsteps) {
            const LAS unsigned char* B = F.lds + buf * SC_BUF;
            const bf16x4 vt = *(const LAS bf16x4*)(B + SC_VT + ((e0 + l15) * 16 + 4 * g4) * 2);
            const bf16x4 pa = *(const LAS bf16x4*)(B + SC_P + (l15 * 16 + 4 * g4) * 2);
            f32x4 ob = {0.f, 0.f, 0.f, 0.f};
            o = __builtin_amdgcn_mfma_f32_16x16x16bf16_1k(pa, vt, o, 0, 0, 0);
#pragma unroll
            for (int kk = 0; kk < 4; ++kk) {
                const bf16x4 q0 = *(const LAS bf16x4*)(B + SC_QI + (l15 * SC_QS + 32 * kk + 4 * g4) * 2);
                const bf16x4 q1 = *(const LAS bf16x4*)(B + SC_QI + (l15 * SC_QS + 32 * kk + 16 + 4 * g4) * 2);
                const bf16x8 qa = {q0[0], q0[1], q0[2], q0[3], q1[0], q1[1], q1[2], q1[3]};
                const u32x4 sb = pack8(S[2 * kk], S[2 * kk + 1]);
                if (kk & 1) ob = __builtin_amdgcn_mfma_f32_16x16x32_bf16(qa, __builtin_bit_cast(bf16x8, sb), ob, 0, 0, 0);
                else o = __builtin_amdgcn_mfma_f32_16x16x32_bf16(qa, __builtin_bit_cast(bf16x8, sb), o, 0, 0, 0);
            }
#pragma unroll
            for (int mt = 0; mt < 8; ++mt) {
                const bf16x4 kt = *(const LAS bf16x4*)(B + SC_KT + ((16 * mt + l15) * 16 + 4 * g4) * 2);
                const f32x4 dc = *(const LAS f32x4*)(B + SC_DEC + (16 * mt + 4 * g4) * 4);
                S[mt] = __builtin_amdgcn_mfma_f32_16x16x16bf16_1k(kt, vt, S[mt], 0, 0, 0);
                S[mt] = S[mt] * dc;
            }
            o = o + ob;
            if constexpr (DBG == 1) {
#pragma unroll
                for (int r = 0; r < 4; ++r) DBGP[(size_t)(mrow0 + 16 * n + 4 * g4 + r) * 1024 + h * 128 + e0 + l15] = o[r];
            }
#pragma unroll
            for (int r = 0; r < 4; ++r) {
                gate[r] = bf2f(*(const LAS unsigned short*)(B + SC_GATE + ((4 * g4 + r) * SC_QS + e0 + l15) * 2));
                const float ss = row16_sum(o[r] * o[r]);
                if (l15 == 0) RED[(buf * 8 + F.wave) * 16 + 4 * g4 + r] = ss;
            }
        }
        if (n > 0) {
            const int pb = (n - 1) & 1;
#pragma unroll
            for (int r = 0; r < 4; ++r) {
                const int t = 4 * g4 + r; float tot = 0.f;
#pragma unroll
                for (int w = 0; w < 8; ++w) tot += RED[(pb * 8 + w) * 16 + t];
                const float rs = __builtin_amdgcn_rsqf(tot * (1.0f / 128.0f) + RMS_EPS);
                if constexpr (DBG == 2) DBGP[(size_t)(mrow0 + 16 * (n - 1) + t) * 1024 + h * 128 + e0 + l15] = tot;
                if constexpr (DBG == 3) DBGP[(size_t)(mrow0 + 16 * (n - 1) + t) * 1024 + h * 128 + e0 + l15] = gate_prev[r];
                if constexpr (DBG == 4) DBGP[(size_t)(mrow0 + 16 * (n - 1) + t) * 1024 + h * 128 + e0 + l15] = o_prev[r];
                if (t < nvalid) MIX[(size_t)(mrow0 + 16 * (n - 1) + t) * mixld + h * 128 + e0 + l15] = f2bf(o_prev[r] * rs * onw * gate_prev[r]);
            }
        }
        o_prev = o; gate_prev = gate;
        __syncthreads();
    }
#pragma unroll
    for (int mt = 0; mt < 8; ++mt)
#pragma unroll
        for (int r = 0; r < 4; ++r) ST[(16 * mt + 4 * g4 + r) * SC_STS + e0 + l15] = S[mt][r];
    __syncthreads();
#pragma unroll
    for (int i = 0; i < 8; ++i) { const int idx = F.tid + 512 * i, c = idx >> 5, e4 = idx & 31; *(f32x4*)(Sout + (size_t)c * 128 + e4 * 4) = *(const LAS f32x4*)(ST + c * SC_STS + e4 * 4); }
}


#ifndef HY_VFIN
#define HY_VFIN 1
#endif
#ifndef HY_VST
#define HY_VST 1
#endif
#ifndef HY_VPART
#define HY_VPART 15
#endif
#ifndef HY_VLDSW
#define HY_VLDSW 1
#endif
#ifndef HY_VISSUE
#define HY_VISSUE 1
#endif
#ifndef HY_VCOMP
#define HY_VCOMP 1
#endif
#ifndef HY_VWRITE
#define HY_VWRITE 1
#endif
constexpr int DS_QSB = 272, DS_SLOT = 18432, DS_R = 6;
constexpr int DS_RED = DS_R * DS_SLOT;
constexpr int DS_OUT = DS_RED + 1024;
constexpr int DS_ST = 0, DS_STS = 132;
static_assert(DS_OUT + 8192 <= LDS_BYTES - 64 && 128 * DS_STS * 4 <= DS_RED && DS_SLOT % 1024 == 0, "dma scan LDS");
#ifdef HY_NO_DMA
extern __shared__ __attribute__((aligned(16))) unsigned char lds_raw2[];
__device__ __forceinline__ void glds16(const void* gsrc, unsigned lds_dst) { u32x4 v = *(const u32x4*)gsrc; if (HY_VLDSW) *(LAS u32x4*)((LAS unsigned char*)lds_raw2 + lds_dst + 16 * (threadIdx.x & 63)) = v; else asm volatile("" :: "v"(v)); }
__device__ __forceinline__ void glds4(const void* gsrc, unsigned lds_dst) { unsigned v = *(const unsigned*)gsrc; if (HY_VLDSW) *(LAS unsigned*)((LAS unsigned char*)lds_raw2 + lds_dst + 4 * (threadIdx.x & 63)) = v; else asm volatile("" :: "v"(v)); }
#else
__device__ __forceinline__ void glds16(const void* gsrc, unsigned lds_dst) { unsigned keep;
    asm volatile("s_mov_b32 %0, m0\n\ts_mov_b32 m0, %2\n\ts_nop 0\n\tglobal_load_lds_dwordx4 %1, off\n\ts_mov_b32 m0, %0" : "=&s"(keep) : "v"(gsrc), "s"(lds_dst) : "memory"); }
__device__ __forceinline__ void glds4(const void* gsrc, unsigned lds_dst) { unsigned keep;
    asm volatile("s_mov_b32 %0, m0\n\ts_mov_b32 m0, %2\n\ts_nop 0\n\tglobal_load_lds_dword %1, off\n\ts_mov_b32 m0, %0" : "=&s"(keep) : "v"(gsrc), "s"(lds_dst) : "memory"); }
#endif
#ifdef HY_DSSYNC
#define DS_BAR() __syncthreads()
#else
#define DS_BAR() do { asm volatile("s_waitcnt lgkmcnt(0)" ::: "memory"); __builtin_amdgcn_s_barrier(); asm volatile("" ::: "memory"); } while (0)
#endif
template <int DBG>
__device__ __forceinline__ void hgrn_scan_dma_t(Frame& F, int ch0, int nsteps, int h, int mrow0, int nvalid, const float* S0, float* Sout, bf16_t* MIXP, int mixld, float* DBGP) {
    const int lane = F.lane, l15 = lane & 15, g4 = lane >> 4, e0 = 16 * F.wave, w = F.wave;
    const unsigned char* ws = F.ws;
    bf16_t* MIX = MIXP;
    const float onw = F.in[I_ONORM][e0 + l15];
    LAS float* RED = (LAS float*)(F.lds + DS_RED);
    LAS float* ST = (LAS float*)(F.lds + DS_ST);
    LAS bf16_t* OUTB = (LAS bf16_t*)(F.lds + DS_OUT);
    const int wq = w & 3;
    const unsigned char* sq = ws + WS_QIN + (((size_t)ch0 * 16 + 4 * wq) * 1024 + h * 128) * 2 + lane * 4;
    const unsigned char* sk = ws + WS_KT + (((size_t)ch0 * 1024 + h * 128) * 16 + (wq * 64 + lane) * 8) * 2;
    const unsigned char* sv = ws + WS_VT + (((size_t)ch0 * 1024 + h * 128) * 16 + (wq * 64 + lane) * 8) * 2;
    const unsigned char* sg = ws + WS_GATE + ((size_t)mrow0 * 1024 + h * 128) * 2 + lane * 4;
    const unsigned char* sc = lane < 32 ? ws + WS_PSC + (((size_t)ch0 * 8 + h) * 256 + lane * 8) * 2 : ws + WS_DEC + ((size_t)ch0 * 1024 + h * 128 + (lane - 32) * 4) * 4;
    int grow[4];
#pragma unroll
    for (int r = 0; r < 4; ++r) { const int t = 4 * wq + r; grow[r] = (t < nvalid ? t : nvalid - 1) * 2048; }
#ifdef HY_NO_DMA
    const unsigned ring0 = 0u;
#else
    const unsigned ring0 = (unsigned)(uintptr_t)F.lds;
#endif
#define DS_ISSUE(step, slot) do { if (w < 4) { const unsigned so_ = ring0 + (unsigned)__builtin_amdgcn_readfirstlane((int)((slot) * DS_SLOT)); const size_t go_ = (size_t)(step) * 32768; \
        if (HY_VPART & 1) { _Pragma("unroll") for (int r_ = 0; r_ < 4; ++r_) glds4(sq + go_ + r_ * 2048, so_ + SC_QI + (4 * wq + r_) * DS_QSB); } \
        if (HY_VPART & 2) { glds16(sk + go_, so_ + SC_KT + wq * 1024); glds16(sv + go_, so_ + SC_VT + wq * 1024); } \
        if (HY_VPART & 4) { _Pragma("unroll") for (int r_ = 0; r_ < 4; ++r_) glds4(sg + go_ + grow[r_], so_ + SC_GATE + (4 * wq + r_) * DS_QSB); } \
        if ((HY_VPART & 8) && w == 0) glds16(sc + (size_t)(step) * 4096, so_ + SC_P); } } while (0)
    __syncthreads();
    f32x4 S[8];
    if (S0) {
#pragma unroll
        for (int i = 0; i < 8; ++i) { const int idx = F.tid + 512 * i, c = idx >> 5, e4 = idx & 31; *(LAS f32x4*)(ST + c * DS_STS + e4 * 4) = *(const f32x4*)(S0 + (size_t)c * 128 + e4 * 4); }
        __syncthreads();
#pragma unroll
        for (int mt = 0; mt < 8; ++mt)
#pragma unroll
            for (int r = 0; r < 4; ++r) S[mt][r] = ST[(16 * mt + 4 * g4 + r) * DS_STS + e0 + l15];
        __syncthreads();
    } else {
#pragma unroll
        for (int mt = 0; mt < 8; ++mt) S[mt] = (f32x4){0.f, 0.f, 0.f, 0.f};
    }
    if (HY_VISSUE) for (int s = 0; s < DS_R - 1 && s < nsteps; ++s) DS_ISSUE(s, s);
    f32x4 o_prev = {0.f, 0.f, 0.f, 0.f}, gate_prev = {0.f, 0.f, 0.f, 0.f};
    int slot = 0;
#pragma unroll 1
    for (int n = 0; n <= nsteps + 1; ++n) {
        if (w < 4) {
#ifndef HY_DRAIN
            if (n >= DS_R && n + DS_R <= nsteps + 1) { if (w == 0) asm volatile("s_waitcnt vmcnt(44)" ::: "memory"); else asm volatile("s_waitcnt vmcnt(40)" ::: "memory"); }
            else
#endif
            asm volatile("s_waitcnt vmcnt(0)" ::: "memory");
        }
        static_assert(DS_R == 6, "the counted waits above are (DS_R - 2) * 11 and (DS_R - 2) * 10");
        DS_BAR();
        if (HY_VISSUE && n - 1 + DS_R < nsteps) { const int ps = slot == 0 ? DS_R - 1 : slot - 1; DS_ISSUE(n - 1 + DS_R, ps); }
        const int buf = n & 1;
        f32x4 o = {0.f, 0.f, 0.f, 0.f}, gate = {0.f, 0.f, 0.f, 0.f};
        if (HY_VCOMP && n < nsteps) {
            const LAS unsigned char* B = F.lds + slot * DS_SLOT;
            const bf16x4 vt = *(const LAS bf16x4*)(B + SC_VT + ((e0 + l15) * 16 + 4 * g4) * 2);
            const bf16x4 pa = *(const LAS bf16x4*)(B + SC_P + (l15 * 16 + 4 * g4) * 2);
            const f32x4 zz = {0.f, 0.f, 0.f, 0.f};
            f32x4 oq[4];
            const f32x4 op = __builtin_amdgcn_mfma_f32_16x16x16bf16_1k(pa, vt, zz, 0, 0, 0);
#pragma unroll
            for (int kk = 0; kk < 4; ++kk) {
                const bf16x4 q0 = *(const LAS bf16x4*)(B + SC_QI + l15 * DS_QSB + (32 * kk + 4 * g4) * 2);
                const bf16x4 q1 = *(const LAS bf16x4*)(B + SC_QI + l15 * DS_QSB + (32 * kk + 16 + 4 * g4) * 2);
                const bf16x8 qa = {q0[0], q0[1], q0[2], q0[3], q1[0], q1[1], q1[2], q1[3]};
                const u32x4 sb8 = pack8(S[2 * kk], S[2 * kk + 1]);
                oq[kk] = __builtin_amdgcn_mfma_f32_16x16x32_bf16(qa, __builtin_bit_cast(bf16x8, sb8), zz, 0, 0, 0);
            }
            o = (oq[0] + oq[2]) + op; const f32x4 ob = oq[1] + oq[3];
#pragma unroll
            for (int mt = 0; mt < 8; ++mt) {
                const bf16x4 kt = *(const LAS bf16x4*)(B + SC_KT + ((16 * mt + l15) * 16 + 4 * g4) * 2);
                const f32x4 dc4 = *(const LAS f32x4*)(B + SC_DEC + (16 * mt + 4 * g4) * 4);
                S[mt] = __builtin_amdgcn_mfma_f32_16x16x16bf16_1k(kt, vt, S[mt], 0, 0, 0);
                S[mt] = S[mt] * dc4;
            }
            o = o + ob;
            if constexpr (DBG == 1) {
#pragma unroll
                for (int r = 0; r < 4; ++r) DBGP[(size_t)(mrow0 + 16 * n + 4 * g4 + r) * 1024 + h * 128 + e0 + l15] = o[r];
            }
#pragma unroll
            for (int r = 0; r < 4; ++r) {
                const int t = 4 * g4 + r;
                gate[r] = bf2f(*(const LAS unsigned short*)(B + SC_GATE + t * DS_QSB + (e0 + l15) * 2));
                const float ss = row16_sum(o[r] * o[r]);
                if (l15 == 0) RED[(buf * 8 + w) * 16 + t] = ss;
            }
        }
        if (HY_VFIN && n > 0 && n <= nsteps) {
            const int pb = buf ^ 1;
#pragma unroll
            for (int r = 0; r < 4; ++r) {
                const int t = 4 * g4 + r; float tot = 0.f;
#pragma unroll
                for (int ww = 0; ww < 8; ++ww) tot += RED[(pb * 8 + ww) * 16 + t];
                const float rs = __builtin_amdgcn_rsqf(tot * (1.0f / 128.0f) + RMS_EPS);
                if constexpr (DBG == 2) DBGP[(size_t)(mrow0 + 16 * (n - 1) + t) * 1024 + h * 128 + e0 + l15] = tot;
                if constexpr (DBG == 3) DBGP[(size_t)(mrow0 + 16 * (n - 1) + t) * 1024 + h * 128 + e0 + l15] = gate_prev[r];
                if constexpr (DBG == 4) DBGP[(size_t)(mrow0 + 16 * (n - 1) + t) * 1024 + h * 128 + e0 + l15] = o_prev[r];
                OUTB[(buf * 16 + t) * 128 + e0 + l15] = f2bf(o_prev[r] * rs * onw * gate_prev[r]);
            }
        }
        if (n > 1 && w >= 4) {
            const int i = (w - 4) * 64 + lane, t = i >> 4, p = i & 15;
            if (HY_VWRITE && t < nvalid) *(u32x4*)(MIX + (size_t)(mrow0 + 16 * (n - 2) + t) * mixld + h * 128 + p * 8) = *(const LAS u32x4*)(OUTB + ((buf ^ 1) * 16 + t) * 128 + p * 8);
        }
        o_prev = o; gate_prev = gate;
        slot = slot == DS_R - 1 ? 0 : slot + 1;
    }
    asm volatile("s_waitcnt vmcnt(0)" ::: "memory");
    __syncthreads();
    if (HY_VST) {
#pragma unroll
    for (int mt = 0; mt < 8; ++mt)
#pragma unroll
        for (int r = 0; r < 4; ++r) ST[(16 * mt + 4 * g4 + r) * DS_STS + e0 + l15] = S[mt][r];
    }
    __syncthreads();
    if (HY_VWRITE)
#pragma unroll
    for (int i = 0; i < 8; ++i) { const int idx = F.tid + 512 * i, c = idx >> 5, e4 = idx & 31; *(f32x4*)(Sout + (size_t)c * 128 + e4 * 4) = *(const LAS f32x4*)(ST + c * DS_STS + e4 * 4); }
#undef DS_ISSUE
}


constexpr int D2_RED = DS_R * DS_SLOT;
constexpr int D2_RS = D2_RED + 1024;
constexpr int D2_OUT = D2_RS + 128;
static_assert(D2_OUT + 3 * 16 * 132 * 4 <= LDS_BYTES - 64 && D2_OUT % 16 == 0, "dma2 / dma4 scan LDS");
template <int N> __device__ __forceinline__ float dpp_bcast(float v) { return __int_as_float(__builtin_amdgcn_update_dpp(0, __float_as_int(v), 0x150 + N, 0xF, 0xF, true)); }
template <int MT> __device__ __forceinline__ void scan_decay(f32x4& s, float d0, float d1) {
    s[0] = s[0] * dpp_bcast<2 * MT>(d0); s[1] = s[1] * dpp_bcast<2 * MT>(d1); s[2] = s[2] * dpp_bcast<2 * MT + 1>(d0); s[3] = s[3] * dpp_bcast<2 * MT + 1>(d1);
}
__device__ __forceinline__ void hgrn_scan_dma2(Frame& F, int ch0, int nsteps, int h, int mrow0, float* Sout, unsigned* rdy, unsigned need, int rdy_step) {
    const int lane = F.lane, l15 = lane & 15, g4 = lane >> 4, e0 = 16 * F.wave, w = F.wave;
    const unsigned char* ws = F.ws;
    bf16_t* MIX = (bf16_t*)(F.ws + WS_MIX);
    const float onw = F.in[I_ONORM][e0 + l15];
    LAS float* RED = (LAS float*)(F.lds + D2_RED);
    LAS float* RS = (LAS float*)(F.lds + D2_RS);
    LAS float* ST = (LAS float*)(F.lds + DS_ST);
    LAS bf16_t* OUTB = (LAS bf16_t*)(F.lds + D2_OUT);
    const int wq = w & 3;
    const unsigned char* sq = ws + WS_QIN + (((size_t)ch0 * 16 + 4 * wq) * 1024 + h * 128) * 2 + lane * 4;
    const unsigned char* sk = ws + WS_KT + (((size_t)ch0 * 1024 + h * 128) * 16 + (wq * 64 + lane) * 8) * 2;
    const unsigned char* sv = ws + WS_VT + (((size_t)ch0 * 1024 + h * 128) * 16 + (wq * 64 + lane) * 8) * 2;
    const unsigned char* sg = ws + WS_GATE + (((size_t)mrow0 + 4 * wq) * 1024 + h * 128) * 2 + lane * 4;
    const unsigned char* sc = lane < 32 ? ws + WS_PSC + (((size_t)ch0 * 8 + h) * 256 + lane * 8) * 2 : ws + WS_DEC + ((size_t)ch0 * 1024 + h * 128 + (lane - 32) * 4) * 4;
    const unsigned ring0 = (unsigned)(uintptr_t)F.lds;
#define D2_ISSUE(step, slot) do { if (w < 4) { const unsigned so_ = ring0 + (unsigned)__builtin_amdgcn_readfirstlane((int)((slot) * DS_SLOT)); const size_t go_ = (size_t)(step) * 32768; \
        _Pragma("unroll") for (int r_ = 0; r_ < 4; ++r_) glds4(sq + go_ + r_ * 2048, so_ + SC_QI + (4 * wq + r_) * DS_QSB); \
        glds16(sk + go_, so_ + SC_KT + wq * 1024); glds16(sv + go_, so_ + SC_VT + wq * 1024); \
        _Pragma("unroll") for (int r_ = 0; r_ < 4; ++r_) glds4(sg + go_ + r_ * 2048, so_ + SC_GATE + (4 * wq + r_) * DS_QSB); \
        if (w == 0) glds16(sc + (size_t)(step) * 4096, so_ + SC_P); } } while (0)
    __syncthreads();
    f32x4 S[8];
#pragma unroll
    for (int mt = 0; mt < 8; ++mt) S[mt] = (f32x4){0.f, 0.f, 0.f, 0.f};
    for (int s = 0; s < DS_R - 1 && s < nsteps; ++s) D2_ISSUE(s, s);
    f32x4 o_p1 = {0.f, 0.f, 0.f, 0.f}, o_p2 = o_p1, gate_p1 = o_p1, gate_p2 = o_p1;
    int slot = 0;
#pragma unroll 1
    for (int n = 0; n <= nsteps + 2; ++n) {
        if (w < 4) {
            if (n >= DS_R && n + DS_R <= nsteps + 1) { if (w == 0) asm volatile("s_waitcnt vmcnt(44)" ::: "memory"); else asm volatile("s_waitcnt vmcnt(40)" ::: "memory"); }
            else asm volatile("s_waitcnt vmcnt(0)" ::: "memory");
        }
        static_assert(DS_R == 6, "the counted waits above are (DS_R - 2) * 11 and (DS_R - 2) * 10");
        DS_BAR();
        if (rdy && n - 1 + DS_R == rdy_step) flag_wait(rdy, need);
        if (n - 1 + DS_R < nsteps) { const int ps = slot == 0 ? DS_R - 1 : slot - 1; D2_ISSUE(n - 1 + DS_R, ps); }
        const int buf = n & 1;
        f32x4 o = {0.f, 0.f, 0.f, 0.f}, gate = {0.f, 0.f, 0.f, 0.f};
        if (n < nsteps) {
            const LAS unsigned char* B = F.lds + slot * DS_SLOT;
            const bf16x4 vt = *(const LAS bf16x4*)(B + SC_VT + ((e0 + l15) * 16 + 4 * g4) * 2);
            const bf16x4 pa = *(const LAS bf16x4*)(B + SC_P + (l15 * 16 + 4 * g4) * 2);
            const f32x2 dcp = *(const LAS f32x2*)(B + SC_DEC + (16 * (l15 >> 1) + 4 * g4 + 2 * (l15 & 1)) * 4);
            const f32x4 zz = {0.f, 0.f, 0.f, 0.f};
            f32x4 oq[4];
            const f32x4 op = __builtin_amdgcn_mfma_f32_16x16x16bf16_1k(pa, vt, zz, 0, 0, 0);
#pragma unroll
            for (int kk = 0; kk < 4; ++kk) {
                const bf16x4 q0 = *(const LAS bf16x4*)(B + SC_QI + l15 * DS_QSB + (32 * kk + 4 * g4) * 2);
                const bf16x4 q1 = *(const LAS bf16x4*)(B + SC_QI + l15 * DS_QSB + (32 * kk + 16 + 4 * g4) * 2);
                const bf16x8 qa = {q0[0], q0[1], q0[2], q0[3], q1[0], q1[1], q1[2], q1[3]};
                const u32x4 sb8 = pack8(S[2 * kk], S[2 * kk + 1]);
                oq[kk] = __builtin_amdgcn_mfma_f32_16x16x32_bf16(qa, __builtin_bit_cast(bf16x8, sb8), zz, 0, 0, 0);
            }
            bf16x4 kt[8];
#pragma unroll
            for (int mt = 0; mt < 8; ++mt) kt[mt] = *(const LAS bf16x4*)(B + SC_KT + ((16 * mt + l15) * 16 + 4 * g4) * 2);
#pragma unroll
            for (int mt = 0; mt < 8; ++mt) S[mt] = __builtin_amdgcn_mfma_f32_16x16x16bf16_1k(kt[mt], vt, S[mt], 0, 0, 0);
            scan_decay<0>(S[0], dcp[0], dcp[1]); scan_decay<1>(S[1], dcp[0], dcp[1]); scan_decay<2>(S[2], dcp[0], dcp[1]); scan_decay<3>(S[3], dcp[0], dcp[1]);
            scan_decay<4>(S[4], dcp[0], dcp[1]); scan_decay<5>(S[5], dcp[0], dcp[1]); scan_decay<6>(S[6], dcp[0], dcp[1]); scan_decay<7>(S[7], dcp[0], dcp[1]);
            o = ((oq[0] + oq[2]) + op) + (oq[1] + oq[3]);
#pragma unroll
            for (int r = 0; r < 4; ++r) {
                const int t = 4 * g4 + r;
                gate[r] = bf2f(*(const LAS unsigned short*)(B + SC_GATE + t * DS_QSB + (e0 + l15) * 2));
                const float ss = row16_sum(o[r] * o[r]);
                if (l15 == 0) RED[(buf * 16 + t) * 8 + w] = ss;
            }
        }
        if (n > 0 && n <= nsteps) {
            const int i = lane & 15, t = 2 * w + (i >> 3);
            float v = RED[((buf ^ 1) * 16 + t) * 8 + (i & 7)];
            v += dpp_mov<0xB1>(v); v += dpp_mov<0x4E>(v); v += dpp_mov<0x141>(v);
            const float rs = __builtin_amdgcn_rsqf(v * (1.0f / 128.0f) + RMS_EPS);
            if (lane < 16 && (lane & 7) == 0) RS[(buf ^ 1) * 16 + t] = rs;
        }
        if (n > 1 && n <= nsteps + 1) {
            const f32x4 rs4 = *(const LAS f32x4*)(RS + buf * 16 + 4 * g4);
#pragma unroll
            for (int r = 0; r < 4; ++r) OUTB[(buf * 16 + 4 * g4 + r) * 128 + e0 + l15] = f2bf(o_p2[r] * rs4[r] * onw * gate_p2[r]);
        }
        if (n > 2 && w >= 4) {
            const int i = (w - 4) * 64 + lane, t = i >> 4, p = i & 15;
            *(u32x4*)(MIX + (size_t)(mrow0 + 16 * (n - 3) + t) * DM + h * 128 + p * 8) = *(const LAS u32x4*)(OUTB + ((buf ^ 1) * 16 + t) * 128 + p * 8);
        }
        o_p2 = o_p1; gate_p2 = gate_p1; o_p1 = o; gate_p1 = gate;
        slot = slot == DS_R - 1 ? 0 : slot + 1;
    }
    asm volatile("s_waitcnt vmcnt(0)" ::: "memory");
    __syncthreads();
#pragma unroll
    for (int mt = 0; mt < 8; ++mt)
#pragma unroll
        for (int r = 0; r < 4; ++r) ST[(16 * mt + 4 * g4 + r) * DS_STS + e0 + l15] = S[mt][r];
    __syncthreads();
#pragma unroll
    for (int i = 0; i < 8; ++i) { const int idx = F.tid + 512 * i, c = idx >> 5, e4 = idx & 31; *(f32x4*)(Sout + (size_t)c * 128 + e4 * 4) = *(const LAS f32x4*)(ST + c * DS_STS + e4 * 4); }
#undef D2_ISSUE
}

__device__ __forceinline__ void hgrn_scan_dma4(Frame& F, int ch0, int nsteps, int h, int mrow0, float* Sout, unsigned* rdy, unsigned need, int rdy_step) {
    const int lane = F.lane, l15 = lane & 15, g4 = lane >> 4, e0 = 16 * F.wave, w = F.wave;
    const unsigned char* ws = F.ws;
    bf16_t* MIX = (bf16_t*)(F.ws + WS_MIX);
    const float onw = F.in[I_ONORM][e0 + l15];
    LAS float* RED = (LAS float*)(F.lds + D2_RED);
    LAS float* RS = (LAS float*)(F.lds + D2_RS);
    LAS float* ST = (LAS float*)(F.lds + DS_ST);
    LAS float* UB = (LAS float*)(F.lds + D2_OUT);
    const int wq = w & 3;
    const unsigned char* sq = ws + WS_QIN + (((size_t)ch0 * 16 + 4 * wq) * 1024 + h * 128) * 2 + lane * 4;
    const unsigned char* sk = ws + WS_KT + (((size_t)ch0 * 1024 + h * 128) * 16 + (wq * 64 + lane) * 8) * 2;
    const unsigned char* sv = ws + WS_VT + (((size_t)ch0 * 1024 + h * 128) * 16 + (wq * 64 + lane) * 8) * 2;
    const unsigned char* sg = ws + WS_GATE + (((size_t)mrow0 + 4 * wq) * 1024 + h * 128) * 2 + lane * 4;
    const unsigned char* sc = lane < 32 ? ws + WS_PSC + (((size_t)ch0 * 8 + h) * 256 + lane * 8) * 2 : ws + WS_DEC + ((size_t)ch0 * 1024 + h * 128 + (lane - 32) * 4) * 4;
    const unsigned ring0 = (unsigned)(uintptr_t)F.lds;
#define D4_ISSUE(step, slot) do { if (w < 4) { const unsigned so_ = ring0 + (unsigned)__builtin_amdgcn_readfirstlane((int)((slot) * DS_SLOT)); const size_t go_ = (size_t)(step) * 32768; \
        _Pragma("unroll") for (int r_ = 0; r_ < 4; ++r_) glds4(sq + go_ + r_ * 2048, so_ + SC_QI + (4 * wq + r_) * DS_QSB); \
        glds16(sk + go_, so_ + SC_KT + wq * 1024); glds16(sv + go_, so_ + SC_VT + wq * 1024); \
        _Pragma("unroll") for (int r_ = 0; r_ < 4; ++r_) glds4(sg + go_ + r_ * 2048, so_ + SC_GATE + (4 * wq + r_) * DS_QSB); \
        if (w == 0) glds16(sc + (size_t)(step) * 4096, so_ + SC_P); } } while (0)
    __syncthreads();
    f32x4 S[8];
#pragma unroll
    for (int mt = 0; mt < 8; ++mt) S[mt] = (f32x4){0.f, 0.f, 0.f, 0.f};
    for (int s = 0; s < DS_R - 1 && s < nsteps; ++s) D4_ISSUE(s, s);
    int ub = 0;
    int slot = 0;
#pragma unroll 1
    for (int n = 0; n <= nsteps + 1; ++n) {
        if (w < 4) {
            if (n >= DS_R && n + DS_R <= nsteps + 1) { if (w == 0) asm volatile("s_waitcnt vmcnt(44)" ::: "memory"); else asm volatile("s_waitcnt vmcnt(40)" ::: "memory"); }
            else asm volatile("s_waitcnt vmcnt(0)" ::: "memory");
        }
        static_assert(DS_R == 6, "the counted waits above are (DS_R - 2) * 11 and (DS_R - 2) * 10");
        DS_BAR();
        if (rdy && n - 1 + DS_R == rdy_step) flag_wait(rdy, need);
        if (n - 1 + DS_R < nsteps) { const int ps = slot == 0 ? DS_R - 1 : slot - 1; D4_ISSUE(n - 1 + DS_R, ps); }
        const int buf = n & 1;
        if (n < nsteps) {
            const LAS unsigned char* B = F.lds + slot * DS_SLOT;
            const bf16x4 vt = *(const LAS bf16x4*)(B + SC_VT + ((e0 + l15) * 16 + 4 * g4) * 2);
            const bf16x4 pa = *(const LAS bf16x4*)(B + SC_P + (l15 * 16 + 4 * g4) * 2);
            const f32x2 dcp = *(const LAS f32x2*)(B + SC_DEC + (16 * (l15 >> 1) + 4 * g4 + 2 * (l15 & 1)) * 4);
            const f32x4 zz = {0.f, 0.f, 0.f, 0.f};
            f32x4 oq[4];
            const f32x4 op = __builtin_amdgcn_mfma_f32_16x16x16bf16_1k(pa, vt, zz, 0, 0, 0);
#pragma unroll
            for (int kk = 0; kk < 4; ++kk) {
                const bf16x4 q0 = *(const LAS bf16x4*)(B + SC_QI + l15 * DS_QSB + (32 * kk + 4 * g4) * 2);
                const bf16x4 q1 = *(const LAS bf16x4*)(B + SC_QI + l15 * DS_QSB + (32 * kk + 16 + 4 * g4) * 2);
                const bf16x8 qa = {q0[0], q0[1], q0[2], q0[3], q1[0], q1[1], q1[2], q1[3]};
                const u32x4 sb8 = pack8(S[2 * kk], S[2 * kk + 1]);
                oq[kk] = __builtin_amdgcn_mfma_f32_16x16x32_bf16(qa, __builtin_bit_cast(bf16x8, sb8), zz, 0, 0, 0);
            }
            bf16x4 kt[8];
#pragma unroll
            for (int mt = 0; mt < 8; ++mt) kt[mt] = *(const LAS bf16x4*)(B + SC_KT + ((16 * mt + l15) * 16 + 4 * g4) * 2);
#pragma unroll
            for (int mt = 0; mt < 8; ++mt) S[mt] = __builtin_amdgcn_mfma_f32_16x16x16bf16_1k(kt[mt], vt, S[mt], 0, 0, 0);
#ifdef HY_DCLDS
#pragma unroll
            for (int mt = 0; mt < 8; ++mt) { const f32x4 dc4 = *(const LAS f32x4*)(B + SC_DEC + (16 * mt + 4 * g4) * 4); S[mt] = S[mt] * dc4; }
#else
            scan_decay<0>(S[0], dcp[0], dcp[1]); scan_decay<1>(S[1], dcp[0], dcp[1]); scan_decay<2>(S[2], dcp[0], dcp[1]); scan_decay<3>(S[3], dcp[0], dcp[1]);
            scan_decay<4>(S[4], dcp[0], dcp[1]); scan_decay<5>(S[5], dcp[0], dcp[1]); scan_decay<6>(S[6], dcp[0], dcp[1]); scan_decay<7>(S[7], dcp[0], dcp[1]);
#endif
            const f32x4 o = ((oq[0] + oq[2]) + op) + (oq[1] + oq[3]);
#pragma unroll
            for (int r = 0; r < 4; ++r) {
                const int t = 4 * g4 + r;
                const float gt = bf2f(*(const LAS unsigned short*)(B + SC_GATE + t * DS_QSB + (e0 + l15) * 2));
                UB[(ub * 16 + t) * 132 + e0 + l15] = o[r] * gt * onw;
                const float ss = row16_sum(o[r] * o[r]);
                if (l15 == 0) RED[(buf * 16 + t) * 8 + w] = ss;
            }
        }
        if (n > 0 && n <= nsteps) {
            const int i = lane & 15, t = 2 * w + (i >> 3);
            float v = RED[((buf ^ 1) * 16 + t) * 8 + (i & 7)];
            v += dpp_mov<0xB1>(v); v += dpp_mov<0x4E>(v); v += dpp_mov<0x141>(v);
            const float rs = __builtin_amdgcn_rsqf(v * (1.0f / 128.0f) + RMS_EPS);
            if (lane < 16 && (lane & 7) == 0) RS[(buf ^ 1) * 16 + t] = rs;
        }
        if (n > 1 && w >= 4) {
            const int i = (w - 4) * 64 + lane, t = i >> 4, p = i & 15, ub2 = ub == 0 ? 1 : ub - 2 + (ub == 1 ? 3 : 0);
            const float rs = RS[buf * 16 + t];
            const LAS float* ur = UB + (ub2 * 16 + t) * 132 + p * 8;
            const f32x4 u0 = *(const LAS f32x4*)ur, u1 = *(const LAS f32x4*)(ur + 4);
            *(u32x4*)(MIX + (size_t)(mrow0 + 16 * (n - 2) + t) * DM + h * 128 + p * 8) = pack8(u0 * rs, u1 * rs);
        }
        ub = ub == 2 ? 0 : ub + 1;
        slot = slot == DS_R - 1 ? 0 : slot + 1;
    }
    asm volatile("s_waitcnt vmcnt(0)" ::: "memory");
    __syncthreads();
#pragma unroll
    for (int mt = 0; mt < 8; ++mt)
#pragma unroll
        for (int r = 0; r < 4; ++r) ST[(16 * mt + 4 * g4 + r) * DS_STS + e0 + l15] = S[mt][r];
    __syncthreads();
#pragma unroll
    for (int i = 0; i < 8; ++i) { const int idx = F.tid + 512 * i, c = idx >> 5, e4 = idx & 31; *(f32x4*)(Sout + (size_t)c * 128 + e4 * 4) = *(const LAS f32x4*)(ST + c * DS_STS + e4 * 4); }
#undef D4_ISSUE
}

constexpr int D5_RED = DS_R * DS_SLOT;
__device__ __forceinline__ void hgrn_scan_dma5(Frame& F, int ch0, int nsteps, int h, int mrow0, float* Sout) {
    const int lane = F.lane, l15 = lane & 15, g4 = lane >> 4, w = F.wave, wq = w & 3, eb = 32 * wq;
    const bool cw = w < 4;
    const unsigned char* ws = F.ws;
    bf16_t* MIX = (bf16_t*)(F.ws + WS_MIX);
    const float onw0 = F.in[I_ONORM][eb + l15], onw1 = F.in[I_ONORM][eb + 16 + l15];
    LAS float* RED = (LAS float*)(F.lds + D5_RED);
    LAS float* RS = (LAS float*)(F.lds + D2_RS);
    LAS float* ST = (LAS float*)(F.lds + DS_ST);
    LAS float* UB = (LAS float*)(F.lds + D2_OUT);
    const unsigned char* sq = ws + WS_QIN + (((size_t)ch0 * 16 + 4 * wq) * 1024 + h * 128) * 2 + lane * 4;
    const unsigned char* sk = ws + WS_KT + (((size_t)ch0 * 1024 + h * 128) * 16 + (wq * 64 + lane) * 8) * 2;
    const unsigned char* sv = ws + WS_VT + (((size_t)ch0 * 1024 + h * 128) * 16 + (wq * 64 + lane) * 8) * 2;
    const unsigned char* sg = ws + WS_GATE + (((size_t)mrow0 + 4 * wq) * 1024 + h * 128) * 2 + lane * 4;
    const unsigned char* sc = lane < 32 ? ws + WS_PSC + (((size_t)ch0 * 8 + h) * 256 + lane * 8) * 2 : ws + WS_DEC + ((size_t)ch0 * 1024 + h * 128 + (lane - 32) * 4) * 4;
    const unsigned ring0 = (unsigned)(uintptr_t)F.lds;
#define D5_ISSUE(step, slot) do { if (cw) { const unsigned so_ = ring0 + (unsigned)__builtin_amdgcn_readfirstlane((int)((slot) * DS_SLOT)); const size_t go_ = (size_t)(step) * 32768; \
        _Pragma("unroll") for (int r_ = 0; r_ < 4; ++r_) glds4(sq + go_ + r_ * 2048, so_ + SC_QI + (4 * wq + r_) * DS_QSB); \
        glds16(sk + go_, so_ + SC_KT + wq * 1024); glds16(sv + go_, so_ + SC_VT + wq * 1024); \
        _Pragma("unroll") for (int r_ = 0; r_ < 4; ++r_) glds4(sg + go_ + r_ * 2048, so_ + SC_GATE + (4 * wq + r_) * DS_QSB); \
        if (w == 0) glds16(sc + (size_t)(step) * 4096, so_ + SC_P); } } while (0)
    __syncthreads();
    f32x4 S0[8], S1[8];
#pragma unroll
    for (int mt = 0; mt < 8; ++mt) { S0[mt] = (f32x4){0.f, 0.f, 0.f, 0.f}; S1[mt] = S0[mt]; }
    for (int s = 0; s < DS_R - 1 && s < nsteps; ++s) D5_ISSUE(s, s);
    int ub = 0;
    int slot = 0;
#pragma unroll 1
    for (int n = 0; n <= nsteps + 1; ++n) {
        if (cw) {
            if (n >= DS_R && n + DS_R <= nsteps + 1) { if (w == 0) asm volatile("s_waitcnt vmcnt(44)" ::: "memory"); else asm volatile("s_waitcnt vmcnt(40)" ::: "memory"); }
            else asm volatile("s_waitcnt vmcnt(0)" ::: "memory");
        }
        static_assert(DS_R == 6, "the counted waits above are (DS_R - 2) * 11 and (DS_R - 2) * 10");
        DS_BAR();
        if (n - 1 + DS_R < nsteps) { const int ps = slot == 0 ? DS_R - 1 : slot - 1; D5_ISSUE(n - 1 + DS_R, ps); }
        const int buf = n & 1;
        if (cw && n < nsteps) {
            const LAS unsigned char* B = F.lds + slot * DS_SLOT;
            const bf16x4 vt0 = *(const LAS bf16x4*)(B + SC_VT + ((eb + l15) * 16 + 4 * g4) * 2), vt1 = *(const LAS bf16x4*)(B + SC_VT + ((eb + 16 + l15) * 16 + 4 * g4) * 2);
            const bf16x4 pa = *(const LAS bf16x4*)(B + SC_P + (l15 * 16 + 4 * g4) * 2);
            const f32x2 dcp = *(const LAS f32x2*)(B + SC_DEC + (16 * (l15 >> 1) + 4 * g4 + 2 * (l15 & 1)) * 4);
            const f32x4 zz = {0.f, 0.f, 0.f, 0.f};
            f32x4 oq0[4], oq1[4];
            const f32x4 op0 = __builtin_amdgcn_mfma_f32_16x16x16bf16_1k(pa, vt0, zz, 0, 0, 0), op1 = __builtin_amdgcn_mfma_f32_16x16x16bf16_1k(pa, vt1, zz, 0, 0, 0);
#pragma unroll
            for (int kk = 0; kk < 4; ++kk) {
                const bf16x4 q0 = *(const LAS bf16x4*)(B + SC_QI + l15 * DS_QSB + (32 * kk + 4 * g4) * 2);
                const bf16x4 q1 = *(const LAS bf16x4*)(B + SC_QI + l15 * DS_QSB + (32 * kk + 16 + 4 * g4) * 2);
                const bf16x8 qa = {q0[0], q0[1], q0[2], q0[3], q1[0], q1[1], q1[2], q1[3]};
                const u32x4 sa = pack8(S0[2 * kk], S0[2 * kk + 1]), sb = pack8(S1[2 * kk], S1[2 * kk + 1]);
                oq0[kk] = __builtin_amdgcn_mfma_f32_16x16x32_bf16(qa, __builtin_bit_cast(bf16x8, sa), zz, 0, 0, 0);
                oq1[kk] = __builtin_amdgcn_mfma_f32_16x16x32_bf16(qa, __builtin_bit_cast(bf16x8, sb), zz, 0, 0, 0);
            }
#pragma unroll
            for (int mt = 0; mt < 8; ++mt) {
                const bf16x4 kt = *(const LAS bf16x4*)(B + SC_KT + ((16 * mt + l15) * 16 + 4 * g4) * 2);
                S0[mt] = __builtin_amdgcn_mfma_f32_16x16x16bf16_1k(kt, vt0, S0[mt], 0, 0, 0);
                S1[mt] = __builtin_amdgcn_mfma_f32_16x16x16bf16_1k(kt, vt1, S1[mt], 0, 0, 0);
            }
            scan_decay<0>(S0[0], dcp[0], dcp[1]); scan_decay<1>(S0[1], dcp[0], dcp[1]); scan_decay<2>(S0[2], dcp[0], dcp[1]); scan_decay<3>(S0[3], dcp[0], dcp[1]);
            scan_decay<4>(S0[4], dcp[0], dcp[1]); scan_decay<5>(S0[5], dcp[0], dcp[1]); scan_decay<6>(S0[6], dcp[0], dcp[1]); scan_decay<7>(S0[7], dcp[0], dcp[1]);
            scan_decay<0>(S1[0], dcp[0], dcp[1]); scan_decay<1>(S1[1], dcp[0], dcp[1]); scan_decay<2>(S1[2], dcp[0], dcp[1]); scan_decay<3>(S1[3], dcp[0], dcp[1]);
            scan_decay<4>(S1[4], dcp[0], dcp[1]); scan_decay<5>(S1[5], dcp[0], dcp[1]); scan_decay<6>(S1[6], dcp[0], dcp[1]); scan_decay<7>(S1[7], dcp[0], dcp[1]);
            const f32x4 o0 = ((oq0[0] + oq0[2]) + op0) + (oq0[1] + oq0[3]), o1 = ((oq1[0] + oq1[2]) + op1) + (oq1[1] + oq1[3]);
#pragma unroll
            for (int r = 0; r < 4; ++r) {
                const int t = 4 * g4 + r;
                const float g0 = bf2f(*(const LAS unsigned short*)(B + SC_GATE + t * DS_QSB + (eb + l15) * 2)), g1 = bf2f(*(const LAS unsigned short*)(B + SC_GATE + t * DS_QSB + (eb + 16 + l15) * 2));
                UB[(ub * 16 + t) * 132 + eb + l15] = o0[r] * g0 * onw0; UB[(ub * 16 + t) * 132 + eb + 16 + l15] = o1[r] * g1 * onw1;
                const float ss = row16_sum(o0[r] * o0[r] + o1[r] * o1[r]);
                if (l15 == 0) RED[(buf * 16 + t) * 4 + w] = ss;
            }
        }
        if (!cw && n > 0 && n <= nsteps) {
            const int i = lane & 15, t = 4 * (w - 4) + (i >> 2);
            float v = RED[((buf ^ 1) * 16 + t) * 4 + (i & 3)];
            v += dpp_mov<0xB1>(v); v += dpp_mov<0x4E>(v);
            const float rs = __builtin_amdgcn_rsqf(v * (1.0f / 128.0f) + RMS_EPS);
            if (lane < 16 && (lane & 3) == 0) RS[(buf ^ 1) * 16 + t] = rs;
        }
        if (!cw && n > 1) {
            const int i = (w - 4) * 64 + lane, t = i >> 4, p = i & 15, ub2 = ub == 0 ? 1 : ub - 2 + (ub == 1 ? 3 : 0);
            const float rs = RS[buf * 16 + t];
            const LAS float* ur = UB + (ub2 * 16 + t) * 132 + p * 8;
            const f32x4 u0 = *(const LAS f32x4*)ur, u1 = *(const LAS f32x4*)(ur + 4);
            *(u32x4*)(MIX + (size_t)(mrow0 + 16 * (n - 2) + t) * DM + h * 128 + p * 8) = pack8(u0 * rs, u1 * rs);
        }
        ub = ub == 2 ? 0 : ub + 1;
        slot = slot == DS_R - 1 ? 0 : slot + 1;
    }
    asm volatile("s_waitcnt vmcnt(0)" ::: "memory");
    __syncthreads();
    if (cw) {
#pragma unroll
        for (int mt = 0; mt < 8; ++mt)
#pragma unroll
            for (int r = 0; r < 4; ++r) { ST[(16 * mt + 4 * g4 + r) * DS_STS + eb + l15] = S0[mt][r]; ST[(16 * mt + 4 * g4 + r) * DS_STS + eb + 16 + l15] = S1[mt][r]; }
    }
    __syncthreads();
#pragma unroll
    for (int i = 0; i < 8; ++i) { const int idx = F.tid + 512 * i, c = idx >> 5, e4 = idx & 31; *(f32x4*)(Sout + (size_t)c * 128 + e4 * 4) = *(const LAS f32x4*)(ST + c * DS_STS + e4 * 4); }
#undef D5_ISSUE
}

__device__ __forceinline__ void hgrn_scan_dma6(Frame& F, int ch0, int nsteps, int h, int mrow0, float* Sout) {
    const int lane = F.lane, l15 = lane & 15, g4 = lane >> 4, w = F.wave, wq = w & 3, eb = 32 * wq;
    const bool cw = w < 4;
    const unsigned char* ws = F.ws;
    bf16_t* MIX = (bf16_t*)(F.ws + WS_MIX);
    const float onw0 = F.in[I_ONORM][eb + l15], onw1 = F.in[I_ONORM][eb + 16 + l15];
    LAS float* RED = (LAS float*)(F.lds + D5_RED);
    LAS float* RS = (LAS float*)(F.lds + D2_RS);
    LAS float* ST = (LAS float*)(F.lds + DS_ST);
    LAS float* UB = (LAS float*)(F.lds + D2_OUT);
    const int trow = 4 * wq + (lane >> 4), lch = (lane & 15) ^ trow;
    const unsigned char* sq = ws + WS_QIN + (((size_t)ch0 * 16 + trow) * 1024 + h * 128) * 2 + lch * 16;
    const unsigned char* sk = ws + WS_KT + (((size_t)ch0 * 1024 + h * 128) * 16 + (wq * 64 + lane) * 8) * 2;
    const unsigned char* sv = ws + WS_VT + (((size_t)ch0 * 1024 + h * 128) * 16 + (wq * 64 + lane) * 8) * 2;
    const unsigned char* sg = ws + WS_GATE + (((size_t)mrow0 + trow) * 1024 + h * 128) * 2 + lch * 16;
    const unsigned char* sc = lane < 32 ? ws + WS_PSC + (((size_t)ch0 * 8 + h) * 256 + lane * 8) * 2 : ws + WS_DEC + ((size_t)ch0 * 1024 + h * 128 + (lane - 32) * 4) * 4;
#define D6_DMA16(src, off) __builtin_amdgcn_global_load_lds((const unsigned*)(src), (LAS unsigned*)(F.lds + (off)), 16, 0, 0)
#define D6_ISSUE(step, slot) do { if (cw) { const int so_ = __builtin_amdgcn_readfirstlane((int)((slot) * DS_SLOT)) + wq * 1024; const size_t go_ = (size_t)(step) * 32768; \
        D6_DMA16(sq + go_, so_ + SC_QI); D6_DMA16(sk + go_, so_ + SC_KT); D6_DMA16(sv + go_, so_ + SC_VT); D6_DMA16(sg + go_, so_ + SC_GATE); \
        if (w == 0) D6_DMA16(sc + (size_t)(step) * 4096, so_ + SC_P); } } while (0)
    __syncthreads();
    f32x4 S0[8], S1[8];
#pragma unroll
    for (int mt = 0; mt < 8; ++mt) { S0[mt] = (f32x4){0.f, 0.f, 0.f, 0.f}; S1[mt] = S0[mt]; }
    for (int s = 0; s < DS_R - 1 && s < nsteps; ++s) D6_ISSUE(s, s);
    int ub = 0;
    int slot = 0;
#pragma unroll 1
    for (int n = 0; n <= nsteps + 1; ++n) {
        if (cw) {
            if (n >= DS_R && n + DS_R <= nsteps + 1) { if (w == 0) asm volatile("s_waitcnt vmcnt(20)" ::: "memory"); else asm volatile("s_waitcnt vmcnt(16)" ::: "memory"); }
            else asm volatile("s_waitcnt vmcnt(0)" ::: "memory");
        }
        static_assert(DS_R == 6, "the counted waits above are (DS_R - 2) * 5 and (DS_R - 2) * 4");
        DS_BAR();
        if (n - 1 + DS_R < nsteps) { const int ps = slot == 0 ? DS_R - 1 : slot - 1; D6_ISSUE(n - 1 + DS_R, ps); }
        const int buf = n & 1;
        if (cw && n < nsteps) {
            const LAS unsigned char* B = F.lds + slot * DS_SLOT;
            const bf16x4 vt0 = *(const LAS bf16x4*)(B + SC_VT + ((eb + l15) * 16 + 4 * g4) * 2), vt1 = *(const LAS bf16x4*)(B + SC_VT + ((eb + 16 + l15) * 16 + 4 * g4) * 2);
            const bf16x4 pa = *(const LAS bf16x4*)(B + SC_P + (l15 * 16 + 4 * g4) * 2);
            const f32x2 dcp = *(const LAS f32x2*)(B + SC_DEC + (16 * (l15 >> 1) + 4 * g4 + 2 * (l15 & 1)) * 4);
            const f32x4 zz = {0.f, 0.f, 0.f, 0.f};
            f32x4 oq0[4], oq1[4];
            const f32x4 op0 = __builtin_amdgcn_mfma_f32_16x16x16bf16_1k(pa, vt0, zz, 0, 0, 0), op1 = __builtin_amdgcn_mfma_f32_16x16x16bf16_1k(pa, vt1, zz, 0, 0, 0);
#pragma unroll
            for (int kk = 0; kk < 4; ++kk) {
                const bf16x4 q0 = *(const LAS bf16x4*)(B + SC_QI + l15 * 256 + (((4 * kk + (g4 >> 1)) ^ l15) << 4) + (g4 & 1) * 8);
                const bf16x4 q1 = *(const LAS bf16x4*)(B + SC_QI + l15 * 256 + (((4 * kk + 2 + (g4 >> 1)) ^ l15) << 4) + (g4 & 1) * 8);
                const bf16x8 qa = {q0[0], q0[1], q0[2], q0[3], q1[0], q1[1], q1[2], q1[3]};
                const u32x4 sa = pack8(S0[2 * kk], S0[2 * kk + 1]), sb = pack8(S1[2 * kk], S1[2 * kk + 1]);
                oq0[kk] = __builtin_amdgcn_mfma_f32_16x16x32_bf16(qa, __builtin_bit_cast(bf16x8, sa), zz, 0, 0, 0);
                oq1[kk] = __builtin_amdgcn_mfma_f32_16x16x32_bf16(qa, __builtin_bit_cast(bf16x8, sb), zz, 0, 0, 0);
            }
#pragma unroll
            for (int mt = 0; mt < 8; ++mt) {
                const bf16x4 kt = *(const LAS bf16x4*)(B + SC_KT + ((16 * mt + l15) * 16 + 4 * g4) * 2);
                S0[mt] = __builtin_amdgcn_mfma_f32_16x16x16bf16_1k(kt, vt0, S0[mt], 0, 0, 0);
                S1[mt] = __builtin_amdgcn_mfma_f32_16x16x16bf16_1k(kt, vt1, S1[mt], 0, 0, 0);
            }
            scan_decay<0>(S0[0], dcp[0], dcp[1]); scan_decay<1>(S0[1], dcp[0], dcp[1]); scan_decay<2>(S0[2], dcp[0], dcp[1]); scan_decay<3>(S0[3], dcp[0], dcp[1]);
            scan_decay<4>(S0[4], dcp[0], dcp[1]); scan_decay<5>(S0[5], dcp[0], dcp[1]); scan_decay<6>(S0[6], dcp[0], dcp[1]); scan_decay<7>(S0[7], dcp[0], dcp[1]);
            scan_decay<0>(S1[0], dcp[0], dcp[1]); scan_decay<1>(S1[1], dcp[0], dcp[1]); scan_decay<2>(S1[2], dcp[0], dcp[1]); scan_decay<3>(S1[3], dcp[0], dcp[1]);
            scan_decay<4>(S1[4], dcp[0], dcp[1]); scan_decay<5>(S1[5], dcp[0], dcp[1]); scan_decay<6>(S1[6], dcp[0], dcp[1]); scan_decay<7>(S1[7], dcp[0], dcp[1]);
            const f32x4 o0 = ((oq0[0] + oq0[2]) + op0) + (oq0[1] + oq0[3]), o1 = ((oq1[0] + oq1[2]) + op1) + (oq1[1] + oq1[3]);
#pragma unroll
            for (int r = 0; r < 4; ++r) {
                const int t = 4 * g4 + r;
                const float g0 = bf2f(*(const LAS unsigned short*)(B + SC_GATE + t * 256 + (((4 * wq + (l15 >> 3)) ^ t) << 4) + (l15 & 7) * 2)), g1 = bf2f(*(const LAS unsigned short*)(B + SC_GATE + t * 256 + (((4 * wq + 2 + (l15 >> 3)) ^ t) << 4) + (l15 & 7) * 2));
                UB[(ub * 16 + t) * 132 + eb + l15] = o0[r] * g0 * onw0; UB[(ub * 16 + t) * 132 + eb + 16 + l15] = o1[r] * g1 * onw1;
                const float ss = row16_sum(o0[r] * o0[r] + o1[r] * o1[r]);
                if (l15 == 0) RED[(buf * 16 + t) * 4 + w] = ss;
            }
        }
        if (!cw && n > 0 && n <= nsteps) {
            const int i = lane & 15, t = 4 * (w - 4) + (i >> 2);
            float v = RED[((buf ^ 1) * 16 + t) * 4 + (i & 3)];
            v += dpp_mov<0xB1>(v); v += dpp_mov<0x4E>(v);
            const float rs = __builtin_amdgcn_rsqf(v * (1.0f / 128.0f) + RMS_EPS);
            if (lane < 16 && (lane & 3) == 0) RS[(buf ^ 1) * 16 + t] = rs;
        }
        if (!cw && n > 1) {
            const int i = (w - 4) * 64 + lane, t = i >> 4, p = i & 15, ub2 = ub == 0 ? 1 : ub - 2 + (ub == 1 ? 3 : 0);
            const float rs = RS[buf * 16 + t];
            const LAS float* ur = UB + (ub2 * 16 + t) * 132 + p * 8;
            const f32x4 u0 = *(const LAS f32x4*)ur, u1 = *(const LAS f32x4*)(ur + 4);
            *(u32x4*)(MIX + (size_t)(mrow0 + 16 * (n - 2) + t) * DM + h * 128 + p * 8) = pack8(u0 * rs, u1 * rs);
        }
        ub = ub == 2 ? 0 : ub + 1;
        slot = slot == DS_R - 1 ? 0 : slot + 1;
    }
    asm volatile("s_waitcnt vmcnt(0)" ::: "memory");
    __syncthreads();
    if (cw) {
#pragma unroll
        for (int mt = 0; mt < 8; ++mt)
#pragma unroll
            for (int r = 0; r < 4; ++r) { ST[(16 * mt + 4 * g4 + r) * DS_STS + eb + l15] = S0[mt][r]; ST[(16 * mt + 4 * g4 + r) * DS_STS + eb + 16 + l15] = S1[mt][r]; }
    }
    __syncthreads();
#pragma unroll
    for (int i = 0; i < 8; ++i) { const int idx = F.tid + 512 * i, c = idx >> 5, e4 = idx & 31; *(f32x4*)(Sout + (size_t)c * 128 + e4 * 4) = *(const LAS f32x4*)(ST + c * DS_STS + e4 * 4); }
#undef D6_ISSUE
#undef D6_DMA16
}

constexpr int D7_O = DS_R * DS_SLOT;
static_assert(D7_O + 2 * 16 * 132 * 4 <= LDS_BYTES - 64, "dma7 scan LDS");
__device__ __forceinline__ void hgrn_scan_dma7(Frame& F, int ch0, int nsteps, int h, int mrow0, float* Sout) {
    const int lane = F.lane, l15 = lane & 15, g4 = lane >> 4, w = F.wave, wq = w & 3, eb = 32 * wq;
    const bool cw = w < 4;
    const unsigned char* ws = F.ws;
    bf16_t* MIX = (bf16_t*)(F.ws + WS_MIX);
    LAS float* OB = (LAS float*)(F.lds + D7_O);
    LAS float* ST = (LAS float*)(F.lds + DS_ST);
    const int hi_ = wq * 64 + lane, ht = hi_ >> 4, hp = hi_ & 15;
    const f32x4 onwa = *(const f32x4*)(F.in[I_ONORM] + 8 * hp), onwb = *(const f32x4*)(F.in[I_ONORM] + 8 * hp + 4);
    const int trow = 4 * wq + (lane >> 4), lch = (lane & 15) ^ trow;
    const unsigned char* sq = ws + WS_QIN + (((size_t)ch0 * 16 + trow) * 1024 + h * 128) * 2 + lch * 16;
    const unsigned char* sk = ws + WS_KT + (((size_t)ch0 * 1024 + h * 128) * 16 + (wq * 64 + lane) * 8) * 2;
    const unsigned char* sv = ws + WS_VT + (((size_t)ch0 * 1024 + h * 128) * 16 + (wq * 64 + lane) * 8) * 2;
    const unsigned char* sg = ws + WS_GATE + (((size_t)mrow0 + trow) * 1024 + h * 128) * 2 + lch * 16;
    const unsigned char* sc = lane < 32 ? ws + WS_PSC + (((size_t)ch0 * 8 + h) * 256 + lane * 8) * 2 : ws + WS_DEC + ((size_t)ch0 * 1024 + h * 128 + (lane - 32) * 4) * 4;
#define D7_DMA16(src, off) __builtin_amdgcn_global_load_lds((const unsigned*)(src), (LAS unsigned*)(F.lds + (off)), 16, 0, 0)
#define D7_ISSUE(step, slot) do { if (cw) { const int so_ = __builtin_amdgcn_readfirstlane((int)((slot) * DS_SLOT)) + wq * 1024; const size_t go_ = (size_t)(step) * 32768; \
        D7_DMA16(sq + go_, so_ + SC_QI); D7_DMA16(sk + go_, so_ + SC_KT); D7_DMA16(sv + go_, so_ + SC_VT); D7_DMA16(sg + go_, so_ + SC_GATE); \
        if (w == 0) D7_DMA16(sc + (size_t)(step) * 4096, so_ + SC_P); } } while (0)
    __syncthreads();
    f32x4 S0[8], S1[8];
#pragma unroll
    for (int mt = 0; mt < 8; ++mt) { S0[mt] = (f32x4){0.f, 0.f, 0.f, 0.f}; S1[mt] = S0[mt]; }
    for (int s = 0; s < DS_R - 2 && s < nsteps; ++s) D7_ISSUE(s, s);
    int slot = 0, slot4 = DS_R - 2;
#pragma unroll 1
    for (int n = 0; n <= nsteps; ++n) {
        if (cw) {
            if (n + 4 <= nsteps) { if (w == 0) asm volatile("s_waitcnt vmcnt(15)" ::: "memory"); else asm volatile("s_waitcnt vmcnt(12)" ::: "memory"); }
            else asm volatile("s_waitcnt vmcnt(0)" ::: "memory");
        }
        static_assert(DS_R == 6, "ring of six slots, prefetch distance four");
        DS_BAR();
        if (n + 4 < nsteps) D7_ISSUE(n + 4, slot4);
        const int buf = n & 1;
        if (cw) {
            if (n < nsteps) {
                const LAS unsigned char* B = F.lds + slot * DS_SLOT;
                const bf16x4 vt0 = *(const LAS bf16x4*)(B + SC_VT + ((eb + l15) * 16 + 4 * g4) * 2), vt1 = *(const LAS bf16x4*)(B + SC_VT + ((eb + 16 + l15) * 16 + 4 * g4) * 2);
                const bf16x4 pa = *(const LAS bf16x4*)(B + SC_P + (l15 * 16 + 4 * g4) * 2);
                const f32x2 dcp = *(const LAS f32x2*)(B + SC_DEC + (16 * (l15 >> 1) + 4 * g4 + 2 * (l15 & 1)) * 4);
                const f32x4 zz = {0.f, 0.f, 0.f, 0.f};
                f32x4 oq0[4], oq1[4];
                const f32x4 op0 = __builtin_amdgcn_mfma_f32_16x16x16bf16_1k(pa, vt0, zz, 0, 0, 0), op1 = __builtin_amdgcn_mfma_f32_16x16x16bf16_1k(pa, vt1, zz, 0, 0, 0);
#pragma unroll
                for (int kk = 0; kk < 4; ++kk) {
                    const bf16x4 q0 = *(const LAS bf16x4*)(B + SC_QI + l15 * 256 + (((4 * kk + (g4 >> 1)) ^ l15) << 4) + (g4 & 1) * 8);
                    const bf16x4 q1 = *(const LAS bf16x4*)(B + SC_QI + l15 * 256 + (((4 * kk + 2 + (g4 >> 1)) ^ l15) << 4) + (g4 & 1) * 8);
                    const bf16x8 qa = {q0[0], q0[1], q0[2], q0[3], q1[0], q1[1], q1[2], q1[3]};
                    const u32x4 sa = pack8(S0[2 * kk], S0[2 * kk + 1]), sb = pack8(S1[2 * kk], S1[2 * kk + 1]);
                    oq0[kk] = __builtin_amdgcn_mfma_f32_16x16x32_bf16(qa, __builtin_bit_cast(bf16x8, sa), zz, 0, 0, 0);
                    oq1[kk] = __builtin_amdgcn_mfma_f32_16x16x32_bf16(qa, __builtin_bit_cast(bf16x8, sb), zz, 0, 0, 0);
                }
#pragma unroll
                for (int mt = 0; mt < 8; ++mt) {
                    const bf16x4 kt = *(const LAS bf16x4*)(B + SC_KT + ((16 * mt + l15) * 16 + 4 * g4) * 2);
                    S0[mt] = __builtin_amdgcn_mfma_f32_16x16x16bf16_1k(kt, vt0, S0[mt], 0, 0, 0);
                    S1[mt] = __builtin_amdgcn_mfma_f32_16x16x16bf16_1k(kt, vt1, S1[mt], 0, 0, 0);
                }
                scan_decay<0>(S0[0], dcp[0], dcp[1]); scan_decay<1>(S0[1], dcp[0], dcp[1]); scan_decay<2>(S0[2], dcp[0], dcp[1]); scan_decay<3>(S0[3], dcp[0], dcp[1]);
                scan_decay<4>(S0[4], dcp[0], dcp[1]); scan_decay<5>(S0[5], dcp[0], dcp[1]); scan_decay<6>(S0[6], dcp[0], dcp[1]); scan_decay<7>(S0[7], dcp[0], dcp[1]);
                scan_decay<0>(S1[0], dcp[0], dcp[1]); scan_decay<1>(S1[1], dcp[0], dcp[1]); scan_decay<2>(S1[2], dcp[0], dcp[1]); scan_decay<3>(S1[3], dcp[0], dcp[1]);
                scan_decay<4>(S1[4], dcp[0], dcp[1]); scan_decay<5>(S1[5], dcp[0], dcp[1]); scan_decay<6>(S1[6], dcp[0], dcp[1]); scan_decay<7>(S1[7], dcp[0], dcp[1]);
                const f32x4 o0 = ((oq0[0] + oq0[2]) + op0) + (oq0[1] + oq0[3]), o1 = ((oq1[0] + oq1[2]) + op1) + (oq1[1] + oq1[3]);
#pragma unroll
                for (int r = 0; r < 4; ++r) { OB[(buf * 16 + 4 * g4 + r) * 132 + eb + l15] = o0[r]; OB[(buf * 16 + 4 * g4 + r) * 132 + eb + 16 + l15] = o1[r]; }
            }
        } else if (n > 0) {
            const int ps = slot == 0 ? DS_R - 1 : slot - 1;
            const LAS unsigned char* B = F.lds + ps * DS_SLOT;
            const LAS float* orow = OB + ((buf ^ 1) * 16 + ht) * 132 + hp * 8;
            const f32x4 a0 = *(const LAS f32x4*)orow, a1 = *(const LAS f32x4*)(orow + 4);
            const u32x4 gw = *(const LAS u32x4*)(B + SC_GATE + ht * 256 + ((hp ^ ht) << 4));
            float ss = (a0[0] * a0[0] + a0[1] * a0[1]) + (a0[2] * a0[2] + a0[3] * a0[3]) + (a1[0] * a1[0] + a1[1] * a1[1]) + (a1[2] * a1[2] + a1[3] * a1[3]);
            ss = row16_sum(ss);
            const float rs = __builtin_amdgcn_rsqf(ss * (1.0f / 128.0f) + RMS_EPS);
            f32x4 g0, g1;
            g0[0] = __uint_as_float(gw.x << 16); g0[1] = __uint_as_float(gw.x & 0xffff0000u); g0[2] = __uint_as_float(gw.y << 16); g0[3] = __uint_as_float(gw.y & 0xffff0000u);
            g1[0] = __uint_as_float(gw.z << 16); g1[1] = __uint_as_float(gw.z & 0xffff0000u); g1[2] = __uint_as_float(gw.w << 16); g1[3] = __uint_as_float(gw.w & 0xffff0000u);
            *(u32x4*)(MIX + (size_t)(mrow0 + 16 * (n - 1) + ht) * DM + h * 128 + hp * 8) = pack8(a0 * g0 * onwa * rs, a1 * g1 * onwb * rs);
        }
        slot = slot == DS_R - 1 ? 0 : slot + 1; slot4 = slot4 == DS_R - 1 ? 0 : slot4 + 1;
    }
    asm volatile("s_waitcnt vmcnt(0)" ::: "memory");
    __syncthreads();
    if (cw) {
#pragma unroll
        for (int mt = 0; mt < 8; ++mt)
#pragma unroll
            for (int r = 0; r < 4; ++r) { ST[(16 * mt + 4 * g4 + r) * DS_STS + eb + l15] = S0[mt][r]; ST[(16 * mt + 4 * g4 + r) * DS_STS + eb + 16 + l15] = S1[mt][r]; }
    }
    __syncthreads();
#pragma unroll
    for (int i = 0; i < 8; ++i) { const int idx = F.tid + 512 * i, c = idx >> 5, e4 = idx & 31; *(f32x4*)(Sout + (size_t)c * 128 + e4 * 4) = *(const LAS f32x4*)(ST + c * DS_STS + e4 * 4); }
#undef D7_ISSUE
#undef D7_DMA16
}

__device__ __forceinline__ void hgrn_scan_dma3(Frame& F, int ch0, int nsteps, int h, int mrow0, float* Sout, unsigned* rdy, unsigned need, int rdy_step) {
    const int lane = F.lane, l15 = lane & 15, g4 = lane >> 4, e0 = 16 * F.wave, w = F.wave;
    const unsigned char* ws = F.ws;
    bf16_t* MIX = (bf16_t*)(F.ws + WS_MIX);
    const float onw = F.in[I_ONORM][e0 + l15];
    LAS float* RED = (LAS float*)(F.lds + D2_RED);
    LAS float* RS = (LAS float*)(F.lds + D2_RS);
    LAS float* ST = (LAS float*)(F.lds + DS_ST);
    LAS bf16_t* OUTB = (LAS bf16_t*)(F.lds + D2_OUT);
    const int wq = w & 3;
    const int trow = 4 * wq + (lane >> 4), lch = (lane & 15) ^ trow;
    const unsigned char* sq = ws + WS_QIN + (((size_t)ch0 * 16 + trow) * 1024 + h * 128) * 2 + lch * 16;
    const unsigned char* sk = ws + WS_KT + (((size_t)ch0 * 1024 + h * 128) * 16 + (wq * 64 + lane) * 8) * 2;
    const unsigned char* sv = ws + WS_VT + (((size_t)ch0 * 1024 + h * 128) * 16 + (wq * 64 + lane) * 8) * 2;
    const unsigned char* sg = ws + WS_GATE + (((size_t)mrow0 + trow) * 1024 + h * 128) * 2 + lch * 16;
    const unsigned char* sc = lane < 32 ? ws + WS_PSC + (((size_t)ch0 * 8 + h) * 256 + lane * 8) * 2 : ws + WS_DEC + ((size_t)ch0 * 1024 + h * 128 + (lane - 32) * 4) * 4;
#define D3_DMA16(src, off) __builtin_amdgcn_global_load_lds((const unsigned*)(src), (LAS unsigned*)(F.lds + (off)), 16, 0, 0)
#define D3_ISSUE(step, slot) do { if (w < 4) { const int so_ = __builtin_amdgcn_readfirstlane((int)((slot) * DS_SLOT)) + wq * 1024; const size_t go_ = (size_t)(step) * 32768; \
        D3_DMA16(sq + go_, so_ + SC_QI); D3_DMA16(sk + go_, so_ + SC_KT); D3_DMA16(sv + go_, so_ + SC_VT); D3_DMA16(sg + go_, so_ + SC_GATE); \
        if (w == 0) D3_DMA16(sc + (size_t)(step) * 4096, so_ + SC_P); } } while (0)
    __syncthreads();
    f32x4 S[8];
#pragma unroll
    for (int mt = 0; mt < 8; ++mt) S[mt] = (f32x4){0.f, 0.f, 0.f, 0.f};
    for (int s = 0; s < DS_R - 1 && s < nsteps; ++s) D3_ISSUE(s, s);
    f32x4 o_p1 = {0.f, 0.f, 0.f, 0.f}, o_p2 = o_p1, gate_p1 = o_p1, gate_p2 = o_p1;
    int slot = 0;
#pragma unroll 1
    for (int n = 0; n <= nsteps + 2; ++n) {
        if (w < 4) {
            if (n >= DS_R && n + DS_R <= nsteps + 1) { if (w == 0) asm volatile("s_waitcnt vmcnt(20)" ::: "memory"); else asm volatile("s_waitcnt vmcnt(16)" ::: "memory"); }
            else asm volatile("s_waitcnt vmcnt(0)" ::: "memory");
        }
        static_assert(DS_R == 6, "the counted waits above are (DS_R - 2) * 5 and (DS_R - 2) * 4");
        DS_BAR();
        if (rdy && n - 1 + DS_R == rdy_step) flag_wait(rdy, need);
        if (n - 1 + DS_R < nsteps) { const int ps = slot == 0 ? DS_R - 1 : slot - 1; D3_ISSUE(n - 1 + DS_R, ps); }
        const int buf = n & 1;
        f32x4 o = {0.f, 0.f, 0.f, 0.f}, gate = {0.f, 0.f, 0.f, 0.f};
        if (n < nsteps) {
            const LAS unsigned char* B = F.lds + slot * DS_SLOT;
            const bf16x4 vt = *(const LAS bf16x4*)(B + SC_VT + ((e0 + l15) * 16 + 4 * g4) * 2);
            const bf16x4 pa = *(const LAS bf16x4*)(B + SC_P + (l15 * 16 + 4 * g4) * 2);
            const f32x2 dcp = *(const LAS f32x2*)(B + SC_DEC + (16 * (l15 >> 1) + 4 * g4 + 2 * (l15 & 1)) * 4);
            const f32x4 zz = {0.f, 0.f, 0.f, 0.f};
            f32x4 oq[4];
            const f32x4 op = __builtin_amdgcn_mfma_f32_16x16x16bf16_1k(pa, vt, zz, 0, 0, 0);
#pragma unroll
            for (int kk = 0; kk < 4; ++kk) {
                const bf16x4 q0 = *(const LAS bf16x4*)(B + SC_QI + l15 * 256 + (((4 * kk + (g4 >> 1)) ^ l15) << 4) + (g4 & 1) * 8);
                const bf16x4 q1 = *(const LAS bf16x4*)(B + SC_QI + l15 * 256 + (((4 * kk + 2 + (g4 >> 1)) ^ l15) << 4) + (g4 & 1) * 8);
                const bf16x8 qa = {q0[0], q0[1], q0[2], q0[3], q1[0], q1[1], q1[2], q1[3]};
                const u32x4 sb8 = pack8(S[2 * kk], S[2 * kk + 1]);
                oq[kk] = __builtin_amdgcn_mfma_f32_16x16x32_bf16(qa, __builtin_bit_cast(bf16x8, sb8), zz, 0, 0, 0);
            }
            bf16x4 kt[8];
#pragma unroll
            for (int mt = 0; mt < 8; ++mt) kt[mt] = *(const LAS bf16x4*)(B + SC_KT + ((16 * mt + l15) * 16 + 4 * g4) * 2);
#pragma unroll
            for (int mt = 0; mt < 8; ++mt) S[mt] = __builtin_amdgcn_mfma_f32_16x16x16bf16_1k(kt[mt], vt, S[mt], 0, 0, 0);
            scan_decay<0>(S[0], dcp[0], dcp[1]); scan_decay<1>(S[1], dcp[0], dcp[1]); scan_decay<2>(S[2], dcp[0], dcp[1]); scan_decay<3>(S[3], dcp[0], dcp[1]);
            scan_decay<4>(S[4], dcp[0], dcp[1]); scan_decay<5>(S[5], dcp[0], dcp[1]); scan_decay<6>(S[6], dcp[0], dcp[1]); scan_decay<7>(S[7], dcp[0], dcp[1]);
            o = ((oq[0] + oq[2]) + op) + (oq[1] + oq[3]);
#pragma unroll
            for (int r = 0; r < 4; ++r) {
                const int t = 4 * g4 + r;
                gate[r] = bf2f(*(const LAS unsigned short*)(B + SC_GATE + t * 256 + (((2 * w + (l15 >> 3)) ^ t) << 4) + (l15 & 7) * 2));
                const float ss = row16_sum(o[r] * o[r]);
                if (l15 == 0) RED[(buf * 16 + t) * 8 + w] = ss;
            }
        }
        if (n > 0 && n <= nsteps) {
            const int i = lane & 15, t = 2 * w + (i >> 3);
            float v = RED[((buf ^ 1) * 16 + t) * 8 + (i & 7)];
            v += dpp_mov<0xB1>(v); v += dpp_mov<0x4E>(v); v += dpp_mov<0x141>(v);
            const float rs = __builtin_amdgcn_rsqf(v * (1.0f / 128.0f) + RMS_EPS);
            if (lane < 16 && (lane & 7) == 0) RS[(buf ^ 1) * 16 + t] = rs;
        }
        if (n > 1 && n <= nsteps + 1) {
            const f32x4 rs4 = *(const LAS f32x4*)(RS + buf * 16 + 4 * g4);
#pragma unroll
            for (int r = 0; r < 4; ++r) OUTB[(buf * 16 + 4 * g4 + r) * 128 + e0 + l15] = f2bf(o_p2[r] * rs4[r] * onw * gate_p2[r]);
        }
        if (n > 2 && w >= 4) {
            const int i = (w - 4) * 64 + lane, t = i >> 4, p = i & 15;
            *(u32x4*)(MIX + (size_t)(mrow0 + 16 * (n - 3) + t) * DM + h * 128 + p * 8) = *(const LAS u32x4*)(OUTB + ((buf ^ 1) * 16 + t) * 128 + p * 8);
        }
        o_p2 = o_p1; gate_p2 = gate_p1; o_p1 = o; gate_p1 = gate;
        slot = slot == DS_R - 1 ? 0 : slot + 1;
    }
    asm volatile("s_waitcnt vmcnt(0)" ::: "memory");
    __syncthreads();
#pragma unroll
    for (int mt = 0; mt < 8; ++mt)
#pragma unroll
        for (int r = 0; r < 4; ++r) ST[(16 * mt + 4 * g4 + r) * DS_STS + e0 + l15] = S[mt][r];
    __syncthreads();
#pragma unroll
    for (int i = 0; i < 8; ++i) { const int idx = F.tid + 512 * i, c = idx >> 5, e4 = idx & 31; *(f32x4*)(Sout + (size_t)c * 128 + e4 * 4) = *(const LAS f32x4*)(ST + c * DS_STS + e4 * 4); }
#undef D3_ISSUE
#undef D3_DMA16
}

__device__ __forceinline__ void hgrn_scan_dma(Frame& F, int ch0, int nsteps, int h, int mrow0, int nvalid, const float* S0, float* Sout) {
#ifdef HY_DMA1
    hgrn_scan_dma_t<0>(F, ch0, nsteps, h, mrow0, nvalid, S0, Sout, (bf16_t*)(F.ws + WS_MIX), DM, nullptr);
#elif defined(HY_DMA7)
    hgrn_scan_dma7(F, ch0, nsteps, h, mrow0, Sout);
#elif defined(HY_DMA6)
    hgrn_scan_dma6(F, ch0, nsteps, h, mrow0, Sout);
#elif defined(HY_DMA5)
    hgrn_scan_dma5(F, ch0, nsteps, h, mrow0, Sout);
#elif defined(HY_DMA4)
    hgrn_scan_dma4(F, ch0, nsteps, h, mrow0, Sout, nullptr, 0u, 0);
#elif defined(HY_DMA2)
    hgrn_scan_dma2(F, ch0, nsteps, h, mrow0, Sout, nullptr, 0u, 0);
#else
    hgrn_scan_dma3(F, ch0, nsteps, h, mrow0, Sout, nullptr, 0u, 0);
#endif
}
__device__ __forceinline__ void hgrn_scan(Frame& F, int ch0, int nsteps, int h, int mrow0, int nvalid, const float* S0, float* Sout) {
    hgrn_scan_t<0>(F, ch0, nsteps, h, mrow0, nvalid, S0, Sout, (bf16_t*)(F.ws + WS_MIX), DM, nullptr);
}


constexpr int SW_KS = 72, SW_VS = 264;
constexpr int SW_K = 0, SW_V = 256 * SW_KS * 2, SW_BT = SW_V + 64 * SW_VS * 2, SW_END = SW_BT + 8 * 160 * 4;
static_assert(SW_END <= LDS_BYTES, "swa LDS");
__device__ __forceinline__ void swa_qtile(Frame& F, int j, int h, size_t qrow, bool qvalid, bool first_block, float sink2) {
    const int lane = F.lane, l15 = lane & 15, g4 = lane >> 4;
    const bf16_t* SQ = (const bf16_t*)(F.ws + WS_SQ); bf16_t* MIX = (bf16_t*)(F.ws + WS_MIX);
    const LAS bf16_t* Kb = (const LAS bf16_t*)(F.lds + SW_K); const LAS bf16_t* Vt = (const LAS bf16_t*)(F.lds + SW_V);
    const LAS float* BT = (const LAS float*)(F.lds + SW_BT) + F.wave * 160;
    bf16x8 qf[2];
#pragma unroll
    for (int kk = 0; kk < 2; ++kk) qf[kk] = *(const bf16x8*)(SQ + qrow * 1024 + h * 64 + 32 * kk + 8 * g4);
    f32x4 s[9]; float mx = sink2;
    const int bidx = 15 + 4 * g4 - l15;
#pragma unroll
    for (int u = 0; u < 9; ++u) {
        const int mt = j + u; f32x4 acc = {0.f, 0.f, 0.f, 0.f};
#pragma unroll
        for (int kk = 0; kk < 2; ++kk) {
            const bf16x8 a = *(const LAS bf16x8*)(Kb + (16 * mt + l15) * SW_KS + 32 * kk + 8 * g4);
            acc = __builtin_amdgcn_mfma_f32_16x16x32_bf16(a, qf[kk], acc, 0, 0, 0);
        }
        const bool dead = first_block && (mt < 8);
#pragma unroll
        for (int r = 0; r < 4; ++r) { float v = acc[r] + BT[bidx + 16 * u + r]; v = dead ? -INFINITY : v; s[u][r] = v; mx = fmaxf(mx, v); }
    }
    mx = fmaxf(mx, __shfl_xor(mx, 16)); mx = fmaxf(mx, __shfl_xor(mx, 32));
    float sum = 0.f; bf16x4 pb[9];
#pragma unroll
    for (int u = 0; u < 9; ++u) {
        f32x4 p;
#pragma unroll
        for (int r = 0; r < 4; ++r) { p[r] = __builtin_amdgcn_exp2f(s[u][r] - mx); sum += p[r]; }
        pb[u] = __builtin_bit_cast(bf16x4, pack4(p));
    }
    sum += __shfl_xor(sum, 16); sum += __shfl_xor(sum, 32);
    sum += __builtin_amdgcn_exp2f(sink2 - mx);
    const float inv = 1.0f / sum;
#pragma unroll
    for (int dt = 0; dt < 4; ++dt) {
        f32x4 o = {0.f, 0.f, 0.f, 0.f};
#pragma unroll
        for (int u = 0; u < 9; ++u) {
            const bf16x4 a = *(const LAS bf16x4*)(Vt + (16 * dt + l15) * SW_VS + 16 * (j + u) + 4 * g4);
            o = __builtin_amdgcn_mfma_f32_16x16x16bf16_1k(a, pb[u], o, 0, 0, 0);
        }
        if (qvalid) *(u32x2*)(MIX + qrow * DM + 1024 + h * 64 + 16 * dt + 4 * g4) = pack4(o * inv);
    }
}
__device__ __forceinline__ void swa_load_tables(Frame& F, int k) {
    const float* BTg = (const float*)(F.ws + WS_TAB + 8192); LAS float* BT = (LAS float*)(F.lds + SW_BT);
    for (int i = F.tid; i < 8 * 160; i += NTHREADS) BT[i] = BTg[k * 8 * 160 + i];
}
__device__ __forceinline__ void swa_prompt_unit(Frame& F, int unit) {
    const int k = unit & 1, n = (unit >> 1) & 31, b = unit >> 6;
    const bf16_t* SKV = (const bf16_t*)(F.ws + WS_SKV);
    LAS bf16_t* Kb = (LAS bf16_t*)(F.lds + SW_K); LAS bf16_t* Vt = (LAS bf16_t*)(F.lds + SW_V);
    __syncthreads();
    swa_load_tables(F, k);
#pragma unroll
    for (int i = 0; i < 4; ++i) {
        const int idx = F.tid + 512 * i, kj = idx >> 3, p = idx & 7, pos = 128 * (n - 1) + kj;
        u32x4 kv = {0u, 0u, 0u, 0u}, vv = {0u, 0u, 0u, 0u};
        if (pos >= 0) { const bf16_t* src = SKV + (size_t)(b * SEQ + pos) * 256 + k * 64 + p * 8; kv = *(const u32x4*)src; vv = *(const u32x4*)(src + 128); }
        *(LAS u32x4*)(Kb + kj * SW_KS + p * 8) = kv;
        const unsigned w[4] = {vv.x, vv.y, vv.z, vv.w};
#pragma unroll
        for (int e = 0; e < 4; ++e) { Vt[(8 * p + 2 * e) * SW_VS + kj] = (bf16_t)(w[e] & 0xffffu); Vt[(8 * p + 2 * e + 1) * SW_VS + kj] = (bf16_t)(w[e] >> 16); }
    }
    __syncthreads();
    const int h = k * 8 + F.wave; const float sink2 = F.in[I_SINKS][h] * LOG2E;
#pragma unroll 1
    for (int j = 0; j < 8; ++j) swa_qtile(F, j, h, (size_t)(b * SEQ + 128 * n + 16 * j + (F.lane & 15)), true, n == 0, sink2);
}
__device__ __forceinline__ void swa_sample_unit(Frame& F, int unit) {
    const int k = unit & 1, b = unit >> 1;
    const bf16_t* SKV = (const bf16_t*)(F.ws + WS_SKV);
    LAS bf16_t* Kb = (LAS bf16_t*)(F.lds + SW_K); LAS bf16_t* Vt = (LAS bf16_t*)(F.lds + SW_V);
    __syncthreads();
    swa_load_tables(F, k);
#pragma unroll
    for (int i = 0; i < 4; ++i) {
        const int idx = F.tid + 512 * i, kj = idx >> 4, p = idx & 15;
        const size_t so = ((size_t)(b * 128 + kj) * 2 + k) * 64 + p * 4;
        const f32x4 kv = *(const f32x4*)(F.in[I_CSK] + so), vv = *(const f32x4*)(F.in[I_CSV] + so);
        *(LAS u32x2*)(Kb + kj * SW_KS + p * 4) = pack4(kv);
#pragma unroll
        for (int e = 0; e < 4; ++e) Vt[(4 * p + e) * SW_VS + kj] = f2bf(vv[e]);
        if (kj >= 4) { const size_t dof = ((size_t)(b * 128 + kj - 4) * 2 + k) * 64 + p * 4; *(f32x4*)(F.out + O_SSK + dof) = kv; *(f32x4*)(F.out + O_SSV + dof) = vv; }
    }
    if (F.tid < 128) {
        const int kj = 128 + (F.tid >> 3), p = F.tid & 7;
        u32x4 kv = {0u, 0u, 0u, 0u}, vv = {0u, 0u, 0u, 0u};
        if (kj < 132) { const bf16_t* src = SKV + (size_t)(TP + 4 * b + (kj - 128)) * 256 + k * 64 + p * 8; kv = *(const u32x4*)src; vv = *(const u32x4*)(src + 128); }
        *(LAS u32x4*)(Kb + kj * SW_KS + p * 8) = kv;
        const unsigned w[4] = {vv.x, vv.y, vv.z, vv.w};
#pragma unroll
        for (int e = 0; e < 4; ++e) { Vt[(8 * p + 2 * e) * SW_VS + kj] = (bf16_t)(w[e] & 0xffffu); Vt[(8 * p + 2 * e + 1) * SW_VS + kj] = (bf16_t)(w[e] >> 16); }
    }
    __syncthreads();
    const int h = k * 8 + F.wave, l15 = F.lane & 15; const float sink2 = F.in[I_SINKS][h] * LOG2E;
    swa_qtile(F, 0, h, (size_t)(TP + 4 * b + (l15 < 4 ? l15 : 3)), l15 < 4, false, sink2);
}

constexpr int MA_KS = 136, MA_VS = 264;
constexpr int MA_K = 0, MA_V = 256 * MA_KS * 2, MA_END = MA_V + 128 * MA_VS * 2;
static_assert(MA_END <= LDS_BYTES, "memattn LDS");
__device__ __forceinline__ void memattn_prompt_unit(Frame& F, int unit) {
    const int h = unit & 3, pm = unit >> 2, b = pm >> 4;
    const bf16_t* MK = (const bf16_t*)(F.ws + WS_MK); const bf16_t* MVT = (const bf16_t*)(F.ws + WS_MVT);
    const bf16_t* QM = (const bf16_t*)(F.ws + WS_QM); bf16_t* OM = (bf16_t*)(F.ws + WS_OM);
    LAS bf16_t* Kh = (LAS bf16_t*)(F.lds + MA_K); LAS bf16_t* Vt = (LAS bf16_t*)(F.lds + MA_V);
    const int lane = F.lane, l15 = lane & 15, g4 = lane >> 4;
    __syncthreads();
#pragma unroll
    for (int i = 0; i < 8; ++i) {
        const int idx = F.tid + 512 * i;
        { const int m = idx >> 4, p = idx & 15; *(LAS u32x4*)(Kh + m * MA_KS + p * 8) = *(const u32x4*)(MK + (size_t)(b * 256 + m) * 512 + h * 128 + p * 8); }
        { const int d = idx >> 5, p = idx & 31; *(LAS u32x4*)(Vt + d * MA_VS + p * 8) = *(const u32x4*)(MVT + ((size_t)(b * 4 + h) * 128 + d) * 256 + p * 8); }
    }
    __syncthreads();
#pragma unroll 1
    for (int jj = 0; jj < 2; ++jj) {
        const size_t row = (size_t)pm * 256 + 16 * (2 * F.wave + jj) + l15;
        bf16x8 qf[4];
#pragma unroll
        for (int kk = 0; kk < 4; ++kk) qf[kk] = *(const bf16x8*)(QM + row * 512 + h * 128 + 32 * kk + 8 * g4);
        f32x4 s[16]; float mx = -INFINITY;
#pragma unroll
        for (int mt = 0; mt < 16; ++mt) {
            f32x4 acc = {0.f, 0.f, 0.f, 0.f};
#pragma unroll
            for (int kk = 0; kk < 4; ++kk) {
                const bf16x8 a = *(const LAS bf16x8*)(Kh + (16 * mt + l15) * MA_KS + 32 * kk + 8 * g4);
                acc = __builtin_amdgcn_mfma_f32_16x16x32_bf16(a, qf[kk], acc, 0, 0, 0);
            }
            s[mt] = acc; mx = fmaxf(fmaxf(mx, fmaxf(acc[0], acc[1])), fmaxf(acc[2], acc[3]));
            __builtin_amdgcn_sched_barrier(0);
        }
        mx = fmaxf(mx, __shfl_xor(mx, 16)); mx = fmaxf(mx, __shfl_xor(mx, 32));
        float sum = 0.f; bf16x8 pb[8];
#pragma unroll
        for (int i = 0; i < 8; ++i) {
            f32x4 p0, p1;
#pragma unroll
            for (int r = 0; r < 4; ++r) { p0[r] = __builtin_amdgcn_exp2f(s[2 * i][r] - mx); p1[r] = __builtin_amdgcn_exp2f(s[2 * i + 1][r] - mx); sum += p0[r] + p1[r]; }
            pb[i] = __builtin_bit_cast(bf16x8, pack8(p0, p1));
        }
        sum += __shfl_xor(sum, 16); sum += __shfl_xor(sum, 32);
        const float inv = 1.0f / sum;
#pragma unroll
        for (int dt = 0; dt < 8; ++dt) {
            f32x4 o = {0.f, 0.f, 0.f, 0.f};
#pragma unroll
            for (int i = 0; i < 8; ++i) {
                const bf16x4 a0 = *(const LAS bf16x4*)(Vt + (16 * dt + l15) * MA_VS + 32 * i + 4 * g4);
                const bf16x4 a1 = *(const LAS bf16x4*)(Vt + (16 * dt + l15) * MA_VS + 32 * i + 16 + 4 * g4);
                const bf16x8 a = {a0[0], a0[1], a0[2], a0[3], a1[0], a1[1], a1[2], a1[3]};
                o = __builtin_amdgcn_mfma_f32_16x16x32_bf16(a, pb[i], o, 0, 0, 0);
            }
            *(u32x2*)(OM + row * 512 + h * 128 + 16 * dt + 4 * g4) = pack4(o * inv);
            __builtin_amdgcn_sched_barrier(0);
        }
    }
}
constexpr int MSP_P = 0, MSP_O = 8192, MSP_ML = 8192 + 16384;
__device__ __forceinline__ void memattn_sample_block(Frame& F, int task) {
    const int hp = task & 1, b = task >> 1, w = F.wave, h = 2 * hp + (w >> 2), kq = w & 3;
    const float* CK = F.in[I_CMK] + ((size_t)b * 256 + 64 * kq) * 512 + h * 128; const float* CV = F.in[I_CMV] + ((size_t)b * 256 + 64 * kq) * 512 + h * 128;
    const bf16_t* QM = (const bf16_t*)(F.ws + WS_QM); bf16_t* OM = (bf16_t*)(F.ws + WS_OM);
    const int lane = F.lane, l15 = lane & 15, g4 = lane >> 4;
    LAS float* pl = (LAS float*)(F.lds + MSP_P) + w * 256; LAS float* po = (LAS float*)(F.lds + MSP_O) + w * 512; LAS float* ml = (LAS float*)(F.lds + MSP_ML);
    __syncthreads();
    bf16x8 qf[4];
#pragma unroll
    for (int kk = 0; kk < 4; ++kk) { qf[kk] = *(const bf16x8*)(QM + (size_t)(TP + 4 * b + (l15 & 3)) * 512 + h * 128 + 32 * kk + 8 * g4); if (l15 >= 4) qf[kk] = (bf16x8){0, 0, 0, 0, 0, 0, 0, 0}; }
    f32x4 s[4]; float mx = -INFINITY;
#pragma unroll
    for (int mt = 0; mt < 4; ++mt) {
        f32x4 acc = {0.f, 0.f, 0.f, 0.f};
#pragma unroll
        for (int kk = 0; kk < 4; ++kk) {
            const float* kp = CK + (size_t)(16 * mt + l15) * 512 + 32 * kk + 8 * g4;
            const u32x4 a = pack8(*(const f32x4*)kp, *(const f32x4*)(kp + 4));
            acc = __builtin_amdgcn_mfma_f32_16x16x32_bf16(__builtin_bit_cast(bf16x8, a), qf[kk], acc, 0, 0, 0);
        }
        s[mt] = acc; mx = fmaxf(fmaxf(mx, fmaxf(acc[0], acc[1])), fmaxf(acc[2], acc[3]));
    }
    mx = fmaxf(mx, __shfl_xor(mx, 16)); mx = fmaxf(mx, __shfl_xor(mx, 32));
    float sum = 0.f;
#pragma unroll
    for (int mt = 0; mt < 4; ++mt)
#pragma unroll
        for (int r = 0; r < 4; ++r) { const float p = __builtin_amdgcn_exp2f(s[mt][r] - mx); sum += p; if (l15 < 4) pl[(16 * mt + 4 * g4 + r) * 4 + l15] = p; }
    sum += __shfl_xor(sum, 16); sum += __shfl_xor(sum, 32);
    if (lane < 4) { ml[w * 8 + lane] = mx; ml[w * 8 + 4 + lane] = sum; }
    LDS_WAIT(); asm volatile("" ::: "memory");
    f32x2 o[4] = {{0.f, 0.f}, {0.f, 0.f}, {0.f, 0.f}, {0.f, 0.f}};
#pragma unroll 16
    for (int m = 0; m < 64; ++m) {
        const f32x2 v = *(const f32x2*)(CV + (size_t)m * 512 + 2 * lane);
        const f32x4 p = *(const LAS f32x4*)(pl + m * 4);
#pragma unroll
        for (int t = 0; t < 4; ++t) { o[t][0] += p[t] * v[0]; o[t][1] += p[t] * v[1]; }
    }
#pragma unroll
    for (int t = 0; t < 4; ++t) *(LAS f32x2*)(po + t * 128 + 2 * lane) = o[t];
    __syncthreads();
    {
        const int hh = F.tid >> 8, t = (F.tid >> 6) & 3, d = 2 * (F.tid & 63);
        float mq[4], M = -INFINITY;
#pragma unroll
        for (int q = 0; q < 4; ++q) { mq[q] = ml[(hh * 4 + q) * 8 + t]; M = fmaxf(M, mq[q]); }
        float den = 0.f; f32x2 num = {0.f, 0.f};
#pragma unroll
        for (int q = 0; q < 4; ++q) { const float f = __builtin_amdgcn_exp2f(mq[q] - M); den += f * ml[(hh * 4 + q) * 8 + 4 + t];
            const f32x2 oq = *(const LAS f32x2*)((LAS float*)(F.lds + MSP_O) + (hh * 4 + q) * 512 + t * 128 + d); num[0] += f * oq[0]; num[1] += f * oq[1]; }
        const float inv = 1.0f / den;
        *(unsigned*)(OM + (size_t)(TP + 4 * b + t) * 512 + (2 * hp + hh) * 128 + d) = cvtpk(num[0] * inv, num[1] * inv);
    }
}

__device__ __forceinline__ f32x4 bf4_f32(u32x2 w) { f32x4 v; v[0] = __uint_as_float(w.x << 16); v[1] = __uint_as_float(w.x & 0xffff0000u); v[2] = __uint_as_float(w.y << 16); v[3] = __uint_as_float(w.y & 0xffff0000u); return v; }
__device__ __forceinline__ void final_norm_row_slabs_b(float* yrow, const bf16_t* xbrow, const float* slab_row, size_t slab_stride, int ns, const float* w, int lane) {
    f32x4* yr = (f32x4*)yrow + lane; const u32x2* xr = (const u32x2*)xbrow + lane; const f32x4* wr = (const f32x4*)w + lane;
    f32x4 v[8]; float s = 0.f;
#pragma unroll
    for (int j = 0; j < 8; ++j) v[j] = bf4_f32(xr[64 * j]);
    for (int k = 0; k < ns; ++k) { const f32x4* sr = (const f32x4*)(slab_row + (size_t)k * slab_stride) + lane;
#pragma unroll
        for (int j = 0; j < 8; ++j) v[j] += sr[64 * j]; }
#pragma unroll
    for (int j = 0; j < 8; ++j) s += (v[j][0] * v[j][0] + v[j][1] * v[j][1]) + (v[j][2] * v[j][2] + v[j][3] * v[j][3]);
    const float rs = __builtin_amdgcn_rsqf(wave_sum(s) * (1.0f / DM) + RMS_EPS);
#pragma unroll
    for (int j = 0; j < 8; ++j) { const f32x4 ww = wr[64 * j]; f32x4 y; y[0] = v[j][0] * rs * ww[0]; y[1] = v[j][1] * rs * ww[1]; y[2] = v[j][2] * rs * ww[2]; y[3] = v[j][3] * rs * ww[3]; yr[64 * j] = y; }
}
__device__ __forceinline__ void final_norm_row_b(float* yrow, const bf16_t* xbrow, const float* SS, int row, const float* w, int lane) {
    const float rs = row_rs(SS, row);
    f32x4* yr = (f32x4*)yrow + lane; const u32x2* xr = (const u32x2*)xbrow + lane; const f32x4* wr = (const f32x4*)w + lane;
#pragma unroll
    for (int j = 0; j < 8; ++j) { f32x4 v = bf4_f32(xr[64 * j]); const f32x4 ww = wr[64 * j]; v[0] = v[0] * rs * ww[0]; v[1] = v[1] * rs * ww[1]; v[2] = v[2] * rs * ww[2]; v[3] = v[3] * rs * ww[3]; yr[64 * j] = v; }
}
__device__ __forceinline__ void final_norm_row_slabs(float* xrow, const float* slab_row, size_t slab_stride, int ns, const float* w, int lane) {
    f32x4* xr = (f32x4*)xrow + lane; const f32x4* wr = (const f32x4*)w + lane;
    f32x4 v[8]; float s = 0.f;
#pragma unroll
    for (int j = 0; j < 8; ++j) v[j] = xr[64 * j];
    for (int k = 0; k < ns; ++k) { const f32x4* sr = (const f32x4*)(slab_row + (size_t)k * slab_stride) + lane;
#pragma unroll
        for (int j = 0; j < 8; ++j) v[j] += sr[64 * j]; }
#pragma unroll
    for (int j = 0; j < 8; ++j) s += (v[j][0] * v[j][0] + v[j][1] * v[j][1]) + (v[j][2] * v[j][2] + v[j][3] * v[j][3]);
    const float rs = __builtin_amdgcn_rsqf(wave_sum(s) * (1.0f / DM) + RMS_EPS);
#pragma unroll
    for (int j = 0; j < 8; ++j) { const f32x4 ww = wr[64 * j]; f32x4 y; y[0] = v[j][0] * rs * ww[0]; y[1] = v[j][1] * rs * ww[1]; y[2] = v[j][2] * rs * ww[2]; y[3] = v[j][3] * rs * ww[3]; xr[64 * j] = y; }
}
__device__ __forceinline__ void final_norm_row(float* xrow, const float* SS, int row, const float* w, int lane) {
    const float rs = row_rs(SS, row);
    f32x4* xr = (f32x4*)xrow + lane; const f32x4* wr = (const f32x4*)w + lane;
#pragma unroll
    for (int j = 0; j < 8; ++j) { f32x4 v = xr[64 * j]; const f32x4 ww = wr[64 * j]; v[0] = v[0] * rs * ww[0]; v[1] = v[1] * rs * ww[1]; v[2] = v[2] * rs * ww[2]; v[3] = v[3] * rs * ww[3]; xr[64 * j] = v; }
}

#ifndef HGRN_SCAN_PROMPT
#define HGRN_SCAN_PROMPT hgrn_scan_dma
#endif
#define HGRN_SCAN_SAMPLE hgrn_scan
#ifdef HY_P3DELAY
#define P3_DELAY do { for (int z_ = 0; z_ < 16; ++z_) __builtin_amdgcn_s_sleep(127); __syncthreads(); } while (0)
#else
#define P3_DELAY do {} while (0)
#endif
#define XB_TMO      128
#define XB_XCNT(j)  (256  + 64 * (j))
#define XB_XSUB(j)  (1280 + 64 * (j))
#define XB_XGEN(j)  (2304 + 64 * (j))
#define XB_TOP      3328
#define XB_TOPGEN   3392
#define XCD_BAR_WORDS 3456
#define XB_SPIN_CAP (1u << 18)

__device__ __forceinline__ unsigned xb_ld(unsigned* p)              { return __hip_atomic_load(p, __ATOMIC_RELAXED, __HIP_MEMORY_SCOPE_AGENT); }
__device__ __forceinline__ unsigned xb_add(unsigned* p, unsigned v) { return __hip_atomic_fetch_add(p, v, __ATOMIC_RELAXED, __HIP_MEMORY_SCOPE_AGENT); }
__device__ __forceinline__ unsigned xb_xcc_id() { return (unsigned)__builtin_amdgcn_s_getreg((3 << 11) | 20) & 0xFu; }
#define XB_SPIN(cond, bar) do { unsigned _sp = 0; while (cond) { __builtin_amdgcn_s_sleep(1); \
    if ((++_sp & 255u) == 0u) { if (xb_ld(&(bar)[XB_TMO])) break; if (_sp > XB_SPIN_CAP) { atomicAdd(&(bar)[XB_TMO], 1u); break; } } } } while (0)

struct XcdBarrier {
    unsigned* bar; unsigned x;
    volatile LAS unsigned* st;
};

__device__ __forceinline__ XcdBarrier xcd_barrier_post(unsigned* bar, volatile LAS unsigned* st) {
    XcdBarrier b; b.bar = bar; b.x = xb_xcc_id(); b.st = st;
    if (threadIdx.x == 0) (void)xb_add(&bar[XB_XCNT(b.x)], 1u);
    return b;
}
__device__ __forceinline__ void xcd_barrier_complete(unsigned* bar, unsigned x, unsigned& nloc, unsigned& nx) {
    const unsigned G = gridDim.x * gridDim.y * gridDim.z;
    unsigned sum, cnt, mine, sp = 0u;
    for (;;) {
        sum = 0u; cnt = 0u; mine = 0u;
#pragma unroll
        for (unsigned j = 0; j < 16; ++j) { const unsigned c = xb_ld(&bar[XB_XCNT(j)]); sum += c; cnt += (c > 0u) ? 1u : 0u; mine = (j == x) ? c : mine; }
        if (sum == G) break;
        __builtin_amdgcn_s_sleep(1);
        if ((++sp & 255u) == 0u) { if (xb_ld(&bar[XB_TMO])) break; if (sp > XB_SPIN_CAP) { atomicAdd(&bar[XB_TMO], 1u); break; } }
    }
    nloc = mine > 0u ? mine : 1u; nx = cnt > 0u ? cnt : 1u;
}

__device__ __forceinline__ void xcd_barrier(const XcdBarrier& b) {
    asm volatile("s_waitcnt vmcnt(0)" ::: "memory");
    __syncthreads();
    if (threadIdx.x == 0) {
        unsigned* bar = b.bar;
        __builtin_amdgcn_s_waitcnt(0);
        unsigned nloc = b.st[0], nx = b.st[1];
        if (nloc == 0u) { xcd_barrier_complete(bar, b.x, nloc, nx); b.st[0] = nloc; b.st[1] = nx; }
        const unsigned old = xb_add(&bar[XB_XSUB(b.x)], 1u);
        const unsigned gen = old / nloc;
        if (old + 1u == (gen + 1u) * nloc) {
            __builtin_amdgcn_fence(__ATOMIC_RELEASE, "agent");
            asm volatile("s_waitcnt vmcnt(0)" ::: "memory");
            const unsigned og = xb_add(&bar[XB_TOP], 1u);
            const unsigned tg = og / nx;
            if (og + 1u == (tg + 1u) * nx) xb_add(&bar[XB_TOPGEN], 1u);
            else XB_SPIN(xb_ld(&bar[XB_TOPGEN]) == tg, bar);
            __builtin_amdgcn_fence(__ATOMIC_ACQUIRE, "agent");
            xb_add(&bar[XB_XGEN(b.x)], 1u);
            asm volatile("s_waitcnt vmcnt(0)" ::: "memory");
        } else {
            XB_SPIN(xb_ld(&bar[XB_XGEN(b.x)]) == gen, bar);
            __builtin_amdgcn_fence(__ATOMIC_ACQUIRE, "agent");
            asm volatile("s_waitcnt vmcnt(0)" ::: "memory");
        }
    }
    __syncthreads();
}

constexpr size_t WS_CH = 4096 + 16384 + 256; constexpr int CH_WORDS = 67 * 64;
#ifndef HY_LINKS
#define HY_LINKS 0
#endif
#if HY_LINKS
#define LINK_ORDER pg8::ChainOrder
#define LINK_SET(...) __VA_ARGS__
#else
#define LINK_ORDER pg8::StaticOrder
#define LINK_SET(...)
#endif
constexpr size_t WS_CNT = 4096 + 16384;
template <class SO> __device__ __forceinline__ void publish_units(const SO& S, unsigned* pub) {
    asm volatile("s_waitcnt vmcnt(0)" ::: "memory"); __syncthreads();
    if (threadIdx.x == 0) {
        __builtin_amdgcn_fence(__ATOMIC_RELEASE, "agent"); asm volatile("s_waitcnt vmcnt(0)" ::: "memory");
        pg8::Unit u; for (int i = 0; S.next(i, u); ++i) { __hip_atomic_fetch_add(pub + 64 * u.pm, 1u, __ATOMIC_RELAXED, __HIP_MEMORY_SCOPE_AGENT); __hip_atomic_fetch_add(pub + 64 * 66, 1u, __ATOMIC_RELAXED, __HIP_MEMORY_SCOPE_AGENT); }
    }
}
constexpr size_t WS_BAR = 4096;
constexpr int LDS_BARST = LDS_BYTES - 64;
constexpr int N_PHASES = 11;
__global__ void __launch_bounds__(NTHREADS, 2) hymba_fwd(Args args) {
    extern __shared__ __attribute__((aligned(16))) unsigned char lds_raw[];
    cg::grid_group grid = cg::this_grid();
    Frame F;
    F.lds = (LAS unsigned char*)lds_raw;
    F.tid = threadIdx.x; F.lane = F.tid & 63; F.wave = __builtin_amdgcn_readfirstlane(F.tid >> 6);
    F.G = gridDim.x; F.bid = blockIdx.x;
    F.in = args.in; F.out = args.out; F.ws = args.ws;
    unsigned char* ws = args.ws; float* out = args.out;
    if (F.tid < 16) ((LAS unsigned*)(F.lds + LDS_BARST))[F.tid] = 0u;
    __syncthreads();
    XcdBarrier xbar = xcd_barrier_post((unsigned*)(ws + WS_BAR), (volatile LAS unsigned*)(F.lds + LDS_BARST));
    if (args.ph_lo > 1000) grid.sync();
#ifdef HY_LDSCLR
    for (int i = F.tid; i < LDS_BYTES / 16; i += NTHREADS) *(LAS u32x4*)(F.lds + i * 16) = (u32x4){0u, 0u, 0u, 0u};
    __syncthreads();
#endif
    const int lo = args.ph_lo, hi = args.ph_hi;
#ifndef HY_PHASE_MASK
#define HY_PHASE_MASK 0x7ff
#endif
#define IN(k) (((HY_PHASE_MASK >> (k)) & 1) && lo <= (k) && (k) < hi)
#ifndef HY_REPMASK
#define HY_REPMASK 0
#endif
#define PHASE(k, ...) do { if (IN(k)) { __VA_ARGS__ } if (IN(k) && ((HY_REPMASK >> (k)) & 1)) { __VA_ARGS__ } } while (0)
#ifdef HY_XACQ
#define SEAM(k) do { if (IN(k) && IN((k) + 1)) { asm volatile("s_waitcnt vmcnt(0)" ::: "memory"); __builtin_amdgcn_fence(__ATOMIC_RELEASE, "agent"); asm volatile("s_waitcnt vmcnt(0)" ::: "memory"); grid.sync(); __builtin_amdgcn_fence(__ATOMIC_ACQUIRE, "agent"); asm volatile("s_waitcnt vmcnt(0)" ::: "memory"); __syncthreads(); } } while (0)
#else
#define SEAM(k) do { if (IN(k) && IN((k) + 1)) { xcd_barrier(xbar); } } while (0)
#endif
#ifndef HY_P1LATE
#define HY_P1LATE 0
#endif
    const bool p1late = HY_P1LATE && F.G == 256 && lo == 0 && hi == N_PHASES; const bool p1shadow = p1late && HY_P1LATE == 2;
    const bool chain = F.G > 32 && lo == 0 && hi == N_PHASES;
    const bool link1 = chain && (HY_LINKS & 1), link2 = chain && (HY_LINKS & 2), link3 = chain && (HY_LINKS & 4);
    unsigned* CH1 = (unsigned*)(ws + WS_CH); unsigned* CH2 = CH1 + CH_WORDS; unsigned* CH3 = CH2 + CH_WORDS; unsigned* CHT = (unsigned*)(ws + WS_BAR) + XB_TMO;
    float* SS0 = (float*)(ws + WS_SS); float* SS1 = (float*)(ws + WS_SS + SS_STRIDE); float* SS2 = (float*)(ws + WS_SS + 2 * SS_STRIDE);
    bf16_t* XB = (bf16_t*)(ws + WS_XB);

#ifndef HY_FILL
#define HY_FILL 0
#endif
    const bool fill = HY_FILL && F.G > 32;
    constexpr int FL_C = CV_ALL - CV_DN, FL_A = CV_EARLY + 4000, FL_B = FL_A + 4300;
#ifndef HY_FILLMASK
#define HY_FILLMASK 15
#endif
#define FILL(bit, nunits, busy_hi, it0, it1) do { const int rem_ = (nunits) % F.G, hi_ = (busy_hi); if (fill && ((HY_FILLMASK >> (bit)) & 1) && F.bid >= rem_ && F.bid < hi_) { __syncthreads(); p0_convert(F, it0, it1, (F.bid - rem_) * NWAVES + F.wave, (hi_ - rem_) * NWAVES); } } while (0)
    PHASE(0, p0_prologue(F, !(F.G > 32)););
    SEAM(0);
    PHASE(1,
        { const int n1 = p1late ? NIN - 512 : NIN;
          pg8::Gemm g{XB, (const bf16_t*)(ws + WS_WIN), TT, n1, DM, DM}; pg8::StaticOrder S; S.init(TT, n1, F.G, F.bid);
          EpiIn E{(bf16_t*)out, (bf16_t*)out + (size_t)TT * 1024, (bf16_t*)(out + O_SST), (bf16_t*)(ws + WS_GATE), (bf16_t*)(ws + WS_SQ), (bf16_t*)(ws + WS_SKV), (const float*)(ws + WS_TAB), out};
          pg8::gemm_phase<EpiIn, pg8::StaticOrder, true, true>(F.lds, g, S, E); }
        { pg8::Gemm g{(const bf16_t*)(ws + WS_MN), (const bf16_t*)(ws + WS_WMKV), 1024, 1024, DM, DM}; pg8::StaticOrder S; S.init(1024, 1024, F.G, (F.bid + 16) % F.G);
          EpiMemKV E{(bf16_t*)(ws + WS_MK), (bf16_t*)(ws + WS_MVT), out};
          pg8::gemm_phase<EpiMemKV, pg8::StaticOrder, true, true>(F.lds, g, S, E); }
        FILL(0, (TT / 256) * (NIN / 256), F.G - 16, CV_EARLY, FL_A);
    );
    SEAM(1);
#ifndef HY_P6ALT
#define HY_P6ALT 0
#endif
#ifndef HY_P2OVL
#define HY_P2OVL 0
#endif
    PHASE(2,
        if (p1late && !p1shadow) {
            constexpr int NPJ = (TT / 256) * 2, NCK = 8 * (256 - NPJ);
            if (F.bid < NPJ) {
                pg8::Gemm g{XB, (const bf16_t*)(ws + WS_WIN) + (size_t)(NIN - 512) * DM, TT, 512, DM, DM}; pg8::StaticOrder S; S.init(TT, 512, NPJ, F.bid);
                EpiIn E{(bf16_t*)out, (bf16_t*)out + (size_t)TT * 1024, (bf16_t*)(out + O_SST), (bf16_t*)(ws + WS_GATE), (bf16_t*)(ws + WS_SQ), (bf16_t*)(ws + WS_SKV), (const float*)(ws + WS_TAB), out, (NIN - 512) / 256};
                pg8::gemm_phase<EpiIn, pg8::StaticOrder, true, true>(F.lds, g, S, E);
                __syncthreads();
                hgrn_prep(F, NCK + F.bid, NCH, NPJ, false);
            } else hgrn_prep(F, F.bid - NPJ, NCK, 256 - NPJ, false);
        } else if (!(HY_P2OVL && F.G > 32)) hgrn_prep(F, F.bid, NCH, F.G, false);
    );
    if (!(HY_P2OVL && F.G > 32)) SEAM(2);
    PHASE(3,
        const bool split = F.G > 32;
        constexpr int NCVA = 5 * 224 * NWAVES, NCVS = 7 * 32 * NWAVES; const bool convsplit = F.G == 256 && !p1shadow && !(HY_FILL && F.G > 32);
#define P3_SCAN do { if (F.bid < 32) { P3_DELAY; for (int bh = F.bid; bh < 32; bh += F.G) { const int b = bh >> 3, h = bh & 7; \
                if (HY_P2OVL && split) { flag_wait(RDY0, (unsigned)(F.G - 32)); hgrn_scan_dma4(F, b * 256, 256, h, b * SEQ, out + O_PST + (size_t)bh * 16384, RDYA, (unsigned)(F.G - 32), (F.G - 32) / 4); } \
                else HGRN_SCAN_PROMPT(F, b * 256, 256, h, b * SEQ, 16, nullptr, out + O_PST + (size_t)bh * 16384); } \
                if (convsplit) { __syncthreads(); p0_convert(F, CV_EARLY + NCVA, CV_EARLY + NCVA + NCVS, F.bid * NWAVES + F.wave, 32 * NWAVES); } } } while (0)
#ifndef HY_OTHBAL
#define HY_OTHBAL 1
#endif
#define P3_HSAMPLE(tt_) do { const int ts_ = (tt_), bs_ = ts_ >> 3, hs_ = ts_ & 7; HGRN_SCAN_SAMPLE(F, NCHP + bs_, 1, hs_, TP + 4 * bs_, 4, F.in[I_STATE] + (size_t)ts_ * 16384, out + O_SST + (size_t)ts_ * 16384); } while (0)
#define P3_OTHERS do { if (!split || F.bid >= 32) { const int nw = split ? F.G - 32 : F.G; const int c = split ? F.bid - 32 : F.bid; \
            if (HY_OTHBAL && nw == 224) {                \
                for (int i = c; i < 256; i += nw) swa_prompt_unit(F, i); \
                if (c < 32) P3_HSAMPLE(c); \
                else { for (int i = c - 32; i < 256; i += nw - 32) swa_sample_unit(F, i); for (int t = 32 + (c - 32); t < 1024; t += nw - 32) P3_HSAMPLE(t); } \
            } else \
            for (int i = c; i < 1536; i += nw) { \
                if (i < 256) swa_prompt_unit(F, i); \
                else if (i < 512) swa_sample_unit(F, i - 256); \
                else P3_HSAMPLE(i - 512); } } } while (0)
        unsigned* RDY0 = (unsigned*)(ws + WS_CNT) + 16; unsigned* RDYA = (unsigned*)(ws + WS_CNT) + 32;
        if (HY_P2OVL && split && F.bid >= 32) {
            hgrn_prep(F, F.bid - 32, F.G - 32, F.G - 32, true); flag_signal(RDY0);
            hgrn_prep(F, F.bid - 32 + (F.G - 32), NCH, F.G - 32, true); flag_signal(RDYA);
            flag_wait(RDYA, (unsigned)(F.G - 32));
        }
        if (split && F.bid >= 32) { p0_convert(F, CV_IN, CV_MID1, (F.bid - 32) * NWAVES + F.wave, (F.G - 32) * NWAVES); __syncthreads(); }
        constexpr int NPJS = (TT / 256) * 2, NCV1 = 13 * (224 - NPJS) * NWAVES; unsigned* CNT2 = (unsigned*)(ws + WS_CNT) + 48;
        if (p1shadow && F.bid >= 32) {
            if (F.bid - 32 < NPJS) {
                pg8::Gemm g{XB, (const bf16_t*)(ws + WS_WIN) + (size_t)(NIN - 512) * DM, TT, 512, DM, DM}; pg8::StaticOrder S; S.init(TT, 512, NPJS, F.bid - 32);
                EpiIn E{(bf16_t*)out, (bf16_t*)out + (size_t)TT * 1024, (bf16_t*)(out + O_SST), (bf16_t*)(ws + WS_GATE), (bf16_t*)(ws + WS_SQ), (bf16_t*)(ws + WS_SKV), (const float*)(ws + WS_TAB), out, (NIN - 512) / 256};
                pg8::gemm_phase<EpiIn, pg8::StaticOrder, true, true>(F.lds, g, S, E);
            } else p0_convert(F, CV_EARLY, CV_EARLY + NCV1, (F.bid - 32 - NPJS) * NWAVES + F.wave, (F.G - 32 - NPJS) * NWAVES);
            flag_signal(CNT2); flag_wait(CNT2, (unsigned)(F.G - 32));
        }
        P3_SCAN;
        if ((HY_REPMASK >> 11) & 1) P3_SCAN;
        P3_OTHERS;
        if ((HY_REPMASK >> 12) & 1) P3_OTHERS;
        if (split && F.bid >= 32) {
            const int nw = F.G - 32; unsigned* CNT = (unsigned*)(ws + WS_CNT);
            asm volatile("s_waitcnt vmcnt(0)" ::: "memory"); __syncthreads();
            if (F.tid == 0) {
                __builtin_amdgcn_fence(__ATOMIC_RELEASE, "agent"); asm volatile("s_waitcnt vmcnt(0)" ::: "memory");
                __hip_atomic_fetch_add(CNT, 1u, __ATOMIC_RELAXED, __HIP_MEMORY_SCOPE_AGENT);
                unsigned sp = 0; while (__hip_atomic_load(CNT, __ATOMIC_RELAXED, __HIP_MEMORY_SCOPE_AGENT) < (unsigned)nw) { __builtin_amdgcn_s_sleep(2); if (++sp > (1u << 22)) break; }
                __builtin_amdgcn_fence(__ATOMIC_ACQUIRE, "agent"); asm volatile("s_waitcnt vmcnt(0)" ::: "memory");
            }
            __syncthreads();
            if (F.bid - 32 < nw - 16) {
                pg8::Gemm g{(const bf16_t*)(ws + WS_MIX), (const bf16_t*)(ws + WS_WOUT), TP, DM, DM / 2, DM}; pg8::StaticOrder S; S.init(TP, DM, nw - 16, F.bid - 32); S.ksv = 1;
                EpiResidB E{F.in[I_XP], F.in[I_XS], XB, nullptr};
                pg8::gemm_phase<EpiResidB, pg8::StaticOrder, true, true>(F.lds, g, S, E);
                if ((HY_REPMASK >> 13) & 1) { __syncthreads(); pg8::gemm_phase<EpiResidB, pg8::StaticOrder, true, true>(F.lds, g, S, E); }
            } else {
                pg8::Gemm g{(const bf16_t*)(ws + WS_MIX), (const bf16_t*)(ws + WS_WOUT), TT, DM, DM, DM}; SplitOrder S{F.bid - 32 - (nw - 16), 1};
                EpiResidB E{F.in[I_XP], F.in[I_XS], XB, SS0};
                pg8::gemm_phase<EpiResidB, SplitOrder, true, true>(F.lds, g, S, E);
            }
            __syncthreads();
            if ((HY_REPMASK >> 14) & 1) { p0_convert(F, CV_EARLY, CV_ALL, (F.bid - 32) * NWAVES + F.wave, nw * NWAVES); __syncthreads(); }
            if (p1shadow) { if (F.bid - 32 >= 96) p0_convert(F, CV_EARLY + NCV1, CV_ALL, (F.bid - 32 - 96) * NWAVES + F.wave, (nw - 96) * NWAVES); }
            else if (!fill) {
                if (convsplit) {
                    p0_convert(F, CV_EARLY, CV_EARLY + NCVA, (F.bid - 32) * NWAVES + F.wave, nw * NWAVES);
                    if (F.bid - 32 >= 96) p0_convert(F, CV_EARLY + NCVA + NCVS, CV_ALL, (F.bid - 32 - 96) * NWAVES + F.wave, 128 * NWAVES);
                } else p0_convert(F, CV_EARLY, CV_ALL, (F.bid - 32) * NWAVES + F.wave, nw * NWAVES);
            }
            else { if (!(HY_FILLMASK & 1)) p0_convert(F, CV_EARLY, FL_A, (F.bid - 32) * NWAVES + F.wave, nw * NWAVES); if (!(HY_FILLMASK & 2)) p0_convert(F, FL_A, FL_B, (F.bid - 32) * NWAVES + F.wave, nw * NWAVES);
                   if (!(HY_FILLMASK & 4)) p0_convert(F, FL_B, FL_C, (F.bid - 32) * NWAVES + F.wave, nw * NWAVES); if (!(HY_FILLMASK & 8)) p0_convert(F, FL_C, CV_ALL, (F.bid - 32) * NWAVES + F.wave, nw * NWAVES); }
        }
    );
    SEAM(3);
    PHASE(4,
        if (!(F.G > 32)) {
            pg8::Gemm g0{(const bf16_t*)(ws + WS_MIX), (const bf16_t*)(ws + WS_WOUT), TT, DM, DM / 2, DM}; pg8::StaticOrder S0; S0.init(TT, DM, F.G, F.bid); S0.ksv = 1;
            EpiResidB E0{F.in[I_XP], F.in[I_XS], XB, nullptr};
            pg8::gemm_phase<EpiResidB, pg8::StaticOrder, true, true>(F.lds, g0, S0, E0);
            xcd_barrier(xbar);
        }
        const int p4m = (F.G > 32) ? TP : TT;
        pg8::Gemm g{(const bf16_t*)(ws + WS_MIX), (const bf16_t*)(ws + WS_WOUT), p4m, DM, DM / 2, DM}; LINK_ORDER S; S.init(p4m, DM, F.G, F.bid);
        EpiResidB E{nullptr, nullptr, XB, SS0};
        pg8::gemm_phase<EpiResidB, LINK_ORDER, true, true>(F.lds, g, S, E);
        LINK_SET(if (link1) publish_units(S, CH1);)
        FILL(1, (TT / 256) * (DM / 256), F.G, FL_A, FL_B);
    );
    if (!link1) SEAM(4);
    PHASE(5,
        pg8::Gemm g{XB, (const bf16_t*)(ws + WS_WMQ), TT, MEMW, DM, DM}; LINK_ORDER S; S.init(TT, MEMW, F.G, F.bid);
        LINK_SET(if (link1) { S.h.ready = CH1; S.h.need = (DM / 256); S.h.total = (TT / 256) * (DM / 256); S.h.tmo = CHT; })
        EpiScaleBf16 E{(bf16_t*)(ws + WS_QM), MEMW, SS0, MEM_QSCALE};
        pg8::gemm_phase<EpiScaleBf16, LINK_ORDER, true, true>(F.lds, g, S, E);
        FILL(2, (TT / 256) * (MEMW / 256), F.G, FL_B, FL_C);
    );
    SEAM(5);
    PHASE(6,
        if (HY_P6ALT && (F.bid & 1)) {
            for (int t = F.bid; t < 256; t += F.G) memattn_sample_block(F, t);
            for (int u = F.bid; u < 256; u += F.G) memattn_prompt_unit(F, u);
        } else {
            for (int u = F.bid; u < 256; u += F.G) memattn_prompt_unit(F, u);
#ifdef HY_P6REP
            if (HY_P6REP & 1) for (int u = F.bid; u < 256; u += F.G) memattn_prompt_unit(F, u);
            if (HY_P6REP & 2) for (int t = F.bid; t < 256; t += F.G) memattn_sample_block(F, t);
#endif
            for (int t = F.bid; t < 256; t += F.G) memattn_sample_block(F, t);
        }
    );
    SEAM(6);
#ifndef HY_P7S
#define HY_P7S 0
#endif
    const bool p7s = HY_P7S && F.G >= 256 && lo == 0 && hi == N_PHASES; unsigned* C7 = (unsigned*)(ws + WS_CH) + 128;
    if (IN(7)) {
        const int p7m = p7s ? TP : TT;
        pg8::Gemm g{(const bf16_t*)(ws + WS_OM), (const bf16_t*)(ws + WS_WMO), p7m, DM, MEMW, MEMW}; LINK_ORDER S; S.init(p7m, DM, F.G, F.bid);
        EpiResidB E{nullptr, nullptr, XB, SS1};
        pg8::gemm_phase<EpiResidB, LINK_ORDER, true, true>(F.lds, g, S, E);
        LINK_SET(if (link2) publish_units(S, CH2);)
    }
    if (!link2) SEAM(7);
#ifndef HY_TAIL89
#define HY_TAIL89 0
#endif
    const bool tail89 = HY_TAIL89 && F.G >= 256 && lo == 0 && hi == N_PHASES;
    unsigned* A8 = (unsigned*)(ws + WS_CH); unsigned* B8 = A8 + 64;
    constexpr int DN_NS = 11; constexpr size_t SLAB_STRIDE = (size_t)TS * DM;
    PHASE(8,
        if (!tail89 && !p7s) {
            pg8::Gemm g{XB, (const bf16_t*)(ws + WS_WGU), TT, 2 * FF, DM, DM}; pg8::StaticOrder S; S.init(TT, 2 * FF, F.G, F.bid);
            EpiSwiGLU E{(bf16_t*)(ws + WS_HID), SS1};
            pg8::gemm_phase<EpiSwiGLU, pg8::StaticOrder, true, true>(F.lds, g, S, E);
        } else {
            if (p7s && F.bid >= F.G - 16) {
                pg8::Gemm g7{(const bf16_t*)(ws + WS_OM), (const bf16_t*)(ws + WS_WMO), TT, DM, MEMW, MEMW}; SplitOrder S7{F.bid - (F.G - 16), 1};
                EpiResidB E7{nullptr, nullptr, XB, SS1};
                pg8::gemm_phase<EpiResidB, SplitOrder, true, true>(F.lds, g7, S7, E7);
                flag_signal(C7);
            }
            { pg8::Gemm g{XB, (const bf16_t*)(ws + WS_WGU), TP, 2 * FF, DM, DM}; pg8::StaticOrder S; S.init(TP, 2 * FF, F.G, F.bid);
              EpiSwiGLU E{(bf16_t*)(ws + WS_HID), SS1};
              pg8::gemm_phase<EpiSwiGLU, pg8::StaticOrder, true, true>(F.lds, g, S, E); }
            if (tail89) flag_signal(A8);
            if (F.bid < 2 * (2 * FF / 256)) {
                if (p7s) flag_wait(C7, 16u);
                pg8::Gemm g{XB, (const bf16_t*)(ws + WS_WGU), TT, 2 * FF, DM, DM}; SampleOrder S{F.bid, 2 * FF / 256};
                EpiSwiGLU E{(bf16_t*)(ws + WS_HID), SS1};
                pg8::gemm_phase<EpiSwiGLU, SampleOrder, true, true>(F.lds, g, S, E);
                if (tail89) flag_signal(B8);
            }
        }
    );
    if (!tail89) SEAM(8);
    if (IN(9)) {
        if (tail89) flag_wait(A8, (unsigned)F.G);
        { pg8::Gemm g{(const bf16_t*)(ws + WS_HID), (const bf16_t*)(ws + WS_WDN), TP, DM, FF, FF}; pg8::StaticOrder S; S.init(TP, DM, F.G, F.bid);
          EpiResidB E{nullptr, nullptr, XB, SS2};
          pg8::gemm_phase<EpiResidB, pg8::StaticOrder, true, true>(F.lds, g, S, E); }
        { const int c9 = tail89 ? F.bid - (F.G - 16 * DN_NS) : F.bid;
          if (c9 >= 0) {
            if (tail89) flag_wait(B8, 2u * (2 * FF / 256));
            pg8::Gemm g{(const bf16_t*)(ws + WS_HID), (const bf16_t*)(ws + WS_WDN), TT, DM, FF / DN_NS, FF}; SplitOrder S{c9, DN_NS};
            EpiSlab E{(float*)(ws + WS_MIX), TP, SLAB_STRIDE};
            pg8::gemm_phase<EpiSlab, SplitOrder, true, true>(F.lds, g, S, E); } }
    }
    SEAM(9);
#ifdef HY_XBAR
    for (int z_ = 0; z_ < HY_XBAR; ++z_) xcd_barrier(xbar);
#endif
    if (IN(10)) {
        for (int m = F.bid * NWAVES + F.wave; m < TT; m += F.G * NWAVES) {
            if (m < TP) final_norm_row_b(out + (size_t)m * DM, XB + (size_t)m * DM, SS2, m, F.in[I_NFINAL], F.lane);
            else final_norm_row_slabs_b(out + (size_t)m * DM, XB + (size_t)m * DM, (const float*)(ws + WS_MIX) + (size_t)(m - TP) * DM, SLAB_STRIDE, DN_NS, F.in[I_NFINAL], F.lane);
        }
    }
#undef IN
#undef SEAM
}

#ifndef HY_N_LAUNCHES
#define HY_N_LAUNCHES 1
#endif
extern "C" void kernel_launch(void* const* d_in, const int* in_sizes, int n_in, void* d_out, int out_size, void* d_ws, size_t ws_size, hipStream_t stream) {
    static int grid = 0;
    if (grid == 0) {
        if (n_in != 26 || (size_t)out_size != O_END || ws_size < WS_END) { fprintf(stderr, "kernel_launch: unexpected problem: n_in %d out %d ws %zu (need %zu)\n", n_in, out_size, ws_size, (size_t)WS_END); grid = -1; return; }
        int dev = 0, cus = 0, per_cu = 0;
        hipGetDevice(&dev); hipDeviceGetAttribute(&cus, hipDeviceAttributeMultiprocessorCount, dev);
        if (hipFuncSetAttribute((const void*)hymba_fwd, hipFuncAttributeMaxDynamicSharedMemorySize, LDS_BYTES) != hipSuccess) { fprintf(stderr, "kernel_launch: hipFuncSetAttribute failed\n"); grid = -1; return; }
        if (hipOccupancyMaxActiveBlocksPerMultiprocessor(&per_cu, (const void*)hymba_fwd, NTHREADS, LDS_BYTES) != hipSuccess || per_cu < 1) { fprintf(stderr, "kernel_launch: occupancy query says %d blocks/CU\n", per_cu); per_cu = 1; }
        (void)hipGetLastError();
        grid = cus;
        fprintf(stderr, "kernel_launch: %d CUs, occupancy %d blocks/CU, grid %d\n", cus, per_cu, grid);
    }
    if (grid < 0) return;
    Args a{};
    for (int i = 0; i < 26; ++i) a.in[i] = (const float*)d_in[i];
    a.out = (float*)d_out; a.ws = (unsigned char*)d_ws;
    if (hipMemsetAsync((char*)d_ws + WS_BAR, 0, 16384 + 256 + 3 * CH_WORDS * 4, stream) != hipSuccess) { fprintf(stderr, "kernel_launch: hipMemsetAsync failed\n"); return; }
#if HY_N_LAUNCHES == 1
    a.ph_lo = 0; a.ph_hi = N_PHASES;
    void* kargs[] = {&a};
    hipError_t e = hipLaunchCooperativeKernel((const void*)hymba_fwd, dim3(grid), dim3(NTHREADS), kargs, LDS_BYTES, stream);
    if (e != hipSuccess) fprintf(stderr, "kernel_launch: cooperative launch failed: %s\n", hipGetErrorString(e));
#else
    for (int p = 0; p < N_PHASES; ++p) {
        a.ph_lo = p; a.ph_hi = p + 1;
        hipLaunchKernelGGL(hymba_fwd, dim3(grid), dim3(NTHREADS), LDS_BYTES, stream, a);
    }
#endif
}
```

```cpp
#include <hip/hip_runtime.h>
#include <hip/hip_cooperative_groups.h>
#include <cstdio>
#include <cstdint>
namespace cg = cooperative_groups;

#define HY_DMA7 1
#define HY_P1LATE 1
namespace pg8 {
#define PG8_LAS __attribute__((address_space(3)))
typedef unsigned short bf16_t;
typedef short bf16x8 __attribute__((ext_vector_type(8)));
typedef float f32x4 __attribute__((ext_vector_type(4)));
typedef unsigned u32x4 __attribute__((ext_vector_type(4)));
constexpr int BM = 256, BK = 64, HALF = 128, HTB = HALF * BK * 2  , STAGE_BYTES = 8 * HTB, NXCD = 8, WGM = 8;

__host__ __device__ __forceinline__ int lds_byte(int r, int c) { const int st = (r >> 4) * 2 + (c >> 5), rr = r & 15, cc = c & 31, ob = rr * 64 + cc * 2; return st * 1024 + (ob ^ (((ob >> 9) & 1) << 5)); }
__host__ __device__ __forceinline__ void stage_rc(int b, int& R, int& C) { const int st = b / 1024, sb = b % 1024, swz = sb ^ (((sb >> 9) & 1) << 5); R = (st >> 1) * 16 + swz / 64; C = (st & 1) * 32 + (swz % 64) / 2; }
__host__ __device__ __forceinline__ int perm32(int rho) { const int n = rho >> 4, i = rho & 15; return 8 * (i >> 2) + 4 * n + (i & 3); }

struct Unit { int pm, pn, ks; };
struct Gemm { const bf16_t* A; const bf16_t* Bt; int M, N, K, ld; };

struct StaticOrder {
    int nM, nN, nwg, G, c, ksv = 0;
    __host__ __device__ void init(int M, int N, int G_, int c_) { nM = M / BM; nN = N / BM; nwg = nM * nN; G = G_; c = c_; }
    __host__ __device__ bool next(int i, Unit& u) const {
        const long L = (long)i * G + c; if (L >= nwg) return false;
        int wgid = (int)L; { const int q = nwg / NXCD, r = nwg % NXCD, xcd = wgid % NXCD, off = wgid / NXCD; wgid = (xcd < r ? xcd * (q + 1) : r * (q + 1) + (xcd - r) * q) + off; }
        const int nig = WGM * nN, gid = wgid / nig, fm = gid * WGM, gsz = (nM - fm) < WGM ? (nM - fm) : WGM;
        u.pm = fm + ((wgid % nig) % gsz); u.pn = (wgid % nig) / gsz; u.ks = ksv; return true;
    }
    __device__ __forceinline__ void a_ready(const Unit&) const {}
    __device__ __forceinline__ void done(const Unit&) const {}
};
struct ChainHooks {
    const unsigned* ready = nullptr; unsigned need = 0, total = 0; unsigned* pub = nullptr; unsigned* tmo = nullptr;
    mutable unsigned known = 0;
    __device__ __forceinline__ void wait(int pm) const {
        if (!ready) return;
        if (threadIdx.x < 64 && !known) {
            const unsigned long long t0 = __builtin_amdgcn_s_memrealtime(); unsigned polls = 0;
            while ((unsigned)__builtin_amdgcn_readfirstlane(__hip_atomic_load(ready + 64 * pm, __ATOMIC_RELAXED, __HIP_MEMORY_SCOPE_AGENT)) < need) {
                if ((++polls & 255u) == 0u && __builtin_amdgcn_readfirstlane(__hip_atomic_load(tmo, __ATOMIC_RELAXED, __HIP_MEMORY_SCOPE_AGENT)) != 0u) break;
                if (__builtin_amdgcn_s_memrealtime() - t0 > 2000000ull) { if (threadIdx.x == 0) __hip_atomic_store(tmo, 1u, __ATOMIC_RELAXED, __HIP_MEMORY_SCOPE_AGENT); break; }
                __builtin_amdgcn_s_sleep(2); }
            if ((unsigned)__builtin_amdgcn_readfirstlane(__hip_atomic_load(ready + 64 * 66, __ATOMIC_RELAXED, __HIP_MEMORY_SCOPE_AGENT)) >= total) known = 1u;
            __builtin_amdgcn_fence(__ATOMIC_ACQUIRE, "agent");
            asm volatile("s_waitcnt vmcnt(0)" ::: "memory");
        }
        asm volatile("" ::: "memory"); __builtin_amdgcn_s_barrier(); asm volatile("" ::: "memory");
    }
    __device__ __forceinline__ void publish(int pm) const {
        if (!pub) return;
        asm volatile("s_waitcnt vmcnt(0)" ::: "memory");
        __builtin_amdgcn_fence(__ATOMIC_RELEASE, "agent");
        asm volatile("s_waitcnt vmcnt(0)" ::: "memory");
        if ((threadIdx.x & 63) == 0) { __hip_atomic_fetch_add(pub + 64 * pm, 1u, __ATOMIC_RELAXED, __HIP_MEMORY_SCOPE_AGENT); __hip_atomic_fetch_add(pub + 64 * 66, 1u, __ATOMIC_RELAXED, __HIP_MEMORY_SCOPE_AGENT); }
    }
};
struct ChainOrder : StaticOrder {
    ChainHooks h;
    __device__ __forceinline__ void a_ready(const Unit& u) const { h.wait(u.pm); }
    __device__ __forceinline__ void done(const Unit& u) const { h.publish(u.pm); }
};

template <class Epi, class Sched, bool ALIGN_EPI = false, bool SP2 = false>
__device__ __forceinline__ void gemm_phase(PG8_LAS unsigned char* lds, const Gemm g, const Sched& S, const Epi& E) {
    const int tid = threadIdx.x, wid = __builtin_amdgcn_readfirstlane(tid >> 6), lane = tid & 63, wr = wid >> 2, wc = wid & 3, fr = lane & 15, fq = lane >> 4;
    const int K = g.ld, nt = g.K / BK;
    unsigned voffA[2], voffB[2];
#pragma unroll
    for (int i = 0; i < 2; ++i) { int R, C; stage_rc(tid * 16 + i * 8192, R, C); const int Rb = Epi::PERM ? ((R & ~31) + perm32(R & 31)) : R;
        voffA[i] = (unsigned)(R * K + C) * 2u; voffB[i] = (unsigned)(Rb * K + C) * 2u; }
    const size_t kstep = (size_t)(BK * 2);
    const size_t hstep = (size_t)HALF * K * 2;
    const size_t tstep = 2 * hstep;
    const unsigned ldsw = (unsigned)wid * 1024u;
    const int aoff = lds_byte(wr * 64 + fr, fq * 8), boff = lds_byte(wc * 32 + fr, fq * 8);
#define PG8_SA(b, h) (((b) * 2 + (h)) * HTB)
#define PG8_SB(b, h) ((4 + (b) * 2 + (h)) * HTB)
#define PG8_STAGE(bufoff, gbase, voff) do { _Pragma("unroll") for (int _i = 0; _i < 2; ++_i) \
        __builtin_amdgcn_global_load_lds((const unsigned*)((const char*)(gbase) + (voff)[_i]), (PG8_LAS unsigned*)(lds + (bufoff) + ldsw + _i * 8192), 16, 0, 0); } while (0)
#define PG8_LDA(dst, b, h) do { _Pragma("unroll") for (int m = 0; m < 4; ++m) _Pragma("unroll") for (int k = 0; k < 2; ++k) dst[m][k] = *(const PG8_LAS bf16x8*)(lds + PG8_SA(b, h) + aoff + m * 2048 + k * 1024); } while (0)
#define PG8_LDB(dst, b, h) do { _Pragma("unroll") for (int n = 0; n < 2; ++n) _Pragma("unroll") for (int k = 0; k < 2; ++k) dst[n][k] = *(const PG8_LAS bf16x8*)(lds + PG8_SB(b, h) + boff + n * 2048 + k * 1024); } while (0)
#define PG8_MMA(ai, bj, At, Bt) do { __builtin_amdgcn_s_setprio(1); _Pragma("unroll") for (int m = 0; m < 4; ++m) _Pragma("unroll") for (int n = 0; n < 2; ++n) _Pragma("unroll") for (int k = 0; k < 2; ++k) \
        acc[ai][bj][m][n] = __builtin_amdgcn_mfma_f32_16x16x32_bf16(Bt[n][k], At[m][k], acc[ai][bj][m][n], 0, 0, 0); __builtin_amdgcn_s_setprio(0); } while (0)
#define PG8_WAIT_V(n) asm volatile("s_waitcnt vmcnt(" #n ")" ::: "memory")
#define PG8_WAIT_L(n) asm volatile("s_waitcnt lgkmcnt(" #n ")" ::: "memory")
#define PG8_BAR __builtin_amdgcn_s_barrier()
#define PG8_SCHED __builtin_amdgcn_sched_barrier(0)
    Unit cur, nxt; int ui = 0;
    if (!S.next(0, cur)) return;
    f32x4 acc[2][2][4][2];
#pragma unroll
    for (int a = 0; a < 2; ++a)
#pragma unroll
        for (int b = 0; b < 2; ++b)
#pragma unroll
            for (int m = 0; m < 4; ++m)
#pragma unroll
                for (int n = 0; n < 2; ++n) acc[a][b][m][n] = (f32x4){0.f, 0.f, 0.f, 0.f};
    bf16x8 At[4][2], B0[2][2], B1[2][2];
    const char* cA = (const char*)g.A + (size_t)cur.pm * tstep + (size_t)cur.ks * g.K * 2; const char* cB = (const char*)g.Bt + (size_t)cur.pn * tstep + (size_t)cur.ks * g.K * 2;
    S.a_ready(cur);
    if constexpr (SP2) {
        PG8_STAGE(PG8_SB(0, 0), cB, voffB); PG8_STAGE(PG8_SB(0, 1), cB + hstep, voffB); PG8_STAGE(PG8_SA(0, 0), cA, voffA); PG8_STAGE(PG8_SA(0, 1), cA + hstep, voffA);
        if (wr == 1) PG8_BAR;
        PG8_WAIT_V(2); PG8_BAR;
        PG8_STAGE(PG8_SB(1, 0), cB + kstep, voffB); PG8_STAGE(PG8_SA(1, 0), cA + kstep, voffA); PG8_STAGE(PG8_SB(1, 1), cB + hstep + kstep, voffB);
        PG8_WAIT_V(6); PG8_BAR;
    } else {
        PG8_STAGE(PG8_SB(0, 0), cB, voffB); PG8_STAGE(PG8_SA(0, 0), cA, voffA); PG8_STAGE(PG8_SB(0, 1), cB + hstep, voffB); PG8_STAGE(PG8_SA(0, 1), cA + hstep, voffA);
        if (wr == 1) PG8_BAR;
        PG8_WAIT_V(4); PG8_BAR;
        PG8_STAGE(PG8_SB(1, 0), cB + kstep, voffB); PG8_STAGE(PG8_SA(1, 0), cA + kstep, voffA); PG8_STAGE(PG8_SB(1, 1), cB + hstep + kstep, voffB);
        PG8_WAIT_V(6); PG8_BAR;
    }
    for (;;) {
        const bool has_next = S.next(ui + 1, nxt);
        const char* nA = has_next ? (const char*)g.A + (size_t)nxt.pm * tstep + (size_t)nxt.ks * g.K * 2 : cA; const char* nB = has_next ? (const char*)g.Bt + (size_t)nxt.pn * tstep + (size_t)nxt.ks * g.K * 2 : cB;
        for (int t = 0; t < nt; t += 2) {
            const bool last = (t == nt - 2);
            const char* a1 = cA + (size_t)(t + 1) * kstep;
            const char* a2 = last ? nA : cA + (size_t)(t + 2) * kstep; const char* b2 = last ? nB : cB + (size_t)(t + 2) * kstep;
            const char* a3 = a2 + kstep; const char* b3 = b2 + kstep;
            if (last && has_next) S.a_ready(nxt);
            if constexpr (SP2) {
            PG8_LDB(B0, 0, 0); PG8_LDB(B1, 0, 1); PG8_SCHED; PG8_LDA(At, 0, 0); PG8_STAGE(PG8_SA(1, 1), a1 + hstep, voffA);
            PG8_WAIT_V(8); PG8_WAIT_L(0); PG8_BAR; PG8_MMA(0, 0, At, B0); PG8_MMA(0, 1, At, B1); PG8_BAR; PG8_SCHED;
            PG8_LDA(At, 0, 1); PG8_STAGE(PG8_SB(0, 0), b2, voffB); PG8_STAGE(PG8_SB(0, 1), b2 + hstep, voffB); PG8_STAGE(PG8_SA(0, 0), a2, voffA);
            PG8_WAIT_V(8); PG8_WAIT_L(0); PG8_BAR; PG8_MMA(1, 0, At, B0); PG8_MMA(1, 1, At, B1); PG8_BAR; PG8_SCHED;
            PG8_LDB(B0, 1, 0); PG8_LDB(B1, 1, 1); PG8_SCHED; PG8_LDA(At, 1, 0); PG8_STAGE(PG8_SA(0, 1), a2 + hstep, voffA);
            PG8_WAIT_V(8); PG8_WAIT_L(0); PG8_BAR; PG8_MMA(0, 0, At, B0); PG8_MMA(0, 1, At, B1); PG8_BAR; PG8_SCHED;
            PG8_LDA(At, 1, 1); PG8_STAGE(PG8_SB(1, 0), b3, voffB); PG8_STAGE(PG8_SB(1, 1), b3 + hstep, voffB); PG8_STAGE(PG8_SA(1, 0), a3, voffA);
            PG8_WAIT_V(8); PG8_WAIT_L(0); PG8_BAR; PG8_MMA(1, 0, At, B0); PG8_MMA(1, 1, At, B1); PG8_BAR; PG8_SCHED;
            } else {
            PG8_LDB(B0, 0, 0); PG8_SCHED; PG8_LDA(At, 0, 0); PG8_STAGE(PG8_SA(1, 1), a1 + hstep, voffA);
            PG8_WAIT_L(8); PG8_BAR; PG8_WAIT_L(0); PG8_MMA(0, 0, At, B0); PG8_BAR; PG8_SCHED;
            PG8_LDB(B1, 0, 1); PG8_STAGE(PG8_SB(0, 0), b2, voffB);
            PG8_BAR; PG8_WAIT_L(0); PG8_MMA(0, 1, At, B1); PG8_BAR;
            PG8_LDA(At, 0, 1); PG8_STAGE(PG8_SA(0, 0), a2, voffA);
            PG8_BAR; PG8_WAIT_L(0); PG8_MMA(1, 0, At, B0); PG8_BAR; PG8_SCHED;
            PG8_STAGE(PG8_SB(0, 1), b2 + hstep, voffB);
            PG8_WAIT_V(6); PG8_BAR; PG8_MMA(1, 1, At, B1); PG8_BAR;
            PG8_LDB(B0, 1, 0); PG8_SCHED; PG8_LDA(At, 1, 0); PG8_STAGE(PG8_SA(0, 1), a2 + hstep, voffA);
            PG8_WAIT_L(8); PG8_BAR; PG8_WAIT_L(0); PG8_MMA(0, 0, At, B0); PG8_BAR; PG8_SCHED;
            PG8_LDB(B1, 1, 1); PG8_STAGE(PG8_SB(1, 0), b3, voffB);
            PG8_BAR; PG8_WAIT_L(0); PG8_MMA(0, 1, At, B1); PG8_BAR;
            PG8_LDA(At, 1, 1); PG8_STAGE(PG8_SA(1, 0), a3, voffA);
            PG8_BAR; PG8_WAIT_L(0); PG8_MMA(1, 0, At, B0); PG8_BAR; PG8_SCHED;
            PG8_STAGE(PG8_SB(1, 1), b3 + hstep, voffB);
            PG8_WAIT_V(6); PG8_BAR; PG8_MMA(1, 1, At, B1); PG8_BAR;
            }
        }
        if constexpr (ALIGN_EPI) { if (wr == 0) PG8_BAR; }
        if constexpr (!Epi::AFTER_DRAIN) { E(acc, cur, wr, wc, fr, fq); S.done(cur); }
        if (!has_next) break;
#pragma unroll
        for (int a = 0; a < 2; ++a)
#pragma unroll
            for (int b = 0; b < 2; ++b)
#pragma unroll
                for (int m = 0; m < 4; ++m)
#pragma unroll
                    for (int n = 0; n < 2; ++n) acc[a][b][m][n] = (f32x4){0.f, 0.f, 0.f, 0.f};
        cur = nxt; cA = nA; cB = nB; ++ui;
        if constexpr (ALIGN_EPI) { if (wr == 1) PG8_BAR; }
    }
    PG8_WAIT_V(0);
    if constexpr (!ALIGN_EPI) { if (wr == 0) PG8_BAR; }
    PG8_BAR;
    if constexpr (Epi::AFTER_DRAIN) { E.fused(acc, cur, wr, wc, fr, fq, lds, wid, lane); S.done(cur); }
#undef PG8_SA
#undef PG8_SB
#undef PG8_STAGE
#undef PG8_LDA
#undef PG8_LDB
#undef PG8_MMA
#undef PG8_WAIT_V
#undef PG8_WAIT_L
#undef PG8_BAR
#undef PG8_SCHED
}
}

#define LAS __attribute__((address_space(3)))
typedef unsigned short bf16_t;
typedef short bf16x8 __attribute__((ext_vector_type(8)));
typedef short bf16x4 __attribute__((ext_vector_type(4)));
typedef float f32x4 __attribute__((ext_vector_type(4)));
typedef float f32x2 __attribute__((ext_vector_type(2)));
typedef unsigned u32x4 __attribute__((ext_vector_type(4)));
typedef unsigned u32x2 __attribute__((ext_vector_type(2)));
typedef __bf16 hbf16x2 __attribute__((ext_vector_type(2)));

constexpr int DM = 2048, TP = 16384, TS = 512, TT = TP + TS, SEQ = 4096, DB = 128;
constexpr int NIN = 5376, FF = 5632, MEMW = 512;
constexpr int NCHP = TP / 16, NCH = NCHP + DB;
constexpr float RMS_EPS = 1e-6f;
constexpr float LOG2E = 1.4426950408889634f;
constexpr float SWA_QSCALE = 0.125f * LOG2E;
constexpr float MEM_QSCALE = 0.08838834764831845f * LOG2E;
constexpr int NWAVES = 8, NTHREADS = 512;
constexpr int LDS_BYTES = 147456;

constexpr size_t O_YP = 0, O_YS = 33554432, O_PST = 34603008, O_PSK = 35127296, O_PSV = 35192832, O_PMK = 35258368, O_PMV = 35782656,
                 O_SST = 36306944, O_SSK = 53084160, O_SSV = 55181312, O_END = 57278464;
constexpr size_t MiB = 1u << 20;
constexpr size_t WS_TAB = 1 * MiB;
constexpr size_t WS_WIN = 2 * MiB, WS_WOUT = 23 * MiB, WS_WMQ = 31 * MiB, WS_WMKV = 33 * MiB, WS_WMO = 37 * MiB, WS_WGU = 39 * MiB, WS_WDN = 83 * MiB;
constexpr size_t WS_SS = 105 * MiB;
constexpr size_t SS_STRIDE = 2359296;
constexpr size_t WS_MK = 112 * MiB, WS_MVT = 113 * MiB, WS_QM = 114 * MiB, WS_OM = 131 * MiB, WS_MN = 148 * MiB, WS_XB = 152 * MiB;
constexpr size_t WS_D = 218 * MiB;
constexpr size_t WS_GATE = WS_D, WS_SQ = WS_D + 33 * MiB, WS_SKV = WS_D + 66 * MiB, WS_QIN = WS_D + 75 * MiB, WS_KT = WS_D + 111 * MiB, WS_VT = WS_D + 147 * MiB,
                 WS_PSC = WS_D + 183 * MiB, WS_DEC = WS_D + 188 * MiB, WS_MIX = WS_D + 193 * MiB, WS_END = WS_D + 259 * MiB;
constexpr size_t WS_HID = WS_D;
static_assert((size_t)TT * FF * 2 <= 183 * MiB, "HID overlay");

struct Args {
    const float* in[26];
    float* out; unsigned char* ws;
    int ph_lo, ph_hi;
};

__device__ __forceinline__ unsigned cvtpk(float lo, float hi) { f32x2 v = {lo, hi}; hbf16x2 b = __builtin_convertvector(v, hbf16x2); return __builtin_bit_cast(unsigned, b); }
__device__ __forceinline__ float bf2f(unsigned short b) { return __uint_as_float((unsigned)b << 16); }
__device__ __forceinline__ unsigned short f2bf(float f) { return (unsigned short)(cvtpk(f, 0.f) & 0xffffu); }
__device__ __forceinline__ u32x4 pack8(f32x4 a, f32x4 b) { u32x4 w; w.x = cvtpk(a[0], a[1]); w.y = cvtpk(a[2], a[3]); w.z = cvtpk(b[0], b[1]); w.w = cvtpk(b[2], b[3]); return w; }
__device__ __forceinline__ u32x2 pack4(f32x4 a) { u32x2 w; w.x = cvtpk(a[0], a[1]); w.y = cvtpk(a[2], a[3]); return w; }
__device__ __forceinline__ float fexp(float x) { return __builtin_amdgcn_exp2f(x * LOG2E); }
__device__ __forceinline__ float fsigmoid(float x) { return __builtin_amdgcn_rcpf(1.0f + fexp(-x)); }
__device__ __forceinline__ float wave_sum(float v) {
#pragma unroll
    for (int o = 1; o < 64; o <<= 1) v += __shfl_xor(v, o);
    return v;
}
#define LDS_WAIT() asm volatile("s_waitcnt lgkmcnt(0)" ::: "memory")

__device__ __forceinline__ float row_rs(const float* SS, int row) {
    const f32x4* p = (const f32x4*)(SS + (size_t)row * 32);
    f32x4 s = p[0];
#pragma unroll
    for (int i = 1; i < 8; ++i) s += p[i];
    return __builtin_amdgcn_rsqf(((s[0] + s[1]) + (s[2] + s[3])) * (1.0f / DM) + RMS_EPS);
}

using pg8::Unit;
struct EpiIn {
    static constexpr bool PERM = true, AFTER_DRAIN = false;
    bf16_t* QF; bf16_t* GF; bf16_t* VB; bf16_t* GATE; bf16_t* SQ; bf16_t* SKV; const float* LB; float* out; int pn0 = 0;
    __device__ __forceinline__ void operator()(const f32x4 (&acc)[2][2][4][2], const Unit& u, int wr, int wc, int fr, int fq) const {
        const int pn = u.pn + pn0;
#pragma unroll
        for (int ai = 0; ai < 2; ++ai)
#pragma unroll
            for (int m = 0; m < 4; ++m) {
                const int row = u.pm * 256 + ai * 128 + wr * 64 + m * 16 + fr;
#pragma unroll
                for (int bj = 0; bj < 2; ++bj) {
                    const int c = pn * 256 + bj * 128 + wc * 32 + 8 * fq;
                    f32x4 v0 = acc[ai][bj][m][0], v1 = acc[ai][bj][m][1];
                    if (pn < 4) {
                        *(u32x4*)(QF + (size_t)row * 1024 + c) = pack8(v0, v1);
                    } else if (pn < 8) {
                        const int cc = c - 1024;
                        const f32x4 l0 = *(const f32x4*)(LB + cc), l1 = *(const f32x4*)(LB + cc + 4);
#pragma unroll
                        for (int j = 0; j < 4; ++j) { v0[j] = __logf(l0[j] + (1.0f - l0[j]) * fsigmoid(v0[j])); v1[j] = __logf(l1[j] + (1.0f - l1[j]) * fsigmoid(v1[j])); }
                        *(u32x4*)(GF + (size_t)row * 1024 + cc) = pack8(v0, v1);
                    } else if (pn < 12) {
                        *(u32x4*)(VB + (size_t)row * 1024 + (c - 2048)) = pack8(v0, v1);
                    } else if (pn < 16) {
#pragma unroll
                        for (int j = 0; j < 4; ++j) { v0[j] = v0[j] * fsigmoid(v0[j]); v1[j] = v1[j] * fsigmoid(v1[j]); }
                        *(u32x4*)(GATE + (size_t)row * 1024 + (c - 3072)) = pack8(v0, v1);
                    } else if (pn < 20) {
                        *(u32x4*)(SQ + (size_t)row * 1024 + (c - 4096)) = pack8(v0 * SWA_QSCALE, v1 * SWA_QSCALE);
                    } else {
                        const int cc = c - 5120;
                        *(u32x4*)(SKV + (size_t)row * 256 + cc) = pack8(v0, v1);
                        float* d = nullptr;
                        if (row < TP) { const int b = row >> 12, t = row & 4095; if (t >= SEQ - 128) d = out + (bj == 0 ? O_PSK : O_PSV) + (size_t)(b * 128 + (t - (SEQ - 128))) * 128 + (cc & 127); }
                        else { const int rs = row - TP, b = rs >> 2, t = rs & 3; d = out + (bj == 0 ? O_SSK : O_SSV) + (size_t)(b * 128 + 124 + t) * 128 + (cc & 127); }
                        if (d) { *(f32x4*)d = v0; *(f32x4*)(d + 4) = v1; }
                    }
                }
            }
    }
};
struct EpiMemKV {
    static constexpr bool PERM = true, AFTER_DRAIN = false;
    bf16_t* MK; bf16_t* MVT; float* out;
    __device__ __forceinline__ void operator()(const f32x4 (&acc)[2][2][4][2], const Unit& u, int wr, int wc, int fr, int fq) const {
#pragma unroll
        for (int ai = 0; ai < 2; ++ai)
#pragma unroll
            for (int m = 0; m < 4; ++m) {
                const int row = u.pm * 256 + ai * 128 + wr * 64 + m * 16 + fr;
#pragma unroll
                for (int bj = 0; bj < 2; ++bj) {
                    const int c = u.pn * 256 + bj * 128 + wc * 32 + 8 * fq;
                    const f32x4 v0 = acc[ai][bj][m][0], v1 = acc[ai][bj][m][1];
                    if (u.pn < 2) {
                        float* d = out + O_PMK + (size_t)row * 512 + c; *(f32x4*)d = v0; *(f32x4*)(d + 4) = v1;
                        *(u32x4*)(MK + (size_t)row * 512 + c) = pack8(v0, v1);
                    } else {
                        const int cv = c - 512, h = cv >> 7, dd = cv & 127, b = row >> 8, mm = row & 255;
                        float* d = out + O_PMV + (size_t)row * 512 + cv; *(f32x4*)d = v0; *(f32x4*)(d + 4) = v1;
                        bf16_t* t = MVT + ((size_t)((b * 4 + h) * 128 + dd)) * 256 + mm;
#pragma unroll
                        for (int j = 0; j < 4; ++j) { t[(size_t)j * 256] = f2bf(v0[j]); t[(size_t)(j + 4) * 256] = f2bf(v1[j]); }
                    }
                }
            }
    }
};
struct EpiResid {
    static constexpr bool PERM = true, AFTER_DRAIN = false;
    const float* resP; const float* resS; float* X; bf16_t* XB; float* SS;
    __device__ __forceinline__ void operator()(const f32x4 (&acc)[2][2][4][2], const Unit& u, int wr, int wc, int fr, int fq) const {
#pragma unroll
        for (int ai = 0; ai < 2; ++ai)
#pragma unroll
            for (int m = 0; m < 4; ++m) {
                const int row = u.pm * 256 + ai * 128 + wr * 64 + m * 16 + fr;
                const float* rrow = (row < TP) ? resP + (size_t)row * DM : resS + (size_t)(row - TP) * DM;
                float ss = 0.f;
#pragma unroll
                for (int bj = 0; bj < 2; ++bj) {
                    const int c = u.pn * 256 + bj * 128 + wc * 32 + 8 * fq;
                    const f32x4 v0 = acc[ai][bj][m][0] + *(const f32x4*)(rrow + c), v1 = acc[ai][bj][m][1] + *(const f32x4*)(rrow + c + 4);
                    float* d = X + (size_t)row * DM + c; *(f32x4*)d = v0; *(f32x4*)(d + 4) = v1;
                    ss += (v0[0] * v0[0] + v0[1] * v0[1]) + (v0[2] * v0[2] + v0[3] * v0[3]) + (v1[0] * v1[0] + v1[1] * v1[1]) + (v1[2] * v1[2] + v1[3] * v1[3]);
                    if (XB) *(u32x4*)(XB + (size_t)row * DM + c) = pack8(v0, v1);
                }
                ss += __shfl_xor(ss, 16); ss += __shfl_xor(ss, 32);
                if (SS && fq == 0) SS[(size_t)row * 32 + u.pn * 4 + wc] = ss;
            }
    }
};
struct EpiResidB {
    static constexpr bool PERM = true, AFTER_DRAIN = false;
    const float* resP; const float* resS; bf16_t* XB; float* SS;
    __device__ __forceinline__ void operator()(const f32x4 (&acc)[2][2][4][2], const Unit& u, int wr, int wc, int fr, int fq) const {
#pragma unroll
        for (int ai = 0; ai < 2; ++ai)
#pragma unroll
            for (int m = 0; m < 4; ++m) {
                const int row = u.pm * 256 + ai * 128 + wr * 64 + m * 16 + fr;
                float ss = 0.f;
#pragma unroll
                for (int bj = 0; bj < 2; ++bj) {
                    const int c = u.pn * 256 + bj * 128 + wc * 32 + 8 * fq;
                    bf16_t* d = XB + (size_t)row * DM + c;
                    f32x4 r0, r1;
                    if (resP) { const float* rrow = (row < TP) ? resP + (size_t)row * DM : resS + (size_t)(row - TP) * DM; r0 = *(const f32x4*)(rrow + c); r1 = *(const f32x4*)(rrow + c + 4); }
                    else { const u32x4 w = *(const u32x4*)d;
                        r0[0] = __uint_as_float(w.x << 16); r0[1] = __uint_as_float(w.x & 0xffff0000u); r0[2] = __uint_as_float(w.y << 16); r0[3] = __uint_as_float(w.y & 0xffff0000u);
                        r1[0] = __uint_as_float(w.z << 16); r1[1] = __uint_as_float(w.z & 0xffff0000u); r1[2] = __uint_as_float(w.w << 16); r1[3] = __uint_as_float(w.w & 0xffff0000u); }
                    const f32x4 v0 = acc[ai][bj][m][0] + r0, v1 = acc[ai][bj][m][1] + r1;
                    *(u32x4*)d = pack8(v0, v1);
                    ss += (v0[0] * v0[0] + v0[1] * v0[1]) + (v0[2] * v0[2] + v0[3] * v0[3]) + (v1[0] * v1[0] + v1[1] * v1[1]) + (v1[2] * v1[2] + v1[3] * v1[3]);
                }
                ss += __shfl_xor(ss, 16); ss += __shfl_xor(ss, 32);
                if (SS && fq == 0) SS[(size_t)row * 32 + u.pn * 4 + wc] = ss;
            }
    }
};
struct EpiSlab {
    static constexpr bool PERM = true, AFTER_DRAIN = false;
    float* SLAB; int row0; size_t slab_stride;
    __device__ __forceinline__ void operator()(const f32x4 (&acc)[2][2][4][2], const Unit& u, int wr, int wc, int fr, int fq) const {
        float* base = SLAB + (size_t)u.ks * slab_stride;
#pragma unroll
        for (int ai = 0; ai < 2; ++ai)
#pragma unroll
            for (int m = 0; m < 4; ++m) {
                const int row = u.pm * 256 + ai * 128 + wr * 64 + m * 16 + fr - row0;
#pragma unroll
                for (int bj = 0; bj < 2; ++bj) {
                    float* d = base + (size_t)row * DM + u.pn * 256 + bj * 128 + wc * 32 + 8 * fq;
                    *(f32x4*)d = acc[ai][bj][m][0]; *(f32x4*)(d + 4) = acc[ai][bj][m][1];
                }
            }
    }
};
struct SampleOrder {
    int c, nN;
    __device__ bool next(int i, Unit& u) const { if (i > 0 || c >= 2 * nN) return false; u.pm = TP / 256 + c / nN; u.pn = c % nN; u.ks = 0; return true; }
    __device__ __forceinline__ void a_ready(const Unit&) const {}
    __device__ __forceinline__ void done(const Unit&) const {}
};
struct SplitOrder {
    int c, ns;
#if defined(HY_LINKS) && HY_LINKS
    pg8::ChainHooks h;
#endif
    __device__ bool next(int i, Unit& u) const { if (i > 0 || c >= 16 * ns) return false; const int tile = c / ns; u.pm = TP / 256 + (tile >> 3); u.pn = tile & 7; u.ks = c % ns; return true; }
#if defined(HY_LINKS) && HY_LINKS
    __device__ __forceinline__ void a_ready(const Unit& u) const { h.wait(u.pm); }
#else
    __device__ __forceinline__ void a_ready(const Unit&) const {}
#endif
    __device__ __forceinline__ void done(const Unit&) const {}
};
struct EpiScaleBf16 {
    static constexpr bool PERM = true, AFTER_DRAIN = false;
    bf16_t* O; int ldc; const float* SS; float scale;
    __device__ __forceinline__ void operator()(const f32x4 (&acc)[2][2][4][2], const Unit& u, int wr, int wc, int fr, int fq) const {
#pragma unroll
        for (int ai = 0; ai < 2; ++ai)
#pragma unroll
            for (int m = 0; m < 4; ++m) {
                const int row = u.pm * 256 + ai * 128 + wr * 64 + m * 16 + fr;
                const float s = row_rs(SS, row) * scale;
#pragma unroll
                for (int bj = 0; bj < 2; ++bj) {
                    const int c = u.pn * 256 + bj * 128 + wc * 32 + 8 * fq;
                    *(u32x4*)(O + (size_t)row * ldc + c) = pack8(acc[ai][bj][m][0] * s, acc[ai][bj][m][1] * s);
                }
            }
    }
};
struct EpiSwiGLU {
    static constexpr bool PERM = true, AFTER_DRAIN = false;
    bf16_t* HID; const float* SS;
    __device__ __forceinline__ void operator()(const f32x4 (&acc)[2][2][4][2], const Unit& u, int wr, int wc, int fr, int fq) const {
#pragma unroll
        for (int ai = 0; ai < 2; ++ai)
#pragma unroll
            for (int m = 0; m < 4; ++m) {
                const int row = u.pm * 256 + ai * 128 + wr * 64 + m * 16 + fr;
                const float s = row_rs(SS, row);
                f32x4 h0, h1;
#pragma unroll
                for (int j = 0; j < 4; ++j) {
                    const float g0 = acc[ai][0][m][0][j] * s, u0 = acc[ai][1][m][0][j] * s, g1 = acc[ai][0][m][1][j] * s, u1 = acc[ai][1][m][1][j] * s;
                    h0[j] = g0 * fsigmoid(g0) * u0; h1[j] = g1 * fsigmoid(g1) * u1;
                }
                *(u32x4*)(HID + (size_t)row * FF + u.pn * 128 + wc * 32 + 8 * fq) = pack8(h0, h1);
            }
    }
};

struct Frame {
    LAS unsigned char* lds;
    int tid, lane, wave, G, bid;
    const float* const* in;
    float* out; unsigned char* ws;
};
enum { I_XP = 0, I_XS, I_STATE, I_CSK, I_CSV, I_CMK, I_CMV, I_MEMP, I_NMIX, I_WIN, I_LB, I_ONORM, I_SINKS, I_RELB, I_WOUT, I_NXATT, I_NMEM,
       I_WMQ, I_WMK, I_WMV, I_WMO, I_NFFN, I_WGATE, I_WUP, I_WDOWN, I_NFINAL };

__device__ __forceinline__ void p0_tr_item(const float* __restrict__ W, int K, int N, bf16_t* WT, int k0, int n0, int drow0, const float* __restrict__ scale, LAS float* scr, int lane) {
    float v[32];
#pragma unroll
    for (int i = 0; i < 32; ++i) v[i] = __builtin_nontemporal_load(&W[(size_t)(k0 + 2 * i + (lane >> 5)) * N + n0 + (lane & 31)]);
    if (scale) {
#pragma unroll
        for (int i = 0; i < 32; ++i) v[i] *= scale[k0 + 2 * i + (lane >> 5)];
    }
#pragma unroll
    for (int i = 0; i < 32; ++i) scr[(2 * i + (lane >> 5)) * 33 + (lane & 31)] = v[i];
    LDS_WAIT(); asm volatile("" ::: "memory");
    const int c = lane & 7;
#pragma unroll
    for (int j = 0; j < 4; ++j) { const int n = (lane >> 3) + 8 * j; const LAS float* s = scr + (8 * c) * 33 + n;
        u32x4 o; o.x = cvtpk(s[0 * 33], s[1 * 33]); o.y = cvtpk(s[2 * 33], s[3 * 33]); o.z = cvtpk(s[4 * 33], s[5 * 33]); o.w = cvtpk(s[6 * 33], s[7 * 33]);
        *(u32x4*)(WT + (size_t)(drow0 + n) * K + k0 + 8 * c) = o; }
    LDS_WAIT(); asm volatile("" ::: "memory");
}
__device__ __forceinline__ void p0_rms_row(const float* xrow, const float* w, bf16_t* orow, int lane) {
    const f32x4* xr = (const f32x4*)xrow + lane; const f32x4* wr = (const f32x4*)w + lane;
    f32x4 v[8]; float s = 0.f;
#pragma unroll
    for (int j = 0; j < 8; ++j) { v[j] = __builtin_nontemporal_load(&xr[64 * j]); s += (v[j][0] * v[j][0] + v[j][1] * v[j][1]) + (v[j][2] * v[j][2] + v[j][3] * v[j][3]); }
    const float rs = __builtin_amdgcn_rsqf(wave_sum(s) * (1.0f / DM) + RMS_EPS);
    u32x2* o8 = (u32x2*)orow + lane;
#pragma unroll
    for (int j = 0; j < 8; ++j) { const f32x4 ww = wr[64 * j]; f32x4 y; y[0] = v[j][0] * rs * ww[0]; y[1] = v[j][1] * rs * ww[1]; y[2] = v[j][2] * rs * ww[2]; y[3] = v[j][3] * rs * ww[3]; o8[64 * j] = pack4(y); }
}
__device__ __forceinline__ int rel_bucket(int n) {
    if (n < 16) return n;
    int b = 16 + (int)(__logf((float)n * (1.0f / 16.0f)) / 2.0794415416798357f * 16.0f);
    return b < 31 ? b : 31;
}
constexpr int CV_IN = 32 * (NIN / 32), CV_OUT = 32 * 64, CV_MQ = 32 * 16, CV_MO = 8 * 64, CV_G = 32 * (FF / 32), CV_DN = (FF / 64) * 64;
constexpr int CV_MID1 = CV_IN + CV_OUT + CV_MQ;
constexpr int CV_EARLY = CV_IN + CV_OUT + 3 * CV_MQ, CV_ALL = CV_EARLY + CV_MO + 2 * CV_G + CV_DN;
__device__ __forceinline__ void p0_convert(Frame& F, int it0, int it1, int gw, int NGW) {
    LAS float* scr = (LAS float*)(F.lds + F.wave * 16384);
    unsigned char* ws = F.ws;
    constexpr int I_IN = CV_IN, I_OUT = CV_OUT, I_MQ = CV_MQ, I_MO = CV_MO, I_G = CV_G;
    for (int it = it0 + gw; it < it1; it += NGW) {
        int r = it;
        if (r < I_IN) { const int nb = NIN / 32, kb = r / nb, n0 = (r % nb) * 32; p0_tr_item(F.in[I_WIN], DM, NIN, (bf16_t*)(ws + WS_WIN), kb * 64, n0, n0, nullptr, scr, F.lane); continue; } r -= I_IN;
        if (r < I_OUT) { const int kb = r / 64, n0 = (r % 64) * 32; p0_tr_item(F.in[I_WOUT], DM, DM, (bf16_t*)(ws + WS_WOUT), kb * 64, n0, n0, nullptr, scr, F.lane); continue; } r -= I_OUT;
        if (r < I_MQ) { const int kb = r / 16, n0 = (r % 16) * 32; p0_tr_item(F.in[I_WMQ], DM, MEMW, (bf16_t*)(ws + WS_WMQ), kb * 64, n0, n0, F.in[I_NXATT], scr, F.lane); continue; } r -= I_MQ;
        if (r < I_MQ) { const int kb = r / 16, n0 = (r % 16) * 32; p0_tr_item(F.in[I_WMK], DM, MEMW, (bf16_t*)(ws + WS_WMKV), kb * 64, n0, n0, nullptr, scr, F.lane); continue; } r -= I_MQ;
        if (r < I_MQ) { const int kb = r / 16, n0 = (r % 16) * 32; p0_tr_item(F.in[I_WMV], DM, MEMW, (bf16_t*)(ws + WS_WMKV), kb * 64, n0, 512 + n0, nullptr, scr, F.lane); continue; } r -= I_MQ;
        if (r < I_MO) { const int kb = r / 64, n0 = (r % 64) * 32; p0_tr_item(F.in[I_WMO], MEMW, DM, (bf16_t*)(ws + WS_WMO), kb * 64, n0, n0, nullptr, scr, F.lane); continue; } r -= I_MO;
        if (r < 2 * I_G) { const int up = r >= I_G; if (up) r -= I_G; const int nb = FF / 32, kb = r / nb, n0 = (r % nb) * 32;
            p0_tr_item(F.in[up ? I_WUP : I_WGATE], DM, FF, (bf16_t*)(ws + WS_WGU), kb * 64, n0, (n0 >> 7) * 256 + (n0 & 127) + (up ? 128 : 0), F.in[I_NFFN], scr, F.lane); continue; } r -= 2 * I_G;
        { const int kb = r / 64, n0 = (r % 64) * 32; p0_tr_item(F.in[I_WDOWN], FF, DM, (bf16_t*)(ws + WS_WDN), kb * 64, n0, n0, nullptr, scr, F.lane); }
    }
}
__device__ __forceinline__ void p0_prologue(Frame& F, bool all_weights) {
    const int gw = F.bid * NWAVES + F.wave, NGW = F.G * NWAVES;
    unsigned char* ws = F.ws;
    if (all_weights) p0_convert(F, 0, CV_ALL, gw, NGW);
    else { p0_convert(F, 0, CV_IN, gw, NGW); p0_convert(F, CV_MID1, CV_EARLY, gw, NGW); }
    for (int m = gw; m < TT + 1024; m += NGW) {
        if (m < TP) p0_rms_row(F.in[I_XP] + (size_t)m * DM, F.in[I_NMIX], (bf16_t*)(ws + WS_XB) + (size_t)m * DM, F.lane);
        else if (m < TT) p0_rms_row(F.in[I_XS] + (size_t)(m - TP) * DM, F.in[I_NMIX], (bf16_t*)(ws + WS_XB) + (size_t)m * DM, F.lane);
        else p0_rms_row(F.in[I_MEMP] + (size_t)(m - TT) * DM, F.in[I_NMEM], (bf16_t*)(ws + WS_MN) + (size_t)(m - TT) * DM, F.lane);
    }
    float* LBt = (float*)(ws + WS_TAB); float* BT = (float*)(ws + WS_TAB + 8192);
    const int gt = F.bid * NTHREADS + F.tid, NGT = F.G * NTHREADS;
    for (int i = gt; i < 1024 + 16 * 160; i += NGT) {
        if (i < 1024) { const float l0 = F.in[I_LB][i], l1 = F.in[I_LB][1024 + i]; LBt[i] = 1.0f / (1.0f + __expf(l1 - l0)); }
        else { const int j = i - 1024, h = j / 160, ix = j % 160, dist = 143 - ix;
            BT[j] = (dist >= 0 && dist < 128) ? F.in[I_RELB][rel_bucket(dist) * 16 + h] * LOG2E : -INFINITY; }
    }
}


constexpr int PREP_RS = 1032;
__device__ __forceinline__ void hgrn_prep(Frame& F, int j0, int j1, int stride, bool stepmajor) {
    unsigned char* ws = F.ws;
    const bf16_t* QF = (const bf16_t*)F.out; const bf16_t* GF = QF + (size_t)TT * 1024; const bf16_t* VB = (const bf16_t*)(F.out + O_SST);
    bf16_t* QIN = (bf16_t*)(ws + WS_QIN); bf16_t* KT = (bf16_t*)(ws + WS_KT); bf16_t* VT = (bf16_t*)(ws + WS_VT); bf16_t* PSC = (bf16_t*)(ws + WS_PSC); float* DEC = (float*)(ws + WS_DEC);
    LAS bf16_t* lq = (LAS bf16_t*)F.lds; LAS bf16_t* lk = lq + 16 * PREP_RS;
    const int l15 = F.lane & 15, g4 = F.lane >> 4;
    for (int j = j0; j < j1; j += stride) {
        const int ch = (stepmajor && j < NCHP) ? ((j & 3) * (NCHP / 4) + (j >> 2)) : j;
        const int nv = ch < NCHP ? 16 : 4; const int row0 = ch < NCHP ? ch * 16 : TP + (ch - NCHP) * 4;
        {
            const int c2 = 2 * F.tid;
            unsigned gq[16], qq[16], vv[16];
#pragma unroll
            for (int t = 0; t < 16; ++t) {
                if (t < nv) { gq[t] = *(const unsigned*)(GF + (size_t)(row0 + t) * 1024 + c2); qq[t] = *(const unsigned*)(QF + (size_t)(row0 + t) * 1024 + c2); vv[t] = *(const unsigned*)(VB + (size_t)(row0 + t) * 1024 + c2); }
                else { gq[t] = 0u; qq[t] = 0u; vv[t] = 0u; }
            }
            float G0 = 0.f, G1 = 0.f; unsigned kd0[8], kd1[8], vt0[8], vt1[8];
#pragma unroll
            for (int t = 0; t < 16; t += 2) {
                float ka[2], kb[2];
#pragma unroll
                for (int z = 0; z < 2; ++z) {
                    const float g0 = __uint_as_float(gq[t + z] << 16), g1 = __uint_as_float(gq[t + z] & 0xffff0000u);
                    const float q0 = __uint_as_float(qq[t + z] << 16), q1 = __uint_as_float(qq[t + z] & 0xffff0000u);
                    G0 += g0; G1 += g1;
                    const float qi0 = q0 * fexp(G0), qi1 = q1 * fexp(G1);
                    ka[z] = (1.0f - fexp(g0)) * fexp(fminf(-G0, 80.0f)); kb[z] = (1.0f - fexp(g1)) * fexp(fminf(-G1, 80.0f));
                    *(LAS unsigned*)(lq + (t + z) * PREP_RS + c2) = cvtpk(qi0, qi1); *(LAS unsigned*)(lk + (t + z) * PREP_RS + c2) = cvtpk(ka[z], kb[z]);
                }
                kd0[t >> 1] = cvtpk(ka[0], ka[1]); kd1[t >> 1] = cvtpk(kb[0], kb[1]);
                vt0[t >> 1] = (vv[t] & 0xffffu) | (vv[t + 1] << 16); vt1[t >> 1] = (vv[t] >> 16) | (vv[t + 1] & 0xffff0000u);
            }
            *(f32x2*)(DEC + (size_t)ch * 1024 + c2) = (f32x2){fexp(G0), fexp(G1)};
            u32x4* kp = (u32x4*)(KT + ((size_t)ch * 1024 + c2) * 16); kp[0] = (u32x4){kd0[0], kd0[1], kd0[2], kd0[3]}; kp[1] = (u32x4){kd0[4], kd0[5], kd0[6], kd0[7]}; kp[2] = (u32x4){kd1[0], kd1[1], kd1[2], kd1[3]}; kp[3] = (u32x4){kd1[4], kd1[5], kd1[6], kd1[7]};
            u32x4* vp = (u32x4*)(VT + ((size_t)ch * 1024 + c2) * 16); vp[0] = (u32x4){vt0[0], vt0[1], vt0[2], vt0[3]}; vp[1] = (u32x4){vt0[4], vt0[5], vt0[6], vt0[7]}; vp[2] = (u32x4){vt1[0], vt1[1], vt1[2], vt1[3]}; vp[3] = (u32x4){vt1[4], vt1[5], vt1[6], vt1[7]};
        }
        __syncthreads();
#pragma unroll
        for (int i = 0; i < 4; ++i) { const int idx = F.tid + 512 * i, t = idx >> 7, c8 = idx & 127;
            *(u32x4*)(QIN + ((size_t)ch * 16 + t) * 1024 + c8 * 8) = *(const LAS u32x4*)(lq + t * PREP_RS + c8 * 8); }
        {
            const int h = F.wave; f32x4 acc = {0.f, 0.f, 0.f, 0.f};
#pragma unroll
            for (int kk = 0; kk < 4; ++kk) {
                const bf16x8 a = *(const LAS bf16x8*)(lq + l15 * PREP_RS + h * 128 + 32 * kk + 8 * g4);
                const bf16x8 b = *(const LAS bf16x8*)(lk + l15 * PREP_RS + h * 128 + 32 * kk + 8 * g4);
                acc = __builtin_amdgcn_mfma_f32_16x16x32_bf16(a, b, acc, 0, 0, 0);
            }
            bf16_t* pd = PSC + ((size_t)ch * 8 + h) * 256;
#pragma unroll
            for (int r = 0; r < 4; ++r) { const int t = 4 * g4 + r, s = l15; pd[t * 16 + s] = (s <= t) ? f2bf(acc[r]) : (bf16_t)0; }
        }
        __syncthreads();
    }
}

__device__ __forceinline__ void flag_signal(unsigned* p) {
    asm volatile("s_waitcnt vmcnt(0)" ::: "memory"); __syncthreads();
    if (threadIdx.x == 0) { __builtin_amdgcn_fence(__ATOMIC_RELEASE, "agent"); asm volatile("s_waitcnt vmcnt(0)" ::: "memory"); __hip_atomic_fetch_add(p, 1u, __ATOMIC_RELAXED, __HIP_MEMORY_SCOPE_AGENT); }
}
__device__ __forceinline__ void flag_wait(unsigned* p, unsigned need) {
    if (threadIdx.x == 0) {
        unsigned sp = 0; while (__hip_atomic_load(p, __ATOMIC_RELAXED, __HIP_MEMORY_SCOPE_AGENT) < need) { __builtin_amdgcn_s_sleep(2); if (++sp > (1u << 22)) break; }
        __builtin_amdgcn_fence(__ATOMIC_ACQUIRE, "agent"); asm volatile("s_waitcnt vmcnt(0)" ::: "memory");
    }
    __syncthreads();
}
constexpr int SC_QS = 136;
constexpr int SC_QI = 0, SC_KT = 16 * SC_QS * 2, SC_VT = SC_KT + 4096, SC_P = SC_VT + 4096, SC_DEC = SC_P + 512, SC_GATE = SC_DEC + 512, SC_BUF = SC_GATE + 16 * SC_QS * 2;
constexpr int SC_RED = 2 * SC_BUF;
static_assert(SC_RED + 1024 <= LDS_BYTES && SC_BUF % 16 == 0, "scan LDS");
struct ScanPf { u32x4 a, b, c; };
struct ScanSrc { const unsigned char* a; const unsigned char* b; const unsigned char* c; unsigned oa, ob, oc; };
__device__ __forceinline__ ScanSrc scan_src(const Frame& F, int ch0, int h, int grow0, int ngr) {
    const unsigned char* ws = F.ws; const int tid = F.tid; ScanSrc s;
    const bf16_t* QIN = (const bf16_t*)(ws + WS_QIN); const bf16_t* KT = (const bf16_t*)(ws + WS_KT); const bf16_t* VT = (const bf16_t*)(ws + WS_VT);
    const bf16_t* PSC = (const bf16_t*)(ws + WS_PSC); const float* DEC = (const float*)(ws + WS_DEC); const bf16_t* GATE = (const bf16_t*)(ws + WS_GATE);
    if (tid < 256) { const int t = tid >> 4, p = tid & 15;
        s.a = (const unsigned char*)(QIN + ((size_t)ch0 * 16 + t) * 1024 + h * 128 + p * 8); s.oa = SC_QI + (t * SC_QS + p * 8) * 2;
        s.b = (const unsigned char*)(VT + ((size_t)ch0 * 1024 + h * 128) * 16 + tid * 8); s.ob = SC_VT + tid * 16;
    } else { const int i = tid - 256, t = i >> 4, p = i & 15; const int tr = t < ngr ? t : ngr - 1;
        s.a = (const unsigned char*)(KT + ((size_t)ch0 * 1024 + h * 128) * 16 + i * 8); s.oa = SC_KT + i * 16;
        s.b = (const unsigned char*)(GATE + (size_t)(grow0 + tr) * 1024 + h * 128 + p * 8); s.ob = SC_GATE + (t * SC_QS + p * 8) * 2;
    }
    if (tid < 32) { s.c = (const unsigned char*)(PSC + ((size_t)ch0 * 8 + h) * 256 + tid * 8); s.oc = SC_P + tid * 16; }
    else { const int i = (tid - 32) & 31; s.c = (const unsigned char*)(DEC + (size_t)ch0 * 1024 + h * 128 + i * 4); s.oc = SC_DEC + i * 16; }
    return s;
}
__device__ __forceinline__ void scan_fetch(ScanPf& pf, const ScanSrc& s, const Frame& F, int step) {
    pf.a = *(const u32x4*)(s.a + (size_t)step * 32768); pf.b = *(const u32x4*)(s.b + (size_t)step * 32768);
    if (F.tid < 64) pf.c = *(const u32x4*)(s.c + (size_t)step * 4096);
}
__device__ __forceinline__ void scan_stash(const ScanPf& pf, const ScanSrc& s, const Frame& F, int buf) {
    LAS unsigned char* B = F.lds + buf * SC_BUF;
    *(LAS u32x4*)(B + s.oa) = pf.a; *(LAS u32x4*)(B + s.ob) = pf.b;
    if (F.tid < 64) *(LAS u32x4*)(B + s.oc) = pf.c;
}
template <int CTRL> __device__ __forceinline__ float dpp_mov(float v) { return __int_as_float(__builtin_amdgcn_update_dpp(0, __float_as_int(v), CTRL, 0xF, 0xF, true)); }
__device__ __forceinline__ float row16_sum(float v) { v += dpp_mov<0xB1>(v); v += dpp_mov<0x4E>(v); v += dpp_mov<0x141>(v); v += dpp_mov<0x140>(v); return v; }
constexpr int SC_ST = SC_RED + 1024, SC_STS = 132;
static_assert(SC_ST + 128 * SC_STS * 4 <= LDS_BYTES, "scan LDS (state image)");
template <int DBG>
__device__ __forceinline__ void hgrn_scan_t(Frame& F, int ch0, int nsteps, int h, int mrow0, int nvalid, const float* S0, float* Sout, bf16_t* MIXP, int mixld, float* DBGP) {
    const int lane = F.lane, l15 = lane & 15, g4 = lane >> 4, e0 = 16 * F.wave;
    bf16_t* MIX = MIXP;
    const float onw = F.in[I_ONORM][e0 + l15];
    LAS float* RED = (LAS float*)(F.lds + SC_RED);
    LAS float* ST = (LAS float*)(F.lds + SC_ST);
    ScanPf pf;
    __syncthreads();
    const ScanSrc src = scan_src(F, ch0, h, mrow0, nvalid);
    scan_fetch(pf, src, F, 0); scan_stash(pf, src, F, 0);
    if (nsteps > 1) scan_fetch(pf, src, F, 1);
    f32x4 S[8];
    if (S0) {
#pragma unroll
        for (int i = 0; i < 8; ++i) { const int idx = F.tid + 512 * i, c = idx >> 5, e4 = idx & 31; *(LAS f32x4*)(ST + c * SC_STS + e4 * 4) = __builtin_nontemporal_load((const f32x4*)(S0 + (size_t)c * 128 + e4 * 4)); }
    }
    __syncthreads();
#pragma unroll
    for (int mt = 0; mt < 8; ++mt)
#pragma unroll
        for (int r = 0; r < 4; ++r) S[mt][r] = S0 ? ST[(16 * mt + 4 * g4 + r) * SC_STS + e0 + l15] : 0.f;
    f32x4 o_prev = {0.f, 0.f, 0.f, 0.f}, gate_prev = {0.f, 0.f, 0.f, 0.f};
#pragma unroll 1
    for (int n = 0; n <= nsteps; ++n) {
        const int buf = n & 1;
        f32x4 o = {0.f, 0.f, 0.f, 0.f}, gate = {0.f, 0.f, 0.f, 0.f};
        if (n + 1 < nsteps) {
            scan_stash(pf, src, F, buf ^ 1);
            if (n + 2 < nsteps) scan_fetch(pf, src, F, n + 2);
        }
        if (n < nsteps) {
            const LAS unsigned char* B = F.lds + buf * SC_BUF;
            const bf16x4 vt = *(const LAS bf16x4*)(B + SC_VT + ((e0 + l15) * 16 + 4 * g4) * 2);
            const bf16x4 pa = *(const LAS bf16x4*)(B + SC_P + (l15 * 16 + 4 * g4) * 2);
            const f32x4 zz = {0.f, 0.f, 0.f, 0.f};
            f32x4 oq[4];
            const f32x4 op = __builtin_amdgcn_mfma_f32_16x16x16bf16_1k(pa, vt, zz, 0, 0, 0);
#pragma unroll
            for (int kk = 0; kk < 4; ++kk) {
                const bf16x4 q0 = *(const LAS bf16x4*)(B + SC_QI + (l15 * SC_QS + 32 * kk + 4 * g4) * 2);
                const bf16x4 q1 = *(const LAS bf16x4*)(B + SC_QI + (l15 * SC_QS + 32 * kk + 16 + 4 * g4) * 2);
                const bf16x8 qa = {q0[0], q0[1], q0[2], q0[3], q1[0], q1[1], q1[2], q1[3]};
                const u32x4 sb = pack8(S[2 * kk], S[2 * kk + 1]);
                oq[kk] = __builtin_amdgcn_mfma_f32_16x16x32_bf16(qa, __builtin_bit_cast(bf16x8, sb), zz, 0, 0, 0);
            }
            o = (oq[0] + oq[2]) + op; const f32x4 ob = oq[1] + oq[3];
#pragma unroll
            for (int mt = 0; mt < 8; ++mt) {
                const bf16x4 kt = *(const LAS bf16x4*)(B + SC_KT + ((16 * mt + l15) * 16 + 4 * g4) * 2);
                const f32x4 dc = *(const LAS f32x4*)(B + SC_DEC + (16 * mt + 4 * g4) * 4);
                S[mt] = __builtin_amdgcn_mfma_f32_16x16x16bf16_1k(kt, vt, S[mt], 0, 0, 0);
                S[mt] = S[mt] * dc;
            }
            o = o + ob;
            if constexpr (DBG == 1) {
#pragma unroll
                for (int r = 0; r < 4; ++r) DBGP[(size_t)(mrow0 + 16 * n + 4 * g4 + r) * 1024 + h * 128 + e0 + l15] = o[r];
            }
#pragma unroll
            for (int r = 0; r < 4; ++r) {
                gate[r] = bf2f(*(const LAS unsigned short*)(B + SC_GATE + ((4 * g4 + r) * SC_QS + e0 + l15) * 2));
                const float ss = row16_sum(o[r] * o[r]);
                if (l15 == 0) RED[(buf * 8 + F.wave) * 16 + 4 * g4 + r] = ss;
            }
        }
        if (n > 0) {
            const int pb = (n - 1) & 1;
#pragma unroll
            for (int r = 0; r < 4; ++r) {
                const int t = 4 * g4 + r; float tot = 0.f;
#pragma unroll
                for (int w = 0; w < 8; ++w) tot += RED[(pb * 8 + w) * 16 + t];
                const float rs = __builtin_amdgcn_rsqf(tot * (1.0f / 128.0f) + RMS_EPS);
                if constexpr (DBG == 2) DBGP[(size_t)(mrow0 + 16 * (n - 1) + t) * 1024 + h * 128 + e0 + l15] = tot;
                if constexpr (DBG == 3) DBGP[(size_t)(mrow0 + 16 * (n - 1) + t) * 1024 + h * 128 + e0 + l15] = gate_prev[r];
                if constexpr (DBG == 4) DBGP[(size_t)(mrow0 + 16 * (n - 1) + t) * 1024 + h * 128 + e0 + l15] = o_prev[r];
                if (t < nvalid) MIX[(size_t)(mrow0 + 16 * (n - 1) + t) * mixld + h * 128 + e0 + l15] = f2bf(o_prev[r] * rs * onw * gate_prev[r]);
            }
        }
        o_prev = o; gate_prev = gate;
        __syncthreads();
    }
#pragma unroll
    for (int mt = 0; mt < 8; ++mt)
#pragma unroll
        for (int r = 0; r < 4; ++r) ST[(16 * mt + 4 * g4 + r) * SC_STS + e0 + l15] = S[mt][r];
    __syncthreads();
#pragma unroll
    for (int i = 0; i < 8; ++i) { const int idx = F.tid + 512 * i, c = idx >> 5, e4 = idx & 31; __builtin_nontemporal_store(*(const LAS f32x4*)(ST + c * SC_STS + e4 * 4), (f32x4*)(Sout + (size_t)c * 128 + e4 * 4)); }
}


template <int DBG>
__device__ __forceinline__ void hgrn_scan_pd_t(Frame& F, int ch0, int nsteps, int h, int mrow0, int nvalid, const float* S0, float* Sout, bf16_t* MIXP, int mixld, float* DBGP) {
    const int lane = F.lane, l15 = lane & 15, g4 = lane >> 4, e0 = 16 * F.wave;
    bf16_t* MIX = MIXP;
    const float onw = F.in[I_ONORM][e0 + l15];
    LAS float* RED = (LAS float*)(F.lds + SC_RED);
    LAS float* ST = (LAS float*)(F.lds + SC_ST);
    constexpr int PD = 2;
    ScanPf pf[PD];
    __syncthreads();
    const ScanSrc src = scan_src(F, ch0, h, mrow0, nvalid);
#pragma unroll
    for (int j = 0; j < PD; ++j) if (j < nsteps) scan_fetch(pf[j], src, F, j);
    scan_stash(pf[0], src, F, 0);
    if (PD < nsteps) scan_fetch(pf[0], src, F, PD);
    f32x4 S[8];
    if (S0) {
#pragma unroll
        for (int i = 0; i < 8; ++i) { const int idx = F.tid + 512 * i, c = idx >> 5, e4 = idx & 31; *(LAS f32x4*)(ST + c * SC_STS + e4 * 4) = *(const f32x4*)(S0 + (size_t)c * 128 + e4 * 4); }
    }
    __syncthreads();
#pragma unroll
    for (int mt = 0; mt < 8; ++mt)
#pragma unroll
        for (int r = 0; r < 4; ++r) S[mt][r] = S0 ? ST[(16 * mt + 4 * g4 + r) * SC_STS + e0 + l15] : 0.f;
    f32x4 o_prev = {0.f, 0.f, 0.f, 0.f}, gate_prev = {0.f, 0.f, 0.f, 0.f};
#pragma unroll 1
    for (int n = 0; n <= nsteps; ++n) {
        const int buf = n & 1;
        f32x4 o = {0.f, 0.f, 0.f, 0.f}, gate = {0.f, 0.f, 0.f, 0.f};
        if (n + 1 < nsteps) {
            const bool more = n + 1 + PD < nsteps;
            if (((n + 1) & 1) == 0) { scan_stash(pf[0], src, F, buf ^ 1); if (more) scan_fetch(pf[0], src, F, n + 1 + PD); }
            else { scan_stash(pf[1], src, F, buf ^ 1); if (more) scan_fetch(pf[1], src, F, n + 1 + PD); }
        }
        if (n < nsteps) {
            const LAS unsigned char* B = F.lds + buf * SC_BUF;
            const bf16x4 vt = *(const LAS bf16x4*)(B + SC_VT + ((e0 + l15) * 16 + 4 * g4) * 2);
            const bf16x4 pa = *(const LAS bf16x4*)(B + SC_P + (l15 * 16 + 4 * g4) * 2);
            f32x4 ob = {0.f, 0.f, 0.f, 0.f};
            o = __builtin_amdgcn_mfma_f32_16x16x16bf16_1k(pa, vt, o, 0, 0, 0);
#pragma unroll
            for (int kk = 0; kk < 4; ++kk) {
                const bf16x4 q0 = *(const LAS bf16x4*)(B + SC_QI + (l15 * SC_QS + 32 * kk + 4 * g4) * 2);
                const bf16x4 q1 = *(const LAS bf16x4*)(B + SC_QI + (l15 * SC_QS + 32 * kk + 16 + 4 * g4) * 2);
                const bf16x8 qa = {q0[0], q0[1], q0[2], q0[3], q1[0], q1[1], q1[2], q1[3]};
                const u32x4 sb = pack8(S[2 * kk], S[2 * kk + 1]);
                if (kk & 1) ob = __builtin_amdgcn_mfma_f32_16x16x32_bf16(qa, __builtin_bit_cast(bf16x8, sb), ob, 0, 0, 0);
                else o = __builtin_amdgcn_mfma_f32_16x16x32_bf16(qa, __builtin_bit_cast(bf16x8, sb), o, 0, 0, 0);
            }
#pragma unroll
            for (int mt = 0; mt < 8; ++mt) {
                const bf16x4 kt = *(const LAS bf16x4*)(B + SC_KT + ((16 * mt + l15) * 16 + 4 * g4) * 2);
                const f32x4 dc = *(const LAS f32x4*)(B + SC_DEC + (16 * mt + 4 * g4) * 4);
                S[mt] = __builtin_amdgcn_mfma_f32_16x16x16bf16_1k(kt, vt, S[mt], 0, 0, 0);
                S[mt] = S[mt] * dc;
            }
            o = o + ob;
            if constexpr (DBG == 1) {
#pragma unroll
                for (int r = 0; r < 4; ++r) DBGP[(size_t)(mrow0 + 16 * n + 4 * g4 + r) * 1024 + h * 128 + e0 + l15] = o[r];
            }
#pragma unroll
            for (int r = 0; r < 4; ++r) {
                gate[r] = bf2f(*(const LAS unsigned short*)(B + SC_GATE + ((4 * g4 + r) * SC_QS + e0 + l15) * 2));
                const float ss = row16_sum(o[r] * o[r]);
                if (l15 == 0) RED[(buf * 8 + F.wave) * 16 + 4 * g4 + r] = ss;
            }
        }
        if (n > 0) {
            const int pb = (n - 1) & 1;
#pragma unroll
            for (int r = 0; r < 4; ++r) {
                const int t = 4 * g4 + r; float tot = 0.f;
#pragma unroll
                for (int w = 0; w < 8; ++w) tot += RED[(pb * 8 + w) * 16 + t];
                const float rs = __builtin_amdgcn_rsqf(tot * (1.0f / 128.0f) + RMS_EPS);
                if constexpr (DBG == 2) DBGP[(size_t)(mrow0 + 16 * (n - 1) + t) * 1024 + h * 128 + e0 + l15] = tot;
                if constexpr (DBG == 3) DBGP[(size_t)(mrow0 + 16 * (n - 1) + t) * 1024 + h * 128 + e0 + l15] = gate_prev[r];
                if constexpr (DBG == 4) DBGP[(size_t)(mrow0 + 16 * (n - 1) + t) * 1024 + h * 128 + e0 + l15] = o_prev[r];
                if (t < nvalid) MIX[(size_t)(mrow0 + 16 * (n - 1) + t) * mixld + h * 128 + e0 + l15] = f2bf(o_prev[r] * rs * onw * gate_prev[r]);
            }
        }
        o_prev = o; gate_prev = gate;
        __syncthreads();
    }
#pragma unroll
    for (int mt = 0; mt < 8; ++mt)
#pragma unroll
        for (int r = 0; r < 4; ++r) ST[(16 * mt + 4 * g4 + r) * SC_STS + e0 + l15] = S[mt][r];
    __syncthreads();
#pragma unroll
    for (int i = 0; i < 8; ++i) { const int idx = F.tid + 512 * i, c = idx >> 5, e4 = idx & 31; *(f32x4*)(Sout + (size_t)c * 128 + e4 * 4) = *(const LAS f32x4*)(ST + c * SC_STS + e4 * 4); }
}


#ifndef HY_VFIN
#define HY_VFIN 1
#endif
#ifndef HY_VST
#define HY_VST 1
#endif
#ifndef HY_VPART
#define HY_VPART 15
#endif
#ifndef HY_VLDSW
#define HY_VLDSW 1
#endif
#ifndef HY_VISSUE
#define HY_VISSUE 1
#endif
#ifndef HY_VCOMP
#define HY_VCOMP 1
#endif
#ifndef HY_VWRITE
#define HY_VWRITE 1
#endif
constexpr int DS_QSB = 272, DS_SLOT = 18432, DS_R = 6;
constexpr int DS_RED = DS_R * DS_SLOT;
constexpr int DS_OUT = DS_RED + 1024;
constexpr int DS_ST = 0, DS_STS = 132;
static_assert(DS_OUT + 8192 <= LDS_BYTES - 64 && 128 * DS_STS * 4 <= DS_RED && DS_SLOT % 1024 == 0, "dma scan LDS");
#ifdef HY_NO_DMA
extern __shared__ __attribute__((aligned(16))) unsigned char lds_raw2[];
__device__ __forceinline__ void glds16(const void* gsrc, unsigned lds_dst) { u32x4 v = *(const u32x4*)gsrc; if (HY_VLDSW) *(LAS u32x4*)((LAS unsigned char*)lds_raw2 + lds_dst + 16 * (threadIdx.x & 63)) = v; else asm volatile("" :: "v"(v)); }
__device__ __forceinline__ void glds4(const void* gsrc, unsigned lds_dst) { unsigned v = *(const unsigned*)gsrc; if (HY_VLDSW) *(LAS unsigned*)((LAS unsigned char*)lds_raw2 + lds_dst + 4 * (threadIdx.x & 63)) = v; else asm volatile("" :: "v"(v)); }
#else
__device__ __forceinline__ void glds16(const void* gsrc, unsigned lds_dst) { unsigned keep;
    asm volatile("s_mov_b32 %0, m0\n\ts_mov_b32 m0, %2\n\ts_nop 0\n\tglobal_load_lds_dwordx4 %1, off\n\ts_mov_b32 m0, %0" : "=&s"(keep) : "v"(gsrc), "s"(lds_dst) : "memory"); }
__device__ __forceinline__ void glds4(const void* gsrc, unsigned lds_dst) { unsigned keep;
    asm volatile("s_mov_b32 %0, m0\n\ts_mov_b32 m0, %2\n\ts_nop 0\n\tglobal_load_lds_dword %1, off\n\ts_mov_b32 m0, %0" : "=&s"(keep) : "v"(gsrc), "s"(lds_dst) : "memory"); }
#endif
#ifdef HY_DSSYNC
#define DS_BAR() __syncthreads()
#else
#define DS_BAR() do { asm volatile("s_waitcnt lgkmcnt(0)" ::: "memory"); __builtin_amdgcn_s_barrier(); asm volatile("" ::: "memory"); } while (0)
#endif
template <int DBG>
__device__ __forceinline__ void hgrn_scan_dma_t(Frame& F, int ch0, int nsteps, int h, int mrow0, int nvalid, const float* S0, float* Sout, bf16_t* MIXP, int mixld, float* DBGP) {
    const int lane = F.lane, l15 = lane & 15, g4 = lane >> 4, e0 = 16 * F.wave, w = F.wave;
    const unsigned char* ws = F.ws;
    bf16_t* MIX = MIXP;
    const float onw = F.in[I_ONORM][e0 + l15];
    LAS float* RED = (LAS float*)(F.lds + DS_RED);
    LAS float* ST = (LAS float*)(F.lds + DS_ST);
    LAS bf16_t* OUTB = (LAS bf16_t*)(F.lds + DS_OUT);
    const int wq = w & 3;
    const unsigned char* sq = ws + WS_QIN + (((size_t)ch0 * 16 + 4 * wq) * 1024 + h * 128) * 2 + lane * 4;
    const unsigned char* sk = ws + WS_KT + (((size_t)ch0 * 1024 + h * 128) * 16 + (wq * 64 + lane) * 8) * 2;
    const unsigned char* sv = ws + WS_VT + (((size_t)ch0 * 1024 + h * 128) * 16 + (wq * 64 + lane) * 8) * 2;
    const unsigned char* sg = ws + WS_GATE + ((size_t)mrow0 * 1024 + h * 128) * 2 + lane * 4;
    const unsigned char* sc = lane < 32 ? ws + WS_PSC + (((size_t)ch0 * 8 + h) * 256 + lane * 8) * 2 : ws + WS_DEC + ((size_t)ch0 * 1024 + h * 128 + (lane - 32) * 4) * 4;
    int grow[4];
#pragma unroll
    for (int r = 0; r < 4; ++r) { const int t = 4 * wq + r; grow[r] = (t < nvalid ? t : nvalid - 1) * 2048; }
#ifdef HY_NO_DMA
    const unsigned ring0 = 0u;
#else
    const unsigned ring0 = (unsigned)(uintptr_t)F.lds;
#endif
#define DS_ISSUE(step, slot) do { if (w < 4) { const unsigned so_ = ring0 + (unsigned)__builtin_amdgcn_readfirstlane((int)((slot) * DS_SLOT)); const size_t go_ = (size_t)(step) * 32768; \
        if (HY_VPART & 1) { _Pragma("unroll") for (int r_ = 0; r_ < 4; ++r_) glds4(sq + go_ + r_ * 2048, so_ + SC_QI + (4 * wq + r_) * DS_QSB); } \
        if (HY_VPART & 2) { glds16(sk + go_, so_ + SC_KT + wq * 1024); glds16(sv + go_, so_ + SC_VT + wq * 1024); } \
        if (HY_VPART & 4) { _Pragma("unroll") for (int r_ = 0; r_ < 4; ++r_) glds4(sg + go_ + grow[r_], so_ + SC_GATE + (4 * wq + r_) * DS_QSB); } \
        if ((HY_VPART & 8) && w == 0) glds16(sc + (size_t)(step) * 4096, so_ + SC_P); } } while (0)
    __syncthreads();
    f32x4 S[8];
    if (S0) {
#pragma unroll
        for (int i = 0; i < 8; ++i) { const int idx = F.tid + 512 * i, c = idx >> 5, e4 = idx & 31; *(LAS f32x4*)(ST + c * DS_STS + e4 * 4) = *(const f32x4*)(S0 + (size_t)c * 128 + e4 * 4); }
        __syncthreads();
#pragma unroll
        for (int mt = 0; mt < 8; ++mt)
#pragma unroll
            for (int r = 0; r < 4; ++r) S[mt][r] = ST[(16 * mt + 4 * g4 + r) * DS_STS + e0 + l15];
        __syncthreads();
    } else {
#pragma unroll
        for (int mt = 0; mt < 8; ++mt) S[mt] = (f32x4){0.f, 0.f, 0.f, 0.f};
    }
    if (HY_VISSUE) for (int s = 0; s < DS_R - 1 && s < nsteps; ++s) DS_ISSUE(s, s);
    f32x4 o_prev = {0.f, 0.f, 0.f, 0.f}, gate_prev = {0.f, 0.f, 0.f, 0.f};
    int slot = 0;
#pragma unroll 1
    for (int n = 0; n <= nsteps + 1; ++n) {
        if (w < 4) {
#ifndef HY_DRAIN
            if (n >= DS_R && n + DS_R <= nsteps + 1) { if (w == 0) asm volatile("s_waitcnt vmcnt(44)" ::: "memory"); else asm volatile("s_waitcnt vmcnt(40)" ::: "memory"); }
            else
#endif
            asm volatile("s_waitcnt vmcnt(0)" ::: "memory");
        }
        static_assert(DS_R == 6, "the counted waits above are (DS_R - 2) * 11 and (DS_R - 2) * 10");
        DS_BAR();
        if (HY_VISSUE && n - 1 + DS_R < nsteps) { const int ps = slot == 0 ? DS_R - 1 : slot - 1; DS_ISSUE(n - 1 + DS_R, ps); }
        const int buf = n & 1;
        f32x4 o = {0.f, 0.f, 0.f, 0.f}, gate = {0.f, 0.f, 0.f, 0.f};
        if (HY_VCOMP && n < nsteps) {
            const LAS unsigned char* B = F.lds + slot * DS_SLOT;
            const bf16x4 vt = *(const LAS bf16x4*)(B + SC_VT + ((e0 + l15) * 16 + 4 * g4) * 2);
            const bf16x4 pa = *(const LAS bf16x4*)(B + SC_P + (l15 * 16 + 4 * g4) * 2);
            const f32x4 zz = {0.f, 0.f, 0.f, 0.f};
            f32x4 oq[4];
            const f32x4 op = __builtin_amdgcn_mfma_f32_16x16x16bf16_1k(pa, vt, zz, 0, 0, 0);
#pragma unroll
            for (int kk = 0; kk < 4; ++kk) {
                const bf16x4 q0 = *(const LAS bf16x4*)(B + SC_QI + l15 * DS_QSB + (32 * kk + 4 * g4) * 2);
                const bf16x4 q1 = *(const LAS bf16x4*)(B + SC_QI + l15 * DS_QSB + (32 * kk + 16 + 4 * g4) * 2);
                const bf16x8 qa = {q0[0], q0[1], q0[2], q0[3], q1[0], q1[1], q1[2], q1[3]};
                const u32x4 sb8 = pack8(S[2 * kk], S[2 * kk + 1]);
                oq[kk] = __builtin_amdgcn_mfma_f32_16x16x32_bf16(qa, __builtin_bit_cast(bf16x8, sb8), zz, 0, 0, 0);
            }
            o = (oq[0] + oq[2]) + op; const f32x4 ob = oq[1] + oq[3];
#pragma unroll
            for (int mt = 0; mt < 8; ++mt) {
                const bf16x4 kt = *(const LAS bf16x4*)(B + SC_KT + ((16 * mt + l15) * 16 + 4 * g4) * 2);
                const f32x4 dc4 = *(const LAS f32x4*)(B + SC_DEC + (16 * mt + 4 * g4) * 4);
                S[mt] = __builtin_amdgcn_mfma_f32_16x16x16bf16_1k(kt, vt, S[mt], 0, 0, 0);
                S[mt] = S[mt] * dc4;
            }
            o = o + ob;
            if constexpr (DBG == 1) {
#pragma unroll
                for (int r = 0; r < 4; ++r) DBGP[(size_t)(mrow0 + 16 * n + 4 * g4 + r) * 1024 + h * 128 + e0 + l15] = o[r];
            }
#pragma unroll
            for (int r = 0; r < 4; ++r) {
                const int t = 4 * g4 + r;
                gate[r] = bf2f(*(const LAS unsigned short*)(B + SC_GATE + t * DS_QSB + (e0 + l15) * 2));
                const float ss = row16_sum(o[r] * o[r]);
                if (l15 == 0) RED[(buf * 8 + w) * 16 + t] = ss;
            }
        }
        if (HY_VFIN && n > 0 && n <= nsteps) {
            const int pb = buf ^ 1;
#pragma unroll
            for (int r = 0; r < 4; ++r) {
                const int t = 4 * g4 + r; float tot = 0.f;
#pragma unroll
                for (int ww = 0; ww < 8; ++ww) tot += RED[(pb * 8 + ww) * 16 + t];
                const float rs = __builtin_amdgcn_rsqf(tot * (1.0f / 128.0f) + RMS_EPS);
                if constexpr (DBG == 2) DBGP[(size_t)(mrow0 + 16 * (n - 1) + t) * 1024 + h * 128 + e0 + l15] = tot;
                if constexpr (DBG == 3) DBGP[(size_t)(mrow0 + 16 * (n - 1) + t) * 1024 + h * 128 + e0 + l15] = gate_prev[r];
                if constexpr (DBG == 4) DBGP[(size_t)(mrow0 + 16 * (n - 1) + t) * 1024 + h * 128 + e0 + l15] = o_prev[r];
                OUTB[(buf * 16 + t) * 128 + e0 + l15] = f2bf(o_prev[r] * rs * onw * gate_prev[r]);
            }
        }
        if (n > 1 && w >= 4) {
            const int i = (w - 4) * 64 + lane, t = i >> 4, p = i & 15;
            if (HY_VWRITE && t < nvalid) *(u32x4*)(MIX + (size_t)(mrow0 + 16 * (n - 2) + t) * mixld + h * 128 + p * 8) = *(const LAS u32x4*)(OUTB + ((buf ^ 1) * 16 + t) * 128 + p * 8);
        }
        o_prev = o; gate_prev = gate;
        slot = slot == DS_R - 1 ? 0 : slot + 1;
    }
    asm volatile("s_waitcnt vmcnt(0)" ::: "memory");
    __syncthreads();
    if (HY_VST) {
#pragma unroll
    for (int mt = 0; mt < 8; ++mt)
#pragma unroll
        for (int r = 0; r < 4; ++r) ST[(16 * mt + 4 * g4 + r) * DS_STS + e0 + l15] = S[mt][r];
    }
    __syncthreads();
    if (HY_VWRITE)
#pragma unroll
    for (int i = 0; i < 8; ++i) { const int idx = F.tid + 512 * i, c = idx >> 5, e4 = idx & 31; *(f32x4*)(Sout + (size_t)c * 128 + e4 * 4) = *(const LAS f32x4*)(ST + c * DS_STS + e4 * 4); }
#undef DS_ISSUE
}


constexpr int D2_RED = DS_R * DS_SLOT;
constexpr int D2_RS = D2_RED + 1024;
constexpr int D2_OUT = D2_RS + 128;
static_assert(D2_OUT + 3 * 16 * 132 * 4 <= LDS_BYTES - 64 && D2_OUT % 16 == 0, "dma2 / dma4 scan LDS");
template <int N> __device__ __forceinline__ float dpp_bcast(float v) { return __int_as_float(__builtin_amdgcn_update_dpp(0, __float_as_int(v), 0x150 + N, 0xF, 0xF, true)); }
template <int MT> __device__ __forceinline__ void scan_decay(f32x4& s, float d0, float d1) {
    s[0] = s[0] * dpp_bcast<2 * MT>(d0); s[1] = s[1] * dpp_bcast<2 * MT>(d1); s[2] = s[2] * dpp_bcast<2 * MT + 1>(d0); s[3] = s[3] * dpp_bcast<2 * MT + 1>(d1);
}
__device__ __forceinline__ void hgrn_scan_dma2(Frame& F, int ch0, int nsteps, int h, int mrow0, float* Sout, unsigned* rdy, unsigned need, int rdy_step) {
    const int lane = F.lane, l15 = lane & 15, g4 = lane >> 4, e0 = 16 * F.wave, w = F.wave;
    const unsigned char* ws = F.ws;
    bf16_t* MIX = (bf16_t*)(F.ws + WS_MIX);
    const float onw = F.in[I_ONORM][e0 + l15];
    LAS float* RED = (LAS float*)(F.lds + D2_RED);
    LAS float* RS = (LAS float*)(F.lds + D2_RS);
    LAS float* ST = (LAS float*)(F.lds + DS_ST);
    LAS bf16_t* OUTB = (LAS bf16_t*)(F.lds + D2_OUT);
    const int wq = w & 3;
    const unsigned char* sq = ws + WS_QIN + (((size_t)ch0 * 16 + 4 * wq) * 1024 + h * 128) * 2 + lane * 4;
    const unsigned char* sk = ws + WS_KT + (((size_t)ch0 * 1024 + h * 128) * 16 + (wq * 64 + lane) * 8) * 2;
    const unsigned char* sv = ws + WS_VT + (((size_t)ch0 * 1024 + h * 128) * 16 + (wq * 64 + lane) * 8) * 2;
    const unsigned char* sg = ws + WS_GATE + (((size_t)mrow0 + 4 * wq) * 1024 + h * 128) * 2 + lane * 4;
    const unsigned char* sc = lane < 32 ? ws + WS_PSC + (((size_t)ch0 * 8 + h) * 256 + lane * 8) * 2 : ws + WS_DEC + ((size_t)ch0 * 1024 + h * 128 + (lane - 32) * 4) * 4;
    const unsigned ring0 = (unsigned)(uintptr_t)F.lds;
#define D2_ISSUE(step, slot) do { if (w < 4) { const unsigned so_ = ring0 + (unsigned)__builtin_amdgcn_readfirstlane((int)((slot) * DS_SLOT)); const size_t go_ = (size_t)(step) * 32768; \
        _Pragma("unroll") for (int r_ = 0; r_ < 4; ++r_) glds4(sq + go_ + r_ * 2048, so_ + SC_QI + (4 * wq + r_) * DS_QSB); \
        glds16(sk + go_, so_ + SC_KT + wq * 1024); glds16(sv + go_, so_ + SC_VT + wq * 1024); \
        _Pragma("unroll") for (int r_ = 0; r_ < 4; ++r_) glds4(sg + go_ + r_ * 2048, so_ + SC_GATE + (4 * wq + r_) * DS_QSB); \
        if (w == 0) glds16(sc + (size_t)(step) * 4096, so_ + SC_P); } } while (0)
    __syncthreads();
    f32x4 S[8];
#pragma unroll
    for (int mt = 0; mt < 8; ++mt) S[mt] = (f32x4){0.f, 0.f, 0.f, 0.f};
    for (int s = 0; s < DS_R - 1 && s < nsteps; ++s) D2_ISSUE(s, s);
    f32x4 o_p1 = {0.f, 0.f, 0.f, 0.f}, o_p2 = o_p1, gate_p1 = o_p1, gate_p2 = o_p1;
    int slot = 0;
#pragma unroll 1
    for (int n = 0; n <= nsteps + 2; ++n) {
        if (w < 4) {
            if (n >= DS_R && n + DS_R <= nsteps + 1) { if (w == 0) asm volatile("s_waitcnt vmcnt(44)" ::: "memory"); else asm volatile("s_waitcnt vmcnt(40)" ::: "memory"); }
            else asm volatile("s_waitcnt vmcnt(0)" ::: "memory");
        }
        static_assert(DS_R == 6, "the counted waits above are (DS_R - 2) * 11 and (DS_R - 2) * 10");
        DS_BAR();
        if (rdy && n - 1 + DS_R == rdy_step) flag_wait(rdy, need);
        if (n - 1 + DS_R < nsteps) { const int ps = slot == 0 ? DS_R - 1 : slot - 1; D2_ISSUE(n - 1 + DS_R, ps); }
        const int buf = n & 1;
        f32x4 o = {0.f, 0.f, 0.f, 0.f}, gate = {0.f, 0.f, 0.f, 0.f};
        if (n < nsteps) {
            const LAS unsigned char* B = F.lds + slot * DS_SLOT;
            const bf16x4 vt = *(const LAS bf16x4*)(B + SC_VT + ((e0 + l15) * 16 + 4 * g4) * 2);
            const bf16x4 pa = *(const LAS bf16x4*)(B + SC_P + (l15 * 16 + 4 * g4) * 2);
            const f32x2 dcp = *(const LAS f32x2*)(B + SC_DEC + (16 * (l15 >> 1) + 4 * g4 + 2 * (l15 & 1)) * 4);
            const f32x4 zz = {0.f, 0.f, 0.f, 0.f};
            f32x4 oq[4];
            const f32x4 op = __builtin_amdgcn_mfma_f32_16x16x16bf16_1k(pa, vt, zz, 0, 0, 0);
#pragma unroll
            for (int kk = 0; kk < 4; ++kk) {
                const bf16x4 q0 = *(const LAS bf16x4*)(B + SC_QI + l15 * DS_QSB + (32 * kk + 4 * g4) * 2);
                const bf16x4 q1 = *(const LAS bf16x4*)(B + SC_QI + l15 * DS_QSB + (32 * kk + 16 + 4 * g4) * 2);
                const bf16x8 qa = {q0[0], q0[1], q0[2], q0[3], q1[0], q1[1], q1[2], q1[3]};
                const u32x4 sb8 = pack8(S[2 * kk], S[2 * kk + 1]);
                oq[kk] = __builtin_amdgcn_mfma_f32_16x16x32_bf16(qa, __builtin_bit_cast(bf16x8, sb8), zz, 0, 0, 0);
            }
            bf16x4 kt[8];
#pragma unroll
            for (int mt = 0; mt < 8; ++mt) kt[mt] = *(const LAS bf16x4*)(B + SC_KT + ((16 * mt + l15) * 16 + 4 * g4) * 2);
#pragma unroll
            for (int mt = 0; mt < 8; ++mt) S[mt] = __builtin_amdgcn_mfma_f32_16x16x16bf16_1k(kt[mt], vt, S[mt], 0, 0, 0);
            scan_decay<0>(S[0], dcp[0], dcp[1]); scan_decay<1>(S[1], dcp[0], dcp[1]); scan_decay<2>(S[2], dcp[0], dcp[1]); scan_decay<3>(S[3], dcp[0], dcp[1]);
            scan_decay<4>(S[4], dcp[0], dcp[1]); scan_decay<5>(S[5], dcp[0], dcp[1]); scan_decay<6>(S[6], dcp[0], dcp[1]); scan_decay<7>(S[7], dcp[0], dcp[1]);
            o = ((oq[0] + oq[2]) + op) + (oq[1] + oq[3]);
#pragma unroll
            for (int r = 0; r < 4; ++r) {
                const int t = 4 * g4 + r;
                gate[r] = bf2f(*(const LAS unsigned short*)(B + SC_GATE + t * DS_QSB + (e0 + l15) * 2));
                const float ss = row16_sum(o[r] * o[r]);
                if (l15 == 0) RED[(buf * 16 + t) * 8 + w] = ss;
            }
        }
        if (n > 0 && n <= nsteps) {
            const int i = lane & 15, t = 2 * w + (i >> 3);
            float v = RED[((buf ^ 1) * 16 + t) * 8 + (i & 7)];
            v += dpp_mov<0xB1>(v); v += dpp_mov<0x4E>(v); v += dpp_mov<0x141>(v);
            const float rs = __builtin_amdgcn_rsqf(v * (1.0f / 128.0f) + RMS_EPS);
            if (lane < 16 && (lane & 7) == 0) RS[(buf ^ 1) * 16 + t] = rs;
        }
        if (n > 1 && n <= nsteps + 1) {
            const f32x4 rs4 = *(const LAS f32x4*)(RS + buf * 16 + 4 * g4);
#pragma unroll
            for (int r = 0; r < 4; ++r) OUTB[(buf * 16 + 4 * g4 + r) * 128 + e0 + l15] = f2bf(o_p2[r] * rs4[r] * onw * gate_p2[r]);
        }
        if (n > 2 && w >= 4) {
            const int i = (w - 4) * 64 + lane, t = i >> 4, p = i & 15;
            *(u32x4*)(MIX + (size_t)(mrow0 + 16 * (n - 3) + t) * DM + h * 128 + p * 8) = *(const LAS u32x4*)(OUTB + ((buf ^ 1) * 16 + t) * 128 + p * 8);
        }
        o_p2 = o_p1; gate_p2 = gate_p1; o_p1 = o; gate_p1 = gate;
        slot = slot == DS_R - 1 ? 0 : slot + 1;
    }
    asm volatile("s_waitcnt vmcnt(0)" ::: "memory");
    __syncthreads();
#pragma unroll
    for (int mt = 0; mt < 8; ++mt)
#pragma unroll
        for (int r = 0; r < 4; ++r) ST[(16 * mt + 4 * g4 + r) * DS_STS + e0 + l15] = S[mt][r];
    __syncthreads();
#pragma unroll
    for (int i = 0; i < 8; ++i) { const int idx = F.tid + 512 * i, c = idx >> 5, e4 = idx & 31; *(f32x4*)(Sout + (size_t)c * 128 + e4 * 4) = *(const LAS f32x4*)(ST + c * DS_STS + e4 * 4); }
#undef D2_ISSUE
}

__device__ __forceinline__ void hgrn_scan_dma4(Frame& F, int ch0, int nsteps, int h, int mrow0, float* Sout, unsigned* rdy, unsigned need, int rdy_step) {
    const int lane = F.lane, l15 = lane & 15, g4 = lane >> 4, e0 = 16 * F.wave, w = F.wave;
    const unsigned char* ws = F.ws;
    bf16_t* MIX = (bf16_t*)(F.ws + WS_MIX);
    const float onw = F.in[I_ONORM][e0 + l15];
    LAS float* RED = (LAS float*)(F.lds + D2_RED);
    LAS float* RS = (LAS float*)(F.lds + D2_RS);
    LAS float* ST = (LAS float*)(F.lds + DS_ST);
    LAS float* UB = (LAS float*)(F.lds + D2_OUT);
    const int wq = w & 3;
    const unsigned char* sq = ws + WS_QIN + (((size_t)ch0 * 16 + 4 * wq) * 1024 + h * 128) * 2 + lane * 4;
    const unsigned char* sk = ws + WS_KT + (((size_t)ch0 * 1024 + h * 128) * 16 + (wq * 64 + lane) * 8) * 2;
    const unsigned char* sv = ws + WS_VT + (((size_t)ch0 * 1024 + h * 128) * 16 + (wq * 64 + lane) * 8) * 2;
    const unsigned char* sg = ws + WS_GATE + (((size_t)mrow0 + 4 * wq) * 1024 + h * 128) * 2 + lane * 4;
    const unsigned char* sc = lane < 32 ? ws + WS_PSC + (((size_t)ch0 * 8 + h) * 256 + lane * 8) * 2 : ws + WS_DEC + ((size_t)ch0 * 1024 + h * 128 + (lane - 32) * 4) * 4;
    const unsigned ring0 = (unsigned)(uintptr_t)F.lds;
#define D4_ISSUE(step, slot) do { if (w < 4) { const unsigned so_ = ring0 + (unsigned)__builtin_amdgcn_readfirstlane((int)((slot) * DS_SLOT)); const size_t go_ = (size_t)(step) * 32768; \
        _Pragma("unroll") for (int r_ = 0; r_ < 4; ++r_) glds4(sq + go_ + r_ * 2048, so_ + SC_QI + (4 * wq + r_) * DS_QSB); \
        glds16(sk + go_, so_ + SC_KT + wq * 1024); glds16(sv + go_, so_ + SC_VT + wq * 1024); \
        _Pragma("unroll") for (int r_ = 0; r_ < 4; ++r_) glds4(sg + go_ + r_ * 2048, so_ + SC_GATE + (4 * wq + r_) * DS_QSB); \
        if (w == 0) glds16(sc + (size_t)(step) * 4096, so_ + SC_P); } } while (0)
    __syncthreads();
    f32x4 S[8];
#pragma unroll
    for (int mt = 0; mt < 8; ++mt) S[mt] = (f32x4){0.f, 0.f, 0.f, 0.f};
    for (int s = 0; s < DS_R - 1 && s < nsteps; ++s) D4_ISSUE(s, s);
    int ub = 0;
    int slot = 0;
#pragma unroll 1
    for (int n = 0; n <= nsteps + 1; ++n) {
        if (w < 4) {
            if (n >= DS_R && n + DS_R <= nsteps + 1) { if (w == 0) asm volatile("s_waitcnt vmcnt(44)" ::: "memory"); else asm volatile("s_waitcnt vmcnt(40)" ::: "memory"); }
            else asm volatile("s_waitcnt vmcnt(0)" ::: "memory");
        }
        static_assert(DS_R == 6, "the counted waits above are (DS_R - 2) * 11 and (DS_R - 2) * 10");
        DS_BAR();
        if (rdy && n - 1 + DS_R == rdy_step) flag_wait(rdy, need);
        if (n - 1 + DS_R < nsteps) { const int ps = slot == 0 ? DS_R - 1 : slot - 1; D4_ISSUE(n - 1 + DS_R, ps); }
        const int buf = n & 1;
        if (n < nsteps) {
            const LAS unsigned char* B = F.lds + slot * DS_SLOT;
            const bf16x4 vt = *(const LAS bf16x4*)(B + SC_VT + ((e0 + l15) * 16 + 4 * g4) * 2);
            const bf16x4 pa = *(const LAS bf16x4*)(B + SC_P + (l15 * 16 + 4 * g4) * 2);
            const f32x2 dcp = *(const LAS f32x2*)(B + SC_DEC + (16 * (l15 >> 1) + 4 * g4 + 2 * (l15 & 1)) * 4);
            const f32x4 zz = {0.f, 0.f, 0.f, 0.f};
            f32x4 oq[4];
            const f32x4 op = __builtin_amdgcn_mfma_f32_16x16x16bf16_1k(pa, vt, zz, 0, 0, 0);
#pragma unroll
            for (int kk = 0; kk < 4; ++kk) {
                const bf16x4 q0 = *(const LAS bf16x4*)(B + SC_QI + l15 * DS_QSB + (32 * kk + 4 * g4) * 2);
                const bf16x4 q1 = *(const LAS bf16x4*)(B + SC_QI + l15 * DS_QSB + (32 * kk + 16 + 4 * g4) * 2);
                const bf16x8 qa = {q0[0], q0[1], q0[2], q0[3], q1[0], q1[1], q1[2], q1[3]};
                const u32x4 sb8 = pack8(S[2 * kk], S[2 * kk + 1]);
                oq[kk] = __builtin_amdgcn_mfma_f32_16x16x32_bf16(qa, __builtin_bit_cast(bf16x8, sb8), zz, 0, 0, 0);
            }
            bf16x4 kt[8];
#pragma unroll
            for (int mt = 0; mt < 8; ++mt) kt[mt] = *(const LAS bf16x4*)(B + SC_KT + ((16 * mt + l15) * 16 + 4 * g4) * 2);
#pragma unroll
            for (int mt = 0; mt < 8; ++mt) S[mt] = __builtin_amdgcn_mfma_f32_16x16x16bf16_1k(kt[mt], vt, S[mt], 0, 0, 0);
#ifdef HY_DCLDS
#pragma unroll
            for (int mt = 0; mt < 8; ++mt) { const f32x4 dc4 = *(const LAS f32x4*)(B + SC_DEC + (16 * mt + 4 * g4) * 4); S[mt] = S[mt] * dc4; }
#else
            scan_decay<0>(S[0], dcp[0], dcp[1]); scan_decay<1>(S[1], dcp[0], dcp[1]); scan_decay<2>(S[2], dcp[0], dcp[1]); scan_decay<3>(S[3], dcp[0], dcp[1]);
            scan_decay<4>(S[4], dcp[0], dcp[1]); scan_decay<5>(S[5], dcp[0], dcp[1]); scan_decay<6>(S[6], dcp[0], dcp[1]); scan_decay<7>(S[7], dcp[0], dcp[1]);
#endif
            const f32x4 o = ((oq[0] + oq[2]) + op) + (oq[1] + oq[3]);
#pragma unroll
            for (int r = 0; r < 4; ++r) {
                const int t = 4 * g4 + r;
                const float gt = bf2f(*(const LAS unsigned short*)(B + SC_GATE + t * DS_QSB + (e0 + l15) * 2));
                UB[(ub * 16 + t) * 132 + e0 + l15] = o[r] * gt * onw;
                const float ss = row16_sum(o[r] * o[r]);
                if (l15 == 0) RED[(buf * 16 + t) * 8 + w] = ss;
            }
        }
        if (n > 0 && n <= nsteps) {
            const int i = lane & 15, t = 2 * w + (i >> 3);
            float v = RED[((buf ^ 1) * 16 + t) * 8 + (i & 7)];
            v += dpp_mov<0xB1>(v); v += dpp_mov<0x4E>(v); v += dpp_mov<0x141>(v);
            const float rs = __builtin_amdgcn_rsqf(v * (1.0f / 128.0f) + RMS_EPS);
            if (lane < 16 && (lane & 7) == 0) RS[(buf ^ 1) * 16 + t] = rs;
        }
        if (n > 1 && w >= 4) {
            const int i = (w - 4) * 64 + lane, t = i >> 4, p = i & 15, ub2 = ub == 0 ? 1 : ub - 2 + (ub == 1 ? 3 : 0);
            const float rs = RS[buf * 16 + t];
            const LAS float* ur = UB + (ub2 * 16 + t) * 132 + p * 8;
            const f32x4 u0 = *(const LAS f32x4*)ur, u1 = *(const LAS f32x4*)(ur + 4);
            *(u32x4*)(MIX + (size_t)(mrow0 + 16 * (n - 2) + t) * DM + h * 128 + p * 8) = pack8(u0 * rs, u1 * rs);
        }
        ub = ub == 2 ? 0 : ub + 1;
        slot = slot == DS_R - 1 ? 0 : slot + 1;
    }
    asm volatile("s_waitcnt vmcnt(0)" ::: "memory");
    __syncthreads();
#pragma unroll
    for (int mt = 0; mt < 8; ++mt)
#pragma unroll
        for (int r = 0; r < 4; ++r) ST[(16 * mt + 4 * g4 + r) * DS_STS + e0 + l15] = S[mt][r];
    __syncthreads();
#pragma unroll
    for (int i = 0; i < 8; ++i) { const int idx = F.tid + 512 * i, c = idx >> 5, e4 = idx & 31; *(f32x4*)(Sout + (size_t)c * 128 + e4 * 4) = *(const LAS f32x4*)(ST + c * DS_STS + e4 * 4); }
#undef D4_ISSUE
}

constexpr int D5_RED = DS_R * DS_SLOT;
__device__ __forceinline__ void hgrn_scan_dma5(Frame& F, int ch0, int nsteps, int h, int mrow0, float* Sout) {
    const int lane = F.lane, l15 = lane & 15, g4 = lane >> 4, w = F.wave, wq = w & 3, eb = 32 * wq;
    const bool cw = w < 4;
    const unsigned char* ws = F.ws;
    bf16_t* MIX = (bf16_t*)(F.ws + WS_MIX);
    const float onw0 = F.in[I_ONORM][eb + l15], onw1 = F.in[I_ONORM][eb + 16 + l15];
    LAS float* RED = (LAS float*)(F.lds + D5_RED);
    LAS float* RS = (LAS float*)(F.lds + D2_RS);
    LAS float* ST = (LAS float*)(F.lds + DS_ST);
    LAS float* UB = (LAS float*)(F.lds + D2_OUT);
    const unsigned char* sq = ws + WS_QIN + (((size_t)ch0 * 16 + 4 * wq) * 1024 + h * 128) * 2 + lane * 4;
    const unsigned char* sk = ws + WS_KT + (((size_t)ch0 * 1024 + h * 128) * 16 + (wq * 64 + lane) * 8) * 2;
    const unsigned char* sv = ws + WS_VT + (((size_t)ch0 * 1024 + h * 128) * 16 + (wq * 64 + lane) * 8) * 2;
    const unsigned char* sg = ws + WS_GATE + (((size_t)mrow0 + 4 * wq) * 1024 + h * 128) * 2 + lane * 4;
    const unsigned char* sc = lane < 32 ? ws + WS_PSC + (((size_t)ch0 * 8 + h) * 256 + lane * 8) * 2 : ws + WS_DEC + ((size_t)ch0 * 1024 + h * 128 + (lane - 32) * 4) * 4;
    const unsigned ring0 = (unsigned)(uintptr_t)F.lds;
#define D5_ISSUE(step, slot) do { if (cw) { const unsigned so_ = ring0 + (unsigned)__builtin_amdgcn_readfirstlane((int)((slot) * DS_SLOT)); const size_t go_ = (size_t)(step) * 32768; \
        _Pragma("unroll") for (int r_ = 0; r_ < 4; ++r_) glds4(sq + go_ + r_ * 2048, so_ + SC_QI + (4 * wq + r_) * DS_QSB); \
        glds16(sk + go_, so_ + SC_KT + wq * 1024); glds16(sv + go_, so_ + SC_VT + wq * 1024); \
        _Pragma("unroll") for (int r_ = 0; r_ < 4; ++r_) glds4(sg + go_ + r_ * 2048, so_ + SC_GATE + (4 * wq + r_) * DS_QSB); \
        if (w == 0) glds16(sc + (size_t)(step) * 4096, so_ + SC_P); } } while (0)
    __syncthreads();
    f32x4 S0[8], S1[8];
#pragma unroll
    for (int mt = 0; mt < 8; ++mt) { S0[mt] = (f32x4){0.f, 0.f, 0.f, 0.f}; S1[mt] = S0[mt]; }
    for (int s = 0; s < DS_R - 1 && s < nsteps; ++s) D5_ISSUE(s, s);
    int ub = 0;
    int slot = 0;
#pragma unroll 1
    for (int n = 0; n <= nsteps + 1; ++n) {
        if (cw) {
            if (n >= DS_R && n + DS_R <= nsteps + 1) { if (w == 0) asm volatile("s_waitcnt vmcnt(44)" ::: "memory"); else asm volatile("s_waitcnt vmcnt(40)" ::: "memory"); }
            else asm volatile("s_waitcnt vmcnt(0)" ::: "memory");
        }
        static_assert(DS_R == 6, "the counted waits above are (DS_R - 2) * 11 and (DS_R - 2) * 10");
        DS_BAR();
        if (n - 1 + DS_R < nsteps) { const int ps = slot == 0 ? DS_R - 1 : slot - 1; D5_ISSUE(n - 1 + DS_R, ps); }
        const int buf = n & 1;
        if (cw && n < nsteps) {
            const LAS unsigned char* B = F.lds + slot * DS_SLOT;
            const bf16x4 vt0 = *(const LAS bf16x4*)(B + SC_VT + ((eb + l15) * 16 + 4 * g4) * 2), vt1 = *(const LAS bf16x4*)(B + SC_VT + ((eb + 16 + l15) * 16 + 4 * g4) * 2);
            const bf16x4 pa = *(const LAS bf16x4*)(B + SC_P + (l15 * 16 + 4 * g4) * 2);
            const f32x2 dcp = *(const LAS f32x2*)(B + SC_DEC + (16 * (l15 >> 1) + 4 * g4 + 2 * (l15 & 1)) * 4);
            const f32x4 zz = {0.f, 0.f, 0.f, 0.f};
            f32x4 oq0[4], oq1[4];
            const f32x4 op0 = __builtin_amdgcn_mfma_f32_16x16x16bf16_1k(pa, vt0, zz, 0, 0, 0), op1 = __builtin_amdgcn_mfma_f32_16x16x16bf16_1k(pa, vt1, zz, 0, 0, 0);
#pragma unroll
            for (int kk = 0; kk < 4; ++kk) {
                const bf16x4 q0 = *(const LAS bf16x4*)(B + SC_QI + l15 * DS_QSB + (32 * kk + 4 * g4) * 2);
                const bf16x4 q1 = *(const LAS bf16x4*)(B + SC_QI + l15 * DS_QSB + (32 * kk + 16 + 4 * g4) * 2);
                const bf16x8 qa = {q0[0], q0[1], q0[2], q0[3], q1[0], q1[1], q1[2], q1[3]};
                const u32x4 sa = pack8(S0[2 * kk], S0[2 * kk + 1]), sb = pack8(S1[2 * kk], S1[2 * kk + 1]);
                oq0[kk] = __builtin_amdgcn_mfma_f32_16x16x32_bf16(qa, __builtin_bit_cast(bf16x8, sa), zz, 0, 0, 0);
                oq1[kk] = __builtin_amdgcn_mfma_f32_16x16x32_bf16(qa, __builtin_bit_cast(bf16x8, sb), zz, 0, 0, 0);
            }
#pragma unroll
            for (int mt = 0; mt < 8; ++mt) {
                const bf16x4 kt = *(const LAS bf16x4*)(B + SC_KT + ((16 * mt + l15) * 16 + 4 * g4) * 2);
                S0[mt] = __builtin_amdgcn_mfma_f32_16x16x16bf16_1k(kt, vt0, S0[mt], 0, 0, 0);
                S1[mt] = __builtin_amdgcn_mfma_f32_16x16x16bf16_1k(kt, vt1, S1[mt], 0, 0, 0);
            }
            scan_decay<0>(S0[0], dcp[0], dcp[1]); scan_decay<1>(S0[1], dcp[0], dcp[1]); scan_decay<2>(S0[2], dcp[0], dcp[1]); scan_decay<3>(S0[3], dcp[0], dcp[1]);
            scan_decay<4>(S0[4], dcp[0], dcp[1]); scan_decay<5>(S0[5], dcp[0], dcp[1]); scan_decay<6>(S0[6], dcp[0], dcp[1]); scan_decay<7>(S0[7], dcp[0], dcp[1]);
            scan_decay<0>(S1[0], dcp[0], dcp[1]); scan_decay<1>(S1[1], dcp[0], dcp[1]); scan_decay<2>(S1[2], dcp[0], dcp[1]); scan_decay<3>(S1[3], dcp[0], dcp[1]);
            scan_decay<4>(S1[4], dcp[0], dcp[1]); scan_decay<5>(S1[5], dcp[0], dcp[1]); scan_decay<6>(S1[6], dcp[0], dcp[1]); scan_decay<7>(S1[7], dcp[0], dcp[1]);
            const f32x4 o0 = ((oq0[0] + oq0[2]) + op0) + (oq0[1] + oq0[3]), o1 = ((oq1[0] + oq1[2]) + op1) + (oq1[1] + oq1[3]);
#pragma unroll
            for (int r = 0; r < 4; ++r) {
                const int t = 4 * g4 + r;
                const float g0 = bf2f(*(const LAS unsigned short*)(B + SC_GATE + t * DS_QSB + (eb + l15) * 2)), g1 = bf2f(*(const LAS unsigned short*)(B + SC_GATE + t * DS_QSB + (eb + 16 + l15) * 2));
                UB[(ub * 16 + t) * 132 + eb + l15] = o0[r] * g0 * onw0; UB[(ub * 16 + t) * 132 + eb + 16 + l15] = o1[r] * g1 * onw1;
                const float ss = row16_sum(o0[r] * o0[r] + o1[r] * o1[r]);
                if (l15 == 0) RED[(buf * 16 + t) * 4 + w] = ss;
            }
        }
        if (!cw && n > 0 && n <= nsteps) {
            const int i = lane & 15, t = 4 * (w - 4) + (i >> 2);
            float v = RED[((buf ^ 1) * 16 + t) * 4 + (i & 3)];
            v += dpp_mov<0xB1>(v); v += dpp_mov<0x4E>(v);
            const float rs = __builtin_amdgcn_rsqf(v * (1.0f / 128.0f) + RMS_EPS);
            if (lane < 16 && (lane & 3) == 0) RS[(buf ^ 1) * 16 + t] = rs;
        }
        if (!cw && n > 1) {
            const int i = (w - 4) * 64 + lane, t = i >> 4, p = i & 15, ub2 = ub == 0 ? 1 : ub - 2 + (ub == 1 ? 3 : 0);
            const float rs = RS[buf * 16 + t];
            const LAS float* ur = UB + (ub2 * 16 + t) * 132 + p * 8;
            const f32x4 u0 = *(const LAS f32x4*)ur, u1 = *(const LAS f32x4*)(ur + 4);
            *(u32x4*)(MIX + (size_t)(mrow0 + 16 * (n - 2) + t) * DM + h * 128 + p * 8) = pack8(u0 * rs, u1 * rs);
        }
        ub = ub == 2 ? 0 : ub + 1;
        slot = slot == DS_R - 1 ? 0 : slot + 1;
    }
    asm volatile("s_waitcnt vmcnt(0)" ::: "memory");
    __syncthreads();
    if (cw) {
#pragma unroll
        for (int mt = 0; mt < 8; ++mt)
#pragma unroll
            for (int r = 0; r < 4; ++r) { ST[(16 * mt + 4 * g4 + r) * DS_STS + eb + l15] = S0[mt][r]; ST[(16 * mt + 4 * g4 + r) * DS_STS + eb + 16 + l15] = S1[mt][r]; }
    }
    __syncthreads();
#pragma unroll
    for (int i = 0; i < 8; ++i) { const int idx = F.tid + 512 * i, c = idx >> 5, e4 = idx & 31; *(f32x4*)(Sout + (size_t)c * 128 + e4 * 4) = *(const LAS f32x4*)(ST + c * DS_STS + e4 * 4); }
#undef D5_ISSUE
}

__device__ __forceinline__ void hgrn_scan_dma6(Frame& F, int ch0, int nsteps, int h, int mrow0, float* Sout) {
    const int lane = F.lane, l15 = lane & 15, g4 = lane >> 4, w = F.wave, wq = w & 3, eb = 32 * wq;
    const bool cw = w < 4;
    const unsigned char* ws = F.ws;
    bf16_t* MIX = (bf16_t*)(F.ws + WS_MIX);
    const float onw0 = F.in[I_ONORM][eb + l15], onw1 = F.in[I_ONORM][eb + 16 + l15];
    LAS float* RED = (LAS float*)(F.lds + D5_RED);
    LAS float* RS = (LAS float*)(F.lds + D2_RS);
    LAS float* ST = (LAS float*)(F.lds + DS_ST);
    LAS float* UB = (LAS float*)(F.lds + D2_OUT);
    const int trow = 4 * wq + (lane >> 4), lch = (lane & 15) ^ trow;
    const unsigned char* sq = ws + WS_QIN + (((size_t)ch0 * 16 + trow) * 1024 + h * 128) * 2 + lch * 16;
    const unsigned char* sk = ws + WS_KT + (((size_t)ch0 * 1024 + h * 128) * 16 + (wq * 64 + lane) * 8) * 2;
    const unsigned char* sv = ws + WS_VT + (((size_t)ch0 * 1024 + h * 128) * 16 + (wq * 64 + lane) * 8) * 2;
    const unsigned char* sg = ws + WS_GATE + (((size_t)mrow0 + trow) * 1024 + h * 128) * 2 + lch * 16;
    const unsigned char* sc = lane < 32 ? ws + WS_PSC + (((size_t)ch0 * 8 + h) * 256 + lane * 8) * 2 : ws + WS_DEC + ((size_t)ch0 * 1024 + h * 128 + (lane - 32) * 4) * 4;
#define D6_DMA16(src, off) __builtin_amdgcn_global_load_lds((const unsigned*)(src), (LAS unsigned*)(F.lds + (off)), 16, 0, 0)
#define D6_ISSUE(step, slot) do { if (cw) { const int so_ = __builtin_amdgcn_readfirstlane((int)((slot) * DS_SLOT)) + wq * 1024; const size_t go_ = (size_t)(step) * 32768; \
        D6_DMA16(sq + go_, so_ + SC_QI); D6_DMA16(sk + go_, so_ + SC_KT); D6_DMA16(sv + go_, so_ + SC_VT); D6_DMA16(sg + go_, so_ + SC_GATE); \
        if (w == 0) D6_DMA16(sc + (size_t)(step) * 4096, so_ + SC_P); } } while (0)
    __syncthreads();
    f32x4 S0[8], S1[8];
#pragma unroll
    for (int mt = 0; mt < 8; ++mt) { S0[mt] = (f32x4){0.f, 0.f, 0.f, 0.f}; S1[mt] = S0[mt]; }
    for (int s = 0; s < DS_R - 1 && s < nsteps; ++s) D6_ISSUE(s, s);
    int ub = 0;
    int slot = 0;
#pragma unroll 1
    for (int n = 0; n <= nsteps + 1; ++n) {
        if (cw) {
            if (n >= DS_R && n + DS_R <= nsteps + 1) { if (w == 0) asm volatile("s_waitcnt vmcnt(20)" ::: "memory"); else asm volatile("s_waitcnt vmcnt(16)" ::: "memory"); }
            else asm volatile("s_waitcnt vmcnt(0)" ::: "memory");
        }
        static_assert(DS_R == 6, "the counted waits above are (DS_R - 2) * 5 and (DS_R - 2) * 4");
        DS_BAR();
        if (n - 1 + DS_R < nsteps) { const int ps = slot == 0 ? DS_R - 1 : slot - 1; D6_ISSUE(n - 1 + DS_R, ps); }
        const int buf = n & 1;
        if (cw && n < nsteps) {
            const LAS unsigned char* B = F.lds + slot * DS_SLOT;
            const bf16x4 vt0 = *(const LAS bf16x4*)(B + SC_VT + ((eb + l15) * 16 + 4 * g4) * 2), vt1 = *(const LAS bf16x4*)(B + SC_VT + ((eb + 16 + l15) * 16 + 4 * g4) * 2);
            const bf16x4 pa = *(const LAS bf16x4*)(B + SC_P + (l15 * 16 + 4 * g4) * 2);
            const f32x2 dcp = *(const LAS f32x2*)(B + SC_DEC + (16 * (l15 >> 1) + 4 * g4 + 2 * (l15 & 1)) * 4);
            const f32x4 zz = {0.f, 0.f, 0.f, 0.f};
            f32x4 oq0[4], oq1[4];
            const f32x4 op0 = __builtin_amdgcn_mfma_f32_16x16x16bf16_1k(pa, vt0, zz, 0, 0, 0), op1 = __builtin_amdgcn_mfma_f32_16x16x16bf16_1k(pa, vt1, zz, 0, 0, 0);
#pragma unroll
            for (int kk = 0; kk < 4; ++kk) {
                const bf16x4 q0 = *(const LAS bf16x4*)(B + SC_QI + l15 * 256 + (((4 * kk + (g4 >> 1)) ^ l15) << 4) + (g4 & 1) * 8);
                const bf16x4 q1 = *(const LAS bf16x4*)(B + SC_QI + l15 * 256 + (((4 * kk + 2 + (g4 >> 1)) ^ l15) << 4) + (g4 & 1) * 8);
                const bf16x8 qa = {q0[0], q0[1], q0[2], q0[3], q1[0], q1[1], q1[2], q1[3]};
                const u32x4 sa = pack8(S0[2 * kk], S0[2 * kk + 1]), sb = pack8(S1[2 * kk], S1[2 * kk + 1]);
                oq0[kk] = __builtin_amdgcn_mfma_f32_16x16x32_bf16(qa, __builtin_bit_cast(bf16x8, sa), zz, 0, 0, 0);
                oq1[kk] = __builtin_amdgcn_mfma_f32_16x16x32_bf16(qa, __builtin_bit_cast(bf16x8, sb), zz, 0, 0, 0);
            }
#pragma unroll
            for (int mt = 0; mt < 8; ++mt) {
                const bf16x4 kt = *(const LAS bf16x4*)(B + SC_KT + ((16 * mt + l15) * 16 + 4 * g4) * 2);
                S0[mt] = __builtin_amdgcn_mfma_f32_16x16x16bf16_1k(kt, vt0, S0[mt], 0, 0, 0);
                S1[mt] = __builtin_amdgcn_mfma_f32_16x16x16bf16_1k(kt, vt1, S1[mt], 0, 0, 0);
            }
            scan_decay<0>(S0[0], dcp[0], dcp[1]); scan_decay<1>(S0[1], dcp[0], dcp[1]); scan_decay<2>(S0[2], dcp[0], dcp[1]); scan_decay<3>(S0[3], dcp[0], dcp[1]);
            scan_decay<4>(S0[4], dcp[0], dcp[1]); scan_decay<5>(S0[5], dcp[0], dcp[1]); scan_decay<6>(S0[6], dcp[0], dcp[1]); scan_decay<7>(S0[7], dcp[0], dcp[1]);
            scan_decay<0>(S1[0], dcp[0], dcp[1]); scan_decay<1>(S1[1], dcp[0], dcp[1]); scan_decay<2>(S1[2], dcp[0], dcp[1]); scan_decay<3>(S1[3], dcp[0], dcp[1]);
            scan_decay<4>(S1[4], dcp[0], dcp[1]); scan_decay<5>(S1[5], dcp[0], dcp[1]); scan_decay<6>(S1[6], dcp[0], dcp[1]); scan_decay<7>(S1[7], dcp[0], dcp[1]);
            const f32x4 o0 = ((oq0[0] + oq0[2]) + op0) + (oq0[1] + oq0[3]), o1 = ((oq1[0] + oq1[2]) + op1) + (oq1[1] + oq1[3]);
#pragma unroll
            for (int r = 0; r < 4; ++r) {
                const int t = 4 * g4 + r;
                const float g0 = bf2f(*(const LAS unsigned short*)(B + SC_GATE + t * 256 + (((4 * wq + (l15 >> 3)) ^ t) << 4) + (l15 & 7) * 2)), g1 = bf2f(*(const LAS unsigned short*)(B + SC_GATE + t * 256 + (((4 * wq + 2 + (l15 >> 3)) ^ t) << 4) + (l15 & 7) * 2));
                UB[(ub * 16 + t) * 132 + eb + l15] = o0[r] * g0 * onw0; UB[(ub * 16 + t) * 132 + eb + 16 + l15] = o1[r] * g1 * onw1;
                const float ss = row16_sum(o0[r] * o0[r] + o1[r] * o1[r]);
                if (l15 == 0) RED[(buf * 16 + t) * 4 + w] = ss;
            }
        }
        if (!cw && n > 0 && n <= nsteps) {
            const int i = lane & 15, t = 4 * (w - 4) + (i >> 2);
            float v = RED[((buf ^ 1) * 16 + t) * 4 + (i & 3)];
            v += dpp_mov<0xB1>(v); v += dpp_mov<0x4E>(v);
            const float rs = __builtin_amdgcn_rsqf(v * (1.0f / 128.0f) + RMS_EPS);
            if (lane < 16 && (lane & 3) == 0) RS[(buf ^ 1) * 16 + t] = rs;
        }
        if (!cw && n > 1) {
            const int i = (w - 4) * 64 + lane, t = i >> 4, p = i & 15, ub2 = ub == 0 ? 1 : ub - 2 + (ub == 1 ? 3 : 0);
            const float rs = RS[buf * 16 + t];
            const LAS float* ur = UB + (ub2 * 16 + t) * 132 + p * 8;
            const f32x4 u0 = *(const LAS f32x4*)ur, u1 = *(const LAS f32x4*)(ur + 4);
            *(u32x4*)(MIX + (size_t)(mrow0 + 16 * (n - 2) + t) * DM + h * 128 + p * 8) = pack8(u0 * rs, u1 * rs);
        }
        ub = ub == 2 ? 0 : ub + 1;
        slot = slot == DS_R - 1 ? 0 : slot + 1;
    }
    asm volatile("s_waitcnt vmcnt(0)" ::: "memory");
    __syncthreads();
    if (cw) {
#pragma unroll
        for (int mt = 0; mt < 8; ++mt)
#pragma unroll
            for (int r = 0; r < 4; ++r) { ST[(16 * mt + 4 * g4 + r) * DS_STS + eb + l15] = S0[mt][r]; ST[(16 * mt + 4 * g4 + r) * DS_STS + eb + 16 + l15] = S1[mt][r]; }
    }
    __syncthreads();
#pragma unroll
    for (int i = 0; i < 8; ++i) { const int idx = F.tid + 512 * i, c = idx >> 5, e4 = idx & 31; *(f32x4*)(Sout + (size_t)c * 128 + e4 * 4) = *(const LAS f32x4*)(ST + c * DS_STS + e4 * 4); }
#undef D6_ISSUE
#undef D6_DMA16
}

constexpr int D7_O = DS_R * DS_SLOT;
static_assert(D7_O + 2 * 16 * 132 * 4 <= LDS_BYTES - 64, "dma7 scan LDS");
__device__ __forceinline__ void hgrn_scan_dma7(Frame& F, int ch0, int nsteps, int h, int mrow0, float* Sout) {
    const int lane = F.lane, l15 = lane & 15, g4 = lane >> 4, w = F.wave, wq = w & 3, eb = 32 * wq;
    const bool cw = w < 4;
    const unsigned char* ws = F.ws;
    bf16_t* MIX = (bf16_t*)(F.ws + WS_MIX);
    LAS float* OB = (LAS float*)(F.lds + D7_O);
    LAS float* ST = (LAS float*)(F.lds + DS_ST);
    const int hi_ = wq * 64 + lane, ht = hi_ >> 4, hp = hi_ & 15;
    const f32x4 onwa = *(const f32x4*)(F.in[I_ONORM] + 8 * hp), onwb = *(const f32x4*)(F.in[I_ONORM] + 8 * hp + 4);
    const int trow = 4 * wq + (lane >> 4), lch = (lane & 15) ^ trow;
    const unsigned char* sq = ws + WS_QIN + (((size_t)ch0 * 16 + trow) * 1024 + h * 128) * 2 + lch * 16;
    const unsigned char* sk = ws + WS_KT + (((size_t)ch0 * 1024 + h * 128) * 16 + (wq * 64 + lane) * 8) * 2;
    const unsigned char* sv = ws + WS_VT + (((size_t)ch0 * 1024 + h * 128) * 16 + (wq * 64 + lane) * 8) * 2;
    const unsigned char* sg = ws + WS_GATE + (((size_t)mrow0 + trow) * 1024 + h * 128) * 2 + lch * 16;
    const unsigned char* sc = lane < 32 ? ws + WS_PSC + (((size_t)ch0 * 8 + h) * 256 + lane * 8) * 2 : ws + WS_DEC + ((size_t)ch0 * 1024 + h * 128 + (lane - 32) * 4) * 4;
#define D7_DMA16(src, off) __builtin_amdgcn_global_load_lds((const unsigned*)(src), (LAS unsigned*)(F.lds + (off)), 16, 0, 0)
#define D7_ISSUE(step, slot) do { if (cw) { const int so_ = __builtin_amdgcn_readfirstlane((int)((slot) * DS_SLOT)) + wq * 1024; const size_t go_ = (size_t)(step) * 32768; \
        D7_DMA16(sq + go_, so_ + SC_QI); D7_DMA16(sk + go_, so_ + SC_KT); D7_DMA16(sv + go_, so_ + SC_VT); D7_DMA16(sg + go_, so_ + SC_GATE); \
        if (w == 0) D7_DMA16(sc + (size_t)(step) * 4096, so_ + SC_P); } } while (0)
    __syncthreads();
    f32x4 S0[8], S1[8];
#pragma unroll
    for (int mt = 0; mt < 8; ++mt) { S0[mt] = (f32x4){0.f, 0.f, 0.f, 0.f}; S1[mt] = S0[mt]; }
    for (int s = 0; s < DS_R - 2 && s < nsteps; ++s) D7_ISSUE(s, s);
    int slot = 0, slot4 = DS_R - 2;
#pragma unroll 1
    for (int n = 0; n <= nsteps; ++n) {
        if (cw) {
            if (n + 4 <= nsteps) { if (w == 0) asm volatile("s_waitcnt vmcnt(15)" ::: "memory"); else asm volatile("s_waitcnt vmcnt(12)" ::: "memory"); }
            else asm volatile("s_waitcnt vmcnt(0)" ::: "memory");
        }
        static_assert(DS_R == 6, "ring of six slots, prefetch distance four");
        DS_BAR();
        if (n + 4 < nsteps) D7_ISSUE(n + 4, slot4);
        const int buf = n & 1;
        if (cw) {
            if (n < nsteps) {
                const LAS unsigned char* B = F.lds + slot * DS_SLOT;
                const bf16x4 vt0 = *(const LAS bf16x4*)(B + SC_VT + ((eb + l15) * 16 + 4 * g4) * 2), vt1 = *(const LAS bf16x4*)(B + SC_VT + ((eb + 16 + l15) * 16 + 4 * g4) * 2);
                const bf16x4 pa = *(const LAS bf16x4*)(B + SC_P + (l15 * 16 + 4 * g4) * 2);
                const f32x2 dcp = *(const LAS f32x2*)(B + SC_DEC + (16 * (l15 >> 1) + 4 * g4 + 2 * (l15 & 1)) * 4);
                const f32x4 zz = {0.f, 0.f, 0.f, 0.f};
                f32x4 oq0[4], oq1[4];
                const f32x4 op0 = __builtin_amdgcn_mfma_f32_16x16x16bf16_1k(pa, vt0, zz, 0, 0, 0), op1 = __builtin_amdgcn_mfma_f32_16x16x16bf16_1k(pa, vt1, zz, 0, 0, 0);
#pragma unroll
                for (int kk = 0; kk < 4; ++kk) {
                    const bf16x4 q0 = *(const LAS bf16x4*)(B + SC_QI + l15 * 256 + (((4 * kk + (g4 >> 1)) ^ l15) << 4) + (g4 & 1) * 8);
                    const bf16x4 q1 = *(const LAS bf16x4*)(B + SC_QI + l15 * 256 + (((4 * kk + 2 + (g4 >> 1)) ^ l15) << 4) + (g4 & 1) * 8);
                    const bf16x8 qa = {q0[0], q0[1], q0[2], q0[3], q1[0], q1[1], q1[2], q1[3]};
                    const u32x4 sa = pack8(S0[2 * kk], S0[2 * kk + 1]), sb = pack8(S1[2 * kk], S1[2 * kk + 1]);
                    oq0[kk] = __builtin_amdgcn_mfma_f32_16x16x32_bf16(qa, __builtin_bit_cast(bf16x8, sa), zz, 0, 0, 0);
                    oq1[kk] = __builtin_amdgcn_mfma_f32_16x16x32_bf16(qa, __builtin_bit_cast(bf16x8, sb), zz, 0, 0, 0);
                }
#pragma unroll
                for (int mt = 0; mt < 8; ++mt) {
                    const bf16x4 kt = *(const LAS bf16x4*)(B + SC_KT + ((16 * mt + l15) * 16 + 4 * g4) * 2);
                    S0[mt] = __builtin_amdgcn_mfma_f32_16x16x16bf16_1k(kt, vt0, S0[mt], 0, 0, 0);
                    S1[mt] = __builtin_amdgcn_mfma_f32_16x16x16bf16_1k(kt, vt1, S1[mt], 0, 0, 0);
                }
                scan_decay<0>(S0[0], dcp[0], dcp[1]); scan_decay<1>(S0[1], dcp[0], dcp[1]); scan_decay<2>(S0[2], dcp[0], dcp[1]); scan_decay<3>(S0[3], dcp[0], dcp[1]);
                scan_decay<4>(S0[4], dcp[0], dcp[1]); scan_decay<5>(S0[5], dcp[0], dcp[1]); scan_decay<6>(S0[6], dcp[0], dcp[1]); scan_decay<7>(S0[7], dcp[0], dcp[1]);
                scan_decay<0>(S1[0], dcp[0], dcp[1]); scan_decay<1>(S1[1], dcp[0], dcp[1]); scan_decay<2>(S1[2], dcp[0], dcp[1]); scan_decay<3>(S1[3], dcp[0], dcp[1]);
                scan_decay<4>(S1[4], dcp[0], dcp[1]); scan_decay<5>(S1[5], dcp[0], dcp[1]); scan_decay<6>(S1[6], dcp[0], dcp[1]); scan_decay<7>(S1[7], dcp[0], dcp[1]);
                const f32x4 o0 = ((oq0[0] + oq0[2]) + op0) + (oq0[1] + oq0[3]), o1 = ((oq1[0] + oq1[2]) + op1) + (oq1[1] + oq1[3]);
#pragma unroll
                for (int r = 0; r < 4; ++r) { OB[(buf * 16 + 4 * g4 + r) * 132 + eb + l15] = o0[r]; OB[(buf * 16 + 4 * g4 + r) * 132 + eb + 16 + l15] = o1[r]; }
            }
        } else if (n > 0) {
            const int ps = slot == 0 ? DS_R - 1 : slot - 1;
            const LAS unsigned char* B = F.lds + ps * DS_SLOT;
            const LAS float* orow = OB + ((buf ^ 1) * 16 + ht) * 132 + hp * 8;
            const f32x4 a0 = *(const LAS f32x4*)orow, a1 = *(const LAS f32x4*)(orow + 4);
            const u32x4 gw = *(const LAS u32x4*)(B + SC_GATE + ht * 256 + ((hp ^ ht) << 4));
            float ss = (a0[0] * a0[0] + a0[1] * a0[1]) + (a0[2] * a0[2] + a0[3] * a0[3]) + (a1[0] * a1[0] + a1[1] * a1[1]) + (a1[2] * a1[2] + a1[3] * a1[3]);
            ss = row16_sum(ss);
            const float rs = __builtin_amdgcn_rsqf(ss * (1.0f / 128.0f) + RMS_EPS);
            f32x4 g0, g1;
            g0[0] = __uint_as_float(gw.x << 16); g0[1] = __uint_as_float(gw.x & 0xffff0000u); g0[2] = __uint_as_float(gw.y << 16); g0[3] = __uint_as_float(gw.y & 0xffff0000u);
            g1[0] = __uint_as_float(gw.z << 16); g1[1] = __uint_as_float(gw.z & 0xffff0000u); g1[2] = __uint_as_float(gw.w << 16); g1[3] = __uint_as_float(gw.w & 0xffff0000u);
            *(u32x4*)(MIX + (size_t)(mrow0 + 16 * (n - 1) + ht) * DM + h * 128 + hp * 8) = pack8(a0 * g0 * onwa * rs, a1 * g1 * onwb * rs);
        }
        slot = slot == DS_R - 1 ? 0 : slot + 1; slot4 = slot4 == DS_R - 1 ? 0 : slot4 + 1;
    }
    asm volatile("s_waitcnt vmcnt(0)" ::: "memory");
    __syncthreads();
    if (cw) {
#pragma unroll
        for (int mt = 0; mt < 8; ++mt)
#pragma unroll
            for (int r = 0; r < 4; ++r) { ST[(16 * mt + 4 * g4 + r) * DS_STS + eb + l15] = S0[mt][r]; ST[(16 * mt + 4 * g4 + r) * DS_STS + eb + 16 + l15] = S1[mt][r]; }
    }
    __syncthreads();
#pragma unroll
    for (int i = 0; i < 8; ++i) { const int idx = F.tid + 512 * i, c = idx >> 5, e4 = idx & 31; *(f32x4*)(Sout + (size_t)c * 128 + e4 * 4) = *(const LAS f32x4*)(ST + c * DS_STS + e4 * 4); }
#undef D7_ISSUE
#undef D7_DMA16
}

__device__ __forceinline__ void hgrn_scan_dma3(Frame& F, int ch0, int nsteps, int h, int mrow0, float* Sout, unsigned* rdy, unsigned need, int rdy_step) {
    const int lane = F.lane, l15 = lane & 15, g4 = lane >> 4, e0 = 16 * F.wave, w = F.wave;
    const unsigned char* ws = F.ws;
    bf16_t* MIX = (bf16_t*)(F.ws + WS_MIX);
    const float onw = F.in[I_ONORM][e0 + l15];
    LAS float* RED = (LAS float*)(F.lds + D2_RED);
    LAS float* RS = (LAS float*)(F.lds + D2_RS);
    LAS float* ST = (LAS float*)(F.lds + DS_ST);
    LAS bf16_t* OUTB = (LAS bf16_t*)(F.lds + D2_OUT);
    const int wq = w & 3;
    const int trow = 4 * wq + (lane >> 4), lch = (lane & 15) ^ trow;
    const unsigned char* sq = ws + WS_QIN + (((size_t)ch0 * 16 + trow) * 1024 + h * 128) * 2 + lch * 16;
    const unsigned char* sk = ws + WS_KT + (((size_t)ch0 * 1024 + h * 128) * 16 + (wq * 64 + lane) * 8) * 2;
    const unsigned char* sv = ws + WS_VT + (((size_t)ch0 * 1024 + h * 128) * 16 + (wq * 64 + lane) * 8) * 2;
    const unsigned char* sg = ws + WS_GATE + (((size_t)mrow0 + trow) * 1024 + h * 128) * 2 + lch * 16;
    const unsigned char* sc = lane < 32 ? ws + WS_PSC + (((size_t)ch0 * 8 + h) * 256 + lane * 8) * 2 : ws + WS_DEC + ((size_t)ch0 * 1024 + h * 128 + (lane - 32) * 4) * 4;
#define D3_DMA16(src, off) __builtin_amdgcn_global_load_lds((const unsigned*)(src), (LAS unsigned*)(F.lds + (off)), 16, 0, 0)
#define D3_ISSUE(step, slot) do { if (w < 4) { const int so_ = __builtin_amdgcn_readfirstlane((int)((slot) * DS_SLOT)) + wq * 1024; const size_t go_ = (size_t)(step) * 32768; \
        D3_DMA16(sq + go_, so_ + SC_QI); D3_DMA16(sk + go_, so_ + SC_KT); D3_DMA16(sv + go_, so_ + SC_VT); D3_DMA16(sg + go_, so_ + SC_GATE); \
        if (w == 0) D3_DMA16(sc + (size_t)(step) * 4096, so_ + SC_P); } } while (0)
    __syncthreads();
    f32x4 S[8];
#pragma unroll
    for (int mt = 0; mt < 8; ++mt) S[mt] = (f32x4){0.f, 0.f, 0.f, 0.f};
    for (int s = 0; s < DS_R - 1 && s < nsteps; ++s) D3_ISSUE(s, s);
    f32x4 o_p1 = {0.f, 0.f, 0.f, 0.f}, o_p2 = o_p1, gate_p1 = o_p1, gate_p2 = o_p1;
    int slot = 0;
#pragma unroll 1
    for (int n = 0; n <= nsteps + 2; ++n) {
        if (w < 4) {
            if (n >= DS_R && n + DS_R <= nsteps + 1) { if (w == 0) asm volatile("s_waitcnt vmcnt(20)" ::: "memory"); else asm volatile("s_waitcnt vmcnt(16)" ::: "memory"); }
            else asm volatile("s_waitcnt vmcnt(0)" ::: "memory");
        }
        static_assert(DS_R == 6, "the counted waits above are (DS_R - 2) * 5 and (DS_R - 2) * 4");
        DS_BAR();
        if (rdy && n - 1 + DS_R == rdy_step) flag_wait(rdy, need);
        if (n - 1 + DS_R < nsteps) { const int ps = slot == 0 ? DS_R - 1 : slot - 1; D3_ISSUE(n - 1 + DS_R, ps); }
        const int buf = n & 1;
        f32x4 o = {0.f, 0.f, 0.f, 0.f}, gate = {0.f, 0.f, 0.f, 0.f};
        if (n < nsteps) {
            const LAS unsigned char* B = F.lds + slot * DS_SLOT;
            const bf16x4 vt = *(const LAS bf16x4*)(B + SC_VT + ((e0 + l15) * 16 + 4 * g4) * 2);
            const bf16x4 pa = *(const LAS bf16x4*)(B + SC_P + (l15 * 16 + 4 * g4) * 2);
            const f32x2 dcp = *(const LAS f32x2*)(B + SC_DEC + (16 * (l15 >> 1) + 4 * g4 + 2 * (l15 & 1)) * 4);
            const f32x4 zz = {0.f, 0.f, 0.f, 0.f};
            f32x4 oq[4];
            const f32x4 op = __builtin_amdgcn_mfma_f32_16x16x16bf16_1k(pa, vt, zz, 0, 0, 0);
#pragma unroll
            for (int kk = 0; kk < 4; ++kk) {
                const bf16x4 q0 = *(const LAS bf16x4*)(B + SC_QI + l15 * 256 + (((4 * kk + (g4 >> 1)) ^ l15) << 4) + (g4 & 1) * 8);
                const bf16x4 q1 = *(const LAS bf16x4*)(B + SC_QI + l15 * 256 + (((4 * kk + 2 + (g4 >> 1)) ^ l15) << 4) + (g4 & 1) * 8);
                const bf16x8 qa = {q0[0], q0[1], q0[2], q0[3], q1[0], q1[1], q1[2], q1[3]};
                const u32x4 sb8 = pack8(S[2 * kk], S[2 * kk + 1]);
                oq[kk] = __builtin_amdgcn_mfma_f32_16x16x32_bf16(qa, __builtin_bit_cast(bf16x8, sb8), zz, 0, 0, 0);
            }
            bf16x4 kt[8];
#pragma unroll
            for (int mt = 0; mt < 8; ++mt) kt[mt] = *(const LAS bf16x4*)(B + SC_KT + ((16 * mt + l15) * 16 + 4 * g4) * 2);
#pragma unroll
            for (int mt = 0; mt < 8; ++mt) S[mt] = __builtin_amdgcn_mfma_f32_16x16x16bf16_1k(kt[mt], vt, S[mt], 0, 0, 0);
            scan_decay<0>(S[0], dcp[0], dcp[1]); scan_decay<1>(S[1], dcp[0], dcp[1]); scan_decay<2>(S[2], dcp[0], dcp[1]); scan_decay<3>(S[3], dcp[0], dcp[1]);
            scan_decay<4>(S[4], dcp[0], dcp[1]); scan_decay<5>(S[5], dcp[0], dcp[1]); scan_decay<6>(S[6], dcp[0], dcp[1]); scan_decay<7>(S[7], dcp[0], dcp[1]);
            o = ((oq[0] + oq[2]) + op) + (oq[1] + oq[3]);
#pragma unroll
            for (int r = 0; r < 4; ++r) {
                const int t = 4 * g4 + r;
                gate[r] = bf2f(*(const LAS unsigned short*)(B + SC_GATE + t * 256 + (((2 * w + (l15 >> 3)) ^ t) << 4) + (l15 & 7) * 2));
                const float ss = row16_sum(o[r] * o[r]);
                if (l15 == 0) RED[(buf * 16 + t) * 8 + w] = ss;
            }
        }
        if (n > 0 && n <= nsteps) {
            const int i = lane & 15, t = 2 * w + (i >> 3);
            float v = RED[((buf ^ 1) * 16 + t) * 8 + (i & 7)];
            v += dpp_mov<0xB1>(v); v += dpp_mov<0x4E>(v); v += dpp_mov<0x141>(v);
            const float rs = __builtin_amdgcn_rsqf(v * (1.0f / 128.0f) + RMS_EPS);
            if (lane < 16 && (lane & 7) == 0) RS[(buf ^ 1) * 16 + t] = rs;
        }
        if (n > 1 && n <= nsteps + 1) {
            const f32x4 rs4 = *(const LAS f32x4*)(RS + buf * 16 + 4 * g4);
#pragma unroll
            for (int r = 0; r < 4; ++r) OUTB[(buf * 16 + 4 * g4 + r) * 128 + e0 + l15] = f2bf(o_p2[r] * rs4[r] * onw * gate_p2[r]);
        }
        if (n > 2 && w >= 4) {
            const int i = (w - 4) * 64 + lane, t = i >> 4, p = i & 15;
            *(u32x4*)(MIX + (size_t)(mrow0 + 16 * (n - 3) + t) * DM + h * 128 + p * 8) = *(const LAS u32x4*)(OUTB + ((buf ^ 1) * 16 + t) * 128 + p * 8);
        }
        o_p2 = o_p1; gate_p2 = gate_p1; o_p1 = o; gate_p1 = gate;
        slot = slot == DS_R - 1 ? 0 : slot + 1;
    }
    asm volatile("s_waitcnt vmcnt(0)" ::: "memory");
    __syncthreads();
#pragma unroll
    for (int mt = 0; mt < 8; ++mt)
#pragma unroll
        for (int r = 0; r < 4; ++r) ST[(16 * mt + 4 * g4 + r) * DS_STS + e0 + l15] = S[mt][r];
    __syncthreads();
#pragma unroll
    for (int i = 0; i < 8; ++i) { const int idx = F.tid + 512 * i, c = idx >> 5, e4 = idx & 31; *(f32x4*)(Sout + (size_t)c * 128 + e4 * 4) = *(const LAS f32x4*)(ST + c * DS_STS + e4 * 4); }
#undef D3_ISSUE
#undef D3_DMA16
}

__device__ __forceinline__ void hgrn_scan_dma(Frame& F, int ch0, int nsteps, int h, int mrow0, int nvalid, const float* S0, float* Sout) {
#ifdef HY_DMA1
    hgrn_scan_dma_t<0>(F, ch0, nsteps, h, mrow0, nvalid, S0, Sout, (bf16_t*)(F.ws + WS_MIX), DM, nullptr);
#elif defined(HY_DMA7)
    hgrn_scan_dma7(F, ch0, nsteps, h, mrow0, Sout);
#elif defined(HY_DMA6)
    hgrn_scan_dma6(F, ch0, nsteps, h, mrow0, Sout);
#elif defined(HY_DMA5)
    hgrn_scan_dma5(F, ch0, nsteps, h, mrow0, Sout);
#elif defined(HY_DMA4)
    hgrn_scan_dma4(F, ch0, nsteps, h, mrow0, Sout, nullptr, 0u, 0);
#elif defined(HY_DMA2)
    hgrn_scan_dma2(F, ch0, nsteps, h, mrow0, Sout, nullptr, 0u, 0);
#else
    hgrn_scan_dma3(F, ch0, nsteps, h, mrow0, Sout, nullptr, 0u, 0);
#endif
}
__device__ __forceinline__ void hgrn_scan(Frame& F, int ch0, int nsteps, int h, int mrow0, int nvalid, const float* S0, float* Sout) {
    hgrn_scan_t<0>(F, ch0, nsteps, h, mrow0, nvalid, S0, Sout, (bf16_t*)(F.ws + WS_MIX), DM, nullptr);
}


constexpr int SW_KS = 72, SW_VS = 264;
constexpr int SW_K = 0, SW_V = 256 * SW_KS * 2, SW_BT = SW_V + 64 * SW_VS * 2, SW_END = SW_BT + 8 * 160 * 4;
static_assert(SW_END <= LDS_BYTES, "swa LDS");
__device__ __forceinline__ void swa_qtile(Frame& F, int j, int h, size_t qrow, bool qvalid, bool first_block, float sink2) {
    const int lane = F.lane, l15 = lane & 15, g4 = lane >> 4;
    const bf16_t* SQ = (const bf16_t*)(F.ws + WS_SQ); bf16_t* MIX = (bf16_t*)(F.ws + WS_MIX);
    const LAS bf16_t* Kb = (const LAS bf16_t*)(F.lds + SW_K); const LAS bf16_t* Vt = (const LAS bf16_t*)(F.lds + SW_V);
    const LAS float* BT = (const LAS float*)(F.lds + SW_BT) + F.wave * 160;
    bf16x8 qf[2];
#pragma unroll
    for (int kk = 0; kk < 2; ++kk) qf[kk] = *(const bf16x8*)(SQ + qrow * 1024 + h * 64 + 32 * kk + 8 * g4);
    f32x4 s[9]; float mx = sink2;
    const int bidx = 15 + 4 * g4 - l15;
#pragma unroll
    for (int u = 0; u < 9; ++u) {
        const int mt = j + u; f32x4 acc = {0.f, 0.f, 0.f, 0.f};
#pragma unroll
        for (int kk = 0; kk < 2; ++kk) {
            const bf16x8 a = *(const LAS bf16x8*)(Kb + (16 * mt + l15) * SW_KS + 32 * kk + 8 * g4);
            acc = __builtin_amdgcn_mfma_f32_16x16x32_bf16(a, qf[kk], acc, 0, 0, 0);
        }
        const bool dead = first_block && (mt < 8);
#pragma unroll
        for (int r = 0; r < 4; ++r) { float v = acc[r] + BT[bidx + 16 * u + r]; v = dead ? -INFINITY : v; s[u][r] = v; mx = fmaxf(mx, v); }
    }
    mx = fmaxf(mx, __shfl_xor(mx, 16)); mx = fmaxf(mx, __shfl_xor(mx, 32));
    float sum = 0.f; bf16x4 pb[9];
#pragma unroll
    for (int u = 0; u < 9; ++u) {
        f32x4 p;
#pragma unroll
        for (int r = 0; r < 4; ++r) { p[r] = __builtin_amdgcn_exp2f(s[u][r] - mx); sum += p[r]; }
        pb[u] = __builtin_bit_cast(bf16x4, pack4(p));
    }
    sum += __shfl_xor(sum, 16); sum += __shfl_xor(sum, 32);
    sum += __builtin_amdgcn_exp2f(sink2 - mx);
    const float inv = 1.0f / sum;
#pragma unroll
    for (int dt = 0; dt < 4; ++dt) {
        f32x4 o = {0.f, 0.f, 0.f, 0.f};
#pragma unroll
        for (int u = 0; u < 9; ++u) {
            const bf16x4 a = *(const LAS bf16x4*)(Vt + (16 * dt + l15) * SW_VS + 16 * (j + u) + 4 * g4);
            o = __builtin_amdgcn_mfma_f32_16x16x16bf16_1k(a, pb[u], o, 0, 0, 0);
        }
        if (qvalid) *(u32x2*)(MIX + qrow * DM + 1024 + h * 64 + 16 * dt + 4 * g4) = pack4(o * inv);
    }
}
__device__ __forceinline__ void swa_load_tables(Frame& F, int k) {
    const float* BTg = (const float*)(F.ws + WS_TAB + 8192); LAS float* BT = (LAS float*)(F.lds + SW_BT);
    for (int i = F.tid; i < 8 * 160; i += NTHREADS) BT[i] = BTg[k * 8 * 160 + i];
}
__device__ __forceinline__ void swa_prompt_unit(Frame& F, int unit) {
    const int k = unit & 1, n = (unit >> 1) & 31, b = unit >> 6;
    const bf16_t* SKV = (const bf16_t*)(F.ws + WS_SKV);
    LAS bf16_t* Kb = (LAS bf16_t*)(F.lds + SW_K); LAS bf16_t* Vt = (LAS bf16_t*)(F.lds + SW_V);
    __syncthreads();
    swa_load_tables(F, k);
#pragma unroll
    for (int i = 0; i < 4; ++i) {
        const int idx = F.tid + 512 * i, kj = idx >> 3, p = idx & 7, pos = 128 * (n - 1) + kj;
        u32x4 kv = {0u, 0u, 0u, 0u}, vv = {0u, 0u, 0u, 0u};
        if (pos >= 0) { const bf16_t* src = SKV + (size_t)(b * SEQ + pos) * 256 + k * 64 + p * 8; kv = *(const u32x4*)src; vv = *(const u32x4*)(src + 128); }
        *(LAS u32x4*)(Kb + kj * SW_KS + p * 8) = kv;
        const unsigned w[4] = {vv.x, vv.y, vv.z, vv.w};
#pragma unroll
        for (int e = 0; e < 4; ++e) { Vt[(8 * p + 2 * e) * SW_VS + kj] = (bf16_t)(w[e] & 0xffffu); Vt[(8 * p + 2 * e + 1) * SW_VS + kj] = (bf16_t)(w[e] >> 16); }
    }
    __syncthreads();
    const int h = k * 8 + F.wave; const float sink2 = F.in[I_SINKS][h] * LOG2E;
#pragma unroll 1
    for (int j = 0; j < 8; ++j) swa_qtile(F, j, h, (size_t)(b * SEQ + 128 * n + 16 * j + (F.lane & 15)), true, n == 0, sink2);
}
__device__ __forceinline__ void swa_sample_unit(Frame& F, int unit) {
    const int k = unit & 1, b = unit >> 1;
    const bf16_t* SKV = (const bf16_t*)(F.ws + WS_SKV);
    LAS bf16_t* Kb = (LAS bf16_t*)(F.lds + SW_K); LAS bf16_t* Vt = (LAS bf16_t*)(F.lds + SW_V);
    __syncthreads();
    swa_load_tables(F, k);
#pragma unroll
    for (int i = 0; i < 4; ++i) {
        const int idx = F.tid + 512 * i, kj = idx >> 4, p = idx & 15;
        const size_t so = ((size_t)(b * 128 + kj) * 2 + k) * 64 + p * 4;
        const f32x4 kv = *(const f32x4*)(F.in[I_CSK] + so), vv = *(const f32x4*)(F.in[I_CSV] + so);
        *(LAS u32x2*)(Kb + kj * SW_KS + p * 4) = pack4(kv);
#pragma unroll
        for (int e = 0; e < 4; ++e) Vt[(4 * p + e) * SW_VS + kj] = f2bf(vv[e]);
        if (kj >= 4) { const size_t dof = ((size_t)(b * 128 + kj - 4) * 2 + k) * 64 + p * 4; *(f32x4*)(F.out + O_SSK + dof) = kv; *(f32x4*)(F.out + O_SSV + dof) = vv; }
    }
    if (F.tid < 128) {
        const int kj = 128 + (F.tid >> 3), p = F.tid & 7;
        u32x4 kv = {0u, 0u, 0u, 0u}, vv = {0u, 0u, 0u, 0u};
        if (kj < 132) { const bf16_t* src = SKV + (size_t)(TP + 4 * b + (kj - 128)) * 256 + k * 64 + p * 8; kv = *(const u32x4*)src; vv = *(const u32x4*)(src + 128); }
        *(LAS u32x4*)(Kb + kj * SW_KS + p * 8) = kv;
        const unsigned w[4] = {vv.x, vv.y, vv.z, vv.w};
#pragma unroll
        for (int e = 0; e < 4; ++e) { Vt[(8 * p + 2 * e) * SW_VS + kj] = (bf16_t)(w[e] & 0xffffu); Vt[(8 * p + 2 * e + 1) * SW_VS + kj] = (bf16_t)(w[e] >> 16); }
    }
    __syncthreads();
    const int h = k * 8 + F.wave, l15 = F.lane & 15; const float sink2 = F.in[I_SINKS][h] * LOG2E;
    swa_qtile(F, 0, h, (size_t)(TP + 4 * b + (l15 < 4 ? l15 : 3)), l15 < 4, false, sink2);
}

constexpr int MA_KS = 136, MA_VS = 264;
constexpr int MA_K = 0, MA_V = 256 * MA_KS * 2, MA_END = MA_V + 128 * MA_VS * 2;
static_assert(MA_END <= LDS_BYTES, "memattn LDS");
__device__ __forceinline__ void memattn_prompt_unit(Frame& F, int unit) {
    const int h = unit & 3, pm = unit >> 2, b = pm >> 4;
    const bf16_t* MK = (const bf16_t*)(F.ws + WS_MK); const bf16_t* MVT = (const bf16_t*)(F.ws + WS_MVT);
    const bf16_t* QM = (const bf16_t*)(F.ws + WS_QM); bf16_t* OM = (bf16_t*)(F.ws + WS_OM);
    LAS bf16_t* Kh = (LAS bf16_t*)(F.lds + MA_K); LAS bf16_t* Vt = (LAS bf16_t*)(F.lds + MA_V);
    const int lane = F.lane, l15 = lane & 15, g4 = lane >> 4;
    __syncthreads();
#pragma unroll
    for (int i = 0; i < 8; ++i) {
        const int idx = F.tid + 512 * i;
        { const int m = idx >> 4, p = idx & 15; *(LAS u32x4*)(Kh + m * MA_KS + p * 8) = *(const u32x4*)(MK + (size_t)(b * 256 + m) * 512 + h * 128 + p * 8); }
        { const int d = idx >> 5, p = idx & 31; *(LAS u32x4*)(Vt + d * MA_VS + p * 8) = *(const u32x4*)(MVT + ((size_t)(b * 4 + h) * 128 + d) * 256 + p * 8); }
    }
    __syncthreads();
#pragma unroll 1
    for (int jj = 0; jj < 2; ++jj) {
        const size_t row = (size_t)pm * 256 + 16 * (2 * F.wave + jj) + l15;
        bf16x8 qf[4];
#pragma unroll
        for (int kk = 0; kk < 4; ++kk) qf[kk] = *(const bf16x8*)(QM + row * 512 + h * 128 + 32 * kk + 8 * g4);
        f32x4 s[16]; float mx = -INFINITY;
#pragma unroll
        for (int mt = 0; mt < 16; ++mt) {
            f32x4 acc = {0.f, 0.f, 0.f, 0.f};
#pragma unroll
            for (int kk = 0; kk < 4; ++kk) {
                const bf16x8 a = *(const LAS bf16x8*)(Kh + (16 * mt + l15) * MA_KS + 32 * kk + 8 * g4);
                acc = __builtin_amdgcn_mfma_f32_16x16x32_bf16(a, qf[kk], acc, 0, 0, 0);
            }
            s[mt] = acc; mx = fmaxf(fmaxf(mx, fmaxf(acc[0], acc[1])), fmaxf(acc[2], acc[3]));
            __builtin_amdgcn_sched_barrier(0);
        }
        mx = fmaxf(mx, __shfl_xor(mx, 16)); mx = fmaxf(mx, __shfl_xor(mx, 32));
        float sum = 0.f; bf16x8 pb[8];
#pragma unroll
        for (int i = 0; i < 8; ++i) {
            f32x4 p0, p1;
#pragma unroll
            for (int r = 0; r < 4; ++r) { p0[r] = __builtin_amdgcn_exp2f(s[2 * i][r] - mx); p1[r] = __builtin_amdgcn_exp2f(s[2 * i + 1][r] - mx); sum += p0[r] + p1[r]; }
            pb[i] = __builtin_bit_cast(bf16x8, pack8(p0, p1));
        }
        sum += __shfl_xor(sum, 16); sum += __shfl_xor(sum, 32);
        const float inv = 1.0f / sum;
#pragma unroll
        for (int dt = 0; dt < 8; ++dt) {
            f32x4 o = {0.f, 0.f, 0.f, 0.f};
#pragma unroll
            for (int i = 0; i < 8; ++i) {
                const bf16x4 a0 = *(const LAS bf16x4*)(Vt + (16 * dt + l15) * MA_VS + 32 * i + 4 * g4);
                const bf16x4 a1 = *(const LAS bf16x4*)(Vt + (16 * dt + l15) * MA_VS + 32 * i + 16 + 4 * g4);
                const bf16x8 a = {a0[0], a0[1], a0[2], a0[3], a1[0], a1[1], a1[2], a1[3]};
                o = __builtin_amdgcn_mfma_f32_16x16x32_bf16(a, pb[i], o, 0, 0, 0);
            }
            *(u32x2*)(OM + row * 512 + h * 128 + 16 * dt + 4 * g4) = pack4(o * inv);
            __builtin_amdgcn_sched_barrier(0);
        }
    }
}
constexpr int MSP_P = 0, MSP_O = 8192, MSP_ML = 8192 + 16384;
__device__ __forceinline__ void memattn_sample_block(Frame& F, int task) {
    const int hp = task & 1, b = task >> 1, w = F.wave, h = 2 * hp + (w >> 2), kq = w & 3;
    const float* CK = F.in[I_CMK] + ((size_t)b * 256 + 64 * kq) * 512 + h * 128; const float* CV = F.in[I_CMV] + ((size_t)b * 256 + 64 * kq) * 512 + h * 128;
    const bf16_t* QM = (const bf16_t*)(F.ws + WS_QM); bf16_t* OM = (bf16_t*)(F.ws + WS_OM);
    const int lane = F.lane, l15 = lane & 15, g4 = lane >> 4;
    LAS float* pl = (LAS float*)(F.lds + MSP_P) + w * 256; LAS float* po = (LAS float*)(F.lds + MSP_O) + w * 512; LAS float* ml = (LAS float*)(F.lds + MSP_ML);
    __syncthreads();
    bf16x8 qf[4];
#pragma unroll
    for (int kk = 0; kk < 4; ++kk) { qf[kk] = *(const bf16x8*)(QM + (size_t)(TP + 4 * b + (l15 & 3)) * 512 + h * 128 + 32 * kk + 8 * g4); if (l15 >= 4) qf[kk] = (bf16x8){0, 0, 0, 0, 0, 0, 0, 0}; }
    f32x4 s[4]; float mx = -INFINITY;
#pragma unroll
    for (int mt = 0; mt < 4; ++mt) {
        f32x4 acc = {0.f, 0.f, 0.f, 0.f};
#pragma unroll
        for (int kk = 0; kk < 4; ++kk) {
            const float* kp = CK + (size_t)(16 * mt + l15) * 512 + 32 * kk + 8 * g4;
            const u32x4 a = pack8(*(const f32x4*)kp, *(const f32x4*)(kp + 4));
            acc = __builtin_amdgcn_mfma_f32_16x16x32_bf16(__builtin_bit_cast(bf16x8, a), qf[kk], acc, 0, 0, 0);
        }
        s[mt] = acc; mx = fmaxf(fmaxf(mx, fmaxf(acc[0], acc[1])), fmaxf(acc[2], acc[3]));
    }
    mx = fmaxf(mx, __shfl_xor(mx, 16)); mx = fmaxf(mx, __shfl_xor(mx, 32));
    float sum = 0.f;
#pragma unroll
    for (int mt = 0; mt < 4; ++mt)
#pragma unroll
        for (int r = 0; r < 4; ++r) { const float p = __builtin_amdgcn_exp2f(s[mt][r] - mx); sum += p; if (l15 < 4) pl[(16 * mt + 4 * g4 + r) * 4 + l15] = p; }
    sum += __shfl_xor(sum, 16); sum += __shfl_xor(sum, 32);
    if (lane < 4) { ml[w * 8 + lane] = mx; ml[w * 8 + 4 + lane] = sum; }
    LDS_WAIT(); asm volatile("" ::: "memory");
    f32x2 o[4] = {{0.f, 0.f}, {0.f, 0.f}, {0.f, 0.f}, {0.f, 0.f}};
#pragma unroll 16
    for (int m = 0; m < 64; ++m) {
        const f32x2 v = *(const f32x2*)(CV + (size_t)m * 512 + 2 * lane);
        const f32x4 p = *(const LAS f32x4*)(pl + m * 4);
#pragma unroll
        for (int t = 0; t < 4; ++t) { o[t][0] += p[t] * v[0]; o[t][1] += p[t] * v[1]; }
    }
#pragma unroll
    for (int t = 0; t < 4; ++t) *(LAS f32x2*)(po + t * 128 + 2 * lane) = o[t];
    __syncthreads();
    {
        const int hh = F.tid >> 8, t = (F.tid >> 6) & 3, d = 2 * (F.tid & 63);
        float mq[4], M = -INFINITY;
#pragma unroll
        for (int q = 0; q < 4; ++q) { mq[q] = ml[(hh * 4 + q) * 8 + t]; M = fmaxf(M, mq[q]); }
        float den = 0.f; f32x2 num = {0.f, 0.f};
#pragma unroll
        for (int q = 0; q < 4; ++q) { const float f = __builtin_amdgcn_exp2f(mq[q] - M); den += f * ml[(hh * 4 + q) * 8 + 4 + t];
            const f32x2 oq = *(const LAS f32x2*)((LAS float*)(F.lds + MSP_O) + (hh * 4 + q) * 512 + t * 128 + d); num[0] += f * oq[0]; num[1] += f * oq[1]; }
        const float inv = 1.0f / den;
        *(unsigned*)(OM + (size_t)(TP + 4 * b + t) * 512 + (2 * hp + hh) * 128 + d) = cvtpk(num[0] * inv, num[1] * inv);
    }
}

__device__ __forceinline__ f32x4 bf4_f32(u32x2 w) { f32x4 v; v[0] = __uint_as_float(w.x << 16); v[1] = __uint_as_float(w.x & 0xffff0000u); v[2] = __uint_as_float(w.y << 16); v[3] = __uint_as_float(w.y & 0xffff0000u); return v; }
__device__ __forceinline__ void final_norm_row_slabs_b(float* yrow, const bf16_t* xbrow, const float* slab_row, size_t slab_stride, int ns, const float* w, int lane) {
    f32x4* yr = (f32x4*)yrow + lane; const u32x2* xr = (const u32x2*)xbrow + lane; const f32x4* wr = (const f32x4*)w + lane;
    f32x4 v[8]; float s = 0.f;
#pragma unroll
    for (int j = 0; j < 8; ++j) v[j] = bf4_f32(xr[64 * j]);
    for (int k = 0; k < ns; ++k) { const f32x4* sr = (const f32x4*)(slab_row + (size_t)k * slab_stride) + lane;
#pragma unroll
        for (int j = 0; j < 8; ++j) v[j] += sr[64 * j]; }
#pragma unroll
    for (int j = 0; j < 8; ++j) s += (v[j][0] * v[j][0] + v[j][1] * v[j][1]) + (v[j][2] * v[j][2] + v[j][3] * v[j][3]);
    const float rs = __builtin_amdgcn_rsqf(wave_sum(s) * (1.0f / DM) + RMS_EPS);
#pragma unroll
    for (int j = 0; j < 8; ++j) { const f32x4 ww = wr[64 * j]; f32x4 y; y[0] = v[j][0] * rs * ww[0]; y[1] = v[j][1] * rs * ww[1]; y[2] = v[j][2] * rs * ww[2]; y[3] = v[j][3] * rs * ww[3]; __builtin_nontemporal_store(y, &yr[64 * j]); }
}
__device__ __forceinline__ void final_norm_row_b(float* yrow, const bf16_t* xbrow, const float* SS, int row, const float* w, int lane) {
    const float rs = row_rs(SS, row);
    f32x4* yr = (f32x4*)yrow + lane; const u32x2* xr = (const u32x2*)xbrow + lane; const f32x4* wr = (const f32x4*)w + lane;
#pragma unroll
    for (int j = 0; j < 8; ++j) { f32x4 v = bf4_f32(xr[64 * j]); const f32x4 ww = wr[64 * j]; v[0] = v[0] * rs * ww[0]; v[1] = v[1] * rs * ww[1]; v[2] = v[2] * rs * ww[2]; v[3] = v[3] * rs * ww[3]; __builtin_nontemporal_store(v, &yr[64 * j]); }
}
__device__ __forceinline__ void final_norm_row_slabs(float* xrow, const float* slab_row, size_t slab_stride, int ns, const float* w, int lane) {
    f32x4* xr = (f32x4*)xrow + lane; const f32x4* wr = (const f32x4*)w + lane;
    f32x4 v[8]; float s = 0.f;
#pragma unroll
    for (int j = 0; j < 8; ++j) v[j] = xr[64 * j];
    for (int k = 0; k < ns; ++k) { const f32x4* sr = (const f32x4*)(slab_row + (size_t)k * slab_stride) + lane;
#pragma unroll
        for (int j = 0; j < 8; ++j) v[j] += sr[64 * j]; }
#pragma unroll
    for (int j = 0; j < 8; ++j) s += (v[j][0] * v[j][0] + v[j][1] * v[j][1]) + (v[j][2] * v[j][2] + v[j][3] * v[j][3]);
    const float rs = __builtin_amdgcn_rsqf(wave_sum(s) * (1.0f / DM) + RMS_EPS);
#pragma unroll
    for (int j = 0; j < 8; ++j) { const f32x4 ww = wr[64 * j]; f32x4 y; y[0] = v[j][0] * rs * ww[0]; y[1] = v[j][1] * rs * ww[1]; y[2] = v[j][2] * rs * ww[2]; y[3] = v[j][3] * rs * ww[3]; xr[64 * j] = y; }
}
__device__ __forceinline__ void final_norm_row(float* xrow, const float* SS, int row, const float* w, int lane) {
    const float rs = row_rs(SS, row);
    f32x4* xr = (f32x4*)xrow + lane; const f32x4* wr = (const f32x4*)w + lane;
#pragma unroll
    for (int j = 0; j < 8; ++j) { f32x4 v = xr[64 * j]; const f32x4 ww = wr[64 * j]; v[0] = v[0] * rs * ww[0]; v[1] = v[1] * rs * ww[1]; v[2] = v[2] * rs * ww[2]; v[3] = v[3] * rs * ww[3]; xr[64 * j] = v; }
}

#ifndef HGRN_SCAN_PROMPT
#define HGRN_SCAN_PROMPT hgrn_scan_dma
#endif
#define HGRN_SCAN_SAMPLE hgrn_scan
#ifdef HY_P3DELAY
#define P3_DELAY do { for (int z_ = 0; z_ < 16; ++z_) __builtin_amdgcn_s_sleep(127); __syncthreads(); } while (0)
#else
#define P3_DELAY do {} while (0)
#endif
#define XB_TMO      128
#define XB_XCNT(j)  (256  + 64 * (j))
#define XB_XSUB(j)  (1280 + 64 * (j))
#define XB_XGEN(j)  (2304 + 64 * (j))
#define XB_TOP      3328
#define XB_TOPGEN   3392
#define XCD_BAR_WORDS 3456
#define XB_SPIN_CAP (1u << 18)

__device__ __forceinline__ unsigned xb_ld(unsigned* p)              { return __hip_atomic_load(p, __ATOMIC_RELAXED, __HIP_MEMORY_SCOPE_AGENT); }
__device__ __forceinline__ unsigned xb_add(unsigned* p, unsigned v) { return __hip_atomic_fetch_add(p, v, __ATOMIC_RELAXED, __HIP_MEMORY_SCOPE_AGENT); }
__device__ __forceinline__ unsigned xb_xcc_id() { return (unsigned)__builtin_amdgcn_s_getreg((3 << 11) | 20) & 0xFu; }
#define XB_SPIN(cond, bar) do { unsigned _sp = 0; while (cond) { __builtin_amdgcn_s_sleep(1); \
    if ((++_sp & 255u) == 0u) { if (xb_ld(&(bar)[XB_TMO])) break; if (_sp > XB_SPIN_CAP) { atomicAdd(&(bar)[XB_TMO], 1u); break; } } } } while (0)

struct XcdBarrier {
    unsigned* bar; unsigned x;
    volatile LAS unsigned* st;
};

__device__ __forceinline__ XcdBarrier xcd_barrier_post(unsigned* bar, volatile LAS unsigned* st) {
    XcdBarrier b; b.bar = bar; b.x = xb_xcc_id(); b.st = st;
    if (threadIdx.x == 0) (void)xb_add(&bar[XB_XCNT(b.x)], 1u);
    return b;
}
__device__ __forceinline__ void xcd_barrier_complete(unsigned* bar, unsigned x, unsigned& nloc, unsigned& nx) {
    const unsigned G = gridDim.x * gridDim.y * gridDim.z;
    unsigned sum, cnt, mine, sp = 0u;
    for (;;) {
        sum = 0u; cnt = 0u; mine = 0u;
#pragma unroll
        for (unsigned j = 0; j < 16; ++j) { const unsigned c = xb_ld(&bar[XB_XCNT(j)]); sum += c; cnt += (c > 0u) ? 1u : 0u; mine = (j == x) ? c : mine; }
        if (sum == G) break;
        __builtin_amdgcn_s_sleep(1);
        if ((++sp & 255u) == 0u) { if (xb_ld(&bar[XB_TMO])) break; if (sp > XB_SPIN_CAP) { atomicAdd(&bar[XB_TMO], 1u); break; } }
    }
    nloc = mine > 0u ? mine : 1u; nx = cnt > 0u ? cnt : 1u;
}

__device__ __forceinline__ void xcd_barrier(const XcdBarrier& b) {
    asm volatile("s_waitcnt vmcnt(0)" ::: "memory");
    __syncthreads();
    if (threadIdx.x == 0) {
        unsigned* bar = b.bar;
        __builtin_amdgcn_s_waitcnt(0);
        unsigned nloc = b.st[0], nx = b.st[1];
        if (nloc == 0u) { xcd_barrier_complete(bar, b.x, nloc, nx); b.st[0] = nloc; b.st[1] = nx; }
        const unsigned old = xb_add(&bar[XB_XSUB(b.x)], 1u);
        const unsigned gen = old / nloc;
        if (old + 1u == (gen + 1u) * nloc) {
            __builtin_amdgcn_fence(__ATOMIC_RELEASE, "agent");
            asm volatile("s_waitcnt vmcnt(0)" ::: "memory");
            const unsigned og = xb_add(&bar[XB_TOP], 1u);
            const unsigned tg = og / nx;
            if (og + 1u == (tg + 1u) * nx) xb_add(&bar[XB_TOPGEN], 1u);
            else XB_SPIN(xb_ld(&bar[XB_TOPGEN]) == tg, bar);
            __builtin_amdgcn_fence(__ATOMIC_ACQUIRE, "agent");
            xb_add(&bar[XB_XGEN(b.x)], 1u);
            asm volatile("s_waitcnt vmcnt(0)" ::: "memory");
        } else {
            XB_SPIN(xb_ld(&bar[XB_XGEN(b.x)]) == gen, bar);
            __builtin_amdgcn_fence(__ATOMIC_ACQUIRE, "agent");
            asm volatile("s_waitcnt vmcnt(0)" ::: "memory");
        }
    }
    __syncthreads();
}

constexpr size_t WS_CH = 4096 + 16384 + 256; constexpr int CH_WORDS = 67 * 64;
#ifndef HY_LINKS
#define HY_LINKS 0
#endif
#if HY_LINKS
#define LINK_ORDER pg8::ChainOrder
#define LINK_SET(...) __VA_ARGS__
#else
#define LINK_ORDER pg8::StaticOrder
#define LINK_SET(...)
#endif
constexpr size_t WS_CNT = 4096 + 16384;
template <class SO> __device__ __forceinline__ void publish_units(const SO& S, unsigned* pub) {
    asm volatile("s_waitcnt vmcnt(0)" ::: "memory"); __syncthreads();
    if (threadIdx.x == 0) {
        __builtin_amdgcn_fence(__ATOMIC_RELEASE, "agent"); asm volatile("s_waitcnt vmcnt(0)" ::: "memory");
        pg8::Unit u; for (int i = 0; S.next(i, u); ++i) { __hip_atomic_fetch_add(pub + 64 * u.pm, 1u, __ATOMIC_RELAXED, __HIP_MEMORY_SCOPE_AGENT); __hip_atomic_fetch_add(pub + 64 * 66, 1u, __ATOMIC_RELAXED, __HIP_MEMORY_SCOPE_AGENT); }
    }
}
constexpr size_t WS_BAR = 4096;
constexpr int LDS_BARST = LDS_BYTES - 64;
constexpr int N_PHASES = 11;
__global__ void __launch_bounds__(NTHREADS, 2) hymba_fwd(Args args) {
    extern __shared__ __attribute__((aligned(16))) unsigned char lds_raw[];
    cg::grid_group grid = cg::this_grid();
    Frame F;
    F.lds = (LAS unsigned char*)lds_raw;
    F.tid = threadIdx.x; F.lane = F.tid & 63; F.wave = __builtin_amdgcn_readfirstlane(F.tid >> 6);
    F.G = gridDim.x; F.bid = blockIdx.x;
    F.in = args.in; F.out = args.out; F.ws = args.ws;
    unsigned char* ws = args.ws; float* out = args.out;
    if (F.tid < 16) ((LAS unsigned*)(F.lds + LDS_BARST))[F.tid] = 0u;
    __syncthreads();
    XcdBarrier xbar = xcd_barrier_post((unsigned*)(ws + WS_BAR), (volatile LAS unsigned*)(F.lds + LDS_BARST));
    if (args.ph_lo > 1000) grid.sync();
#ifdef HY_LDSCLR
    for (int i = F.tid; i < LDS_BYTES / 16; i += NTHREADS) *(LAS u32x4*)(F.lds + i * 16) = (u32x4){0u, 0u, 0u, 0u};
    __syncthreads();
#endif
    const int lo = args.ph_lo, hi = args.ph_hi;
#ifndef HY_PHASE_MASK
#define HY_PHASE_MASK 0x7ff
#endif
#define IN(k) (((HY_PHASE_MASK >> (k)) & 1) && lo <= (k) && (k) < hi)
#ifndef HY_REPMASK
#define HY_REPMASK 0
#endif
#define PHASE(k, ...) do { if (IN(k)) { __VA_ARGS__ } if (IN(k) && ((HY_REPMASK >> (k)) & 1)) { __VA_ARGS__ } } while (0)
#ifdef HY_XACQ
#define SEAM(k) do { if (IN(k) && IN((k) + 1)) { asm volatile("s_waitcnt vmcnt(0)" ::: "memory"); __builtin_amdgcn_fence(__ATOMIC_RELEASE, "agent"); asm volatile("s_waitcnt vmcnt(0)" ::: "memory"); grid.sync(); __builtin_amdgcn_fence(__ATOMIC_ACQUIRE, "agent"); asm volatile("s_waitcnt vmcnt(0)" ::: "memory"); __syncthreads(); } } while (0)
#else
#define SEAM(k) do { if (IN(k) && IN((k) + 1)) { xcd_barrier(xbar); } } while (0)
#endif
#ifndef HY_P1LATE
#define HY_P1LATE 0
#endif
    const bool p1late = HY_P1LATE && F.G == 256 && lo == 0 && hi == N_PHASES; const bool p1shadow = p1late && HY_P1LATE == 2;
    const bool chain = F.G > 32 && lo == 0 && hi == N_PHASES;
    const bool link1 = chain && (HY_LINKS & 1), link2 = chain && (HY_LINKS & 2), link3 = chain && (HY_LINKS & 4);
    unsigned* CH1 = (unsigned*)(ws + WS_CH); unsigned* CH2 = CH1 + CH_WORDS; unsigned* CH3 = CH2 + CH_WORDS; unsigned* CHT = (unsigned*)(ws + WS_BAR) + XB_TMO;
    float* SS0 = (float*)(ws + WS_SS); float* SS1 = (float*)(ws + WS_SS + SS_STRIDE); float* SS2 = (float*)(ws + WS_SS + 2 * SS_STRIDE);
    bf16_t* XB = (bf16_t*)(ws + WS_XB);

#ifndef HY_FILL
#define HY_FILL 0
#endif
    const bool fill = HY_FILL && F.G > 32;
    constexpr int FL_C = CV_ALL - CV_DN, FL_A = CV_EARLY + 4000, FL_B = FL_A + 4300;
#ifndef HY_FILLMASK
#define HY_FILLMASK 15
#endif
#define FILL(bit, nunits, busy_hi, it0, it1) do { const int rem_ = (nunits) % F.G, hi_ = (busy_hi); if (fill && ((HY_FILLMASK >> (bit)) & 1) && F.bid >= rem_ && F.bid < hi_) { __syncthreads(); p0_convert(F, it0, it1, (F.bid - rem_) * NWAVES + F.wave, (hi_ - rem_) * NWAVES); } } while (0)
    PHASE(0, p0_prologue(F, !(F.G > 32)););
    SEAM(0);
    PHASE(1,
        { const int n1 = p1late ? NIN - 512 : NIN;
          pg8::Gemm g{XB, (const bf16_t*)(ws + WS_WIN), TT, n1, DM, DM}; pg8::StaticOrder S; S.init(TT, n1, F.G, F.bid);
          EpiIn E{(bf16_t*)out, (bf16_t*)out + (size_t)TT * 1024, (bf16_t*)(out + O_SST), (bf16_t*)(ws + WS_GATE), (bf16_t*)(ws + WS_SQ), (bf16_t*)(ws + WS_SKV), (const float*)(ws + WS_TAB), out};
          pg8::gemm_phase<EpiIn, pg8::StaticOrder, true, true>(F.lds, g, S, E); }
        { pg8::Gemm g{(const bf16_t*)(ws + WS_MN), (const bf16_t*)(ws + WS_WMKV), 1024, 1024, DM, DM}; pg8::StaticOrder S; S.init(1024, 1024, F.G, (F.bid + 16) % F.G);
          EpiMemKV E{(bf16_t*)(ws + WS_MK), (bf16_t*)(ws + WS_MVT), out};
          pg8::gemm_phase<EpiMemKV, pg8::StaticOrder, true, true>(F.lds, g, S, E); }
        FILL(0, (TT / 256) * (NIN / 256), F.G - 16, CV_EARLY, FL_A);
    );
    SEAM(1);
#ifndef HY_P6ALT
#define HY_P6ALT 0
#endif
#ifndef HY_P2OVL
#define HY_P2OVL 0
#endif
    PHASE(2,
        if (p1late && !p1shadow) {
            constexpr int NPJ = (TT / 256) * 2, NCK = 8 * (256 - NPJ);
            if (F.bid < NPJ) {
                pg8::Gemm g{XB, (const bf16_t*)(ws + WS_WIN) + (size_t)(NIN - 512) * DM, TT, 512, DM, DM}; pg8::StaticOrder S; S.init(TT, 512, NPJ, F.bid);
                EpiIn E{(bf16_t*)out, (bf16_t*)out + (size_t)TT * 1024, (bf16_t*)(out + O_SST), (bf16_t*)(ws + WS_GATE), (bf16_t*)(ws + WS_SQ), (bf16_t*)(ws + WS_SKV), (const float*)(ws + WS_TAB), out, (NIN - 512) / 256};
                pg8::gemm_phase<EpiIn, pg8::StaticOrder, true, true>(F.lds, g, S, E);
                __syncthreads();
                hgrn_prep(F, NCK + F.bid, NCH, NPJ, false);
            } else hgrn_prep(F, F.bid - NPJ, NCK, 256 - NPJ, false);
        } else if (!(HY_P2OVL && F.G > 32)) hgrn_prep(F, F.bid, NCH, F.G, false);
    );
    if (!(HY_P2OVL && F.G > 32)) SEAM(2);
    PHASE(3,
        const bool split = F.G > 32;
        constexpr int NCVA = 5 * 224 * NWAVES, NCVS = 7 * 32 * NWAVES; const bool convsplit = HY_CONVSPLIT && F.G == 256 && !p1shadow && !(HY_FILL && F.G > 32);
#define P3_SCAN do { if (F.bid < 32) { P3_DELAY; for (int bh = F.bid; bh < 32; bh += F.G) { const int b = bh >> 3, h = bh & 7; \
                if (HY_P2OVL && split) { flag_wait(RDY0, (unsigned)(F.G - 32)); hgrn_scan_dma4(F, b * 256, 256, h, b * SEQ, out + O_PST + (size_t)bh * 16384, RDYA, (unsigned)(F.G - 32), (F.G - 32) / 4); } \
                else HGRN_SCAN_PROMPT(F, b * 256, 256, h, b * SEQ, 16, nullptr, out + O_PST + (size_t)bh * 16384); } \
                if (convsplit) { __syncthreads(); p0_convert(F, CV_EARLY + NCVA, CV_EARLY + NCVA + NCVS, F.bid * NWAVES + F.wave, 32 * NWAVES); } } } while (0)
#ifndef HY_CONVSPLIT
#define HY_CONVSPLIT 0
#endif
#ifndef HY_OTHBAL
#define HY_OTHBAL 1
#endif
#define P3_HSAMPLE(tt_) do { const int ts_ = (tt_), bs_ = ts_ >> 3, hs_ = ts_ & 7; HGRN_SCAN_SAMPLE(F, NCHP + bs_, 1, hs_, TP + 4 * bs_, 4, F.in[I_STATE] + (size_t)ts_ * 16384, out + O_SST + (size_t)ts_ * 16384); } while (0)
#define P3_OTHERS do { if (!split || F.bid >= 32) { const int nw = split ? F.G - 32 : F.G; const int c = split ? F.bid - 32 : F.bid; \
            if (HY_OTHBAL && nw == 224) {                \
                for (int i = c; i < 256; i += nw) swa_prompt_unit(F, i); \
                if (c < 32) P3_HSAMPLE(c); \
                else { for (int i = c - 32; i < 256; i += nw - 32) swa_sample_unit(F, i); for (int t = 32 + (c - 32); t < 1024; t += nw - 32) P3_HSAMPLE(t); } \
            } else \
            for (int i = c; i < 1536; i += nw) { \
                if (i < 256) swa_prompt_unit(F, i); \
                else if (i < 512) swa_sample_unit(F, i - 256); \
                else P3_HSAMPLE(i - 512); } } } while (0)
        unsigned* RDY0 = (unsigned*)(ws + WS_CNT) + 16; unsigned* RDYA = (unsigned*)(ws + WS_CNT) + 32;
        if (HY_P2OVL && split && F.bid >= 32) {
            hgrn_prep(F, F.bid - 32, F.G - 32, F.G - 32, true); flag_signal(RDY0);
            hgrn_prep(F, F.bid - 32 + (F.G - 32), NCH, F.G - 32, true); flag_signal(RDYA);
            flag_wait(RDYA, (unsigned)(F.G - 32));
        }
        if (split && F.bid >= 32) { p0_convert(F, CV_IN, CV_MID1, (F.bid - 32) * NWAVES + F.wave, (F.G - 32) * NWAVES); __syncthreads(); }
        constexpr int NPJS = (TT / 256) * 2, NCV1 = 13 * (224 - NPJS) * NWAVES; unsigned* CNT2 = (unsigned*)(ws + WS_CNT) + 48;
        if (p1shadow && F.bid >= 32) {
            if (F.bid - 32 < NPJS) {
                pg8::Gemm g{XB, (const bf16_t*)(ws + WS_WIN) + (size_t)(NIN - 512) * DM, TT, 512, DM, DM}; pg8::StaticOrder S; S.init(TT, 512, NPJS, F.bid - 32);
                EpiIn E{(bf16_t*)out, (bf16_t*)out + (size_t)TT * 1024, (bf16_t*)(out + O_SST), (bf16_t*)(ws + WS_GATE), (bf16_t*)(ws + WS_SQ), (bf16_t*)(ws + WS_SKV), (const float*)(ws + WS_TAB), out, (NIN - 512) / 256};
                pg8::gemm_phase<EpiIn, pg8::StaticOrder, true, true>(F.lds, g, S, E);
            } else p0_convert(F, CV_EARLY, CV_EARLY + NCV1, (F.bid - 32 - NPJS) * NWAVES + F.wave, (F.G - 32 - NPJS) * NWAVES);
            flag_signal(CNT2); flag_wait(CNT2, (unsigned)(F.G - 32));
        }
        P3_SCAN;
        if ((HY_REPMASK >> 11) & 1) P3_SCAN;
        P3_OTHERS;
        if ((HY_REPMASK >> 12) & 1) P3_OTHERS;
        if (split && F.bid >= 32) {
            const int nw = F.G - 32; unsigned* CNT = (unsigned*)(ws + WS_CNT);
            asm volatile("s_waitcnt vmcnt(0)" ::: "memory"); __syncthreads();
            if (F.tid == 0) {
                __builtin_amdgcn_fence(__ATOMIC_RELEASE, "agent"); asm volatile("s_waitcnt vmcnt(0)" ::: "memory");
                __hip_atomic_fetch_add(CNT, 1u, __ATOMIC_RELAXED, __HIP_MEMORY_SCOPE_AGENT);
                unsigned sp = 0; while (__hip_atomic_load(CNT, __ATOMIC_RELAXED, __HIP_MEMORY_SCOPE_AGENT) < (unsigned)nw) { __builtin_amdgcn_s_sleep(2); if (++sp > (1u << 22)) break; }
                __builtin_amdgcn_fence(__ATOMIC_ACQUIRE, "agent"); asm volatile("s_waitcnt vmcnt(0)" ::: "memory");
            }
            __syncthreads();
            if (F.bid - 32 < nw - 16) {
                pg8::Gemm g{(const bf16_t*)(ws + WS_MIX), (const bf16_t*)(ws + WS_WOUT), TP, DM, DM / 2, DM}; pg8::StaticOrder S; S.init(TP, DM, nw - 16, F.bid - 32); S.ksv = 1;
                EpiResidB E{F.in[I_XP], F.in[I_XS], XB, nullptr};
                pg8::gemm_phase<EpiResidB, pg8::StaticOrder, true, true>(F.lds, g, S, E);
                if ((HY_REPMASK >> 13) & 1) { __syncthreads(); pg8::gemm_phase<EpiResidB, pg8::StaticOrder, true, true>(F.lds, g, S, E); }
            } else {
                pg8::Gemm g{(const bf16_t*)(ws + WS_MIX), (const bf16_t*)(ws + WS_WOUT), TT, DM, DM, DM}; SplitOrder S{F.bid - 32 - (nw - 16), 1};
                EpiResidB E{F.in[I_XP], F.in[I_XS], XB, SS0};
                pg8::gemm_phase<EpiResidB, SplitOrder, true, true>(F.lds, g, S, E);
            }
            __syncthreads();
            if ((HY_REPMASK >> 14) & 1) { p0_convert(F, CV_EARLY, CV_ALL, (F.bid - 32) * NWAVES + F.wave, nw * NWAVES); __syncthreads(); }
            if (p1shadow) { if (F.bid - 32 >= 96) p0_convert(F, CV_EARLY + NCV1, CV_ALL, (F.bid - 32 - 96) * NWAVES + F.wave, (nw - 96) * NWAVES); }
            else if (!fill) {
                if (convsplit) {
                    p0_convert(F, CV_EARLY, CV_EARLY + NCVA, (F.bid - 32) * NWAVES + F.wave, nw * NWAVES);
                    if (F.bid - 32 >= 96) p0_convert(F, CV_EARLY + NCVA + NCVS, CV_ALL, (F.bid - 32 - 96) * NWAVES + F.wave, 128 * NWAVES);
                } else {
                    constexpr int NA = 8 * 224 * NWAVES;
                    if (nw == 224 && CV_ALL - CV_EARLY - NA == 3 * 128 * NWAVES) {
                        p0_convert(F, CV_EARLY, CV_EARLY + NA, (F.bid - 32) * NWAVES + F.wave, nw * NWAVES);
                        if (F.bid - 32 >= 96) p0_convert(F, CV_EARLY + NA, CV_ALL, (F.bid - 32 - 96) * NWAVES + F.wave, 128 * NWAVES);
                    } else p0_convert(F, CV_EARLY, CV_ALL, (F.bid - 32) * NWAVES + F.wave, nw * NWAVES);
                }
            }
            else { if (!(HY_FILLMASK & 1)) p0_convert(F, CV_EARLY, FL_A, (F.bid - 32) * NWAVES + F.wave, nw * NWAVES); if (!(HY_FILLMASK & 2)) p0_convert(F, FL_A, FL_B, (F.bid - 32) * NWAVES + F.wave, nw * NWAVES);
                   if (!(HY_FILLMASK & 4)) p0_convert(F, FL_B, FL_C, (F.bid - 32) * NWAVES + F.wave, nw * NWAVES); if (!(HY_FILLMASK & 8)) p0_convert(F, FL_C, CV_ALL, (F.bid - 32) * NWAVES + F.wave, nw * NWAVES); }
        }
    );
    SEAM(3);
    PHASE(4,
        if (!(F.G > 32)) {
            pg8::Gemm g0{(const bf16_t*)(ws + WS_MIX), (const bf16_t*)(ws + WS_WOUT), TT, DM, DM / 2, DM}; pg8::StaticOrder S0; S0.init(TT, DM, F.G, F.bid); S0.ksv = 1;
            EpiResidB E0{F.in[I_XP], F.in[I_XS], XB, nullptr};
            pg8::gemm_phase<EpiResidB, pg8::StaticOrder, true, true>(F.lds, g0, S0, E0);
            xcd_barrier(xbar);
        }
        const int p4m = (F.G > 32) ? TP : TT;
        pg8::Gemm g{(const bf16_t*)(ws + WS_MIX), (const bf16_t*)(ws + WS_WOUT), p4m, DM, DM / 2, DM}; LINK_ORDER S; S.init(p4m, DM, F.G, F.bid);
        EpiResidB E{nullptr, nullptr, XB, SS0};
        pg8::gemm_phase<EpiResidB, LINK_ORDER, true, true>(F.lds, g, S, E);
        LINK_SET(if (link1) publish_units(S, CH1);)
        FILL(1, (TT / 256) * (DM / 256), F.G, FL_A, FL_B);
    );
    if (!link1) SEAM(4);
    PHASE(5,
        pg8::Gemm g{XB, (const bf16_t*)(ws + WS_WMQ), TT, MEMW, DM, DM}; LINK_ORDER S; S.init(TT, MEMW, F.G, F.bid);
        LINK_SET(if (link1) { S.h.ready = CH1; S.h.need = (DM / 256); S.h.total = (TT / 256) * (DM / 256); S.h.tmo = CHT; })
        EpiScaleBf16 E{(bf16_t*)(ws + WS_QM), MEMW, SS0, MEM_QSCALE};
        pg8::gemm_phase<EpiScaleBf16, LINK_ORDER, true, true>(F.lds, g, S, E);
        FILL(2, (TT / 256) * (MEMW / 256), F.G, FL_B, FL_C);
    );
    SEAM(5);
    PHASE(6,
        if (HY_P6ALT && (F.bid & 1)) {
            for (int t = F.bid; t < 256; t += F.G) memattn_sample_block(F, t);
            for (int u = F.bid; u < 256; u += F.G) memattn_prompt_unit(F, u);
        } else {
            for (int u = F.bid; u < 256; u += F.G) memattn_prompt_unit(F, u);
#ifdef HY_P6REP
            if (HY_P6REP & 1) for (int u = F.bid; u < 256; u += F.G) memattn_prompt_unit(F, u);
            if (HY_P6REP & 2) for (int t = F.bid; t < 256; t += F.G) memattn_sample_block(F, t);
#endif
            for (int t = F.bid; t < 256; t += F.G) memattn_sample_block(F, t);
        }
    );
    SEAM(6);
#ifndef HY_P7S
#define HY_P7S 0
#endif
    const bool p7s = HY_P7S && F.G >= 256 && lo == 0 && hi == N_PHASES; unsigned* C7 = (unsigned*)(ws + WS_CH) + 128;
    if (IN(7)) {
        const int p7m = p7s ? TP : TT;
        pg8::Gemm g{(const bf16_t*)(ws + WS_OM), (const bf16_t*)(ws + WS_WMO), p7m, DM, MEMW, MEMW}; LINK_ORDER S; S.init(p7m, DM, F.G, F.bid);
        EpiResidB E{nullptr, nullptr, XB, SS1};
        pg8::gemm_phase<EpiResidB, LINK_ORDER, true, true>(F.lds, g, S, E);
        LINK_SET(if (link2) publish_units(S, CH2);)
    }
    if (!link2) SEAM(7);
#ifndef HY_TAIL89
#define HY_TAIL89 0
#endif
    const bool tail89 = HY_TAIL89 && F.G >= 256 && lo == 0 && hi == N_PHASES;
    unsigned* A8 = (unsigned*)(ws + WS_CH); unsigned* B8 = A8 + 64;
    constexpr int DN_NS = 11; constexpr size_t SLAB_STRIDE = (size_t)TS * DM;
    PHASE(8,
        if (!tail89 && !p7s) {
            pg8::Gemm g{XB, (const bf16_t*)(ws + WS_WGU), TT, 2 * FF, DM, DM}; pg8::StaticOrder S; S.init(TT, 2 * FF, F.G, F.bid);
            EpiSwiGLU E{(bf16_t*)(ws + WS_HID), SS1};
            pg8::gemm_phase<EpiSwiGLU, pg8::StaticOrder, true, true>(F.lds, g, S, E);
        } else {
            if (p7s && F.bid >= F.G - 16) {
                pg8::Gemm g7{(const bf16_t*)(ws + WS_OM), (const bf16_t*)(ws + WS_WMO), TT, DM, MEMW, MEMW}; SplitOrder S7{F.bid - (F.G - 16), 1};
                EpiResidB E7{nullptr, nullptr, XB, SS1};
                pg8::gemm_phase<EpiResidB, SplitOrder, true, true>(F.lds, g7, S7, E7);
                flag_signal(C7);
            }
            { pg8::Gemm g{XB, (const bf16_t*)(ws + WS_WGU), TP, 2 * FF, DM, DM}; pg8::StaticOrder S; S.init(TP, 2 * FF, F.G, F.bid);
              EpiSwiGLU E{(bf16_t*)(ws + WS_HID), SS1};
              pg8::gemm_phase<EpiSwiGLU, pg8::StaticOrder, true, true>(F.lds, g, S, E); }
            if (tail89) flag_signal(A8);
            if (F.bid < 2 * (2 * FF / 256)) {
                if (p7s) flag_wait(C7, 16u);
                pg8::Gemm g{XB, (const bf16_t*)(ws + WS_WGU), TT, 2 * FF, DM, DM}; SampleOrder S{F.bid, 2 * FF / 256};
                EpiSwiGLU E{(bf16_t*)(ws + WS_HID), SS1};
                pg8::gemm_phase<EpiSwiGLU, SampleOrder, true, true>(F.lds, g, S, E);
                if (tail89) flag_signal(B8);
            }
        }
    );
    if (!tail89) SEAM(8);
    if (IN(9)) {
        if (tail89) flag_wait(A8, (unsigned)F.G);
        { pg8::Gemm g{(const bf16_t*)(ws + WS_HID), (const bf16_t*)(ws + WS_WDN), TP, DM, FF, FF}; pg8::StaticOrder S; S.init(TP, DM, F.G, F.bid);
          EpiResidB E{nullptr, nullptr, XB, SS2};
          pg8::gemm_phase<EpiResidB, pg8::StaticOrder, true, true>(F.lds, g, S, E); }
        { const int c9 = tail89 ? F.bid - (F.G - 16 * DN_NS) : F.bid;
          if (c9 >= 0) {
            if (tail89) flag_wait(B8, 2u * (2 * FF / 256));
            pg8::Gemm g{(const bf16_t*)(ws + WS_HID), (const bf16_t*)(ws + WS_WDN), TT, DM, FF / DN_NS, FF}; SplitOrder S{c9, DN_NS};
            EpiSlab E{(float*)(ws + WS_MIX), TP, SLAB_STRIDE};
            pg8::gemm_phase<EpiSlab, SplitOrder, true, true>(F.lds, g, S, E); } }
    }
    SEAM(9);
#ifdef HY_XBAR
    for (int z_ = 0; z_ < HY_XBAR; ++z_) xcd_barrier(xbar);
#endif
    if (IN(10)) {
        for (int m = F.bid * NWAVES + F.wave; m < TT; m += F.G * NWAVES) {
            if (m < TP) final_norm_row_b(out + (size_t)m * DM, XB + (size_t)m * DM, SS2, m, F.in[I_NFINAL], F.lane);
            else final_norm_row_slabs_b(out + (size_t)m * DM, XB + (size_t)m * DM, (const float*)(ws + WS_MIX) + (size_t)(m - TP) * DM, SLAB_STRIDE, DN_NS, F.in[I_NFINAL], F.lane);
        }
    }
#undef IN
#undef SEAM
}

#ifndef HY_N_LAUNCHES
#define HY_N_LAUNCHES 1
#endif
extern "C" void kernel_launch(void* const* d_in, const int* in_sizes, int n_in, void* d_out, int out_size, void* d_ws, size_t ws_size, hipStream_t stream) {
    static int grid = 0;
    if (grid == 0) {
        if (n_in != 26 || (size_t)out_size != O_END || ws_size < WS_END) { fprintf(stderr, "kernel_launch: unexpected problem: n_in %d out %d ws %zu (need %zu)\n", n_in, out_size, ws_size, (size_t)WS_END); grid = -1; return; }
        int dev = 0, cus = 0, per_cu = 0;
        hipGetDevice(&dev); hipDeviceGetAttribute(&cus, hipDeviceAttributeMultiprocessorCount, dev);
        if (hipFuncSetAttribute((const void*)hymba_fwd, hipFuncAttributeMaxDynamicSharedMemorySize, LDS_BYTES) != hipSuccess) { fprintf(stderr, "kernel_launch: hipFuncSetAttribute failed\n"); grid = -1; return; }
        if (hipOccupancyMaxActiveBlocksPerMultiprocessor(&per_cu, (const void*)hymba_fwd, NTHREADS, LDS_BYTES) != hipSuccess || per_cu < 1) { fprintf(stderr, "kernel_launch: occupancy query says %d blocks/CU\n", per_cu); per_cu = 1; }
        (void)hipGetLastError();
        grid = cus;
        fprintf(stderr, "kernel_launch: %d CUs, occupancy %d blocks/CU, grid %d\n", cus, per_cu, grid);
    }
    if (grid < 0) return;
    Args a{};
    for (int i = 0; i < 26; ++i) a.in[i] = (const float*)d_in[i];
    a.out = (float*)d_out; a.ws = (unsigned char*)d_ws;
    if (hipMemsetAsync((char*)d_ws + WS_BAR, 0, 16384 + 256 + 3 * CH_WORDS * 4, stream) != hipSuccess) { fprintf(stderr, "kernel_launch: hipMemsetAsync failed\n"); return; }
#if HY_N_LAUNCHES == 1
    a.ph_lo = 0; a.ph_hi = N_PHASES;
    void* kargs[] = {&a};
    hipError_t e = hipLaunchCooperativeKernel((const void*)hymba_fwd, dim3(grid), dim3(NTHREADS), kargs, LDS_BYTES, stream);
    if (e != hipSuccess) fprintf(stderr, "kernel_launch: cooperative launch failed: %s\n", hipGetErrorString(e));
#else
    for (int p = 0; p < N_PHASES; ++p) {
        a.ph_lo = p; a.ph_hi = p + 1;
        hipLaunchKernelGGL(hymba_fwd, dim3(grid), dim3(NTHREADS), LDS_BYTES, stream, a);
    }
#endif
}
```
